# Optimizing an MI355X kernel written in HIP

```python
import jax, jax.numpy as jnp
from jax import lax
import numpy as np

D_MODEL = 1024
BATCH = 32
SEQ = 2048
DEPTH = 4

HG_HEADS = 8
HG_DK = D_MODEL // HG_HEADS
HG_DV = D_MODEL // HG_HEADS
HG_WIDTH = HG_HEADS * HG_DK
HG_CHUNK = 32
S5_WIDTH = D_MODEL
S5_GROUP = 16
S5_GROUPS = S5_WIDTH // S5_GROUP
S5_STATE = 64
S5_DT_MIN = 1e-3
S5_DT_MAX = 1e-1
PEER_HEADS = 8
PEER_NKEYS = 128
PEER_EXPERTS = PEER_NKEYS * PEER_NKEYS
PEER_QDIM = 256
PEER_HALF = PEER_QDIM // 2
PEER_TOPK = 16
PEER_BLOCK = 128
IN_COLS = 4 * HG_WIDTH + S5_WIDTH + 2 * D_MODEL
N_MOD = 6
EPS = 1e-6

kernel_name = "hybrid_hgrn2_s5_peer_adaln"


def rms_norm(x, g):
    x32 = x.astype(jnp.float32)
    y = x32 * lax.rsqrt(jnp.mean(x32 * x32, axis=-1, keepdims=True) + EPS)
    return (y * g.astype(jnp.float32)).astype(x.dtype)


def modulate(h, shift, scale):
    return h * (1.0 + scale[:, None, :]) + shift[:, None, :]


def hgrn2_branch(q_pre, f_pre, i_in, og, lb, norm_g):
    dt = q_pre.dtype
    B_, L = q_pre.shape[0], q_pre.shape[1]
    n_chunks = L // HG_CHUNK
    f32 = f_pre.astype(jnp.float32)
    q = jax.nn.silu(q_pre.astype(jnp.float32))
    log_f = jnp.logaddexp(jnp.log(lb), jnp.log1p(-lb) + jax.nn.log_sigmoid(f32))
    k = (1.0 - lb) * jax.nn.sigmoid(-f32)
    v = i_in.astype(jnp.float32)

    def to_chunks(t, d):
        return t.reshape(B_, n_chunks, HG_CHUNK, HG_HEADS, d).transpose(1, 0, 3, 2, 4)

    qs, ks, gs = to_chunks(q, HG_DK), to_chunks(k, HG_DK), to_chunks(log_f, HG_DK)
    vs = to_chunks(v, HG_DV)
    causal = jnp.tril(jnp.ones((HG_CHUNK, HG_CHUNK), dtype=bool))[:, :, None]

    def step(S, inp):
        qc, kc, vc, gc = inp
        b = jnp.cumsum(gc, axis=-2)
        inter = jnp.einsum('bhck,bhkv->bhcv', qc * jnp.exp(b), S)
        diff = b[:, :, :, None, :] - b[:, :, None, :, :]
        decay = jnp.where(causal, jnp.exp(jnp.where(causal, diff, 0.0)), 0.0)
        att = jnp.einsum('bhtk,bhsk,bhtsk->bhts', qc, kc, decay)
        intra = jnp.einsum('bhts,bhsv->bhtv', att, vc)
        b_last = b[:, :, -1:, :]
        S_new = jnp.exp(b_last[:, :, 0, :])[..., None] * S + jnp.einsum(
            'bhsk,bhsv->bhkv', kc * jnp.exp(b_last - b), vc)
        return S_new, inter + intra

    S0 = jnp.zeros((B_, HG_HEADS, HG_DK, HG_DV), jnp.float32)
    _, o = lax.scan(step, S0, (qs, ks, vs, gs))
    o = o.transpose(1, 0, 3, 2, 4).reshape(B_, L, HG_HEADS, HG_DV)
    o = o * lax.rsqrt(jnp.mean(o * o, axis=-1, keepdims=True) + EPS) * norm_g.astype(jnp.float32)
    o = o.reshape(B_, L, HG_HEADS * HG_DV) * jax.nn.silu(og.astype(jnp.float32))
    return o.astype(dt)


def s5_branch(u, a_re, a_im, log_dt, b_re, b_im, c_re, c_im, d_skip):
    dt_in = u.dtype
    B_, L = u.shape[0], u.shape[1]
    ug = u.astype(jnp.float32).reshape(B_, L, S5_GROUPS, S5_GROUP)
    a_re, a_im = a_re.astype(jnp.float32), a_im.astype(jnp.float32)
    b_re, b_im = b_re.astype(jnp.float32), b_im.astype(jnp.float32)
    c_re, c_im = c_re.astype(jnp.float32), c_im.astype(jnp.float32)
    step = jnp.exp(log_dt.astype(jnp.float32))[:, None]
    mag = jnp.exp(step * a_re)
    ang = step * a_im
    ab_re, ab_im = mag * jnp.cos(ang), mag * jnp.sin(ang)
    den = a_re * a_re + a_im * a_im
    z_re = ((ab_re - 1.0) * a_re + ab_im * a_im) / den
    z_im = (ab_im * a_re - (ab_re - 1.0) * a_im) / den
    bb_re = z_re[..., None] * b_re - z_im[..., None] * b_im
    bb_im = z_re[..., None] * b_im + z_im[..., None] * b_re
    bu_re = jnp.einsum('blgc,gpc->blgp', ug, bb_re)
    bu_im = jnp.einsum('blgc,gpc->blgp', ug, bb_im)
    ar = jnp.broadcast_to(ab_re, bu_re.shape)
    ai = jnp.broadcast_to(ab_im, bu_im.shape)

    def combine(e1, e2):
        a1r, a1i, b1r, b1i = e1
        a2r, a2i, b2r, b2i = e2
        return (a1r * a2r - a1i * a2i,
                a1r * a2i + a1i * a2r,
                a2r * b1r - a2i * b1i + b2r,
                a2r * b1i + a2i * b1r + b2i)

    _, _, xr, xi = lax.associative_scan(combine, (ar, ai, bu_re, bu_im), axis=1)
    y = (jnp.einsum('blgp,gcp->blgc', xr, c_re) - jnp.einsum('blgp,gcp->blgc', xi, c_im)
         + d_skip.astype(jnp.float32).reshape(S5_GROUPS, S5_GROUP) * ug)
    return y.reshape(B_, L, S5_WIDTH).astype(dt_in)


def peer_layer(h, wq, subkeys, u_tab, v_tab):
    B_, L, D = h.shape
    dt = h.dtype
    n_blocks = (B_ * L) // PEER_BLOCK
    blocks = h.reshape(n_blocks, PEER_BLOCK, D)
    keys32 = subkeys.astype(jnp.float32)

    def peer_block(hb):
        q = (hb @ wq).astype(jnp.float32).reshape(PEER_BLOCK, PEER_HEADS, 2, PEER_HALF)
        s = jnp.einsum('thpd,hpnd->thpn', q, keys32)
        s1_v, s1_i = lax.top_k(s[:, :, 0, :], PEER_TOPK)
        s2_v, s2_i = lax.top_k(s[:, :, 1, :], PEER_TOPK)
        cand_v = (s1_v[..., :, None] + s2_v[..., None, :]).reshape(PEER_BLOCK, PEER_HEADS, PEER_TOPK * PEER_TOPK)
        cand_i = (s1_i[..., :, None] * PEER_NKEYS + s2_i[..., None, :]).reshape(PEER_BLOCK, PEER_HEADS, PEER_TOPK * PEER_TOPK)
        top_v, top_j = lax.top_k(cand_v, PEER_TOPK)
        idx = jnp.take_along_axis(cand_i, top_j, axis=-1)
        gate = jax.nn.softmax(top_v, axis=-1)
        u_sel = jnp.take(u_tab, idx, axis=0)
        v_sel = jnp.take(v_tab, idx, axis=0)
        act = jax.nn.gelu(jnp.einsum('thkd,td->thk', u_sel, hb).astype(jnp.float32))
        return jnp.einsum('thk,thkd->td', (gate * act).astype(dt), v_sel)

    out = lax.map(peer_block, blocks)
    return out.reshape(B_, L, D)


def setup_inputs(seed: int = 0) -> dict:
    key = jax.random.key(seed)
    ks = jax.random.split(key, 26)
    f = jnp.float32
    nrm = lambda k, shape, s: jax.random.normal(k, shape, f) * s
    n_idx = jnp.arange(S5_STATE, dtype=f)
    inp = {}
    inp['x'] = nrm(ks[0], (BATCH, SEQ, D_MODEL), 1.0)
    inp['c'] = nrm(ks[1], (BATCH, D_MODEL), 1.0)
    inp['ada_w'] = nrm(ks[2], (DEPTH, D_MODEL, N_MOD * D_MODEL), 0.5 * D_MODEL ** -0.5)
    inp['ada_b'] = nrm(ks[3], (DEPTH, N_MOD * D_MODEL), 0.02)
    inp['norm1_g'] = 1.0 + nrm(ks[4], (DEPTH, D_MODEL), 0.02)
    inp['norm2_g'] = 1.0 + nrm(ks[5], (DEPTH, D_MODEL), 0.02)
    inp['w_in'] = nrm(ks[6], (DEPTH, D_MODEL, IN_COLS), D_MODEL ** -0.5)
    inp['hg_lb_logits'] = nrm(ks[7], (DEPTH, HG_WIDTH), 0.5)
    inp['hg_norm_g'] = 1.0 + nrm(ks[8], (DEPTH, HG_DV), 0.02)
    inp['s5_a_re'] = -0.5 * (1.0 + nrm(ks[9], (DEPTH, S5_GROUPS, S5_STATE), 0.05))
    inp['s5_a_im'] = jnp.pi * n_idx + nrm(ks[10], (DEPTH, S5_GROUPS, S5_STATE), 0.01)
    inp['s5_log_dt'] = jax.random.uniform(ks[11], (DEPTH, S5_GROUPS), f,
                                          np.log(S5_DT_MIN).astype(np.float32), np.log(S5_DT_MAX).astype(np.float32))
    inp['s5_b_re'] = nrm(ks[12], (DEPTH, S5_GROUPS, S5_STATE, S5_GROUP), (2.0 * S5_GROUP) ** -0.5)
    inp['s5_b_im'] = nrm(ks[13], (DEPTH, S5_GROUPS, S5_STATE, S5_GROUP), (2.0 * S5_GROUP) ** -0.5)
    inp['s5_c_re'] = nrm(ks[14], (DEPTH, S5_GROUPS, S5_GROUP, S5_STATE), (2.0 * S5_STATE) ** -0.5)
    inp['s5_c_im'] = nrm(ks[15], (DEPTH, S5_GROUPS, S5_GROUP, S5_STATE), (2.0 * S5_STATE) ** -0.5)
    inp['s5_d'] = nrm(ks[16], (DEPTH, S5_WIDTH), 1.0)
    inp['glu_w'] = nrm(ks[17], (DEPTH, S5_WIDTH, S5_WIDTH), S5_WIDTH ** -0.5)
    inp['glu_b'] = nrm(ks[18], (DEPTH, S5_WIDTH), 0.02)
    inp['w_out'] = nrm(ks[19], (DEPTH, D_MODEL, D_MODEL), D_MODEL ** -0.5)
    inp['peer_wq'] = nrm(ks[20], (DEPTH, D_MODEL, PEER_HEADS * PEER_QDIM), D_MODEL ** -0.5)
    inp['peer_subkeys'] = nrm(ks[21], (DEPTH, PEER_HEADS, 2, PEER_NKEYS, PEER_HALF), PEER_HALF ** -0.5)
    inp['peer_u'] = nrm(ks[22], (DEPTH, PEER_EXPERTS, D_MODEL), D_MODEL ** -0.5)
    inp['peer_v'] = nrm(ks[23], (DEPTH, PEER_EXPERTS, D_MODEL), PEER_HEADS ** -0.5)
    inp['final_g'] = 1.0 + nrm(ks[24], (D_MODEL,), 0.02)
    return inp


def reference(x, c, ada_w, ada_b, norm1_g, norm2_g, w_in, hg_lb_logits, hg_norm_g,
              s5_a_re, s5_a_im, s5_log_dt, s5_b_re, s5_b_im, s5_c_re, s5_c_im, s5_d,
              glu_w, glu_b, w_out, peer_wq, peer_subkeys, peer_u, peer_v, final_g):
    lb_cum = jnp.cumsum(jax.nn.softmax(hg_lb_logits.astype(jnp.float32), axis=0), axis=0)
    lb_all = lb_cum - lb_cum[0:1]
    c_act = jax.nn.silu(c)
    splits = [HG_WIDTH, 2 * HG_WIDTH, 3 * HG_WIDTH, 4 * HG_WIDTH,
              4 * HG_WIDTH + S5_WIDTH, 4 * HG_WIDTH + S5_WIDTH + D_MODEL]
    for l in range(DEPTH):
        mod = c_act @ ada_w[l] + ada_b[l]
        sh1, sc1, g1, sh2, sc2, g2 = jnp.split(mod, N_MOD, axis=-1)
        h = modulate(rms_norm(x, norm1_g[l]), sh1, sc1)
        proj = h @ w_in[l]
        q_pre, f_pre, i_in, og, u_s5, ga, gb = jnp.split(proj, splits, axis=-1)
        y_a = hgrn2_branch(q_pre, f_pre, i_in, og, lb_all[l], hg_norm_g[l])
        y_s = jax.nn.gelu(s5_branch(u_s5, s5_a_re[l], s5_a_im[l], s5_log_dt[l], s5_b_re[l], s5_b_im[l],
                                    s5_c_re[l], s5_c_im[l], s5_d[l]))
        y_b = y_s * jax.nn.sigmoid(y_s @ glu_w[l] + glu_b[l])
        merged = jax.nn.sigmoid(ga) * y_a + jax.nn.sigmoid(gb) * y_b
        x = x + g1[:, None, :] * (merged @ w_out[l])
        h2 = modulate(rms_norm(x, norm2_g[l]), sh2, sc2)
        x = x + g2[:, None, :] * peer_layer(h2, peer_wq[l], peer_subkeys[l], peer_u[l], peer_v[l])
    return rms_norm(x, final_g)
```

```cpp
#include <hip/hip_runtime.h>
#include <cstdio>
#include <cstdint>

#define DBG_HASHSEL 0
#define DBG_H2_FROM_INPUT 0
#define DBG_NO_YA 0
#define DBG_NO_YB 0
#define DBG_NO_ACC 0
#define DBG_NO_GB 0
#define DBG_S5_NOSSM 0
#define DBG_S5_NOREC 0
#define DBG_SELFCHECK 0
#ifndef MK_LAUNCHES
#define MK_LAUNCHES 1
#endif

#define LAS __attribute__((address_space(3)))
typedef unsigned short bf16_t;
typedef short bf16x8 __attribute__((ext_vector_type(8)));
typedef float f32x2 __attribute__((ext_vector_type(2)));
typedef float f32x4 __attribute__((ext_vector_type(4)));
typedef float f32x16 __attribute__((ext_vector_type(16)));
typedef unsigned u32x2 __attribute__((ext_vector_type(2)));
typedef unsigned u32x4 __attribute__((ext_vector_type(4)));
typedef __bf16 bf16v2 __attribute__((ext_vector_type(2)));
typedef int i32x8 __attribute__((ext_vector_type(8)));
typedef int i32x4 __attribute__((ext_vector_type(4)));

constexpr int D = 1024, BATCH = 32, SEQ = 2048, DEPTH = 4, M = BATCH * SEQ;
constexpr int INC = 7168, NMODC = 6 * D;
constexpr int NPH = 11, GP_SETUP = 0, GP_FINAL = 1 + DEPTH * NPH, GP_END = GP_FINAL + 1;
constexpr float EPS = 1e-6f;
constexpr float U_SCALE = 64.0f, V_SCALE = 4.0f;
constexpr float WIN_SCALE = 64.0f, HIN_SCALE = 4.0f;
constexpr float WO_SCALE = 64.0f, MG_SCALE = 8.0f;

constexpr size_t MiB = 1u << 20;
constexpr size_t WS_CTL = 0, CTL_ZERO_BYTES = 1 * MiB;
constexpr size_t WS_MOD = 1 * MiB;
constexpr size_t WS_LB = 4 * MiB;
constexpr size_t WS_ABAR = 4 * MiB + 65536;
constexpr size_t WS_BOP = 5 * MiB;
constexpr size_t WS_COP = 6 * MiB;
constexpr size_t WS_WIN = 8 * MiB;
constexpr size_t WS_WGLU = 22 * MiB;
constexpr size_t WS_WOUT = 24 * MiB;
constexpr size_t WS_WQ = 26 * MiB;
constexpr size_t WS_KEYS = 30 * MiB;
constexpr size_t WS_U = 32 * MiB;
constexpr size_t WS_V = 64 * MiB;
constexpr size_t WS_H = 96 * MiB;
constexpr size_t WS_OR = 224 * MiB;
constexpr size_t WS_SSQ = 352 * MiB;
constexpr size_t WS_R0 = 354 * MiB;
constexpr size_t WS_SEL = WS_R0 + 256 * MiB;
constexpr size_t WS_YS = WS_R0 + 512 * MiB;
constexpr size_t WS_END = WS_YS + 128 * MiB;

constexpr int LDS_BYTES = 147456;
constexpr int MISC_OFF = LDS_BYTES - 256;

__device__ __forceinline__ unsigned pk2(float lo, float hi) { f32x2 v = {lo, hi}; bf16v2 r = __builtin_convertvector(v, bf16v2); return __builtin_bit_cast(unsigned, r); }
__device__ __forceinline__ float bflo(unsigned w) { return __uint_as_float(w << 16); }
__device__ __forceinline__ float bfhi(unsigned w) { return __uint_as_float(w & 0xffff0000u); }
__device__ __forceinline__ float fsigmoid(float x) { return __builtin_amdgcn_rcpf(1.0f + __expf(-x)); }
__device__ __forceinline__ float fsilu(float x) { return x * fsigmoid(x); }
__device__ __forceinline__ float fgelu(float x) { return x * fsigmoid(1.5957691216f * (x + 0.044715f * x * x * x)); }
__device__ __forceinline__ float wave_sum(float v) {
#pragma unroll
    for (int o = 1; o < 64; o <<= 1) v += __shfl_xor(v, o);
    return v;
}
#define LDS_WAIT() asm volatile("s_waitcnt lgkmcnt(0)" ::: "memory")
#define LDS_BARRIER() asm volatile("s_waitcnt lgkmcnt(0)\n\ts_barrier" ::: "memory")
__device__ __forceinline__ int opaque_tid() { int t = threadIdx.x; asm volatile("" : "+v"(t)); return t; }

namespace pg8 {
#define PG8_LAS __attribute__((address_space(3)))
constexpr int BM = 256, BK = 64, HALF = 128, HTB = HALF * BK * 2, STAGE_BYTES = 8 * HTB, NXCD = 8, WGM = 8;
__host__ __device__ __forceinline__ int lds_byte(int r, int c) { const int st = (r >> 4) * 2 + (c >> 5), rr = r & 15, cc = c & 31, ob = rr * 64 + cc * 2; return st * 1024 + (ob ^ (((ob >> 9) & 1) << 5)); }
__host__ __device__ __forceinline__ void stage_rc(int b, int& R, int& C) { const int st = b / 1024, sb = b % 1024, swz = sb ^ (((sb >> 9) & 1) << 5); R = (st >> 1) * 16 + swz / 64; C = (st & 1) * 32 + (swz % 64) / 2; }
__host__ __device__ __forceinline__ int perm32(int rho) { const int n = rho >> 4, i = rho & 15; return 8 * (i >> 2) + 4 * n + (i & 3); }
struct Unit { int pm, pn; };
struct Gemm { const bf16_t* A; const bf16_t* Bt; int M, N, K, lda, ldb; };
struct StaticOrder {
    int nM, nN, nwg, G, c;
    __host__ __device__ void init(int M_, int N_, int G_, int c_) { nM = M_ / BM; nN = N_ / BM; nwg = nM * nN; G = G_; c = c_; }
    __host__ __device__ bool next(int i, Unit& u) const {
        const long L = (long)i * G + c; if (L >= nwg) return false;
        int wgid = (int)L; { const int q = nwg / NXCD, r = nwg % NXCD, xcd = wgid % NXCD, off = wgid / NXCD; wgid = (xcd < r ? xcd * (q + 1) : r * (q + 1) + (xcd - r) * q) + off; }
        const int nig = WGM * nN, gid = wgid / nig, fm = gid * WGM, gsz = (nM - fm) < WGM ? (nM - fm) : WGM;
        u.pm = fm + ((wgid % nig) % gsz); u.pn = (wgid % nig) / gsz; return true;
    }
    __device__ __forceinline__ void a_ready(const Unit&) const {}
    __device__ __forceinline__ void done(const Unit&) const {}
};
template <class Epi, class Sched, bool ALIGN_EPI = false, bool SP2 = false, bool F8 = false>
__device__ __forceinline__ void gemm_phase(PG8_LAS unsigned char* lds, const Gemm g, const Sched& S, const Epi& E) {
    const int tid = opaque_tid(), wid = __builtin_amdgcn_readfirstlane(tid >> 6), lane = tid & 63, wr = wid >> 2, wc = wid & 3, fr = lane & 15, fq = lane >> 4;
    const int K = g.K, nt = K / BK;
    unsigned voffA[2], voffB[2];
#pragma unroll
    for (int i = 0; i < 2; ++i) { int R, C; stage_rc(tid * 16 + i * 8192, R, C); const int Rb = Epi::PERM ? ((R & ~31) + perm32(R & 31)) : R;
        voffA[i] = (unsigned)(R * g.lda + C) * 2u; voffB[i] = (unsigned)(Rb * g.ldb + C) * 2u; }
    const size_t kstep = (size_t)(BK * 2);
    const size_t hstepA = (size_t)HALF * g.lda * 2, hstepB = (size_t)HALF * g.ldb * 2;
    const size_t tstepA = 2 * hstepA, tstepB = 2 * hstepB;
    const unsigned ldsw = (unsigned)wid * 1024u;
    const int aoff = lds_byte(wr * 64 + fr, fq * 8), boff = lds_byte(wc * 32 + fr, fq * 8);
#define PG8_SA(b, h) (((b) * 2 + (h)) * HTB)
#define PG8_SB(b, h) ((4 + (b) * 2 + (h)) * HTB)
#define PG8_STAGE(bufoff, gbase, voff) do { _Pragma("unroll") for (int _i = 0; _i < 2; ++_i) \
        __builtin_amdgcn_global_load_lds((const unsigned*)((const char*)(gbase) + (voff)[_i]), (PG8_LAS unsigned*)(lds + (bufoff) + ldsw + _i * 8192), 16, 0, 0); } while (0)
#define PG8_LD8(p) __builtin_shufflevector(*(const PG8_LAS i32x4*)(p), *(const PG8_LAS i32x4*)((p) + 1024), 0, 1, 2, 3, 4, 5, 6, 7)
#define PG8_LDA(dst, b, h) do { if constexpr (F8) { _Pragma("unroll") for (int m = 0; m < 4; ++m) dst##8[m] = PG8_LD8(lds + PG8_SA(b, h) + aoff + m * 2048); } \
        else { _Pragma("unroll") for (int m = 0; m < 4; ++m) _Pragma("unroll") for (int k = 0; k < 2; ++k) dst[m][k] = *(const PG8_LAS bf16x8*)(lds + PG8_SA(b, h) + aoff + m * 2048 + k * 1024); } } while (0)
#define PG8_LDB(dst, b, h) do { if constexpr (F8) { _Pragma("unroll") for (int n = 0; n < 2; ++n) dst##8[n] = PG8_LD8(lds + PG8_SB(b, h) + boff + n * 2048); } \
        else { _Pragma("unroll") for (int n = 0; n < 2; ++n) _Pragma("unroll") for (int k = 0; k < 2; ++k) dst[n][k] = *(const PG8_LAS bf16x8*)(lds + PG8_SB(b, h) + boff + n * 2048 + k * 1024); } } while (0)
#define PG8_MMA(ai, bj, At, Bt) do { __builtin_amdgcn_s_setprio(1); _Pragma("unroll") for (int m = 0; m < 4; ++m) _Pragma("unroll") for (int n = 0; n < 2; ++n) { \
        if constexpr (F8) {   \
            acc[ai][bj][m][n] = __builtin_amdgcn_mfma_scale_f32_16x16x128_f8f6f4(Bt##8[n], At##8[m], acc[ai][bj][m][n], 0, 0, 0, 0x7f7f7f7f, 0, 0x7f7f7f7f); \
        } else { _Pragma("unroll") for (int k = 0; k < 2; ++k) acc[ai][bj][m][n] = __builtin_amdgcn_mfma_f32_16x16x32_bf16(Bt[n][k], At[m][k], acc[ai][bj][m][n], 0, 0, 0); } } \
        __builtin_amdgcn_s_setprio(0); } while (0)
#define PG8_WAIT_V(n) asm volatile("s_waitcnt vmcnt(" #n ")" ::: "memory")
#define PG8_WAIT_L(n) asm volatile("s_waitcnt lgkmcnt(" #n ")" ::: "memory")
#define PG8_BAR __builtin_amdgcn_s_barrier()
#define PG8_SCHED __builtin_amdgcn_sched_barrier(0)
    Unit cur, nxt; int ui = 0;
    if (!S.next(0, cur)) return;
    f32x4 acc[2][2][4][2];
#pragma unroll
    for (int a = 0; a < 2; ++a)
#pragma unroll
        for (int b = 0; b < 2; ++b)
#pragma unroll
            for (int m = 0; m < 4; ++m)
#pragma unroll
                for (int n = 0; n < 2; ++n) acc[a][b][m][n] = (f32x4){0.f, 0.f, 0.f, 0.f};
    bf16x8 At[4][2], B0[2][2], B1[2][2]; i32x8 At8[4], B08[2], B18[2];
    const char* cA = (const char*)g.A + (size_t)cur.pm * tstepA; const char* cB = (const char*)g.Bt + (size_t)cur.pn * tstepB;
    S.a_ready(cur);
    if constexpr (SP2) {
        PG8_STAGE(PG8_SB(0, 0), cB, voffB); PG8_STAGE(PG8_SB(0, 1), cB + hstepB, voffB); PG8_STAGE(PG8_SA(0, 0), cA, voffA); PG8_STAGE(PG8_SA(0, 1), cA + hstepA, voffA);
        if (wr == 1) PG8_BAR;
        PG8_WAIT_V(2); PG8_BAR;
        PG8_STAGE(PG8_SB(1, 0), cB + kstep, voffB); PG8_STAGE(PG8_SA(1, 0), cA + kstep, voffA); PG8_STAGE(PG8_SB(1, 1), cB + hstepB + kstep, voffB);
        PG8_WAIT_V(6); PG8_BAR;
    } else {
        PG8_STAGE(PG8_SB(0, 0), cB, voffB); PG8_STAGE(PG8_SA(0, 0), cA, voffA); PG8_STAGE(PG8_SB(0, 1), cB + hstepB, voffB); PG8_STAGE(PG8_SA(0, 1), cA + hstepA, voffA);
        if (wr == 1) PG8_BAR;
        PG8_WAIT_V(4); PG8_BAR;
        PG8_STAGE(PG8_SB(1, 0), cB + kstep, voffB); PG8_STAGE(PG8_SA(1, 0), cA + kstep, voffA); PG8_STAGE(PG8_SB(1, 1), cB + hstepB + kstep, voffB);
        PG8_WAIT_V(6); PG8_BAR;
    }
    for (;;) {
        const bool has_next = S.next(ui + 1, nxt);
        const char* nA = has_next ? (const char*)g.A + (size_t)nxt.pm * tstepA : cA; const char* nB = has_next ? (const char*)g.Bt + (size_t)nxt.pn * tstepB : cB;
        for (int t = 0; t < nt; t += 2) {
            const bool last = (t == nt - 2);
            const char* a1 = cA + (size_t)(t + 1) * kstep;
            const char* a2 = last ? nA : cA + (size_t)(t + 2) * kstep; const char* b2 = last ? nB : cB + (size_t)(t + 2) * kstep;
            const char* a3 = a2 + kstep; const char* b3 = b2 + kstep;
            if (last && has_next) S.a_ready(nxt);
            if constexpr (SP2) {
            PG8_LDB(B0, 0, 0); PG8_LDB(B1, 0, 1); PG8_SCHED; PG8_LDA(At, 0, 0); PG8_STAGE(PG8_SA(1, 1), a1 + hstepA, voffA);
            PG8_WAIT_V(8); PG8_WAIT_L(0); PG8_BAR; PG8_MMA(0, 0, At, B0); PG8_MMA(0, 1, At, B1); PG8_BAR; PG8_SCHED;
            PG8_LDA(At, 0, 1); PG8_STAGE(PG8_SB(0, 0), b2, voffB); PG8_STAGE(PG8_SB(0, 1), b2 + hstepB, voffB); PG8_STAGE(PG8_SA(0, 0), a2, voffA);
            PG8_WAIT_V(8); PG8_WAIT_L(0); PG8_BAR; PG8_MMA(1, 0, At, B0); PG8_MMA(1, 1, At, B1); PG8_BAR; PG8_SCHED;
            PG8_LDB(B0, 1, 0); PG8_LDB(B1, 1, 1); PG8_SCHED; PG8_LDA(At, 1, 0); PG8_STAGE(PG8_SA(0, 1), a2 + hstepA, voffA);
            PG8_WAIT_V(8); PG8_WAIT_L(0); PG8_BAR; PG8_MMA(0, 0, At, B0); PG8_MMA(0, 1, At, B1); PG8_BAR; PG8_SCHED;
            PG8_LDA(At, 1, 1); PG8_STAGE(PG8_SB(1, 0), b3, voffB); PG8_STAGE(PG8_SB(1, 1), b3 + hstepB, voffB); PG8_STAGE(PG8_SA(1, 0), a3, voffA);
            PG8_WAIT_V(8); PG8_WAIT_L(0); PG8_BAR; PG8_MMA(1, 0, At, B0); PG8_MMA(1, 1, At, B1); PG8_BAR; PG8_SCHED;
            } else {
            PG8_LDB(B0, 0, 0); PG8_SCHED; PG8_LDA(At, 0, 0); PG8_STAGE(PG8_SA(1, 1), a1 + hstepA, voffA);
            PG8_WAIT_L(8); PG8_BAR; PG8_WAIT_L(0); PG8_MMA(0, 0, At, B0); PG8_BAR; PG8_SCHED;
            PG8_LDB(B1, 0, 1); PG8_STAGE(PG8_SB(0, 0), b2, voffB);
            PG8_BAR; PG8_WAIT_L(0); PG8_MMA(0, 1, At, B1); PG8_BAR;
            PG8_LDA(At, 0, 1); PG8_STAGE(PG8_SA(0, 0), a2, voffA);
            PG8_BAR; PG8_WAIT_L(0); PG8_MMA(1, 0, At, B0); PG8_BAR; PG8_SCHED;
            PG8_STAGE(PG8_SB(0, 1), b2 + hstepB, voffB);
            PG8_WAIT_V(6); PG8_BAR; PG8_MMA(1, 1, At, B1); PG8_BAR;
            PG8_LDB(B0, 1, 0); PG8_SCHED; PG8_LDA(At, 1, 0); PG8_STAGE(PG8_SA(0, 1), a2 + hstepA, voffA);
            PG8_WAIT_L(8); PG8_BAR; PG8_WAIT_L(0); PG8_MMA(0, 0, At, B0); PG8_BAR; PG8_SCHED;
            PG8_LDB(B1, 1, 1); PG8_STAGE(PG8_SB(1, 0), b3, voffB);
            PG8_BAR; PG8_WAIT_L(0); PG8_MMA(0, 1, At, B1); PG8_BAR;
            PG8_LDA(At, 1, 1); PG8_STAGE(PG8_SA(1, 0), a3, voffA);
            PG8_BAR; PG8_WAIT_L(0); PG8_MMA(1, 0, At, B0); PG8_BAR; PG8_SCHED;
            PG8_STAGE(PG8_SB(1, 1), b3 + hstepB, voffB);
            PG8_WAIT_V(6); PG8_BAR; PG8_MMA(1, 1, At, B1); PG8_BAR;
            }
        }
        if constexpr (ALIGN_EPI) { if (wr == 0) PG8_BAR; }
        E(acc, cur, wr, wc, fr, fq);
        if (!has_next) break;
#pragma unroll
        for (int a = 0; a < 2; ++a)
#pragma unroll
            for (int b = 0; b < 2; ++b)
#pragma unroll
                for (int m = 0; m < 4; ++m)
#pragma unroll
                    for (int n = 0; n < 2; ++n) acc[a][b][m][n] = (f32x4){0.f, 0.f, 0.f, 0.f};
        cur = nxt; cA = nA; cB = nB; ++ui;
        if constexpr (ALIGN_EPI) { if (wr == 1) PG8_BAR; }
    }
    PG8_WAIT_V(0);
    if constexpr (!ALIGN_EPI) { if (wr == 0) PG8_BAR; }
    PG8_BAR;
#undef PG8_SA
#undef PG8_SB
#undef PG8_STAGE
#undef PG8_LDA
#undef PG8_LD8
#undef PG8_LDB
#undef PG8_MMA
#undef PG8_WAIT_V
#undef PG8_WAIT_L
#undef PG8_BAR
#undef PG8_SCHED
}

struct EpiStoreBf16 {
    static constexpr bool PERM = true;
    bf16_t* O; int ldc; float scale;
    __device__ __forceinline__ void operator()(const f32x4 (&acc)[2][2][4][2], const Unit& u, int wr, int wc, int fr, int fq) const {
        const int row0 = u.pm * BM + wr * 64 + fr, col0 = u.pn * BM + wc * 32 + 8 * fq;
#pragma unroll
        for (int ai = 0; ai < 2; ++ai)
#pragma unroll
            for (int m = 0; m < 4; ++m) { bf16_t* rowp = O + (size_t)(row0 + ai * HALF + m * 16) * ldc + col0;
#pragma unroll
                for (int bj = 0; bj < 2; ++bj) { const f32x4 v0 = acc[ai][bj][m][0] * scale, v1 = acc[ai][bj][m][1] * scale;
                    u32x4 w; w.x = pk2(v0[0], v0[1]); w.y = pk2(v0[2], v0[3]); w.z = pk2(v1[0], v1[1]); w.w = pk2(v1[2], v1[3]);
                    *(u32x4*)(rowp + bj * HALF) = w; } }
    }
};
struct EpiStoreQ {
    static constexpr bool PERM = true;
    bf16_t* O;
    __device__ __forceinline__ void operator()(const f32x4 (&acc)[2][2][4][2], const Unit& u, int wr, int wc, int fr, int fq) const {
        const int row0 = u.pm * BM + wr * 64 + fr, col0 = u.pn * BM + wc * 32 + 8 * fq;
#pragma unroll
        for (int ai = 0; ai < 2; ++ai)
#pragma unroll
            for (int m = 0; m < 4; ++m) { const int row = row0 + ai * HALF + m * 16, tg = row >> 5, t = row & 31;
#pragma unroll
                for (int bj = 0; bj < 2; ++bj) { const int c0 = col0 + bj * HALF, h = c0 >> 8, pp = (c0 >> 7) & 1, cc = c0 & 127, ks = cc >> 4, hh = (cc >> 3) & 1;
                    const f32x4 v0 = acc[ai][bj][m][0], v1 = acc[ai][bj][m][1];
                    u32x4 w; w.x = pk2(v0[0], v0[1]); w.y = pk2(v0[2], v0[3]); w.z = pk2(v1[0], v1[1]); w.w = pk2(v1[2], v1[3]);
                    *(u32x4*)(O + ((size_t)((((tg * 8 + h) * 2 + pp) * 8 + ks) * 64 + hh * 32 + t)) * 8) = w; } }
    }
};
struct EpiWout {
    static constexpr bool PERM = false;
    const float* xs; float* out; const float* g1;
    __device__ __forceinline__ void operator()(const f32x4 (&acc)[2][2][4][2], const Unit& u, int wr, int wc, int fr, int fq) const {
        const int row0 = u.pm * BM + wr * 64 + fr, col0 = u.pn * BM + wc * 32 + 4 * fq;
        const int b = (u.pm * BM) >> 11;
        f32x4 gv[2][2];
#pragma unroll
        for (int bj = 0; bj < 2; ++bj)
#pragma unroll
            for (int n = 0; n < 2; ++n) gv[bj][n] = *(const f32x4*)(g1 + (size_t)b * NMODC + col0 + bj * HALF + n * 16);
#pragma unroll
        for (int ai = 0; ai < 2; ++ai)
#pragma unroll
            for (int m = 0; m < 4; ++m) { const size_t off = (size_t)(row0 + ai * HALF + m * 16) * D + col0;
#pragma unroll
                for (int bj = 0; bj < 2; ++bj)
#pragma unroll
                    for (int n = 0; n < 2; ++n) { const f32x4 xv = *(const f32x4*)(xs + off + bj * HALF + n * 16);
                        *(f32x4*)(out + off + bj * HALF + n * 16) = xv + gv[bj][n] * acc[ai][bj][m][n]; } }
    }
};
struct EpiGlu {
    static constexpr bool PERM = true;
    const bf16_t* PB; const bf16_t* YS; const bf16_t* ORAW; const float* SSQ; const float* ng; const float* gb_; bf16_t* O;
    __device__ __forceinline__ void operator()(const f32x4 (&acc)[2][2][4][2], const Unit& u, int wr, int wc, int fr, int fq) const {
        const int row0 = u.pm * BM + wr * 64 + fr, col0 = u.pn * BM + wc * 32 + 8 * fq;
#pragma unroll
        for (int bj = 0; bj < 2; ++bj) {
            const int c = col0 + bj * HALF, head = c >> 7;
            const f32x4 n0 = *(const f32x4*)(ng + (c & 127)), n1 = *(const f32x4*)(ng + (c & 127) + 4);
            const f32x4 b0 = *(const f32x4*)(gb_ + c), b1 = *(const f32x4*)(gb_ + c + 4);
            const float ngv[8] = {n0[0], n0[1], n0[2], n0[3], n1[0], n1[1], n1[2], n1[3]};
            const float bbv[8] = {b0[0], b0[1], b0[2], b0[3], b1[0], b1[1], b1[2], b1[3]};
#pragma unroll
            for (int ai = 0; ai < 2; ++ai)
#pragma unroll
                for (int m = 0; m < 4; ++m) {
                    const int row = row0 + ai * HALF + m * 16;
                    const bf16_t* pb = PB + (size_t)row * 4096 + c;
                    const u32x4 og = *(const u32x4*)(pb), ys = *(const u32x4*)(YS + (size_t)row * D + c), ga = *(const u32x4*)(pb + 2048), gb = *(const u32x4*)(pb + 3072);
                    const u32x4 orw = *(const u32x4*)(ORAW + (size_t)row * D + c);
                    const float rstd = __builtin_amdgcn_rsqf(SSQ[(size_t)row * 8 + head] * (1.0f / 128.0f) + EPS);
                    const f32x4 a0 = acc[ai][bj][m][0], a1 = acc[ai][bj][m][1];
                    const float av[8] = {a0[0], a0[1], a0[2], a0[3], a1[0], a1[1], a1[2], a1[3]};
                    float res[8];
#pragma unroll
                    for (int j = 0; j < 8; ++j) {
                        const unsigned wog = og[j >> 1], wys = ys[j >> 1], wga = ga[j >> 1], wgb = gb[j >> 1], wor = orw[j >> 1];
                        const float fog = (j & 1) ? bfhi(wog) : bflo(wog), fys = (j & 1) ? bfhi(wys) : bflo(wys), fga = (j & 1) ? bfhi(wga) : bflo(wga),
                                    fgb = (j & 1) ? bfhi(wgb) : bflo(wgb), fo = (j & 1) ? bfhi(wor) : bflo(wor);
                        const float ya = fo * rstd * ngv[j] * fsilu(fog);
                        const float yb = fys * fsigmoid((DBG_NO_ACC ? 0.f : av[j]) + bbv[j]);
                        res[j] = (DBG_NO_YA ? 0.f : fsigmoid(fga) * ya) + (DBG_NO_YB ? 0.f : (DBG_NO_GB ? 0.5f : fsigmoid(fgb)) * yb);
                    }
                    int w0 = 0, w1 = 0;
                    w0 = __builtin_amdgcn_cvt_pk_fp8_f32(res[0] * MG_SCALE, res[1] * MG_SCALE, w0, false); w0 = __builtin_amdgcn_cvt_pk_fp8_f32(res[2] * MG_SCALE, res[3] * MG_SCALE, w0, true);
                    w1 = __builtin_amdgcn_cvt_pk_fp8_f32(res[4] * MG_SCALE, res[5] * MG_SCALE, w1, false); w1 = __builtin_amdgcn_cvt_pk_fp8_f32(res[6] * MG_SCALE, res[7] * MG_SCALE, w1, true);
                    *(u32x2*)((unsigned char*)O + (size_t)row * D + c) = (u32x2){(unsigned)w0, (unsigned)w1};
                }
        }
    }
};
}

#define XB_TMO      128
#define XB_XCNT(j)  (256  + 64 * (j))
#define XB_XSUB(j)  (1280 + 64 * (j))
#define XB_XGEN(j)  (2304 + 64 * (j))
#define XB_TOP      3328
#define XB_TOPGEN   3392
#define XCD_BAR_WORDS 3456
#define XB_SPIN_CAP (1u << 25)
__device__ __forceinline__ unsigned xb_ld(unsigned* p)              { return __hip_atomic_load(p, __ATOMIC_RELAXED, __HIP_MEMORY_SCOPE_AGENT); }
__device__ __forceinline__ unsigned xb_add(unsigned* p, unsigned v) { return __hip_atomic_fetch_add(p, v, __ATOMIC_RELAXED, __HIP_MEMORY_SCOPE_AGENT); }
__device__ __forceinline__ unsigned xb_xcc_id() { return (unsigned)__builtin_amdgcn_s_getreg((3 << 11) | 20) & 0xFu; }
#define XB_SPIN(cond, bar) do { unsigned _sp = 0; while (cond) { __builtin_amdgcn_s_sleep(1); \
    if ((++_sp & 255u) == 0u) { if (xb_ld(&(bar)[XB_TMO])) break; if (_sp > XB_SPIN_CAP) { atomicAdd(&(bar)[XB_TMO], 1u); break; } } } } while (0)
struct XcdBarrier { unsigned* bar; unsigned x; volatile LAS unsigned* st; };
__device__ __forceinline__ XcdBarrier xcd_barrier_post(unsigned* bar, volatile LAS unsigned* st) {
    XcdBarrier b; b.bar = bar; b.x = xb_xcc_id(); b.st = st;
    if (threadIdx.x == 0) (void)xb_add(&bar[XB_XCNT(b.x)], 1u);
    return b;
}
__device__ __forceinline__ void xcd_barrier_complete(unsigned* bar, unsigned x, unsigned& nloc, unsigned& nx) {
    const unsigned G = gridDim.x * gridDim.y * gridDim.z;
    unsigned sum, cnt, mine, sp = 0u;
    for (;;) {
        sum = 0u; cnt = 0u; mine = 0u;
#pragma unroll
        for (unsigned j = 0; j < 16; ++j) { const unsigned c = xb_ld(&bar[XB_XCNT(j)]); sum += c; cnt += (c > 0u) ? 1u : 0u; mine = (j == x) ? c : mine; }
        if (sum == G) break;
        __builtin_amdgcn_s_sleep(1);
        if ((++sp & 255u) == 0u) { if (xb_ld(&bar[XB_TMO])) break; if (sp > XB_SPIN_CAP) { atomicAdd(&bar[XB_TMO], 1u); break; } }
    }
    nloc = mine > 0u ? mine : 1u; nx = cnt > 0u ? cnt : 1u;
}
__device__ __forceinline__ void xcd_barrier(const XcdBarrier& b) {
    asm volatile("s_waitcnt vmcnt(0)" ::: "memory");
    __syncthreads();
    if (threadIdx.x == 0) {
        unsigned* bar = b.bar;
        __builtin_amdgcn_s_waitcnt(0);
        unsigned nloc = b.st[0], nx = b.st[1];
        if (nloc == 0u) { xcd_barrier_complete(bar, b.x, nloc, nx); b.st[0] = nloc; b.st[1] = nx; }
        const unsigned old = xb_add(&bar[XB_XSUB(b.x)], 1u);
        const unsigned gen = old / nloc;
        if (old + 1u == (gen + 1u) * nloc) {
            __builtin_amdgcn_fence(__ATOMIC_RELEASE, "agent");
            asm volatile("s_waitcnt vmcnt(0)" ::: "memory");
            const unsigned og = xb_add(&bar[XB_TOP], 1u);
            const unsigned tg = og / nx;
            if (og + 1u == (tg + 1u) * nx) xb_add(&bar[XB_TOPGEN], 1u);
            else XB_SPIN(xb_ld(&bar[XB_TOPGEN]) == tg, bar);
            __builtin_amdgcn_fence(__ATOMIC_ACQUIRE, "agent");
            xb_add(&bar[XB_XGEN(b.x)], 1u);
            asm volatile("s_waitcnt vmcnt(0)" ::: "memory");
        } else {
            XB_SPIN(xb_ld(&bar[XB_XGEN(b.x)]) == gen, bar);
            __builtin_amdgcn_fence(__ATOMIC_ACQUIRE, "agent");
            asm volatile("s_waitcnt vmcnt(0)" ::: "memory");
        }
    }
    __syncthreads();
}

struct KP { const float* in[25]; float* out; unsigned char* ws; int gp_lo, gp_hi; };
enum { I_X = 0, I_C, I_ADAW, I_ADAB, I_N1G, I_N2G, I_WIN, I_LBL, I_HNG, I_ARE, I_AIM, I_LDT, I_BRE, I_BIM, I_CRE, I_CIM, I_S5D, I_GLUW, I_GLUB, I_WOUT, I_WQ, I_SUBK, I_PU, I_PV, I_FG };

typedef const KP __attribute__((address_space(4)))* kp_cptr;
__device__ __forceinline__ KP load_kp() {
#if defined(__HIP_DEVICE_COMPILE__)
    unsigned long long a = (unsigned long long)__builtin_amdgcn_kernarg_segment_ptr(); asm volatile("" : "+s"(a)); return *(kp_cptr)a;
#else
    return KP{};
#endif
}

__device__ __forceinline__ void phase_setup(const KP& p, LAS unsigned char* lds, int G) {
    const int tid = opaque_tid();
    {
        LAS float* cact = (LAS float*)lds;
        for (int it = blockIdx.x; it < 4 * 48; it += G) {
            for (int i = tid; i < 32 * 1024; i += 512) cact[i] = fsilu(p.in[I_C][i]);
            __syncthreads();
            const int l = it / 48, cb = it % 48, col = cb * 128 + (tid & 127), bg = tid >> 7;
            const float* W = p.in[I_ADAW] + (size_t)l * D * NMODC + col;
            float acc[8];
#pragma unroll
            for (int j = 0; j < 8; ++j) acc[j] = 0.f;
            for (int k4 = 0; k4 < 256; ++k4) {
                const float w0 = W[(size_t)(4 * k4 + 0) * NMODC], w1 = W[(size_t)(4 * k4 + 1) * NMODC], w2 = W[(size_t)(4 * k4 + 2) * NMODC], w3 = W[(size_t)(4 * k4 + 3) * NMODC];
#pragma unroll
                for (int j = 0; j < 8; ++j) { const f32x4 c4 = *(const LAS f32x4*)(cact + (8 * bg + j) * 1024 + 4 * k4); acc[j] += c4[0] * w0 + c4[1] * w1 + c4[2] * w2 + c4[3] * w3; }
            }
            float* MOD = (float*)(p.ws + WS_MOD);
            const float bias = p.in[I_ADAB][l * NMODC + col];
#pragma unroll
            for (int j = 0; j < 8; ++j) MOD[((size_t)l * 32 + 8 * bg + j) * NMODC + col] = acc[j] + bias;
            __syncthreads();
        }
    }
    const int gtid = blockIdx.x * 512 + tid;
    if (gtid < 1024) {
        const float* lg = p.in[I_LBL]; float v[4], mx = -1e30f;
#pragma unroll
        for (int l = 0; l < 4; ++l) { v[l] = lg[l * 1024 + gtid]; mx = fmaxf(mx, v[l]); }
        float s = 0.f;
#pragma unroll
        for (int l = 0; l < 4; ++l) { v[l] = __expf(v[l] - mx); s += v[l]; }
        float* LB = (float*)(p.ws + WS_LB); float cum = 0.f; const float first = v[0] / s;
#pragma unroll
        for (int l = 0; l < 4; ++l) { cum += v[l] / s; LB[l * 1024 + gtid] = (l == 0) ? 0.f : (cum - first); }
    }
    if (gtid >= 1024 && gtid < 1024 + 16384) {
        const int id = gtid - 1024, lg = id >> 6, pp = id & 63;
        const float a_re = p.in[I_ARE][id], a_im = p.in[I_AIM][id];
        const float step = expf(p.in[I_LDT][lg]);
        const float mag = expf(step * a_re), ang = step * a_im;
        const float ab_re = mag * cosf(ang), ab_im = mag * sinf(ang);
        const float den = a_re * a_re + a_im * a_im;
        const float z_re = ((ab_re - 1.0f) * a_re + ab_im * a_im) / den;
        const float z_im = (ab_im * a_re - (ab_re - 1.0f) * a_im) / den;
        float* ABAR = (float*)(p.ws + WS_ABAR); ABAR[2 * id] = ab_re; ABAR[2 * id + 1] = ab_im;
        bf16_t* BOP = (bf16_t*)(p.ws + WS_BOP); bf16_t* COP = (bf16_t*)(p.ws + WS_COP);
        const float* bre = p.in[I_BRE] + (size_t)id * 16; const float* bim = p.in[I_BIM] + (size_t)id * 16;
#pragma unroll
        for (int c = 0; c < 16; ++c) {
            const float br = bre[c], bi = bim[c];
            const float rr = z_re * br - z_im * bi, ii = z_re * bi + z_im * br;
            BOP[((size_t)lg * 128 + 2 * pp) * 16 + c] = (bf16_t)(pk2(rr, 0.f) & 0xffffu);
            BOP[((size_t)lg * 128 + 2 * pp + 1) * 16 + c] = (bf16_t)(pk2(ii, 0.f) & 0xffffu);
            const float cr = p.in[I_CRE][((size_t)lg * 16 + c) * 64 + pp], ci = p.in[I_CIM][((size_t)lg * 16 + c) * 64 + pp];
            COP[((size_t)lg * 16 + c) * 128 + 2 * pp] = (bf16_t)(pk2(cr, 0.f) & 0xffffu);
            COP[((size_t)lg * 16 + c) * 128 + 2 * pp + 1] = (bf16_t)(pk2(-ci, 0.f) & 0xffffu);
        }
    }
}

__device__ __forceinline__ void transpose_item(const float* W, int K, int N, bf16_t* WT, LAS float* scr, int item, int lane) {
    const int nblk = N / 32, kb = item / nblk, nb = item % nblk, k0 = 64 * kb, n0 = 32 * nb;
#pragma unroll 8
    for (int i = 0; i < 32; ++i) { const int kk = 2 * i + (lane >> 5); scr[kk * 33 + (lane & 31)] = W[(size_t)(k0 + kk) * N + n0 + (lane & 31)]; }
    LDS_WAIT();
    const int c = lane & 7;
#pragma unroll
    for (int j = 0; j < 4; ++j) { const int n = (lane >> 3) + 8 * j; const LAS float* s = scr + (8 * c) * 33 + n;
        u32x4 o; o.x = pk2(s[0 * 33], s[1 * 33]); o.y = pk2(s[2 * 33], s[3 * 33]); o.z = pk2(s[4 * 33], s[5 * 33]); o.w = pk2(s[6 * 33], s[7 * 33]);
        *(u32x4*)(WT + (size_t)(n0 + n) * K + k0 + 8 * c) = o; }
    LDS_WAIT();
}
__device__ __forceinline__ void cvt_f32_fp8(const float* src, unsigned char* dst, size_t n4, size_t gtid, size_t nthr, float scale) {
    for (size_t i = gtid; i < n4; i += nthr) { const f32x4 v = ((const f32x4*)src)[i] * scale; int w = 0;
        w = __builtin_amdgcn_cvt_pk_fp8_f32(v[0], v[1], w, false); w = __builtin_amdgcn_cvt_pk_fp8_f32(v[2], v[3], w, true); ((unsigned*)dst)[i] = (unsigned)w; }
}
__device__ __forceinline__ void cvt_f32_fp8_sliced(const float* src, unsigned char* dst, size_t gtid, size_t nthr, float scale) {
    for (size_t i = gtid; i < (size_t)16384 * 64; i += nthr) {
        const size_t e = i >> 6; const int sl = (int)(i & 63) >> 3, c = (int)(i & 7);
        const f32x4* sp = (const f32x4*)(src + e * 1024 + sl * 128 + c * 16); u32x4 o;
#pragma unroll
        for (int q = 0; q < 4; ++q) { const f32x4 v = sp[q] * scale; int w = 0; w = __builtin_amdgcn_cvt_pk_fp8_f32(v[0], v[1], w, false); w = __builtin_amdgcn_cvt_pk_fp8_f32(v[2], v[3], w, true); o[q] = (unsigned)w; }
        *(u32x4*)(dst + ((size_t)sl * 16384 + e) * 128 + c * 16) = o;
    }
}
__device__ __forceinline__ void transpose_item_fp8(const float* W, int K, int N, unsigned char* WT, LAS float* scr, int item, int lane, float scale) {
    const int nblk = N / 32, kb = item / nblk, nb = item % nblk, k0 = 64 * kb, n0 = 32 * nb;
#pragma unroll 8
    for (int i = 0; i < 32; ++i) { const int kk = 2 * i + (lane >> 5); scr[kk * 33 + (lane & 31)] = W[(size_t)(k0 + kk) * N + n0 + (lane & 31)]; }
    LDS_WAIT();
    const int c = lane & 7;
#pragma unroll
    for (int j = 0; j < 4; ++j) { const int n = (lane >> 3) + 8 * j; const LAS float* sp = scr + (8 * c) * 33 + n;
        int w0 = 0, w1 = 0;
        w0 = __builtin_amdgcn_cvt_pk_fp8_f32(sp[0 * 33] * scale, sp[1 * 33] * scale, w0, false); w0 = __builtin_amdgcn_cvt_pk_fp8_f32(sp[2 * 33] * scale, sp[3 * 33] * scale, w0, true);
        w1 = __builtin_amdgcn_cvt_pk_fp8_f32(sp[4 * 33] * scale, sp[5 * 33] * scale, w1, false); w1 = __builtin_amdgcn_cvt_pk_fp8_f32(sp[6 * 33] * scale, sp[7 * 33] * scale, w1, true);
        *(u32x2*)(WT + (size_t)(n0 + n) * K + k0 + 8 * c) = (u32x2){(unsigned)w0, (unsigned)w1}; }
    LDS_WAIT();
}
__device__ __forceinline__ void cvt_f32_bf16(const float* src, bf16_t* dst, size_t n4, size_t gtid, size_t nthr) {
    for (size_t i = gtid; i < n4; i += nthr) { const f32x4 v = ((const f32x4*)src)[i]; u32x2 o; o.x = pk2(v[0], v[1]); o.y = pk2(v[2], v[3]); ((u32x2*)dst)[i] = o; }
}
template <bool F8OUT>
__device__ __forceinline__ void norm_rows(const float* xsrc, bf16_t* hdst, const float* gain, const float* mod_l, int sh_off, int sc_off, int gw, int ngw, int lane) {
    for (int r0 = gw * 4; r0 < M; r0 += ngw * 4) {
        const int b = r0 >> 11;
        f32x4 v[4][4]; float ss[4];
#pragma unroll
        for (int i = 0; i < 4; ++i) { const f32x4* xr = (const f32x4*)(xsrc + (size_t)(r0 + i) * D) + lane;
#pragma unroll
            for (int j = 0; j < 4; ++j) v[i][j] = xr[64 * j]; }
#pragma unroll
        for (int i = 0; i < 4; ++i) { float t = 0.f;
#pragma unroll
            for (int j = 0; j < 4; ++j) t += (v[i][j][0] * v[i][j][0] + v[i][j][1] * v[i][j][1]) + (v[i][j][2] * v[i][j][2] + v[i][j][3] * v[i][j][3]);
            ss[i] = t; }
#pragma unroll
        for (int o = 1; o < 64; o <<= 1) {
#pragma unroll
            for (int i = 0; i < 4; ++i) ss[i] += __shfl_xor(ss[i], o); }
        const float* mb = mod_l + (size_t)b * NMODC;
#pragma unroll
        for (int j = 0; j < 4; ++j) { const int col = 256 * j + 4 * lane;
            const f32x4 g4 = *(const f32x4*)(gain + col), sc = *(const f32x4*)(mb + sc_off + col), sh = *(const f32x4*)(mb + sh_off + col);
            const f32x4 gs = g4 * (sc + 1.0f);
#pragma unroll
            for (int i = 0; i < 4; ++i) { const float rstd = __builtin_amdgcn_rsqf(ss[i] * (1.0f / D) + EPS);
                const f32x4 h = v[i][j] * rstd * gs + sh;
                if constexpr (F8OUT) { int w8 = 0; w8 = __builtin_amdgcn_cvt_pk_fp8_f32(h[0] * HIN_SCALE, h[1] * HIN_SCALE, w8, false); w8 = __builtin_amdgcn_cvt_pk_fp8_f32(h[2] * HIN_SCALE, h[3] * HIN_SCALE, w8, true);
                    *(unsigned*)((unsigned char*)hdst + (size_t)(r0 + i) * D + col) = (unsigned)w8; }
                else { u32x2 o; o.x = pk2(h[0], h[1]); o.y = pk2(h[2], h[3]); *(u32x2*)(hdst + (size_t)(r0 + i) * D + col) = o; } } }
    }
}
__device__ __forceinline__ void resid_norm_rows(const float* xsrc, float* xdst, const bf16_t* delta, bf16_t* hdst, const float* gain, const float* mod_l, int gw, int ngw, int lane) {
    for (int r0 = gw * 4; r0 < M; r0 += ngw * 4) {
        const int b = r0 >> 11; const float* mb = mod_l + (size_t)b * NMODC;
        f32x4 v[4][4]; u32x2 dl[4][4]; float ss[4];
#pragma unroll
        for (int i = 0; i < 4; ++i) { const f32x4* xr = (const f32x4*)(xsrc + (size_t)(r0 + i) * D) + lane; const u32x2* dp = (const u32x2*)(delta + (size_t)(r0 + i) * D) + lane;
#pragma unroll
            for (int j = 0; j < 4; ++j) { v[i][j] = xr[64 * j]; dl[i][j] = dp[64 * j]; } }
#pragma unroll
        for (int j = 0; j < 4; ++j) { const f32x4 g1 = *(const f32x4*)(mb + 2048 + 256 * j + 4 * lane);
#pragma unroll
            for (int i = 0; i < 4; ++i) { const f32x4 dv = {bflo(dl[i][j][0]), bfhi(dl[i][j][0]), bflo(dl[i][j][1]), bfhi(dl[i][j][1])}; v[i][j] = v[i][j] + g1 * dv;
                ((f32x4*)(xdst + (size_t)(r0 + i) * D) + lane)[64 * j] = v[i][j]; } }
#pragma unroll
        for (int i = 0; i < 4; ++i) { float t = 0.f;
#pragma unroll
            for (int j = 0; j < 4; ++j) t += (v[i][j][0] * v[i][j][0] + v[i][j][1] * v[i][j][1]) + (v[i][j][2] * v[i][j][2] + v[i][j][3] * v[i][j][3]);
            ss[i] = t; }
#pragma unroll
        for (int o = 1; o < 64; o <<= 1) {
#pragma unroll
            for (int i = 0; i < 4; ++i) ss[i] += __shfl_xor(ss[i], o); }
#pragma unroll
        for (int j = 0; j < 4; ++j) { const int col = 256 * j + 4 * lane;
            const f32x4 g4 = *(const f32x4*)(gain + col), sc = *(const f32x4*)(mb + 4096 + col), sh = *(const f32x4*)(mb + 3072 + col);
            const f32x4 gs = g4 * (sc + 1.0f);
#pragma unroll
            for (int i = 0; i < 4; ++i) { const float rstd = __builtin_amdgcn_rsqf(ss[i] * (1.0f / D) + EPS);
                const f32x4 h = v[i][j] * rstd * gs + sh; u32x2 o; o.x = pk2(h[0], h[1]); o.y = pk2(h[2], h[3]); *(u32x2*)(hdst + (size_t)(r0 + i) * D + col) = o; } }
    }
}
__device__ __forceinline__ void phase_conv_norm1(const KP& p, LAS unsigned char* lds, int l, int G) {
    const int tid = opaque_tid(), lane = tid & 63, wave = __builtin_amdgcn_readfirstlane(tid >> 6);
    const int gw = blockIdx.x * 8 + wave, ngw = G * 8;
    LAS float* scr = (LAS float*)(lds + wave * 8448);
    constexpr int I_IN = 16 * (INC / 32), I_G = 16 * 32, I_O = 16 * 32, I_Q = 16 * 64, NIT = I_IN + I_G + I_O + I_Q;
    for (int it = gw; it < NIT; it += ngw) {
        int r = it;
        if (r < I_IN) { transpose_item_fp8(p.in[I_WIN] + (size_t)l * D * INC, D, INC, p.ws + WS_WIN, scr, r, lane, WIN_SCALE); continue; } r -= I_IN;
        if (r < I_G) { transpose_item(p.in[I_GLUW] + (size_t)l * D * D, D, D, (bf16_t*)(p.ws + WS_WGLU), scr, r, lane); continue; } r -= I_G;
        if (r < I_O) { transpose_item_fp8(p.in[I_WOUT] + (size_t)l * D * D, D, D, p.ws + WS_WOUT, scr, r, lane, WO_SCALE); continue; } r -= I_O;
        transpose_item(p.in[I_WQ] + (size_t)l * D * 2048, D, 2048, (bf16_t*)(p.ws + WS_WQ), scr, r, lane);
    }
    const size_t gtid = (size_t)blockIdx.x * 512 + tid, nthr = (size_t)G * 512;
    cvt_f32_bf16(p.in[I_SUBK] + (size_t)l * 262144, (bf16_t*)(p.ws + WS_KEYS), 262144 / 4, gtid, nthr);
    cvt_f32_fp8_sliced(p.in[I_PU] + (size_t)l * 16384 * 1024, p.ws + WS_U, gtid, nthr, U_SCALE);
    cvt_f32_fp8_sliced(p.in[I_PV] + (size_t)l * 16384 * 1024, p.ws + WS_V, gtid, nthr, V_SCALE);
    const float* xsrc = (l == 0) ? p.in[I_X] : p.out;
    norm_rows<true>(xsrc, (bf16_t*)(p.ws + WS_H), p.in[I_N1G] + l * D, (const float*)(p.ws + WS_MOD) + (size_t)l * 32 * NMODC, 0, 1024, gw, ngw, lane);
}

__device__ __forceinline__ void phase_hgrn2(const KP& p, LAS unsigned char* lds, int l, int G) {
    const int tid = opaque_tid(), lane = tid & 63, w = __builtin_amdgcn_readfirstlane(tid >> 6), fr = lane & 15, g = lane >> 4;
    constexpr int QS = 272, TS = 72;
    constexpr int OFF_QT = 0, OFF_KH = 8704, OFF_KT = 17408, OFF_VT = 26624, OFF_EREF = 35840, OFF_ELR = 36352, OFF_SEG = 36864, PBUF = 40960;
    const bf16_t* PA = (const bf16_t*)(p.ws + WS_R0);
    bf16_t* ORAW = (bf16_t*)(p.ws + WS_OR);
    const float* LB = (const float*)(p.ws + WS_LB) + l * 1024;
    for (int unit = blockIdx.x; unit < 256; unit += G) {
        const int b = unit >> 3, h = unit & 7, k0 = 2 * lane;
        const float lb0 = LB[h * 128 + k0], lb1 = LB[h * 128 + k0 + 1];
        const float om0 = 1.0f - lb0, om1 = 1.0f - lb1;
        f32x4 S[8];
#pragma unroll
        for (int kt = 0; kt < 8; ++kt) S[kt] = (f32x4){0.f, 0.f, 0.f, 0.f};
        unsigned rqA[4], rfA[4], rvA[4], rqB[4], rfB[4], rvB[4];
#define HG_LOAD(RQ, RF, RV, cc) do { const bf16_t* nb_ = PA + ((size_t)b * SEQ + (cc) * 32 + 4 * w) * 3072 + h * 128 + k0; _Pragma("unroll") \
            for (int i = 0; i < 4; ++i) { RQ[i] = *(const unsigned*)(nb_ + (size_t)i * 3072); RF[i] = *(const unsigned*)(nb_ + (size_t)i * 3072 + 1024); RV[i] = *(const unsigned*)(nb_ + (size_t)i * 3072 + 2048); } } while (0)
        HG_LOAD(rqA, rfA, rvA, 0);
        auto chunk = [&](const int c, unsigned (&rq)[4], unsigned (&rf)[4], unsigned (&rv)[4], unsigned (&nq)[4], unsigned (&nf)[4], unsigned (&nv)[4]) __attribute__((always_inline)) {
            if (c + 1 < 64) HG_LOAD(nq, nf, nv, c + 1);
            LAS unsigned char* base = lds + (c & 1) * PBUF;
            float cs0[4], cs1[4], qv0[4], qv1[4], kv0[4], kv1[4];
            float run0 = 0.f, run1 = 0.f;
#pragma unroll
            for (int i = 0; i < 4; ++i) {
                const float fp0 = bflo(rf[i]), fp1 = bfhi(rf[i]);
                const float s0 = fsigmoid(fp0), s1 = fsigmoid(fp1);
                run0 += __logf(lb0 + om0 * s0); run1 += __logf(lb1 + om1 * s1);
                cs0[i] = run0; cs1[i] = run1;
                kv0[i] = om0 * (1.0f - s0); kv1[i] = om1 * (1.0f - s1);
                qv0[i] = fsilu(bflo(rq[i])); qv1[i] = fsilu(bfhi(rq[i]));
            }
            *(LAS f32x2*)(base + OFF_SEG + (w * 128 + k0) * 4) = (f32x2){run0, run1};
            LDS_BARRIER();
            float off0 = 0.f, off1 = 0.f, ref0 = 0.f, ref1 = 0.f, all0 = 0.f, all1 = 0.f;
#pragma unroll
            for (int s = 0; s < 8; ++s) { const f32x2 t2 = *(const LAS f32x2*)(base + OFF_SEG + (s * 128 + k0) * 4);
                if (s < w) { off0 += t2[0]; off1 += t2[1]; }
                if (s < 4) { ref0 += t2[0]; ref1 += t2[1]; }
                all0 += t2[0]; all1 += t2[1]; }
            float kh0[4], kh1[4];
#pragma unroll
            for (int i = 0; i < 4; ++i) {
                const float b0 = off0 + cs0[i], b1 = off1 + cs1[i];
                const float q0 = qv0[i] * __expf(b0 - ref0), q1 = qv1[i] * __expf(b1 - ref1);
                kh0[i] = kv0[i] * __expf(ref0 - b0); kh1[i] = kv1[i] * __expf(ref1 - b1);
                const int t = 4 * w + i;
                *(LAS unsigned*)(base + OFF_QT + t * QS + k0 * 2) = pk2(q0, q1);
                *(LAS unsigned*)(base + OFF_KH + t * QS + k0 * 2) = pk2(kh0[i], kh1[i]);
            }
            *(LAS u32x2*)(base + OFF_KT + k0 * TS + 8 * w) = (u32x2){pk2(kh0[0], kh0[1]), pk2(kh0[2], kh0[3])};
            *(LAS u32x2*)(base + OFF_KT + (k0 + 1) * TS + 8 * w) = (u32x2){pk2(kh1[0], kh1[1]), pk2(kh1[2], kh1[3])};
            *(LAS u32x2*)(base + OFF_VT + k0 * TS + 8 * w) = (u32x2){(rv[0] & 0xffffu) | (rv[1] << 16), (rv[2] & 0xffffu) | (rv[3] << 16)};
            *(LAS u32x2*)(base + OFF_VT + (k0 + 1) * TS + 8 * w) = (u32x2){(rv[0] >> 16) | (rv[1] & 0xffff0000u), (rv[2] >> 16) | (rv[3] & 0xffff0000u)};
            if (w == 0) {
                *(LAS f32x2*)(base + OFF_EREF + k0 * 4) = (f32x2){__expf(ref0), __expf(ref1)};
                *(LAS f32x2*)(base + OFF_ELR + k0 * 4) = (f32x2){__expf(all0 - ref0), __expf(all1 - ref1)};
            }
            LDS_BARRIER();
            bf16x8 qf[2][4], kf[2][4];
#pragma unroll
            for (int tt = 0; tt < 2; ++tt)
#pragma unroll
                for (int m = 0; m < 4; ++m) {
                    const LAS unsigned char* pq = base + OFF_QT + (16 * tt + fr) * QS + (32 * m + 4 * g) * 2;
                    const u32x2 lo = *(const LAS u32x2*)pq, hi = *(const LAS u32x2*)(pq + 32);
                    qf[tt][m] = __builtin_bit_cast(bf16x8, (u32x4){lo[0], lo[1], hi[0], hi[1]});
                    const LAS unsigned char* pk = base + OFF_KH + (16 * tt + fr) * QS + (32 * m + 4 * g) * 2;
                    const u32x2 lo2 = *(const LAS u32x2*)pk, hi2 = *(const LAS u32x2*)(pk + 32);
                    kf[tt][m] = __builtin_bit_cast(bf16x8, (u32x4){lo2[0], lo2[1], hi2[0], hi2[1]});
                }
            f32x4 PT00 = {0.f, 0.f, 0.f, 0.f}, PT01 = {0.f, 0.f, 0.f, 0.f}, PT11 = {0.f, 0.f, 0.f, 0.f};
#pragma unroll
            for (int m = 0; m < 4; ++m) {
                PT00 = __builtin_amdgcn_mfma_f32_16x16x32_bf16(kf[0][m], qf[0][m], PT00, 0, 0, 0);
                PT01 = __builtin_amdgcn_mfma_f32_16x16x32_bf16(kf[0][m], qf[1][m], PT01, 0, 0, 0);
                PT11 = __builtin_amdgcn_mfma_f32_16x16x32_bf16(kf[1][m], qf[1][m], PT11, 0, 0, 0);
            }
#pragma unroll
            for (int r = 0; r < 4; ++r) { if (4 * g + r > fr) { PT00[r] = 0.f; PT11[r] = 0.f; } }
            const bf16x8 pa0 = __builtin_bit_cast(bf16x8, (u32x4){pk2(PT00[0], PT00[1]), pk2(PT00[2], PT00[3]), 0u, 0u});
            const bf16x8 pa1 = __builtin_bit_cast(bf16x8, (u32x4){pk2(PT01[0], PT01[1]), pk2(PT01[2], PT01[3]), pk2(PT11[0], PT11[1]), pk2(PT11[2], PT11[3])});
            const LAS unsigned char* vrow = base + OFF_VT + (16 * w + fr) * TS;
            const u32x2 vpa = *(const LAS u32x2*)(vrow + 8 * g), vpb = *(const LAS u32x2*)(vrow + 32 + 8 * g);
            const u32x2 vna = *(const LAS u32x2*)(vrow + 16 * g), vnb = *(const LAS u32x2*)(vrow + 16 * g + 8);
            const bf16x8 vperm = __builtin_bit_cast(bf16x8, (u32x4){vpa[0], vpa[1], vpb[0], vpb[1]});
            const bf16x8 vnat = __builtin_bit_cast(bf16x8, (u32x4){vna[0], vna[1], vnb[0], vnb[1]});
            {   f32x4 er[8];
#pragma unroll
                for (int kt = 0; kt < 8; ++kt) er[kt] = *(const LAS f32x4*)(base + OFF_EREF + (16 * kt + 4 * g) * 4);
                asm volatile("s_waitcnt lgkmcnt(0)" ::: "memory");
#pragma unroll
                for (int kt = 0; kt < 8; ++kt) S[kt] = S[kt] * er[kt]; }
            f32x4 O0 = {0.f, 0.f, 0.f, 0.f}, O1 = {0.f, 0.f, 0.f, 0.f};
#pragma unroll
            for (int m = 0; m < 4; ++m) {
                const bf16x8 sf = __builtin_bit_cast(bf16x8, (u32x4){pk2(S[2 * m][0], S[2 * m][1]), pk2(S[2 * m][2], S[2 * m][3]), pk2(S[2 * m + 1][0], S[2 * m + 1][1]), pk2(S[2 * m + 1][2], S[2 * m + 1][3])});
                O0 = __builtin_amdgcn_mfma_f32_16x16x32_bf16(qf[0][m], sf, O0, 0, 0, 0);
                O1 = __builtin_amdgcn_mfma_f32_16x16x32_bf16(qf[1][m], sf, O1, 0, 0, 0);
            }
            O0 = __builtin_amdgcn_mfma_f32_16x16x32_bf16(pa0, vperm, O0, 0, 0, 0);
            O1 = __builtin_amdgcn_mfma_f32_16x16x32_bf16(pa1, vperm, O1, 0, 0, 0);
            {
                u32x4 ktw[8]; f32x4 el[8];
#pragma unroll
                for (int kt = 0; kt < 8; ++kt) { const LAS unsigned char* krow = base + OFF_KT + (16 * kt + fr) * TS + 16 * g;
                    const u32x2 ka = *(const LAS u32x2*)krow, kb = *(const LAS u32x2*)(krow + 8); ktw[kt] = (u32x4){ka[0], ka[1], kb[0], kb[1]}; }
#pragma unroll
                for (int kt = 0; kt < 8; ++kt) el[kt] = *(const LAS f32x4*)(base + OFF_ELR + (16 * kt + 4 * g) * 4);
                asm volatile("s_waitcnt lgkmcnt(0)" ::: "memory");
#pragma unroll
                for (int kt = 0; kt < 8; ++kt) S[kt] = __builtin_amdgcn_mfma_f32_16x16x32_bf16(__builtin_bit_cast(bf16x8, ktw[kt]), vnat, S[kt], 0, 0, 0);
#pragma unroll
                for (int kt = 0; kt < 8; ++kt) S[kt] = S[kt] * el[kt];
            }
            bf16_t* orow = ORAW + ((size_t)b * SEQ + c * 32 + 4 * g) * D + h * 128 + 16 * w + fr;
#pragma unroll
            for (int r = 0; r < 4; ++r) { orow[(size_t)r * D] = (bf16_t)(pk2(O0[r], 0.f) & 0xffffu); orow[(size_t)(16 + r) * D] = (bf16_t)(pk2(O1[r], 0.f) & 0xffffu); }
                };
#pragma nounroll
        for (int c = 0; c < 64; c += 2) { chunk(c, rqA, rfA, rvA, rqB, rfB, rvB); chunk(c + 1, rqB, rfB, rvB, rqA, rfA, rvA); }
#undef HG_LOAD
        __syncthreads();
    }
}

__device__ __forceinline__ void phase_s5(const KP& p, LAS unsigned char* lds, int l, int G, size_t ys_off) {
    const int tid = opaque_tid(), lane = tid & 63, w = __builtin_amdgcn_readfirstlane(tid >> 6), fr = lane & 15, g = lane >> 4;
    const int gw = blockIdx.x * 8 + w, ngw = G * 8;
    constexpr int BUS = 132;
    LAS float* BU = (LAS float*)(lds + w * 16896);
    LAS unsigned char* XI = (LAS unsigned char*)BU;
    const bf16_t* PB = (const bf16_t*)(p.ws + WS_R0);
    const bf16x8 zero8 = {0, 0, 0, 0, 0, 0, 0, 0};
    for (int unit = gw; unit < BATCH * 64; unit += ngw) {
        const int b = unit >> 6, grp = unit & 63, lg = l * 64 + grp;
        const bf16_t* BOP = (const bf16_t*)(p.ws + WS_BOP) + (size_t)lg * 128 * 16;
        const bf16_t* COP = (const bf16_t*)(p.ws + WS_COP) + (size_t)lg * 16 * 128;
        bf16x8 bfrag[8], cfrag[4], dfrag;
#pragma unroll
        for (int nt = 0; nt < 8; ++nt) bfrag[nt] = (g < 2) ? *(const bf16x8*)(BOP + (size_t)(16 * nt + fr) * 16 + 8 * g) : zero8;
#pragma unroll
        for (int ks = 0; ks < 4; ++ks) cfrag[ks] = DBG_S5_NOSSM ? zero8 : *(const bf16x8*)(COP + (size_t)fr * 128 + 32 * ks + 8 * g);
        {
            const unsigned dbits = pk2(p.in[I_S5D][l * 1024 + grp * 16 + fr], 0.f) & 0xffffu;
#pragma unroll
            for (int j = 0; j < 8; ++j) dfrag[j] = (g < 2 && (8 * g + j) == fr) ? (short)dbits : (short)0;
        }
        const float ar = ((const float*)(p.ws + WS_ABAR))[2 * ((size_t)lg * 64 + lane)], ai = ((const float*)(p.ws + WS_ABAR))[2 * ((size_t)lg * 64 + lane) + 1];
        const float nai = -ai; float xr = 0.f, xi = 0.f; unsigned hBU = 0u, hXI = 0u, hY = 0u;
        const bf16_t* ub = PB + ((size_t)b * SEQ) * 4096 + 1024 + grp * 16;
        bf16_t* yb_ = (bf16_t*)(p.ws + ys_off) + ((size_t)b * SEQ) * D + grp * 16;
        bf16x8 unext[2];
#pragma unroll
        for (int tt = 0; tt < 2; ++tt) unext[tt] = (g < 2) ? *(const bf16x8*)(ub + (size_t)(16 * tt + fr) * 4096 + 8 * g) : zero8;
        for (int t0 = 0; t0 < SEQ; t0 += 32) {
            bf16x8 ufrag[2];
#pragma unroll
            for (int tt = 0; tt < 2; ++tt) { ufrag[tt] = unext[tt]; if (t0 + 32 < SEQ) unext[tt] = (g < 2) ? *(const bf16x8*)(ub + (size_t)(t0 + 32 + 16 * tt + fr) * 4096 + 8 * g) : zero8; }
#pragma unroll
            for (int tt = 0; tt < 2; ++tt)
#pragma unroll
                for (int nt = 0; nt < 8; ++nt) {
                    const f32x4 a = __builtin_amdgcn_mfma_f32_16x16x32_bf16(ufrag[tt], bfrag[nt], (f32x4){0.f, 0.f, 0.f, 0.f}, 0, 0, 0);
#pragma unroll
                    for (int r = 0; r < 4; ++r) BU[(16 * tt + 4 * g + r) * BUS + 16 * nt + fr] = a[r];
                }
            LDS_WAIT();
#pragma unroll
            for (int t = 0; t < 32; ++t) {
                const f32x2 bb = *(const LAS f32x2*)(BU + t * BUS + 2 * lane); hBU += __float_as_uint(bb[0]) * 3u + __float_as_uint(bb[1]);
                float t1, t2, nr, ni;
                asm("v_fma_f32 %0, %1, %2, %3" : "=v"(t1) : "v"(nai), "v"(xi), "v"(bb[0]));
                asm("v_fma_f32 %0, %1, %2, %3" : "=v"(t2) : "v"(ai), "v"(xr), "v"(bb[1]));
                asm("v_fma_f32 %0, %1, %2, %3" : "=v"(nr) : "v"(ar), "v"(xr), "v"(t1));
                asm("v_fma_f32 %0, %1, %2, %3" : "=v"(ni) : "v"(ar), "v"(xi), "v"(t2));
                xr = nr; xi = ni;
                { const unsigned pv = pk2(nr, ni); hXI += pv; *(LAS unsigned*)(XI + t * (BUS * 4) + lane * 4) = pv; }
            }
            LDS_WAIT();
#pragma unroll
            for (int tt = 0; tt < 2; ++tt) {
                f32x4 y = {0.f, 0.f, 0.f, 0.f};
#pragma unroll
                for (int ks = 0; ks < 4; ++ks) {
                    const bf16x8 xf = *(const LAS bf16x8*)(XI + (16 * tt + fr) * (BUS * 4) + (32 * ks + 8 * g) * 2);
                    y = __builtin_amdgcn_mfma_f32_16x16x32_bf16(xf, cfrag[ks], y, 0, 0, 0);
                }
                y = __builtin_amdgcn_mfma_f32_16x16x32_bf16(ufrag[tt], dfrag, y, 0, 0, 0);
#pragma unroll
                for (int r = 0; r < 4; ++r) { const unsigned yv = pk2(fgelu(y[r]), 0.f) & 0xffffu; hY += yv * (unsigned)(r + 1); yb_[(size_t)(t0 + 16 * tt + 4 * g + r) * D + fr] = (bf16_t)yv; }
            }
            LDS_WAIT();
        }
        if (DBG_SELFCHECK) { for (int o = 1; o < 64; o <<= 1) { hBU += __shfl_xor((int)hBU, o); hXI += __shfl_xor((int)hXI, o); hY += __shfl_xor((int)hY, o); }
            unsigned* hs = (unsigned*)(p.ws + WS_CTL) + 65536 + (ys_off == WS_YS ? 0 : 8192) + unit * 4; unsigned hA = __float_as_uint(ar) * 7u + __float_as_uint(ai); for (int o = 1; o < 64; o <<= 1) hA += __shfl_xor((int)hA, o); if (lane == 0) { hs[0] = hBU; hs[1] = hXI; hs[2] = hA; } }
    }
    const bf16_t* ORAW = (const bf16_t*)(p.ws + WS_OR); float* SSQ = (float*)(p.ws + WS_SSQ);
    for (int row = gw; row < M; row += ngw) {
        const u32x4 a = *(const u32x4*)(ORAW + (size_t)row * D + 8 * lane), c2 = *(const u32x4*)(ORAW + (size_t)row * D + 512 + 8 * lane);
        float s0 = 0.f, s1 = 0.f;
#pragma unroll
        for (int j = 0; j < 4; ++j) { const float x0 = bflo(a[j]), x1 = bfhi(a[j]), y0 = bflo(c2[j]), y1 = bfhi(c2[j]); s0 += x0 * x0 + x1 * x1; s1 += y0 * y0 + y1 * y1; }
#pragma unroll
        for (int o = 1; o < 16; o <<= 1) { s0 += __shfl_xor(s0, o); s1 += __shfl_xor(s1, o); }
        if (fr == 0) { SSQ[(size_t)row * 8 + g] = s0; SSQ[(size_t)row * 8 + 4 + g] = s1; }
    }
}

__device__ __forceinline__ unsigned fkey(float f) { const unsigned u = __float_as_uint(f); return u ^ ((unsigned)((int)u >> 31) | 0x80000000u); }
__device__ __forceinline__ float kval(unsigned k) { const unsigned u = (k & 0x80000000u) ? (k ^ 0x80000000u) : ~k; return __uint_as_float(u); }
#define CE_DESC(a, b) do { const unsigned _mx = (a) > (b) ? (a) : (b), _mn = (a) > (b) ? (b) : (a); (a) = _mx; (b) = _mn; } while (0)
__device__ __forceinline__ void sort16_desc(unsigned (&a)[16]) {
#pragma unroll
    for (int kk = 1; kk <= 4; ++kk)
#pragma unroll
        for (int jj = kk - 1; jj >= 0; --jj)
#pragma unroll
            for (int i = 0; i < 16; ++i) { const int k = 1 << kk, j = 1 << jj, l2 = i ^ j;
                if (l2 > i) { if ((i & k) == 0) CE_DESC(a[i], a[l2]); else CE_DESC(a[l2], a[i]); } }
}
__device__ __forceinline__ void merge_top16(unsigned (&a)[16], const unsigned (&b)[16]) {
#pragma unroll
    for (int i = 0; i < 16; ++i) a[i] = a[i] > b[15 - i] ? a[i] : b[15 - i];
#pragma unroll
    for (int jj = 3; jj >= 0; --jj)
#pragma unroll
        for (int i = 0; i < 16; ++i) { const int j = 1 << jj, l2 = i ^ j; if (l2 > i) CE_DESC(a[i], a[l2]); }
}
__device__ __forceinline__ void phase_topk(const KP& p, LAS unsigned char* lds, int G) {
    const int tid = opaque_tid(), lane = tid & 63, w = __builtin_amdgcn_readfirstlane(tid >> 6), hh = lane >> 5;
    const int gw = blockIdx.x * 8 + w, ngw = G * 8;
    const bf16_t* Q = (const bf16_t*)(p.ws + WS_R0); const bf16_t* KEYS = (const bf16_t*)(p.ws + WS_KEYS);
    unsigned* SEL = (unsigned*)(p.ws + WS_SEL);
    LAS unsigned char* tab = lds + w * 2048 + lane * 32;
    const int CI[50] = {0,0,0,0,0,0,0,0,0,0,0,0,0,0,0,0, 1,1,1,1,1,1,1,1, 2,2,2,2,2, 3,3,3,3, 4,4,4, 5,5, 6,6, 7,7, 8,9,10,11,12,13,14,15};
    const int CJ[50] = {0,1,2,3,4,5,6,7,8,9,10,11,12,13,14,15, 0,1,2,3,4,5,6,7, 0,1,2,3,4, 0,1,2,3, 0,1,2, 0,1, 0,1, 0,1, 0,0,0,0,0,0,0,0};
    LAS unsigned char* kimg = lds + 16384;
    for (int h = 0; h < 8; ++h) {
      __syncthreads();
#pragma unroll
      for (int i = 0; i < 8; ++i) { const int ch = tid + 512 * i, row = ch >> 4, c16 = ch & 15;
          *(LAS u32x4*)(kimg + row * 272 + c16 * 16) = *(const u32x4*)(KEYS + (size_t)(h * 256 + row) * 128 + c16 * 8); }
      __syncthreads();
      for (int tg = gw; tg < 2048; tg += ngw) {
        const int t = tg * 32 + (lane & 31);
        unsigned top[2][16];
#pragma unroll
        for (int pp = 0; pp < 2; ++pp) {
            bf16x8 qf[8];
#pragma unroll
            for (int ks = 0; ks < 8; ++ks) qf[ks] = *(const bf16x8*)(Q + ((size_t)((((tg * 8 + h) * 2 + pp) * 8 + ks) * 64 + lane)) * 8);
            const LAS unsigned char* kb = kimg + (pp * 128 + (lane & 31)) * 272 + 16 * hh;
#pragma unroll
            for (int nt = 0; nt < 4; ++nt) {
                f32x16 acc;
#pragma unroll
                for (int i = 0; i < 16; ++i) acc[i] = 0.f;
#pragma unroll
                for (int ks = 0; ks < 8; ++ks) { const bf16x8 kf = *(const LAS bf16x8*)(kb + (32 * nt) * 272 + 32 * ks);
                    acc = __builtin_amdgcn_mfma_f32_32x32x16_bf16(kf, qf[ks], acc, 0, 0, 0); }
                unsigned ky[16];
#pragma unroll
                for (int r = 0; r < 16; ++r) ky[r] = (fkey(acc[r]) & ~127u) | (unsigned)(32 * nt + (r & 3) + 8 * (r >> 2)) | (unsigned)(4 * hh);
                sort16_desc(ky);
                if (nt == 0) {
#pragma unroll
                    for (int i = 0; i < 16; ++i) top[pp][i] = ky[i];
                } else merge_top16(top[pp], ky);
            }
            unsigned other[16];
#pragma unroll
            for (int i = 0; i < 16; ++i) other[i] = (unsigned)__shfl_xor((int)top[pp][i], 32);
            merge_top16(top[pp], other);
        }
        float sa[16], sb[16];
#pragma unroll
        for (int i = 0; i < 16; ++i) { sa[i] = kval(top[0][i] & ~127u); sb[i] = kval(top[1][i] & ~127u); }
        unsigned c0[16], c1[16];
#pragma unroll
        for (int s = 0; s < 32; ++s) {
            unsigned key = 0u;
            if (s < 25) {
                const float v0 = sa[CI[s]] + sb[CJ[s]], v1 = sa[CI[25 + s]] + sb[CJ[25 + s]];
                const unsigned k0 = (fkey(v0) & ~255u) | (unsigned)(CI[s] * 16 + CJ[s]), k1 = (fkey(v1) & ~255u) | (unsigned)(CI[25 + s] * 16 + CJ[25 + s]);
                key = hh ? k1 : k0;
            }
            if (s < 16) c0[s] = key; else c1[s - 16] = key;
        }
        sort16_desc(c0); sort16_desc(c1); merge_top16(c0, c1);
#pragma unroll
        for (int i = 0; i < 16; ++i) c1[i] = (unsigned)__shfl_xor((int)c0[i], 32);
        merge_top16(c0, c1);
        {
            u32x4 wa, wb;
#pragma unroll
            for (int q4 = 0; q4 < 4; ++q4) {
                wa[q4] = (top[0][4 * q4] & 127u) | ((top[0][4 * q4 + 1] & 127u) << 8) | ((top[0][4 * q4 + 2] & 127u) << 16) | ((top[0][4 * q4 + 3] & 127u) << 24);
                wb[q4] = (top[1][4 * q4] & 127u) | ((top[1][4 * q4 + 1] & 127u) << 8) | ((top[1][4 * q4 + 2] & 127u) << 16) | ((top[1][4 * q4 + 3] & 127u) << 24);
            }
            *(LAS u32x4*)tab = wa; *(LAS u32x4*)(tab + 16) = wb;
        }
        float ev[16], esum = 0.f; const float vmax = kval(c0[0] & ~255u);
#pragma unroll
        for (int k = 0; k < 16; ++k) { ev[k] = __expf(kval(c0[k] & ~255u) - vmax); esum += ev[k]; }
        const float rs = 1.0f / esum;
        LDS_WAIT();
        unsigned outw[8]; const unsigned hmask = hh ? 0xffffffffu : 0u;
#pragma unroll
        for (int kk = 0; kk < 8; ++kk) {
            const unsigned key = c0[kk] ^ ((c0[kk] ^ c0[8 + kk]) & hmask); const float e = __uint_as_float(__float_as_uint(ev[kk]) ^ ((__float_as_uint(ev[kk]) ^ __float_as_uint(ev[8 + kk])) & hmask));
            const unsigned code = key & 255u, ia = tab[code >> 4], ib = tab[16 + (code & 15u)];
            outw[kk] = (pk2(0.f, e * rs) & 0xffff0000u) | (ia * 128u + ib);
        }
        u32x4* dst = (u32x4*)(SEL + (size_t)t * 128 + h * 16 + hh * 8);
        dst[0] = (u32x4){outw[0], outw[1], outw[2], outw[3]}; dst[1] = (u32x4){outw[4], outw[5], outw[6], outw[7]};
        LDS_WAIT();
      }
    }
    __syncthreads();
}

__device__ __forceinline__ void fp8x4_to_f32(unsigned w, float& a, float& b, float& c, float& d) {
    const f32x2 lo = __builtin_amdgcn_cvt_pk_f32_fp8((int)w, false), hi = __builtin_amdgcn_cvt_pk_f32_fp8((int)w, true); a = lo[0]; b = lo[1]; c = hi[0]; d = hi[1];
}
struct XSlice { int sl, rank, nloc; };
__device__ __forceinline__ XSlice xslice_of_block(const KP& p, volatile LAS unsigned* MISC, int G) {
    unsigned* bar = (unsigned*)(p.ws + WS_CTL) + 4096; unsigned cnt[8]; unsigned tot = 0; bool ok = true;
#pragma unroll
    for (int j = 0; j < 8; ++j) { cnt[j] = xb_ld(&bar[XB_XCNT(j)]); tot += cnt[j]; ok = ok && (cnt[j] > 0u); }
    ok = ok && (tot == (unsigned)G);
    XSlice x;
    if (ok) { const unsigned myx = MISC[16]; x.sl = (int)myx; x.rank = (int)MISC[17]; x.nloc = (int)cnt[myx & 7u]; }
    else { x.sl = (int)(blockIdx.x & 7); x.rank = (int)(blockIdx.x >> 3); x.nloc = (G - x.sl + 7) >> 3; }
    x.sl = __builtin_amdgcn_readfirstlane(x.sl); x.rank = __builtin_amdgcn_readfirstlane(x.rank); x.nloc = __builtin_amdgcn_readfirstlane(x.nloc);
    return x;
}
__device__ __forceinline__ float dot16_fp8(const u32x4 u, const float (&hf)[16]) {
    float d = 0.f;
#pragma unroll
    for (int j = 0; j < 4; ++j) { float f0, f1, f2, f3; fp8x4_to_f32(u[j], f0, f1, f2, f3);
        d = __builtin_fmaf(f0, hf[4 * j], d); d = __builtin_fmaf(f1, hf[4 * j + 1], d); d = __builtin_fmaf(f2, hf[4 * j + 2], d); d = __builtin_fmaf(f3, hf[4 * j + 3], d); }
    return d;
}
typedef __bf16 bf16v8 __attribute__((ext_vector_type(8)));
__device__ __forceinline__ float dot16_fp8_bf16(const u32x4 u, const bf16v8 h0, const bf16v8 h1) {
    float d0 = 0.f, d1 = 0.f;
    d0 = __builtin_amdgcn_fdot2_f32_bf16(__builtin_amdgcn_cvt_scalef32_pk_bf16_fp8(u[0], 1.0f, false), __builtin_shufflevector(h0, h0, 0, 1), d0, false);
    d1 = __builtin_amdgcn_fdot2_f32_bf16(__builtin_amdgcn_cvt_scalef32_pk_bf16_fp8(u[0], 1.0f, true),  __builtin_shufflevector(h0, h0, 2, 3), d1, false);
    d0 = __builtin_amdgcn_fdot2_f32_bf16(__builtin_amdgcn_cvt_scalef32_pk_bf16_fp8(u[1], 1.0f, false), __builtin_shufflevector(h0, h0, 4, 5), d0, false);
    d1 = __builtin_amdgcn_fdot2_f32_bf16(__builtin_amdgcn_cvt_scalef32_pk_bf16_fp8(u[1], 1.0f, true),  __builtin_shufflevector(h0, h0, 6, 7), d1, false);
    d0 = __builtin_amdgcn_fdot2_f32_bf16(__builtin_amdgcn_cvt_scalef32_pk_bf16_fp8(u[2], 1.0f, false), __builtin_shufflevector(h1, h1, 0, 1), d0, false);
    d1 = __builtin_amdgcn_fdot2_f32_bf16(__builtin_amdgcn_cvt_scalef32_pk_bf16_fp8(u[2], 1.0f, true),  __builtin_shufflevector(h1, h1, 2, 3), d1, false);
    d0 = __builtin_amdgcn_fdot2_f32_bf16(__builtin_amdgcn_cvt_scalef32_pk_bf16_fp8(u[3], 1.0f, false), __builtin_shufflevector(h1, h1, 4, 5), d0, false);
    d1 = __builtin_amdgcn_fdot2_f32_bf16(__builtin_amdgcn_cvt_scalef32_pk_bf16_fp8(u[3], 1.0f, true),  __builtin_shufflevector(h1, h1, 6, 7), d1, false);
    return d0 + d1;
}
__device__ __forceinline__ float dpp_sum8(float d) {
    d += __uint_as_float(__builtin_amdgcn_update_dpp(0, __float_as_uint(d), 0xB1, 0xF, 0xF, true));
    d += __uint_as_float(__builtin_amdgcn_update_dpp(0, __float_as_uint(d), 0x4E, 0xF, 0xF, true));
    d += __uint_as_float(__builtin_amdgcn_update_dpp(0, __float_as_uint(d), 0x141, 0xF, 0xF, true));
    return d;
}
__device__ __forceinline__ void phase_expert_u(const KP& p, LAS unsigned char* lds, volatile LAS unsigned* MISC, int G) {
    const int tid = opaque_tid(), lane = tid & 63, w = __builtin_amdgcn_readfirstlane(tid >> 6), j = lane >> 3, c = lane & 7;
    const XSlice xs = xslice_of_block(p, MISC, G);
    const bf16_t* H2 = (const bf16_t*)(p.ws + WS_H); const unsigned char* Us = p.ws + WS_U + (size_t)xs.sl * 16384 * 128;
    const unsigned* SEL = (const unsigned*)(p.ws + WS_SEL); unsigned* PDu = (unsigned*)(p.ws + WS_R0) + (size_t)xs.sl * M * 64;
    const int t0 = xs.rank * 8 + w, tstep = xs.nloc * 8;
    LAS unsigned char* ring = lds + w * 17920;
    LAS unsigned char* selb = ring + 16384; LAS unsigned char* hbuf = ring + 16384 + 1024;
    const int tlast = t0 + ((M - 1 - t0) / tstep) * tstep;
#define E1_CL(t) ((t) <= tlast ? (t) : tlast)
#define E1_DMA_SEL(t, par) do { const unsigned* sp = SEL + (size_t)E1_CL(t) * 128 + lane; \
            __builtin_amdgcn_global_load_lds(sp, (LAS unsigned*)(selb + (par) * 512), 4, 0, 0); __builtin_amdgcn_global_load_lds(sp + 64, (LAS unsigned*)(selb + (par) * 512 + 256), 4, 0, 0); } while (0)
#define E1_DMA_H(t, par) do { __builtin_amdgcn_global_load_lds((const unsigned*)(H2 + (size_t)E1_CL(t) * D + xs.sl * 128) + lane, (LAS unsigned*)(hbuf + (par) * 256), 4, 0, 0); } while (0)
#define E1_DMA_ROW(i, idxv) do { __builtin_amdgcn_global_load_lds((const unsigned*)(Us + (size_t)((idxv) & 0x3fffu) * 128 + 16 * c), (LAS unsigned*)(ring + (i) * 1024), 16, 0, 0); } while (0)
    if (t0 < M) {
        E1_DMA_SEL(t0, 0); E1_DMA_SEL(t0 + tstep, 1); E1_DMA_H(t0, 0);
        asm volatile("s_waitcnt vmcnt(0)" ::: "memory");
        { u32x4 s0[4];
#pragma unroll
          for (int q = 0; q < 4; ++q) s0[q] = *(const LAS u32x4*)(selb + (16 * j + 4 * q) * 4);
#pragma unroll
          for (int i = 0; i < 16; ++i) E1_DMA_ROW(i, s0[i >> 2][i & 3]); }
        { PDu[(size_t)t0 * 64 + 8 * j + (c >> 1) + 4 * (c & 1)] = 0u; }
        int par = 0;
        for (int tok = t0; tok < M; tok += tstep, par ^= 1) {
            E1_DMA_SEL(tok + 2 * tstep, par); E1_DMA_H(tok + tstep, par ^ 1);
            asm volatile("s_waitcnt vmcnt(19)" ::: "memory");
            u32x4 sn[4];
#pragma unroll
            for (int q = 0; q < 4; ++q) sn[q] = *(const LAS u32x4*)(selb + (par ^ 1) * 512 + (16 * j + 4 * q) * 4);
            const bf16v8 hb0 = *(const LAS bf16v8*)(hbuf + par * 256 + 32 * c), hb1 = *(const LAS bf16v8*)(hbuf + par * 256 + 32 * c + 16);
            float pd0 = 0.f, pd1 = 0.f;
#pragma unroll
            for (int i0 = 0; i0 < 16; i0 += 4) {
                asm volatile("s_waitcnt vmcnt(16)" ::: "memory");
                u32x4 row[4];
#pragma unroll
                for (int r = 0; r < 4; ++r) row[r] = *(const LAS u32x4*)(ring + (i0 + r) * 1024 + 16 * lane);
                asm volatile("s_waitcnt lgkmcnt(0)" ::: "memory");
#pragma unroll
                for (int r = 0; r < 4; ++r) E1_DMA_ROW(i0 + r, sn[(i0 + r) >> 2][(i0 + r) & 3]);
#pragma unroll
                for (int r = 0; r < 4; ++r) { const int i = i0 + r; const float d = dpp_sum8(dot16_fp8_bf16(row[r], hb0, hb1));
                    if (i < 8) pd0 = (c == i) ? d : pd0; else pd1 = (c == i - 8) ? d : pd1; }
            }
            { const float nb0 = __uint_as_float(__builtin_amdgcn_update_dpp(0, __float_as_uint(pd0), 0xB1, 0xF, 0xF, true)), nb1 = __uint_as_float(__builtin_amdgcn_update_dpp(0, __float_as_uint(pd1), 0xB1, 0xF, 0xF, true));
              PDu[(size_t)tok * 64 + 8 * j + (c >> 1) + 4 * (c & 1)] = (c & 1) ? pk2(nb1, pd1) : pk2(pd0, nb0); }
        }
        asm volatile("s_waitcnt vmcnt(0)" ::: "memory");
    }
#undef E1_CL
#undef E1_DMA_SEL
#undef E1_DMA_H
#undef E1_DMA_ROW
}
__device__ __forceinline__ void phase_expert_w(const KP& p, int G) {
    const int tid = opaque_tid(), lane = tid & 63, w = __builtin_amdgcn_readfirstlane(tid >> 6);
    const int gw = blockIdx.x * 8 + w, ngw = G * 8;
    unsigned* SEL = (unsigned*)(p.ws + WS_SEL); const unsigned* PDu = (const unsigned*)(p.ws + WS_R0);
    for (int tok = gw; tok < M; tok += ngw) {
        f32x2 d = {0.f, 0.f};
#pragma unroll
        for (int sl = 0; sl < 8; ++sl) { const unsigned pw = PDu[((size_t)sl * M + tok) * 64 + lane]; d[0] += bflo(pw); d[1] += bfhi(pw); }
        u32x2* sp = (u32x2*)(SEL + (size_t)tok * 128 + 2 * lane); const u32x2 s2 = *sp;
        const float w0 = __uint_as_float(s2[0] & 0xffff0000u) * fgelu(d[0] * (1.0f / U_SCALE)) * (1.0f / V_SCALE);
        const float w1 = __uint_as_float(s2[1] & 0xffff0000u) * fgelu(d[1] * (1.0f / U_SCALE)) * (1.0f / V_SCALE);
        u32x2 o; o[0] = (pk2(0.f, w0) & 0xffff0000u) | (s2[0] & 0x3fffu); o[1] = (pk2(0.f, w1) & 0xffff0000u) | (s2[1] & 0x3fffu);
        *sp = o;
    }
}
__device__ __forceinline__ void phase_expert_v(const KP& p, LAS unsigned char* lds, volatile LAS unsigned* MISC, int l, int G) {
    const int tid = opaque_tid(), lane = tid & 63, w = __builtin_amdgcn_readfirstlane(tid >> 6), j = lane >> 3, c = lane & 7;
    const XSlice xs = xslice_of_block(p, MISC, G);
    const unsigned char* Vs = p.ws + WS_V + (size_t)xs.sl * 16384 * 128;
    const unsigned* SEL = (const unsigned*)(p.ws + WS_SEL);
    const float* g2 = (const float*)(p.ws + WS_MOD) + (size_t)l * 32 * NMODC + 5120;
    float* X = p.out;
    const int t0 = xs.rank * 8 + w, tstep = xs.nloc * 8;
    const bool b3 = (lane & 8) != 0;
    LAS unsigned char* ring = lds + w * 17920; LAS unsigned char* selb = ring + 16384;
    const int tlast = t0 + ((M - 1 - t0) / tstep) * tstep;
#define E2_CL(t) ((t) <= tlast ? (t) : tlast)
#define E2_DMA_SEL(t, par) do { const unsigned* sp = SEL + (size_t)E2_CL(t) * 128 + lane; \
            __builtin_amdgcn_global_load_lds(sp, (LAS unsigned*)(selb + (par) * 512), 4, 0, 0); __builtin_amdgcn_global_load_lds(sp + 64, (LAS unsigned*)(selb + (par) * 512 + 256), 4, 0, 0); } while (0)
#define E2_DMA_ROW(i, idxv) do { __builtin_amdgcn_global_load_lds((const unsigned*)(Vs + (size_t)((idxv) & 0x3fffu) * 128 + 16 * c), (LAS unsigned*)(ring + (i) * 1024), 16, 0, 0); } while (0)
    if (t0 < M) {
        E2_DMA_SEL(t0, 0); E2_DMA_SEL(t0 + tstep, 1);
        asm volatile("s_waitcnt vmcnt(0)" ::: "memory");
        u32x4 sc[4];
#pragma unroll
        for (int q = 0; q < 4; ++q) sc[q] = *(const LAS u32x4*)(selb + (16 * j + 4 * q) * 4);
#pragma unroll
        for (int i = 0; i < 16; ++i) E2_DMA_ROW(i, sc[i >> 2][i & 3]);
        LAS float* xbuf = (LAS float*)(ring + 16384 + 1024);
        { float* xd = X + (size_t)t0 * D + xs.sl * 128 + 16 * c + 2 * j; __builtin_amdgcn_global_load_lds((const unsigned*)xd, (LAS unsigned*)xbuf, 4, 0, 0); }
        int par = 0, bcur = -1; f32x2 gv = {0.f, 0.f};
        for (int tok = t0; tok < M; tok += tstep, par ^= 1) {
            const int dim = xs.sl * 128 + 16 * c + 2 * j;
            float* xp = X + (size_t)tok * D + dim;
            if ((tok >> 11) != bcur) { bcur = tok >> 11; const f32x2 gl = *(const f32x2*)(g2 + (size_t)bcur * NMODC + dim); asm volatile("s_waitcnt vmcnt(0)" ::: "memory"); gv[0] = gl[0] * 1.0f; gv[1] = gl[1] * 1.0f; asm volatile("" : "+v"(gv)); }
            E2_DMA_SEL(tok + 2 * tstep, par);
            __builtin_amdgcn_global_load_lds((const unsigned*)xp, (LAS unsigned*)xbuf, 4, 0, 0); __builtin_amdgcn_global_load_lds((const unsigned*)(xp + 1), (LAS unsigned*)(xbuf + 64), 4, 0, 0);
            asm volatile("s_waitcnt vmcnt(21)" ::: "memory");
            u32x4 sn[4];
#pragma unroll
            for (int q = 0; q < 4; ++q) sn[q] = *(const LAS u32x4*)(selb + (par ^ 1) * 512 + (16 * j + 4 * q) * 4);
            f32x2 o2[8];
#pragma unroll
            for (int q = 0; q < 8; ++q) o2[q] = (f32x2){0.f, 0.f};
#pragma unroll
            for (int i0 = 0; i0 < 16; i0 += 4) {
                asm volatile("s_waitcnt vmcnt(17)" ::: "memory");
                u32x4 row[4];
#pragma unroll
                for (int r = 0; r < 4; ++r) row[r] = *(const LAS u32x4*)(ring + (i0 + r) * 1024 + 16 * lane);
                asm volatile("s_waitcnt lgkmcnt(0)" ::: "memory");
#pragma unroll
                for (int r = 0; r < 4; ++r) E2_DMA_ROW(i0 + r, sn[(i0 + r) >> 2][(i0 + r) & 3]);
                {
                    const u32x2 wA = {sc[i0 >> 2][0], sc[i0 >> 2][1]}, wB = {sc[i0 >> 2][2], sc[i0 >> 2][3]};
#pragma unroll
                    for (int r = 0; r < 4; ++r)
#pragma unroll
                        for (int q = 0; q < 4; ++q) { const f32x2 lo = __builtin_amdgcn_cvt_pk_f32_fp8((int)row[r][q], false), hi = __builtin_amdgcn_cvt_pk_f32_fp8((int)row[r][q], true);
                            if (r & 1) { asm("v_pk_fma_f32 %0, %1, %2, %0 op_sel:[1,0,0] op_sel_hi:[1,1,1]" : "+v"(o2[2 * q]) : "v"(r < 2 ? wA : wB), "v"(lo));
                                         asm("v_pk_fma_f32 %0, %1, %2, %0 op_sel:[1,0,0] op_sel_hi:[1,1,1]" : "+v"(o2[2 * q + 1]) : "v"(r < 2 ? wA : wB), "v"(hi)); }
                            else       { asm("v_pk_fma_f32 %0, %1, %2, %0 op_sel:[0,0,0] op_sel_hi:[0,1,1]" : "+v"(o2[2 * q]) : "v"(r < 2 ? wA : wB), "v"(lo));
                                         asm("v_pk_fma_f32 %0, %1, %2, %0 op_sel:[0,0,0] op_sel_hi:[0,1,1]" : "+v"(o2[2 * q + 1]) : "v"(r < 2 ? wA : wB), "v"(hi)); } }
                }
            }
            float o[16];
#pragma unroll
            for (int q = 0; q < 8; ++q) { o[2 * q] = o2[q][0]; o[2 * q + 1] = o2[q][1]; }
            float r8[8], r4[4], r2[2];
#pragma unroll
            for (int k = 0; k < 8; ++k) { const u32x2 sw = __builtin_amdgcn_permlane32_swap(__float_as_uint(o[k]), __float_as_uint(o[8 + k]), false, false); r8[k] = __uint_as_float(sw[0]) + __uint_as_float(sw[1]); }
#pragma unroll
            for (int k = 0; k < 4; ++k) { const u32x2 sw = __builtin_amdgcn_permlane16_swap(__float_as_uint(r8[k]), __float_as_uint(r8[4 + k]), false, false); r4[k] = __uint_as_float(sw[0]) + __uint_as_float(sw[1]); }
#pragma unroll
            for (int k = 0; k < 2; ++k) { const float keep = b3 ? r4[2 + k] : r4[k], send = b3 ? r4[k] : r4[2 + k];
                r2[k] = keep + __uint_as_float(__builtin_amdgcn_update_dpp(0, __float_as_uint(send), 0x128, 0xF, 0xF, true)); }
            asm volatile("s_waitcnt vmcnt(16)" ::: "memory");
            { f32x2 xv; xv[0] = xbuf[lane] + gv[0] * r2[0]; xv[1] = xbuf[64 + lane] + gv[1] * r2[1]; *(f32x2*)xp = xv; }
#pragma unroll
            for (int q = 0; q < 4; ++q) sc[q] = sn[q];
        }
        asm volatile("s_waitcnt vmcnt(0)" ::: "memory");
    }
#undef E2_CL
#undef E2_DMA_SEL
#undef E2_DMA_ROW
}

__device__ __forceinline__ void phase_final(const KP& p, int G) {
    const int tid = opaque_tid(), lane = tid & 63, w = __builtin_amdgcn_readfirstlane(tid >> 6);
    const int gw = blockIdx.x * 8 + w, ngw = G * 8;
    const float* fg = p.in[I_FG];
    for (int r0 = gw * 4; r0 < M; r0 += ngw * 4) {
        f32x4 v[4][4]; float ss[4];
#pragma unroll
        for (int i = 0; i < 4; ++i) { const f32x4* xr = (const f32x4*)(p.out + (size_t)(r0 + i) * D) + lane;
#pragma unroll
            for (int j = 0; j < 4; ++j) v[i][j] = xr[64 * j]; }
#pragma unroll
        for (int i = 0; i < 4; ++i) { float t = 0.f;
#pragma unroll
            for (int j = 0; j < 4; ++j) t += (v[i][j][0] * v[i][j][0] + v[i][j][1] * v[i][j][1]) + (v[i][j][2] * v[i][j][2] + v[i][j][3] * v[i][j][3]);
            ss[i] = t; }
#pragma unroll
        for (int o = 1; o < 64; o <<= 1) {
#pragma unroll
            for (int i = 0; i < 4; ++i) ss[i] += __shfl_xor(ss[i], o); }
#pragma unroll
        for (int j = 0; j < 4; ++j) { const f32x4 g4 = *(const f32x4*)(fg + 256 * j + 4 * lane);
#pragma unroll
            for (int i = 0; i < 4; ++i) { const float rstd = __builtin_amdgcn_rsqf(ss[i] * (1.0f / D) + EPS); ((f32x4*)(p.out + (size_t)(r0 + i) * D) + lane)[64 * j] = v[i][j] * rstd * g4; } }
    }
}

__global__ void __launch_bounds__(512, 2) mk_fwd(KP p_) {
    extern __shared__ __attribute__((aligned(16))) unsigned char lds_raw[];
    LAS unsigned char* lds = (LAS unsigned char*)lds_raw;
    const int tid = threadIdx.x, G = gridDim.x;
    volatile LAS unsigned* MISC = (volatile LAS unsigned*)(lds + MISC_OFF);
    for (int i = tid; i < LDS_BYTES / 4; i += 512) ((LAS unsigned*)lds)[i] = 0u;
    __syncthreads();
    XcdBarrier bar = xcd_barrier_post((unsigned*)(p_.ws + WS_CTL) + 4096, MISC + 8);
    if (tid == 0) { const unsigned myx = xb_xcc_id(); MISC[16] = myx; MISC[17] = xb_add((unsigned*)(p_.ws + WS_CTL) + 8192 + 64 * (myx & 15u), 1u); }
    __syncthreads();
    const int lo = p_.gp_lo, hi = p_.gp_hi;
#ifndef PH_MASK
#define PH_MASK 0xFFFFF
#endif
#define IN(k) (lo <= (k) && (k) < hi)
#define EN(b) ((PH_MASK >> (b)) & 1)
#ifndef PH_REPEAT
#define PH_REPEAT 0
#endif
#define NREP(b) (((PH_REPEAT >> (b)) & 1) ? 2 : 1)
#define SEAM(k) do { if ((k) + 1 < hi) xcd_barrier(bar); } while (0)
    if (EN(12) && IN(GP_SETUP)) { const KP p = load_kp(); phase_setup(p, lds, G); SEAM(GP_SETUP); }
    for (int l = 0; l < DEPTH; ++l) {
        const int g0 = 1 + l * NPH;
        if (EN(0) && IN(g0 + 0)) { _Pragma("nounroll") for (int rep = 0; rep < NREP(0); ++rep) { const KP p = load_kp(); phase_conv_norm1(p, lds, l, G); } SEAM(g0 + 0); }
        if (EN(1) && IN(g0 + 1)) { const KP p = load_kp();
            pg8::Gemm g{(const bf16_t*)(p.ws + WS_H), (const bf16_t*)(p.ws + WS_WIN), M, 3072, D / 2, D / 2, D / 2}; pg8::StaticOrder S; S.init(M, 3072, G, (int)blockIdx.x);
            pg8::EpiStoreBf16 E{(bf16_t*)(p.ws + WS_R0), 3072, 1.0f / (WIN_SCALE * HIN_SCALE)};
            _Pragma("nounroll") for (int rep = 0; rep < NREP(1); ++rep) pg8::gemm_phase<pg8::EpiStoreBf16, pg8::StaticOrder, false, true, true>(lds, g, S, E);
            SEAM(g0 + 1);
        }
        if (EN(2) && IN(g0 + 2)) { _Pragma("nounroll") for (int rep = 0; rep < NREP(2); ++rep) { const KP p = load_kp(); phase_hgrn2(p, lds, l, G); } SEAM(g0 + 2); }
        if (EN(3) && IN(g0 + 3)) { const KP p = load_kp();
            pg8::Gemm g{(const bf16_t*)(p.ws + WS_H), (const bf16_t*)(p.ws + WS_WIN) + (size_t)3072 * (D / 2), M, 4096, D / 2, D / 2, D / 2}; pg8::StaticOrder S; S.init(M, 4096, G, (int)blockIdx.x);
            pg8::EpiStoreBf16 E{(bf16_t*)(p.ws + WS_R0), 4096, 1.0f / (WIN_SCALE * HIN_SCALE)};
            _Pragma("nounroll") for (int rep = 0; rep < NREP(3); ++rep) pg8::gemm_phase<pg8::EpiStoreBf16, pg8::StaticOrder, false, true, true>(lds, g, S, E);
            SEAM(g0 + 3);
        }
        #if DBG_SELFCHECK
        if (EN(4) && IN(g0 + 4)) {
#pragma nounroll
            for (int rep = 0; rep < 2; ++rep) { const KP p = load_kp(); size_t yo = rep ? WS_H : WS_YS; asm volatile("" : "+s"(yo)); phase_s5(p, lds, l, G, yo); SEAM(g0 + 4); }
            const KP p = load_kp();
            const unsigned* a = (const unsigned*)(p.ws + WS_YS); const unsigned* b2 = (const unsigned*)(p.ws + WS_H); unsigned bad = 0;
            for (size_t i = (size_t)blockIdx.x * 512 + opaque_tid(); i < (size_t)M * D / 2; i += (size_t)G * 512) bad += (a[i] != b2[i]) ? 1u : 0u;
            if (bad) atomicAdd((unsigned*)(p.ws + WS_CTL) + 64, bad);
            { const unsigned* h1 = (const unsigned*)(p.ws + WS_CTL) + 65536; const unsigned* h2 = h1 + 8192; const int u2 = blockIdx.x * 512 + opaque_tid();
              if (u2 < 2048) { if (h1[u2 * 4] != h2[u2 * 4]) atomicAdd((unsigned*)(p.ws + WS_CTL) + 128, 1u); if (h1[u2 * 4 + 1] != h2[u2 * 4 + 1]) atomicAdd((unsigned*)(p.ws + WS_CTL) + 192, 1u); if (h1[u2 * 4 + 2] != h2[u2 * 4 + 2]) atomicAdd((unsigned*)(p.ws + WS_CTL) + 256, 1u); } }
            SEAM(g0 + 4); }
#else
        if (EN(4) && IN(g0 + 4)) { _Pragma("nounroll") for (int rep = 0; rep < NREP(4); ++rep) { const KP p = load_kp(); phase_s5(p, lds, l, G, WS_YS); } SEAM(g0 + 4); }
#endif
        if (EN(5) && IN(g0 + 5)) { const KP p = load_kp();
            pg8::Gemm g{(const bf16_t*)(p.ws + WS_YS), (const bf16_t*)(p.ws + WS_WGLU), M, D, D, D, D}; pg8::StaticOrder S; S.init(M, D, G, (int)blockIdx.x);
            pg8::EpiGlu E{(const bf16_t*)(p.ws + WS_R0), (const bf16_t*)(p.ws + WS_YS), (const bf16_t*)(p.ws + WS_OR), (const float*)(p.ws + WS_SSQ), p.in[I_HNG] + l * 128, p.in[I_GLUB] + l * D, (bf16_t*)(p.ws + WS_H)};
            _Pragma("nounroll") for (int rep = 0; rep < NREP(5); ++rep) pg8::gemm_phase<pg8::EpiGlu, pg8::StaticOrder, true, true>(lds, g, S, E);
            SEAM(g0 + 5);
        }
        if (EN(6) && IN(g0 + 6)) { const KP p = load_kp();
            pg8::Gemm g{(const bf16_t*)(p.ws + WS_H), (const bf16_t*)(p.ws + WS_WOUT), M, D, D / 2, D / 2, D / 2}; pg8::StaticOrder S; S.init(M, D, G, (int)blockIdx.x);
            pg8::EpiStoreBf16 E{(bf16_t*)(p.ws + WS_OR), D, 1.0f / (WO_SCALE * MG_SCALE)};
            pg8::gemm_phase<pg8::EpiStoreBf16, pg8::StaticOrder, false, true, true>(lds, g, S, E);
            SEAM(g0 + 6);
        }
        if (EN(7) && IN(g0 + 7)) { const KP p = load_kp();
            const int t2 = opaque_tid(), lane = t2 & 63, wave = __builtin_amdgcn_readfirstlane(t2 >> 6);
            resid_norm_rows((l == 0) ? p.in[I_X] : p.out, p.out, (const bf16_t*)(p.ws + WS_OR), (bf16_t*)(p.ws + WS_H), p.in[I_N2G] + l * D, (const float*)(p.ws + WS_MOD) + (size_t)l * 32 * NMODC, blockIdx.x * 8 + wave, G * 8, lane);
            SEAM(g0 + 7);
        }
        if (EN(8) && IN(g0 + 8)) { const KP p = load_kp();
            pg8::Gemm g{(const bf16_t*)(p.ws + WS_H), (const bf16_t*)(p.ws + WS_WQ), M, 2048, D, D, D}; pg8::StaticOrder S; S.init(M, 2048, G, (int)blockIdx.x);
            pg8::EpiStoreQ E{(bf16_t*)(p.ws + WS_R0)};
            _Pragma("nounroll") for (int rep = 0; rep < NREP(8); ++rep) pg8::gemm_phase<pg8::EpiStoreQ, pg8::StaticOrder, true, true>(lds, g, S, E);
            SEAM(g0 + 8);
        }
        if (EN(9) && IN(g0 + 9)) { _Pragma("nounroll") for (int rep = 0; rep < NREP(9); ++rep) { const KP p = load_kp(); phase_topk(p, lds, G); } SEAM(g0 + 9); }
        if (EN(10) && IN(g0 + 10)) {
            { const KP p = load_kp(); phase_expert_u(p, lds, MISC, G); } xcd_barrier(bar);
            { const KP p = load_kp(); phase_expert_w(p, G); } xcd_barrier(bar);
            { const KP p = load_kp(); phase_expert_v(p, lds, MISC, l, G); }
            SEAM(g0 + 10); }
    }
    if (EN(13) && IN(GP_FINAL)) { const KP p = load_kp(); phase_final(p, G); }
#undef IN
#undef EN
#undef NREP
#undef SEAM
}

extern "C" void kernel_launch(void* const* d_in, const int* in_sizes, int n_in, void* d_out, int out_size, void* d_ws, size_t ws_size, hipStream_t stream) {
    static int grid = 0;
    if (grid == 0) {
        if (n_in != 25 || out_size != M * D || ws_size < WS_END) { fprintf(stderr, "kernel_launch: unexpected shapes (n_in %d, out %d, ws %zu < %zu)\n", n_in, out_size, ws_size, (size_t)WS_END); grid = -1; return; }
        int dev = 0, cus = 0, per_cu = 0;
        if (hipGetDevice(&dev) != hipSuccess || hipDeviceGetAttribute(&cus, hipDeviceAttributeMultiprocessorCount, dev) != hipSuccess) { grid = -1; return; }
        if (hipFuncSetAttribute((const void*)mk_fwd, hipFuncAttributeMaxDynamicSharedMemorySize, LDS_BYTES) != hipSuccess) { fprintf(stderr, "kernel_launch: hipFuncSetAttribute failed\n"); grid = -1; return; }
        if (hipOccupancyMaxActiveBlocksPerMultiprocessor(&per_cu, (const void*)mk_fwd, 512, LDS_BYTES) != hipSuccess || per_cu < 1) fprintf(stderr, "kernel_launch: occupancy query says %d\n", per_cu);
        (void)hipGetLastError();
        grid = cus;
    }
    if (grid < 0) return;
    (void)hipMemsetAsync((char*)d_ws + WS_CTL, 0, CTL_ZERO_BYTES, stream);
    KP a{};
    for (int i = 0; i < 25; ++i) a.in[i] = (const float*)d_in[i];
    a.out = (float*)d_out; a.ws = (unsigned char*)d_ws;
#if MK_LAUNCHES == 1
    a.gp_lo = 0; a.gp_hi = GP_END;
    hipLaunchKernelGGL(mk_fwd, dim3(grid), dim3(512), LDS_BYTES, stream, a);
#else
    for (int gp = 0; gp < GP_END; ++gp) { a.gp_lo = gp; a.gp_hi = gp + 1; hipLaunchKernelGGL(mk_fwd, dim3(grid), dim3(512), LDS_BYTES, stream, a); }
#endif
}
```

```cpp
#include <hip/hip_runtime.h>
#include <cstdio>
#include <cstdint>

#define DBG_HASHSEL 0
#define DBG_H2_FROM_INPUT 0
#define DBG_NO_YA 0
#define DBG_NO_YB 0
#define DBG_NO_ACC 0
#define DBG_NO_GB 0
#define DBG_S5_NOSSM 0
#define DBG_S5_NOREC 0
#define DBG_SELFCHECK 0
#ifndef MK_LAUNCHES
#define MK_LAUNCHES 1
#endif

#define LAS __attribute__((address_space(3)))
typedef unsigned short bf16_t;
typedef short bf16x8 __attribute__((ext_vector_type(8)));
typedef float f32x2 __attribute__((ext_vector_type(2)));
typedef float f32x4 __attribute__((ext_vector_type(4)));
typedef float f32x16 __attribute__((ext_vector_type(16)));
typedef unsigned u32x2 __attribute__((ext_vector_type(2)));
typedef unsigned u32x4 __attribute__((ext_vector_type(4)));
typedef __bf16 bf16v2 __attribute__((ext_vector_type(2)));
typedef int i32x8 __attribute__((ext_vector_type(8)));
typedef int i32x4 __attribute__((ext_vector_type(4)));

constexpr int D = 1024, BATCH = 32, SEQ = 2048, DEPTH = 4, M = BATCH * SEQ;
constexpr int INC = 7168, NMODC = 6 * D;
constexpr int NPH = 11, GP_SETUP = 0, GP_FINAL = 1 + DEPTH * NPH, GP_END = GP_FINAL + 1;
constexpr float EPS = 1e-6f;
constexpr float U_SCALE = 64.0f, V_SCALE = 4.0f;
constexpr float WIN_SCALE = 64.0f, HIN_SCALE = 4.0f;
constexpr float WO_SCALE = 64.0f, MG_SCALE = 8.0f;

constexpr size_t MiB = 1u << 20;
constexpr size_t WS_CTL = 0, CTL_ZERO_BYTES = 1 * MiB;
constexpr size_t WS_MOD = 1 * MiB;
constexpr size_t WS_LB = 4 * MiB;
constexpr size_t WS_ABAR = 4 * MiB + 65536;
constexpr size_t WS_BOP = 5 * MiB;
constexpr size_t WS_COP = 6 * MiB;
constexpr size_t WS_WIN = 8 * MiB;
constexpr size_t WS_WGLU = 22 * MiB;
constexpr size_t WS_WOUT = 24 * MiB;
constexpr size_t WS_WQ = 26 * MiB;
constexpr size_t WS_KEYS = 30 * MiB;
constexpr size_t WS_U = 32 * MiB;
constexpr size_t WS_V = 64 * MiB;
constexpr size_t WS_H = 96 * MiB;
constexpr size_t WS_OR = 224 * MiB;
constexpr size_t WS_SSQ = 352 * MiB;
constexpr size_t WS_R0 = 354 * MiB;
constexpr size_t WS_SEL = WS_R0 + 256 * MiB;
constexpr size_t WS_YS = WS_R0 + 512 * MiB;
constexpr size_t WS_END = WS_YS + 128 * MiB;

constexpr int LDS_BYTES = 147456;
constexpr int MISC_OFF = LDS_BYTES - 256;

__device__ __forceinline__ unsigned pk2(float lo, float hi) { f32x2 v = {lo, hi}; bf16v2 r = __builtin_convertvector(v, bf16v2); return __builtin_bit_cast(unsigned, r); }
__device__ __forceinline__ float bflo(unsigned w) { return __uint_as_float(w << 16); }
__device__ __forceinline__ float bfhi(unsigned w) { return __uint_as_float(w & 0xffff0000u); }
__device__ __forceinline__ float fsigmoid(float x) { return __builtin_amdgcn_rcpf(1.0f + __expf(-x)); }
__device__ __forceinline__ float fsilu(float x) { return x * fsigmoid(x); }
__device__ __forceinline__ float fgelu(float x) { return x * fsigmoid(1.5957691216f * (x + 0.044715f * x * x * x)); }
__device__ __forceinline__ float wave_sum(float v) {
#pragma unroll
    for (int o = 1; o < 64; o <<= 1) v += __shfl_xor(v, o);
    return v;
}
#define LDS_WAIT() asm volatile("s_waitcnt lgkmcnt(0)" ::: "memory")
#define LDS_BARRIER() asm volatile("s_waitcnt lgkmcnt(0)\n\ts_barrier" ::: "memory")
__device__ __forceinline__ int opaque_tid() { int t = threadIdx.x; asm volatile("" : "+v"(t)); return t; }

namespace pg8 {
#define PG8_LAS __attribute__((address_space(3)))
constexpr int BM = 256, BK = 64, HALF = 128, HTB = HALF * BK * 2, STAGE_BYTES = 8 * HTB, NXCD = 8, WGM = 8;
__host__ __device__ __forceinline__ int lds_byte(int r, int c) { const int st = (r >> 4) * 2 + (c >> 5), rr = r & 15, cc = c & 31, ob = rr * 64 + cc * 2; return st * 1024 + (ob ^ (((ob >> 9) & 1) << 5)); }
__host__ __device__ __forceinline__ void stage_rc(int b, int& R, int& C) { const int st = b / 1024, sb = b % 1024, swz = sb ^ (((sb >> 9) & 1) << 5); R = (st >> 1) * 16 + swz / 64; C = (st & 1) * 32 + (swz % 64) / 2; }
__host__ __device__ __forceinline__ int perm32(int rho) { const int n = rho >> 4, i = rho & 15; return 8 * (i >> 2) + 4 * n + (i & 3); }
struct Unit { int pm, pn; };
struct Gemm { const bf16_t* A; const bf16_t* Bt; int M, N, K, lda, ldb; };
struct StaticOrder {
    int nM, nN, nwg, G, c;
    __host__ __device__ void init(int M_, int N_, int G_, int c_) { nM = M_ / BM; nN = N_ / BM; nwg = nM * nN; G = G_; c = c_; }
    __host__ __device__ bool next(int i, Unit& u) const {
        const long L = (long)i * G + c; if (L >= nwg) return false;
        int wgid = (int)L; { const int q = nwg / NXCD, r = nwg % NXCD, xcd = wgid % NXCD, off = wgid / NXCD; wgid = (xcd < r ? xcd * (q + 1) : r * (q + 1) + (xcd - r) * q) + off; }
        const int nig = WGM * nN, gid = wgid / nig, fm = gid * WGM, gsz = (nM - fm) < WGM ? (nM - fm) : WGM;
        u.pm = fm + ((wgid % nig) % gsz); u.pn = (wgid % nig) / gsz; return true;
    }
    __device__ __forceinline__ void a_ready(const Unit&) const {}
    __device__ __forceinline__ void done(const Unit&) const {}
};
template <class Epi, class Sched, bool ALIGN_EPI = false, bool SP2 = false, bool F8 = false>
__device__ __forceinline__ void gemm_phase(PG8_LAS unsigned char* lds, const Gemm g, const Sched& S, const Epi& E) {
    const int tid = opaque_tid(), wid = __builtin_amdgcn_readfirstlane(tid >> 6), lane = tid & 63, wr = wid >> 2, wc = wid & 3, fr = lane & 15, fq = lane >> 4;
    const int K = g.K, nt = K / BK;
    unsigned voffA[2], voffB[2];
#pragma unroll
    for (int i = 0; i < 2; ++i) { int R, C; stage_rc(tid * 16 + i * 8192, R, C); const int Rb = Epi::PERM ? ((R & ~31) + perm32(R & 31)) : R;
        voffA[i] = (unsigned)(R * g.lda + C) * 2u; voffB[i] = (unsigned)(Rb * g.ldb + C) * 2u; }
    const size_t kstep = (size_t)(BK * 2);
    const size_t hstepA = (size_t)HALF * g.lda * 2, hstepB = (size_t)HALF * g.ldb * 2;
    const size_t tstepA = 2 * hstepA, tstepB = 2 * hstepB;
    const unsigned ldsw = (unsigned)wid * 1024u;
    const int aoff = lds_byte(wr * 64 + fr, fq * 8), boff = lds_byte(wc * 32 + fr, fq * 8);
#define PG8_SA(b, h) (((b) * 2 + (h)) * HTB)
#define PG8_SB(b, h) ((4 + (b) * 2 + (h)) * HTB)
#define PG8_STAGE(bufoff, gbase, voff) do { _Pragma("unroll") for (int _i = 0; _i < 2; ++_i) \
        __builtin_amdgcn_global_load_lds((const unsigned*)((const char*)(gbase) + (voff)[_i]), (PG8_LAS unsigned*)(lds + (bufoff) + ldsw + _i * 8192), 16, 0, 0); } while (0)
#define PG8_LD8(p) __builtin_shufflevector(*(const PG8_LAS i32x4*)(p), *(const PG8_LAS i32x4*)((p) + 1024), 0, 1, 2, 3, 4, 5, 6, 7)
#define PG8_LDA(dst, b, h) do { if constexpr (F8) { _Pragma("unroll") for (int m = 0; m < 4; ++m) dst##8[m] = PG8_LD8(lds + PG8_SA(b, h) + aoff + m * 2048); } \
        else { _Pragma("unroll") for (int m = 0; m < 4; ++m) _Pragma("unroll") for (int k = 0; k < 2; ++k) dst[m][k] = *(const PG8_LAS bf16x8*)(lds + PG8_SA(b, h) + aoff + m * 2048 + k * 1024); } } while (0)
#define PG8_LDB(dst, b, h) do { if constexpr (F8) { _Pragma("unroll") for (int n = 0; n < 2; ++n) dst##8[n] = PG8_LD8(lds + PG8_SB(b, h) + boff + n * 2048); } \
        else { _Pragma("unroll") for (int n = 0; n < 2; ++n) _Pragma("unroll") for (int k = 0; k < 2; ++k) dst[n][k] = *(const PG8_LAS bf16x8*)(lds + PG8_SB(b, h) + boff + n * 2048 + k * 1024); } } while (0)
#define PG8_MMA(ai, bj, At, Bt) do { __builtin_amdgcn_s_setprio(1); _Pragma("unroll") for (int m = 0; m < 4; ++m) _Pragma("unroll") for (int n = 0; n < 2; ++n) { \
        if constexpr (F8) {   \
            acc[ai][bj][m][n] = __builtin_amdgcn_mfma_scale_f32_16x16x128_f8f6f4(Bt##8[n], At##8[m], acc[ai][bj][m][n], 0, 0, 0, 0x7f7f7f7f, 0, 0x7f7f7f7f); \
        } else { _Pragma("unroll") for (int k = 0; k < 2; ++k) acc[ai][bj][m][n] = __builtin_amdgcn_mfma_f32_16x16x32_bf16(Bt[n][k], At[m][k], acc[ai][bj][m][n], 0, 0, 0); } } \
        __builtin_amdgcn_s_setprio(0); } while (0)
#define PG8_WAIT_V(n) asm volatile("s_waitcnt vmcnt(" #n ")" ::: "memory")
#define PG8_WAIT_L(n) asm volatile("s_waitcnt lgkmcnt(" #n ")" ::: "memory")
#define PG8_BAR __builtin_amdgcn_s_barrier()
#define PG8_SCHED __builtin_amdgcn_sched_barrier(0)
    Unit cur, nxt; int ui = 0;
    if (!S.next(0, cur)) return;
    f32x4 acc[2][2][4][2];
#pragma unroll
    for (int a = 0; a < 2; ++a)
#pragma unroll
        for (int b = 0; b < 2; ++b)
#pragma unroll
            for (int m = 0; m < 4; ++m)
#pragma unroll
                for (int n = 0; n < 2; ++n) acc[a][b][m][n] = (f32x4){0.f, 0.f, 0.f, 0.f};
    bf16x8 At[4][2], B0[2][2], B1[2][2]; i32x8 At8[4], B08[2], B18[2];
    const char* cA = (const char*)g.A + (size_t)cur.pm * tstepA; const char* cB = (const char*)g.Bt + (size_t)cur.pn * tstepB;
    S.a_ready(cur);
    if constexpr (SP2) {
        PG8_STAGE(PG8_SB(0, 0), cB, voffB); PG8_STAGE(PG8_SB(0, 1), cB + hstepB, voffB); PG8_STAGE(PG8_SA(0, 0), cA, voffA); PG8_STAGE(PG8_SA(0, 1), cA + hstepA, voffA);
        if (wr == 1) PG8_BAR;
        PG8_WAIT_V(2); PG8_BAR;
        PG8_STAGE(PG8_SB(1, 0), cB + kstep, voffB); PG8_STAGE(PG8_SA(1, 0), cA + kstep, voffA); PG8_STAGE(PG8_SB(1, 1), cB + hstepB + kstep, voffB);
        PG8_WAIT_V(6); PG8_BAR;
    } else {
        PG8_STAGE(PG8_SB(0, 0), cB, voffB); PG8_STAGE(PG8_SA(0, 0), cA, voffA); PG8_STAGE(PG8_SB(0, 1), cB + hstepB, voffB); PG8_STAGE(PG8_SA(0, 1), cA + hstepA, voffA);
        if (wr == 1) PG8_BAR;
        PG8_WAIT_V(4); PG8_BAR;
        PG8_STAGE(PG8_SB(1, 0), cB + kstep, voffB); PG8_STAGE(PG8_SA(1, 0), cA + kstep, voffA); PG8_STAGE(PG8_SB(1, 1), cB + hstepB + kstep, voffB);
        PG8_WAIT_V(6); PG8_BAR;
    }
    for (;;) {
        const bool has_next = S.next(ui + 1, nxt);
        const char* nA = has_next ? (const char*)g.A + (size_t)nxt.pm * tstepA : cA; const char* nB = has_next ? (const char*)g.Bt + (size_t)nxt.pn * tstepB : cB;
        for (int t = 0; t < nt; t += 2) {
            const bool last = (t == nt - 2);
            const char* a1 = cA + (size_t)(t + 1) * kstep;
            const char* a2 = last ? nA : cA + (size_t)(t + 2) * kstep; const char* b2 = last ? nB : cB + (size_t)(t + 2) * kstep;
            const char* a3 = a2 + kstep; const char* b3 = b2 + kstep;
            if (last && has_next) S.a_ready(nxt);
            if constexpr (SP2) {
            PG8_LDB(B0, 0, 0); PG8_LDB(B1, 0, 1); PG8_SCHED; PG8_LDA(At, 0, 0); PG8_STAGE(PG8_SA(1, 1), a1 + hstepA, voffA);
            PG8_WAIT_V(8); PG8_WAIT_L(0); PG8_BAR; PG8_MMA(0, 0, At, B0); PG8_MMA(0, 1, At, B1); PG8_BAR; PG8_SCHED;
            PG8_LDA(At, 0, 1); PG8_STAGE(PG8_SB(0, 0), b2, voffB); PG8_STAGE(PG8_SB(0, 1), b2 + hstepB, voffB); PG8_STAGE(PG8_SA(0, 0), a2, voffA);
            PG8_WAIT_V(8); PG8_WAIT_L(0); PG8_BAR; PG8_MMA(1, 0, At, B0); PG8_MMA(1, 1, At, B1); PG8_BAR; PG8_SCHED;
            PG8_LDB(B0, 1, 0); PG8_LDB(B1, 1, 1); PG8_SCHED; PG8_LDA(At, 1, 0); PG8_STAGE(PG8_SA(0, 1), a2 + hstepA, voffA);
            PG8_WAIT_V(8); PG8_WAIT_L(0); PG8_BAR; PG8_MMA(0, 0, At, B0); PG8_MMA(0, 1, At, B1); PG8_BAR; PG8_SCHED;
            PG8_LDA(At, 1, 1); PG8_STAGE(PG8_SB(1, 0), b3, voffB); PG8_STAGE(PG8_SB(1, 1), b3 + hstepB, voffB); PG8_STAGE(PG8_SA(1, 0), a3, voffA);
            PG8_WAIT_V(8); PG8_WAIT_L(0); PG8_BAR; PG8_MMA(1, 0, At, B0); PG8_MMA(1, 1, At, B1); PG8_BAR; PG8_SCHED;
            } else {
            PG8_LDB(B0, 0, 0); PG8_SCHED; PG8_LDA(At, 0, 0); PG8_STAGE(PG8_SA(1, 1), a1 + hstepA, voffA);
            PG8_WAIT_L(8); PG8_BAR; PG8_WAIT_L(0); PG8_MMA(0, 0, At, B0); PG8_BAR; PG8_SCHED;
            PG8_LDB(B1, 0, 1); PG8_STAGE(PG8_SB(0, 0), b2, voffB);
            PG8_BAR; PG8_WAIT_L(0); PG8_MMA(0, 1, At, B1); PG8_BAR;
            PG8_LDA(At, 0, 1); PG8_STAGE(PG8_SA(0, 0), a2, voffA);
            PG8_BAR; PG8_WAIT_L(0); PG8_MMA(1, 0, At, B0); PG8_BAR; PG8_SCHED;
            PG8_STAGE(PG8_SB(0, 1), b2 + hstepB, voffB);
            PG8_WAIT_V(6); PG8_BAR; PG8_MMA(1, 1, At, B1); PG8_BAR;
            PG8_LDB(B0, 1, 0); PG8_SCHED; PG8_LDA(At, 1, 0); PG8_STAGE(PG8_SA(0, 1), a2 + hstepA, voffA);
            PG8_WAIT_L(8); PG8_BAR; PG8_WAIT_L(0); PG8_MMA(0, 0, At, B0); PG8_BAR; PG8_SCHED;
            PG8_LDB(B1, 1, 1); PG8_STAGE(PG8_SB(1, 0), b3, voffB);
            PG8_BAR; PG8_WAIT_L(0); PG8_MMA(0, 1, At, B1); PG8_BAR;
            PG8_LDA(At, 1, 1); PG8_STAGE(PG8_SA(1, 0), a3, voffA);
            PG8_BAR; PG8_WAIT_L(0); PG8_MMA(1, 0, At, B0); PG8_BAR; PG8_SCHED;
            PG8_STAGE(PG8_SB(1, 1), b3 + hstepB, voffB);
            PG8_WAIT_V(6); PG8_BAR; PG8_MMA(1, 1, At, B1); PG8_BAR;
            }
        }
        if constexpr (ALIGN_EPI) { if (wr == 0) PG8_BAR; }
        E(acc, cur, wr, wc, fr, fq);
        if (!has_next) break;
#pragma unroll
        for (int a = 0; a < 2; ++a)
#pragma unroll
            for (int b = 0; b < 2; ++b)
#pragma unroll
                for (int m = 0; m < 4; ++m)
#pragma unroll
                    for (int n = 0; n < 2; ++n) acc[a][b][m][n] = (f32x4){0.f, 0.f, 0.f, 0.f};
        cur = nxt; cA = nA; cB = nB; ++ui;
        if constexpr (ALIGN_EPI) { if (wr == 1) PG8_BAR; }
    }
    PG8_WAIT_V(0);
    if constexpr (!ALIGN_EPI) { if (wr == 0) PG8_BAR; }
    PG8_BAR;
#undef PG8_SA
#undef PG8_SB
#undef PG8_STAGE
#undef PG8_LDA
#undef PG8_LD8
#undef PG8_LDB
#undef PG8_MMA
#undef PG8_WAIT_V
#undef PG8_WAIT_L
#undef PG8_BAR
#undef PG8_SCHED
}

struct EpiStoreBf16 {
    static constexpr bool PERM = true;
    bf16_t* O; int ldc; float scale;
    __device__ __forceinline__ void operator()(const f32x4 (&acc)[2][2][4][2], const Unit& u, int wr, int wc, int fr, int fq) const {
        const int row0 = u.pm * BM + wr * 64 + fr, col0 = u.pn * BM + wc * 32 + 8 * fq;
#pragma unroll
        for (int ai = 0; ai < 2; ++ai)
#pragma unroll
            for (int m = 0; m < 4; ++m) { bf16_t* rowp = O + (size_t)(row0 + ai * HALF + m * 16) * ldc + col0;
#pragma unroll
                for (int bj = 0; bj < 2; ++bj) { const f32x4 v0 = acc[ai][bj][m][0] * scale, v1 = acc[ai][bj][m][1] * scale;
                    u32x4 w; w.x = pk2(v0[0], v0[1]); w.y = pk2(v0[2], v0[3]); w.z = pk2(v1[0], v1[1]); w.w = pk2(v1[2], v1[3]);
                    *(u32x4*)(rowp + bj * HALF) = w; } }
    }
};
struct EpiStoreQ {
    static constexpr bool PERM = true;
    bf16_t* O;
    __device__ __forceinline__ void operator()(const f32x4 (&acc)[2][2][4][2], const Unit& u, int wr, int wc, int fr, int fq) const {
        const int row0 = u.pm * BM + wr * 64 + fr, col0 = u.pn * BM + wc * 32 + 8 * fq;
#pragma unroll
        for (int ai = 0; ai < 2; ++ai)
#pragma unroll
            for (int m = 0; m < 4; ++m) { const int row = row0 + ai * HALF + m * 16, tg = row >> 5, t = row & 31;
#pragma unroll
                for (int bj = 0; bj < 2; ++bj) { const int c0 = col0 + bj * HALF, h = c0 >> 8, pp = (c0 >> 7) & 1, cc = c0 & 127, ks = cc >> 4, hh = (cc >> 3) & 1;
                    const f32x4 v0 = acc[ai][bj][m][0], v1 = acc[ai][bj][m][1];
                    u32x4 w; w.x = pk2(v0[0], v0[1]); w.y = pk2(v0[2], v0[3]); w.z = pk2(v1[0], v1[1]); w.w = pk2(v1[2], v1[3]);
                    *(u32x4*)(O + ((size_t)((((tg * 8 + h) * 2 + pp) * 8 + ks) * 64 + hh * 32 + t)) * 8) = w; } }
    }
};
struct EpiWout {
    static constexpr bool PERM = false;
    const float* xs; float* out; const float* g1;
    __device__ __forceinline__ void operator()(const f32x4 (&acc)[2][2][4][2], const Unit& u, int wr, int wc, int fr, int fq) const {
        const int row0 = u.pm * BM + wr * 64 + fr, col0 = u.pn * BM + wc * 32 + 4 * fq;
        const int b = (u.pm * BM) >> 11;
        f32x4 gv[2][2];
#pragma unroll
        for (int bj = 0; bj < 2; ++bj)
#pragma unroll
            for (int n = 0; n < 2; ++n) gv[bj][n] = *(const f32x4*)(g1 + (size_t)b * NMODC + col0 + bj * HALF + n * 16);
#pragma unroll
        for (int ai = 0; ai < 2; ++ai)
#pragma unroll
            for (int m = 0; m < 4; ++m) { const size_t off = (size_t)(row0 + ai * HALF + m * 16) * D + col0;
#pragma unroll
                for (int bj = 0; bj < 2; ++bj)
#pragma unroll
                    for (int n = 0; n < 2; ++n) { const f32x4 xv = *(const f32x4*)(xs + off + bj * HALF + n * 16);
                        *(f32x4*)(out + off + bj * HALF + n * 16) = xv + gv[bj][n] * acc[ai][bj][m][n]; } }
    }
};
struct EpiGlu {
    static constexpr bool PERM = true;
    const bf16_t* PB; const bf16_t* YS; const bf16_t* ORAW; const float* SSQ; const float* ng; const float* gb_; bf16_t* O;
    __device__ __forceinline__ void operator()(const f32x4 (&acc)[2][2][4][2], const Unit& u, int wr, int wc, int fr, int fq) const {
        const int row0 = u.pm * BM + wr * 64 + fr, col0 = u.pn * BM + wc * 32 + 8 * fq;
#pragma unroll
        for (int bj = 0; bj < 2; ++bj) {
            const int c = col0 + bj * HALF, head = c >> 7;
            const f32x4 n0 = *(const f32x4*)(ng + (c & 127)), n1 = *(const f32x4*)(ng + (c & 127) + 4);
            const f32x4 b0 = *(const f32x4*)(gb_ + c), b1 = *(const f32x4*)(gb_ + c + 4);
            const float ngv[8] = {n0[0], n0[1], n0[2], n0[3], n1[0], n1[1], n1[2], n1[3]};
            const float bbv[8] = {b0[0], b0[1], b0[2], b0[3], b1[0], b1[1], b1[2], b1[3]};
#pragma unroll
            for (int ai = 0; ai < 2; ++ai)
#pragma unroll
                for (int m = 0; m < 4; ++m) {
                    const int row = row0 + ai * HALF + m * 16;
                    const bf16_t* pb = PB + (size_t)row * 4096 + c;
                    const u32x4 og = *(const u32x4*)(pb), ys = *(const u32x4*)(YS + (size_t)row * D + c), ga = *(const u32x4*)(pb + 2048), gb = *(const u32x4*)(pb + 3072);
                    const u32x4 orw = *(const u32x4*)(ORAW + (size_t)row * D + c);
                    const float rstd = __builtin_amdgcn_rsqf(SSQ[(size_t)row * 8 + head] * (1.0f / 128.0f) + EPS);
                    const f32x4 a0 = acc[ai][bj][m][0], a1 = acc[ai][bj][m][1];
                    const float av[8] = {a0[0], a0[1], a0[2], a0[3], a1[0], a1[1], a1[2], a1[3]};
                    float res[8];
#pragma unroll
                    for (int j = 0; j < 8; ++j) {
                        const unsigned wog = og[j >> 1], wys = ys[j >> 1], wga = ga[j >> 1], wgb = gb[j >> 1], wor = orw[j >> 1];
                        const float fog = (j & 1) ? bfhi(wog) : bflo(wog), fys = (j & 1) ? bfhi(wys) : bflo(wys), fga = (j & 1) ? bfhi(wga) : bflo(wga),
                                    fgb = (j & 1) ? bfhi(wgb) : bflo(wgb), fo = (j & 1) ? bfhi(wor) : bflo(wor);
                        const float ya = fo * rstd * ngv[j] * fsilu(fog);
                        const float yb = fys * fsigmoid((DBG_NO_ACC ? 0.f : av[j]) + bbv[j]);
                        res[j] = (DBG_NO_YA ? 0.f : fsigmoid(fga) * ya) + (DBG_NO_YB ? 0.f : (DBG_NO_GB ? 0.5f : fsigmoid(fgb)) * yb);
                    }
                    int w0 = 0, w1 = 0;
                    w0 = __builtin_amdgcn_cvt_pk_fp8_f32(res[0] * MG_SCALE, res[1] * MG_SCALE, w0, false); w0 = __builtin_amdgcn_cvt_pk_fp8_f32(res[2] * MG_SCALE, res[3] * MG_SCALE, w0, true);
                    w1 = __builtin_amdgcn_cvt_pk_fp8_f32(res[4] * MG_SCALE, res[5] * MG_SCALE, w1, false); w1 = __builtin_amdgcn_cvt_pk_fp8_f32(res[6] * MG_SCALE, res[7] * MG_SCALE, w1, true);
                    *(u32x2*)((unsigned char*)O + (size_t)row * D + c) = (u32x2){(unsigned)w0, (unsigned)w1};
                }
        }
    }
};
}

#define XB_TMO      128
#define XB_XCNT(j)  (256  + 64 * (j))
#define XB_XSUB(j)  (1280 + 64 * (j))
#define XB_XGEN(j)  (2304 + 64 * (j))
#define XB_TOP      3328
#define XB_TOPGEN   3392
#define XCD_BAR_WORDS 3456
#define XB_SPIN_CAP (1u << 25)
__device__ __forceinline__ unsigned xb_ld(unsigned* p)              { return __hip_atomic_load(p, __ATOMIC_RELAXED, __HIP_MEMORY_SCOPE_AGENT); }
__device__ __forceinline__ unsigned xb_add(unsigned* p, unsigned v) { return __hip_atomic_fetch_add(p, v, __ATOMIC_RELAXED, __HIP_MEMORY_SCOPE_AGENT); }
__device__ __forceinline__ unsigned xb_xcc_id() { return (unsigned)__builtin_amdgcn_s_getreg((3 << 11) | 20) & 0xFu; }
#define XB_SPIN(cond, bar) do { unsigned _sp = 0; while (cond) { __builtin_amdgcn_s_sleep(1); \
    if ((++_sp & 255u) == 0u) { if (xb_ld(&(bar)[XB_TMO])) break; if (_sp > XB_SPIN_CAP) { atomicAdd(&(bar)[XB_TMO], 1u); break; } } } } while (0)
struct XcdBarrier { unsigned* bar; unsigned x; volatile LAS unsigned* st; };
__device__ __forceinline__ XcdBarrier xcd_barrier_post(unsigned* bar, volatile LAS unsigned* st) {
    XcdBarrier b; b.bar = bar; b.x = xb_xcc_id(); b.st = st;
    if (threadIdx.x == 0) (void)xb_add(&bar[XB_XCNT(b.x)], 1u);
    return b;
}
__device__ __forceinline__ void xcd_barrier_complete(unsigned* bar, unsigned x, unsigned& nloc, unsigned& nx) {
    const unsigned G = gridDim.x * gridDim.y * gridDim.z;
    unsigned sum, cnt, mine, sp = 0u;
    for (;;) {
        sum = 0u; cnt = 0u; mine = 0u;
#pragma unroll
        for (unsigned j = 0; j < 16; ++j) { const unsigned c = xb_ld(&bar[XB_XCNT(j)]); sum += c; cnt += (c > 0u) ? 1u : 0u; mine = (j == x) ? c : mine; }
        if (sum == G) break;
        __builtin_amdgcn_s_sleep(1);
        if ((++sp & 255u) == 0u) { if (xb_ld(&bar[XB_TMO])) break; if (sp > XB_SPIN_CAP) { atomicAdd(&bar[XB_TMO], 1u); break; } }
    }
    nloc = mine > 0u ? mine : 1u; nx = cnt > 0u ? cnt : 1u;
}
__device__ __forceinline__ void xcd_barrier(const XcdBarrier& b) {
    asm volatile("s_waitcnt vmcnt(0)" ::: "memory");
    __syncthreads();
    if (threadIdx.x == 0) {
        unsigned* bar = b.bar;
        __builtin_amdgcn_s_waitcnt(0);
        unsigned nloc = b.st[0], nx = b.st[1];
        if (nloc == 0u) { xcd_barrier_complete(bar, b.x, nloc, nx); b.st[0] = nloc; b.st[1] = nx; }
        const unsigned old = xb_add(&bar[XB_XSUB(b.x)], 1u);
        const unsigned gen = old / nloc;
        if (old + 1u == (gen + 1u) * nloc) {
            __builtin_amdgcn_fence(__ATOMIC_RELEASE, "agent");
            asm volatile("s_waitcnt vmcnt(0)" ::: "memory");
            const unsigned og = xb_add(&bar[XB_TOP], 1u);
            const unsigned tg = og / nx;
            if (og + 1u == (tg + 1u) * nx) xb_add(&bar[XB_TOPGEN], 1u);
            else XB_SPIN(xb_ld(&bar[XB_TOPGEN]) == tg, bar);
            __builtin_amdgcn_fence(__ATOMIC_ACQUIRE, "agent");
            xb_add(&bar[XB_XGEN(b.x)], 1u);
            asm volatile("s_waitcnt vmcnt(0)" ::: "memory");
        } else {
            XB_SPIN(xb_ld(&bar[XB_XGEN(b.x)]) == gen, bar);
            __builtin_amdgcn_fence(__ATOMIC_ACQUIRE, "agent");
            asm volatile("s_waitcnt vmcnt(0)" ::: "memory");
        }
    }
    __syncthreads();
}

struct KP { const float* in[25]; float* out; unsigned char* ws; int gp_lo, gp_hi; };
enum { I_X = 0, I_C, I_ADAW, I_ADAB, I_N1G, I_N2G, I_WIN, I_LBL, I_HNG, I_ARE, I_AIM, I_LDT, I_BRE, I_BIM, I_CRE, I_CIM, I_S5D, I_GLUW, I_GLUB, I_WOUT, I_WQ, I_SUBK, I_PU, I_PV, I_FG };

typedef const KP __attribute__((address_space(4)))* kp_cptr;
__device__ __forceinline__ KP load_kp() {
#if defined(__HIP_DEVICE_COMPILE__)
    unsigned long long a = (unsigned long long)__builtin_amdgcn_kernarg_segment_ptr(); asm volatile("" : "+s"(a)); return *(kp_cptr)a;
#else
    return KP{};
#endif
}

__device__ __forceinline__ void phase_setup(const KP& p, LAS unsigned char* lds, int G) {
    const int tid = opaque_tid();
    {
        LAS float* cact = (LAS float*)lds;
        for (int it = blockIdx.x; it < 4 * 48; it += G) {
            for (int i = tid; i < 32 * 1024; i += 512) cact[i] = fsilu(p.in[I_C][i]);
            __syncthreads();
            const int l = it / 48, cb = it % 48, col = cb * 128 + (tid & 127), bg = tid >> 7;
            const float* W = p.in[I_ADAW] + (size_t)l * D * NMODC + col;
            float acc[8];
#pragma unroll
            for (int j = 0; j < 8; ++j) acc[j] = 0.f;
            for (int k4 = 0; k4 < 256; ++k4) {
                const float w0 = W[(size_t)(4 * k4 + 0) * NMODC], w1 = W[(size_t)(4 * k4 + 1) * NMODC], w2 = W[(size_t)(4 * k4 + 2) * NMODC], w3 = W[(size_t)(4 * k4 + 3) * NMODC];
#pragma unroll
                for (int j = 0; j < 8; ++j) { const f32x4 c4 = *(const LAS f32x4*)(cact + (8 * bg + j) * 1024 + 4 * k4); acc[j] += c4[0] * w0 + c4[1] * w1 + c4[2] * w2 + c4[3] * w3; }
            }
            float* MOD = (float*)(p.ws + WS_MOD);
            const float bias = p.in[I_ADAB][l * NMODC + col];
#pragma unroll
            for (int j = 0; j < 8; ++j) MOD[((size_t)l * 32 + 8 * bg + j) * NMODC + col] = acc[j] + bias;
            __syncthreads();
        }
    }
    const int gtid = blockIdx.x * 512 + tid;
    if (gtid < 1024) {
        const float* lg = p.in[I_LBL]; float v[4], mx = -1e30f;
#pragma unroll
        for (int l = 0; l < 4; ++l) { v[l] = lg[l * 1024 + gtid]; mx = fmaxf(mx, v[l]); }
        float s = 0.f;
#pragma unroll
        for (int l = 0; l < 4; ++l) { v[l] = __expf(v[l] - mx); s += v[l]; }
        float* LB = (float*)(p.ws + WS_LB); float cum = 0.f; const float first = v[0] / s;
#pragma unroll
        for (int l = 0; l < 4; ++l) { cum += v[l] / s; LB[l * 1024 + gtid] = (l == 0) ? 0.f : (cum - first); }
    }
    if (gtid >= 1024 && gtid < 1024 + 16384) {
        const int id = gtid - 1024, lg = id >> 6, pp = id & 63;
        const float a_re = p.in[I_ARE][id], a_im = p.in[I_AIM][id];
        const float step = expf(p.in[I_LDT][lg]);
        const float mag = expf(step * a_re), ang = step * a_im;
        const float ab_re = mag * cosf(ang), ab_im = mag * sinf(ang);
        const float den = a_re * a_re + a_im * a_im;
        const float z_re = ((ab_re - 1.0f) * a_re + ab_im * a_im) / den;
        const float z_im = (ab_im * a_re - (ab_re - 1.0f) * a_im) / den;
        float* ABAR = (float*)(p.ws + WS_ABAR); ABAR[2 * id] = ab_re; ABAR[2 * id + 1] = ab_im;
        bf16_t* BOP = (bf16_t*)(p.ws + WS_BOP); bf16_t* COP = (bf16_t*)(p.ws + WS_COP);
        const float* bre = p.in[I_BRE] + (size_t)id * 16; const float* bim = p.in[I_BIM] + (size_t)id * 16;
#pragma unroll
        for (int c = 0; c < 16; ++c) {
            const float br = bre[c], bi = bim[c];
            const float rr = z_re * br - z_im * bi, ii = z_re * bi + z_im * br;
            BOP[((size_t)lg * 128 + 2 * pp) * 16 + c] = (bf16_t)(pk2(rr, 0.f) & 0xffffu);
            BOP[((size_t)lg * 128 + 2 * pp + 1) * 16 + c] = (bf16_t)(pk2(ii, 0.f) & 0xffffu);
            const float cr = p.in[I_CRE][((size_t)lg * 16 + c) * 64 + pp], ci = p.in[I_CIM][((size_t)lg * 16 + c) * 64 + pp];
            COP[((size_t)lg * 16 + c) * 128 + 2 * pp] = (bf16_t)(pk2(cr, 0.f) & 0xffffu);
            COP[((size_t)lg * 16 + c) * 128 + 2 * pp + 1] = (bf16_t)(pk2(-ci, 0.f) & 0xffffu);
        }
    }
}

__device__ __forceinline__ void transpose_item(const float* W, int K, int N, bf16_t* WT, LAS float* scr, int item, int lane) {
    const int nblk = N / 32, kb = item / nblk, nb = item % nblk, k0 = 64 * kb, n0 = 32 * nb;
#pragma unroll 8
    for (int i = 0; i < 32; ++i) { const int kk = 2 * i + (lane >> 5); scr[kk * 33 + (lane & 31)] = W[(size_t)(k0 + kk) * N + n0 + (lane & 31)]; }
    LDS_WAIT();
    const int c = lane & 7;
#pragma unroll
    for (int j = 0; j < 4; ++j) { const int n = (lane >> 3) + 8 * j; const LAS float* s = scr + (8 * c) * 33 + n;
        u32x4 o; o.x = pk2(s[0 * 33], s[1 * 33]); o.y = pk2(s[2 * 33], s[3 * 33]); o.z = pk2(s[4 * 33], s[5 * 33]); o.w = pk2(s[6 * 33], s[7 * 33]);
        *(u32x4*)(WT + (size_t)(n0 + n) * K + k0 + 8 * c) = o; }
    LDS_WAIT();
}
__device__ __forceinline__ void cvt_f32_fp8(const float* src, unsigned char* dst, size_t n4, size_t gtid, size_t nthr, float scale) {
    for (size_t i = gtid; i < n4; i += nthr) { const f32x4 v = ((const f32x4*)src)[i] * scale; int w = 0;
        w = __builtin_amdgcn_cvt_pk_fp8_f32(v[0], v[1], w, false); w = __builtin_amdgcn_cvt_pk_fp8_f32(v[2], v[3], w, true); ((unsigned*)dst)[i] = (unsigned)w; }
}
__device__ __forceinline__ void cvt_f32_fp8_sliced(const float* src, unsigned char* dst, size_t gtid, size_t nthr, float scale) {
    for (size_t i = gtid; i < (size_t)16384 * 64; i += nthr) {
        const size_t e = i >> 6; const int sl = (int)(i & 63) >> 3, c = (int)(i & 7);
        const f32x4* sp = (const f32x4*)(src + e * 1024 + sl * 128 + c * 16); u32x4 o;
#pragma unroll
        for (int q = 0; q < 4; ++q) { const f32x4 v = sp[q] * scale; int w = 0; w = __builtin_amdgcn_cvt_pk_fp8_f32(v[0], v[1], w, false); w = __builtin_amdgcn_cvt_pk_fp8_f32(v[2], v[3], w, true); o[q] = (unsigned)w; }
        *(u32x4*)(dst + ((size_t)sl * 16384 + e) * 128 + c * 16) = o;
    }
}
__device__ __forceinline__ void transpose_item_fp8(const float* W, int K, int N, unsigned char* WT, LAS float* scr, int item, int lane, float scale) {
    const int nblk = N / 32, kb = item / nblk, nb = item % nblk, k0 = 64 * kb, n0 = 32 * nb;
#pragma unroll 8
    for (int i = 0; i < 32; ++i) { const int kk = 2 * i + (lane >> 5); scr[kk * 33 + (lane & 31)] = W[(size_t)(k0 + kk) * N + n0 + (lane & 31)]; }
    LDS_WAIT();
    const int c = lane & 7;
#pragma unroll
    for (int j = 0; j < 4; ++j) { const int n = (lane >> 3) + 8 * j; const LAS float* sp = scr + (8 * c) * 33 + n;
        int w0 = 0, w1 = 0;
        w0 = __builtin_amdgcn_cvt_pk_fp8_f32(sp[0 * 33] * scale, sp[1 * 33] * scale, w0, false); w0 = __builtin_amdgcn_cvt_pk_fp8_f32(sp[2 * 33] * scale, sp[3 * 33] * scale, w0, true);
        w1 = __builtin_amdgcn_cvt_pk_fp8_f32(sp[4 * 33] * scale, sp[5 * 33] * scale, w1, false); w1 = __builtin_amdgcn_cvt_pk_fp8_f32(sp[6 * 33] * scale, sp[7 * 33] * scale, w1, true);
        *(u32x2*)(WT + (size_t)(n0 + n) * K + k0 + 8 * c) = (u32x2){(unsigned)w0, (unsigned)w1}; }
    LDS_WAIT();
}
__device__ __forceinline__ void cvt_f32_bf16(const float* src, bf16_t* dst, size_t n4, size_t gtid, size_t nthr) {
    for (size_t i = gtid; i < n4; i += nthr) { const f32x4 v = ((const f32x4*)src)[i]; u32x2 o; o.x = pk2(v[0], v[1]); o.y = pk2(v[2], v[3]); ((u32x2*)dst)[i] = o; }
}
template <bool F8OUT>
__device__ __forceinline__ void norm_rows(const float* xsrc, bf16_t* hdst, const float* gain, const float* mod_l, int sh_off, int sc_off, int gw, int ngw, int lane) {
    for (int r0 = gw * 4; r0 < M; r0 += ngw * 4) {
        const int b = r0 >> 11;
        f32x4 v[4][4]; float ss[4];
#pragma unroll
        for (int i = 0; i < 4; ++i) { const f32x4* xr = (const f32x4*)(xsrc + (size_t)(r0 + i) * D) + lane;
#pragma unroll
            for (int j = 0; j < 4; ++j) v[i][j] = xr[64 * j]; }
#pragma unroll
        for (int i = 0; i < 4; ++i) { float t = 0.f;
#pragma unroll
            for (int j = 0; j < 4; ++j) t += (v[i][j][0] * v[i][j][0] + v[i][j][1] * v[i][j][1]) + (v[i][j][2] * v[i][j][2] + v[i][j][3] * v[i][j][3]);
            ss[i] = t; }
#pragma unroll
        for (int o = 1; o < 64; o <<= 1) {
#pragma unroll
            for (int i = 0; i < 4; ++i) ss[i] += __shfl_xor(ss[i], o); }
        const float* mb = mod_l + (size_t)b * NMODC;
#pragma unroll
        for (int j = 0; j < 4; ++j) { const int col = 256 * j + 4 * lane;
            const f32x4 g4 = *(const f32x4*)(gain + col), sc = *(const f32x4*)(mb + sc_off + col), sh = *(const f32x4*)(mb + sh_off + col);
            const f32x4 gs = g4 * (sc + 1.0f);
#pragma unroll
            for (int i = 0; i < 4; ++i) { const float rstd = __builtin_amdgcn_rsqf(ss[i] * (1.0f / D) + EPS);
                const f32x4 h = v[i][j] * rstd * gs + sh;
                if constexpr (F8OUT) { int w8 = 0; w8 = __builtin_amdgcn_cvt_pk_fp8_f32(h[0] * HIN_SCALE, h[1] * HIN_SCALE, w8, false); w8 = __builtin_amdgcn_cvt_pk_fp8_f32(h[2] * HIN_SCALE, h[3] * HIN_SCALE, w8, true);
                    *(unsigned*)((unsigned char*)hdst + (size_t)(r0 + i) * D + col) = (unsigned)w8; }
                else { u32x2 o; o.x = pk2(h[0], h[1]); o.y = pk2(h[2], h[3]); *(u32x2*)(hdst + (size_t)(r0 + i) * D + col) = o; } } }
    }
}
__device__ __forceinline__ void resid_norm_rows(const float* xsrc, float* xdst, const bf16_t* delta, bf16_t* hdst, const float* gain, const float* mod_l, int gw, int ngw, int lane) {
    for (int r0 = gw * 4; r0 < M; r0 += ngw * 4) {
        const int b = r0 >> 11; const float* mb = mod_l + (size_t)b * NMODC;
        f32x4 v[4][4]; u32x2 dl[4][4]; float ss[4];
#pragma unroll
        for (int i = 0; i < 4; ++i) { const f32x4* xr = (const f32x4*)(xsrc + (size_t)(r0 + i) * D) + lane; const u32x2* dp = (const u32x2*)(delta + (size_t)(r0 + i) * D) + lane;
#pragma unroll
            for (int j = 0; j < 4; ++j) { v[i][j] = xr[64 * j]; dl[i][j] = dp[64 * j]; } }
#pragma unroll
        for (int j = 0; j < 4; ++j) { const f32x4 g1 = *(const f32x4*)(mb + 2048 + 256 * j + 4 * lane);
#pragma unroll
            for (int i = 0; i < 4; ++i) { const f32x4 dv = {bflo(dl[i][j][0]), bfhi(dl[i][j][0]), bflo(dl[i][j][1]), bfhi(dl[i][j][1])}; v[i][j] = v[i][j] + g1 * dv;
                ((f32x4*)(xdst + (size_t)(r0 + i) * D) + lane)[64 * j] = v[i][j]; } }
#pragma unroll
        for (int i = 0; i < 4; ++i) { float t = 0.f;
#pragma unroll
            for (int j = 0; j < 4; ++j) t += (v[i][j][0] * v[i][j][0] + v[i][j][1] * v[i][j][1]) + (v[i][j][2] * v[i][j][2] + v[i][j][3] * v[i][j][3]);
            ss[i] = t; }
#pragma unroll
        for (int o = 1; o < 64; o <<= 1) {
#pragma unroll
            for (int i = 0; i < 4; ++i) ss[i] += __shfl_xor(ss[i], o); }
#pragma unroll
        for (int j = 0; j < 4; ++j) { const int col = 256 * j + 4 * lane;
            const f32x4 g4 = *(const f32x4*)(gain + col), sc = *(const f32x4*)(mb + 4096 + col), sh = *(const f32x4*)(mb + 3072 + col);
            const f32x4 gs = g4 * (sc + 1.0f);
#pragma unroll
            for (int i = 0; i < 4; ++i) { const float rstd = __builtin_amdgcn_rsqf(ss[i] * (1.0f / D) + EPS);
                const f32x4 h = v[i][j] * rstd * gs + sh; u32x2 o; o.x = pk2(h[0], h[1]); o.y = pk2(h[2], h[3]); *(u32x2*)(hdst + (size_t)(r0 + i) * D + col) = o; } }
    }
}
__device__ __forceinline__ void phase_conv_norm1(const KP& p, LAS unsigned char* lds, int l, int G) {
    const int tid = opaque_tid(), lane = tid & 63, wave = __builtin_amdgcn_readfirstlane(tid >> 6);
    const int gw = blockIdx.x * 8 + wave, ngw = G * 8;
    LAS float* scr = (LAS float*)(lds + wave * 8448);
    constexpr int I_IN = 16 * (INC / 32), I_G = 16 * 32, I_O = 16 * 32, I_Q = 16 * 64, NIT = I_IN + I_G + I_O + I_Q;
    for (int it = gw; it < NIT; it += ngw) {
        int r = it;
        if (r < I_IN) { transpose_item_fp8(p.in[I_WIN] + (size_t)l * D * INC, D, INC, p.ws + WS_WIN, scr, r, lane, WIN_SCALE); continue; } r -= I_IN;
        if (r < I_G) { transpose_item(p.in[I_GLUW] + (size_t)l * D * D, D, D, (bf16_t*)(p.ws + WS_WGLU), scr, r, lane); continue; } r -= I_G;
        if (r < I_O) { transpose_item_fp8(p.in[I_WOUT] + (size_t)l * D * D, D, D, p.ws + WS_WOUT, scr, r, lane, WO_SCALE); continue; } r -= I_O;
        transpose_item(p.in[I_WQ] + (size_t)l * D * 2048, D, 2048, (bf16_t*)(p.ws + WS_WQ), scr, r, lane);
    }
    const size_t gtid = (size_t)blockIdx.x * 512 + tid, nthr = (size_t)G * 512;
    cvt_f32_bf16(p.in[I_SUBK] + (size_t)l * 262144, (bf16_t*)(p.ws + WS_KEYS), 262144 / 4, gtid, nthr);
    cvt_f32_fp8_sliced(p.in[I_PU] + (size_t)l * 16384 * 1024, p.ws + WS_U, gtid, nthr, U_SCALE);
    cvt_f32_fp8_sliced(p.in[I_PV] + (size_t)l * 16384 * 1024, p.ws + WS_V, gtid, nthr, V_SCALE);
    const float* xsrc = (l == 0) ? p.in[I_X] : p.out;
    norm_rows<true>(xsrc, (bf16_t*)(p.ws + WS_H), p.in[I_N1G] + l * D, (const float*)(p.ws + WS_MOD) + (size_t)l * 32 * NMODC, 0, 1024, gw, ngw, lane);
}

__device__ __forceinline__ void phase_hgrn2(const KP& p, LAS unsigned char* lds, int l, int G) {
    const int tid = opaque_tid(), lane = tid & 63, w = __builtin_amdgcn_readfirstlane(tid >> 6), fr = lane & 15, g = lane >> 4;
    constexpr int QS = 272, TS = 72;
    constexpr int OFF_QT = 0, OFF_KH = 8704, OFF_KT = 17408, OFF_VT = 26624, OFF_EREF = 35840, OFF_ELR = 36352, OFF_SEG = 36864, PBUF = 40960;
    const bf16_t* PA = (const bf16_t*)(p.ws + WS_R0);
    bf16_t* ORAW = (bf16_t*)(p.ws + WS_OR);
    const float* LB = (const float*)(p.ws + WS_LB) + l * 1024;
    for (int unit = blockIdx.x; unit < 256; unit += G) {
        const int b = unit >> 3, h = unit & 7, k0 = 2 * lane;
        const float lb0 = LB[h * 128 + k0], lb1 = LB[h * 128 + k0 + 1];
        const float om0 = 1.0f - lb0, om1 = 1.0f - lb1;
        f32x4 S[8];
#pragma unroll
        for (int kt = 0; kt < 8; ++kt) S[kt] = (f32x4){0.f, 0.f, 0.f, 0.f};
        unsigned rq[4], rf[4], rv[4];
        {
            const bf16_t* base = PA + ((size_t)b * SEQ + 4 * w) * 3072 + h * 128 + k0;
#pragma unroll
            for (int i = 0; i < 4; ++i) { rq[i] = *(const unsigned*)(base + (size_t)i * 3072); rf[i] = *(const unsigned*)(base + (size_t)i * 3072 + 1024); rv[i] = *(const unsigned*)(base + (size_t)i * 3072 + 2048); }
        }
        for (int c = 0; c < 64; ++c) {
            LAS unsigned char* base = lds + (c & 1) * PBUF;
            float cs0[4], cs1[4], qv0[4], qv1[4], kv0[4], kv1[4];
            float run0 = 0.f, run1 = 0.f;
#pragma unroll
            for (int i = 0; i < 4; ++i) {
                const float fp0 = bflo(rf[i]), fp1 = bfhi(rf[i]);
                const float s0 = fsigmoid(fp0), s1 = fsigmoid(fp1);
                run0 += __logf(lb0 + om0 * s0); run1 += __logf(lb1 + om1 * s1);
                cs0[i] = run0; cs1[i] = run1;
                kv0[i] = om0 * (1.0f - s0); kv1[i] = om1 * (1.0f - s1);
                qv0[i] = fsilu(bflo(rq[i])); qv1[i] = fsilu(bfhi(rq[i]));
            }
            *(LAS f32x2*)(base + OFF_SEG + (w * 128 + k0) * 4) = (f32x2){run0, run1};
            LDS_BARRIER();
            float off0 = 0.f, off1 = 0.f, ref0 = 0.f, ref1 = 0.f, all0 = 0.f, all1 = 0.f;
#pragma unroll
            for (int s = 0; s < 8; ++s) { const f32x2 t2 = *(const LAS f32x2*)(base + OFF_SEG + (s * 128 + k0) * 4);
                if (s < w) { off0 += t2[0]; off1 += t2[1]; }
                if (s < 4) { ref0 += t2[0]; ref1 += t2[1]; }
                all0 += t2[0]; all1 += t2[1]; }
            float kh0[4], kh1[4];
#pragma unroll
            for (int i = 0; i < 4; ++i) {
                const float b0 = off0 + cs0[i], b1 = off1 + cs1[i];
                const float q0 = qv0[i] * __expf(b0 - ref0), q1 = qv1[i] * __expf(b1 - ref1);
                kh0[i] = kv0[i] * __expf(ref0 - b0); kh1[i] = kv1[i] * __expf(ref1 - b1);
                const int t = 4 * w + i;
                *(LAS unsigned*)(base + OFF_QT + t * QS + k0 * 2) = pk2(q0, q1);
                *(LAS unsigned*)(base + OFF_KH + t * QS + k0 * 2) = pk2(kh0[i], kh1[i]);
            }
            *(LAS u32x2*)(base + OFF_KT + k0 * TS + 8 * w) = (u32x2){pk2(kh0[0], kh0[1]), pk2(kh0[2], kh0[3])};
            *(LAS u32x2*)(base + OFF_KT + (k0 + 1) * TS + 8 * w) = (u32x2){pk2(kh1[0], kh1[1]), pk2(kh1[2], kh1[3])};
            *(LAS u32x2*)(base + OFF_VT + k0 * TS + 8 * w) = (u32x2){(rv[0] & 0xffffu) | (rv[1] << 16), (rv[2] & 0xffffu) | (rv[3] << 16)};
            *(LAS u32x2*)(base + OFF_VT + (k0 + 1) * TS + 8 * w) = (u32x2){(rv[0] >> 16) | (rv[1] & 0xffff0000u), (rv[2] >> 16) | (rv[3] & 0xffff0000u)};
            if (w == 0) {
                *(LAS f32x2*)(base + OFF_EREF + k0 * 4) = (f32x2){__expf(ref0), __expf(ref1)};
                *(LAS f32x2*)(base + OFF_ELR + k0 * 4) = (f32x2){__expf(all0 - ref0), __expf(all1 - ref1)};
            }
            LDS_BARRIER();
            if (c + 1 < 64) {
                const bf16_t* nb = PA + ((size_t)b * SEQ + (c + 1) * 32 + 4 * w) * 3072 + h * 128 + k0;
#pragma unroll
                for (int i = 0; i < 4; ++i) { rq[i] = *(const unsigned*)(nb + (size_t)i * 3072); rf[i] = *(const unsigned*)(nb + (size_t)i * 3072 + 1024); rv[i] = *(const unsigned*)(nb + (size_t)i * 3072 + 2048); }
            }
            bf16x8 qf[2][4], kf[2][4];
#pragma unroll
            for (int tt = 0; tt < 2; ++tt)
#pragma unroll
                for (int m = 0; m < 4; ++m) {
                    const LAS unsigned char* pq = base + OFF_QT + (16 * tt + fr) * QS + (32 * m + 4 * g) * 2;
                    const u32x2 lo = *(const LAS u32x2*)pq, hi = *(const LAS u32x2*)(pq + 32);
                    qf[tt][m] = __builtin_bit_cast(bf16x8, (u32x4){lo[0], lo[1], hi[0], hi[1]});
                    const LAS unsigned char* pk = base + OFF_KH + (16 * tt + fr) * QS + (32 * m + 4 * g) * 2;
                    const u32x2 lo2 = *(const LAS u32x2*)pk, hi2 = *(const LAS u32x2*)(pk + 32);
                    kf[tt][m] = __builtin_bit_cast(bf16x8, (u32x4){lo2[0], lo2[1], hi2[0], hi2[1]});
                }
            f32x4 PT00 = {0.f, 0.f, 0.f, 0.f}, PT01 = {0.f, 0.f, 0.f, 0.f}, PT11 = {0.f, 0.f, 0.f, 0.f};
#pragma unroll
            for (int m = 0; m < 4; ++m) {
                PT00 = __builtin_amdgcn_mfma_f32_16x16x32_bf16(kf[0][m], qf[0][m], PT00, 0, 0, 0);
                PT01 = __builtin_amdgcn_mfma_f32_16x16x32_bf16(kf[0][m], qf[1][m], PT01, 0, 0, 0);
                PT11 = __builtin_amdgcn_mfma_f32_16x16x32_bf16(kf[1][m], qf[1][m], PT11, 0, 0, 0);
            }
#pragma unroll
            for (int r = 0; r < 4; ++r) { if (4 * g + r > fr) { PT00[r] = 0.f; PT11[r] = 0.f; } }
            const bf16x8 pa0 = __builtin_bit_cast(bf16x8, (u32x4){pk2(PT00[0], PT00[1]), pk2(PT00[2], PT00[3]), 0u, 0u});
            const bf16x8 pa1 = __builtin_bit_cast(bf16x8, (u32x4){pk2(PT01[0], PT01[1]), pk2(PT01[2], PT01[3]), pk2(PT11[0], PT11[1]), pk2(PT11[2], PT11[3])});
            const LAS unsigned char* vrow = base + OFF_VT + (16 * w + fr) * TS;
            const u32x2 vpa = *(const LAS u32x2*)(vrow + 8 * g), vpb = *(const LAS u32x2*)(vrow + 32 + 8 * g);
            const u32x2 vna = *(const LAS u32x2*)(vrow + 16 * g), vnb = *(const LAS u32x2*)(vrow + 16 * g + 8);
            const bf16x8 vperm = __builtin_bit_cast(bf16x8, (u32x4){vpa[0], vpa[1], vpb[0], vpb[1]});
            const bf16x8 vnat = __builtin_bit_cast(bf16x8, (u32x4){vna[0], vna[1], vnb[0], vnb[1]});
#pragma unroll
            for (int kt = 0; kt < 8; ++kt) { const f32x4 e = *(const LAS f32x4*)(base + OFF_EREF + (16 * kt + 4 * g) * 4); S[kt] = S[kt] * e; }
            f32x4 O0 = {0.f, 0.f, 0.f, 0.f}, O1 = {0.f, 0.f, 0.f, 0.f};
#pragma unroll
            for (int m = 0; m < 4; ++m) {
                const bf16x8 sf = __builtin_bit_cast(bf16x8, (u32x4){pk2(S[2 * m][0], S[2 * m][1]), pk2(S[2 * m][2], S[2 * m][3]), pk2(S[2 * m + 1][0], S[2 * m + 1][1]), pk2(S[2 * m + 1][2], S[2 * m + 1][3])});
                O0 = __builtin_amdgcn_mfma_f32_16x16x32_bf16(qf[0][m], sf, O0, 0, 0, 0);
                O1 = __builtin_amdgcn_mfma_f32_16x16x32_bf16(qf[1][m], sf, O1, 0, 0, 0);
            }
            O0 = __builtin_amdgcn_mfma_f32_16x16x32_bf16(pa0, vperm, O0, 0, 0, 0);
            O1 = __builtin_amdgcn_mfma_f32_16x16x32_bf16(pa1, vperm, O1, 0, 0, 0);
#pragma unroll
            for (int kt = 0; kt < 8; ++kt) {
                const LAS unsigned char* krow = base + OFF_KT + (16 * kt + fr) * TS + 16 * g;
                const u32x2 ka = *(const LAS u32x2*)krow, kb = *(const LAS u32x2*)(krow + 8);
                const bf16x8 ktf = __builtin_bit_cast(bf16x8, (u32x4){ka[0], ka[1], kb[0], kb[1]});
                S[kt] = __builtin_amdgcn_mfma_f32_16x16x32_bf16(ktf, vnat, S[kt], 0, 0, 0);
            }
#pragma unroll
            for (int kt = 0; kt < 8; ++kt) { const f32x4 e = *(const LAS f32x4*)(base + OFF_ELR + (16 * kt + 4 * g) * 4); S[kt] = S[kt] * e; }
            bf16_t* orow = ORAW + ((size_t)b * SEQ + c * 32 + 4 * g) * D + h * 128 + 16 * w + fr;
#pragma unroll
            for (int r = 0; r < 4; ++r) { orow[(size_t)r * D] = (bf16_t)(pk2(O0[r], 0.f) & 0xffffu); orow[(size_t)(16 + r) * D] = (bf16_t)(pk2(O1[r], 0.f) & 0xffffu); }
        }
        __syncthreads();
    }
}

__device__ __forceinline__ void phase_s5(const KP& p, LAS unsigned char* lds, int l, int G, size_t ys_off) {
    const int tid = opaque_tid(), lane = tid & 63, w = __builtin_amdgcn_readfirstlane(tid >> 6), fr = lane & 15, g = lane >> 4;
    const int gw = blockIdx.x * 8 + w, ngw = G * 8;
    constexpr int BUS = 132;
    LAS float* BU = (LAS float*)(lds + w * 16896);
    LAS unsigned char* XI = (LAS unsigned char*)BU;
    const bf16_t* PB = (const bf16_t*)(p.ws + WS_R0);
    const bf16x8 zero8 = {0, 0, 0, 0, 0, 0, 0, 0};
    for (int unit = gw; unit < BATCH * 64; unit += ngw) {
        const int b = unit >> 6, grp = unit & 63, lg = l * 64 + grp;
        const bf16_t* BOP = (const bf16_t*)(p.ws + WS_BOP) + (size_t)lg * 128 * 16;
        const bf16_t* COP = (const bf16_t*)(p.ws + WS_COP) + (size_t)lg * 16 * 128;
        bf16x8 bfrag[8], cfrag[4], dfrag;
#pragma unroll
        for (int nt = 0; nt < 8; ++nt) bfrag[nt] = (g < 2) ? *(const bf16x8*)(BOP + (size_t)(16 * nt + fr) * 16 + 8 * g) : zero8;
#pragma unroll
        for (int ks = 0; ks < 4; ++ks) cfrag[ks] = DBG_S5_NOSSM ? zero8 : *(const bf16x8*)(COP + (size_t)fr * 128 + 32 * ks + 8 * g);
        {
            const unsigned dbits = pk2(p.in[I_S5D][l * 1024 + grp * 16 + fr], 0.f) & 0xffffu;
#pragma unroll
            for (int j = 0; j < 8; ++j) dfrag[j] = (g < 2 && (8 * g + j) == fr) ? (short)dbits : (short)0;
        }
        const float ar = ((const float*)(p.ws + WS_ABAR))[2 * ((size_t)lg * 64 + lane)], ai = ((const float*)(p.ws + WS_ABAR))[2 * ((size_t)lg * 64 + lane) + 1];
        const float nai = -ai; float xr = 0.f, xi = 0.f; unsigned hBU = 0u, hXI = 0u, hY = 0u;
        const bf16_t* ub = PB + ((size_t)b * SEQ) * 4096 + 1024 + grp * 16;
        bf16_t* yb_ = (bf16_t*)(p.ws + ys_off) + ((size_t)b * SEQ) * D + grp * 16;
        bf16x8 unext[2];
#pragma unroll
        for (int tt = 0; tt < 2; ++tt) unext[tt] = (g < 2) ? *(const bf16x8*)(ub + (size_t)(16 * tt + fr) * 4096 + 8 * g) : zero8;
        for (int t0 = 0; t0 < SEQ; t0 += 32) {
            bf16x8 ufrag[2];
#pragma unroll
            for (int tt = 0; tt < 2; ++tt) { ufrag[tt] = unext[tt]; if (t0 + 32 < SEQ) unext[tt] = (g < 2) ? *(const bf16x8*)(ub + (size_t)(t0 + 32 + 16 * tt + fr) * 4096 + 8 * g) : zero8; }
#pragma unroll
            for (int tt = 0; tt < 2; ++tt)
#pragma unroll
                for (int nt = 0; nt < 8; ++nt) {
                    const f32x4 a = __builtin_amdgcn_mfma_f32_16x16x32_bf16(ufrag[tt], bfrag[nt], (f32x4){0.f, 0.f, 0.f, 0.f}, 0, 0, 0);
#pragma unroll
                    for (int r = 0; r < 4; ++r) BU[(16 * tt + 4 * g + r) * BUS + 16 * nt + fr] = a[r];
                }
            LDS_WAIT();
#pragma unroll
            for (int t = 0; t < 32; ++t) {
                const f32x2 bb = *(const LAS f32x2*)(BU + t * BUS + 2 * lane); hBU += __float_as_uint(bb[0]) * 3u + __float_as_uint(bb[1]);
                float t1, t2, nr, ni;
                asm("v_fma_f32 %0, %1, %2, %3" : "=v"(t1) : "v"(nai), "v"(xi), "v"(bb[0]));
                asm("v_fma_f32 %0, %1, %2, %3" : "=v"(t2) : "v"(ai), "v"(xr), "v"(bb[1]));
                asm("v_fma_f32 %0, %1, %2, %3" : "=v"(nr) : "v"(ar), "v"(xr), "v"(t1));
                asm("v_fma_f32 %0, %1, %2, %3" : "=v"(ni) : "v"(ar), "v"(xi), "v"(t2));
                xr = nr; xi = ni;
                { const unsigned pv = pk2(nr, ni); hXI += pv; *(LAS unsigned*)(XI + t * (BUS * 4) + lane * 4) = pv; }
            }
            LDS_WAIT();
#pragma unroll
            for (int tt = 0; tt < 2; ++tt) {
                f32x4 y = {0.f, 0.f, 0.f, 0.f};
#pragma unroll
                for (int ks = 0; ks < 4; ++ks) {
                    const bf16x8 xf = *(const LAS bf16x8*)(XI + (16 * tt + fr) * (BUS * 4) + (32 * ks + 8 * g) * 2);
                    y = __builtin_amdgcn_mfma_f32_16x16x32_bf16(xf, cfrag[ks], y, 0, 0, 0);
                }
                y = __builtin_amdgcn_mfma_f32_16x16x32_bf16(ufrag[tt], dfrag, y, 0, 0, 0);
#pragma unroll
                for (int r = 0; r < 4; ++r) { const unsigned yv = pk2(fgelu(y[r]), 0.f) & 0xffffu; hY += yv * (unsigned)(r + 1); yb_[(size_t)(t0 + 16 * tt + 4 * g + r) * D + fr] = (bf16_t)yv; }
            }
            LDS_WAIT();
        }
        if (DBG_SELFCHECK) { for (int o = 1; o < 64; o <<= 1) { hBU += __shfl_xor((int)hBU, o); hXI += __shfl_xor((int)hXI, o); hY += __shfl_xor((int)hY, o); }
            unsigned* hs = (unsigned*)(p.ws + WS_CTL) + 65536 + (ys_off == WS_YS ? 0 : 8192) + unit * 4; unsigned hA = __float_as_uint(ar) * 7u + __float_as_uint(ai); for (int o = 1; o < 64; o <<= 1) hA += __shfl_xor((int)hA, o); if (lane == 0) { hs[0] = hBU; hs[1] = hXI; hs[2] = hA; } }
    }
    const bf16_t* ORAW = (const bf16_t*)(p.ws + WS_OR); float* SSQ = (float*)(p.ws + WS_SSQ);
    for (int row = gw; row < M; row += ngw) {
        const u32x4 a = *(const u32x4*)(ORAW + (size_t)row * D + 8 * lane), c2 = *(const u32x4*)(ORAW + (size_t)row * D + 512 + 8 * lane);
        float s0 = 0.f, s1 = 0.f;
#pragma unroll
        for (int j = 0; j < 4; ++j) { const float x0 = bflo(a[j]), x1 = bfhi(a[j]), y0 = bflo(c2[j]), y1 = bfhi(c2[j]); s0 += x0 * x0 + x1 * x1; s1 += y0 * y0 + y1 * y1; }
#pragma unroll
        for (int o = 1; o < 16; o <<= 1) { s0 += __shfl_xor(s0, o); s1 += __shfl_xor(s1, o); }
        if (fr == 0) { SSQ[(size_t)row * 8 + g] = s0; SSQ[(size_t)row * 8 + 4 + g] = s1; }
    }
}

__device__ __forceinline__ unsigned fkey(float f) { const unsigned u = __float_as_uint(f); return u ^ ((unsigned)((int)u >> 31) | 0x80000000u); }
__device__ __forceinline__ float kval(unsigned k) { const unsigned u = (k & 0x80000000u) ? (k ^ 0x80000000u) : ~k; return __uint_as_float(u); }
#define CE_DESC(a, b) do { const unsigned _mx = (a) > (b) ? (a) : (b), _mn = (a) > (b) ? (b) : (a); (a) = _mx; (b) = _mn; } while (0)
__device__ __forceinline__ void sort16_desc(unsigned (&a)[16]) {
#pragma unroll
    for (int kk = 1; kk <= 4; ++kk)
#pragma unroll
        for (int jj = kk - 1; jj >= 0; --jj)
#pragma unroll
            for (int i = 0; i < 16; ++i) { const int k = 1 << kk, j = 1 << jj, l2 = i ^ j;
                if (l2 > i) { if ((i & k) == 0) CE_DESC(a[i], a[l2]); else CE_DESC(a[l2], a[i]); } }
}
__device__ __forceinline__ void merge_top16(unsigned (&a)[16], const unsigned (&b)[16]) {
#pragma unroll
    for (int i = 0; i < 16; ++i) a[i] = a[i] > b[15 - i] ? a[i] : b[15 - i];
#pragma unroll
    for (int jj = 3; jj >= 0; --jj)
#pragma unroll
        for (int i = 0; i < 16; ++i) { const int j = 1 << jj, l2 = i ^ j; if (l2 > i) CE_DESC(a[i], a[l2]); }
}
__device__ __forceinline__ void phase_topk(const KP& p, LAS unsigned char* lds, int G) {
    const int tid = opaque_tid(), lane = tid & 63, w = __builtin_amdgcn_readfirstlane(tid >> 6), hh = lane >> 5;
    const int gw = blockIdx.x * 8 + w, ngw = G * 8;
    const bf16_t* Q = (const bf16_t*)(p.ws + WS_R0); const bf16_t* KEYS = (const bf16_t*)(p.ws + WS_KEYS);
    unsigned* SEL = (unsigned*)(p.ws + WS_SEL);
    LAS unsigned char* tab = lds + w * 2048 + lane * 32;
    const int CI[50] = {0,0,0,0,0,0,0,0,0,0,0,0,0,0,0,0, 1,1,1,1,1,1,1,1, 2,2,2,2,2, 3,3,3,3, 4,4,4, 5,5, 6,6, 7,7, 8,9,10,11,12,13,14,15};
    const int CJ[50] = {0,1,2,3,4,5,6,7,8,9,10,11,12,13,14,15, 0,1,2,3,4,5,6,7, 0,1,2,3,4, 0,1,2,3, 0,1,2, 0,1, 0,1, 0,1, 0,0,0,0,0,0,0,0};
    LAS unsigned char* kimg = lds + 16384;
    for (int h = 0; h < 8; ++h) {
      __syncthreads();
#pragma unroll
      for (int i = 0; i < 8; ++i) { const int ch = tid + 512 * i, row = ch >> 4, c16 = ch & 15;
          *(LAS u32x4*)(kimg + row * 272 + c16 * 16) = *(const u32x4*)(KEYS + (size_t)(h * 256 + row) * 128 + c16 * 8); }
      __syncthreads();
      for (int tg = gw; tg < 2048; tg += ngw) {
        const int t = tg * 32 + (lane & 31);
        unsigned top[2][16];
#pragma unroll
        for (int pp = 0; pp < 2; ++pp) {
            bf16x8 qf[8];
#pragma unroll
            for (int ks = 0; ks < 8; ++ks) qf[ks] = *(const bf16x8*)(Q + ((size_t)((((tg * 8 + h) * 2 + pp) * 8 + ks) * 64 + lane)) * 8);
            const LAS unsigned char* kb = kimg + (pp * 128 + (lane & 31)) * 272 + 16 * hh;
#pragma unroll
            for (int nt = 0; nt < 4; ++nt) {
                f32x16 acc;
#pragma unroll
                for (int i = 0; i < 16; ++i) acc[i] = 0.f;
#pragma unroll
                for (int ks = 0; ks < 8; ++ks) { const bf16x8 kf = *(const LAS bf16x8*)(kb + (32 * nt) * 272 + 32 * ks);
                    acc = __builtin_amdgcn_mfma_f32_32x32x16_bf16(kf, qf[ks], acc, 0, 0, 0); }
                unsigned ky[16];
#pragma unroll
                for (int r = 0; r < 16; ++r) ky[r] = (fkey(acc[r]) & ~127u) | (unsigned)(32 * nt + (r & 3) + 8 * (r >> 2)) | (unsigned)(4 * hh);
                sort16_desc(ky);
                if (nt == 0) {
#pragma unroll
                    for (int i = 0; i < 16; ++i) top[pp][i] = ky[i];
                } else merge_top16(top[pp], ky);
            }
            unsigned other[16];
#pragma unroll
            for (int i = 0; i < 16; ++i) other[i] = (unsigned)__shfl_xor((int)top[pp][i], 32);
            merge_top16(top[pp], other);
        }
        float sa[16], sb[16];
#pragma unroll
        for (int i = 0; i < 16; ++i) { sa[i] = kval(top[0][i] & ~127u); sb[i] = kval(top[1][i] & ~127u); }
        unsigned c0[16], c1[16];
#pragma unroll
        for (int s = 0; s < 32; ++s) {
            unsigned key = 0u;
            if (s < 25) {
                const float v0 = sa[CI[s]] + sb[CJ[s]], v1 = sa[CI[25 + s]] + sb[CJ[25 + s]];
                const unsigned k0 = (fkey(v0) & ~255u) | (unsigned)(CI[s] * 16 + CJ[s]), k1 = (fkey(v1) & ~255u) | (unsigned)(CI[25 + s] * 16 + CJ[25 + s]);
                key = hh ? k1 : k0;
            }
            if (s < 16) c0[s] = key; else c1[s - 16] = key;
        }
        sort16_desc(c0); sort16_desc(c1); merge_top16(c0, c1);
#pragma unroll
        for (int i = 0; i < 16; ++i) c1[i] = (unsigned)__shfl_xor((int)c0[i], 32);
        merge_top16(c0, c1);
        {
            u32x4 wa, wb;
#pragma unroll
            for (int q4 = 0; q4 < 4; ++q4) {
                wa[q4] = (top[0][4 * q4] & 127u) | ((top[0][4 * q4 + 1] & 127u) << 8) | ((top[0][4 * q4 + 2] & 127u) << 16) | ((top[0][4 * q4 + 3] & 127u) << 24);
                wb[q4] = (top[1][4 * q4] & 127u) | ((top[1][4 * q4 + 1] & 127u) << 8) | ((top[1][4 * q4 + 2] & 127u) << 16) | ((top[1][4 * q4 + 3] & 127u) << 24);
            }
            *(LAS u32x4*)tab = wa; *(LAS u32x4*)(tab + 16) = wb;
        }
        float ev[16], esum = 0.f; const float vmax = kval(c0[0] & ~255u);
#pragma unroll
        for (int k = 0; k < 16; ++k) { ev[k] = __expf(kval(c0[k] & ~255u) - vmax); esum += ev[k]; }
        const float rs = 1.0f / esum;
        LDS_WAIT();
        unsigned outw[8]; const unsigned hmask = hh ? 0xffffffffu : 0u;
#pragma unroll
        for (int kk = 0; kk < 8; ++kk) {
            const unsigned key = c0[kk] ^ ((c0[kk] ^ c0[8 + kk]) & hmask); const float e = __uint_as_float(__float_as_uint(ev[kk]) ^ ((__float_as_uint(ev[kk]) ^ __float_as_uint(ev[8 + kk])) & hmask));
            const unsigned code = key & 255u, ia = tab[code >> 4], ib = tab[16 + (code & 15u)];
            outw[kk] = (pk2(0.f, e * rs) & 0xffff0000u) | (ia * 128u + ib);
        }
        u32x4* dst = (u32x4*)(SEL + (size_t)t * 128 + h * 16 + hh * 8);
        dst[0] = (u32x4){outw[0], outw[1], outw[2], outw[3]}; dst[1] = (u32x4){outw[4], outw[5], outw[6], outw[7]};
        LDS_WAIT();
      }
    }
    __syncthreads();
}

__device__ __forceinline__ void fp8x4_to_f32(unsigned w, float& a, float& b, float& c, float& d) {
    const f32x2 lo = __builtin_amdgcn_cvt_pk_f32_fp8((int)w, false), hi = __builtin_amdgcn_cvt_pk_f32_fp8((int)w, true); a = lo[0]; b = lo[1]; c = hi[0]; d = hi[1];
}
struct XSlice { int sl, rank, nloc; };
__device__ __forceinline__ XSlice xslice_of_block(const KP& p, volatile LAS unsigned* MISC, int G) {
    unsigned* bar = (unsigned*)(p.ws + WS_CTL) + 4096; unsigned cnt[8]; unsigned tot = 0; bool ok = true;
#pragma unroll
    for (int j = 0; j < 8; ++j) { cnt[j] = xb_ld(&bar[XB_XCNT(j)]); tot += cnt[j]; ok = ok && (cnt[j] > 0u); }
    ok = ok && (tot == (unsigned)G);
    XSlice x;
    if (ok) { const unsigned myx = MISC[16]; x.sl = (int)myx; x.rank = (int)MISC[17]; x.nloc = (int)cnt[myx & 7u]; }
    else { x.sl = (int)(blockIdx.x & 7); x.rank = (int)(blockIdx.x >> 3); x.nloc = (G - x.sl + 7) >> 3; }
    x.sl = __builtin_amdgcn_readfirstlane(x.sl); x.rank = __builtin_amdgcn_readfirstlane(x.rank); x.nloc = __builtin_amdgcn_readfirstlane(x.nloc);
    return x;
}
__device__ __forceinline__ float dot16_fp8(const u32x4 u, const float (&hf)[16]) {
    float d = 0.f;
#pragma unroll
    for (int j = 0; j < 4; ++j) { float f0, f1, f2, f3; fp8x4_to_f32(u[j], f0, f1, f2, f3);
        d = __builtin_fmaf(f0, hf[4 * j], d); d = __builtin_fmaf(f1, hf[4 * j + 1], d); d = __builtin_fmaf(f2, hf[4 * j + 2], d); d = __builtin_fmaf(f3, hf[4 * j + 3], d); }
    return d;
}
typedef __bf16 bf16v8 __attribute__((ext_vector_type(8)));
__device__ __forceinline__ float dot16_fp8_bf16(const u32x4 u, const bf16v8 h0, const bf16v8 h1) {
    float d0 = 0.f, d1 = 0.f;
    d0 = __builtin_amdgcn_fdot2_f32_bf16(__builtin_amdgcn_cvt_scalef32_pk_bf16_fp8(u[0], 1.0f, false), __builtin_shufflevector(h0, h0, 0, 1), d0, false);
    d1 = __builtin_amdgcn_fdot2_f32_bf16(__builtin_amdgcn_cvt_scalef32_pk_bf16_fp8(u[0], 1.0f, true),  __builtin_shufflevector(h0, h0, 2, 3), d1, false);
    d0 = __builtin_amdgcn_fdot2_f32_bf16(__builtin_amdgcn_cvt_scalef32_pk_bf16_fp8(u[1], 1.0f, false), __builtin_shufflevector(h0, h0, 4, 5), d0, false);
    d1 = __builtin_amdgcn_fdot2_f32_bf16(__builtin_amdgcn_cvt_scalef32_pk_bf16_fp8(u[1], 1.0f, true),  __builtin_shufflevector(h0, h0, 6, 7), d1, false);
    d0 = __builtin_amdgcn_fdot2_f32_bf16(__builtin_amdgcn_cvt_scalef32_pk_bf16_fp8(u[2], 1.0f, false), __builtin_shufflevector(h1, h1, 0, 1), d0, false);
    d1 = __builtin_amdgcn_fdot2_f32_bf16(__builtin_amdgcn_cvt_scalef32_pk_bf16_fp8(u[2], 1.0f, true),  __builtin_shufflevector(h1, h1, 2, 3), d1, false);
    d0 = __builtin_amdgcn_fdot2_f32_bf16(__builtin_amdgcn_cvt_scalef32_pk_bf16_fp8(u[3], 1.0f, false), __builtin_shufflevector(h1, h1, 4, 5), d0, false);
    d1 = __builtin_amdgcn_fdot2_f32_bf16(__builtin_amdgcn_cvt_scalef32_pk_bf16_fp8(u[3], 1.0f, true),  __builtin_shufflevector(h1, h1, 6, 7), d1, false);
    return d0 + d1;
}
__device__ __forceinline__ float dpp_sum8(float d) {
    d += __uint_as_float(__builtin_amdgcn_update_dpp(0, __float_as_uint(d), 0xB1, 0xF, 0xF, true));
    d += __uint_as_float(__builtin_amdgcn_update_dpp(0, __float_as_uint(d), 0x4E, 0xF, 0xF, true));
    d += __uint_as_float(__builtin_amdgcn_update_dpp(0, __float_as_uint(d), 0x141, 0xF, 0xF, true));
    return d;
}
__device__ __forceinline__ void phase_expert_u(const KP& p, LAS unsigned char* lds, volatile LAS unsigned* MISC, int G) {
    const int tid = opaque_tid(), lane = tid & 63, w = __builtin_amdgcn_readfirstlane(tid >> 6), j = lane >> 3, c = lane & 7;
    const XSlice xs = xslice_of_block(p, MISC, G);
    const bf16_t* H2 = (const bf16_t*)(p.ws + WS_H); const unsigned char* Us = p.ws + WS_U + (size_t)xs.sl * 16384 * 128;
    const unsigned* SEL = (const unsigned*)(p.ws + WS_SEL); unsigned* PDu = (unsigned*)(p.ws + WS_R0) + (size_t)xs.sl * M * 64;
    const int t0 = xs.rank * 8 + w, tstep = xs.nloc * 8;
    LAS unsigned char* ring = lds + w * 17920;
    LAS unsigned char* selb = ring + 16384; LAS unsigned char* hbuf = ring + 16384 + 1024;
    const int tlast = t0 + ((M - 1 - t0) / tstep) * tstep;
#define E1_CL(t) ((t) <= tlast ? (t) : tlast)
#define E1_DMA_SEL(t, par) do { const unsigned* sp = SEL + (size_t)E1_CL(t) * 128 + lane; \
            __builtin_amdgcn_global_load_lds(sp, (LAS unsigned*)(selb + (par) * 512), 4, 0, 0); __builtin_amdgcn_global_load_lds(sp + 64, (LAS unsigned*)(selb + (par) * 512 + 256), 4, 0, 0); } while (0)
#define E1_DMA_H(t, par) do { __builtin_amdgcn_global_load_lds((const unsigned*)(H2 + (size_t)E1_CL(t) * D + xs.sl * 128) + lane, (LAS unsigned*)(hbuf + (par) * 256), 4, 0, 0); } while (0)
#define E1_DMA_ROW(i, idxv) do { __builtin_amdgcn_global_load_lds((const unsigned*)(Us + (size_t)((idxv) & 0x3fffu) * 128 + 16 * c), (LAS unsigned*)(ring + (i) * 1024), 16, 0, 0); } while (0)
    if (t0 < M) {
        E1_DMA_SEL(t0, 0); E1_DMA_SEL(t0 + tstep, 1); E1_DMA_H(t0, 0);
        asm volatile("s_waitcnt vmcnt(0)" ::: "memory");
        { u32x4 s0[4];
#pragma unroll
          for (int q = 0; q < 4; ++q) s0[q] = *(const LAS u32x4*)(selb + (16 * j + 4 * q) * 4);
#pragma unroll
          for (int i = 0; i < 16; ++i) E1_DMA_ROW(i, s0[i >> 2][i & 3]); }
        { PDu[(size_t)t0 * 64 + 8 * j + (c >> 1) + 4 * (c & 1)] = 0u; }
        int par = 0;
        for (int tok = t0; tok < M; tok += tstep, par ^= 1) {
            E1_DMA_SEL(tok + 2 * tstep, par); E1_DMA_H(tok + tstep, par ^ 1);
            asm volatile("s_waitcnt vmcnt(19)" ::: "memory");
            u32x4 sn[4];
#pragma unroll
            for (int q = 0; q < 4; ++q) sn[q] = *(const LAS u32x4*)(selb + (par ^ 1) * 512 + (16 * j + 4 * q) * 4);
            const bf16v8 hb0 = *(const LAS bf16v8*)(hbuf + par * 256 + 32 * c), hb1 = *(const LAS bf16v8*)(hbuf + par * 256 + 32 * c + 16);
            float pd0 = 0.f, pd1 = 0.f;
#pragma unroll
            for (int i0 = 0; i0 < 16; i0 += 4) {
                asm volatile("s_waitcnt vmcnt(16)" ::: "memory");
                u32x4 row[4];
#pragma unroll
                for (int r = 0; r < 4; ++r) row[r] = *(const LAS u32x4*)(ring + (i0 + r) * 1024 + 16 * lane);
                asm volatile("s_waitcnt lgkmcnt(0)" ::: "memory");
#pragma unroll
                for (int r = 0; r < 4; ++r) E1_DMA_ROW(i0 + r, sn[(i0 + r) >> 2][(i0 + r) & 3]);
#pragma unroll
                for (int r = 0; r < 4; ++r) { const int i = i0 + r; const float d = dpp_sum8(dot16_fp8_bf16(row[r], hb0, hb1));
                    if (i < 8) pd0 = (c == i) ? d : pd0; else pd1 = (c == i - 8) ? d : pd1; }
            }
            { const float nb0 = __uint_as_float(__builtin_amdgcn_update_dpp(0, __float_as_uint(pd0), 0xB1, 0xF, 0xF, true)), nb1 = __uint_as_float(__builtin_amdgcn_update_dpp(0, __float_as_uint(pd1), 0xB1, 0xF, 0xF, true));
              PDu[(size_t)tok * 64 + 8 * j + (c >> 1) + 4 * (c & 1)] = (c & 1) ? pk2(nb1, pd1) : pk2(pd0, nb0); }
        }
        asm volatile("s_waitcnt vmcnt(0)" ::: "memory");
    }
#undef E1_CL
#undef E1_DMA_SEL
#undef E1_DMA_H
#undef E1_DMA_ROW
}
__device__ __forceinline__ void phase_expert_w(const KP& p, int G) {
    const int tid = opaque_tid(), lane = tid & 63, w = __builtin_amdgcn_readfirstlane(tid >> 6);
    const int gw = blockIdx.x * 8 + w, ngw = G * 8;
    unsigned* SEL = (unsigned*)(p.ws + WS_SEL); const unsigned* PDu = (const unsigned*)(p.ws + WS_R0);
    for (int tok = gw; tok < M; tok += ngw) {
        f32x2 d = {0.f, 0.f};
#pragma unroll
        for (int sl = 0; sl < 8; ++sl) { const unsigned pw = PDu[((size_t)sl * M + tok) * 64 + lane]; d[0] += bflo(pw); d[1] += bfhi(pw); }
        u32x2* sp = (u32x2*)(SEL + (size_t)tok * 128 + 2 * lane); const u32x2 s2 = *sp;
        const float w0 = __uint_as_float(s2[0] & 0xffff0000u) * fgelu(d[0] * (1.0f / U_SCALE)) * (1.0f / V_SCALE);
        const float w1 = __uint_as_float(s2[1] & 0xffff0000u) * fgelu(d[1] * (1.0f / U_SCALE)) * (1.0f / V_SCALE);
        u32x2 o; o[0] = (pk2(0.f, w0) & 0xffff0000u) | (s2[0] & 0x3fffu); o[1] = (pk2(0.f, w1) & 0xffff0000u) | (s2[1] & 0x3fffu);
        *sp = o;
    }
}
__device__ __forceinline__ void phase_expert_v(const KP& p, LAS unsigned char* lds, volatile LAS unsigned* MISC, int l, int G) {
    const int tid = opaque_tid(), lane = tid & 63, w = __builtin_amdgcn_readfirstlane(tid >> 6), j = lane >> 3, c = lane & 7;
    const XSlice xs = xslice_of_block(p, MISC, G);
    const unsigned char* Vs = p.ws + WS_V + (size_t)xs.sl * 16384 * 128;
    const unsigned* SEL = (const unsigned*)(p.ws + WS_SEL);
    const float* g2 = (const float*)(p.ws + WS_MOD) + (size_t)l * 32 * NMODC + 5120;
    float* X = p.out;
    const int t0 = xs.rank * 8 + w, tstep = xs.nloc * 8;
    const bool b3 = (lane & 8) != 0;
    LAS unsigned char* ring = lds + w * 17920; LAS unsigned char* selb = ring + 16384;
    const int tlast = t0 + ((M - 1 - t0) / tstep) * tstep;
#define E2_CL(t) ((t) <= tlast ? (t) : tlast)
#define E2_DMA_SEL(t, par) do { const unsigned* sp = SEL + (size_t)E2_CL(t) * 128 + lane; \
            __builtin_amdgcn_global_load_lds(sp, (LAS unsigned*)(selb + (par) * 512), 4, 0, 0); __builtin_amdgcn_global_load_lds(sp + 64, (LAS unsigned*)(selb + (par) * 512 + 256), 4, 0, 0); } while (0)
#define E2_DMA_ROW(i, idxv) do { __builtin_amdgcn_global_load_lds((const unsigned*)(Vs + (size_t)((idxv) & 0x3fffu) * 128 + 16 * c), (LAS unsigned*)(ring + (i) * 1024), 16, 0, 0); } while (0)
    if (t0 < M) {
        E2_DMA_SEL(t0, 0); E2_DMA_SEL(t0 + tstep, 1);
        asm volatile("s_waitcnt vmcnt(0)" ::: "memory");
        u32x4 sc[4];
#pragma unroll
        for (int q = 0; q < 4; ++q) sc[q] = *(const LAS u32x4*)(selb + (16 * j + 4 * q) * 4);
#pragma unroll
        for (int i = 0; i < 16; ++i) E2_DMA_ROW(i, sc[i >> 2][i & 3]);
        LAS float* xbuf = (LAS float*)(ring + 16384 + 1024);
        { float* xd = X + (size_t)t0 * D + xs.sl * 128 + 16 * c + 2 * j; __builtin_amdgcn_global_load_lds((const unsigned*)xd, (LAS unsigned*)xbuf, 4, 0, 0); }
        int par = 0, bcur = -1; f32x2 gv = {0.f, 0.f};
        for (int tok = t0; tok < M; tok += tstep, par ^= 1) {
            const int dim = xs.sl * 128 + 16 * c + 2 * j;
            float* xp = X + (size_t)tok * D + dim;
            if ((tok >> 11) != bcur) { bcur = tok >> 11; const f32x2 gl = *(const f32x2*)(g2 + (size_t)bcur * NMODC + dim); asm volatile("s_waitcnt vmcnt(0)" ::: "memory"); gv[0] = gl[0] * 1.0f; gv[1] = gl[1] * 1.0f; asm volatile("" : "+v"(gv)); }
            E2_DMA_SEL(tok + 2 * tstep, par);
            __builtin_amdgcn_global_load_lds((const unsigned*)xp, (LAS unsigned*)xbuf, 4, 0, 0); __builtin_amdgcn_global_load_lds((const unsigned*)(xp + 1), (LAS unsigned*)(xbuf + 64), 4, 0, 0);
            asm volatile("s_waitcnt vmcnt(21)" ::: "memory");
            u32x4 sn[4];
#pragma unroll
            for (int q = 0; q < 4; ++q) sn[q] = *(const LAS u32x4*)(selb + (par ^ 1) * 512 + (16 * j + 4 * q) * 4);
            f32x2 o2[8];
#pragma unroll
            for (int q = 0; q < 8; ++q) o2[q] = (f32x2){0.f, 0.f};
#pragma unroll
            for (int i0 = 0; i0 < 16; i0 += 4) {
                asm volatile("s_waitcnt vmcnt(17)" ::: "memory");
                u32x4 row[4];
#pragma unroll
                for (int r = 0; r < 4; ++r) row[r] = *(const LAS u32x4*)(ring + (i0 + r) * 1024 + 16 * lane);
                asm volatile("s_waitcnt lgkmcnt(0)" ::: "memory");
#pragma unroll
                for (int r = 0; r < 4; ++r) E2_DMA_ROW(i0 + r, sn[(i0 + r) >> 2][(i0 + r) & 3]);
                {
                    const u32x2 wA = {sc[i0 >> 2][0], sc[i0 >> 2][1]}, wB = {sc[i0 >> 2][2], sc[i0 >> 2][3]};
#pragma unroll
                    for (int r = 0; r < 4; ++r)
#pragma unroll
                        for (int q = 0; q < 4; ++q) { const f32x2 lo = __builtin_amdgcn_cvt_pk_f32_fp8((int)row[r][q], false), hi = __builtin_amdgcn_cvt_pk_f32_fp8((int)row[r][q], true);
                            if (r & 1) { asm("v_pk_fma_f32 %0, %1, %2, %0 op_sel:[1,0,0] op_sel_hi:[1,1,1]" : "+v"(o2[2 * q]) : "v"(r < 2 ? wA : wB), "v"(lo));
                                         asm("v_pk_fma_f32 %0, %1, %2, %0 op_sel:[1,0,0] op_sel_hi:[1,1,1]" : "+v"(o2[2 * q + 1]) : "v"(r < 2 ? wA : wB), "v"(hi)); }
                            else       { asm("v_pk_fma_f32 %0, %1, %2, %0 op_sel:[0,0,0] op_sel_hi:[0,1,1]" : "+v"(o2[2 * q]) : "v"(r < 2 ? wA : wB), "v"(lo));
                                         asm("v_pk_fma_f32 %0, %1, %2, %0 op_sel:[0,0,0] op_sel_hi:[0,1,1]" : "+v"(o2[2 * q + 1]) : "v"(r < 2 ? wA : wB), "v"(hi)); } }
                }
            }
            float o[16];
#pragma unroll
            for (int q = 0; q < 8; ++q) { o[2 * q] = o2[q][0]; o[2 * q + 1] = o2[q][1]; }
            float r8[8], r4[4], r2[2];
#pragma unroll
            for (int k = 0; k < 8; ++k) { const u32x2 sw = __builtin_amdgcn_permlane32_swap(__float_as_uint(o[k]), __float_as_uint(o[8 + k]), false, false); r8[k] = __uint_as_float(sw[0]) + __uint_as_float(sw[1]); }
#pragma unroll
            for (int k = 0; k < 4; ++k) { const u32x2 sw = __builtin_amdgcn_permlane16_swap(__float_as_uint(r8[k]), __float_as_uint(r8[4 + k]), false, false); r4[k] = __uint_as_float(sw[0]) + __uint_as_float(sw[1]); }
#pragma unroll
            for (int k = 0; k < 2; ++k) { const float keep = b3 ? r4[2 + k] : r4[k], send = b3 ? r4[k] : r4[2 + k];
                r2[k] = keep + __uint_as_float(__builtin_amdgcn_update_dpp(0, __float_as_uint(send), 0x128, 0xF, 0xF, true)); }
            asm volatile("s_waitcnt vmcnt(16)" ::: "memory");
            { f32x2 xv; xv[0] = xbuf[lane] + gv[0] * r2[0]; xv[1] = xbuf[64 + lane] + gv[1] * r2[1]; *(f32x2*)xp = xv; }
#pragma unroll
            for (int q = 0; q < 4; ++q) sc[q] = sn[q];
        }
        asm volatile("s_waitcnt vmcnt(0)" ::: "memory");
    }
#undef E2_CL
#undef E2_DMA_SEL
#undef E2_DMA_ROW
}

__device__ __forceinline__ void phase_final(const KP& p, int G) {
    const int tid = opaque_tid(), lane = tid & 63, w = __builtin_amdgcn_readfirstlane(tid >> 6);
    const int gw = blockIdx.x * 8 + w, ngw = G * 8;
    const float* fg = p.in[I_FG];
    for (int r0 = gw * 4; r0 < M; r0 += ngw * 4) {
        f32x4 v[4][4]; float ss[4];
#pragma unroll
        for (int i = 0; i < 4; ++i) { const f32x4* xr = (const f32x4*)(p.out + (size_t)(r0 + i) * D) + lane;
#pragma unroll
            for (int j = 0; j < 4; ++j) v[i][j] = xr[64 * j]; }
#pragma unroll
        for (int i = 0; i < 4; ++i) { float t = 0.f;
#pragma unroll
            for (int j = 0; j < 4; ++j) t += (v[i][j][0] * v[i][j][0] + v[i][j][1] * v[i][j][1]) + (v[i][j][2] * v[i][j][2] + v[i][j][3] * v[i][j][3]);
            ss[i] = t; }
#pragma unroll
        for (int o = 1; o < 64; o <<= 1) {
#pragma unroll
            for (int i = 0; i < 4; ++i) ss[i] += __shfl_xor(ss[i], o); }
#pragma unroll
        for (int j = 0; j < 4; ++j) { const f32x4 g4 = *(const f32x4*)(fg + 256 * j + 4 * lane);
#pragma unroll
            for (int i = 0; i < 4; ++i) { const float rstd = __builtin_amdgcn_rsqf(ss[i] * (1.0f / D) + EPS); ((f32x4*)(p.out + (size_t)(r0 + i) * D) + lane)[64 * j] = v[i][j] * rstd * g4; } }
    }
}

__global__ void __launch_bounds__(512, 2) mk_fwd(KP p_) {
    extern __shared__ __attribute__((aligned(16))) unsigned char lds_raw[];
    LAS unsigned char* lds = (LAS unsigned char*)lds_raw;
    const int tid = threadIdx.x, G = gridDim.x;
    volatile LAS unsigned* MISC = (volatile LAS unsigned*)(lds + MISC_OFF);
    for (int i = tid; i < LDS_BYTES / 4; i += 512) ((LAS unsigned*)lds)[i] = 0u;
    __syncthreads();
    XcdBarrier bar = xcd_barrier_post((unsigned*)(p_.ws + WS_CTL) + 4096, MISC + 8);
    if (tid == 0) { const unsigned myx = xb_xcc_id(); MISC[16] = myx; MISC[17] = xb_add((unsigned*)(p_.ws + WS_CTL) + 8192 + 64 * (myx & 15u), 1u); }
    __syncthreads();
    const int lo = p_.gp_lo, hi = p_.gp_hi;
#ifndef PH_MASK
#define PH_MASK 0xFFFFF
#endif
#define IN(k) (lo <= (k) && (k) < hi)
#define EN(b) ((PH_MASK >> (b)) & 1)
#ifndef PH_REPEAT
#define PH_REPEAT 0
#endif
#define NREP(b) (((PH_REPEAT >> (b)) & 1) ? 2 : 1)
#define SEAM(k) do { if ((k) + 1 < hi) xcd_barrier(bar); } while (0)
    if (EN(12) && IN(GP_SETUP)) { const KP p = load_kp(); phase_setup(p, lds, G); SEAM(GP_SETUP); }
    for (int l = 0; l < DEPTH; ++l) {
        const int g0 = 1 + l * NPH;
        if (EN(0) && IN(g0 + 0)) { _Pragma("nounroll") for (int rep = 0; rep < NREP(0); ++rep) { const KP p = load_kp(); phase_conv_norm1(p, lds, l, G); } SEAM(g0 + 0); }
        if (EN(1) && IN(g0 + 1)) { const KP p = load_kp();
            pg8::Gemm g{(const bf16_t*)(p.ws + WS_H), (const bf16_t*)(p.ws + WS_WIN), M, 3072, D / 2, D / 2, D / 2}; pg8::StaticOrder S; S.init(M, 3072, G, (int)blockIdx.x);
            pg8::EpiStoreBf16 E{(bf16_t*)(p.ws + WS_R0), 3072, 1.0f / (WIN_SCALE * HIN_SCALE)};
            _Pragma("nounroll") for (int rep = 0; rep < NREP(1); ++rep) pg8::gemm_phase<pg8::EpiStoreBf16, pg8::StaticOrder, false, true, true>(lds, g, S, E);
            SEAM(g0 + 1);
        }
        if (EN(2) && IN(g0 + 2)) { _Pragma("nounroll") for (int rep = 0; rep < NREP(2); ++rep) { const KP p = load_kp(); phase_hgrn2(p, lds, l, G); } SEAM(g0 + 2); }
        if (EN(3) && IN(g0 + 3)) { const KP p = load_kp();
            pg8::Gemm g{(const bf16_t*)(p.ws + WS_H), (const bf16_t*)(p.ws + WS_WIN) + (size_t)3072 * (D / 2), M, 4096, D / 2, D / 2, D / 2}; pg8::StaticOrder S; S.init(M, 4096, G, (int)blockIdx.x);
            pg8::EpiStoreBf16 E{(bf16_t*)(p.ws + WS_R0), 4096, 1.0f / (WIN_SCALE * HIN_SCALE)};
            _Pragma("nounroll") for (int rep = 0; rep < NREP(3); ++rep) pg8::gemm_phase<pg8::EpiStoreBf16, pg8::StaticOrder, false, true, true>(lds, g, S, E);
            SEAM(g0 + 3);
        }
        #if DBG_SELFCHECK
        if (EN(4) && IN(g0 + 4)) {
#pragma nounroll
            for (int rep = 0; rep < 2; ++rep) { const KP p = load_kp(); size_t yo = rep ? WS_H : WS_YS; asm volatile("" : "+s"(yo)); phase_s5(p, lds, l, G, yo); SEAM(g0 + 4); }
            const KP p = load_kp();
            const unsigned* a = (const unsigned*)(p.ws + WS_YS); const unsigned* b2 = (const unsigned*)(p.ws + WS_H); unsigned bad = 0;
            for (size_t i = (size_t)blockIdx.x * 512 + opaque_tid(); i < (size_t)M * D / 2; i += (size_t)G * 512) bad += (a[i] != b2[i]) ? 1u : 0u;
            if (bad) atomicAdd((unsigned*)(p.ws + WS_CTL) + 64, bad);
            { const unsigned* h1 = (const unsigned*)(p.ws + WS_CTL) + 65536; const unsigned* h2 = h1 + 8192; const int u2 = blockIdx.x * 512 + opaque_tid();
              if (u2 < 2048) { if (h1[u2 * 4] != h2[u2 * 4]) atomicAdd((unsigned*)(p.ws + WS_CTL) + 128, 1u); if (h1[u2 * 4 + 1] != h2[u2 * 4 + 1]) atomicAdd((unsigned*)(p.ws + WS_CTL) + 192, 1u); if (h1[u2 * 4 + 2] != h2[u2 * 4 + 2]) atomicAdd((unsigned*)(p.ws + WS_CTL) + 256, 1u); } }
            SEAM(g0 + 4); }
#else
        if (EN(4) && IN(g0 + 4)) { _Pragma("nounroll") for (int rep = 0; rep < NREP(4); ++rep) { const KP p = load_kp(); phase_s5(p, lds, l, G, WS_YS); } SEAM(g0 + 4); }
#endif
        if (EN(5) && IN(g0 + 5)) { const KP p = load_kp();
            pg8::Gemm g{(const bf16_t*)(p.ws + WS_YS), (const bf16_t*)(p.ws + WS_WGLU), M, D, D, D, D}; pg8::StaticOrder S; S.init(M, D, G, (int)blockIdx.x);
            pg8::EpiGlu E{(const bf16_t*)(p.ws + WS_R0), (const bf16_t*)(p.ws + WS_YS), (const bf16_t*)(p.ws + WS_OR), (const float*)(p.ws + WS_SSQ), p.in[I_HNG] + l * 128, p.in[I_GLUB] + l * D, (bf16_t*)(p.ws + WS_H)};
            _Pragma("nounroll") for (int rep = 0; rep < NREP(5); ++rep) pg8::gemm_phase<pg8::EpiGlu, pg8::StaticOrder, true, true>(lds, g, S, E);
            SEAM(g0 + 5);
        }
        if (EN(6) && IN(g0 + 6)) { const KP p = load_kp();
            pg8::Gemm g{(const bf16_t*)(p.ws + WS_H), (const bf16_t*)(p.ws + WS_WOUT), M, D, D / 2, D / 2, D / 2}; pg8::StaticOrder S; S.init(M, D, G, (int)blockIdx.x);
            pg8::EpiStoreBf16 E{(bf16_t*)(p.ws + WS_OR), D, 1.0f / (WO_SCALE * MG_SCALE)};
            pg8::gemm_phase<pg8::EpiStoreBf16, pg8::StaticOrder, false, true, true>(lds, g, S, E);
            SEAM(g0 + 6);
        }
        if (EN(7) && IN(g0 + 7)) { const KP p = load_kp();
            const int t2 = opaque_tid(), lane = t2 & 63, wave = __builtin_amdgcn_readfirstlane(t2 >> 6);
            resid_norm_rows((l == 0) ? p.in[I_X] : p.out, p.out, (const bf16_t*)(p.ws + WS_OR), (bf16_t*)(p.ws + WS_H), p.in[I_N2G] + l * D, (const float*)(p.ws + WS_MOD) + (size_t)l * 32 * NMODC, blockIdx.x * 8 + wave, G * 8, lane);
            SEAM(g0 + 7);
        }
        if (EN(8) && IN(g0 + 8)) { const KP p = load_kp();
            pg8::Gemm g{(const bf16_t*)(p.ws + WS_H), (const bf16_t*)(p.ws + WS_WQ), M, 2048, D, D, D}; pg8::StaticOrder S; S.init(M, 2048, G, (int)blockIdx.x);
            pg8::EpiStoreQ E{(bf16_t*)(p.ws + WS_R0)};
            _Pragma("nounroll") for (int rep = 0; rep < NREP(8); ++rep) pg8::gemm_phase<pg8::EpiStoreQ, pg8::StaticOrder, true, true>(lds, g, S, E);
            SEAM(g0 + 8);
        }
        if (EN(9) && IN(g0 + 9)) { _Pragma("nounroll") for (int rep = 0; rep < NREP(9); ++rep) { const KP p = load_kp(); phase_topk(p, lds, G); } SEAM(g0 + 9); }
        if (EN(10) && IN(g0 + 10)) {
            { const KP p = load_kp(); phase_expert_u(p, lds, MISC, G); } xcd_barrier(bar);
            { const KP p = load_kp(); phase_expert_w(p, G); } xcd_barrier(bar);
            { const KP p = load_kp(); phase_expert_v(p, lds, MISC, l, G); }
            SEAM(g0 + 10); }
    }
    if (EN(13) && IN(GP_FINAL)) { const KP p = load_kp(); phase_final(p, G); }
#undef IN
#undef EN
#undef NREP
#undef SEAM
}

extern "C" void kernel_launch(void* const* d_in, const int* in_sizes, int n_in, void* d_out, int out_size, void* d_ws, size_t ws_size, hipStream_t stream) {
    static int grid = 0;
    if (grid == 0) {
        if (n_in != 25 || out_size != M * D || ws_size < WS_END) { fprintf(stderr, "kernel_launch: unexpected shapes (n_in %d, out %d, ws %zu < %zu)\n", n_in, out_size, ws_size, (size_t)WS_END); grid = -1; return; }
        int dev = 0, cus = 0, per_cu = 0;
        if (hipGetDevice(&dev) != hipSuccess || hipDeviceGetAttribute(&cus, hipDeviceAttributeMultiprocessorCount, dev) != hipSuccess) { grid = -1; return; }
        if (hipFuncSetAttribute((const void*)mk_fwd, hipFuncAttributeMaxDynamicSharedMemorySize, LDS_BYTES) != hipSuccess) { fprintf(stderr, "kernel_launch: hipFuncSetAttribute failed\n"); grid = -1; return; }
        if (hipOccupancyMaxActiveBlocksPerMultiprocessor(&per_cu, (const void*)mk_fwd, 512, LDS_BYTES) != hipSuccess || per_cu < 1) fprintf(stderr, "kernel_launch: occupancy query says %d\n", per_cu);
        (void)hipGetLastError();
        grid = cus;
    }
    if (grid < 0) return;
    (void)hipMemsetAsync((char*)d_ws + WS_CTL, 0, CTL_ZERO_BYTES, stream);
    KP a{};
    for (int i = 0; i < 25; ++i) a.in[i] = (const float*)d_in[i];
    a.out = (float*)d_out; a.ws = (unsigned char*)d_ws;
#if MK_LAUNCHES == 1
    a.gp_lo = 0; a.gp_hi = GP_END;
    hipLaunchKernelGGL(mk_fwd, dim3(grid), dim3(512), LDS_BYTES, stream, a);
#else
    for (int gp = 0; gp < GP_END; ++gp) { a.gp_lo = gp; a.gp_hi = gp + 1; hipLaunchKernelGGL(mk_fwd, dim3(grid), dim3(512), LDS_BYTES, stream, a); }
#endif
}
```

```cpp
#include <hip/hip_runtime.h>
#include <cstdio>
#include <cstdint>

#define DBG_HASHSEL 0
#define DBG_H2_FROM_INPUT 0
#define DBG_NO_YA 0
#define DBG_NO_YB 0
#define DBG_NO_ACC 0
#define DBG_NO_GB 0
#define DBG_S5_NOSSM 0
#define DBG_S5_NOREC 0
#define DBG_SELFCHECK 0
#ifndef MK_LAUNCHES
#define MK_LAUNCHES 1
#endif

#define LAS __attribute__((address_space(3)))
typedef unsigned short bf16_t;
typedef short bf16x8 __attribute__((ext_vector_type(8)));
typedef float f32x2 __attribute__((ext_vector_type(2)));
typedef float f32x4 __attribute__((ext_vector_type(4)));
typedef float f32x16 __attribute__((ext_vector_type(16)));
typedef unsigned u32x2 __attribute__((ext_vector_type(2)));
typedef unsigned u32x4 __attribute__((ext_vector_type(4)));
typedef __bf16 bf16v2 __attribute__((ext_vector_type(2)));
typedef int i32x8 __attribute__((ext_vector_type(8)));
typedef int i32x4 __attribute__((ext_vector_type(4)));

constexpr int D = 1024, BATCH = 32, SEQ = 2048, DEPTH = 4, M = BATCH * SEQ;
constexpr int INC = 7168, NMODC = 6 * D;
constexpr int NPH = 11, GP_SETUP = 0, GP_FINAL = 1 + DEPTH * NPH, GP_END = GP_FINAL + 1;
constexpr float EPS = 1e-6f;
constexpr float U_SCALE = 64.0f, V_SCALE = 4.0f;
constexpr float WIN_SCALE = 64.0f, HIN_SCALE = 4.0f;
constexpr float WO_SCALE = 64.0f, MG_SCALE = 8.0f;

constexpr size_t MiB = 1u << 20;
constexpr size_t WS_CTL = 0, CTL_ZERO_BYTES = 1 * MiB;
constexpr size_t WS_MOD = 1 * MiB;
constexpr size_t WS_LB = 4 * MiB;
constexpr size_t WS_ABAR = 4 * MiB + 65536;
constexpr size_t WS_BOP = 5 * MiB;
constexpr size_t WS_COP = 6 * MiB;
constexpr size_t WS_WIN = 8 * MiB;
constexpr size_t WS_WGLU = 22 * MiB;
constexpr size_t WS_WOUT = 24 * MiB;
constexpr size_t WS_WQ = 26 * MiB;
constexpr size_t WS_KEYS = 30 * MiB;
constexpr size_t WS_U = 32 * MiB;
constexpr size_t WS_V = 64 * MiB;
constexpr size_t WS_H = 96 * MiB;
constexpr size_t WS_OR = 224 * MiB;
constexpr size_t WS_SSQ = 352 * MiB;
constexpr size_t WS_R0 = 354 * MiB;
constexpr size_t WS_SEL = WS_R0 + 256 * MiB;
constexpr size_t WS_YS = WS_R0 + 512 * MiB;
constexpr size_t WS_END = WS_YS + 128 * MiB;

constexpr int LDS_BYTES = 147456;
constexpr int MISC_OFF = LDS_BYTES - 256;

__device__ __forceinline__ unsigned pk2(float lo, float hi) { f32x2 v = {lo, hi}; bf16v2 r = __builtin_convertvector(v, bf16v2); return __builtin_bit_cast(unsigned, r); }
__device__ __forceinline__ float bflo(unsigned w) { return __uint_as_float(w << 16); }
__device__ __forceinline__ float bfhi(unsigned w) { return __uint_as_float(w & 0xffff0000u); }
__device__ __forceinline__ float fsigmoid(float x) { return __builtin_amdgcn_rcpf(1.0f + __expf(-x)); }
__device__ __forceinline__ float fsilu(float x) { return x * fsigmoid(x); }
__device__ __forceinline__ float fgelu(float x) { return x * fsigmoid(1.5957691216f * (x + 0.044715f * x * x * x)); }
__device__ __forceinline__ float wave_sum(float v) {
#pragma unroll
    for (int o = 1; o < 64; o <<= 1) v += __shfl_xor(v, o);
    return v;
}
#define LDS_WAIT() asm volatile("s_waitcnt lgkmcnt(0)" ::: "memory")
__device__ __forceinline__ int opaque_tid() { int t = threadIdx.x; asm volatile("" : "+v"(t)); return t; }

namespace pg8 {
#define PG8_LAS __attribute__((address_space(3)))
constexpr int BM = 256, BK = 64, HALF = 128, HTB = HALF * BK * 2, STAGE_BYTES = 8 * HTB, NXCD = 8, WGM = 8;
__host__ __device__ __forceinline__ int lds_byte(int r, int c) { const int st = (r >> 4) * 2 + (c >> 5), rr = r & 15, cc = c & 31, ob = rr * 64 + cc * 2; return st * 1024 + (ob ^ (((ob >> 9) & 1) << 5)); }
__host__ __device__ __forceinline__ void stage_rc(int b, int& R, int& C) { const int st = b / 1024, sb = b % 1024, swz = sb ^ (((sb >> 9) & 1) << 5); R = (st >> 1) * 16 + swz / 64; C = (st & 1) * 32 + (swz % 64) / 2; }
__host__ __device__ __forceinline__ int perm32(int rho) { const int n = rho >> 4, i = rho & 15; return 8 * (i >> 2) + 4 * n + (i & 3); }
struct Unit { int pm, pn; };
struct Gemm { const bf16_t* A; const bf16_t* Bt; int M, N, K, lda, ldb; };
struct StaticOrder {
    int nM, nN, nwg, G, c;
    __host__ __device__ void init(int M_, int N_, int G_, int c_) { nM = M_ / BM; nN = N_ / BM; nwg = nM * nN; G = G_; c = c_; }
    __host__ __device__ bool next(int i, Unit& u) const {
        const long L = (long)i * G + c; if (L >= nwg) return false;
        int wgid = (int)L; { const int q = nwg / NXCD, r = nwg % NXCD, xcd = wgid % NXCD, off = wgid / NXCD; wgid = (xcd < r ? xcd * (q + 1) : r * (q + 1) + (xcd - r) * q) + off; }
        const int nig = WGM * nN, gid = wgid / nig, fm = gid * WGM, gsz = (nM - fm) < WGM ? (nM - fm) : WGM;
        u.pm = fm + ((wgid % nig) % gsz); u.pn = (wgid % nig) / gsz; return true;
    }
    __device__ __forceinline__ void a_ready(const Unit&) const {}
    __device__ __forceinline__ void done(const Unit&) const {}
};
template <class Epi, class Sched, bool ALIGN_EPI = false, bool SP2 = false, bool F8 = false>
__device__ __forceinline__ void gemm_phase(PG8_LAS unsigned char* lds, const Gemm g, const Sched& S, const Epi& E) {
    const int tid = opaque_tid(), wid = __builtin_amdgcn_readfirstlane(tid >> 6), lane = tid & 63, wr = wid >> 2, wc = wid & 3, fr = lane & 15, fq = lane >> 4;
    const int K = g.K, nt = K / BK;
    unsigned voffA[2], voffB[2];
#pragma unroll
    for (int i = 0; i < 2; ++i) { int R, C; stage_rc(tid * 16 + i * 8192, R, C); const int Rb = Epi::PERM ? ((R & ~31) + perm32(R & 31)) : R;
        voffA[i] = (unsigned)(R * g.lda + C) * 2u; voffB[i] = (unsigned)(Rb * g.ldb + C) * 2u; }
    const size_t kstep = (size_t)(BK * 2);
    const size_t hstepA = (size_t)HALF * g.lda * 2, hstepB = (size_t)HALF * g.ldb * 2;
    const size_t tstepA = 2 * hstepA, tstepB = 2 * hstepB;
    const unsigned ldsw = (unsigned)wid * 1024u;
    const int aoff = lds_byte(wr * 64 + fr, fq * 8), boff = lds_byte(wc * 32 + fr, fq * 8);
#define PG8_SA(b, h) (((b) * 2 + (h)) * HTB)
#define PG8_SB(b, h) ((4 + (b) * 2 + (h)) * HTB)
#define PG8_STAGE(bufoff, gbase, voff) do { _Pragma("unroll") for (int _i = 0; _i < 2; ++_i) \
        __builtin_amdgcn_global_load_lds((const unsigned*)((const char*)(gbase) + (voff)[_i]), (PG8_LAS unsigned*)(lds + (bufoff) + ldsw + _i * 8192), 16, 0, 0); } while (0)
#define PG8_LD8(p) __builtin_shufflevector(*(const PG8_LAS i32x4*)(p), *(const PG8_LAS i32x4*)((p) + 1024), 0, 1, 2, 3, 4, 5, 6, 7)
#define PG8_LDA(dst, b, h) do { if constexpr (F8) { _Pragma("unroll") for (int m = 0; m < 4; ++m) dst##8[m] = PG8_LD8(lds + PG8_SA(b, h) + aoff + m * 2048); } \
        else { _Pragma("unroll") for (int m = 0; m < 4; ++m) _Pragma("unroll") for (int k = 0; k < 2; ++k) dst[m][k] = *(const PG8_LAS bf16x8*)(lds + PG8_SA(b, h) + aoff + m * 2048 + k * 1024); } } while (0)
#define PG8_LDB(dst, b, h) do { if constexpr (F8) { _Pragma("unroll") for (int n = 0; n < 2; ++n) dst##8[n] = PG8_LD8(lds + PG8_SB(b, h) + boff + n * 2048); } \
        else { _Pragma("unroll") for (int n = 0; n < 2; ++n) _Pragma("unroll") for (int k = 0; k < 2; ++k) dst[n][k] = *(const PG8_LAS bf16x8*)(lds + PG8_SB(b, h) + boff + n * 2048 + k * 1024); } } while (0)
#define PG8_MMA(ai, bj, At, Bt) do { __builtin_amdgcn_s_setprio(1); _Pragma("unroll") for (int m = 0; m < 4; ++m) _Pragma("unroll") for (int n = 0; n < 2; ++n) { \
        if constexpr (F8) {   \
            acc[ai][bj][m][n] = __builtin_amdgcn_mfma_scale_f32_16x16x128_f8f6f4(Bt##8[n], At##8[m], acc[ai][bj][m][n], 0, 0, 0, 0x7f7f7f7f, 0, 0x7f7f7f7f); \
        } else { _Pragma("unroll") for (int k = 0; k < 2; ++k) acc[ai][bj][m][n] = __builtin_amdgcn_mfma_f32_16x16x32_bf16(Bt[n][k], At[m][k], acc[ai][bj][m][n], 0, 0, 0); } } \
        __builtin_amdgcn_s_setprio(0); } while (0)
#define PG8_WAIT_V(n) asm volatile("s_waitcnt vmcnt(" #n ")" ::: "memory")
#define PG8_WAIT_L(n) asm volatile("s_waitcnt lgkmcnt(" #n ")" ::: "memory")
#define PG8_BAR __builtin_amdgcn_s_barrier()
#define PG8_SCHED __builtin_amdgcn_sched_barrier(0)
    Unit cur, nxt; int ui = 0;
    if (!S.next(0, cur)) return;
    f32x4 acc[2][2][4][2];
#pragma unroll
    for (int a = 0; a < 2; ++a)
#pragma unroll
        for (int b = 0; b < 2; ++b)
#pragma unroll
            for (int m = 0; m < 4; ++m)
#pragma unroll
                for (int n = 0; n < 2; ++n) acc[a][b][m][n] = (f32x4){0.f, 0.f, 0.f, 0.f};
    bf16x8 At[4][2], B0[2][2], B1[2][2]; i32x8 At8[4], B08[2], B18[2];
    const char* cA = (const char*)g.A + (size_t)cur.pm * tstepA; const char* cB = (const char*)g.Bt + (size_t)cur.pn * tstepB;
    S.a_ready(cur);
    if constexpr (SP2) {
        PG8_STAGE(PG8_SB(0, 0), cB, voffB); PG8_STAGE(PG8_SB(0, 1), cB + hstepB, voffB); PG8_STAGE(PG8_SA(0, 0), cA, voffA); PG8_STAGE(PG8_SA(0, 1), cA + hstepA, voffA);
        if (wr == 1) PG8_BAR;
        PG8_WAIT_V(2); PG8_BAR;
        PG8_STAGE(PG8_SB(1, 0), cB + kstep, voffB); PG8_STAGE(PG8_SA(1, 0), cA + kstep, voffA); PG8_STAGE(PG8_SB(1, 1), cB + hstepB + kstep, voffB);
        PG8_WAIT_V(6); PG8_BAR;
    } else {
        PG8_STAGE(PG8_SB(0, 0), cB, voffB); PG8_STAGE(PG8_SA(0, 0), cA, voffA); PG8_STAGE(PG8_SB(0, 1), cB + hstepB, voffB); PG8_STAGE(PG8_SA(0, 1), cA + hstepA, voffA);
        if (wr == 1) PG8_BAR;
        PG8_WAIT_V(4); PG8_BAR;
        PG8_STAGE(PG8_SB(1, 0), cB + kstep, voffB); PG8_STAGE(PG8_SA(1, 0), cA + kstep, voffA); PG8_STAGE(PG8_SB(1, 1), cB + hstepB + kstep, voffB);
        PG8_WAIT_V(6); PG8_BAR;
    }
    for (;;) {
        const bool has_next = S.next(ui + 1, nxt);
        const char* nA = has_next ? (const char*)g.A + (size_t)nxt.pm * tstepA : cA; const char* nB = has_next ? (const char*)g.Bt + (size_t)nxt.pn * tstepB : cB;
        for (int t = 0; t < nt; t += 2) {
            const bool last = (t == nt - 2);
            const char* a1 = cA + (size_t)(t + 1) * kstep;
            const char* a2 = last ? nA : cA + (size_t)(t + 2) * kstep; const char* b2 = last ? nB : cB + (size_t)(t + 2) * kstep;
            const char* a3 = a2 + kstep; const char* b3 = b2 + kstep;
            if (last && has_next) S.a_ready(nxt);
            if constexpr (SP2) {
            PG8_LDB(B0, 0, 0); PG8_LDB(B1, 0, 1); PG8_SCHED; PG8_LDA(At, 0, 0); PG8_STAGE(PG8_SA(1, 1), a1 + hstepA, voffA);
            PG8_WAIT_V(8); PG8_WAIT_L(0); PG8_BAR; PG8_MMA(0, 0, At, B0); PG8_MMA(0, 1, At, B1); PG8_BAR; PG8_SCHED;
            PG8_LDA(At, 0, 1); PG8_STAGE(PG8_SB(0, 0), b2, voffB); PG8_STAGE(PG8_SB(0, 1), b2 + hstepB, voffB); PG8_STAGE(PG8_SA(0, 0), a2, voffA);
            PG8_WAIT_V(8); PG8_WAIT_L(0); PG8_BAR; PG8_MMA(1, 0, At, B0); PG8_MMA(1, 1, At, B1); PG8_BAR; PG8_SCHED;
            PG8_LDB(B0, 1, 0); PG8_LDB(B1, 1, 1); PG8_SCHED; PG8_LDA(At, 1, 0); PG8_STAGE(PG8_SA(0, 1), a2 + hstepA, voffA);
            PG8_WAIT_V(8); PG8_WAIT_L(0); PG8_BAR; PG8_MMA(0, 0, At, B0); PG8_MMA(0, 1, At, B1); PG8_BAR; PG8_SCHED;
            PG8_LDA(At, 1, 1); PG8_STAGE(PG8_SB(1, 0), b3, voffB); PG8_STAGE(PG8_SB(1, 1), b3 + hstepB, voffB); PG8_STAGE(PG8_SA(1, 0), a3, voffA);
            PG8_WAIT_V(8); PG8_WAIT_L(0); PG8_BAR; PG8_MMA(1, 0, At, B0); PG8_MMA(1, 1, At, B1); PG8_BAR; PG8_SCHED;
            } else {
            PG8_LDB(B0, 0, 0); PG8_SCHED; PG8_LDA(At, 0, 0); PG8_STAGE(PG8_SA(1, 1), a1 + hstepA, voffA);
            PG8_WAIT_L(8); PG8_BAR; PG8_WAIT_L(0); PG8_MMA(0, 0, At, B0); PG8_BAR; PG8_SCHED;
            PG8_LDB(B1, 0, 1); PG8_STAGE(PG8_SB(0, 0), b2, voffB);
            PG8_BAR; PG8_WAIT_L(0); PG8_MMA(0, 1, At, B1); PG8_BAR;
            PG8_LDA(At, 0, 1); PG8_STAGE(PG8_SA(0, 0), a2, voffA);
            PG8_BAR; PG8_WAIT_L(0); PG8_MMA(1, 0, At, B0); PG8_BAR; PG8_SCHED;
            PG8_STAGE(PG8_SB(0, 1), b2 + hstepB, voffB);
            PG8_WAIT_V(6); PG8_BAR; PG8_MMA(1, 1, At, B1); PG8_BAR;
            PG8_LDB(B0, 1, 0); PG8_SCHED; PG8_LDA(At, 1, 0); PG8_STAGE(PG8_SA(0, 1), a2 + hstepA, voffA);
            PG8_WAIT_L(8); PG8_BAR; PG8_WAIT_L(0); PG8_MMA(0, 0, At, B0); PG8_BAR; PG8_SCHED;
            PG8_LDB(B1, 1, 1); PG8_STAGE(PG8_SB(1, 0), b3, voffB);
            PG8_BAR; PG8_WAIT_L(0); PG8_MMA(0, 1, At, B1); PG8_BAR;
            PG8_LDA(At, 1, 1); PG8_STAGE(PG8_SA(1, 0), a3, voffA);
            PG8_BAR; PG8_WAIT_L(0); PG8_MMA(1, 0, At, B0); PG8_BAR; PG8_SCHED;
            PG8_STAGE(PG8_SB(1, 1), b3 + hstepB, voffB);
            PG8_WAIT_V(6); PG8_BAR; PG8_MMA(1, 1, At, B1); PG8_BAR;
            }
        }
        if constexpr (ALIGN_EPI) { if (wr == 0) PG8_BAR; }
        E(acc, cur, wr, wc, fr, fq);
        if (!has_next) break;
#pragma unroll
        for (int a = 0; a < 2; ++a)
#pragma unroll
            for (int b = 0; b < 2; ++b)
#pragma unroll
                for (int m = 0; m < 4; ++m)
#pragma unroll
                    for (int n = 0; n < 2; ++n) acc[a][b][m][n] = (f32x4){0.f, 0.f, 0.f, 0.f};
        cur = nxt; cA = nA; cB = nB; ++ui;
        if constexpr (ALIGN_EPI) { if (wr == 1) PG8_BAR; }
    }
    PG8_WAIT_V(0);
    if constexpr (!ALIGN_EPI) { if (wr == 0) PG8_BAR; }
    PG8_BAR;
#undef PG8_SA
#undef PG8_SB
#undef PG8_STAGE
#undef PG8_LDA
#undef PG8_LD8
#undef PG8_LDB
#undef PG8_MMA
#undef PG8_WAIT_V
#undef PG8_WAIT_L
#undef PG8_BAR
#undef PG8_SCHED
}

struct EpiStoreBf16 {
    static constexpr bool PERM = true;
    bf16_t* O; int ldc; float scale;
    __device__ __forceinline__ void operator()(const f32x4 (&acc)[2][2][4][2], const Unit& u, int wr, int wc, int fr, int fq) const {
        const int row0 = u.pm * BM + wr * 64 + fr, col0 = u.pn * BM + wc * 32 + 8 * fq;
#pragma unroll
        for (int ai = 0; ai < 2; ++ai)
#pragma unroll
            for (int m = 0; m < 4; ++m) { bf16_t* rowp = O + (size_t)(row0 + ai * HALF + m * 16) * ldc + col0;
#pragma unroll
                for (int bj = 0; bj < 2; ++bj) { const f32x4 v0 = acc[ai][bj][m][0] * scale, v1 = acc[ai][bj][m][1] * scale;
                    u32x4 w; w.x = pk2(v0[0], v0[1]); w.y = pk2(v0[2], v0[3]); w.z = pk2(v1[0], v1[1]); w.w = pk2(v1[2], v1[3]);
                    *(u32x4*)(rowp + bj * HALF) = w; } }
    }
};
struct EpiStoreQ {
    static constexpr bool PERM = true;
    bf16_t* O;
    __device__ __forceinline__ void operator()(const f32x4 (&acc)[2][2][4][2], const Unit& u, int wr, int wc, int fr, int fq) const {
        const int row0 = u.pm * BM + wr * 64 + fr, col0 = u.pn * BM + wc * 32 + 8 * fq;
#pragma unroll
        for (int ai = 0; ai < 2; ++ai)
#pragma unroll
            for (int m = 0; m < 4; ++m) { const int row = row0 + ai * HALF + m * 16, tg = row >> 5, t = row & 31;
#pragma unroll
                for (int bj = 0; bj < 2; ++bj) { const int c0 = col0 + bj * HALF, h = c0 >> 8, pp = (c0 >> 7) & 1, cc = c0 & 127, ks = cc >> 4, hh = (cc >> 3) & 1;
                    const f32x4 v0 = acc[ai][bj][m][0], v1 = acc[ai][bj][m][1];
                    u32x4 w; w.x = pk2(v0[0], v0[1]); w.y = pk2(v0[2], v0[3]); w.z = pk2(v1[0], v1[1]); w.w = pk2(v1[2], v1[3]);
                    *(u32x4*)(O + ((size_t)((((tg * 8 + h) * 2 + pp) * 8 + ks) * 64 + hh * 32 + t)) * 8) = w; } }
    }
};
struct EpiWout {
    static constexpr bool PERM = false;
    const float* xs; float* out; const float* g1;
    __device__ __forceinline__ void operator()(const f32x4 (&acc)[2][2][4][2], const Unit& u, int wr, int wc, int fr, int fq) const {
        const int row0 = u.pm * BM + wr * 64 + fr, col0 = u.pn * BM + wc * 32 + 4 * fq;
        const int b = (u.pm * BM) >> 11;
        f32x4 gv[2][2];
#pragma unroll
        for (int bj = 0; bj < 2; ++bj)
#pragma unroll
            for (int n = 0; n < 2; ++n) gv[bj][n] = *(const f32x4*)(g1 + (size_t)b * NMODC + col0 + bj * HALF + n * 16);
#pragma unroll
        for (int ai = 0; ai < 2; ++ai)
#pragma unroll
            for (int m = 0; m < 4; ++m) { const size_t off = (size_t)(row0 + ai * HALF + m * 16) * D + col0;
#pragma unroll
                for (int bj = 0; bj < 2; ++bj)
#pragma unroll
                    for (int n = 0; n < 2; ++n) { const f32x4 xv = *(const f32x4*)(xs + off + bj * HALF + n * 16);
                        *(f32x4*)(out + off + bj * HALF + n * 16) = xv + gv[bj][n] * acc[ai][bj][m][n]; } }
    }
};
struct EpiGlu {
    static constexpr bool PERM = true;
    const bf16_t* PB; const bf16_t* YS; const bf16_t* ORAW; const float* SSQ; const float* ng; const float* gb_; bf16_t* O;
    __device__ __forceinline__ void operator()(const f32x4 (&acc)[2][2][4][2], const Unit& u, int wr, int wc, int fr, int fq) const {
        const int row0 = u.pm * BM + wr * 64 + fr, col0 = u.pn * BM + wc * 32 + 8 * fq;
#pragma unroll
        for (int bj = 0; bj < 2; ++bj) {
            const int c = col0 + bj * HALF, head = c >> 7;
            const f32x4 n0 = *(const f32x4*)(ng + (c & 127)), n1 = *(const f32x4*)(ng + (c & 127) + 4);
            const f32x4 b0 = *(const f32x4*)(gb_ + c), b1 = *(const f32x4*)(gb_ + c + 4);
            const float ngv[8] = {n0[0], n0[1], n0[2], n0[3], n1[0], n1[1], n1[2], n1[3]};
            const float bbv[8] = {b0[0], b0[1], b0[2], b0[3], b1[0], b1[1], b1[2], b1[3]};
#pragma unroll
            for (int ai = 0; ai < 2; ++ai)
#pragma unroll
                for (int m = 0; m < 4; ++m) {
                    const int row = row0 + ai * HALF + m * 16;
                    const bf16_t* pb = PB + (size_t)row * 4096 + c;
                    const u32x4 og = *(const u32x4*)(pb), ys = *(const u32x4*)(YS + (size_t)row * D + c), ga = *(const u32x4*)(pb + 2048), gb = *(const u32x4*)(pb + 3072);
                    const u32x4 orw = *(const u32x4*)(ORAW + (size_t)row * D + c);
                    const float rstd = __builtin_amdgcn_rsqf(SSQ[(size_t)row * 8 + head] * (1.0f / 128.0f) + EPS);
                    const f32x4 a0 = acc[ai][bj][m][0], a1 = acc[ai][bj][m][1];
                    const float av[8] = {a0[0], a0[1], a0[2], a0[3], a1[0], a1[1], a1[2], a1[3]};
                    float res[8];
#pragma unroll
                    for (int j = 0; j < 8; ++j) {
                        const unsigned wog = og[j >> 1], wys = ys[j >> 1], wga = ga[j >> 1], wgb = gb[j >> 1], wor = orw[j >> 1];
                        const float fog = (j & 1) ? bfhi(wog) : bflo(wog), fys = (j & 1) ? bfhi(wys) : bflo(wys), fga = (j & 1) ? bfhi(wga) : bflo(wga),
                                    fgb = (j & 1) ? bfhi(wgb) : bflo(wgb), fo = (j & 1) ? bfhi(wor) : bflo(wor);
                        const float ya = fo * rstd * ngv[j] * fsilu(fog);
                        const float yb = fys * fsigmoid((DBG_NO_ACC ? 0.f : av[j]) + bbv[j]);
                        res[j] = (DBG_NO_YA ? 0.f : fsigmoid(fga) * ya) + (DBG_NO_YB ? 0.f : (DBG_NO_GB ? 0.5f : fsigmoid(fgb)) * yb);
                    }
                    int w0 = 0, w1 = 0;
                    w0 = __builtin_amdgcn_cvt_pk_fp8_f32(res[0] * MG_SCALE, res[1] * MG_SCALE, w0, false); w0 = __builtin_amdgcn_cvt_pk_fp8_f32(res[2] * MG_SCALE, res[3] * MG_SCALE, w0, true);
                    w1 = __builtin_amdgcn_cvt_pk_fp8_f32(res[4] * MG_SCALE, res[5] * MG_SCALE, w1, false); w1 = __builtin_amdgcn_cvt_pk_fp8_f32(res[6] * MG_SCALE, res[7] * MG_SCALE, w1, true);
                    *(u32x2*)((unsigned char*)O + (size_t)row * D + c) = (u32x2){(unsigned)w0, (unsigned)w1};
                }
        }
    }
};
}

#define XB_TMO      128
#define XB_XCNT(j)  (256  + 64 * (j))
#define XB_XSUB(j)  (1280 + 64 * (j))
#define XB_XGEN(j)  (2304 + 64 * (j))
#define XB_TOP      3328
#define XB_TOPGEN   3392
#define XCD_BAR_WORDS 3456
#define XB_SPIN_CAP (1u << 25)
__device__ __forceinline__ unsigned xb_ld(unsigned* p)              { return __hip_atomic_load(p, __ATOMIC_RELAXED, __HIP_MEMORY_SCOPE_AGENT); }
__device__ __forceinline__ unsigned xb_add(unsigned* p, unsigned v) { return __hip_atomic_fetch_add(p, v, __ATOMIC_RELAXED, __HIP_MEMORY_SCOPE_AGENT); }
__device__ __forceinline__ unsigned xb_xcc_id() { return (unsigned)__builtin_amdgcn_s_getreg((3 << 11) | 20) & 0xFu; }
#define XB_SPIN(cond, bar) do { unsigned _sp = 0; while (cond) { __builtin_amdgcn_s_sleep(1); \
    if ((++_sp & 255u) == 0u) { if (xb_ld(&(bar)[XB_TMO])) break; if (_sp > XB_SPIN_CAP) { atomicAdd(&(bar)[XB_TMO], 1u); break; } } } } while (0)
struct XcdBarrier { unsigned* bar; unsigned x; volatile LAS unsigned* st; };
__device__ __forceinline__ XcdBarrier xcd_barrier_post(unsigned* bar, volatile LAS unsigned* st) {
    XcdBarrier b; b.bar = bar; b.x = xb_xcc_id(); b.st = st;
    if (threadIdx.x == 0) (void)xb_add(&bar[XB_XCNT(b.x)], 1u);
    return b;
}
__device__ __forceinline__ void xcd_barrier_complete(unsigned* bar, unsigned x, unsigned& nloc, unsigned& nx) {
    const unsigned G = gridDim.x * gridDim.y * gridDim.z;
    unsigned sum, cnt, mine, sp = 0u;
    for (;;) {
        sum = 0u; cnt = 0u; mine = 0u;
#pragma unroll
        for (unsigned j = 0; j < 16; ++j) { const unsigned c = xb_ld(&bar[XB_XCNT(j)]); sum += c; cnt += (c > 0u) ? 1u : 0u; mine = (j == x) ? c : mine; }
        if (sum == G) break;
        __builtin_amdgcn_s_sleep(1);
        if ((++sp & 255u) == 0u) { if (xb_ld(&bar[XB_TMO])) break; if (sp > XB_SPIN_CAP) { atomicAdd(&bar[XB_TMO], 1u); break; } }
    }
    nloc = mine > 0u ? mine : 1u; nx = cnt > 0u ? cnt : 1u;
}
__device__ __forceinline__ void xcd_barrier(const XcdBarrier& b) {
    asm volatile("s_waitcnt vmcnt(0)" ::: "memory");
    __syncthreads();
    if (threadIdx.x == 0) {
        unsigned* bar = b.bar;
        __builtin_amdgcn_s_waitcnt(0);
        unsigned nloc = b.st[0], nx = b.st[1];
        if (nloc == 0u) { xcd_barrier_complete(bar, b.x, nloc, nx); b.st[0] = nloc; b.st[1] = nx; }
        const unsigned old = xb_add(&bar[XB_XSUB(b.x)], 1u);
        const unsigned gen = old / nloc;
        if (old + 1u == (gen + 1u) * nloc) {
            __builtin_amdgcn_fence(__ATOMIC_RELEASE, "agent");
            asm volatile("s_waitcnt vmcnt(0)" ::: "memory");
            const unsigned og = xb_add(&bar[XB_TOP], 1u);
            const unsigned tg = og / nx;
            if (og + 1u == (tg + 1u) * nx) xb_add(&bar[XB_TOPGEN], 1u);
            else XB_SPIN(xb_ld(&bar[XB_TOPGEN]) == tg, bar);
            __builtin_amdgcn_fence(__ATOMIC_ACQUIRE, "agent");
            xb_add(&bar[XB_XGEN(b.x)], 1u);
            asm volatile("s_waitcnt vmcnt(0)" ::: "memory");
        } else {
            XB_SPIN(xb_ld(&bar[XB_XGEN(b.x)]) == gen, bar);
            __builtin_amdgcn_fence(__ATOMIC_ACQUIRE, "agent");
            asm volatile("s_waitcnt vmcnt(0)" ::: "memory");
        }
    }
    __syncthreads();
}

struct KP { const float* in[25]; float* out; unsigned char* ws; int gp_lo, gp_hi; };
enum { I_X = 0, I_C, I_ADAW, I_ADAB, I_N1G, I_N2G, I_WIN, I_LBL, I_HNG, I_ARE, I_AIM, I_LDT, I_BRE, I_BIM, I_CRE, I_CIM, I_S5D, I_GLUW, I_GLUB, I_WOUT, I_WQ, I_SUBK, I_PU, I_PV, I_FG };

typedef const KP __attribute__((address_space(4)))* kp_cptr;
__device__ __forceinline__ KP load_kp() {
#if defined(__HIP_DEVICE_COMPILE__)
    unsigned long long a = (unsigned long long)__builtin_amdgcn_kernarg_segment_ptr(); asm volatile("" : "+s"(a)); return *(kp_cptr)a;
#else
    return KP{};
#endif
}

__device__ __forceinline__ void phase_setup(const KP& p, LAS unsigned char* lds, int G) {
    const int tid = opaque_tid();
    {
        LAS float* cact = (LAS float*)lds;
        for (int it = blockIdx.x; it < 4 * 48; it += G) {
            for (int i = tid; i < 32 * 1024; i += 512) cact[i] = fsilu(p.in[I_C][i]);
            __syncthreads();
            const int l = it / 48, cb = it % 48, col = cb * 128 + (tid & 127), bg = tid >> 7;
            const float* W = p.in[I_ADAW] + (size_t)l * D * NMODC + col;
            float acc[8];
#pragma unroll
            for (int j = 0; j < 8; ++j) acc[j] = 0.f;
            for (int k4 = 0; k4 < 256; ++k4) {
                const float w0 = W[(size_t)(4 * k4 + 0) * NMODC], w1 = W[(size_t)(4 * k4 + 1) * NMODC], w2 = W[(size_t)(4 * k4 + 2) * NMODC], w3 = W[(size_t)(4 * k4 + 3) * NMODC];
#pragma unroll
                for (int j = 0; j < 8; ++j) { const f32x4 c4 = *(const LAS f32x4*)(cact + (8 * bg + j) * 1024 + 4 * k4); acc[j] += c4[0] * w0 + c4[1] * w1 + c4[2] * w2 + c4[3] * w3; }
            }
            float* MOD = (float*)(p.ws + WS_MOD);
            const float bias = p.in[I_ADAB][l * NMODC + col];
#pragma unroll
            for (int j = 0; j < 8; ++j) MOD[((size_t)l * 32 + 8 * bg + j) * NMODC + col] = acc[j] + bias;
            __syncthreads();
        }
    }
    const int gtid = blockIdx.x * 512 + tid;
    if (gtid < 1024) {
        const float* lg = p.in[I_LBL]; float v[4], mx = -1e30f;
#pragma unroll
        for (int l = 0; l < 4; ++l) { v[l] = lg[l * 1024 + gtid]; mx = fmaxf(mx, v[l]); }
        float s = 0.f;
#pragma unroll
        for (int l = 0; l < 4; ++l) { v[l] = __expf(v[l] - mx); s += v[l]; }
        float* LB = (float*)(p.ws + WS_LB); float cum = 0.f; const float first = v[0] / s;
#pragma unroll
        for (int l = 0; l < 4; ++l) { cum += v[l] / s; LB[l * 1024 + gtid] = (l == 0) ? 0.f : (cum - first); }
    }
    if (gtid >= 1024 && gtid < 1024 + 16384) {
        const int id = gtid - 1024, lg = id >> 6, pp = id & 63;
        const float a_re = p.in[I_ARE][id], a_im = p.in[I_AIM][id];
        const float step = expf(p.in[I_LDT][lg]);
        const float mag = expf(step * a_re), ang = step * a_im;
        const float ab_re = mag * cosf(ang), ab_im = mag * sinf(ang);
        const float den = a_re * a_re + a_im * a_im;
        const float z_re = ((ab_re - 1.0f) * a_re + ab_im * a_im) / den;
        const float z_im = (ab_im * a_re - (ab_re - 1.0f) * a_im) / den;
        float* ABAR = (float*)(p.ws + WS_ABAR); ABAR[2 * id] = ab_re; ABAR[2 * id + 1] = ab_im;
        bf16_t* BOP = (bf16_t*)(p.ws + WS_BOP); bf16_t* COP = (bf16_t*)(p.ws + WS_COP);
        const float* bre = p.in[I_BRE] + (size_t)id * 16; const float* bim = p.in[I_BIM] + (size_t)id * 16;
#pragma unroll
        for (int c = 0; c < 16; ++c) {
            const float br = bre[c], bi = bim[c];
            const float rr = z_re * br - z_im * bi, ii = z_re * bi + z_im * br;
            BOP[((size_t)lg * 128 + 2 * pp) * 16 + c] = (bf16_t)(pk2(rr, 0.f) & 0xffffu);
            BOP[((size_t)lg * 128 + 2 * pp + 1) * 16 + c] = (bf16_t)(pk2(ii, 0.f) & 0xffffu);
            const float cr = p.in[I_CRE][((size_t)lg * 16 + c) * 64 + pp], ci = p.in[I_CIM][((size_t)lg * 16 + c) * 64 + pp];
            COP[((size_t)lg * 16 + c) * 128 + 2 * pp] = (bf16_t)(pk2(cr, 0.f) & 0xffffu);
            COP[((size_t)lg * 16 + c) * 128 + 2 * pp + 1] = (bf16_t)(pk2(-ci, 0.f) & 0xffffu);
        }
    }
}

__device__ __forceinline__ void transpose_item(const float* W, int K, int N, bf16_t* WT, LAS float* scr, int item, int lane) {
    const int nblk = N / 32, kb = item / nblk, nb = item % nblk, k0 = 64 * kb, n0 = 32 * nb;
#pragma unroll 8
    for (int i = 0; i < 32; ++i) { const int kk = 2 * i + (lane >> 5); scr[kk * 33 + (lane & 31)] = W[(size_t)(k0 + kk) * N + n0 + (lane & 31)]; }
    LDS_WAIT();
    const int c = lane & 7;
#pragma unroll
    for (int j = 0; j < 4; ++j) { const int n = (lane >> 3) + 8 * j; const LAS float* s = scr + (8 * c) * 33 + n;
        u32x4 o; o.x = pk2(s[0 * 33], s[1 * 33]); o.y = pk2(s[2 * 33], s[3 * 33]); o.z = pk2(s[4 * 33], s[5 * 33]); o.w = pk2(s[6 * 33], s[7 * 33]);
        *(u32x4*)(WT + (size_t)(n0 + n) * K + k0 + 8 * c) = o; }
    LDS_WAIT();
}
__device__ __forceinline__ void cvt_f32_fp8(const float* src, unsigned char* dst, size_t n4, size_t gtid, size_t nthr, float scale) {
    for (size_t i = gtid; i < n4; i += nthr) { const f32x4 v = ((const f32x4*)src)[i] * scale; int w = 0;
        w = __builtin_amdgcn_cvt_pk_fp8_f32(v[0], v[1], w, false); w = __builtin_amdgcn_cvt_pk_fp8_f32(v[2], v[3], w, true); ((unsigned*)dst)[i] = (unsigned)w; }
}
__device__ __forceinline__ void cvt_f32_fp8_sliced(const float* src, unsigned char* dst, size_t gtid, size_t nthr, float scale) {
    for (size_t i = gtid; i < (size_t)16384 * 64; i += nthr) {
        const size_t e = i >> 6; const int sl = (int)(i & 63) >> 3, c = (int)(i & 7);
        const f32x4* sp = (const f32x4*)(src + e * 1024 + sl * 128 + c * 16); u32x4 o;
#pragma unroll
        for (int q = 0; q < 4; ++q) { const f32x4 v = sp[q] * scale; int w = 0; w = __builtin_amdgcn_cvt_pk_fp8_f32(v[0], v[1], w, false); w = __builtin_amdgcn_cvt_pk_fp8_f32(v[2], v[3], w, true); o[q] = (unsigned)w; }
        *(u32x4*)(dst + ((size_t)sl * 16384 + e) * 128 + c * 16) = o;
    }
}
__device__ __forceinline__ void transpose_item_fp8(const float* W, int K, int N, unsigned char* WT, LAS float* scr, int item, int lane, float scale) {
    const int nblk = N / 32, kb = item / nblk, nb = item % nblk, k0 = 64 * kb, n0 = 32 * nb;
#pragma unroll 8
    for (int i = 0; i < 32; ++i) { const int kk = 2 * i + (lane >> 5); scr[kk * 33 + (lane & 31)] = W[(size_t)(k0 + kk) * N + n0 + (lane & 31)]; }
    LDS_WAIT();
    const int c = lane & 7;
#pragma unroll
    for (int j = 0; j < 4; ++j) { const int n = (lane >> 3) + 8 * j; const LAS float* sp = scr + (8 * c) * 33 + n;
        int w0 = 0, w1 = 0;
        w0 = __builtin_amdgcn_cvt_pk_fp8_f32(sp[0 * 33] * scale, sp[1 * 33] * scale, w0, false); w0 = __builtin_amdgcn_cvt_pk_fp8_f32(sp[2 * 33] * scale, sp[3 * 33] * scale, w0, true);
        w1 = __builtin_amdgcn_cvt_pk_fp8_f32(sp[4 * 33] * scale, sp[5 * 33] * scale, w1, false); w1 = __builtin_amdgcn_cvt_pk_fp8_f32(sp[6 * 33] * scale, sp[7 * 33] * scale, w1, true);
        *(u32x2*)(WT + (size_t)(n0 + n) * K + k0 + 8 * c) = (u32x2){(unsigned)w0, (unsigned)w1}; }
    LDS_WAIT();
}
__device__ __forceinline__ void cvt_f32_bf16(const float* src, bf16_t* dst, size_t n4, size_t gtid, size_t nthr) {
    for (size_t i = gtid; i < n4; i += nthr) { const f32x4 v = ((const f32x4*)src)[i]; u32x2 o; o.x = pk2(v[0], v[1]); o.y = pk2(v[2], v[3]); ((u32x2*)dst)[i] = o; }
}
template <bool F8OUT>
__device__ __forceinline__ void norm_rows(const float* xsrc, bf16_t* hdst, const float* gain, const float* mod_l, int sh_off, int sc_off, int gw, int ngw, int lane) {
    for (int r0 = gw * 4; r0 < M; r0 += ngw * 4) {
        const int b = r0 >> 11;
        f32x4 v[4][4]; float ss[4];
#pragma unroll
        for (int i = 0; i < 4; ++i) { const f32x4* xr = (const f32x4*)(xsrc + (size_t)(r0 + i) * D) + lane;
#pragma unroll
            for (int j = 0; j < 4; ++j) v[i][j] = xr[64 * j]; }
#pragma unroll
        for (int i = 0; i < 4; ++i) { float t = 0.f;
#pragma unroll
            for (int j = 0; j < 4; ++j) t += (v[i][j][0] * v[i][j][0] + v[i][j][1] * v[i][j][1]) + (v[i][j][2] * v[i][j][2] + v[i][j][3] * v[i][j][3]);
            ss[i] = t; }
#pragma unroll
        for (int o = 1; o < 64; o <<= 1) {
#pragma unroll
            for (int i = 0; i < 4; ++i) ss[i] += __shfl_xor(ss[i], o); }
        const float* mb = mod_l + (size_t)b * NMODC;
#pragma unroll
        for (int j = 0; j < 4; ++j) { const int col = 256 * j + 4 * lane;
            const f32x4 g4 = *(const f32x4*)(gain + col), sc = *(const f32x4*)(mb + sc_off + col), sh = *(const f32x4*)(mb + sh_off + col);
            const f32x4 gs = g4 * (sc + 1.0f);
#pragma unroll
            for (int i = 0; i < 4; ++i) { const float rstd = __builtin_amdgcn_rsqf(ss[i] * (1.0f / D) + EPS);
                const f32x4 h = v[i][j] * rstd * gs + sh;
                if constexpr (F8OUT) { int w8 = 0; w8 = __builtin_amdgcn_cvt_pk_fp8_f32(h[0] * HIN_SCALE, h[1] * HIN_SCALE, w8, false); w8 = __builtin_amdgcn_cvt_pk_fp8_f32(h[2] * HIN_SCALE, h[3] * HIN_SCALE, w8, true);
                    *(unsigned*)((unsigned char*)hdst + (size_t)(r0 + i) * D + col) = (unsigned)w8; }
                else { u32x2 o; o.x = pk2(h[0], h[1]); o.y = pk2(h[2], h[3]); *(u32x2*)(hdst + (size_t)(r0 + i) * D + col) = o; } } }
    }
}
__device__ __forceinline__ void resid_norm_rows(const float* xsrc, float* xdst, const bf16_t* delta, bf16_t* hdst, const float* gain, const float* mod_l, int gw, int ngw, int lane) {
    for (int r0 = gw * 4; r0 < M; r0 += ngw * 4) {
        const int b = r0 >> 11; const float* mb = mod_l + (size_t)b * NMODC;
        f32x4 v[4][4]; u32x2 dl[4][4]; float ss[4];
#pragma unroll
        for (int i = 0; i < 4; ++i) { const f32x4* xr = (const f32x4*)(xsrc + (size_t)(r0 + i) * D) + lane; const u32x2* dp = (const u32x2*)(delta + (size_t)(r0 + i) * D) + lane;
#pragma unroll
            for (int j = 0; j < 4; ++j) { v[i][j] = xr[64 * j]; dl[i][j] = dp[64 * j]; } }
#pragma unroll
        for (int j = 0; j < 4; ++j) { const f32x4 g1 = *(const f32x4*)(mb + 2048 + 256 * j + 4 * lane);
#pragma unroll
            for (int i = 0; i < 4; ++i) { const f32x4 dv = {bflo(dl[i][j][0]), bfhi(dl[i][j][0]), bflo(dl[i][j][1]), bfhi(dl[i][j][1])}; v[i][j] = v[i][j] + g1 * dv;
                ((f32x4*)(xdst + (size_t)(r0 + i) * D) + lane)[64 * j] = v[i][j]; } }
#pragma unroll
        for (int i = 0; i < 4; ++i) { float t = 0.f;
#pragma unroll
            for (int j = 0; j < 4; ++j) t += (v[i][j][0] * v[i][j][0] + v[i][j][1] * v[i][j][1]) + (v[i][j][2] * v[i][j][2] + v[i][j][3] * v[i][j][3]);
            ss[i] = t; }
#pragma unroll
        for (int o = 1; o < 64; o <<= 1) {
#pragma unroll
            for (int i = 0; i < 4; ++i) ss[i] += __shfl_xor(ss[i], o); }
#pragma unroll
        for (int j = 0; j < 4; ++j) { const int col = 256 * j + 4 * lane;
            const f32x4 g4 = *(const f32x4*)(gain + col), sc = *(const f32x4*)(mb + 4096 + col), sh = *(const f32x4*)(mb + 3072 + col);
            const f32x4 gs = g4 * (sc + 1.0f);
#pragma unroll
            for (int i = 0; i < 4; ++i) { const float rstd = __builtin_amdgcn_rsqf(ss[i] * (1.0f / D) + EPS);
                const f32x4 h = v[i][j] * rstd * gs + sh; u32x2 o; o.x = pk2(h[0], h[1]); o.y = pk2(h[2], h[3]); *(u32x2*)(hdst + (size_t)(r0 + i) * D + col) = o; } }
    }
}
__device__ __forceinline__ void phase_conv_norm1(const KP& p, LAS unsigned char* lds, int l, int G) {
    const int tid = opaque_tid(), lane = tid & 63, wave = __builtin_amdgcn_readfirstlane(tid >> 6);
    const int gw = blockIdx.x * 8 + wave, ngw = G * 8;
    LAS float* scr = (LAS float*)(lds + wave * 8448);
    constexpr int I_IN = 16 * (INC / 32), I_G = 16 * 32, I_O = 16 * 32, I_Q = 16 * 64, NIT = I_IN + I_G + I_O + I_Q;
    for (int it = gw; it < NIT; it += ngw) {
        int r = it;
        if (r < I_IN) { transpose_item_fp8(p.in[I_WIN] + (size_t)l * D * INC, D, INC, p.ws + WS_WIN, scr, r, lane, WIN_SCALE); continue; } r -= I_IN;
        if (r < I_G) { transpose_item(p.in[I_GLUW] + (size_t)l * D * D, D, D, (bf16_t*)(p.ws + WS_WGLU), scr, r, lane); continue; } r -= I_G;
        if (r < I_O) { transpose_item_fp8(p.in[I_WOUT] + (size_t)l * D * D, D, D, p.ws + WS_WOUT, scr, r, lane, WO_SCALE); continue; } r -= I_O;
        transpose_item(p.in[I_WQ] + (size_t)l * D * 2048, D, 2048, (bf16_t*)(p.ws + WS_WQ), scr, r, lane);
    }
    const size_t gtid = (size_t)blockIdx.x * 512 + tid, nthr = (size_t)G * 512;
    cvt_f32_bf16(p.in[I_SUBK] + (size_t)l * 262144, (bf16_t*)(p.ws + WS_KEYS), 262144 / 4, gtid, nthr);
    cvt_f32_fp8_sliced(p.in[I_PU] + (size_t)l * 16384 * 1024, p.ws + WS_U, gtid, nthr, U_SCALE);
    cvt_f32_fp8_sliced(p.in[I_PV] + (size_t)l * 16384 * 1024, p.ws + WS_V, gtid, nthr, V_SCALE);
    const float* xsrc = (l == 0) ? p.in[I_X] : p.out;
    norm_rows<true>(xsrc, (bf16_t*)(p.ws + WS_H), p.in[I_N1G] + l * D, (const float*)(p.ws + WS_MOD) + (size_t)l * 32 * NMODC, 0, 1024, gw, ngw, lane);
}

__device__ __forceinline__ void phase_hgrn2(const KP& p, LAS unsigned char* lds, int l, int G) {
    const int tid = opaque_tid(), lane = tid & 63, w = __builtin_amdgcn_readfirstlane(tid >> 6), fr = lane & 15, g = lane >> 4;
    constexpr int QS = 272, TS = 72;
    constexpr int OFF_QT = 0, OFF_KH = 8704, OFF_KT = 17408, OFF_VT = 26624, OFF_EREF = 35840, OFF_ELR = 36352, OFF_SEG = 36864, PBUF = 40960;
    const bf16_t* PA = (const bf16_t*)(p.ws + WS_R0);
    bf16_t* ORAW = (bf16_t*)(p.ws + WS_OR);
    const float* LB = (const float*)(p.ws + WS_LB) + l * 1024;
    for (int unit = blockIdx.x; unit < 256; unit += G) {
        const int b = unit >> 3, h = unit & 7, k0 = 2 * lane;
        const float lb0 = LB[h * 128 + k0], lb1 = LB[h * 128 + k0 + 1];
        const float om0 = 1.0f - lb0, om1 = 1.0f - lb1;
        f32x4 S[8];
#pragma unroll
        for (int kt = 0; kt < 8; ++kt) S[kt] = (f32x4){0.f, 0.f, 0.f, 0.f};
        unsigned rq[4], rf[4], rv[4];
        {
            const bf16_t* base = PA + ((size_t)b * SEQ + 4 * w) * 3072 + h * 128 + k0;
#pragma unroll
            for (int i = 0; i < 4; ++i) { rq[i] = *(const unsigned*)(base + (size_t)i * 3072); rf[i] = *(const unsigned*)(base + (size_t)i * 3072 + 1024); rv[i] = *(const unsigned*)(base + (size_t)i * 3072 + 2048); }
        }
        for (int c = 0; c < 64; ++c) {
            LAS unsigned char* base = lds + (c & 1) * PBUF;
            float cs0[4], cs1[4], qv0[4], qv1[4], kv0[4], kv1[4];
            float run0 = 0.f, run1 = 0.f;
#pragma unroll
            for (int i = 0; i < 4; ++i) {
                const float fp0 = bflo(rf[i]), fp1 = bfhi(rf[i]);
                const float s0 = fsigmoid(fp0), s1 = fsigmoid(fp1);
                run0 += __logf(lb0 + om0 * s0); run1 += __logf(lb1 + om1 * s1);
                cs0[i] = run0; cs1[i] = run1;
                kv0[i] = om0 * (1.0f - s0); kv1[i] = om1 * (1.0f - s1);
                qv0[i] = fsilu(bflo(rq[i])); qv1[i] = fsilu(bfhi(rq[i]));
            }
            *(LAS f32x2*)(base + OFF_SEG + (w * 128 + k0) * 4) = (f32x2){run0, run1};
            __syncthreads();
            float off0 = 0.f, off1 = 0.f, ref0 = 0.f, ref1 = 0.f, all0 = 0.f, all1 = 0.f;
#pragma unroll
            for (int s = 0; s < 8; ++s) { const f32x2 t2 = *(const LAS f32x2*)(base + OFF_SEG + (s * 128 + k0) * 4);
                if (s < w) { off0 += t2[0]; off1 += t2[1]; }
                if (s < 4) { ref0 += t2[0]; ref1 += t2[1]; }
                all0 += t2[0]; all1 += t2[1]; }
            float kh0[4], kh1[4];
#pragma unroll
            for (int i = 0; i < 4; ++i) {
                const float b0 = off0 + cs0[i], b1 = off1 + cs1[i];
                const float q0 = qv0[i] * __expf(b0 - ref0), q1 = qv1[i] * __expf(b1 - ref1);
                kh0[i] = kv0[i] * __expf(ref0 - b0); kh1[i] = kv1[i] * __expf(ref1 - b1);
                const int t = 4 * w + i;
                *(LAS unsigned*)(base + OFF_QT + t * QS + k0 * 2) = pk2(q0, q1);
                *(LAS unsigned*)(base + OFF_KH + t * QS + k0 * 2) = pk2(kh0[i], kh1[i]);
            }
            *(LAS u32x2*)(base + OFF_KT + k0 * TS + 8 * w) = (u32x2){pk2(kh0[0], kh0[1]), pk2(kh0[2], kh0[3])};
            *(LAS u32x2*)(base + OFF_KT + (k0 + 1) * TS + 8 * w) = (u32x2){pk2(kh1[0], kh1[1]), pk2(kh1[2], kh1[3])};
            *(LAS u32x2*)(base + OFF_VT + k0 * TS + 8 * w) = (u32x2){(rv[0] & 0xffffu) | (rv[1] << 16), (rv[2] & 0xffffu) | (rv[3] << 16)};
            *(LAS u32x2*)(base + OFF_VT + (k0 + 1) * TS + 8 * w) = (u32x2){(rv[0] >> 16) | (rv[1] & 0xffff0000u), (rv[2] >> 16) | (rv[3] & 0xffff0000u)};
            if (w == 0) {
                *(LAS f32x2*)(base + OFF_EREF + k0 * 4) = (f32x2){__expf(ref0), __expf(ref1)};
                *(LAS f32x2*)(base + OFF_ELR + k0 * 4) = (f32x2){__expf(all0 - ref0), __expf(all1 - ref1)};
            }
            __syncthreads();
            if (c + 1 < 64) {
                const bf16_t* nb = PA + ((size_t)b * SEQ + (c + 1) * 32 + 4 * w) * 3072 + h * 128 + k0;
#pragma unroll
                for (int i = 0; i < 4; ++i) { rq[i] = *(const unsigned*)(nb + (size_t)i * 3072); rf[i] = *(const unsigned*)(nb + (size_t)i * 3072 + 1024); rv[i] = *(const unsigned*)(nb + (size_t)i * 3072 + 2048); }
            }
            bf16x8 qf[2][4], kf[2][4];
#pragma unroll
            for (int tt = 0; tt < 2; ++tt)
#pragma unroll
                for (int m = 0; m < 4; ++m) {
                    const LAS unsigned char* pq = base + OFF_QT + (16 * tt + fr) * QS + (32 * m + 4 * g) * 2;
                    const u32x2 lo = *(const LAS u32x2*)pq, hi = *(const LAS u32x2*)(pq + 32);
                    qf[tt][m] = __builtin_bit_cast(bf16x8, (u32x4){lo[0], lo[1], hi[0], hi[1]});
                    const LAS unsigned char* pk = base + OFF_KH + (16 * tt + fr) * QS + (32 * m + 4 * g) * 2;
                    const u32x2 lo2 = *(const LAS u32x2*)pk, hi2 = *(const LAS u32x2*)(pk + 32);
                    kf[tt][m] = __builtin_bit_cast(bf16x8, (u32x4){lo2[0], lo2[1], hi2[0], hi2[1]});
                }
            f32x4 PT00 = {0.f, 0.f, 0.f, 0.f}, PT01 = {0.f, 0.f, 0.f, 0.f}, PT11 = {0.f, 0.f, 0.f, 0.f};
#pragma unroll
            for (int m = 0; m < 4; ++m) {
                PT00 = __builtin_amdgcn_mfma_f32_16x16x32_bf16(kf[0][m], qf[0][m], PT00, 0, 0, 0);
                PT01 = __builtin_amdgcn_mfma_f32_16x16x32_bf16(kf[0][m], qf[1][m], PT01, 0, 0, 0);
                PT11 = __builtin_amdgcn_mfma_f32_16x16x32_bf16(kf[1][m], qf[1][m], PT11, 0, 0, 0);
            }
#pragma unroll
            for (int r = 0; r < 4; ++r) { if (4 * g + r > fr) { PT00[r] = 0.f; PT11[r] = 0.f; } }
            const bf16x8 pa0 = __builtin_bit_cast(bf16x8, (u32x4){pk2(PT00[0], PT00[1]), pk2(PT00[2], PT00[3]), 0u, 0u});
            const bf16x8 pa1 = __builtin_bit_cast(bf16x8, (u32x4){pk2(PT01[0], PT01[1]), pk2(PT01[2], PT01[3]), pk2(PT11[0], PT11[1]), pk2(PT11[2], PT11[3])});
            const LAS unsigned char* vrow = base + OFF_VT + (16 * w + fr) * TS;
            const u32x2 vpa = *(const LAS u32x2*)(vrow + 8 * g), vpb = *(const LAS u32x2*)(vrow + 32 + 8 * g);
            const u32x2 vna = *(const LAS u32x2*)(vrow + 16 * g), vnb = *(const LAS u32x2*)(vrow + 16 * g + 8);
            const bf16x8 vperm = __builtin_bit_cast(bf16x8, (u32x4){vpa[0], vpa[1], vpb[0], vpb[1]});
            const bf16x8 vnat = __builtin_bit_cast(bf16x8, (u32x4){vna[0], vna[1], vnb[0], vnb[1]});
#pragma unroll
            for (int kt = 0; kt < 8; ++kt) { const f32x4 e = *(const LAS f32x4*)(base + OFF_EREF + (16 * kt + 4 * g) * 4); S[kt] = S[kt] * e; }
            f32x4 O0 = {0.f, 0.f, 0.f, 0.f}, O1 = {0.f, 0.f, 0.f, 0.f};
#pragma unroll
            for (int m = 0; m < 4; ++m) {
                const bf16x8 sf = __builtin_bit_cast(bf16x8, (u32x4){pk2(S[2 * m][0], S[2 * m][1]), pk2(S[2 * m][2], S[2 * m][3]), pk2(S[2 * m + 1][0], S[2 * m + 1][1]), pk2(S[2 * m + 1][2], S[2 * m + 1][3])});
                O0 = __builtin_amdgcn_mfma_f32_16x16x32_bf16(qf[0][m], sf, O0, 0, 0, 0);
                O1 = __builtin_amdgcn_mfma_f32_16x16x32_bf16(qf[1][m], sf, O1, 0, 0, 0);
            }
            O0 = __builtin_amdgcn_mfma_f32_16x16x32_bf16(pa0, vperm, O0, 0, 0, 0);
            O1 = __builtin_amdgcn_mfma_f32_16x16x32_bf16(pa1, vperm, O1, 0, 0, 0);
#pragma unroll
            for (int kt = 0; kt < 8; ++kt) {
                const LAS unsigned char* krow = base + OFF_KT + (16 * kt + fr) * TS + 16 * g;
                const u32x2 ka = *(const LAS u32x2*)krow, kb = *(const LAS u32x2*)(krow + 8);
                const bf16x8 ktf = __builtin_bit_cast(bf16x8, (u32x4){ka[0], ka[1], kb[0], kb[1]});
                S[kt] = __builtin_amdgcn_mfma_f32_16x16x32_bf16(ktf, vnat, S[kt], 0, 0, 0);
            }
#pragma unroll
            for (int kt = 0; kt < 8; ++kt) { const f32x4 e = *(const LAS f32x4*)(base + OFF_ELR + (16 * kt + 4 * g) * 4); S[kt] = S[kt] * e; }
            bf16_t* orow = ORAW + ((size_t)b * SEQ + c * 32 + 4 * g) * D + h * 128 + 16 * w + fr;
#pragma unroll
            for (int r = 0; r < 4; ++r) { orow[(size_t)r * D] = (bf16_t)(pk2(O0[r], 0.f) & 0xffffu); orow[(size_t)(16 + r) * D] = (bf16_t)(pk2(O1[r], 0.f) & 0xffffu); }
        }
        __syncthreads();
    }
}

__device__ __forceinline__ void phase_s5(const KP& p, LAS unsigned char* lds, int l, int G, size_t ys_off) {
    const int tid = opaque_tid(), lane = tid & 63, w = __builtin_amdgcn_readfirstlane(tid >> 6), fr = lane & 15, g = lane >> 4;
    const int gw = blockIdx.x * 8 + w, ngw = G * 8;
    constexpr int BUS = 132;
    LAS float* BU = (LAS float*)(lds + w * 16896);
    LAS unsigned char* XI = (LAS unsigned char*)BU;
    const bf16_t* PB = (const bf16_t*)(p.ws + WS_R0);
    const bf16x8 zero8 = {0, 0, 0, 0, 0, 0, 0, 0};
    for (int unit = gw; unit < BATCH * 64; unit += ngw) {
        const int b = unit >> 6, grp = unit & 63, lg = l * 64 + grp;
        const bf16_t* BOP = (const bf16_t*)(p.ws + WS_BOP) + (size_t)lg * 128 * 16;
        const bf16_t* COP = (const bf16_t*)(p.ws + WS_COP) + (size_t)lg * 16 * 128;
        bf16x8 bfrag[8], cfrag[4], dfrag;
#pragma unroll
        for (int nt = 0; nt < 8; ++nt) bfrag[nt] = (g < 2) ? *(const bf16x8*)(BOP + (size_t)(16 * nt + fr) * 16 + 8 * g) : zero8;
#pragma unroll
        for (int ks = 0; ks < 4; ++ks) cfrag[ks] = DBG_S5_NOSSM ? zero8 : *(const bf16x8*)(COP + (size_t)fr * 128 + 32 * ks + 8 * g);
        {
            const unsigned dbits = pk2(p.in[I_S5D][l * 1024 + grp * 16 + fr], 0.f) & 0xffffu;
#pragma unroll
            for (int j = 0; j < 8; ++j) dfrag[j] = (g < 2 && (8 * g + j) == fr) ? (short)dbits : (short)0;
        }
        const float ar = ((const float*)(p.ws + WS_ABAR))[2 * ((size_t)lg * 64 + lane)], ai = ((const float*)(p.ws + WS_ABAR))[2 * ((size_t)lg * 64 + lane) + 1];
        const float nai = -ai; float xr = 0.f, xi = 0.f; unsigned hBU = 0u, hXI = 0u, hY = 0u;
        const bf16_t* ub = PB + ((size_t)b * SEQ) * 4096 + 1024 + grp * 16;
        bf16_t* yb_ = (bf16_t*)(p.ws + ys_off) + ((size_t)b * SEQ) * D + grp * 16;
        bf16x8 unext[2];
#pragma unroll
        for (int tt = 0; tt < 2; ++tt) unext[tt] = (g < 2) ? *(const bf16x8*)(ub + (size_t)(16 * tt + fr) * 4096 + 8 * g) : zero8;
        for (int t0 = 0; t0 < SEQ; t0 += 32) {
            bf16x8 ufrag[2];
#pragma unroll
            for (int tt = 0; tt < 2; ++tt) { ufrag[tt] = unext[tt]; if (t0 + 32 < SEQ) unext[tt] = (g < 2) ? *(const bf16x8*)(ub + (size_t)(t0 + 32 + 16 * tt + fr) * 4096 + 8 * g) : zero8; }
#pragma unroll
            for (int tt = 0; tt < 2; ++tt)
#pragma unroll
                for (int nt = 0; nt < 8; ++nt) {
                    const f32x4 a = __builtin_amdgcn_mfma_f32_16x16x32_bf16(ufrag[tt], bfrag[nt], (f32x4){0.f, 0.f, 0.f, 0.f}, 0, 0, 0);
#pragma unroll
                    for (int r = 0; r < 4; ++r) BU[(16 * tt + 4 * g + r) * BUS + 16 * nt + fr] = a[r];
                }
            LDS_WAIT();
#pragma unroll
            for (int t = 0; t < 32; ++t) {
                const f32x2 bb = *(const LAS f32x2*)(BU + t * BUS + 2 * lane); hBU += __float_as_uint(bb[0]) * 3u + __float_as_uint(bb[1]);
                float t1, t2, nr, ni;
                asm("v_fma_f32 %0, %1, %2, %3" : "=v"(t1) : "v"(nai), "v"(xi), "v"(bb[0]));
                asm("v_fma_f32 %0, %1, %2, %3" : "=v"(t2) : "v"(ai), "v"(xr), "v"(bb[1]));
                asm("v_fma_f32 %0, %1, %2, %3" : "=v"(nr) : "v"(ar), "v"(xr), "v"(t1));
                asm("v_fma_f32 %0, %1, %2, %3" : "=v"(ni) : "v"(ar), "v"(xi), "v"(t2));
                xr = nr; xi = ni;
                { const unsigned pv = pk2(nr, ni); hXI += pv; *(LAS unsigned*)(XI + t * (BUS * 4) + lane * 4) = pv; }
            }
            LDS_WAIT();
#pragma unroll
            for (int tt = 0; tt < 2; ++tt) {
                f32x4 y = {0.f, 0.f, 0.f, 0.f};
#pragma unroll
                for (int ks = 0; ks < 4; ++ks) {
                    const bf16x8 xf = *(const LAS bf16x8*)(XI + (16 * tt + fr) * (BUS * 4) + (32 * ks + 8 * g) * 2);
                    y = __builtin_amdgcn_mfma_f32_16x16x32_bf16(xf, cfrag[ks], y, 0, 0, 0);
                }
                y = __builtin_amdgcn_mfma_f32_16x16x32_bf16(ufrag[tt], dfrag, y, 0, 0, 0);
#pragma unroll
                for (int r = 0; r < 4; ++r) { const unsigned yv = pk2(fgelu(y[r]), 0.f) & 0xffffu; hY += yv * (unsigned)(r + 1); yb_[(size_t)(t0 + 16 * tt + 4 * g + r) * D + fr] = (bf16_t)yv; }
            }
            LDS_WAIT();
        }
        if (DBG_SELFCHECK) { for (int o = 1; o < 64; o <<= 1) { hBU += __shfl_xor((int)hBU, o); hXI += __shfl_xor((int)hXI, o); hY += __shfl_xor((int)hY, o); }
            unsigned* hs = (unsigned*)(p.ws + WS_CTL) + 65536 + (ys_off == WS_YS ? 0 : 8192) + unit * 4; unsigned hA = __float_as_uint(ar) * 7u + __float_as_uint(ai); for (int o = 1; o < 64; o <<= 1) hA += __shfl_xor((int)hA, o); if (lane == 0) { hs[0] = hBU; hs[1] = hXI; hs[2] = hA; } }
    }
    const bf16_t* ORAW = (const bf16_t*)(p.ws + WS_OR); float* SSQ = (float*)(p.ws + WS_SSQ);
    for (int row = gw; row < M; row += ngw) {
        const u32x4 a = *(const u32x4*)(ORAW + (size_t)row * D + 8 * lane), c2 = *(const u32x4*)(ORAW + (size_t)row * D + 512 + 8 * lane);
        float s0 = 0.f, s1 = 0.f;
#pragma unroll
        for (int j = 0; j < 4; ++j) { const float x0 = bflo(a[j]), x1 = bfhi(a[j]), y0 = bflo(c2[j]), y1 = bfhi(c2[j]); s0 += x0 * x0 + x1 * x1; s1 += y0 * y0 + y1 * y1; }
#pragma unroll
        for (int o = 1; o < 16; o <<= 1) { s0 += __shfl_xor(s0, o); s1 += __shfl_xor(s1, o); }
        if (fr == 0) { SSQ[(size_t)row * 8 + g] = s0; SSQ[(size_t)row * 8 + 4 + g] = s1; }
    }
}

__device__ __forceinline__ unsigned fkey(float f) { const unsigned u = __float_as_uint(f); return u ^ ((unsigned)((int)u >> 31) | 0x80000000u); }
__device__ __forceinline__ float kval(unsigned k) { const unsigned u = (k & 0x80000000u) ? (k ^ 0x80000000u) : ~k; return __uint_as_float(u); }
#define CE_DESC(a, b) do { const unsigned _mx = (a) > (b) ? (a) : (b), _mn = (a) > (b) ? (b) : (a); (a) = _mx; (b) = _mn; } while (0)
__device__ __forceinline__ void sort16_desc(unsigned (&a)[16]) {
#pragma unroll
    for (int kk = 1; kk <= 4; ++kk)
#pragma unroll
        for (int jj = kk - 1; jj >= 0; --jj)
#pragma unroll
            for (int i = 0; i < 16; ++i) { const int k = 1 << kk, j = 1 << jj, l2 = i ^ j;
                if (l2 > i) { if ((i & k) == 0) CE_DESC(a[i], a[l2]); else CE_DESC(a[l2], a[i]); } }
}
__device__ __forceinline__ void merge_top16(unsigned (&a)[16], const unsigned (&b)[16]) {
#pragma unroll
    for (int i = 0; i < 16; ++i) a[i] = a[i] > b[15 - i] ? a[i] : b[15 - i];
#pragma unroll
    for (int jj = 3; jj >= 0; --jj)
#pragma unroll
        for (int i = 0; i < 16; ++i) { const int j = 1 << jj, l2 = i ^ j; if (l2 > i) CE_DESC(a[i], a[l2]); }
}
__device__ __forceinline__ void phase_topk(const KP& p, LAS unsigned char* lds, int G) {
    const int tid = opaque_tid(), lane = tid & 63, w = __builtin_amdgcn_readfirstlane(tid >> 6), hh = lane >> 5;
    const int gw = blockIdx.x * 8 + w, ngw = G * 8;
    const bf16_t* Q = (const bf16_t*)(p.ws + WS_R0); const bf16_t* KEYS = (const bf16_t*)(p.ws + WS_KEYS);
    unsigned* SEL = (unsigned*)(p.ws + WS_SEL);
    LAS unsigned char* tab = lds + w * 2048 + lane * 32;
    const int CI[50] = {0,0,0,0,0,0,0,0,0,0,0,0,0,0,0,0, 1,1,1,1,1,1,1,1, 2,2,2,2,2, 3,3,3,3, 4,4,4, 5,5, 6,6, 7,7, 8,9,10,11,12,13,14,15};
    const int CJ[50] = {0,1,2,3,4,5,6,7,8,9,10,11,12,13,14,15, 0,1,2,3,4,5,6,7, 0,1,2,3,4, 0,1,2,3, 0,1,2, 0,1, 0,1, 0,1, 0,0,0,0,0,0,0,0};
    LAS unsigned char* kimg = lds + 16384;
    for (int h = 0; h < 8; ++h) {
      __syncthreads();
#pragma unroll
      for (int i = 0; i < 8; ++i) { const int ch = tid + 512 * i, row = ch >> 4, c16 = ch & 15;
          *(LAS u32x4*)(kimg + row * 272 + c16 * 16) = *(const u32x4*)(KEYS + (size_t)(h * 256 + row) * 128 + c16 * 8); }
      __syncthreads();
      for (int tg = gw; tg < 2048; tg += ngw) {
        const int t = tg * 32 + (lane & 31);
        unsigned top[2][16];
#pragma unroll
        for (int pp = 0; pp < 2; ++pp) {
            bf16x8 qf[8];
#pragma unroll
            for (int ks = 0; ks < 8; ++ks) qf[ks] = *(const bf16x8*)(Q + ((size_t)((((tg * 8 + h) * 2 + pp) * 8 + ks) * 64 + lane)) * 8);
            const LAS unsigned char* kb = kimg + (pp * 128 + (lane & 31)) * 272 + 16 * hh;
#pragma unroll
            for (int nt = 0; nt < 4; ++nt) {
                f32x16 acc;
#pragma unroll
                for (int i = 0; i < 16; ++i) acc[i] = 0.f;
#pragma unroll
                for (int ks = 0; ks < 8; ++ks) { const bf16x8 kf = *(const LAS bf16x8*)(kb + (32 * nt) * 272 + 32 * ks);
                    acc = __builtin_amdgcn_mfma_f32_32x32x16_bf16(kf, qf[ks], acc, 0, 0, 0); }
                unsigned ky[16];
#pragma unroll
                for (int r = 0; r < 16; ++r) ky[r] = (fkey(acc[r]) & ~127u) | (unsigned)(32 * nt + (r & 3) + 8 * (r >> 2)) | (unsigned)(4 * hh);
                sort16_desc(ky);
                if (nt == 0) {
#pragma unroll
                    for (int i = 0; i < 16; ++i) top[pp][i] = ky[i];
                } else merge_top16(top[pp], ky);
            }
            unsigned other[16];
#pragma unroll
            for (int i = 0; i < 16; ++i) other[i] = (unsigned)__shfl_xor((int)top[pp][i], 32);
            merge_top16(top[pp], other);
        }
        float sa[16], sb[16];
#pragma unroll
        for (int i = 0; i < 16; ++i) { sa[i] = kval(top[0][i] & ~127u); sb[i] = kval(top[1][i] & ~127u); }
        unsigned c0[16], c1[16];
#pragma unroll
        for (int s = 0; s < 32; ++s) {
            unsigned key = 0u;
            if (s < 25) {
                const float v0 = sa[CI[s]] + sb[CJ[s]], v1 = sa[CI[25 + s]] + sb[CJ[25 + s]];
                const unsigned k0 = (fkey(v0) & ~255u) | (unsigned)(CI[s] * 16 + CJ[s]), k1 = (fkey(v1) & ~255u) | (unsigned)(CI[25 + s] * 16 + CJ[25 + s]);
                key = hh ? k1 : k0;
            }
            if (s < 16) c0[s] = key; else c1[s - 16] = key;
        }
        sort16_desc(c0); sort16_desc(c1); merge_top16(c0, c1);
#pragma unroll
        for (int i = 0; i < 16; ++i) c1[i] = (unsigned)__shfl_xor((int)c0[i], 32);
        merge_top16(c0, c1);
        {
            u32x4 wa, wb;
#pragma unroll
            for (int q4 = 0; q4 < 4; ++q4) {
                wa[q4] = (top[0][4 * q4] & 127u) | ((top[0][4 * q4 + 1] & 127u) << 8) | ((top[0][4 * q4 + 2] & 127u) << 16) | ((top[0][4 * q4 + 3] & 127u) << 24);
                wb[q4] = (top[1][4 * q4] & 127u) | ((top[1][4 * q4 + 1] & 127u) << 8) | ((top[1][4 * q4 + 2] & 127u) << 16) | ((top[1][4 * q4 + 3] & 127u) << 24);
            }
            *(LAS u32x4*)tab = wa; *(LAS u32x4*)(tab + 16) = wb;
        }
        float ev[16], esum = 0.f; const float vmax = kval(c0[0] & ~255u);
#pragma unroll
        for (int k = 0; k < 16; ++k) { ev[k] = __expf(kval(c0[k] & ~255u) - vmax); esum += ev[k]; }
        const float rs = 1.0f / esum;
        LDS_WAIT();
        unsigned outw[8]; const unsigned hmask = hh ? 0xffffffffu : 0u;
#pragma unroll
        for (int kk = 0; kk < 8; ++kk) {
            const unsigned key = c0[kk] ^ ((c0[kk] ^ c0[8 + kk]) & hmask); const float e = __uint_as_float(__float_as_uint(ev[kk]) ^ ((__float_as_uint(ev[kk]) ^ __float_as_uint(ev[8 + kk])) & hmask));
            const unsigned code = key & 255u, ia = tab[code >> 4], ib = tab[16 + (code & 15u)];
            outw[kk] = (pk2(0.f, e * rs) & 0xffff0000u) | (ia * 128u + ib);
        }
        u32x4* dst = (u32x4*)(SEL + (size_t)t * 128 + h * 16 + hh * 8);
        dst[0] = (u32x4){outw[0], outw[1], outw[2], outw[3]}; dst[1] = (u32x4){outw[4], outw[5], outw[6], outw[7]};
        LDS_WAIT();
      }
    }
    __syncthreads();
}

__device__ __forceinline__ void fp8x4_to_f32(unsigned w, float& a, float& b, float& c, float& d) {
    const f32x2 lo = __builtin_amdgcn_cvt_pk_f32_fp8((int)w, false), hi = __builtin_amdgcn_cvt_pk_f32_fp8((int)w, true); a = lo[0]; b = lo[1]; c = hi[0]; d = hi[1];
}
struct XSlice { int sl, rank, nloc; };
__device__ __forceinline__ XSlice xslice_of_block(const KP& p, volatile LAS unsigned* MISC, int G) {
    unsigned* bar = (unsigned*)(p.ws + WS_CTL) + 4096; unsigned cnt[8]; unsigned tot = 0; bool ok = true;
#pragma unroll
    for (int j = 0; j < 8; ++j) { cnt[j] = xb_ld(&bar[XB_XCNT(j)]); tot += cnt[j]; ok = ok && (cnt[j] > 0u); }
    ok = ok && (tot == (unsigned)G);
    XSlice x;
    if (ok) { const unsigned myx = MISC[16]; x.sl = (int)myx; x.rank = (int)MISC[17]; x.nloc = (int)cnt[myx & 7u]; }
    else { x.sl = (int)(blockIdx.x & 7); x.rank = (int)(blockIdx.x >> 3); x.nloc = (G - x.sl + 7) >> 3; }
    x.sl = __builtin_amdgcn_readfirstlane(x.sl); x.rank = __builtin_amdgcn_readfirstlane(x.rank); x.nloc = __builtin_amdgcn_readfirstlane(x.nloc);
    return x;
}
__device__ __forceinline__ float dot16_fp8(const u32x4 u, const float (&hf)[16]) {
    float d = 0.f;
#pragma unroll
    for (int j = 0; j < 4; ++j) { float f0, f1, f2, f3; fp8x4_to_f32(u[j], f0, f1, f2, f3);
        d = __builtin_fmaf(f0, hf[4 * j], d); d = __builtin_fmaf(f1, hf[4 * j + 1], d); d = __builtin_fmaf(f2, hf[4 * j + 2], d); d = __builtin_fmaf(f3, hf[4 * j + 3], d); }
    return d;
}
typedef __bf16 bf16v8 __attribute__((ext_vector_type(8)));
__device__ __forceinline__ float dot16_fp8_bf16(const u32x4 u, const bf16v8 h0, const bf16v8 h1) {
    float d0 = 0.f, d1 = 0.f;
    d0 = __builtin_amdgcn_fdot2_f32_bf16(__builtin_amdgcn_cvt_scalef32_pk_bf16_fp8(u[0], 1.0f, false), __builtin_shufflevector(h0, h0, 0, 1), d0, false);
    d1 = __builtin_amdgcn_fdot2_f32_bf16(__builtin_amdgcn_cvt_scalef32_pk_bf16_fp8(u[0], 1.0f, true),  __builtin_shufflevector(h0, h0, 2, 3), d1, false);
    d0 = __builtin_amdgcn_fdot2_f32_bf16(__builtin_amdgcn_cvt_scalef32_pk_bf16_fp8(u[1], 1.0f, false), __builtin_shufflevector(h0, h0, 4, 5), d0, false);
    d1 = __builtin_amdgcn_fdot2_f32_bf16(__builtin_amdgcn_cvt_scalef32_pk_bf16_fp8(u[1], 1.0f, true),  __builtin_shufflevector(h0, h0, 6, 7), d1, false);
    d0 = __builtin_amdgcn_fdot2_f32_bf16(__builtin_amdgcn_cvt_scalef32_pk_bf16_fp8(u[2], 1.0f, false), __builtin_shufflevector(h1, h1, 0, 1), d0, false);
    d1 = __builtin_amdgcn_fdot2_f32_bf16(__builtin_amdgcn_cvt_scalef32_pk_bf16_fp8(u[2], 1.0f, true),  __builtin_shufflevector(h1, h1, 2, 3), d1, false);
    d0 = __builtin_amdgcn_fdot2_f32_bf16(__builtin_amdgcn_cvt_scalef32_pk_bf16_fp8(u[3], 1.0f, false), __builtin_shufflevector(h1, h1, 4, 5), d0, false);
    d1 = __builtin_amdgcn_fdot2_f32_bf16(__builtin_amdgcn_cvt_scalef32_pk_bf16_fp8(u[3], 1.0f, true),  __builtin_shufflevector(h1, h1, 6, 7), d1, false);
    return d0 + d1;
}
__device__ __forceinline__ float dpp_sum8(float d) {
    d += __uint_as_float(__builtin_amdgcn_update_dpp(0, __float_as_uint(d), 0xB1, 0xF, 0xF, true));
    d += __uint_as_float(__builtin_amdgcn_update_dpp(0, __float_as_uint(d), 0x4E, 0xF, 0xF, true));
    d += __uint_as_float(__builtin_amdgcn_update_dpp(0, __float_as_uint(d), 0x141, 0xF, 0xF, true));
    return d;
}
__device__ __forceinline__ void phase_expert_u(const KP& p, LAS unsigned char* lds, volatile LAS unsigned* MISC, int G) {
    const int tid = opaque_tid(), lane = tid & 63, w = __builtin_amdgcn_readfirstlane(tid >> 6), j = lane >> 3, c = lane & 7;
    const XSlice xs = xslice_of_block(p, MISC, G);
    const bf16_t* H2 = (const bf16_t*)(p.ws + WS_H); const unsigned char* Us = p.ws + WS_U + (size_t)xs.sl * 16384 * 128;
    const unsigned* SEL = (const unsigned*)(p.ws + WS_SEL); unsigned* PDu = (unsigned*)(p.ws + WS_R0) + (size_t)xs.sl * M * 64;
    const int t0 = xs.rank * 8 + w, tstep = xs.nloc * 8;
    LAS unsigned char* ring = lds + w * 17920;
    LAS unsigned char* selb = ring + 16384; LAS unsigned char* hbuf = ring + 16384 + 1024;
    const int tlast = t0 + ((M - 1 - t0) / tstep) * tstep;
#define E1_CL(t) ((t) <= tlast ? (t) : tlast)
#define E1_DMA_SEL(t, par) do { const unsigned* sp = SEL + (size_t)E1_CL(t) * 128 + lane; \
            __builtin_amdgcn_global_load_lds(sp, (LAS unsigned*)(selb + (par) * 512), 4, 0, 0); __builtin_amdgcn_global_load_lds(sp + 64, (LAS unsigned*)(selb + (par) * 512 + 256), 4, 0, 0); } while (0)
#define E1_DMA_H(t, par) do { __builtin_amdgcn_global_load_lds((const unsigned*)(H2 + (size_t)E1_CL(t) * D + xs.sl * 128) + lane, (LAS unsigned*)(hbuf + (par) * 256), 4, 0, 0); } while (0)
#define E1_DMA_ROW(i, idxv) do { __builtin_amdgcn_global_load_lds((const unsigned*)(Us + (size_t)((idxv) & 0x3fffu) * 128 + 16 * c), (LAS unsigned*)(ring + (i) * 1024), 16, 0, 0); } while (0)
    if (t0 < M) {
        E1_DMA_SEL(t0, 0); E1_DMA_SEL(t0 + tstep, 1); E1_DMA_H(t0, 0);
        asm volatile("s_waitcnt vmcnt(0)" ::: "memory");
        { u32x4 s0[4];
#pragma unroll
          for (int q = 0; q < 4; ++q) s0[q] = *(const LAS u32x4*)(selb + (16 * j + 4 * q) * 4);
#pragma unroll
          for (int i = 0; i < 16; ++i) E1_DMA_ROW(i, s0[i >> 2][i & 3]); }
        { PDu[(size_t)t0 * 64 + 8 * j + (c >> 1) + 4 * (c & 1)] = 0u; }
        int par = 0;
        for (int tok = t0; tok < M; tok += tstep, par ^= 1) {
            E1_DMA_SEL(tok + 2 * tstep, par); E1_DMA_H(tok + tstep, par ^ 1);
            asm volatile("s_waitcnt vmcnt(19)" ::: "memory");
            u32x4 sn[4];
#pragma unroll
            for (int q = 0; q < 4; ++q) sn[q] = *(const LAS u32x4*)(selb + (par ^ 1) * 512 + (16 * j + 4 * q) * 4);
            const bf16v8 hb0 = *(const LAS bf16v8*)(hbuf + par * 256 + 32 * c), hb1 = *(const LAS bf16v8*)(hbuf + par * 256 + 32 * c + 16);
            float pd0 = 0.f, pd1 = 0.f;
#pragma unroll
            for (int i0 = 0; i0 < 16; i0 += 4) {
                asm volatile("s_waitcnt vmcnt(16)" ::: "memory");
                u32x4 row[4];
#pragma unroll
                for (int r = 0; r < 4; ++r) row[r] = *(const LAS u32x4*)(ring + (i0 + r) * 1024 + 16 * lane);
                asm volatile("s_waitcnt lgkmcnt(0)" ::: "memory");
#pragma unroll
                for (int r = 0; r < 4; ++r) E1_DMA_ROW(i0 + r, sn[(i0 + r) >> 2][(i0 + r) & 3]);
#pragma unroll
                for (int r = 0; r < 4; ++r) { const int i = i0 + r; const float d = dpp_sum8(dot16_fp8_bf16(row[r], hb0, hb1));
                    if (i < 8) pd0 = (c == i) ? d : pd0; else pd1 = (c == i - 8) ? d : pd1; }
            }
            { const float nb0 = __uint_as_float(__builtin_amdgcn_update_dpp(0, __float_as_uint(pd0), 0xB1, 0xF, 0xF, true)), nb1 = __uint_as_float(__builtin_amdgcn_update_dpp(0, __float_as_uint(pd1), 0xB1, 0xF, 0xF, true));
              PDu[(size_t)tok * 64 + 8 * j + (c >> 1) + 4 * (c & 1)] = (c & 1) ? pk2(nb1, pd1) : pk2(pd0, nb0); }
        }
        asm volatile("s_waitcnt vmcnt(0)" ::: "memory");
    }
#undef E1_CL
#undef E1_DMA_SEL
#undef E1_DMA_H
#undef E1_DMA_ROW
}
__device__ __forceinline__ void phase_expert_w(const KP& p, int G) {
    const int tid = opaque_tid(), lane = tid & 63, w = __builtin_amdgcn_readfirstlane(tid >> 6);
    const int gw = blockIdx.x * 8 + w, ngw = G * 8;
    unsigned* SEL = (unsigned*)(p.ws + WS_SEL); const unsigned* PDu = (const unsigned*)(p.ws + WS_R0);
    for (int tok = gw; tok < M; tok += ngw) {
        f32x2 d = {0.f, 0.f};
#pragma unroll
        for (int sl = 0; sl < 8; ++sl) { const unsigned pw = PDu[((size_t)sl * M + tok) * 64 + lane]; d[0] += bflo(pw); d[1] += bfhi(pw); }
        u32x2* sp = (u32x2*)(SEL + (size_t)tok * 128 + 2 * lane); const u32x2 s2 = *sp;
        const float w0 = __uint_as_float(s2[0] & 0xffff0000u) * fgelu(d[0] * (1.0f / U_SCALE)) * (1.0f / V_SCALE);
        const float w1 = __uint_as_float(s2[1] & 0xffff0000u) * fgelu(d[1] * (1.0f / U_SCALE)) * (1.0f / V_SCALE);
        u32x2 o; o[0] = (pk2(0.f, w0) & 0xffff0000u) | (s2[0] & 0x3fffu); o[1] = (pk2(0.f, w1) & 0xffff0000u) | (s2[1] & 0x3fffu);
        *sp = o;
    }
}
__device__ __forceinline__ void phase_expert_v(const KP& p, LAS unsigned char* lds, volatile LAS unsigned* MISC, int l, int G) {
    const int tid = opaque_tid(), lane = tid & 63, w = __builtin_amdgcn_readfirstlane(tid >> 6), j = lane >> 3, c = lane & 7;
    const XSlice xs = xslice_of_block(p, MISC, G);
    const unsigned char* Vs = p.ws + WS_V + (size_t)xs.sl * 16384 * 128;
    const unsigned* SEL = (const unsigned*)(p.ws + WS_SEL);
    const float* g2 = (const float*)(p.ws + WS_MOD) + (size_t)l * 32 * NMODC + 5120;
    float* X = p.out;
    const int t0 = xs.rank * 8 + w, tstep = xs.nloc * 8;
    const bool b3 = (lane & 8) != 0;
    LAS unsigned char* ring = lds + w * 17920; LAS unsigned char* selb = ring + 16384;
    const int tlast = t0 + ((M - 1 - t0) / tstep) * tstep;
#define E2_CL(t) ((t) <= tlast ? (t) : tlast)
#define E2_DMA_SEL(t, par) do { const unsigned* sp = SEL + (size_t)E2_CL(t) * 128 + lane; \
            __builtin_amdgcn_global_load_lds(sp, (LAS unsigned*)(selb + (par) * 512), 4, 0, 0); __builtin_amdgcn_global_load_lds(sp + 64, (LAS unsigned*)(selb + (par) * 512 + 256), 4, 0, 0); } while (0)
#define E2_DMA_ROW(i, idxv) do { __builtin_amdgcn_global_load_lds((const unsigned*)(Vs + (size_t)((idxv) & 0x3fffu) * 128 + 16 * c), (LAS unsigned*)(ring + (i) * 1024), 16, 0, 0); } while (0)
    if (t0 < M) {
        E2_DMA_SEL(t0, 0); E2_DMA_SEL(t0 + tstep, 1);
        asm volatile("s_waitcnt vmcnt(0)" ::: "memory");
        u32x4 sc[4];
#pragma unroll
        for (int q = 0; q < 4; ++q) sc[q] = *(const LAS u32x4*)(selb + (16 * j + 4 * q) * 4);
#pragma unroll
        for (int i = 0; i < 16; ++i) E2_DMA_ROW(i, sc[i >> 2][i & 3]);
        LAS float* xbuf = (LAS float*)(ring + 16384 + 1024);
        { float* xd = X + (size_t)t0 * D + xs.sl * 128 + 16 * c + 2 * j; __builtin_amdgcn_global_load_lds((const unsigned*)xd, (LAS unsigned*)xbuf, 4, 0, 0); }
        int par = 0, bcur = -1; f32x2 gv = {0.f, 0.f};
        for (int tok = t0; tok < M; tok += tstep, par ^= 1) {
            const int dim = xs.sl * 128 + 16 * c + 2 * j;
            float* xp = X + (size_t)tok * D + dim;
            if ((tok >> 11) != bcur) { bcur = tok >> 11; const f32x2 gl = *(const f32x2*)(g2 + (size_t)bcur * NMODC + dim); asm volatile("s_waitcnt vmcnt(0)" ::: "memory"); gv[0] = gl[0] * 1.0f; gv[1] = gl[1] * 1.0f; asm volatile("" : "+v"(gv)); }
            E2_DMA_SEL(tok + 2 * tstep, par);
            __builtin_amdgcn_global_load_lds((const unsigned*)xp, (LAS unsigned*)xbuf, 4, 0, 0); __builtin_amdgcn_global_load_lds((const unsigned*)(xp + 1), (LAS unsigned*)(xbuf + 64), 4, 0, 0);
            asm volatile("s_waitcnt vmcnt(21)" ::: "memory");
            u32x4 sn[4];
#pragma unroll
            for (int q = 0; q < 4; ++q) sn[q] = *(const LAS u32x4*)(selb + (par ^ 1) * 512 + (16 * j + 4 * q) * 4);
            f32x2 o2[8];
#pragma unroll
            for (int q = 0; q < 8; ++q) o2[q] = (f32x2){0.f, 0.f};
#pragma unroll
            for (int i0 = 0; i0 < 16; i0 += 4) {
                asm volatile("s_waitcnt vmcnt(17)" ::: "memory");
                u32x4 row[4];
#pragma unroll
                for (int r = 0; r < 4; ++r) row[r] = *(const LAS u32x4*)(ring + (i0 + r) * 1024 + 16 * lane);
                asm volatile("s_waitcnt lgkmcnt(0)" ::: "memory");
#pragma unroll
                for (int r = 0; r < 4; ++r) E2_DMA_ROW(i0 + r, sn[(i0 + r) >> 2][(i0 + r) & 3]);
                {
                    const u32x2 wA = {sc[i0 >> 2][0], sc[i0 >> 2][1]}, wB = {sc[i0 >> 2][2], sc[i0 >> 2][3]};
#pragma unroll
                    for (int r = 0; r < 4; ++r)
#pragma unroll
                        for (int q = 0; q < 4; ++q) { const f32x2 lo = __builtin_amdgcn_cvt_pk_f32_fp8((int)row[r][q], false), hi = __builtin_amdgcn_cvt_pk_f32_fp8((int)row[r][q], true);
                            if (r & 1) { asm("v_pk_fma_f32 %0, %1, %2, %0 op_sel:[1,0,0] op_sel_hi:[1,1,1]" : "+v"(o2[2 * q]) : "v"(r < 2 ? wA : wB), "v"(lo));
                                         asm("v_pk_fma_f32 %0, %1, %2, %0 op_sel:[1,0,0] op_sel_hi:[1,1,1]" : "+v"(o2[2 * q + 1]) : "v"(r < 2 ? wA : wB), "v"(hi)); }
                            else       { asm("v_pk_fma_f32 %0, %1, %2, %0 op_sel:[0,0,0] op_sel_hi:[0,1,1]" : "+v"(o2[2 * q]) : "v"(r < 2 ? wA : wB), "v"(lo));
                                         asm("v_pk_fma_f32 %0, %1, %2, %0 op_sel:[0,0,0] op_sel_hi:[0,1,1]" : "+v"(o2[2 * q + 1]) : "v"(r < 2 ? wA : wB), "v"(hi)); } }
                }
            }
            float o[16];
#pragma unroll
            for (int q = 0; q < 8; ++q) { o[2 * q] = o2[q][0]; o[2 * q + 1] = o2[q][1]; }
            float r8[8], r4[4], r2[2];
#pragma unroll
            for (int k = 0; k < 8; ++k) { const u32x2 sw = __builtin_amdgcn_permlane32_swap(__float_as_uint(o[k]), __float_as_uint(o[8 + k]), false, false); r8[k] = __uint_as_float(sw[0]) + __uint_as_float(sw[1]); }
#pragma unroll
            for (int k = 0; k < 4; ++k) { const u32x2 sw = __builtin_amdgcn_permlane16_swap(__float_as_uint(r8[k]), __float_as_uint(r8[4 + k]), false, false); r4[k] = __uint_as_float(sw[0]) + __uint_as_float(sw[1]); }
#pragma unroll
            for (int k = 0; k < 2; ++k) { const float keep = b3 ? r4[2 + k] : r4[k], send = b3 ? r4[k] : r4[2 + k];
                r2[k] = keep + __uint_as_float(__builtin_amdgcn_update_dpp(0, __float_as_uint(send), 0x128, 0xF, 0xF, true)); }
            asm volatile("s_waitcnt vmcnt(16)" ::: "memory");
            { f32x2 xv; xv[0] = xbuf[lane] + gv[0] * r2[0]; xv[1] = xbuf[64 + lane] + gv[1] * r2[1]; *(f32x2*)xp = xv; }
#pragma unroll
            for (int q = 0; q < 4; ++q) sc[q] = sn[q];
        }
        asm volatile("s_waitcnt vmcnt(0)" ::: "memory");
    }
#undef E2_CL
#undef E2_DMA_SEL
#undef E2_DMA_ROW
}

__device__ __forceinline__ void phase_final(const KP& p, int G) {
    const int tid = opaque_tid(), lane = tid & 63, w = __builtin_amdgcn_readfirstlane(tid >> 6);
    const int gw = blockIdx.x * 8 + w, ngw = G * 8;
    const float* fg = p.in[I_FG];
    for (int r0 = gw * 4; r0 < M; r0 += ngw * 4) {
        f32x4 v[4][4]; float ss[4];
#pragma unroll
        for (int i = 0; i < 4; ++i) { const f32x4* xr = (const f32x4*)(p.out + (size_t)(r0 + i) * D) + lane;
#pragma unroll
            for (int j = 0; j < 4; ++j) v[i][j] = xr[64 * j]; }
#pragma unroll
        for (int i = 0; i < 4; ++i) { float t = 0.f;
#pragma unroll
            for (int j = 0; j < 4; ++j) t += (v[i][j][0] * v[i][j][0] + v[i][j][1] * v[i][j][1]) + (v[i][j][2] * v[i][j][2] + v[i][j][3] * v[i][j][3]);
            ss[i] = t; }
#pragma unroll
        for (int o = 1; o < 64; o <<= 1) {
#pragma unroll
            for (int i = 0; i < 4; ++i) ss[i] += __shfl_xor(ss[i], o); }
#pragma unroll
        for (int j = 0; j < 4; ++j) { const f32x4 g4 = *(const f32x4*)(fg + 256 * j + 4 * lane);
#pragma unroll
            for (int i = 0; i < 4; ++i) { const float rstd = __builtin_amdgcn_rsqf(ss[i] * (1.0f / D) + EPS); ((f32x4*)(p.out + (size_t)(r0 + i) * D) + lane)[64 * j] = v[i][j] * rstd * g4; } }
    }
}

__global__ void __launch_bounds__(512, 2) mk_fwd(KP p_) {
    extern __shared__ __attribute__((aligned(16))) unsigned char lds_raw[];
    LAS unsigned char* lds = (LAS unsigned char*)lds_raw;
    const int tid = threadIdx.x, G = gridDim.x;
    volatile LAS unsigned* MISC = (volatile LAS unsigned*)(lds + MISC_OFF);
    for (int i = tid; i < LDS_BYTES / 4; i += 512) ((LAS unsigned*)lds)[i] = 0u;
    __syncthreads();
    XcdBarrier bar = xcd_barrier_post((unsigned*)(p_.ws + WS_CTL) + 4096, MISC + 8);
    if (tid == 0) { const unsigned myx = xb_xcc_id(); MISC[16] = myx; MISC[17] = xb_add((unsigned*)(p_.ws + WS_CTL) + 8192 + 64 * (myx & 15u), 1u); }
    __syncthreads();
    const int lo = p_.gp_lo, hi = p_.gp_hi;
#ifndef PH_MASK
#define PH_MASK 0xFFFFF
#endif
#define IN(k) (lo <= (k) && (k) < hi)
#define EN(b) ((PH_MASK >> (b)) & 1)
#ifndef PH_REPEAT
#define PH_REPEAT 0
#endif
#define NREP(b) (((PH_REPEAT >> (b)) & 1) ? 2 : 1)
#define SEAM(k) do { if ((k) + 1 < hi) xcd_barrier(bar); } while (0)
    if (EN(12) && IN(GP_SETUP)) { const KP p = load_kp(); phase_setup(p, lds, G); SEAM(GP_SETUP); }
    for (int l = 0; l < DEPTH; ++l) {
        const int g0 = 1 + l * NPH;
        if (EN(0) && IN(g0 + 0)) { _Pragma("nounroll") for (int rep = 0; rep < NREP(0); ++rep) { const KP p = load_kp(); phase_conv_norm1(p, lds, l, G); } SEAM(g0 + 0); }
        if (EN(1) && IN(g0 + 1)) { const KP p = load_kp();
            pg8::Gemm g{(const bf16_t*)(p.ws + WS_H), (const bf16_t*)(p.ws + WS_WIN), M, 3072, D / 2, D / 2, D / 2}; pg8::StaticOrder S; S.init(M, 3072, G, (int)blockIdx.x);
            pg8::EpiStoreBf16 E{(bf16_t*)(p.ws + WS_R0), 3072, 1.0f / (WIN_SCALE * HIN_SCALE)};
            _Pragma("nounroll") for (int rep = 0; rep < NREP(1); ++rep) pg8::gemm_phase<pg8::EpiStoreBf16, pg8::StaticOrder, false, true, true>(lds, g, S, E);
            SEAM(g0 + 1);
        }
        if (EN(2) && IN(g0 + 2)) { _Pragma("nounroll") for (int rep = 0; rep < NREP(2); ++rep) { const KP p = load_kp(); phase_hgrn2(p, lds, l, G); } SEAM(g0 + 2); }
        if (EN(3) && IN(g0 + 3)) { const KP p = load_kp();
            pg8::Gemm g{(const bf16_t*)(p.ws + WS_H), (const bf16_t*)(p.ws + WS_WIN) + (size_t)3072 * (D / 2), M, 4096, D / 2, D / 2, D / 2}; pg8::StaticOrder S; S.init(M, 4096, G, (int)blockIdx.x);
            pg8::EpiStoreBf16 E{(bf16_t*)(p.ws + WS_R0), 4096, 1.0f / (WIN_SCALE * HIN_SCALE)};
            _Pragma("nounroll") for (int rep = 0; rep < NREP(3); ++rep) pg8::gemm_phase<pg8::EpiStoreBf16, pg8::StaticOrder, false, true, true>(lds, g, S, E);
            SEAM(g0 + 3);
        }
        #if DBG_SELFCHECK
        if (EN(4) && IN(g0 + 4)) {
#pragma nounroll
            for (int rep = 0; rep < 2; ++rep) { const KP p = load_kp(); size_t yo = rep ? WS_H : WS_YS; asm volatile("" : "+s"(yo)); phase_s5(p, lds, l, G, yo); SEAM(g0 + 4); }
            const KP p = load_kp();
            const unsigned* a = (const unsigned*)(p.ws + WS_YS); const unsigned* b2 = (const unsigned*)(p.ws + WS_H); unsigned bad = 0;
            for (size_t i = (size_t)blockIdx.x * 512 + opaque_tid(); i < (size_t)M * D / 2; i += (size_t)G * 512) bad += (a[i] != b2[i]) ? 1u : 0u;
            if (bad) atomicAdd((unsigned*)(p.ws + WS_CTL) + 64, bad);
            { const unsigned* h1 = (const unsigned*)(p.ws + WS_CTL) + 65536; const unsigned* h2 = h1 + 8192; const int u2 = blockIdx.x * 512 + opaque_tid();
              if (u2 < 2048) { if (h1[u2 * 4] != h2[u2 * 4]) atomicAdd((unsigned*)(p.ws + WS_CTL) + 128, 1u); if (h1[u2 * 4 + 1] != h2[u2 * 4 + 1]) atomicAdd((unsigned*)(p.ws + WS_CTL) + 192, 1u); if (h1[u2 * 4 + 2] != h2[u2 * 4 + 2]) atomicAdd((unsigned*)(p.ws + WS_CTL) + 256, 1u); } }
            SEAM(g0 + 4); }
#else
        if (EN(4) && IN(g0 + 4)) { _Pragma("nounroll") for (int rep = 0; rep < NREP(4); ++rep) { const KP p = load_kp(); phase_s5(p, lds, l, G, WS_YS); } SEAM(g0 + 4); }
#endif
        if (EN(5) && IN(g0 + 5)) { const KP p = load_kp();
            pg8::Gemm g{(const bf16_t*)(p.ws + WS_YS), (const bf16_t*)(p.ws + WS_WGLU), M, D, D, D, D}; pg8::StaticOrder S; S.init(M, D, G, (int)blockIdx.x);
            pg8::EpiGlu E{(const bf16_t*)(p.ws + WS_R0), (const bf16_t*)(p.ws + WS_YS), (const bf16_t*)(p.ws + WS_OR), (const float*)(p.ws + WS_SSQ), p.in[I_HNG] + l * 128, p.in[I_GLUB] + l * D, (bf16_t*)(p.ws + WS_H)};
            _Pragma("nounroll") for (int rep = 0; rep < NREP(5); ++rep) pg8::gemm_phase<pg8::EpiGlu, pg8::StaticOrder, true, true>(lds, g, S, E);
            SEAM(g0 + 5);
        }
        if (EN(6) && IN(g0 + 6)) { const KP p = load_kp();
            pg8::Gemm g{(const bf16_t*)(p.ws + WS_H), (const bf16_t*)(p.ws + WS_WOUT), M, D, D / 2, D / 2, D / 2}; pg8::StaticOrder S; S.init(M, D, G, (int)blockIdx.x);
            pg8::EpiStoreBf16 E{(bf16_t*)(p.ws + WS_OR), D, 1.0f / (WO_SCALE * MG_SCALE)};
            pg8::gemm_phase<pg8::EpiStoreBf16, pg8::StaticOrder, false, true, true>(lds, g, S, E);
            SEAM(g0 + 6);
        }
        if (EN(7) && IN(g0 + 7)) { const KP p = load_kp();
            const int t2 = opaque_tid(), lane = t2 & 63, wave = __builtin_amdgcn_readfirstlane(t2 >> 6);
            resid_norm_rows((l == 0) ? p.in[I_X] : p.out, p.out, (const bf16_t*)(p.ws + WS_OR), (bf16_t*)(p.ws + WS_H), p.in[I_N2G] + l * D, (const float*)(p.ws + WS_MOD) + (size_t)l * 32 * NMODC, blockIdx.x * 8 + wave, G * 8, lane);
            SEAM(g0 + 7);
        }
        if (EN(8) && IN(g0 + 8)) { const KP p = load_kp();
            pg8::Gemm g{(const bf16_t*)(p.ws + WS_H), (const bf16_t*)(p.ws + WS_WQ), M, 2048, D, D, D}; pg8::StaticOrder S; S.init(M, 2048, G, (int)blockIdx.x);
            pg8::EpiStoreQ E{(bf16_t*)(p.ws + WS_R0)};
            _Pragma("nounroll") for (int rep = 0; rep < NREP(8); ++rep) pg8::gemm_phase<pg8::EpiStoreQ, pg8::StaticOrder, true, true>(lds, g, S, E);
            SEAM(g0 + 8);
        }
        if (EN(9) && IN(g0 + 9)) { _Pragma("nounroll") for (int rep = 0; rep < NREP(9); ++rep) { const KP p = load_kp(); phase_topk(p, lds, G); } SEAM(g0 + 9); }
        if (EN(10) && IN(g0 + 10)) {
            { const KP p = load_kp(); phase_expert_u(p, lds, MISC, G); } xcd_barrier(bar);
            { const KP p = load_kp(); phase_expert_w(p, G); } xcd_barrier(bar);
            { const KP p = load_kp(); phase_expert_v(p, lds, MISC, l, G); }
            SEAM(g0 + 10); }
    }
    if (EN(13) && IN(GP_FINAL)) { const KP p = load_kp(); phase_final(p, G); }
#undef IN
#undef EN
#undef NREP
#undef SEAM
}

extern "C" void kernel_launch(void* const* d_in, const int* in_sizes, int n_in, void* d_out, int out_size, void* d_ws, size_t ws_size, hipStream_t stream) {
    static int grid = 0;
    if (grid == 0) {
        if (n_in != 25 || out_size != M * D || ws_size < WS_END) { fprintf(stderr, "kernel_launch: unexpected shapes (n_in %d, out %d, ws %zu < %zu)\n", n_in, out_size, ws_size, (size_t)WS_END); grid = -1; return; }
        int dev = 0, cus = 0, per_cu = 0;
        if (hipGetDevice(&dev) != hipSuccess || hipDeviceGetAttribute(&cus, hipDeviceAttributeMultiprocessorCount, dev) != hipSuccess) { grid = -1; return; }
        if (hipFuncSetAttribute((const void*)mk_fwd, hipFuncAttributeMaxDynamicSharedMemorySize, LDS_BYTES) != hipSuccess) { fprintf(stderr, "kernel_launch: hipFuncSetAttribute failed\n"); grid = -1; return; }
        if (hipOccupancyMaxActiveBlocksPerMultiprocessor(&per_cu, (const void*)mk_fwd, 512, LDS_BYTES) != hipSuccess || per_cu < 1) fprintf(stderr, "kernel_launch: occupancy query says %d\n", per_cu);
        (void)hipGetLastError();
        grid = cus;
    }
    if (grid < 0) return;
    (void)hipMemsetAsync((char*)d_ws + WS_CTL, 0, CTL_ZERO_BYTES, stream);
    KP a{};
    for (int i = 0; i < 25; ++i) a.in[i] = (const float*)d_in[i];
    a.out = (float*)d_out; a.ws = (unsigned char*)d_ws;
#if MK_LAUNCHES == 1
    a.gp_lo = 0; a.gp_hi = GP_END;
    hipLaunchKernelGGL(mk_fwd, dim3(grid), dim3(512), LDS_BYTES, stream, a);
#else
    for (int gp = 0; gp < GP_END; ++gp) { a.gp_lo = gp; a.gp_hi = gp + 1; hipLaunchKernelGGL(mk_fwd, dim3(grid), dim3(512), LDS_BYTES, stream, a); }
#endif
}
```

```cpp
#include <hip/hip_runtime.h>
#include <cstdio>
#include <cstdint>

#define DBG_HASHSEL 0
#define DBG_H2_FROM_INPUT 0
#define DBG_NO_YA 0
#define DBG_NO_YB 0
#define DBG_NO_ACC 0
#define DBG_NO_GB 0
#define DBG_S5_NOSSM 0
#define DBG_S5_NOREC 0
#define DBG_SELFCHECK 0
#ifndef MK_LAUNCHES
#define MK_LAUNCHES 1
#endif

#define LAS __attribute__((address_space(3)))
typedef unsigned short bf16_t;
typedef short bf16x8 __attribute__((ext_vector_type(8)));
typedef float f32x2 __attribute__((ext_vector_type(2)));
typedef float f32x4 __attribute__((ext_vector_type(4)));
typedef float f32x16 __attribute__((ext_vector_type(16)));
typedef unsigned u32x2 __attribute__((ext_vector_type(2)));
typedef unsigned u32x4 __attribute__((ext_vector_type(4)));
typedef __bf16 bf16v2 __attribute__((ext_vector_type(2)));
typedef int i32x8 __attribute__((ext_vector_type(8)));
typedef int i32x4 __attribute__((ext_vector_type(4)));

constexpr int D = 1024, BATCH = 32, SEQ = 2048, DEPTH = 4, M = BATCH * SEQ;
constexpr int INC = 7168, NMODC = 6 * D;
constexpr int NPH = 11, GP_SETUP = 0, GP_FINAL = 1 + DEPTH * NPH, GP_END = GP_FINAL + 1;
constexpr float EPS = 1e-6f;
constexpr float U_SCALE = 64.0f, V_SCALE = 4.0f;
constexpr float WIN_SCALE = 64.0f, HIN_SCALE = 4.0f;
constexpr float WO_SCALE = 64.0f, MG_SCALE = 8.0f;

constexpr size_t MiB = 1u << 20;
constexpr size_t WS_CTL = 0, CTL_ZERO_BYTES = 1 * MiB;
constexpr size_t WS_MOD = 1 * MiB;
constexpr size_t WS_LB = 4 * MiB;
constexpr size_t WS_ABAR = 4 * MiB + 65536;
constexpr size_t WS_BOP = 5 * MiB;
constexpr size_t WS_COP = 6 * MiB;
constexpr size_t WS_WIN = 8 * MiB;
constexpr size_t WS_WGLU = 22 * MiB;
constexpr size_t WS_WOUT = 24 * MiB;
constexpr size_t WS_WQ = 26 * MiB;
constexpr size_t WS_KEYS = 30 * MiB;
constexpr size_t WS_U = 32 * MiB;
constexpr size_t WS_V = 64 * MiB;
constexpr size_t WS_H = 96 * MiB;
constexpr size_t WS_OR = 224 * MiB;
constexpr size_t WS_SSQ = 352 * MiB;
constexpr size_t WS_R0 = 354 * MiB;
constexpr size_t WS_SEL = WS_R0 + 256 * MiB;
constexpr size_t WS_YS = WS_R0 + 512 * MiB;
constexpr size_t WS_END = WS_YS + 128 * MiB;

constexpr int LDS_BYTES = 147456;
constexpr int MISC_OFF = LDS_BYTES - 256;

__device__ __forceinline__ unsigned pk2(float lo, float hi) { f32x2 v = {lo, hi}; bf16v2 r = __builtin_convertvector(v, bf16v2); return __builtin_bit_cast(unsigned, r); }
__device__ __forceinline__ float bflo(unsigned w) { return __uint_as_float(w << 16); }
__device__ __forceinline__ float bfhi(unsigned w) { return __uint_as_float(w & 0xffff0000u); }
__device__ __forceinline__ float fsigmoid(float x) { return __builtin_amdgcn_rcpf(1.0f + __expf(-x)); }
__device__ __forceinline__ float fsilu(float x) { return x * fsigmoid(x); }
__device__ __forceinline__ float fgelu(float x) { return x * fsigmoid(1.5957691216f * (x + 0.044715f * x * x * x)); }
__device__ __forceinline__ float wave_sum(float v) {
#pragma unroll
    for (int o = 1; o < 64; o <<= 1) v += __shfl_xor(v, o);
    return v;
}
#define LDS_WAIT() asm volatile("s_waitcnt lgkmcnt(0)" ::: "memory")
__device__ __forceinline__ int opaque_tid() { int t = threadIdx.x; asm volatile("" : "+v"(t)); return t; }

namespace pg8 {
#define PG8_LAS __attribute__((address_space(3)))
constexpr int BM = 256, BK = 64, HALF = 128, HTB = HALF * BK * 2, STAGE_BYTES = 8 * HTB, NXCD = 8, WGM = 8;
__host__ __device__ __forceinline__ int lds_byte(int r, int c) { const int st = (r >> 4) * 2 + (c >> 5), rr = r & 15, cc = c & 31, ob = rr * 64 + cc * 2; return st * 1024 + (ob ^ (((ob >> 9) & 1) << 5)); }
__host__ __device__ __forceinline__ void stage_rc(int b, int& R, int& C) { const int st = b / 1024, sb = b % 1024, swz = sb ^ (((sb >> 9) & 1) << 5); R = (st >> 1) * 16 + swz / 64; C = (st & 1) * 32 + (swz % 64) / 2; }
__host__ __device__ __forceinline__ int perm32(int rho) { const int n = rho >> 4, i = rho & 15; return 8 * (i >> 2) + 4 * n + (i & 3); }
struct Unit { int pm, pn; };
struct Gemm { const bf16_t* A; const bf16_t* Bt; int M, N, K, lda, ldb; };
struct StaticOrder {
    int nM, nN, nwg, G, c;
    __host__ __device__ void init(int M_, int N_, int G_, int c_) { nM = M_ / BM; nN = N_ / BM; nwg = nM * nN; G = G_; c = c_; }
    __host__ __device__ bool next(int i, Unit& u) const {
        const long L = (long)i * G + c; if (L >= nwg) return false;
        int wgid = (int)L; { const int q = nwg / NXCD, r = nwg % NXCD, xcd = wgid % NXCD, off = wgid / NXCD; wgid = (xcd < r ? xcd * (q + 1) : r * (q + 1) + (xcd - r) * q) + off; }
        const int nig = WGM * nN, gid = wgid / nig, fm = gid * WGM, gsz = (nM - fm) < WGM ? (nM - fm) : WGM;
        u.pm = fm + ((wgid % nig) % gsz); u.pn = (wgid % nig) / gsz; return true;
    }
    __device__ __forceinline__ void a_ready(const Unit&) const {}
    __device__ __forceinline__ void done(const Unit&) const {}
};
template <class Epi, class Sched, bool ALIGN_EPI = false, bool SP2 = false, bool F8 = false>
__device__ __forceinline__ void gemm_phase(PG8_LAS unsigned char* lds, const Gemm g, const Sched& S, const Epi& E) {
    const int tid = opaque_tid(), wid = __builtin_amdgcn_readfirstlane(tid >> 6), lane = tid & 63, wr = wid >> 2, wc = wid & 3, fr = lane & 15, fq = lane >> 4;
    const int K = g.K, nt = K / BK;
    unsigned voffA[2], voffB[2];
#pragma unroll
    for (int i = 0; i < 2; ++i) { int R, C; stage_rc(tid * 16 + i * 8192, R, C); const int Rb = Epi::PERM ? ((R & ~31) + perm32(R & 31)) : R;
        voffA[i] = (unsigned)(R * g.lda + C) * 2u; voffB[i] = (unsigned)(Rb * g.ldb + C) * 2u; }
    const size_t kstep = (size_t)(BK * 2);
    const size_t hstepA = (size_t)HALF * g.lda * 2, hstepB = (size_t)HALF * g.ldb * 2;
    const size_t tstepA = 2 * hstepA, tstepB = 2 * hstepB;
    const unsigned ldsw = (unsigned)wid * 1024u;
    const int aoff = lds_byte(wr * 64 + fr, fq * 8), boff = lds_byte(wc * 32 + fr, fq * 8);
#define PG8_SA(b, h) (((b) * 2 + (h)) * HTB)
#define PG8_SB(b, h) ((4 + (b) * 2 + (h)) * HTB)
#define PG8_STAGE(bufoff, gbase, voff) do { _Pragma("unroll") for (int _i = 0; _i < 2; ++_i) \
        __builtin_amdgcn_global_load_lds((const unsigned*)((const char*)(gbase) + (voff)[_i]), (PG8_LAS unsigned*)(lds + (bufoff) + ldsw + _i * 8192), 16, 0, 0); } while (0)
#define PG8_LD8(p) __builtin_shufflevector(*(const PG8_LAS i32x4*)(p), *(const PG8_LAS i32x4*)((p) + 1024), 0, 1, 2, 3, 4, 5, 6, 7)
#define PG8_LDA(dst, b, h) do { if constexpr (F8) { _Pragma("unroll") for (int m = 0; m < 4; ++m) dst##8[m] = PG8_LD8(lds + PG8_SA(b, h) + aoff + m * 2048); } \
        else { _Pragma("unroll") for (int m = 0; m < 4; ++m) _Pragma("unroll") for (int k = 0; k < 2; ++k) dst[m][k] = *(const PG8_LAS bf16x8*)(lds + PG8_SA(b, h) + aoff + m * 2048 + k * 1024); } } while (0)
#define PG8_LDB(dst, b, h) do { if constexpr (F8) { _Pragma("unroll") for (int n = 0; n < 2; ++n) dst##8[n] = PG8_LD8(lds + PG8_SB(b, h) + boff + n * 2048); } \
        else { _Pragma("unroll") for (int n = 0; n < 2; ++n) _Pragma("unroll") for (int k = 0; k < 2; ++k) dst[n][k] = *(const PG8_LAS bf16x8*)(lds + PG8_SB(b, h) + boff + n * 2048 + k * 1024); } } while (0)
#define PG8_MMA(ai, bj, At, Bt) do { __builtin_amdgcn_s_setprio(1); _Pragma("unroll") for (int m = 0; m < 4; ++m) _Pragma("unroll") for (int n = 0; n < 2; ++n) { \
        if constexpr (F8) {   \
            acc[ai][bj][m][n] = __builtin_amdgcn_mfma_scale_f32_16x16x128_f8f6f4(Bt##8[n], At##8[m], acc[ai][bj][m][n], 0, 0, 0, 0x7f7f7f7f, 0, 0x7f7f7f7f); \
        } else { _Pragma("unroll") for (int k = 0; k < 2; ++k) acc[ai][bj][m][n] = __builtin_amdgcn_mfma_f32_16x16x32_bf16(Bt[n][k], At[m][k], acc[ai][bj][m][n], 0, 0, 0); } } \
        __builtin_amdgcn_s_setprio(0); } while (0)
#define PG8_WAIT_V(n) asm volatile("s_waitcnt vmcnt(" #n ")" ::: "memory")
#define PG8_WAIT_L(n) asm volatile("s_waitcnt lgkmcnt(" #n ")" ::: "memory")
#define PG8_BAR __builtin_amdgcn_s_barrier()
#define PG8_SCHED __builtin_amdgcn_sched_barrier(0)
    Unit cur, nxt; int ui = 0;
    if (!S.next(0, cur)) return;
    f32x4 acc[2][2][4][2];
#pragma unroll
    for (int a = 0; a < 2; ++a)
#pragma unroll
        for (int b = 0; b < 2; ++b)
#pragma unroll
            for (int m = 0; m < 4; ++m)
#pragma unroll
                for (int n = 0; n < 2; ++n) acc[a][b][m][n] = (f32x4){0.f, 0.f, 0.f, 0.f};
    bf16x8 At[4][2], B0[2][2], B1[2][2]; i32x8 At8[4], B08[2], B18[2];
    const char* cA = (const char*)g.A + (size_t)cur.pm * tstepA; const char* cB = (const char*)g.Bt + (size_t)cur.pn * tstepB;
    S.a_ready(cur);
    if constexpr (SP2) {
        PG8_STAGE(PG8_SB(0, 0), cB, voffB); PG8_STAGE(PG8_SB(0, 1), cB + hstepB, voffB); PG8_STAGE(PG8_SA(0, 0), cA, voffA); PG8_STAGE(PG8_SA(0, 1), cA + hstepA, voffA);
        if (wr == 1) PG8_BAR;
        PG8_WAIT_V(2); PG8_BAR;
        PG8_STAGE(PG8_SB(1, 0), cB + kstep, voffB); PG8_STAGE(PG8_SA(1, 0), cA + kstep, voffA); PG8_STAGE(PG8_SB(1, 1), cB + hstepB + kstep, voffB);
        PG8_WAIT_V(6); PG8_BAR;
    } else {
        PG8_STAGE(PG8_SB(0, 0), cB, voffB); PG8_STAGE(PG8_SA(0, 0), cA, voffA); PG8_STAGE(PG8_SB(0, 1), cB + hstepB, voffB); PG8_STAGE(PG8_SA(0, 1), cA + hstepA, voffA);
        if (wr == 1) PG8_BAR;
        PG8_WAIT_V(4); PG8_BAR;
        PG8_STAGE(PG8_SB(1, 0), cB + kstep, voffB); PG8_STAGE(PG8_SA(1, 0), cA + kstep, voffA); PG8_STAGE(PG8_SB(1, 1), cB + hstepB + kstep, voffB);
        PG8_WAIT_V(6); PG8_BAR;
    }
    for (;;) {
        const bool has_next = S.next(ui + 1, nxt);
        const char* nA = has_next ? (const char*)g.A + (size_t)nxt.pm * tstepA : cA; const char* nB = has_next ? (const char*)g.Bt + (size_t)nxt.pn * tstepB : cB;
        for (int t = 0; t < nt; t += 2) {
            const bool last = (t == nt - 2);
            const char* a1 = cA + (size_t)(t + 1) * kstep;
            const char* a2 = last ? nA : cA + (size_t)(t + 2) * kstep; const char* b2 = last ? nB : cB + (size_t)(t + 2) * kstep;
            const char* a3 = a2 + kstep; const char* b3 = b2 + kstep;
            if (last && has_next) S.a_ready(nxt);
            if constexpr (SP2) {
            PG8_LDB(B0, 0, 0); PG8_LDB(B1, 0, 1); PG8_SCHED; PG8_LDA(At, 0, 0); PG8_STAGE(PG8_SA(1, 1), a1 + hstepA, voffA);
            PG8_WAIT_V(8); PG8_WAIT_L(0); PG8_BAR; PG8_MMA(0, 0, At, B0); PG8_MMA(0, 1, At, B1); PG8_BAR; PG8_SCHED;
            PG8_LDA(At, 0, 1); PG8_STAGE(PG8_SB(0, 0), b2, voffB); PG8_STAGE(PG8_SB(0, 1), b2 + hstepB, voffB); PG8_STAGE(PG8_SA(0, 0), a2, voffA);
            PG8_WAIT_V(8); PG8_WAIT_L(0); PG8_BAR; PG8_MMA(1, 0, At, B0); PG8_MMA(1, 1, At, B1); PG8_BAR; PG8_SCHED;
            PG8_LDB(B0, 1, 0); PG8_LDB(B1, 1, 1); PG8_SCHED; PG8_LDA(At, 1, 0); PG8_STAGE(PG8_SA(0, 1), a2 + hstepA, voffA);
            PG8_WAIT_V(8); PG8_WAIT_L(0); PG8_BAR; PG8_MMA(0, 0, At, B0); PG8_MMA(0, 1, At, B1); PG8_BAR; PG8_SCHED;
            PG8_LDA(At, 1, 1); PG8_STAGE(PG8_SB(1, 0), b3, voffB); PG8_STAGE(PG8_SB(1, 1), b3 + hstepB, voffB); PG8_STAGE(PG8_SA(1, 0), a3, voffA);
            PG8_WAIT_V(8); PG8_WAIT_L(0); PG8_BAR; PG8_MMA(1, 0, At, B0); PG8_MMA(1, 1, At, B1); PG8_BAR; PG8_SCHED;
            } else {
            PG8_LDB(B0, 0, 0); PG8_SCHED; PG8_LDA(At, 0, 0); PG8_STAGE(PG8_SA(1, 1), a1 + hstepA, voffA);
            PG8_WAIT_L(8); PG8_BAR; PG8_WAIT_L(0); PG8_MMA(0, 0, At, B0); PG8_BAR; PG8_SCHED;
            PG8_LDB(B1, 0, 1); PG8_STAGE(PG8_SB(0, 0), b2, voffB);
            PG8_BAR; PG8_WAIT_L(0); PG8_MMA(0, 1, At, B1); PG8_BAR;
            PG8_LDA(At, 0, 1); PG8_STAGE(PG8_SA(0, 0), a2, voffA);
            PG8_BAR; PG8_WAIT_L(0); PG8_MMA(1, 0, At, B0); PG8_BAR; PG8_SCHED;
            PG8_STAGE(PG8_SB(0, 1), b2 + hstepB, voffB);
            PG8_WAIT_V(6); PG8_BAR; PG8_MMA(1, 1, At, B1); PG8_BAR;
            PG8_LDB(B0, 1, 0); PG8_SCHED; PG8_LDA(At, 1, 0); PG8_STAGE(PG8_SA(0, 1), a2 + hstepA, voffA);
            PG8_WAIT_L(8); PG8_BAR; PG8_WAIT_L(0); PG8_MMA(0, 0, At, B0); PG8_BAR; PG8_SCHED;
            PG8_LDB(B1, 1, 1); PG8_STAGE(PG8_SB(1, 0), b3, voffB);
            PG8_BAR; PG8_WAIT_L(0); PG8_MMA(0, 1, At, B1); PG8_BAR;
            PG8_LDA(At, 1, 1); PG8_STAGE(PG8_SA(1, 0), a3, voffA);
            PG8_BAR; PG8_WAIT_L(0); PG8_MMA(1, 0, At, B0); PG8_BAR; PG8_SCHED;
            PG8_STAGE(PG8_SB(1, 1), b3 + hstepB, voffB);
            PG8_WAIT_V(6); PG8_BAR; PG8_MMA(1, 1, At, B1); PG8_BAR;
            }
        }
        if constexpr (ALIGN_EPI) { if (wr == 0) PG8_BAR; }
        E(acc, cur, wr, wc, fr, fq);
        if (!has_next) break;
#pragma unroll
        for (int a = 0; a < 2; ++a)
#pragma unroll
            for (int b = 0; b < 2; ++b)
#pragma unroll
                for (int m = 0; m < 4; ++m)
#pragma unroll
                    for (int n = 0; n < 2; ++n) acc[a][b][m][n] = (f32x4){0.f, 0.f, 0.f, 0.f};
        cur = nxt; cA = nA; cB = nB; ++ui;
        if constexpr (ALIGN_EPI) { if (wr == 1) PG8_BAR; }
    }
    PG8_WAIT_V(0);
    if constexpr (!ALIGN_EPI) { if (wr == 0) PG8_BAR; }
    PG8_BAR;
#undef PG8_SA
#undef PG8_SB
#undef PG8_STAGE
#undef PG8_LDA
#undef PG8_LD8
#undef PG8_LDB
#undef PG8_MMA
#undef PG8_WAIT_V
#undef PG8_WAIT_L
#undef PG8_BAR
#undef PG8_SCHED
}

struct EpiStoreBf16 {
    static constexpr bool PERM = true;
    bf16_t* O; int ldc; float scale;
    __device__ __forceinline__ void operator()(const f32x4 (&acc)[2][2][4][2], const Unit& u, int wr, int wc, int fr, int fq) const {
        const int row0 = u.pm * BM + wr * 64 + fr, col0 = u.pn * BM + wc * 32 + 8 * fq;
#pragma unroll
        for (int ai = 0; ai < 2; ++ai)
#pragma unroll
            for (int m = 0; m < 4; ++m) { bf16_t* rowp = O + (size_t)(row0 + ai * HALF + m * 16) * ldc + col0;
#pragma unroll
                for (int bj = 0; bj < 2; ++bj) { const f32x4 v0 = acc[ai][bj][m][0] * scale, v1 = acc[ai][bj][m][1] * scale;
                    u32x4 w; w.x = pk2(v0[0], v0[1]); w.y = pk2(v0[2], v0[3]); w.z = pk2(v1[0], v1[1]); w.w = pk2(v1[2], v1[3]);
                    *(u32x4*)(rowp + bj * HALF) = w; } }
    }
};
struct EpiStoreQ {
    static constexpr bool PERM = true;
    bf16_t* O;
    __device__ __forceinline__ void operator()(const f32x4 (&acc)[2][2][4][2], const Unit& u, int wr, int wc, int fr, int fq) const {
        const int row0 = u.pm * BM + wr * 64 + fr, col0 = u.pn * BM + wc * 32 + 8 * fq;
#pragma unroll
        for (int ai = 0; ai < 2; ++ai)
#pragma unroll
            for (int m = 0; m < 4; ++m) { const int row = row0 + ai * HALF + m * 16, tg = row >> 5, t = row & 31;
#pragma unroll
                for (int bj = 0; bj < 2; ++bj) { const int c0 = col0 + bj * HALF, h = c0 >> 8, pp = (c0 >> 7) & 1, cc = c0 & 127, ks = cc >> 4, hh = (cc >> 3) & 1;
                    const f32x4 v0 = acc[ai][bj][m][0], v1 = acc[ai][bj][m][1];
                    u32x4 w; w.x = pk2(v0[0], v0[1]); w.y = pk2(v0[2], v0[3]); w.z = pk2(v1[0], v1[1]); w.w = pk2(v1[2], v1[3]);
                    *(u32x4*)(O + ((size_t)((((tg * 8 + h) * 2 + pp) * 8 + ks) * 64 + hh * 32 + t)) * 8) = w; } }
    }
};
struct EpiWout {
    static constexpr bool PERM = false;
    const float* xs; float* out; const float* g1;
    __device__ __forceinline__ void operator()(const f32x4 (&acc)[2][2][4][2], const Unit& u, int wr, int wc, int fr, int fq) const {
        const int row0 = u.pm * BM + wr * 64 + fr, col0 = u.pn * BM + wc * 32 + 4 * fq;
        const int b = (u.pm * BM) >> 11;
        f32x4 gv[2][2];
#pragma unroll
        for (int bj = 0; bj < 2; ++bj)
#pragma unroll
            for (int n = 0; n < 2; ++n) gv[bj][n] = *(const f32x4*)(g1 + (size_t)b * NMODC + col0 + bj * HALF + n * 16);
#pragma unroll
        for (int ai = 0; ai < 2; ++ai)
#pragma unroll
            for (int m = 0; m < 4; ++m) { const size_t off = (size_t)(row0 + ai * HALF + m * 16) * D + col0;
#pragma unroll
                for (int bj = 0; bj < 2; ++bj)
#pragma unroll
                    for (int n = 0; n < 2; ++n) { const f32x4 xv = *(const f32x4*)(xs + off + bj * HALF + n * 16);
                        *(f32x4*)(out + off + bj * HALF + n * 16) = xv + gv[bj][n] * acc[ai][bj][m][n]; } }
    }
};
struct EpiGlu {
    static constexpr bool PERM = true;
    const bf16_t* PB; const bf16_t* YS; const bf16_t* ORAW; const float* SSQ; const float* ng; const float* gb_; bf16_t* O;
    __device__ __forceinline__ void operator()(const f32x4 (&acc)[2][2][4][2], const Unit& u, int wr, int wc, int fr, int fq) const {
        const int row0 = u.pm * BM + wr * 64 + fr, col0 = u.pn * BM + wc * 32 + 8 * fq;
#pragma unroll
        for (int bj = 0; bj < 2; ++bj) {
            const int c = col0 + bj * HALF, head = c >> 7;
            const f32x4 n0 = *(const f32x4*)(ng + (c & 127)), n1 = *(const f32x4*)(ng + (c & 127) + 4);
            const f32x4 b0 = *(const f32x4*)(gb_ + c), b1 = *(const f32x4*)(gb_ + c + 4);
            const float ngv[8] = {n0[0], n0[1], n0[2], n0[3], n1[0], n1[1], n1[2], n1[3]};
            const float bbv[8] = {b0[0], b0[1], b0[2], b0[3], b1[0], b1[1], b1[2], b1[3]};
#pragma unroll
            for (int ai = 0; ai < 2; ++ai)
#pragma unroll
                for (int m = 0; m < 4; ++m) {
                    const int row = row0 + ai * HALF + m * 16;
                    const bf16_t* pb = PB + (size_t)row * 4096 + c;
                    const u32x4 og = *(const u32x4*)(pb), ys = *(const u32x4*)(YS + (size_t)row * D + c), ga = *(const u32x4*)(pb + 2048), gb = *(const u32x4*)(pb + 3072);
                    const u32x4 orw = *(const u32x4*)(ORAW + (size_t)row * D + c);
                    const float rstd = __builtin_amdgcn_rsqf(SSQ[(size_t)row * 8 + head] * (1.0f / 128.0f) + EPS);
                    const f32x4 a0 = acc[ai][bj][m][0], a1 = acc[ai][bj][m][1];
                    const float av[8] = {a0[0], a0[1], a0[2], a0[3], a1[0], a1[1], a1[2], a1[3]};
                    float res[8];
#pragma unroll
                    for (int j = 0; j < 8; ++j) {
                        const unsigned wog = og[j >> 1], wys = ys[j >> 1], wga = ga[j >> 1], wgb = gb[j >> 1], wor = orw[j >> 1];
                        const float fog = (j & 1) ? bfhi(wog) : bflo(wog), fys = (j & 1) ? bfhi(wys) : bflo(wys), fga = (j & 1) ? bfhi(wga) : bflo(wga),
                                    fgb = (j & 1) ? bfhi(wgb) : bflo(wgb), fo = (j & 1) ? bfhi(wor) : bflo(wor);
                        const float ya = fo * rstd * ngv[j] * fsilu(fog);
                        const float yb = fys * fsigmoid((DBG_NO_ACC ? 0.f : av[j]) + bbv[j]);
                        res[j] = (DBG_NO_YA ? 0.f : fsigmoid(fga) * ya) + (DBG_NO_YB ? 0.f : (DBG_NO_GB ? 0.5f : fsigmoid(fgb)) * yb);
                    }
                    int w0 = 0, w1 = 0;
                    w0 = __builtin_amdgcn_cvt_pk_fp8_f32(res[0] * MG_SCALE, res[1] * MG_SCALE, w0, false); w0 = __builtin_amdgcn_cvt_pk_fp8_f32(res[2] * MG_SCALE, res[3] * MG_SCALE, w0, true);
                    w1 = __builtin_amdgcn_cvt_pk_fp8_f32(res[4] * MG_SCALE, res[5] * MG_SCALE, w1, false); w1 = __builtin_amdgcn_cvt_pk_fp8_f32(res[6] * MG_SCALE, res[7] * MG_SCALE, w1, true);
                    *(u32x2*)((unsigned char*)O + (size_t)row * D + c) = (u32x2){(unsigned)w0, (unsigned)w1};
                }
        }
    }
};
}

#define XB_TMO      128
#define XB_XCNT(j)  (256  + 64 * (j))
#define XB_XSUB(j)  (1280 + 64 * (j))
#define XB_XGEN(j)  (2304 + 64 * (j))
#define XB_TOP      3328
#define XB_TOPGEN   3392
#define XCD_BAR_WORDS 3456
#define XB_SPIN_CAP (1u << 25)
__device__ __forceinline__ unsigned xb_ld(unsigned* p)              { return __hip_atomic_load(p, __ATOMIC_RELAXED, __HIP_MEMORY_SCOPE_AGENT); }
__device__ __forceinline__ unsigned xb_add(unsigned* p, unsigned v) { return __hip_atomic_fetch_add(p, v, __ATOMIC_RELAXED, __HIP_MEMORY_SCOPE_AGENT); }
__device__ __forceinline__ unsigned xb_xcc_id() { return (unsigned)__builtin_amdgcn_s_getreg((3 << 11) | 20) & 0xFu; }
#define XB_SPIN(cond, bar) do { unsigned _sp = 0; while (cond) { __builtin_amdgcn_s_sleep(1); \
    if ((++_sp & 255u) == 0u) { if (xb_ld(&(bar)[XB_TMO])) break; if (_sp > XB_SPIN_CAP) { atomicAdd(&(bar)[XB_TMO], 1u); break; } } } } while (0)
struct XcdBarrier { unsigned* bar; unsigned x; volatile LAS unsigned* st; };
__device__ __forceinline__ XcdBarrier xcd_barrier_post(unsigned* bar, volatile LAS unsigned* st) {
    XcdBarrier b; b.bar = bar; b.x = xb_xcc_id(); b.st = st;
    if (threadIdx.x == 0) (void)xb_add(&bar[XB_XCNT(b.x)], 1u);
    return b;
}
__device__ __forceinline__ void xcd_barrier_complete(unsigned* bar, unsigned x, unsigned& nloc, unsigned& nx) {
    const unsigned G = gridDim.x * gridDim.y * gridDim.z;
    unsigned sum, cnt, mine, sp = 0u;
    for (;;) {
        sum = 0u; cnt = 0u; mine = 0u;
#pragma unroll
        for (unsigned j = 0; j < 16; ++j) { const unsigned c = xb_ld(&bar[XB_XCNT(j)]); sum += c; cnt += (c > 0u) ? 1u : 0u; mine = (j == x) ? c : mine; }
        if (sum == G) break;
        __builtin_amdgcn_s_sleep(1);
        if ((++sp & 255u) == 0u) { if (xb_ld(&bar[XB_TMO])) break; if (sp > XB_SPIN_CAP) { atomicAdd(&bar[XB_TMO], 1u); break; } }
    }
    nloc = mine > 0u ? mine : 1u; nx = cnt > 0u ? cnt : 1u;
}
__device__ __forceinline__ void xcd_barrier(const XcdBarrier& b) {
    asm volatile("s_waitcnt vmcnt(0)" ::: "memory");
    __syncthreads();
    if (threadIdx.x == 0) {
        unsigned* bar = b.bar;
        __builtin_amdgcn_s_waitcnt(0);
        unsigned nloc = b.st[0], nx = b.st[1];
        if (nloc == 0u) { xcd_barrier_complete(bar, b.x, nloc, nx); b.st[0] = nloc; b.st[1] = nx; }
        const unsigned old = xb_add(&bar[XB_XSUB(b.x)], 1u);
        const unsigned gen = old / nloc;
        if (old + 1u == (gen + 1u) * nloc) {
            __builtin_amdgcn_fence(__ATOMIC_RELEASE, "agent");
            asm volatile("s_waitcnt vmcnt(0)" ::: "memory");
            const unsigned og = xb_add(&bar[XB_TOP], 1u);
            const unsigned tg = og / nx;
            if (og + 1u == (tg + 1u) * nx) xb_add(&bar[XB_TOPGEN], 1u);
            else XB_SPIN(xb_ld(&bar[XB_TOPGEN]) == tg, bar);
            __builtin_amdgcn_fence(__ATOMIC_ACQUIRE, "agent");
            xb_add(&bar[XB_XGEN(b.x)], 1u);
            asm volatile("s_waitcnt vmcnt(0)" ::: "memory");
        } else {
            XB_SPIN(xb_ld(&bar[XB_XGEN(b.x)]) == gen, bar);
            __builtin_amdgcn_fence(__ATOMIC_ACQUIRE, "agent");
            asm volatile("s_waitcnt vmcnt(0)" ::: "memory");
        }
    }
    __syncthreads();
}

struct KP { const float* in[25]; float* out; unsigned char* ws; int gp_lo, gp_hi; };
enum { I_X = 0, I_C, I_ADAW, I_ADAB, I_N1G, I_N2G, I_WIN, I_LBL, I_HNG, I_ARE, I_AIM, I_LDT, I_BRE, I_BIM, I_CRE, I_CIM, I_S5D, I_GLUW, I_GLUB, I_WOUT, I_WQ, I_SUBK, I_PU, I_PV, I_FG };

typedef const KP __attribute__((address_space(4)))* kp_cptr;
__device__ __forceinline__ KP load_kp() {
#if defined(__HIP_DEVICE_COMPILE__)
    unsigned long long a = (unsigned long long)__builtin_amdgcn_kernarg_segment_ptr(); asm volatile("" : "+s"(a)); return *(kp_cptr)a;
#else
    return KP{};
#endif
}

__device__ __forceinline__ void phase_setup(const KP& p, LAS unsigned char* lds, int G) {
    const int tid = opaque_tid();
    {
        LAS float* cact = (LAS float*)lds;
        for (int it = blockIdx.x; it < 4 * 48; it += G) {
            for (int i = tid; i < 32 * 1024; i += 512) cact[i] = fsilu(p.in[I_C][i]);
            __syncthreads();
            const int l = it / 48, cb = it % 48, col = cb * 128 + (tid & 127), bg = tid >> 7;
            const float* W = p.in[I_ADAW] + (size_t)l * D * NMODC + col;
            float acc[8];
#pragma unroll
            for (int j = 0; j < 8; ++j) acc[j] = 0.f;
            for (int k4 = 0; k4 < 256; ++k4) {
                const float w0 = W[(size_t)(4 * k4 + 0) * NMODC], w1 = W[(size_t)(4 * k4 + 1) * NMODC], w2 = W[(size_t)(4 * k4 + 2) * NMODC], w3 = W[(size_t)(4 * k4 + 3) * NMODC];
#pragma unroll
                for (int j = 0; j < 8; ++j) { const f32x4 c4 = *(const LAS f32x4*)(cact + (8 * bg + j) * 1024 + 4 * k4); acc[j] += c4[0] * w0 + c4[1] * w1 + c4[2] * w2 + c4[3] * w3; }
            }
            float* MOD = (float*)(p.ws + WS_MOD);
            const float bias = p.in[I_ADAB][l * NMODC + col];
#pragma unroll
            for (int j = 0; j < 8; ++j) MOD[((size_t)l * 32 + 8 * bg + j) * NMODC + col] = acc[j] + bias;
            __syncthreads();
        }
    }
    const int gtid = blockIdx.x * 512 + tid;
    if (gtid < 1024) {
        const float* lg = p.in[I_LBL]; float v[4], mx = -1e30f;
#pragma unroll
        for (int l = 0; l < 4; ++l) { v[l] = lg[l * 1024 + gtid]; mx = fmaxf(mx, v[l]); }
        float s = 0.f;
#pragma unroll
        for (int l = 0; l < 4; ++l) { v[l] = __expf(v[l] - mx); s += v[l]; }
        float* LB = (float*)(p.ws + WS_LB); float cum = 0.f; const float first = v[0] / s;
#pragma unroll
        for (int l = 0; l < 4; ++l) { cum += v[l] / s; LB[l * 1024 + gtid] = (l == 0) ? 0.f : (cum - first); }
    }
    if (gtid >= 1024 && gtid < 1024 + 16384) {
        const int id = gtid - 1024, lg = id >> 6, pp = id & 63;
        const float a_re = p.in[I_ARE][id], a_im = p.in[I_AIM][id];
        const float step = expf(p.in[I_LDT][lg]);
        const float mag = expf(step * a_re), ang = step * a_im;
        const float ab_re = mag * cosf(ang), ab_im = mag * sinf(ang);
        const float den = a_re * a_re + a_im * a_im;
        const float z_re = ((ab_re - 1.0f) * a_re + ab_im * a_im) / den;
        const float z_im = (ab_im * a_re - (ab_re - 1.0f) * a_im) / den;
        float* ABAR = (float*)(p.ws + WS_ABAR); ABAR[2 * id] = ab_re; ABAR[2 * id + 1] = ab_im;
        bf16_t* BOP = (bf16_t*)(p.ws + WS_BOP); bf16_t* COP = (bf16_t*)(p.ws + WS_COP);
        const float* bre = p.in[I_BRE] + (size_t)id * 16; const float* bim = p.in[I_BIM] + (size_t)id * 16;
#pragma unroll
        for (int c = 0; c < 16; ++c) {
            const float br = bre[c], bi = bim[c];
            const float rr = z_re * br - z_im * bi, ii = z_re * bi + z_im * br;
            BOP[((size_t)lg * 128 + 2 * pp) * 16 + c] = (bf16_t)(pk2(rr, 0.f) & 0xffffu);
            BOP[((size_t)lg * 128 + 2 * pp + 1) * 16 + c] = (bf16_t)(pk2(ii, 0.f) & 0xffffu);
            const float cr = p.in[I_CRE][((size_t)lg * 16 + c) * 64 + pp], ci = p.in[I_CIM][((size_t)lg * 16 + c) * 64 + pp];
            COP[((size_t)lg * 16 + c) * 128 + 2 * pp] = (bf16_t)(pk2(cr, 0.f) & 0xffffu);
            COP[((size_t)lg * 16 + c) * 128 + 2 * pp + 1] = (bf16_t)(pk2(-ci, 0.f) & 0xffffu);
        }
    }
}

__device__ __forceinline__ void transpose_item(const float* W, int K, int N, bf16_t* WT, LAS float* scr, int item, int lane) {
    const int nblk = N / 32, kb = item / nblk, nb = item % nblk, k0 = 64 * kb, n0 = 32 * nb;
#pragma unroll 8
    for (int i = 0; i < 32; ++i) { const int kk = 2 * i + (lane >> 5); scr[kk * 33 + (lane & 31)] = W[(size_t)(k0 + kk) * N + n0 + (lane & 31)]; }
    LDS_WAIT();
    const int c = lane & 7;
#pragma unroll
    for (int j = 0; j < 4; ++j) { const int n = (lane >> 3) + 8 * j; const LAS float* s = scr + (8 * c) * 33 + n;
        u32x4 o; o.x = pk2(s[0 * 33], s[1 * 33]); o.y = pk2(s[2 * 33], s[3 * 33]); o.z = pk2(s[4 * 33], s[5 * 33]); o.w = pk2(s[6 * 33], s[7 * 33]);
        *(u32x4*)(WT + (size_t)(n0 + n) * K + k0 + 8 * c) = o; }
    LDS_WAIT();
}
__device__ __forceinline__ void cvt_f32_fp8(const float* src, unsigned char* dst, size_t n4, size_t gtid, size_t nthr, float scale) {
    for (size_t i = gtid; i < n4; i += nthr) { const f32x4 v = ((const f32x4*)src)[i] * scale; int w = 0;
        w = __builtin_amdgcn_cvt_pk_fp8_f32(v[0], v[1], w, false); w = __builtin_amdgcn_cvt_pk_fp8_f32(v[2], v[3], w, true); ((unsigned*)dst)[i] = (unsigned)w; }
}
__device__ __forceinline__ void cvt_f32_fp8_sliced(const float* src, unsigned char* dst, size_t gtid, size_t nthr, float scale) {
    for (size_t i = gtid; i < (size_t)16384 * 64; i += nthr) {
        const size_t e = i >> 6; const int sl = (int)(i & 63) >> 3, c = (int)(i & 7);
        const f32x4* sp = (const f32x4*)(src + e * 1024 + sl * 128 + c * 16); u32x4 o;
#pragma unroll
        for (int q = 0; q < 4; ++q) { const f32x4 v = sp[q] * scale; int w = 0; w = __builtin_amdgcn_cvt_pk_fp8_f32(v[0], v[1], w, false); w = __builtin_amdgcn_cvt_pk_fp8_f32(v[2], v[3], w, true); o[q] = (unsigned)w; }
        *(u32x4*)(dst + ((size_t)sl * 16384 + e) * 128 + c * 16) = o;
    }
}
__device__ __forceinline__ void transpose_item_fp8(const float* W, int K, int N, unsigned char* WT, LAS float* scr, int item, int lane, float scale) {
    const int nblk = N / 32, kb = item / nblk, nb = item % nblk, k0 = 64 * kb, n0 = 32 * nb;
#pragma unroll 8
    for (int i = 0; i < 32; ++i) { const int kk = 2 * i + (lane >> 5); scr[kk * 33 + (lane & 31)] = W[(size_t)(k0 + kk) * N + n0 + (lane & 31)]; }
    LDS_WAIT();
    const int c = lane & 7;
#pragma unroll
    for (int j = 0; j < 4; ++j) { const int n = (lane >> 3) + 8 * j; const LAS float* sp = scr + (8 * c) * 33 + n;
        int w0 = 0, w1 = 0;
        w0 = __builtin_amdgcn_cvt_pk_fp8_f32(sp[0 * 33] * scale, sp[1 * 33] * scale, w0, false); w0 = __builtin_amdgcn_cvt_pk_fp8_f32(sp[2 * 33] * scale, sp[3 * 33] * scale, w0, true);
        w1 = __builtin_amdgcn_cvt_pk_fp8_f32(sp[4 * 33] * scale, sp[5 * 33] * scale, w1, false); w1 = __builtin_amdgcn_cvt_pk_fp8_f32(sp[6 * 33] * scale, sp[7 * 33] * scale, w1, true);
        *(u32x2*)(WT + (size_t)(n0 + n) * K + k0 + 8 * c) = (u32x2){(unsigned)w0, (unsigned)w1}; }
    LDS_WAIT();
}
__device__ __forceinline__ void cvt_f32_bf16(const float* src, bf16_t* dst, size_t n4, size_t gtid, size_t nthr) {
    for (size_t i = gtid; i < n4; i += nthr) { const f32x4 v = ((const f32x4*)src)[i]; u32x2 o; o.x = pk2(v[0], v[1]); o.y = pk2(v[2], v[3]); ((u32x2*)dst)[i] = o; }
}
template <bool F8OUT, bool XBF>
__device__ __forceinline__ void norm_rows(const float* xsrc, bf16_t* hdst, const float* gain, const float* mod_l, int sh_off, int sc_off, int gw, int ngw, int lane) {
    for (int r0 = gw * 4; r0 < M; r0 += ngw * 4) {
        const int b = r0 >> 11;
        f32x4 v[4][4]; float ss[4];
#pragma unroll
        for (int i = 0; i < 4; ++i) {
            if constexpr (XBF) { const u32x2* xr = (const u32x2*)((const bf16_t*)xsrc + (size_t)(r0 + i) * D) + lane;
#pragma unroll
                for (int j = 0; j < 4; ++j) { const u32x2 xw = xr[64 * j]; v[i][j] = (f32x4){bflo(xw[0]), bfhi(xw[0]), bflo(xw[1]), bfhi(xw[1])}; } }
            else { const f32x4* xr = (const f32x4*)(xsrc + (size_t)(r0 + i) * D) + lane;
#pragma unroll
                for (int j = 0; j < 4; ++j) v[i][j] = xr[64 * j]; } }
#pragma unroll
        for (int i = 0; i < 4; ++i) { float t = 0.f;
#pragma unroll
            for (int j = 0; j < 4; ++j) t += (v[i][j][0] * v[i][j][0] + v[i][j][1] * v[i][j][1]) + (v[i][j][2] * v[i][j][2] + v[i][j][3] * v[i][j][3]);
            ss[i] = t; }
#pragma unroll
        for (int o = 1; o < 64; o <<= 1) {
#pragma unroll
            for (int i = 0; i < 4; ++i) ss[i] += __shfl_xor(ss[i], o); }
        const float* mb = mod_l + (size_t)b * NMODC;
#pragma unroll
        for (int j = 0; j < 4; ++j) { const int col = 256 * j + 4 * lane;
            const f32x4 g4 = *(const f32x4*)(gain + col), sc = *(const f32x4*)(mb + sc_off + col), sh = *(const f32x4*)(mb + sh_off + col);
            const f32x4 gs = g4 * (sc + 1.0f);
#pragma unroll
            for (int i = 0; i < 4; ++i) { const float rstd = __builtin_amdgcn_rsqf(ss[i] * (1.0f / D) + EPS);
                const f32x4 h = v[i][j] * rstd * gs + sh;
                if constexpr (F8OUT) { int w8 = 0; w8 = __builtin_amdgcn_cvt_pk_fp8_f32(h[0] * HIN_SCALE, h[1] * HIN_SCALE, w8, false); w8 = __builtin_amdgcn_cvt_pk_fp8_f32(h[2] * HIN_SCALE, h[3] * HIN_SCALE, w8, true);
                    *(unsigned*)((unsigned char*)hdst + (size_t)(r0 + i) * D + col) = (unsigned)w8; }
                else { u32x2 o; o.x = pk2(h[0], h[1]); o.y = pk2(h[2], h[3]); *(u32x2*)(hdst + (size_t)(r0 + i) * D + col) = o; } } }
    }
}
template <bool XBF>
__device__ __forceinline__ void resid_norm_rows(const float* xsrc, bf16_t* xdst, const bf16_t* delta, bf16_t* hdst, const float* gain, const float* mod_l, int gw, int ngw, int lane) {
    for (int r0 = gw * 4; r0 < M; r0 += ngw * 4) {
        const int b = r0 >> 11; const float* mb = mod_l + (size_t)b * NMODC;
        f32x4 v[4][4]; u32x2 dl[4][4]; float ss[4];
#pragma unroll
        for (int i = 0; i < 4; ++i) { const u32x2* dp = (const u32x2*)(delta + (size_t)(r0 + i) * D) + lane;
            if constexpr (XBF) { const u32x2* xr = (const u32x2*)((const bf16_t*)xsrc + (size_t)(r0 + i) * D) + lane;
#pragma unroll
                for (int j = 0; j < 4; ++j) { const u32x2 xw = xr[64 * j]; v[i][j] = (f32x4){bflo(xw[0]), bfhi(xw[0]), bflo(xw[1]), bfhi(xw[1])}; dl[i][j] = dp[64 * j]; } }
            else { const f32x4* xr = (const f32x4*)(xsrc + (size_t)(r0 + i) * D) + lane;
#pragma unroll
                for (int j = 0; j < 4; ++j) { v[i][j] = xr[64 * j]; dl[i][j] = dp[64 * j]; } } }
#pragma unroll
        for (int j = 0; j < 4; ++j) { const f32x4 g1 = *(const f32x4*)(mb + 2048 + 256 * j + 4 * lane);
#pragma unroll
            for (int i = 0; i < 4; ++i) { const f32x4 dv = {bflo(dl[i][j][0]), bfhi(dl[i][j][0]), bflo(dl[i][j][1]), bfhi(dl[i][j][1])}; v[i][j] = v[i][j] + g1 * dv;
                ((u32x2*)(xdst + (size_t)(r0 + i) * D) + lane)[64 * j] = (u32x2){pk2(v[i][j][0], v[i][j][1]), pk2(v[i][j][2], v[i][j][3])}; } }
#pragma unroll
        for (int i = 0; i < 4; ++i) { float t = 0.f;
#pragma unroll
            for (int j = 0; j < 4; ++j) t += (v[i][j][0] * v[i][j][0] + v[i][j][1] * v[i][j][1]) + (v[i][j][2] * v[i][j][2] + v[i][j][3] * v[i][j][3]);
            ss[i] = t; }
#pragma unroll
        for (int o = 1; o < 64; o <<= 1) {
#pragma unroll
            for (int i = 0; i < 4; ++i) ss[i] += __shfl_xor(ss[i], o); }
#pragma unroll
        for (int j = 0; j < 4; ++j) { const int col = 256 * j + 4 * lane;
            const f32x4 g4 = *(const f32x4*)(gain + col), sc = *(const f32x4*)(mb + 4096 + col), sh = *(const f32x4*)(mb + 3072 + col);
            const f32x4 gs = g4 * (sc + 1.0f);
#pragma unroll
            for (int i = 0; i < 4; ++i) { const float rstd = __builtin_amdgcn_rsqf(ss[i] * (1.0f / D) + EPS);
                const f32x4 h = v[i][j] * rstd * gs + sh; u32x2 o; o.x = pk2(h[0], h[1]); o.y = pk2(h[2], h[3]); *(u32x2*)(hdst + (size_t)(r0 + i) * D + col) = o; } }
    }
}
__device__ __forceinline__ void phase_conv_norm1(const KP& p, LAS unsigned char* lds, int l, int G) {
    const int tid = opaque_tid(), lane = tid & 63, wave = __builtin_amdgcn_readfirstlane(tid >> 6);
    const int gw = blockIdx.x * 8 + wave, ngw = G * 8;
    LAS float* scr = (LAS float*)(lds + wave * 8448);
    constexpr int I_IN = 16 * (INC / 32), I_G = 16 * 32, I_O = 16 * 32, I_Q = 16 * 64, NIT = I_IN + I_G + I_O + I_Q;
    for (int it = gw; it < NIT; it += ngw) {
        int r = it;
        if (r < I_IN) { transpose_item_fp8(p.in[I_WIN] + (size_t)l * D * INC, D, INC, p.ws + WS_WIN, scr, r, lane, WIN_SCALE); continue; } r -= I_IN;
        if (r < I_G) { transpose_item(p.in[I_GLUW] + (size_t)l * D * D, D, D, (bf16_t*)(p.ws + WS_WGLU), scr, r, lane); continue; } r -= I_G;
        if (r < I_O) { transpose_item_fp8(p.in[I_WOUT] + (size_t)l * D * D, D, D, p.ws + WS_WOUT, scr, r, lane, WO_SCALE); continue; } r -= I_O;
        transpose_item(p.in[I_WQ] + (size_t)l * D * 2048, D, 2048, (bf16_t*)(p.ws + WS_WQ), scr, r, lane);
    }
    const size_t gtid = (size_t)blockIdx.x * 512 + tid, nthr = (size_t)G * 512;
    cvt_f32_bf16(p.in[I_SUBK] + (size_t)l * 262144, (bf16_t*)(p.ws + WS_KEYS), 262144 / 4, gtid, nthr);
    cvt_f32_fp8_sliced(p.in[I_PU] + (size_t)l * 16384 * 1024, p.ws + WS_U, gtid, nthr, U_SCALE);
    cvt_f32_fp8_sliced(p.in[I_PV] + (size_t)l * 16384 * 1024, p.ws + WS_V, gtid, nthr, V_SCALE);
    if (l == 0) norm_rows<true, false>(p.in[I_X], (bf16_t*)(p.ws + WS_H), p.in[I_N1G] + l * D, (const float*)(p.ws + WS_MOD) + (size_t)l * 32 * NMODC, 0, 1024, gw, ngw, lane);
    else norm_rows<true, true>(p.out, (bf16_t*)(p.ws + WS_H), p.in[I_N1G] + l * D, (const float*)(p.ws + WS_MOD) + (size_t)l * 32 * NMODC, 0, 1024, gw, ngw, lane);
}

__device__ __forceinline__ void phase_hgrn2(const KP& p, LAS unsigned char* lds, int l, int G) {
    const int tid = opaque_tid(), lane = tid & 63, w = __builtin_amdgcn_readfirstlane(tid >> 6), fr = lane & 15, g = lane >> 4;
    constexpr int QS = 272, TS = 72;
    constexpr int OFF_QT = 0, OFF_KH = 8704, OFF_KT = 17408, OFF_VT = 26624, OFF_EREF = 35840, OFF_ELR = 36352, OFF_SEG = 36864, PBUF = 40960;
    const bf16_t* PA = (const bf16_t*)(p.ws + WS_R0);
    bf16_t* ORAW = (bf16_t*)(p.ws + WS_OR);
    const float* LB = (const float*)(p.ws + WS_LB) + l * 1024;
    for (int unit = blockIdx.x; unit < 256; unit += G) {
        const int b = unit >> 3, h = unit & 7, k0 = 2 * lane;
        const float lb0 = LB[h * 128 + k0], lb1 = LB[h * 128 + k0 + 1];
        const float om0 = 1.0f - lb0, om1 = 1.0f - lb1;
        f32x4 S[8];
#pragma unroll
        for (int kt = 0; kt < 8; ++kt) S[kt] = (f32x4){0.f, 0.f, 0.f, 0.f};
        unsigned rq[4], rf[4], rv[4];
        {
            const bf16_t* base = PA + ((size_t)b * SEQ + 4 * w) * 3072 + h * 128 + k0;
#pragma unroll
            for (int i = 0; i < 4; ++i) { rq[i] = *(const unsigned*)(base + (size_t)i * 3072); rf[i] = *(const unsigned*)(base + (size_t)i * 3072 + 1024); rv[i] = *(const unsigned*)(base + (size_t)i * 3072 + 2048); }
        }
        for (int c = 0; c < 64; ++c) {
            LAS unsigned char* base = lds + (c & 1) * PBUF;
            float cs0[4], cs1[4], qv0[4], qv1[4], kv0[4], kv1[4];
            float run0 = 0.f, run1 = 0.f;
#pragma unroll
            for (int i = 0; i < 4; ++i) {
                const float fp0 = bflo(rf[i]), fp1 = bfhi(rf[i]);
                const float s0 = fsigmoid(fp0), s1 = fsigmoid(fp1);
                run0 += __logf(lb0 + om0 * s0); run1 += __logf(lb1 + om1 * s1);
                cs0[i] = run0; cs1[i] = run1;
                kv0[i] = om0 * (1.0f - s0); kv1[i] = om1 * (1.0f - s1);
                qv0[i] = fsilu(bflo(rq[i])); qv1[i] = fsilu(bfhi(rq[i]));
            }
            *(LAS f32x2*)(base + OFF_SEG + (w * 128 + k0) * 4) = (f32x2){run0, run1};
            __syncthreads();
            float off0 = 0.f, off1 = 0.f, ref0 = 0.f, ref1 = 0.f, all0 = 0.f, all1 = 0.f;
#pragma unroll
            for (int s = 0; s < 8; ++s) { const f32x2 t2 = *(const LAS f32x2*)(base + OFF_SEG + (s * 128 + k0) * 4);
                if (s < w) { off0 += t2[0]; off1 += t2[1]; }
                if (s < 4) { ref0 += t2[0]; ref1 += t2[1]; }
                all0 += t2[0]; all1 += t2[1]; }
            float kh0[4], kh1[4];
#pragma unroll
            for (int i = 0; i < 4; ++i) {
                const float b0 = off0 + cs0[i], b1 = off1 + cs1[i];
                const float q0 = qv0[i] * __expf(b0 - ref0), q1 = qv1[i] * __expf(b1 - ref1);
                kh0[i] = kv0[i] * __expf(ref0 - b0); kh1[i] = kv1[i] * __expf(ref1 - b1);
                const int t = 4 * w + i;
                *(LAS unsigned*)(base + OFF_QT + t * QS + k0 * 2) = pk2(q0, q1);
                *(LAS unsigned*)(base + OFF_KH + t * QS + k0 * 2) = pk2(kh0[i], kh1[i]);
            }
            *(LAS u32x2*)(base + OFF_KT + k0 * TS + 8 * w) = (u32x2){pk2(kh0[0], kh0[1]), pk2(kh0[2], kh0[3])};
            *(LAS u32x2*)(base + OFF_KT + (k0 + 1) * TS + 8 * w) = (u32x2){pk2(kh1[0], kh1[1]), pk2(kh1[2], kh1[3])};
            *(LAS u32x2*)(base + OFF_VT + k0 * TS + 8 * w) = (u32x2){(rv[0] & 0xffffu) | (rv[1] << 16), (rv[2] & 0xffffu) | (rv[3] << 16)};
            *(LAS u32x2*)(base + OFF_VT + (k0 + 1) * TS + 8 * w) = (u32x2){(rv[0] >> 16) | (rv[1] & 0xffff0000u), (rv[2] >> 16) | (rv[3] & 0xffff0000u)};
            if (w == 0) {
                *(LAS f32x2*)(base + OFF_EREF + k0 * 4) = (f32x2){__expf(ref0), __expf(ref1)};
                *(LAS f32x2*)(base + OFF_ELR + k0 * 4) = (f32x2){__expf(all0 - ref0), __expf(all1 - ref1)};
            }
            __syncthreads();
            if (c + 1 < 64) {
                const bf16_t* nb = PA + ((size_t)b * SEQ + (c + 1) * 32 + 4 * w) * 3072 + h * 128 + k0;
#pragma unroll
                for (int i = 0; i < 4; ++i) { rq[i] = *(const unsigned*)(nb + (size_t)i * 3072); rf[i] = *(const unsigned*)(nb + (size_t)i * 3072 + 1024); rv[i] = *(const unsigned*)(nb + (size_t)i * 3072 + 2048); }
            }
            bf16x8 qf[2][4], kf[2][4];
#pragma unroll
            for (int tt = 0; tt < 2; ++tt)
#pragma unroll
                for (int m = 0; m < 4; ++m) {
                    const LAS unsigned char* pq = base + OFF_QT + (16 * tt + fr) * QS + (32 * m + 4 * g) * 2;
                    const u32x2 lo = *(const LAS u32x2*)pq, hi = *(const LAS u32x2*)(pq + 32);
                    qf[tt][m] = __builtin_bit_cast(bf16x8, (u32x4){lo[0], lo[1], hi[0], hi[1]});
                    const LAS unsigned char* pk = base + OFF_KH + (16 * tt + fr) * QS + (32 * m + 4 * g) * 2;
                    const u32x2 lo2 = *(const LAS u32x2*)pk, hi2 = *(const LAS u32x2*)(pk + 32);
                    kf[tt][m] = __builtin_bit_cast(bf16x8, (u32x4){lo2[0], lo2[1], hi2[0], hi2[1]});
                }
            f32x4 PT00 = {0.f, 0.f, 0.f, 0.f}, PT01 = {0.f, 0.f, 0.f, 0.f}, PT11 = {0.f, 0.f, 0.f, 0.f};
#pragma unroll
            for (int m = 0; m < 4; ++m) {
                PT00 = __builtin_amdgcn_mfma_f32_16x16x32_bf16(kf[0][m], qf[0][m], PT00, 0, 0, 0);
                PT01 = __builtin_amdgcn_mfma_f32_16x16x32_bf16(kf[0][m], qf[1][m], PT01, 0, 0, 0);
                PT11 = __builtin_amdgcn_mfma_f32_16x16x32_bf16(kf[1][m], qf[1][m], PT11, 0, 0, 0);
            }
#pragma unroll
            for (int r = 0; r < 4; ++r) { if (4 * g + r > fr) { PT00[r] = 0.f; PT11[r] = 0.f; } }
            const bf16x8 pa0 = __builtin_bit_cast(bf16x8, (u32x4){pk2(PT00[0], PT00[1]), pk2(PT00[2], PT00[3]), 0u, 0u});
            const bf16x8 pa1 = __builtin_bit_cast(bf16x8, (u32x4){pk2(PT01[0], PT01[1]), pk2(PT01[2], PT01[3]), pk2(PT11[0], PT11[1]), pk2(PT11[2], PT11[3])});
            const LAS unsigned char* vrow = base + OFF_VT + (16 * w + fr) * TS;
            const u32x2 vpa = *(const LAS u32x2*)(vrow + 8 * g), vpb = *(const LAS u32x2*)(vrow + 32 + 8 * g);
            const u32x2 vna = *(const LAS u32x2*)(vrow + 16 * g), vnb = *(const LAS u32x2*)(vrow + 16 * g + 8);
            const bf16x8 vperm = __builtin_bit_cast(bf16x8, (u32x4){vpa[0], vpa[1], vpb[0], vpb[1]});
            const bf16x8 vnat = __builtin_bit_cast(bf16x8, (u32x4){vna[0], vna[1], vnb[0], vnb[1]});
#pragma unroll
            for (int kt = 0; kt < 8; ++kt) { const f32x4 e = *(const LAS f32x4*)(base + OFF_EREF + (16 * kt + 4 * g) * 4); S[kt] = S[kt] * e; }
            f32x4 O0 = {0.f, 0.f, 0.f, 0.f}, O1 = {0.f, 0.f, 0.f, 0.f};
#pragma unroll
            for (int m = 0; m < 4; ++m) {
                const bf16x8 sf = __builtin_bit_cast(bf16x8, (u32x4){pk2(S[2 * m][0], S[2 * m][1]), pk2(S[2 * m][2], S[2 * m][3]), pk2(S[2 * m + 1][0], S[2 * m + 1][1]), pk2(S[2 * m + 1][2], S[2 * m + 1][3])});
                O0 = __builtin_amdgcn_mfma_f32_16x16x32_bf16(qf[0][m], sf, O0, 0, 0, 0);
                O1 = __builtin_amdgcn_mfma_f32_16x16x32_bf16(qf[1][m], sf, O1, 0, 0, 0);
            }
            O0 = __builtin_amdgcn_mfma_f32_16x16x32_bf16(pa0, vperm, O0, 0, 0, 0);
            O1 = __builtin_amdgcn_mfma_f32_16x16x32_bf16(pa1, vperm, O1, 0, 0, 0);
#pragma unroll
            for (int kt = 0; kt < 8; ++kt) {
                const LAS unsigned char* krow = base + OFF_KT + (16 * kt + fr) * TS + 16 * g;
                const u32x2 ka = *(const LAS u32x2*)krow, kb = *(const LAS u32x2*)(krow + 8);
                const bf16x8 ktf = __builtin_bit_cast(bf16x8, (u32x4){ka[0], ka[1], kb[0], kb[1]});
                S[kt] = __builtin_amdgcn_mfma_f32_16x16x32_bf16(ktf, vnat, S[kt], 0, 0, 0);
            }
#pragma unroll
            for (int kt = 0; kt < 8; ++kt) { const f32x4 e = *(const LAS f32x4*)(base + OFF_ELR + (16 * kt + 4 * g) * 4); S[kt] = S[kt] * e; }
            bf16_t* orow = ORAW + ((size_t)b * SEQ + c * 32 + 4 * g) * D + h * 128 + 16 * w + fr;
#pragma unroll
            for (int r = 0; r < 4; ++r) { orow[(size_t)r * D] = (bf16_t)(pk2(O0[r], 0.f) & 0xffffu); orow[(size_t)(16 + r) * D] = (bf16_t)(pk2(O1[r], 0.f) & 0xffffu); }
        }
        __syncthreads();
    }
}

__device__ __forceinline__ void phase_s5(const KP& p, LAS unsigned char* lds, int l, int G, size_t ys_off) {
    const int tid = opaque_tid(), lane = tid & 63, w = __builtin_amdgcn_readfirstlane(tid >> 6), fr = lane & 15, g = lane >> 4;
    const int gw = blockIdx.x * 8 + w, ngw = G * 8;
    constexpr int BUS = 132;
    LAS float* BU = (LAS float*)(lds + w * 16896);
    LAS unsigned char* XI = (LAS unsigned char*)BU;
    const bf16_t* PB = (const bf16_t*)(p.ws + WS_R0);
    const bf16x8 zero8 = {0, 0, 0, 0, 0, 0, 0, 0};
    for (int unit = gw; unit < BATCH * 64; unit += ngw) {
        const int b = unit >> 6, grp = unit & 63, lg = l * 64 + grp;
        const bf16_t* BOP = (const bf16_t*)(p.ws + WS_BOP) + (size_t)lg * 128 * 16;
        const bf16_t* COP = (const bf16_t*)(p.ws + WS_COP) + (size_t)lg * 16 * 128;
        bf16x8 bfrag[8], cfrag[4], dfrag;
#pragma unroll
        for (int nt = 0; nt < 8; ++nt) bfrag[nt] = (g < 2) ? *(const bf16x8*)(BOP + (size_t)(16 * nt + fr) * 16 + 8 * g) : zero8;
#pragma unroll
        for (int ks = 0; ks < 4; ++ks) cfrag[ks] = DBG_S5_NOSSM ? zero8 : *(const bf16x8*)(COP + (size_t)fr * 128 + 32 * ks + 8 * g);
        {
            const unsigned dbits = pk2(p.in[I_S5D][l * 1024 + grp * 16 + fr], 0.f) & 0xffffu;
#pragma unroll
            for (int j = 0; j < 8; ++j) dfrag[j] = (g < 2 && (8 * g + j) == fr) ? (short)dbits : (short)0;
        }
        const float ar = ((const float*)(p.ws + WS_ABAR))[2 * ((size_t)lg * 64 + lane)], ai = ((const float*)(p.ws + WS_ABAR))[2 * ((size_t)lg * 64 + lane) + 1];
        const float nai = -ai; float xr = 0.f, xi = 0.f; unsigned hBU = 0u, hXI = 0u, hY = 0u;
        const bf16_t* ub = PB + ((size_t)b * SEQ) * 4096 + 1024 + grp * 16;
        bf16_t* yb_ = (bf16_t*)(p.ws + ys_off) + ((size_t)b * SEQ) * D + grp * 16;
        bf16x8 unext[2];
#pragma unroll
        for (int tt = 0; tt < 2; ++tt) unext[tt] = (g < 2) ? *(const bf16x8*)(ub + (size_t)(16 * tt + fr) * 4096 + 8 * g) : zero8;
        for (int t0 = 0; t0 < SEQ; t0 += 32) {
            bf16x8 ufrag[2];
#pragma unroll
            for (int tt = 0; tt < 2; ++tt) { ufrag[tt] = unext[tt]; if (t0 + 32 < SEQ) unext[tt] = (g < 2) ? *(const bf16x8*)(ub + (size_t)(t0 + 32 + 16 * tt + fr) * 4096 + 8 * g) : zero8; }
#pragma unroll
            for (int tt = 0; tt < 2; ++tt)
#pragma unroll
                for (int nt = 0; nt < 8; ++nt) {
                    const f32x4 a = __builtin_amdgcn_mfma_f32_16x16x32_bf16(ufrag[tt], bfrag[nt], (f32x4){0.f, 0.f, 0.f, 0.f}, 0, 0, 0);
#pragma unroll
                    for (int r = 0; r < 4; ++r) BU[(16 * tt + 4 * g + r) * BUS + 16 * nt + fr] = a[r];
                }
            LDS_WAIT();
#pragma unroll
            for (int t = 0; t < 32; ++t) {
                const f32x2 bb = *(const LAS f32x2*)(BU + t * BUS + 2 * lane); hBU += __float_as_uint(bb[0]) * 3u + __float_as_uint(bb[1]);
                float t1, t2, nr, ni;
                asm("v_fma_f32 %0, %1, %2, %3" : "=v"(t1) : "v"(nai), "v"(xi), "v"(bb[0]));
                asm("v_fma_f32 %0, %1, %2, %3" : "=v"(t2) : "v"(ai), "v"(xr), "v"(bb[1]));
                asm("v_fma_f32 %0, %1, %2, %3" : "=v"(nr) : "v"(ar), "v"(xr), "v"(t1));
                asm("v_fma_f32 %0, %1, %2, %3" : "=v"(ni) : "v"(ar), "v"(xi), "v"(t2));
                xr = nr; xi = ni;
                { const unsigned pv = pk2(nr, ni); hXI += pv; *(LAS unsigned*)(XI + t * (BUS * 4) + lane * 4) = pv; }
            }
            LDS_WAIT();
#pragma unroll
            for (int tt = 0; tt < 2; ++tt) {
                f32x4 y = {0.f, 0.f, 0.f, 0.f};
#pragma unroll
                for (int ks = 0; ks < 4; ++ks) {
                    const bf16x8 xf = *(const LAS bf16x8*)(XI + (16 * tt + fr) * (BUS * 4) + (32 * ks + 8 * g) * 2);
                    y = __builtin_amdgcn_mfma_f32_16x16x32_bf16(xf, cfrag[ks], y, 0, 0, 0);
                }
                y = __builtin_amdgcn_mfma_f32_16x16x32_bf16(ufrag[tt], dfrag, y, 0, 0, 0);
#pragma unroll
                for (int r = 0; r < 4; ++r) { const unsigned yv = pk2(fgelu(y[r]), 0.f) & 0xffffu; hY += yv * (unsigned)(r + 1); yb_[(size_t)(t0 + 16 * tt + 4 * g + r) * D + fr] = (bf16_t)yv; }
            }
            LDS_WAIT();
        }
        if (DBG_SELFCHECK) { for (int o = 1; o < 64; o <<= 1) { hBU += __shfl_xor((int)hBU, o); hXI += __shfl_xor((int)hXI, o); hY += __shfl_xor((int)hY, o); }
            unsigned* hs = (unsigned*)(p.ws + WS_CTL) + 65536 + (ys_off == WS_YS ? 0 : 8192) + unit * 4; unsigned hA = __float_as_uint(ar) * 7u + __float_as_uint(ai); for (int o = 1; o < 64; o <<= 1) hA += __shfl_xor((int)hA, o); if (lane == 0) { hs[0] = hBU; hs[1] = hXI; hs[2] = hA; } }
    }
    const bf16_t* ORAW = (const bf16_t*)(p.ws + WS_OR); float* SSQ = (float*)(p.ws + WS_SSQ);
    for (int row = gw; row < M; row += ngw) {
        const u32x4 a = *(const u32x4*)(ORAW + (size_t)row * D + 8 * lane), c2 = *(const u32x4*)(ORAW + (size_t)row * D + 512 + 8 * lane);
        float s0 = 0.f, s1 = 0.f;
#pragma unroll
        for (int j = 0; j < 4; ++j) { const float x0 = bflo(a[j]), x1 = bfhi(a[j]), y0 = bflo(c2[j]), y1 = bfhi(c2[j]); s0 += x0 * x0 + x1 * x1; s1 += y0 * y0 + y1 * y1; }
#pragma unroll
        for (int o = 1; o < 16; o <<= 1) { s0 += __shfl_xor(s0, o); s1 += __shfl_xor(s1, o); }
        if (fr == 0) { SSQ[(size_t)row * 8 + g] = s0; SSQ[(size_t)row * 8 + 4 + g] = s1; }
    }
}

__device__ __forceinline__ unsigned fkey(float f) { const unsigned u = __float_as_uint(f); return u ^ ((unsigned)((int)u >> 31) | 0x80000000u); }
__device__ __forceinline__ float kval(unsigned k) { const unsigned u = (k & 0x80000000u) ? (k ^ 0x80000000u) : ~k; return __uint_as_float(u); }
#define CE_DESC(a, b) do { const unsigned _mx = (a) > (b) ? (a) : (b), _mn = (a) > (b) ? (b) : (a); (a) = _mx; (b) = _mn; } while (0)
__device__ __forceinline__ void sort16_desc(unsigned (&a)[16]) {
#pragma unroll
    for (int kk = 1; kk <= 4; ++kk)
#pragma unroll
        for (int jj = kk - 1; jj >= 0; --jj)
#pragma unroll
            for (int i = 0; i < 16; ++i) { const int k = 1 << kk, j = 1 << jj, l2 = i ^ j;
                if (l2 > i) { if ((i & k) == 0) CE_DESC(a[i], a[l2]); else CE_DESC(a[l2], a[i]); } }
}
__device__ __forceinline__ void merge_top16(unsigned (&a)[16], const unsigned (&b)[16]) {
#pragma unroll
    for (int i = 0; i < 16; ++i) a[i] = a[i] > b[15 - i] ? a[i] : b[15 - i];
#pragma unroll
    for (int jj = 3; jj >= 0; --jj)
#pragma unroll
        for (int i = 0; i < 16; ++i) { const int j = 1 << jj, l2 = i ^ j; if (l2 > i) CE_DESC(a[i], a[l2]); }
}
__device__ __forceinline__ void phase_topk(const KP& p, LAS unsigned char* lds, int G) {
    const int tid = opaque_tid(), lane = tid & 63, w = __builtin_amdgcn_readfirstlane(tid >> 6), hh = lane >> 5;
    const int gw = blockIdx.x * 8 + w, ngw = G * 8;
    const bf16_t* Q = (const bf16_t*)(p.ws + WS_R0); const bf16_t* KEYS = (const bf16_t*)(p.ws + WS_KEYS);
    unsigned* SEL = (unsigned*)(p.ws + WS_SEL);
    LAS unsigned char* tab = lds + w * 2048 + lane * 32;
    const int CI[50] = {0,0,0,0,0,0,0,0,0,0,0,0,0,0,0,0, 1,1,1,1,1,1,1,1, 2,2,2,2,2, 3,3,3,3, 4,4,4, 5,5, 6,6, 7,7, 8,9,10,11,12,13,14,15};
    const int CJ[50] = {0,1,2,3,4,5,6,7,8,9,10,11,12,13,14,15, 0,1,2,3,4,5,6,7, 0,1,2,3,4, 0,1,2,3, 0,1,2, 0,1, 0,1, 0,1, 0,0,0,0,0,0,0,0};
    LAS unsigned char* kimg = lds + 16384;
    for (int h = 0; h < 8; ++h) {
      __syncthreads();
#pragma unroll
      for (int i = 0; i < 8; ++i) { const int ch = tid + 512 * i, row = ch >> 4, c16 = ch & 15;
          *(LAS u32x4*)(kimg + row * 272 + c16 * 16) = *(const u32x4*)(KEYS + (size_t)(h * 256 + row) * 128 + c16 * 8); }
      __syncthreads();
      for (int tg = gw; tg < 2048; tg += ngw) {
        const int t = tg * 32 + (lane & 31);
        unsigned top[2][16];
#pragma unroll
        for (int pp = 0; pp < 2; ++pp) {
            bf16x8 qf[8];
#pragma unroll
            for (int ks = 0; ks < 8; ++ks) qf[ks] = *(const bf16x8*)(Q + ((size_t)((((tg * 8 + h) * 2 + pp) * 8 + ks) * 64 + lane)) * 8);
            const LAS unsigned char* kb = kimg + (pp * 128 + (lane & 31)) * 272 + 16 * hh;
#pragma unroll
            for (int nt = 0; nt < 4; ++nt) {
                f32x16 acc;
#pragma unroll
                for (int i = 0; i < 16; ++i) acc[i] = 0.f;
#pragma unroll
                for (int ks = 0; ks < 8; ++ks) { const bf16x8 kf = *(const LAS bf16x8*)(kb + (32 * nt) * 272 + 32 * ks);
                    acc = __builtin_amdgcn_mfma_f32_32x32x16_bf16(kf, qf[ks], acc, 0, 0, 0); }
                unsigned ky[16];
#pragma unroll
                for (int r = 0; r < 16; ++r) ky[r] = (fkey(acc[r]) & ~127u) | (unsigned)(32 * nt + (r & 3) + 8 * (r >> 2)) | (unsigned)(4 * hh);
                sort16_desc(ky);
                if (nt == 0) {
#pragma unroll
                    for (int i = 0; i < 16; ++i) top[pp][i] = ky[i];
                } else merge_top16(top[pp], ky);
            }
            unsigned other[16];
#pragma unroll
            for (int i = 0; i < 16; ++i) other[i] = (unsigned)__shfl_xor((int)top[pp][i], 32);
            merge_top16(top[pp], other);
        }
        float sa[16], sb[16];
#pragma unroll
        for (int i = 0; i < 16; ++i) { sa[i] = kval(top[0][i] & ~127u); sb[i] = kval(top[1][i] & ~127u); }
        unsigned c0[16], c1[16];
#pragma unroll
        for (int s = 0; s < 32; ++s) {
            unsigned key = 0u;
            if (s < 25) {
                const float v0 = sa[CI[s]] + sb[CJ[s]], v1 = sa[CI[25 + s]] + sb[CJ[25 + s]];
                const unsigned k0 = (fkey(v0) & ~255u) | (unsigned)(CI[s] * 16 + CJ[s]), k1 = (fkey(v1) & ~255u) | (unsigned)(CI[25 + s] * 16 + CJ[25 + s]);
                key = hh ? k1 : k0;
            }
            if (s < 16) c0[s] = key; else c1[s - 16] = key;
        }
        sort16_desc(c0); sort16_desc(c1); merge_top16(c0, c1);
#pragma unroll
        for (int i = 0; i < 16; ++i) c1[i] = (unsigned)__shfl_xor((int)c0[i], 32);
        merge_top16(c0, c1);
        {
            u32x4 wa, wb;
#pragma unroll
            for (int q4 = 0; q4 < 4; ++q4) {
                wa[q4] = (top[0][4 * q4] & 127u) | ((top[0][4 * q4 + 1] & 127u) << 8) | ((top[0][4 * q4 + 2] & 127u) << 16) | ((top[0][4 * q4 + 3] & 127u) << 24);
                wb[q4] = (top[1][4 * q4] & 127u) | ((top[1][4 * q4 + 1] & 127u) << 8) | ((top[1][4 * q4 + 2] & 127u) << 16) | ((top[1][4 * q4 + 3] & 127u) << 24);
            }
            *(LAS u32x4*)tab = wa; *(LAS u32x4*)(tab + 16) = wb;
        }
        float ev[16], esum = 0.f; const float vmax = kval(c0[0] & ~255u);
#pragma unroll
        for (int k = 0; k < 16; ++k) { ev[k] = __expf(kval(c0[k] & ~255u) - vmax); esum += ev[k]; }
        const float rs = 1.0f / esum;
        LDS_WAIT();
        unsigned outw[8]; const unsigned hmask = hh ? 0xffffffffu : 0u;
#pragma unroll
        for (int kk = 0; kk < 8; ++kk) {
            const unsigned key = c0[kk] ^ ((c0[kk] ^ c0[8 + kk]) & hmask); const float e = __uint_as_float(__float_as_uint(ev[kk]) ^ ((__float_as_uint(ev[kk]) ^ __float_as_uint(ev[8 + kk])) & hmask));
            const unsigned code = key & 255u, ia = tab[code >> 4], ib = tab[16 + (code & 15u)];
            outw[kk] = (pk2(0.f, e * rs) & 0xffff0000u) | (ia * 128u + ib);
        }
        u32x4* dst = (u32x4*)(SEL + (size_t)t * 128 + h * 16 + hh * 8);
        dst[0] = (u32x4){outw[0], outw[1], outw[2], outw[3]}; dst[1] = (u32x4){outw[4], outw[5], outw[6], outw[7]};
        LDS_WAIT();
      }
    }
    __syncthreads();
}

__device__ __forceinline__ void fp8x4_to_f32(unsigned w, float& a, float& b, float& c, float& d) {
    const f32x2 lo = __builtin_amdgcn_cvt_pk_f32_fp8((int)w, false), hi = __builtin_amdgcn_cvt_pk_f32_fp8((int)w, true); a = lo[0]; b = lo[1]; c = hi[0]; d = hi[1];
}
struct XSlice { int sl, rank, nloc; };
__device__ __forceinline__ XSlice xslice_of_block(const KP& p, volatile LAS unsigned* MISC, int G) {
    unsigned* bar = (unsigned*)(p.ws + WS_CTL) + 4096; unsigned cnt[8]; unsigned tot = 0; bool ok = true;
#pragma unroll
    for (int j = 0; j < 8; ++j) { cnt[j] = xb_ld(&bar[XB_XCNT(j)]); tot += cnt[j]; ok = ok && (cnt[j] > 0u); }
    ok = ok && (tot == (unsigned)G);
    XSlice x;
    if (ok) { const unsigned myx = MISC[16]; x.sl = (int)myx; x.rank = (int)MISC[17]; x.nloc = (int)cnt[myx & 7u]; }
    else { x.sl = (int)(blockIdx.x & 7); x.rank = (int)(blockIdx.x >> 3); x.nloc = (G - x.sl + 7) >> 3; }
    x.sl = __builtin_amdgcn_readfirstlane(x.sl); x.rank = __builtin_amdgcn_readfirstlane(x.rank); x.nloc = __builtin_amdgcn_readfirstlane(x.nloc);
    return x;
}
__device__ __forceinline__ float dot16_fp8(const u32x4 u, const float (&hf)[16]) {
    float d = 0.f;
#pragma unroll
    for (int j = 0; j < 4; ++j) { float f0, f1, f2, f3; fp8x4_to_f32(u[j], f0, f1, f2, f3);
        d = __builtin_fmaf(f0, hf[4 * j], d); d = __builtin_fmaf(f1, hf[4 * j + 1], d); d = __builtin_fmaf(f2, hf[4 * j + 2], d); d = __builtin_fmaf(f3, hf[4 * j + 3], d); }
    return d;
}
typedef __bf16 bf16v8 __attribute__((ext_vector_type(8)));
__device__ __forceinline__ float dot16_fp8_bf16(const u32x4 u, const bf16v8 h0, const bf16v8 h1) {
    float d0 = 0.f, d1 = 0.f;
    d0 = __builtin_amdgcn_fdot2_f32_bf16(__builtin_amdgcn_cvt_scalef32_pk_bf16_fp8(u[0], 1.0f, false), __builtin_shufflevector(h0, h0, 0, 1), d0, false);
    d1 = __builtin_amdgcn_fdot2_f32_bf16(__builtin_amdgcn_cvt_scalef32_pk_bf16_fp8(u[0], 1.0f, true),  __builtin_shufflevector(h0, h0, 2, 3), d1, false);
    d0 = __builtin_amdgcn_fdot2_f32_bf16(__builtin_amdgcn_cvt_scalef32_pk_bf16_fp8(u[1], 1.0f, false), __builtin_shufflevector(h0, h0, 4, 5), d0, false);
    d1 = __builtin_amdgcn_fdot2_f32_bf16(__builtin_amdgcn_cvt_scalef32_pk_bf16_fp8(u[1], 1.0f, true),  __builtin_shufflevector(h0, h0, 6, 7), d1, false);
    d0 = __builtin_amdgcn_fdot2_f32_bf16(__builtin_amdgcn_cvt_scalef32_pk_bf16_fp8(u[2], 1.0f, false), __builtin_shufflevector(h1, h1, 0, 1), d0, false);
    d1 = __builtin_amdgcn_fdot2_f32_bf16(__builtin_amdgcn_cvt_scalef32_pk_bf16_fp8(u[2], 1.0f, true),  __builtin_shufflevector(h1, h1, 2, 3), d1, false);
    d0 = __builtin_amdgcn_fdot2_f32_bf16(__builtin_amdgcn_cvt_scalef32_pk_bf16_fp8(u[3], 1.0f, false), __builtin_shufflevector(h1, h1, 4, 5), d0, false);
    d1 = __builtin_amdgcn_fdot2_f32_bf16(__builtin_amdgcn_cvt_scalef32_pk_bf16_fp8(u[3], 1.0f, true),  __builtin_shufflevector(h1, h1, 6, 7), d1, false);
    return d0 + d1;
}
__device__ __forceinline__ float dpp_sum8(float d) {
    d += __uint_as_float(__builtin_amdgcn_update_dpp(0, __float_as_uint(d), 0xB1, 0xF, 0xF, true));
    d += __uint_as_float(__builtin_amdgcn_update_dpp(0, __float_as_uint(d), 0x4E, 0xF, 0xF, true));
    d += __uint_as_float(__builtin_amdgcn_update_dpp(0, __float_as_uint(d), 0x141, 0xF, 0xF, true));
    return d;
}
__device__ __forceinline__ void phase_expert_u(const KP& p, LAS unsigned char* lds, volatile LAS unsigned* MISC, int G) {
    const int tid = opaque_tid(), lane = tid & 63, w = __builtin_amdgcn_readfirstlane(tid >> 6), j = lane >> 3, c = lane & 7;
    const XSlice xs = xslice_of_block(p, MISC, G);
    const bf16_t* H2 = (const bf16_t*)(p.ws + WS_H); const unsigned char* Us = p.ws + WS_U + (size_t)xs.sl * 16384 * 128;
    const unsigned* SEL = (const unsigned*)(p.ws + WS_SEL); unsigned* PDu = (unsigned*)(p.ws + WS_R0) + (size_t)xs.sl * M * 64;
    const int t0 = xs.rank * 8 + w, tstep = xs.nloc * 8;
    LAS unsigned char* ring = lds + w * 17920;
    LAS unsigned char* selb = ring + 16384; LAS unsigned char* hbuf = ring + 16384 + 1024;
    const int tlast = t0 + ((M - 1 - t0) / tstep) * tstep;
#define E1_CL(t) ((t) <= tlast ? (t) : tlast)
#define E1_DMA_SEL(t, par) do { const unsigned* sp = SEL + (size_t)E1_CL(t) * 128 + lane; \
            __builtin_amdgcn_global_load_lds(sp, (LAS unsigned*)(selb + (par) * 512), 4, 0, 0); __builtin_amdgcn_global_load_lds(sp + 64, (LAS unsigned*)(selb + (par) * 512 + 256), 4, 0, 0); } while (0)
#define E1_DMA_H(t, par) do { __builtin_amdgcn_global_load_lds((const unsigned*)(H2 + (size_t)E1_CL(t) * D + xs.sl * 128) + lane, (LAS unsigned*)(hbuf + (par) * 256), 4, 0, 0); } while (0)
#define E1_DMA_ROW(i, idxv) do { __builtin_amdgcn_global_load_lds((const unsigned*)(Us + (size_t)((idxv) & 0x3fffu) * 128 + 16 * c), (LAS unsigned*)(ring + (i) * 1024), 16, 0, 0); } while (0)
    if (t0 < M) {
        E1_DMA_SEL(t0, 0); E1_DMA_SEL(t0 + tstep, 1); E1_DMA_H(t0, 0);
        asm volatile("s_waitcnt vmcnt(0)" ::: "memory");
        { u32x4 s0[4];
#pragma unroll
          for (int q = 0; q < 4; ++q) s0[q] = *(const LAS u32x4*)(selb + (16 * j + 4 * q) * 4);
#pragma unroll
          for (int i = 0; i < 16; ++i) E1_DMA_ROW(i, s0[i >> 2][i & 3]); }
        { PDu[(size_t)t0 * 64 + 8 * j + (c >> 1) + 4 * (c & 1)] = 0u; }
        int par = 0;
        for (int tok = t0; tok < M; tok += tstep, par ^= 1) {
            E1_DMA_SEL(tok + 2 * tstep, par); E1_DMA_H(tok + tstep, par ^ 1);
            asm volatile("s_waitcnt vmcnt(19)" ::: "memory");
            u32x4 sn[4];
#pragma unroll
            for (int q = 0; q < 4; ++q) sn[q] = *(const LAS u32x4*)(selb + (par ^ 1) * 512 + (16 * j + 4 * q) * 4);
            const bf16v8 hb0 = *(const LAS bf16v8*)(hbuf + par * 256 + 32 * c), hb1 = *(const LAS bf16v8*)(hbuf + par * 256 + 32 * c + 16);
            float pd0 = 0.f, pd1 = 0.f;
#pragma unroll
            for (int i0 = 0; i0 < 16; i0 += 4) {
                asm volatile("s_waitcnt vmcnt(16)" ::: "memory");
                u32x4 row[4];
#pragma unroll
                for (int r = 0; r < 4; ++r) row[r] = *(const LAS u32x4*)(ring + (i0 + r) * 1024 + 16 * lane);
                asm volatile("s_waitcnt lgkmcnt(0)" ::: "memory");
#pragma unroll
                for (int r = 0; r < 4; ++r) E1_DMA_ROW(i0 + r, sn[(i0 + r) >> 2][(i0 + r) & 3]);
#pragma unroll
                for (int r = 0; r < 4; ++r) { const int i = i0 + r; const float d = dpp_sum8(dot16_fp8_bf16(row[r], hb0, hb1));
                    if (i < 8) pd0 = (c == i) ? d : pd0; else pd1 = (c == i - 8) ? d : pd1; }
            }
            { const float nb0 = __uint_as_float(__builtin_amdgcn_update_dpp(0, __float_as_uint(pd0), 0xB1, 0xF, 0xF, true)), nb1 = __uint_as_float(__builtin_amdgcn_update_dpp(0, __float_as_uint(pd1), 0xB1, 0xF, 0xF, true));
              PDu[(size_t)tok * 64 + 8 * j + (c >> 1) + 4 * (c & 1)] = (c & 1) ? pk2(nb1, pd1) : pk2(pd0, nb0); }
        }
        asm volatile("s_waitcnt vmcnt(0)" ::: "memory");
    }
#undef E1_CL
#undef E1_DMA_SEL
#undef E1_DMA_H
#undef E1_DMA_ROW
}
__device__ __forceinline__ void phase_expert_w(const KP& p, int G) {
    const int tid = opaque_tid(), lane = tid & 63, w = __builtin_amdgcn_readfirstlane(tid >> 6);
    const int gw = blockIdx.x * 8 + w, ngw = G * 8;
    unsigned* SEL = (unsigned*)(p.ws + WS_SEL); const unsigned* PDu = (const unsigned*)(p.ws + WS_R0);
    for (int tok = gw; tok < M; tok += ngw) {
        f32x2 d = {0.f, 0.f};
#pragma unroll
        for (int sl = 0; sl < 8; ++sl) { const unsigned pw = PDu[((size_t)sl * M + tok) * 64 + lane]; d[0] += bflo(pw); d[1] += bfhi(pw); }
        u32x2* sp = (u32x2*)(SEL + (size_t)tok * 128 + 2 * lane); const u32x2 s2 = *sp;
        const float w0 = __uint_as_float(s2[0] & 0xffff0000u) * fgelu(d[0] * (1.0f / U_SCALE)) * (1.0f / V_SCALE);
        const float w1 = __uint_as_float(s2[1] & 0xffff0000u) * fgelu(d[1] * (1.0f / U_SCALE)) * (1.0f / V_SCALE);
        u32x2 o; o[0] = (pk2(0.f, w0) & 0xffff0000u) | (s2[0] & 0x3fffu); o[1] = (pk2(0.f, w1) & 0xffff0000u) | (s2[1] & 0x3fffu);
        *sp = o;
    }
}
__device__ __forceinline__ void phase_expert_v(const KP& p, LAS unsigned char* lds, volatile LAS unsigned* MISC, int l, int G) {
    const int tid = opaque_tid(), lane = tid & 63, w = __builtin_amdgcn_readfirstlane(tid >> 6), j = lane >> 3, c = lane & 7;
    const XSlice xs = xslice_of_block(p, MISC, G);
    const unsigned char* Vs = p.ws + WS_V + (size_t)xs.sl * 16384 * 128;
    const unsigned* SEL = (const unsigned*)(p.ws + WS_SEL);
    const float* g2 = (const float*)(p.ws + WS_MOD) + (size_t)l * 32 * NMODC + 5120;
    const bf16_t* X = (const bf16_t*)p.out; bf16_t* XO = (l == DEPTH - 1) ? (bf16_t*)(p.ws + WS_YS) : (bf16_t*)p.out;
    const int t0 = xs.rank * 8 + w, tstep = xs.nloc * 8;
    const bool b3 = (lane & 8) != 0;
    LAS unsigned char* ring = lds + w * 17920; LAS unsigned char* selb = ring + 16384;
    const int tlast = t0 + ((M - 1 - t0) / tstep) * tstep;
#define E2_CL(t) ((t) <= tlast ? (t) : tlast)
#define E2_DMA_SEL(t, par) do { const unsigned* sp = SEL + (size_t)E2_CL(t) * 128 + lane; \
            __builtin_amdgcn_global_load_lds(sp, (LAS unsigned*)(selb + (par) * 512), 4, 0, 0); __builtin_amdgcn_global_load_lds(sp + 64, (LAS unsigned*)(selb + (par) * 512 + 256), 4, 0, 0); } while (0)
#define E2_DMA_ROW(i, idxv) do { __builtin_amdgcn_global_load_lds((const unsigned*)(Vs + (size_t)((idxv) & 0x3fffu) * 128 + 16 * c), (LAS unsigned*)(ring + (i) * 1024), 16, 0, 0); } while (0)
    if (t0 < M) {
        E2_DMA_SEL(t0, 0); E2_DMA_SEL(t0 + tstep, 1);
        asm volatile("s_waitcnt vmcnt(0)" ::: "memory");
        u32x4 sc[4];
#pragma unroll
        for (int q = 0; q < 4; ++q) sc[q] = *(const LAS u32x4*)(selb + (16 * j + 4 * q) * 4);
#pragma unroll
        for (int i = 0; i < 16; ++i) E2_DMA_ROW(i, sc[i >> 2][i & 3]);
        LAS float* xbuf = (LAS float*)(ring + 16384 + 1024);
        { const bf16_t* xd = X + (size_t)t0 * D + xs.sl * 128 + 16 * c + 2 * j; __builtin_amdgcn_global_load_lds((const unsigned*)xd, (LAS unsigned*)xbuf, 4, 0, 0); }
        int par = 0, bcur = -1; f32x2 gv = {0.f, 0.f};
        for (int tok = t0; tok < M; tok += tstep, par ^= 1) {
            const int dim = xs.sl * 128 + 16 * c + 2 * j;
            const size_t xo = (size_t)tok * D + dim;
            if ((tok >> 11) != bcur) { bcur = tok >> 11; const f32x2 gl = *(const f32x2*)(g2 + (size_t)bcur * NMODC + dim); asm volatile("s_waitcnt vmcnt(0)" ::: "memory"); gv[0] = gl[0] * 1.0f; gv[1] = gl[1] * 1.0f; asm volatile("" : "+v"(gv)); }
            E2_DMA_SEL(tok + 2 * tstep, par);
            __builtin_amdgcn_global_load_lds((const unsigned*)(X + xo), (LAS unsigned*)xbuf, 4, 0, 0);
            asm volatile("s_waitcnt vmcnt(20)" ::: "memory");
            u32x4 sn[4];
#pragma unroll
            for (int q = 0; q < 4; ++q) sn[q] = *(const LAS u32x4*)(selb + (par ^ 1) * 512 + (16 * j + 4 * q) * 4);
            f32x2 o2[8];
#pragma unroll
            for (int q = 0; q < 8; ++q) o2[q] = (f32x2){0.f, 0.f};
#pragma unroll
            for (int i0 = 0; i0 < 16; i0 += 4) {
                asm volatile("s_waitcnt vmcnt(16)" ::: "memory");
                u32x4 row[4];
#pragma unroll
                for (int r = 0; r < 4; ++r) row[r] = *(const LAS u32x4*)(ring + (i0 + r) * 1024 + 16 * lane);
                asm volatile("s_waitcnt lgkmcnt(0)" ::: "memory");
#pragma unroll
                for (int r = 0; r < 4; ++r) E2_DMA_ROW(i0 + r, sn[(i0 + r) >> 2][(i0 + r) & 3]);
                {
                    const u32x2 wA = {sc[i0 >> 2][0], sc[i0 >> 2][1]}, wB = {sc[i0 >> 2][2], sc[i0 >> 2][3]};
#pragma unroll
                    for (int r = 0; r < 4; ++r)
#pragma unroll
                        for (int q = 0; q < 4; ++q) { const f32x2 lo = __builtin_amdgcn_cvt_pk_f32_fp8((int)row[r][q], false), hi = __builtin_amdgcn_cvt_pk_f32_fp8((int)row[r][q], true);
                            if (r & 1) { asm("v_pk_fma_f32 %0, %1, %2, %0 op_sel:[1,0,0] op_sel_hi:[1,1,1]" : "+v"(o2[2 * q]) : "v"(r < 2 ? wA : wB), "v"(lo));
                                         asm("v_pk_fma_f32 %0, %1, %2, %0 op_sel:[1,0,0] op_sel_hi:[1,1,1]" : "+v"(o2[2 * q + 1]) : "v"(r < 2 ? wA : wB), "v"(hi)); }
                            else       { asm("v_pk_fma_f32 %0, %1, %2, %0 op_sel:[0,0,0] op_sel_hi:[0,1,1]" : "+v"(o2[2 * q]) : "v"(r < 2 ? wA : wB), "v"(lo));
                                         asm("v_pk_fma_f32 %0, %1, %2, %0 op_sel:[0,0,0] op_sel_hi:[0,1,1]" : "+v"(o2[2 * q + 1]) : "v"(r < 2 ? wA : wB), "v"(hi)); } }
                }
            }
            float o[16];
#pragma unroll
            for (int q = 0; q < 8; ++q) { o[2 * q] = o2[q][0]; o[2 * q + 1] = o2[q][1]; }
            float r8[8], r4[4], r2[2];
#pragma unroll
            for (int k = 0; k < 8; ++k) { const u32x2 sw = __builtin_amdgcn_permlane32_swap(__float_as_uint(o[k]), __float_as_uint(o[8 + k]), false, false); r8[k] = __uint_as_float(sw[0]) + __uint_as_float(sw[1]); }
#pragma unroll
            for (int k = 0; k < 4; ++k) { const u32x2 sw = __builtin_amdgcn_permlane16_swap(__float_as_uint(r8[k]), __float_as_uint(r8[4 + k]), false, false); r4[k] = __uint_as_float(sw[0]) + __uint_as_float(sw[1]); }
#pragma unroll
            for (int k = 0; k < 2; ++k) { const float keep = b3 ? r4[2 + k] : r4[k], send = b3 ? r4[k] : r4[2 + k];
                r2[k] = keep + __uint_as_float(__builtin_amdgcn_update_dpp(0, __float_as_uint(send), 0x128, 0xF, 0xF, true)); }
            asm volatile("s_waitcnt vmcnt(16)" ::: "memory");
            { const unsigned xw = __float_as_uint(xbuf[lane]); *(unsigned*)(XO + xo) = pk2(bflo(xw) + gv[0] * r2[0], bfhi(xw) + gv[1] * r2[1]); }
#pragma unroll
            for (int q = 0; q < 4; ++q) sc[q] = sn[q];
        }
        asm volatile("s_waitcnt vmcnt(0)" ::: "memory");
    }
#undef E2_CL
#undef E2_DMA_SEL
#undef E2_DMA_ROW
}

__device__ __forceinline__ void phase_final(const KP& p, int G) {
    const int tid = opaque_tid(), lane = tid & 63, w = __builtin_amdgcn_readfirstlane(tid >> 6);
    const int gw = blockIdx.x * 8 + w, ngw = G * 8;
    const float* fg = p.in[I_FG];
    for (int r0 = gw * 4; r0 < M; r0 += ngw * 4) {
        f32x4 v[4][4]; float ss[4];
#pragma unroll
        for (int i = 0; i < 4; ++i) { const u32x2* xr = (const u32x2*)((const bf16_t*)(p.ws + WS_YS) + (size_t)(r0 + i) * D) + lane;
#pragma unroll
            for (int j = 0; j < 4; ++j) { const u32x2 xw = xr[64 * j]; v[i][j] = (f32x4){bflo(xw[0]), bfhi(xw[0]), bflo(xw[1]), bfhi(xw[1])}; } }
#pragma unroll
        for (int i = 0; i < 4; ++i) { float t = 0.f;
#pragma unroll
            for (int j = 0; j < 4; ++j) t += (v[i][j][0] * v[i][j][0] + v[i][j][1] * v[i][j][1]) + (v[i][j][2] * v[i][j][2] + v[i][j][3] * v[i][j][3]);
            ss[i] = t; }
#pragma unroll
        for (int o = 1; o < 64; o <<= 1) {
#pragma unroll
            for (int i = 0; i < 4; ++i) ss[i] += __shfl_xor(ss[i], o); }
#pragma unroll
        for (int j = 0; j < 4; ++j) { const f32x4 g4 = *(const f32x4*)(fg + 256 * j + 4 * lane);
#pragma unroll
            for (int i = 0; i < 4; ++i) { const float rstd = __builtin_amdgcn_rsqf(ss[i] * (1.0f / D) + EPS); ((f32x4*)(p.out + (size_t)(r0 + i) * D) + lane)[64 * j] = v[i][j] * rstd * g4; } }
    }
}

__global__ void __launch_bounds__(512, 2) mk_fwd(KP p_) {
    extern __shared__ __attribute__((aligned(16))) unsigned char lds_raw[];
    LAS unsigned char* lds = (LAS unsigned char*)lds_raw;
    const int tid = threadIdx.x, G = gridDim.x;
    volatile LAS unsigned* MISC = (volatile LAS unsigned*)(lds + MISC_OFF);
    for (int i = tid; i < LDS_BYTES / 4; i += 512) ((LAS unsigned*)lds)[i] = 0u;
    __syncthreads();
    XcdBarrier bar = xcd_barrier_post((unsigned*)(p_.ws + WS_CTL) + 4096, MISC + 8);
    if (tid == 0) { const unsigned myx = xb_xcc_id(); MISC[16] = myx; MISC[17] = xb_add((unsigned*)(p_.ws + WS_CTL) + 8192 + 64 * (myx & 15u), 1u); }
    __syncthreads();
    const int lo = p_.gp_lo, hi = p_.gp_hi;
#ifndef PH_MASK
#define PH_MASK 0xFFFFF
#endif
#define IN(k) (lo <= (k) && (k) < hi)
#define EN(b) ((PH_MASK >> (b)) & 1)
#ifndef PH_REPEAT
#define PH_REPEAT 0
#endif
#define NREP(b) (((PH_REPEAT >> (b)) & 1) ? 2 : 1)
#define SEAM(k) do { if ((k) + 1 < hi) xcd_barrier(bar); } while (0)
    if (EN(12) && IN(GP_SETUP)) { const KP p = load_kp(); phase_setup(p, lds, G); SEAM(GP_SETUP); }
    for (int l = 0; l < DEPTH; ++l) {
        const int g0 = 1 + l * NPH;
        if (EN(0) && IN(g0 + 0)) { _Pragma("nounroll") for (int rep = 0; rep < NREP(0); ++rep) { const KP p = load_kp(); phase_conv_norm1(p, lds, l, G); } SEAM(g0 + 0); }
        if (EN(1) && IN(g0 + 1)) { const KP p = load_kp();
            pg8::Gemm g{(const bf16_t*)(p.ws + WS_H), (const bf16_t*)(p.ws + WS_WIN), M, 3072, D / 2, D / 2, D / 2}; pg8::StaticOrder S; S.init(M, 3072, G, (int)blockIdx.x);
            pg8::EpiStoreBf16 E{(bf16_t*)(p.ws + WS_R0), 3072, 1.0f / (WIN_SCALE * HIN_SCALE)};
            _Pragma("nounroll") for (int rep = 0; rep < NREP(1); ++rep) pg8::gemm_phase<pg8::EpiStoreBf16, pg8::StaticOrder, false, true, true>(lds, g, S, E);
            SEAM(g0 + 1);
        }
        if (EN(2) && IN(g0 + 2)) { _Pragma("nounroll") for (int rep = 0; rep < NREP(2); ++rep) { const KP p = load_kp(); phase_hgrn2(p, lds, l, G); } SEAM(g0 + 2); }
        if (EN(3) && IN(g0 + 3)) { const KP p = load_kp();
            pg8::Gemm g{(const bf16_t*)(p.ws + WS_H), (const bf16_t*)(p.ws + WS_WIN) + (size_t)3072 * (D / 2), M, 4096, D / 2, D / 2, D / 2}; pg8::StaticOrder S; S.init(M, 4096, G, (int)blockIdx.x);
            pg8::EpiStoreBf16 E{(bf16_t*)(p.ws + WS_R0), 4096, 1.0f / (WIN_SCALE * HIN_SCALE)};
            _Pragma("nounroll") for (int rep = 0; rep < NREP(3); ++rep) pg8::gemm_phase<pg8::EpiStoreBf16, pg8::StaticOrder, false, true, true>(lds, g, S, E);
            SEAM(g0 + 3);
        }
        #if DBG_SELFCHECK
        if (EN(4) && IN(g0 + 4)) {
#pragma nounroll
            for (int rep = 0; rep < 2; ++rep) { const KP p = load_kp(); size_t yo = rep ? WS_H : WS_YS; asm volatile("" : "+s"(yo)); phase_s5(p, lds, l, G, yo); SEAM(g0 + 4); }
            const KP p = load_kp();
            const unsigned* a = (const unsigned*)(p.ws + WS_YS); const unsigned* b2 = (const unsigned*)(p.ws + WS_H); unsigned bad = 0;
            for (size_t i = (size_t)blockIdx.x * 512 + opaque_tid(); i < (size_t)M * D / 2; i += (size_t)G * 512) bad += (a[i] != b2[i]) ? 1u : 0u;
            if (bad) atomicAdd((unsigned*)(p.ws + WS_CTL) + 64, bad);
            { const unsigned* h1 = (const unsigned*)(p.ws + WS_CTL) + 65536; const unsigned* h2 = h1 + 8192; const int u2 = blockIdx.x * 512 + opaque_tid();
              if (u2 < 2048) { if (h1[u2 * 4] != h2[u2 * 4]) atomicAdd((unsigned*)(p.ws + WS_CTL) + 128, 1u); if (h1[u2 * 4 + 1] != h2[u2 * 4 + 1]) atomicAdd((unsigned*)(p.ws + WS_CTL) + 192, 1u); if (h1[u2 * 4 + 2] != h2[u2 * 4 + 2]) atomicAdd((unsigned*)(p.ws + WS_CTL) + 256, 1u); } }
            SEAM(g0 + 4); }
#else
        if (EN(4) && IN(g0 + 4)) { _Pragma("nounroll") for (int rep = 0; rep < NREP(4); ++rep) { const KP p = load_kp(); phase_s5(p, lds, l, G, WS_YS); } SEAM(g0 + 4); }
#endif
        if (EN(5) && IN(g0 + 5)) { const KP p = load_kp();
            pg8::Gemm g{(const bf16_t*)(p.ws + WS_YS), (const bf16_t*)(p.ws + WS_WGLU), M, D, D, D, D}; pg8::StaticOrder S; S.init(M, D, G, (int)blockIdx.x);
            pg8::EpiGlu E{(const bf16_t*)(p.ws + WS_R0), (const bf16_t*)(p.ws + WS_YS), (const bf16_t*)(p.ws + WS_OR), (const float*)(p.ws + WS_SSQ), p.in[I_HNG] + l * 128, p.in[I_GLUB] + l * D, (bf16_t*)(p.ws + WS_H)};
            _Pragma("nounroll") for (int rep = 0; rep < NREP(5); ++rep) pg8::gemm_phase<pg8::EpiGlu, pg8::StaticOrder, true, true>(lds, g, S, E);
            SEAM(g0 + 5);
        }
        if (EN(6) && IN(g0 + 6)) { const KP p = load_kp();
            pg8::Gemm g{(const bf16_t*)(p.ws + WS_H), (const bf16_t*)(p.ws + WS_WOUT), M, D, D / 2, D / 2, D / 2}; pg8::StaticOrder S; S.init(M, D, G, (int)blockIdx.x);
            pg8::EpiStoreBf16 E{(bf16_t*)(p.ws + WS_OR), D, 1.0f / (WO_SCALE * MG_SCALE)};
            pg8::gemm_phase<pg8::EpiStoreBf16, pg8::StaticOrder, false, true, true>(lds, g, S, E);
            SEAM(g0 + 6);
        }
        if (EN(7) && IN(g0 + 7)) { const KP p = load_kp();
            const int t2 = opaque_tid(), lane = t2 & 63, wave = __builtin_amdgcn_readfirstlane(t2 >> 6);
            if (l == 0) resid_norm_rows<false>(p.in[I_X], (bf16_t*)p.out, (const bf16_t*)(p.ws + WS_OR), (bf16_t*)(p.ws + WS_H), p.in[I_N2G] + l * D, (const float*)(p.ws + WS_MOD) + (size_t)l * 32 * NMODC, blockIdx.x * 8 + wave, G * 8, lane);
            else resid_norm_rows<true>(p.out, (bf16_t*)p.out, (const bf16_t*)(p.ws + WS_OR), (bf16_t*)(p.ws + WS_H), p.in[I_N2G] + l * D, (const float*)(p.ws + WS_MOD) + (size_t)l * 32 * NMODC, blockIdx.x * 8 + wave, G * 8, lane);
            SEAM(g0 + 7);
        }
        if (EN(8) && IN(g0 + 8)) { const KP p = load_kp();
            pg8::Gemm g{(const bf16_t*)(p.ws + WS_H), (const bf16_t*)(p.ws + WS_WQ), M, 2048, D, D, D}; pg8::StaticOrder S; S.init(M, 2048, G, (int)blockIdx.x);
            pg8::EpiStoreQ E{(bf16_t*)(p.ws + WS_R0)};
            _Pragma("nounroll") for (int rep = 0; rep < NREP(8); ++rep) pg8::gemm_phase<pg8::EpiStoreQ, pg8::StaticOrder, true, true>(lds, g, S, E);
            SEAM(g0 + 8);
        }
        if (EN(9) && IN(g0 + 9)) { _Pragma("nounroll") for (int rep = 0; rep < NREP(9); ++rep) { const KP p = load_kp(); phase_topk(p, lds, G); } SEAM(g0 + 9); }
        if (EN(10) && IN(g0 + 10)) {
            { const KP p = load_kp(); phase_expert_u(p, lds, MISC, G); } xcd_barrier(bar);
            { const KP p = load_kp(); phase_expert_w(p, G); } xcd_barrier(bar);
            { const KP p = load_kp(); phase_expert_v(p, lds, MISC, l, G); }
            SEAM(g0 + 10); }
    }
    if (EN(13) && IN(GP_FINAL)) { const KP p = load_kp(); phase_final(p, G); }
#undef IN
#undef EN
#undef NREP
#undef SEAM
}

extern "C" void kernel_launch(void* const* d_in, const int* in_sizes, int n_in, void* d_out, int out_size, void* d_ws, size_t ws_size, hipStream_t stream) {
    static int grid = 0;
    if (grid == 0) {
        if (n_in != 25 || out_size != M * D || ws_size < WS_END) { fprintf(stderr, "kernel_launch: unexpected shapes (n_in %d, out %d, ws %zu < %zu)\n", n_in, out_size, ws_size, (size_t)WS_END); grid = -1; return; }
        int dev = 0, cus = 0, per_cu = 0;
        if (hipGetDevice(&dev) != hipSuccess || hipDeviceGetAttribute(&cus, hipDeviceAttributeMultiprocessorCount, dev) != hipSuccess) { grid = -1; return; }
        if (hipFuncSetAttribute((const void*)mk_fwd, hipFuncAttributeMaxDynamicSharedMemorySize, LDS_BYTES) != hipSuccess) { fprintf(stderr, "kernel_launch: hipFuncSetAttribute failed\n"); grid = -1; return; }
        if (hipOccupancyMaxActiveBlocksPerMultiprocessor(&per_cu, (const void*)mk_fwd, 512, LDS_BYTES) != hipSuccess || per_cu < 1) fprintf(stderr, "kernel_launch: occupancy query says %d\n", per_cu);
        (void)hipGetLastError();
        grid = cus;
    }
    if (grid < 0) return;
    (void)hipMemsetAsync((char*)d_ws + WS_CTL, 0, CTL_ZERO_BYTES, stream);
    KP a{};
    for (int i = 0; i < 25; ++i) a.in[i] = (const float*)d_in[i];
    a.out = (float*)d_out; a.ws = (unsigned char*)d_ws;
#if MK_LAUNCHES == 1
    a.gp_lo = 0; a.gp_hi = GP_END;
    hipLaunchKernelGGL(mk_fwd, dim3(grid), dim3(512), LDS_BYTES, stream, a);
#else
    for (int gp = 0; gp < GP_END; ++gp) { a.gp_lo = gp; a.gp_hi = gp + 1; hipLaunchKernelGGL(mk_fwd, dim3(grid), dim3(512), LDS_BYTES, stream, a); }
#endif
}
```

```cpp
#include <hip/hip_runtime.h>
#include <cstdio>
#include <cstdint>

#define DBG_HASHSEL 0
#define DBG_H2_FROM_INPUT 0
#define DBG_NO_YA 0
#define DBG_NO_YB 0
#define DBG_NO_ACC 0
#define DBG_NO_GB 0
#define DBG_S5_NOSSM 0
#define DBG_S5_NOREC 0
#define DBG_SELFCHECK 0
#ifndef MK_LAUNCHES
#define MK_LAUNCHES 1
#endif

#define LAS __attribute__((address_space(3)))
typedef unsigned short bf16_t;
typedef short bf16x8 __attribute__((ext_vector_type(8)));
typedef float f32x2 __attribute__((ext_vector_type(2)));
typedef float f32x4 __attribute__((ext_vector_type(4)));
typedef float f32x16 __attribute__((ext_vector_type(16)));
typedef unsigned u32x2 __attribute__((ext_vector_type(2)));
typedef unsigned u32x4 __attribute__((ext_vector_type(4)));
typedef __bf16 bf16v2 __attribute__((ext_vector_type(2)));
typedef int i32x8 __attribute__((ext_vector_type(8)));
typedef int i32x4 __attribute__((ext_vector_type(4)));

constexpr int D = 1024, BATCH = 32, SEQ = 2048, DEPTH = 4, M = BATCH * SEQ;
constexpr int INC = 7168, NMODC = 6 * D;
constexpr int NPH = 11, GP_SETUP = 0, GP_FINAL = 1 + DEPTH * NPH, GP_END = GP_FINAL + 1;
constexpr float EPS = 1e-6f;
constexpr float U_SCALE = 64.0f, V_SCALE = 4.0f;
constexpr size_t TAB_BYTES = (size_t)16384 * 1024;
constexpr float WIN_SCALE = 64.0f, HIN_SCALE = 4.0f;
constexpr float WO_SCALE = 64.0f, MG_SCALE = 8.0f;

constexpr size_t MiB = 1u << 20;
constexpr size_t WS_CTL = 0, CTL_ZERO_BYTES = 1 * MiB;
constexpr size_t WS_MOD = 1 * MiB;
constexpr size_t WS_LB = 4 * MiB;
constexpr size_t WS_ABAR = 4 * MiB + 65536;
constexpr size_t WS_BOP = 5 * MiB;
constexpr size_t WS_COP = 6 * MiB;
constexpr size_t WS_WIN = 8 * MiB;
constexpr size_t WS_WGLU = 22 * MiB;
constexpr size_t WS_WOUT = 24 * MiB;
constexpr size_t WS_WQ = 26 * MiB;
constexpr size_t WS_KEYS = 30 * MiB;
constexpr size_t WS_U = 32 * MiB;
constexpr size_t WS_V = 64 * MiB;
constexpr size_t WS_H = 96 * MiB;
constexpr size_t WS_OR = 224 * MiB;
constexpr size_t WS_SSQ = 352 * MiB;
constexpr size_t WS_R0 = 354 * MiB;
constexpr size_t WS_SEL = WS_R0 + 256 * MiB;
constexpr size_t WS_YS = WS_R0 + 512 * MiB;
constexpr size_t WS_END = WS_YS + 128 * MiB;

constexpr int LDS_BYTES = 147456;
constexpr int MISC_OFF = LDS_BYTES - 256;

__device__ __forceinline__ unsigned pk2(float lo, float hi) { f32x2 v = {lo, hi}; bf16v2 r = __builtin_convertvector(v, bf16v2); return __builtin_bit_cast(unsigned, r); }
__device__ __forceinline__ float bflo(unsigned w) { return __uint_as_float(w << 16); }
__device__ __forceinline__ float bfhi(unsigned w) { return __uint_as_float(w & 0xffff0000u); }
__device__ __forceinline__ float fsigmoid(float x) { return __builtin_amdgcn_rcpf(1.0f + __expf(-x)); }
__device__ __forceinline__ float fsilu(float x) { return x * fsigmoid(x); }
__device__ __forceinline__ float fgelu(float x) { return x * fsigmoid(1.5957691216f * (x + 0.044715f * x * x * x)); }
__device__ __forceinline__ float wave_sum(float v) {
#pragma unroll
    for (int o = 1; o < 64; o <<= 1) v += __shfl_xor(v, o);
    return v;
}
#define LDS_WAIT() asm volatile("s_waitcnt lgkmcnt(0)" ::: "memory")
__device__ __forceinline__ int opaque_tid() { int t = threadIdx.x; asm volatile("" : "+v"(t)); return t; }

namespace pg8 {
#define PG8_LAS __attribute__((address_space(3)))
constexpr int BM = 256, BK = 64, HALF = 128, HTB = HALF * BK * 2, STAGE_BYTES = 8 * HTB, NXCD = 8, WGM = 8;
__host__ __device__ __forceinline__ int lds_byte(int r, int c) { const int st = (r >> 4) * 2 + (c >> 5), rr = r & 15, cc = c & 31, ob = rr * 64 + cc * 2; return st * 1024 + (ob ^ (((ob >> 9) & 1) << 5)); }
__host__ __device__ __forceinline__ void stage_rc(int b, int& R, int& C) { const int st = b / 1024, sb = b % 1024, swz = sb ^ (((sb >> 9) & 1) << 5); R = (st >> 1) * 16 + swz / 64; C = (st & 1) * 32 + (swz % 64) / 2; }
__host__ __device__ __forceinline__ int perm32(int rho) { const int n = rho >> 4, i = rho & 15; return 8 * (i >> 2) + 4 * n + (i & 3); }
struct Unit { int pm, pn; };
struct Gemm { const bf16_t* A; const bf16_t* Bt; int M, N, K, lda, ldb; };
struct StaticOrder {
    int nM, nN, nwg, G, c;
    __host__ __device__ void init(int M_, int N_, int G_, int c_) { nM = M_ / BM; nN = N_ / BM; nwg = nM * nN; G = G_; c = c_; }
    __host__ __device__ bool next(int i, Unit& u) const {
        const long L = (long)i * G + c; if (L >= nwg) return false;
        int wgid = (int)L; { const int q = nwg / NXCD, r = nwg % NXCD, xcd = wgid % NXCD, off = wgid / NXCD; wgid = (xcd < r ? xcd * (q + 1) : r * (q + 1) + (xcd - r) * q) + off; }
        const int nig = WGM * nN, gid = wgid / nig, fm = gid * WGM, gsz = (nM - fm) < WGM ? (nM - fm) : WGM;
        u.pm = fm + ((wgid % nig) % gsz); u.pn = (wgid % nig) / gsz; return true;
    }
    __device__ __forceinline__ void a_ready(const Unit&) const {}
    __device__ __forceinline__ void done(const Unit&) const {}
};
template <class Epi, class Sched, bool ALIGN_EPI = false, bool SP2 = false, bool F8 = false>
__device__ __forceinline__ void gemm_phase(PG8_LAS unsigned char* lds, const Gemm g, const Sched& S, const Epi& E) {
    const int tid = opaque_tid(), wid = __builtin_amdgcn_readfirstlane(tid >> 6), lane = tid & 63, wr = wid >> 2, wc = wid & 3, fr = lane & 15, fq = lane >> 4;
    const int K = g.K, nt = K / BK;
    unsigned voffA[2], voffB[2];
#pragma unroll
    for (int i = 0; i < 2; ++i) { int R, C; stage_rc(tid * 16 + i * 8192, R, C); const int Rb = Epi::PERM ? ((R & ~31) + perm32(R & 31)) : R;
        voffA[i] = (unsigned)(R * g.lda + C) * 2u; voffB[i] = (unsigned)(Rb * g.ldb + C) * 2u; }
    const size_t kstep = (size_t)(BK * 2);
    const size_t hstepA = (size_t)HALF * g.lda * 2, hstepB = (size_t)HALF * g.ldb * 2;
    const size_t tstepA = 2 * hstepA, tstepB = 2 * hstepB;
    const unsigned ldsw = (unsigned)wid * 1024u;
    const int aoff = lds_byte(wr * 64 + fr, fq * 8), boff = lds_byte(wc * 32 + fr, fq * 8);
#define PG8_SA(b, h) (((b) * 2 + (h)) * HTB)
#define PG8_SB(b, h) ((4 + (b) * 2 + (h)) * HTB)
#define PG8_STAGE(bufoff, gbase, voff) do { _Pragma("unroll") for (int _i = 0; _i < 2; ++_i) \
        __builtin_amdgcn_global_load_lds((const unsigned*)((const char*)(gbase) + (voff)[_i]), (PG8_LAS unsigned*)(lds + (bufoff) + ldsw + _i * 8192), 16, 0, 0); } while (0)
#define PG8_LD8(p) __builtin_shufflevector(*(const PG8_LAS i32x4*)(p), *(const PG8_LAS i32x4*)((p) + 1024), 0, 1, 2, 3, 4, 5, 6, 7)
#define PG8_LDA(dst, b, h) do { if constexpr (F8) { _Pragma("unroll") for (int m = 0; m < 4; ++m) dst##8[m] = PG8_LD8(lds + PG8_SA(b, h) + aoff + m * 2048); } \
        else { _Pragma("unroll") for (int m = 0; m < 4; ++m) _Pragma("unroll") for (int k = 0; k < 2; ++k) dst[m][k] = *(const PG8_LAS bf16x8*)(lds + PG8_SA(b, h) + aoff + m * 2048 + k * 1024); } } while (0)
#define PG8_LDB(dst, b, h) do { if constexpr (F8) { _Pragma("unroll") for (int n = 0; n < 2; ++n) dst##8[n] = PG8_LD8(lds + PG8_SB(b, h) + boff + n * 2048); } \
        else { _Pragma("unroll") for (int n = 0; n < 2; ++n) _Pragma("unroll") for (int k = 0; k < 2; ++k) dst[n][k] = *(const PG8_LAS bf16x8*)(lds + PG8_SB(b, h) + boff + n * 2048 + k * 1024); } } while (0)
#define PG8_MMA(ai, bj, At, Bt) do { __builtin_amdgcn_s_setprio(1); _Pragma("unroll") for (int m = 0; m < 4; ++m) _Pragma("unroll") for (int n = 0; n < 2; ++n) { \
        if constexpr (F8) {   \
            acc[ai][bj][m][n] = __builtin_amdgcn_mfma_scale_f32_16x16x128_f8f6f4(Bt##8[n], At##8[m], acc[ai][bj][m][n], 0, 0, 0, 0x7f7f7f7f, 0, 0x7f7f7f7f); \
        } else { _Pragma("unroll") for (int k = 0; k < 2; ++k) acc[ai][bj][m][n] = __builtin_amdgcn_mfma_f32_16x16x32_bf16(Bt[n][k], At[m][k], acc[ai][bj][m][n], 0, 0, 0); } } \
        __builtin_amdgcn_s_setprio(0); } while (0)
#define PG8_WAIT_V(n) asm volatile("s_waitcnt vmcnt(" #n ")" ::: "memory")
#define PG8_WAIT_L(n) asm volatile("s_waitcnt lgkmcnt(" #n ")" ::: "memory")
#define PG8_BAR __builtin_amdgcn_s_barrier()
#define PG8_SCHED __builtin_amdgcn_sched_barrier(0)
    Unit cur, nxt; int ui = 0;
    if (!S.next(0, cur)) return;
    f32x4 acc[2][2][4][2];
#pragma unroll
    for (int a = 0; a < 2; ++a)
#pragma unroll
        for (int b = 0; b < 2; ++b)
#pragma unroll
            for (int m = 0; m < 4; ++m)
#pragma unroll
                for (int n = 0; n < 2; ++n) acc[a][b][m][n] = (f32x4){0.f, 0.f, 0.f, 0.f};
    bf16x8 At[4][2], B0[2][2], B1[2][2]; i32x8 At8[4], B08[2], B18[2];
    const char* cA = (const char*)g.A + (size_t)cur.pm * tstepA; const char* cB = (const char*)g.Bt + (size_t)cur.pn * tstepB;
    S.a_ready(cur);
    if constexpr (SP2) {
        PG8_STAGE(PG8_SB(0, 0), cB, voffB); PG8_STAGE(PG8_SB(0, 1), cB + hstepB, voffB); PG8_STAGE(PG8_SA(0, 0), cA, voffA); PG8_STAGE(PG8_SA(0, 1), cA + hstepA, voffA);
        if (wr == 1) PG8_BAR;
        PG8_WAIT_V(2); PG8_BAR;
        PG8_STAGE(PG8_SB(1, 0), cB + kstep, voffB); PG8_STAGE(PG8_SA(1, 0), cA + kstep, voffA); PG8_STAGE(PG8_SB(1, 1), cB + hstepB + kstep, voffB);
        PG8_WAIT_V(6); PG8_BAR;
    } else {
        PG8_STAGE(PG8_SB(0, 0), cB, voffB); PG8_STAGE(PG8_SA(0, 0), cA, voffA); PG8_STAGE(PG8_SB(0, 1), cB + hstepB, voffB); PG8_STAGE(PG8_SA(0, 1), cA + hstepA, voffA);
        if (wr == 1) PG8_BAR;
        PG8_WAIT_V(4); PG8_BAR;
        PG8_STAGE(PG8_SB(1, 0), cB + kstep, voffB); PG8_STAGE(PG8_SA(1, 0), cA + kstep, voffA); PG8_STAGE(PG8_SB(1, 1), cB + hstepB + kstep, voffB);
        PG8_WAIT_V(6); PG8_BAR;
    }
    for (;;) {
        const bool has_next = S.next(ui + 1, nxt);
        const char* nA = has_next ? (const char*)g.A + (size_t)nxt.pm * tstepA : cA; const char* nB = has_next ? (const char*)g.Bt + (size_t)nxt.pn * tstepB : cB;
        for (int t = 0; t < nt; t += 2) {
            const bool last = (t == nt - 2);
            const char* a1 = cA + (size_t)(t + 1) * kstep;
            const char* a2 = last ? nA : cA + (size_t)(t + 2) * kstep; const char* b2 = last ? nB : cB + (size_t)(t + 2) * kstep;
            const char* a3 = a2 + kstep; const char* b3 = b2 + kstep;
            if (last && has_next) S.a_ready(nxt);
            if constexpr (SP2) {
            PG8_LDB(B0, 0, 0); PG8_LDB(B1, 0, 1); PG8_SCHED; PG8_LDA(At, 0, 0); PG8_STAGE(PG8_SA(1, 1), a1 + hstepA, voffA);
            PG8_WAIT_V(8); PG8_WAIT_L(0); PG8_BAR; PG8_MMA(0, 0, At, B0); PG8_MMA(0, 1, At, B1); PG8_BAR; PG8_SCHED;
            PG8_LDA(At, 0, 1); PG8_STAGE(PG8_SB(0, 0), b2, voffB); PG8_STAGE(PG8_SB(0, 1), b2 + hstepB, voffB); PG8_STAGE(PG8_SA(0, 0), a2, voffA);
            PG8_WAIT_V(8); PG8_WAIT_L(0); PG8_BAR; PG8_MMA(1, 0, At, B0); PG8_MMA(1, 1, At, B1); PG8_BAR; PG8_SCHED;
            PG8_LDB(B0, 1, 0); PG8_LDB(B1, 1, 1); PG8_SCHED; PG8_LDA(At, 1, 0); PG8_STAGE(PG8_SA(0, 1), a2 + hstepA, voffA);
            PG8_WAIT_V(8); PG8_WAIT_L(0); PG8_BAR; PG8_MMA(0, 0, At, B0); PG8_MMA(0, 1, At, B1); PG8_BAR; PG8_SCHED;
            PG8_LDA(At, 1, 1); PG8_STAGE(PG8_SB(1, 0), b3, voffB); PG8_STAGE(PG8_SB(1, 1), b3 + hstepB, voffB); PG8_STAGE(PG8_SA(1, 0), a3, voffA);
            PG8_WAIT_V(8); PG8_WAIT_L(0); PG8_BAR; PG8_MMA(1, 0, At, B0); PG8_MMA(1, 1, At, B1); PG8_BAR; PG8_SCHED;
            } else {
            PG8_LDB(B0, 0, 0); PG8_SCHED; PG8_LDA(At, 0, 0); PG8_STAGE(PG8_SA(1, 1), a1 + hstepA, voffA);
            PG8_WAIT_L(8); PG8_BAR; PG8_WAIT_L(0); PG8_MMA(0, 0, At, B0); PG8_BAR; PG8_SCHED;
            PG8_LDB(B1, 0, 1); PG8_STAGE(PG8_SB(0, 0), b2, voffB);
            PG8_BAR; PG8_WAIT_L(0); PG8_MMA(0, 1, At, B1); PG8_BAR;
            PG8_LDA(At, 0, 1); PG8_STAGE(PG8_SA(0, 0), a2, voffA);
            PG8_BAR; PG8_WAIT_L(0); PG8_MMA(1, 0, At, B0); PG8_BAR; PG8_SCHED;
            PG8_STAGE(PG8_SB(0, 1), b2 + hstepB, voffB);
            PG8_WAIT_V(6); PG8_BAR; PG8_MMA(1, 1, At, B1); PG8_BAR;
            PG8_LDB(B0, 1, 0); PG8_SCHED; PG8_LDA(At, 1, 0); PG8_STAGE(PG8_SA(0, 1), a2 + hstepA, voffA);
            PG8_WAIT_L(8); PG8_BAR; PG8_WAIT_L(0); PG8_MMA(0, 0, At, B0); PG8_BAR; PG8_SCHED;
            PG8_LDB(B1, 1, 1); PG8_STAGE(PG8_SB(1, 0), b3, voffB);
            PG8_BAR; PG8_WAIT_L(0); PG8_MMA(0, 1, At, B1); PG8_BAR;
            PG8_LDA(At, 1, 1); PG8_STAGE(PG8_SA(1, 0), a3, voffA);
            PG8_BAR; PG8_WAIT_L(0); PG8_MMA(1, 0, At, B0); PG8_BAR; PG8_SCHED;
            PG8_STAGE(PG8_SB(1, 1), b3 + hstepB, voffB);
            PG8_WAIT_V(6); PG8_BAR; PG8_MMA(1, 1, At, B1); PG8_BAR;
            }
        }
        if constexpr (ALIGN_EPI) { if (wr == 0) PG8_BAR; }
        E(acc, cur, wr, wc, fr, fq);
        if (!has_next) break;
#pragma unroll
        for (int a = 0; a < 2; ++a)
#pragma unroll
            for (int b = 0; b < 2; ++b)
#pragma unroll
                for (int m = 0; m < 4; ++m)
#pragma unroll
                    for (int n = 0; n < 2; ++n) acc[a][b][m][n] = (f32x4){0.f, 0.f, 0.f, 0.f};
        cur = nxt; cA = nA; cB = nB; ++ui;
        if constexpr (ALIGN_EPI) { if (wr == 1) PG8_BAR; }
    }
    PG8_WAIT_V(0);
    if constexpr (!ALIGN_EPI) { if (wr == 0) PG8_BAR; }
    PG8_BAR;
#undef PG8_SA
#undef PG8_SB
#undef PG8_STAGE
#undef PG8_LDA
#undef PG8_LD8
#undef PG8_LDB
#undef PG8_MMA
#undef PG8_WAIT_V
#undef PG8_WAIT_L
#undef PG8_BAR
#undef PG8_SCHED
}

struct EpiStoreBf16 {
    static constexpr bool PERM = true;
    bf16_t* O; int ldc; float scale;
    __device__ __forceinline__ void operator()(const f32x4 (&acc)[2][2][4][2], const Unit& u, int wr, int wc, int fr, int fq) const {
        const int row0 = u.pm * BM + wr * 64 + fr, col0 = u.pn * BM + wc * 32 + 8 * fq;
#pragma unroll
        for (int ai = 0; ai < 2; ++ai)
#pragma unroll
            for (int m = 0; m < 4; ++m) { bf16_t* rowp = O + (size_t)(row0 + ai * HALF + m * 16) * ldc + col0;
#pragma unroll
                for (int bj = 0; bj < 2; ++bj) { const f32x4 v0 = acc[ai][bj][m][0] * scale, v1 = acc[ai][bj][m][1] * scale;
                    u32x4 w; w.x = pk2(v0[0], v0[1]); w.y = pk2(v0[2], v0[3]); w.z = pk2(v1[0], v1[1]); w.w = pk2(v1[2], v1[3]);
                    *(u32x4*)(rowp + bj * HALF) = w; } }
    }
};
struct EpiStoreQ {
    static constexpr bool PERM = true;
    bf16_t* O;
    __device__ __forceinline__ void operator()(const f32x4 (&acc)[2][2][4][2], const Unit& u, int wr, int wc, int fr, int fq) const {
        const int row0 = u.pm * BM + wr * 64 + fr, col0 = u.pn * BM + wc * 32 + 8 * fq;
#pragma unroll
        for (int ai = 0; ai < 2; ++ai)
#pragma unroll
            for (int m = 0; m < 4; ++m) { const int row = row0 + ai * HALF + m * 16, tg = row >> 5, t = row & 31;
#pragma unroll
                for (int bj = 0; bj < 2; ++bj) { const int c0 = col0 + bj * HALF, h = c0 >> 8, pp = (c0 >> 7) & 1, cc = c0 & 127, ks = cc >> 4, hh = (cc >> 3) & 1;
                    const f32x4 v0 = acc[ai][bj][m][0], v1 = acc[ai][bj][m][1];
                    u32x4 w; w.x = pk2(v0[0], v0[1]); w.y = pk2(v0[2], v0[3]); w.z = pk2(v1[0], v1[1]); w.w = pk2(v1[2], v1[3]);
                    *(u32x4*)(O + ((size_t)((((tg * 8 + h) * 2 + pp) * 8 + ks) * 64 + hh * 32 + t)) * 8) = w; } }
    }
};
struct EpiWout {
    static constexpr bool PERM = false;
    const float* xs; float* out; const float* g1;
    __device__ __forceinline__ void operator()(const f32x4 (&acc)[2][2][4][2], const Unit& u, int wr, int wc, int fr, int fq) const {
        const int row0 = u.pm * BM + wr * 64 + fr, col0 = u.pn * BM + wc * 32 + 4 * fq;
        const int b = (u.pm * BM) >> 11;
        f32x4 gv[2][2];
#pragma unroll
        for (int bj = 0; bj < 2; ++bj)
#pragma unroll
            for (int n = 0; n < 2; ++n) gv[bj][n] = *(const f32x4*)(g1 + (size_t)b * NMODC + col0 + bj * HALF + n * 16);
#pragma unroll
        for (int ai = 0; ai < 2; ++ai)
#pragma unroll
            for (int m = 0; m < 4; ++m) { const size_t off = (size_t)(row0 + ai * HALF + m * 16) * D + col0;
#pragma unroll
                for (int bj = 0; bj < 2; ++bj)
#pragma unroll
                    for (int n = 0; n < 2; ++n) { const f32x4 xv = *(const f32x4*)(xs + off + bj * HALF + n * 16);
                        *(f32x4*)(out + off + bj * HALF + n * 16) = xv + gv[bj][n] * acc[ai][bj][m][n]; } }
    }
};
struct EpiGlu {
    static constexpr bool PERM = true;
    const bf16_t* PB; const bf16_t* YS; const bf16_t* ORAW; const float* SSQ; const float* ng; const float* gb_; bf16_t* O;
    __device__ __forceinline__ void operator()(const f32x4 (&acc)[2][2][4][2], const Unit& u, int wr, int wc, int fr, int fq) const {
        const int row0 = u.pm * BM + wr * 64 + fr, col0 = u.pn * BM + wc * 32 + 8 * fq;
#pragma unroll
        for (int bj = 0; bj < 2; ++bj) {
            const int c = col0 + bj * HALF, head = c >> 7;
            const f32x4 n0 = *(const f32x4*)(ng + (c & 127)), n1 = *(const f32x4*)(ng + (c & 127) + 4);
            const f32x4 b0 = *(const f32x4*)(gb_ + c), b1 = *(const f32x4*)(gb_ + c + 4);
            const float ngv[8] = {n0[0], n0[1], n0[2], n0[3], n1[0], n1[1], n1[2], n1[3]};
            const float bbv[8] = {b0[0], b0[1], b0[2], b0[3], b1[0], b1[1], b1[2], b1[3]};
#pragma unroll
            for (int ai = 0; ai < 2; ++ai)
#pragma unroll
                for (int m = 0; m < 4; ++m) {
                    const int row = row0 + ai * HALF + m * 16;
                    const bf16_t* pb = PB + (size_t)row * 4096 + c;
                    const u32x4 og = *(const u32x4*)(pb), ys = *(const u32x4*)(YS + (size_t)row * D + c), ga = *(const u32x4*)(pb + 2048), gb = *(const u32x4*)(pb + 3072);
                    const u32x4 orw = *(const u32x4*)(ORAW + (size_t)row * D + c);
                    const float rstd = __builtin_amdgcn_rsqf(SSQ[(size_t)row * 8 + head] * (1.0f / 128.0f) + EPS);
                    const f32x4 a0 = acc[ai][bj][m][0], a1 = acc[ai][bj][m][1];
                    const float av[8] = {a0[0], a0[1], a0[2], a0[3], a1[0], a1[1], a1[2], a1[3]};
                    float res[8];
#pragma unroll
                    for (int j = 0; j < 8; ++j) {
                        const unsigned wog = og[j >> 1], wys = ys[j >> 1], wga = ga[j >> 1], wgb = gb[j >> 1], wor = orw[j >> 1];
                        const float fog = (j & 1) ? bfhi(wog) : bflo(wog), fys = (j & 1) ? bfhi(wys) : bflo(wys), fga = (j & 1) ? bfhi(wga) : bflo(wga),
                                    fgb = (j & 1) ? bfhi(wgb) : bflo(wgb), fo = (j & 1) ? bfhi(wor) : bflo(wor);
                        const float ya = fo * rstd * ngv[j] * fsilu(fog);
                        const float yb = fys * fsigmoid((DBG_NO_ACC ? 0.f : av[j]) + bbv[j]);
                        res[j] = (DBG_NO_YA ? 0.f : fsigmoid(fga) * ya) + (DBG_NO_YB ? 0.f : (DBG_NO_GB ? 0.5f : fsigmoid(fgb)) * yb);
                    }
                    int w0 = 0, w1 = 0;
                    w0 = __builtin_amdgcn_cvt_pk_fp8_f32(res[0] * MG_SCALE, res[1] * MG_SCALE, w0, false); w0 = __builtin_amdgcn_cvt_pk_fp8_f32(res[2] * MG_SCALE, res[3] * MG_SCALE, w0, true);
                    w1 = __builtin_amdgcn_cvt_pk_fp8_f32(res[4] * MG_SCALE, res[5] * MG_SCALE, w1, false); w1 = __builtin_amdgcn_cvt_pk_fp8_f32(res[6] * MG_SCALE, res[7] * MG_SCALE, w1, true);
                    *(u32x2*)((unsigned char*)O + (size_t)row * D + c) = (u32x2){(unsigned)w0, (unsigned)w1};
                }
        }
    }
};
}

#define XB_TMO      128
#define XB_XCNT(j)  (256  + 64 * (j))
#define XB_XSUB(j)  (1280 + 64 * (j))
#define XB_XGEN(j)  (2304 + 64 * (j))
#define XB_TOP      3328
#define XB_TOPGEN   3392
#define XCD_BAR_WORDS 3456
#define XB_SPIN_CAP (1u << 25)
__device__ __forceinline__ unsigned xb_ld(unsigned* p)              { return __hip_atomic_load(p, __ATOMIC_RELAXED, __HIP_MEMORY_SCOPE_AGENT); }
__device__ __forceinline__ unsigned xb_add(unsigned* p, unsigned v) { return __hip_atomic_fetch_add(p, v, __ATOMIC_RELAXED, __HIP_MEMORY_SCOPE_AGENT); }
__device__ __forceinline__ unsigned xb_xcc_id() { return (unsigned)__builtin_amdgcn_s_getreg((3 << 11) | 20) & 0xFu; }
#define XB_SPIN(cond, bar) do { unsigned _sp = 0; while (cond) { __builtin_amdgcn_s_sleep(1); \
    if ((++_sp & 255u) == 0u) { if (xb_ld(&(bar)[XB_TMO])) break; if (_sp > XB_SPIN_CAP) { atomicAdd(&(bar)[XB_TMO], 1u); break; } } } } while (0)
struct XcdBarrier { unsigned* bar; unsigned x; volatile LAS unsigned* st; };
__device__ __forceinline__ XcdBarrier xcd_barrier_post(unsigned* bar, volatile LAS unsigned* st) {
    XcdBarrier b; b.bar = bar; b.x = xb_xcc_id(); b.st = st;
    if (threadIdx.x == 0) (void)xb_add(&bar[XB_XCNT(b.x)], 1u);
    return b;
}
__device__ __forceinline__ void xcd_barrier_complete(unsigned* bar, unsigned x, unsigned& nloc, unsigned& nx) {
    const unsigned G = gridDim.x * gridDim.y * gridDim.z;
    unsigned sum, cnt, mine, sp = 0u;
    for (;;) {
        sum = 0u; cnt = 0u; mine = 0u;
#pragma unroll
        for (unsigned j = 0; j < 16; ++j) { const unsigned c = xb_ld(&bar[XB_XCNT(j)]); sum += c; cnt += (c > 0u) ? 1u : 0u; mine = (j == x) ? c : mine; }
        if (sum == G) break;
        __builtin_amdgcn_s_sleep(1);
        if ((++sp & 255u) == 0u) { if (xb_ld(&bar[XB_TMO])) break; if (sp > XB_SPIN_CAP) { atomicAdd(&bar[XB_TMO], 1u); break; } }
    }
    nloc = mine > 0u ? mine : 1u; nx = cnt > 0u ? cnt : 1u;
}
__device__ __forceinline__ void xcd_barrier(const XcdBarrier& b) {
    asm volatile("s_waitcnt vmcnt(0)" ::: "memory");
    __syncthreads();
    if (threadIdx.x == 0) {
        unsigned* bar = b.bar;
        __builtin_amdgcn_s_waitcnt(0);
        unsigned nloc = b.st[0], nx = b.st[1];
        if (nloc == 0u) { xcd_barrier_complete(bar, b.x, nloc, nx); b.st[0] = nloc; b.st[1] = nx; }
        const unsigned old = xb_add(&bar[XB_XSUB(b.x)], 1u);
        const unsigned gen = old / nloc;
        if (old + 1u == (gen + 1u) * nloc) {
            __builtin_amdgcn_fence(__ATOMIC_RELEASE, "agent");
            asm volatile("s_waitcnt vmcnt(0)" ::: "memory");
            const unsigned og = xb_add(&bar[XB_TOP], 1u);
            const unsigned tg = og / nx;
            if (og + 1u == (tg + 1u) * nx) xb_add(&bar[XB_TOPGEN], 1u);
            else XB_SPIN(xb_ld(&bar[XB_TOPGEN]) == tg, bar);
            __builtin_amdgcn_fence(__ATOMIC_ACQUIRE, "agent");
            xb_add(&bar[XB_XGEN(b.x)], 1u);
            asm volatile("s_waitcnt vmcnt(0)" ::: "memory");
        } else {
            XB_SPIN(xb_ld(&bar[XB_XGEN(b.x)]) == gen, bar);
            __builtin_amdgcn_fence(__ATOMIC_ACQUIRE, "agent");
            asm volatile("s_waitcnt vmcnt(0)" ::: "memory");
        }
    }
    __syncthreads();
}

struct KP { const float* in[25]; float* out; unsigned char* ws; int gp_lo, gp_hi; };
enum { I_X = 0, I_C, I_ADAW, I_ADAB, I_N1G, I_N2G, I_WIN, I_LBL, I_HNG, I_ARE, I_AIM, I_LDT, I_BRE, I_BIM, I_CRE, I_CIM, I_S5D, I_GLUW, I_GLUB, I_WOUT, I_WQ, I_SUBK, I_PU, I_PV, I_FG };

typedef const KP __attribute__((address_space(4)))* kp_cptr;
__device__ __forceinline__ KP load_kp() {
#if defined(__HIP_DEVICE_COMPILE__)
    unsigned long long a = (unsigned long long)__builtin_amdgcn_kernarg_segment_ptr(); asm volatile("" : "+s"(a)); return *(kp_cptr)a;
#else
    return KP{};
#endif
}

__device__ __forceinline__ void phase_setup(const KP& p, LAS unsigned char* lds, int G) {
    const int tid = opaque_tid();
    {
        LAS float* cact = (LAS float*)lds;
        for (int it = blockIdx.x; it < 4 * 48; it += G) {
            for (int i = tid; i < 32 * 1024; i += 512) cact[i] = fsilu(p.in[I_C][i]);
            __syncthreads();
            const int l = it / 48, cb = it % 48, col = cb * 128 + (tid & 127), bg = tid >> 7;
            const float* W = p.in[I_ADAW] + (size_t)l * D * NMODC + col;
            float acc[8];
#pragma unroll
            for (int j = 0; j < 8; ++j) acc[j] = 0.f;
            for (int k4 = 0; k4 < 256; ++k4) {
                const float w0 = W[(size_t)(4 * k4 + 0) * NMODC], w1 = W[(size_t)(4 * k4 + 1) * NMODC], w2 = W[(size_t)(4 * k4 + 2) * NMODC], w3 = W[(size_t)(4 * k4 + 3) * NMODC];
#pragma unroll
                for (int j = 0; j < 8; ++j) { const f32x4 c4 = *(const LAS f32x4*)(cact + (8 * bg + j) * 1024 + 4 * k4); acc[j] += c4[0] * w0 + c4[1] * w1 + c4[2] * w2 + c4[3] * w3; }
            }
            float* MOD = (float*)(p.ws + WS_MOD);
            const float bias = p.in[I_ADAB][l * NMODC + col];
#pragma unroll
            for (int j = 0; j < 8; ++j) MOD[((size_t)l * 32 + 8 * bg + j) * NMODC + col] = acc[j] + bias;
            __syncthreads();
        }
    }
    const int gtid = blockIdx.x * 512 + tid;
    if (gtid < 1024) {
        const float* lg = p.in[I_LBL]; float v[4], mx = -1e30f;
#pragma unroll
        for (int l = 0; l < 4; ++l) { v[l] = lg[l * 1024 + gtid]; mx = fmaxf(mx, v[l]); }
        float s = 0.f;
#pragma unroll
        for (int l = 0; l < 4; ++l) { v[l] = __expf(v[l] - mx); s += v[l]; }
        float* LB = (float*)(p.ws + WS_LB); float cum = 0.f; const float first = v[0] / s;
#pragma unroll
        for (int l = 0; l < 4; ++l) { cum += v[l] / s; LB[l * 1024 + gtid] = (l == 0) ? 0.f : (cum - first); }
    }
    if (gtid >= 1024 && gtid < 1024 + 16384) {
        const int id = gtid - 1024, lg = id >> 6, pp = id & 63;
        const float a_re = p.in[I_ARE][id], a_im = p.in[I_AIM][id];
        const float step = expf(p.in[I_LDT][lg]);
        const float mag = expf(step * a_re), ang = step * a_im;
        const float ab_re = mag * cosf(ang), ab_im = mag * sinf(ang);
        const float den = a_re * a_re + a_im * a_im;
        const float z_re = ((ab_re - 1.0f) * a_re + ab_im * a_im) / den;
        const float z_im = (ab_im * a_re - (ab_re - 1.0f) * a_im) / den;
        float* ABAR = (float*)(p.ws + WS_ABAR); ABAR[2 * id] = ab_re; ABAR[2 * id + 1] = ab_im;
        bf16_t* BOP = (bf16_t*)(p.ws + WS_BOP); bf16_t* COP = (bf16_t*)(p.ws + WS_COP);
        const float* bre = p.in[I_BRE] + (size_t)id * 16; const float* bim = p.in[I_BIM] + (size_t)id * 16;
#pragma unroll
        for (int c = 0; c < 16; ++c) {
            const float br = bre[c], bi = bim[c];
            const float rr = z_re * br - z_im * bi, ii = z_re * bi + z_im * br;
            BOP[((size_t)lg * 128 + 2 * pp) * 16 + c] = (bf16_t)(pk2(rr, 0.f) & 0xffffu);
            BOP[((size_t)lg * 128 + 2 * pp + 1) * 16 + c] = (bf16_t)(pk2(ii, 0.f) & 0xffffu);
            const float cr = p.in[I_CRE][((size_t)lg * 16 + c) * 64 + pp], ci = p.in[I_CIM][((size_t)lg * 16 + c) * 64 + pp];
            COP[((size_t)lg * 16 + c) * 128 + 2 * pp] = (bf16_t)(pk2(cr, 0.f) & 0xffffu);
            COP[((size_t)lg * 16 + c) * 128 + 2 * pp + 1] = (bf16_t)(pk2(-ci, 0.f) & 0xffffu);
        }
    }
}

__device__ __forceinline__ void transpose_item(const float* W, int K, int N, bf16_t* WT, LAS float* scr, int item, int lane) {
    const int nblk = N / 32, kb = item / nblk, nb = item % nblk, k0 = 64 * kb, n0 = 32 * nb;
#pragma unroll 8
    for (int i = 0; i < 32; ++i) { const int kk = 2 * i + (lane >> 5); scr[kk * 33 + (lane & 31)] = W[(size_t)(k0 + kk) * N + n0 + (lane & 31)]; }
    LDS_WAIT();
    const int c = lane & 7;
#pragma unroll
    for (int j = 0; j < 4; ++j) { const int n = (lane >> 3) + 8 * j; const LAS float* s = scr + (8 * c) * 33 + n;
        u32x4 o; o.x = pk2(s[0 * 33], s[1 * 33]); o.y = pk2(s[2 * 33], s[3 * 33]); o.z = pk2(s[4 * 33], s[5 * 33]); o.w = pk2(s[6 * 33], s[7 * 33]);
        *(u32x4*)(WT + (size_t)(n0 + n) * K + k0 + 8 * c) = o; }
    LDS_WAIT();
}
__device__ __forceinline__ void cvt_f32_fp8(const float* src, unsigned char* dst, size_t n4, size_t gtid, size_t nthr, float scale) {
    for (size_t i = gtid; i < n4; i += nthr) { const f32x4 v = ((const f32x4*)src)[i] * scale; int w = 0;
        w = __builtin_amdgcn_cvt_pk_fp8_f32(v[0], v[1], w, false); w = __builtin_amdgcn_cvt_pk_fp8_f32(v[2], v[3], w, true); ((unsigned*)dst)[i] = (unsigned)w; }
}
__device__ __forceinline__ void cvt_f32_fp8_sliced(const float* src, unsigned char* dst, size_t gtid, size_t nthr, float scale) {
    for (size_t i = gtid; i < (size_t)16384 * 64; i += nthr) {
        const size_t e = i >> 6; const int sl = (int)(i & 63) >> 3, c = (int)(i & 7);
        const f32x4* sp = (const f32x4*)(src + e * 1024 + sl * 128 + c * 16); u32x4 o;
#pragma unroll
        for (int q = 0; q < 4; ++q) { const f32x4 v = sp[q] * scale; int w = 0; w = __builtin_amdgcn_cvt_pk_fp8_f32(v[0], v[1], w, false); w = __builtin_amdgcn_cvt_pk_fp8_f32(v[2], v[3], w, true); o[q] = (unsigned)w; }
        *(u32x4*)(dst + ((size_t)sl * 16384 + e) * 128 + c * 16) = o;
    }
}
__device__ __forceinline__ void transpose_item_fp8(const float* W, int K, int N, unsigned char* WT, LAS float* scr, int item, int lane, float scale) {
    const int nblk = N / 32, kb = item / nblk, nb = item % nblk, k0 = 64 * kb, n0 = 32 * nb;
#pragma unroll 8
    for (int i = 0; i < 32; ++i) { const int kk = 2 * i + (lane >> 5); scr[kk * 33 + (lane & 31)] = W[(size_t)(k0 + kk) * N + n0 + (lane & 31)]; }
    LDS_WAIT();
    const int c = lane & 7;
#pragma unroll
    for (int j = 0; j < 4; ++j) { const int n = (lane >> 3) + 8 * j; const LAS float* sp = scr + (8 * c) * 33 + n;
        int w0 = 0, w1 = 0;
        w0 = __builtin_amdgcn_cvt_pk_fp8_f32(sp[0 * 33] * scale, sp[1 * 33] * scale, w0, false); w0 = __builtin_amdgcn_cvt_pk_fp8_f32(sp[2 * 33] * scale, sp[3 * 33] * scale, w0, true);
        w1 = __builtin_amdgcn_cvt_pk_fp8_f32(sp[4 * 33] * scale, sp[5 * 33] * scale, w1, false); w1 = __builtin_amdgcn_cvt_pk_fp8_f32(sp[6 * 33] * scale, sp[7 * 33] * scale, w1, true);
        *(u32x2*)(WT + (size_t)(n0 + n) * K + k0 + 8 * c) = (u32x2){(unsigned)w0, (unsigned)w1}; }
    LDS_WAIT();
}
__device__ __forceinline__ void cvt_f32_bf16(const float* src, bf16_t* dst, size_t n4, size_t gtid, size_t nthr) {
    for (size_t i = gtid; i < n4; i += nthr) { const f32x4 v = ((const f32x4*)src)[i]; u32x2 o; o.x = pk2(v[0], v[1]); o.y = pk2(v[2], v[3]); ((u32x2*)dst)[i] = o; }
}
template <bool F8OUT, bool XBF>
__device__ __forceinline__ void norm_rows(const float* xsrc, bf16_t* hdst, const float* gain, const float* mod_l, int sh_off, int sc_off, int gw, int ngw, int lane) {
    for (int r0 = gw * 4; r0 < M; r0 += ngw * 4) {
        const int b = r0 >> 11;
        f32x4 v[4][4]; float ss[4];
#pragma unroll
        for (int i = 0; i < 4; ++i) {
            if constexpr (XBF) { const u32x2* xr = (const u32x2*)((const bf16_t*)xsrc + (size_t)(r0 + i) * D) + lane;
#pragma unroll
                for (int j = 0; j < 4; ++j) { const u32x2 xw = xr[64 * j]; v[i][j] = (f32x4){bflo(xw[0]), bfhi(xw[0]), bflo(xw[1]), bfhi(xw[1])}; } }
            else { const f32x4* xr = (const f32x4*)(xsrc + (size_t)(r0 + i) * D) + lane;
#pragma unroll
                for (int j = 0; j < 4; ++j) v[i][j] = xr[64 * j]; } }
#pragma unroll
        for (int i = 0; i < 4; ++i) { float t = 0.f;
#pragma unroll
            for (int j = 0; j < 4; ++j) t += (v[i][j][0] * v[i][j][0] + v[i][j][1] * v[i][j][1]) + (v[i][j][2] * v[i][j][2] + v[i][j][3] * v[i][j][3]);
            ss[i] = t; }
#pragma unroll
        for (int o = 1; o < 64; o <<= 1) {
#pragma unroll
            for (int i = 0; i < 4; ++i) ss[i] += __shfl_xor(ss[i], o); }
        const float* mb = mod_l + (size_t)b * NMODC;
#pragma unroll
        for (int j = 0; j < 4; ++j) { const int col = 256 * j + 4 * lane;
            const f32x4 g4 = *(const f32x4*)(gain + col), sc = *(const f32x4*)(mb + sc_off + col), sh = *(const f32x4*)(mb + sh_off + col);
            const f32x4 gs = g4 * (sc + 1.0f);
#pragma unroll
            for (int i = 0; i < 4; ++i) { const float rstd = __builtin_amdgcn_rsqf(ss[i] * (1.0f / D) + EPS);
                const f32x4 h = v[i][j] * rstd * gs + sh;
                if constexpr (F8OUT) { int w8 = 0; w8 = __builtin_amdgcn_cvt_pk_fp8_f32(h[0] * HIN_SCALE, h[1] * HIN_SCALE, w8, false); w8 = __builtin_amdgcn_cvt_pk_fp8_f32(h[2] * HIN_SCALE, h[3] * HIN_SCALE, w8, true);
                    *(unsigned*)((unsigned char*)hdst + (size_t)(r0 + i) * D + col) = (unsigned)w8; }
                else { u32x2 o; o.x = pk2(h[0], h[1]); o.y = pk2(h[2], h[3]); *(u32x2*)(hdst + (size_t)(r0 + i) * D + col) = o; } } }
    }
}
template <bool XBF>
__device__ __forceinline__ void resid_norm_rows(const float* xsrc, bf16_t* xdst, const bf16_t* delta, bf16_t* hdst, const float* gain, const float* mod_l, int gw, int ngw, int lane) {
    for (int r0 = gw * 4; r0 < M; r0 += ngw * 4) {
        const int b = r0 >> 11; const float* mb = mod_l + (size_t)b * NMODC;
        f32x4 v[4][4]; u32x2 dl[4][4]; float ss[4];
#pragma unroll
        for (int i = 0; i < 4; ++i) { const u32x2* dp = (const u32x2*)(delta + (size_t)(r0 + i) * D) + lane;
            if constexpr (XBF) { const u32x2* xr = (const u32x2*)((const bf16_t*)xsrc + (size_t)(r0 + i) * D) + lane;
#pragma unroll
                for (int j = 0; j < 4; ++j) { const u32x2 xw = xr[64 * j]; v[i][j] = (f32x4){bflo(xw[0]), bfhi(xw[0]), bflo(xw[1]), bfhi(xw[1])}; dl[i][j] = dp[64 * j]; } }
            else { const f32x4* xr = (const f32x4*)(xsrc + (size_t)(r0 + i) * D) + lane;
#pragma unroll
                for (int j = 0; j < 4; ++j) { v[i][j] = xr[64 * j]; dl[i][j] = dp[64 * j]; } } }
#pragma unroll
        for (int j = 0; j < 4; ++j) { const f32x4 g1 = *(const f32x4*)(mb + 2048 + 256 * j + 4 * lane);
#pragma unroll
            for (int i = 0; i < 4; ++i) { const f32x4 dv = {bflo(dl[i][j][0]), bfhi(dl[i][j][0]), bflo(dl[i][j][1]), bfhi(dl[i][j][1])}; v[i][j] = v[i][j] + g1 * dv;
                ((u32x2*)(xdst + (size_t)(r0 + i) * D) + lane)[64 * j] = (u32x2){pk2(v[i][j][0], v[i][j][1]), pk2(v[i][j][2], v[i][j][3])}; } }
#pragma unroll
        for (int i = 0; i < 4; ++i) { float t = 0.f;
#pragma unroll
            for (int j = 0; j < 4; ++j) t += (v[i][j][0] * v[i][j][0] + v[i][j][1] * v[i][j][1]) + (v[i][j][2] * v[i][j][2] + v[i][j][3] * v[i][j][3]);
            ss[i] = t; }
#pragma unroll
        for (int o = 1; o < 64; o <<= 1) {
#pragma unroll
            for (int i = 0; i < 4; ++i) ss[i] += __shfl_xor(ss[i], o); }
#pragma unroll
        for (int j = 0; j < 4; ++j) { const int col = 256 * j + 4 * lane;
            const f32x4 g4 = *(const f32x4*)(gain + col), sc = *(const f32x4*)(mb + 4096 + col), sh = *(const f32x4*)(mb + 3072 + col);
            const f32x4 gs = g4 * (sc + 1.0f);
#pragma unroll
            for (int i = 0; i < 4; ++i) { const float rstd = __builtin_amdgcn_rsqf(ss[i] * (1.0f / D) + EPS);
                const f32x4 h = v[i][j] * rstd * gs + sh; u32x2 o; o.x = pk2(h[0], h[1]); o.y = pk2(h[2], h[3]); *(u32x2*)(hdst + (size_t)(r0 + i) * D + col) = o; } }
    }
}
__device__ __forceinline__ void phase_conv_norm1(const KP& p, LAS unsigned char* lds, int l, int G) {
    const int tid = opaque_tid(), lane = tid & 63, wave = __builtin_amdgcn_readfirstlane(tid >> 6);
    const int gw = blockIdx.x * 8 + wave, ngw = G * 8;
    LAS float* scr = (LAS float*)(lds + wave * 8448);
    constexpr int I_IN = 16 * (INC / 32), I_G = 16 * 32, I_O = 16 * 32, I_Q = 16 * 64, NIT = I_IN + I_G + I_O + I_Q;
    for (int it = gw; it < NIT; it += ngw) {
        int r = it;
        if (r < I_IN) { transpose_item_fp8(p.in[I_WIN] + (size_t)l * D * INC, D, INC, p.ws + WS_WIN, scr, r, lane, WIN_SCALE); continue; } r -= I_IN;
        if (r < I_G) { transpose_item(p.in[I_GLUW] + (size_t)l * D * D, D, D, (bf16_t*)(p.ws + WS_WGLU), scr, r, lane); continue; } r -= I_G;
        if (r < I_O) { transpose_item_fp8(p.in[I_WOUT] + (size_t)l * D * D, D, D, p.ws + WS_WOUT, scr, r, lane, WO_SCALE); continue; } r -= I_O;
        transpose_item(p.in[I_WQ] + (size_t)l * D * 2048, D, 2048, (bf16_t*)(p.ws + WS_WQ), scr, r, lane);
    }
    const size_t gtid = (size_t)blockIdx.x * 512 + tid, nthr = (size_t)G * 512;
    cvt_f32_bf16(p.in[I_SUBK] + (size_t)l * 262144, (bf16_t*)(p.ws + WS_KEYS), 262144 / 4, gtid, nthr);
    if (l == 0) {
        cvt_f32_fp8_sliced(p.in[I_PU], p.ws + WS_U, gtid, nthr, U_SCALE);
        cvt_f32_fp8_sliced(p.in[I_PV], p.ws + WS_V, gtid, nthr, V_SCALE); }
    if (l == 0) norm_rows<true, false>(p.in[I_X], (bf16_t*)(p.ws + WS_H), p.in[I_N1G] + l * D, (const float*)(p.ws + WS_MOD) + (size_t)l * 32 * NMODC, 0, 1024, gw, ngw, lane);
    else norm_rows<true, true>(p.out, (bf16_t*)(p.ws + WS_H), p.in[I_N1G] + l * D, (const float*)(p.ws + WS_MOD) + (size_t)l * 32 * NMODC, 0, 1024, gw, ngw, lane);
}

__device__ __forceinline__ void phase_hgrn2(const KP& p, LAS unsigned char* lds, int l, int G) {
    const int tid = opaque_tid(), lane = tid & 63, w = __builtin_amdgcn_readfirstlane(tid >> 6), fr = lane & 15, g = lane >> 4;
    constexpr int QS = 272, TS = 72;
    constexpr int OFF_QT = 0, OFF_KH = 8704, OFF_KT = 17408, OFF_VT = 26624, OFF_EREF = 35840, OFF_ELR = 36352, OFF_SEG = 36864, PBUF = 40960;
    const bf16_t* PA = (const bf16_t*)(p.ws + WS_R0);
    bf16_t* ORAW = (bf16_t*)(p.ws + WS_OR);
    const float* LB = (const float*)(p.ws + WS_LB) + l * 1024;
    for (int unit = blockIdx.x; unit < 256; unit += G) {
        const int b = unit >> 3, h = unit & 7, k0 = 2 * lane;
        const float lb0 = LB[h * 128 + k0], lb1 = LB[h * 128 + k0 + 1];
        const float om0 = 1.0f - lb0, om1 = 1.0f - lb1;
        f32x4 S[8];
#pragma unroll
        for (int kt = 0; kt < 8; ++kt) S[kt] = (f32x4){0.f, 0.f, 0.f, 0.f};
        unsigned rq[4], rf[4], rv[4];
        {
            const bf16_t* base = PA + ((size_t)b * SEQ + 4 * w) * 3072 + h * 128 + k0;
#pragma unroll
            for (int i = 0; i < 4; ++i) { rq[i] = *(const unsigned*)(base + (size_t)i * 3072); rf[i] = *(const unsigned*)(base + (size_t)i * 3072 + 1024); rv[i] = *(const unsigned*)(base + (size_t)i * 3072 + 2048); }
        }
        for (int c = 0; c < 64; ++c) {
            LAS unsigned char* base = lds + (c & 1) * PBUF;
            float cs0[4], cs1[4], qv0[4], qv1[4], kv0[4], kv1[4];
            float run0 = 0.f, run1 = 0.f;
#pragma unroll
            for (int i = 0; i < 4; ++i) {
                const float fp0 = bflo(rf[i]), fp1 = bfhi(rf[i]);
                const float s0 = fsigmoid(fp0), s1 = fsigmoid(fp1);
                run0 += __logf(lb0 + om0 * s0); run1 += __logf(lb1 + om1 * s1);
                cs0[i] = run0; cs1[i] = run1;
                kv0[i] = om0 * (1.0f - s0); kv1[i] = om1 * (1.0f - s1);
                qv0[i] = fsilu(bflo(rq[i])); qv1[i] = fsilu(bfhi(rq[i]));
            }
            *(LAS f32x2*)(base + OFF_SEG + (w * 128 + k0) * 4) = (f32x2){run0, run1};
            __syncthreads();
            float off0 = 0.f, off1 = 0.f, ref0 = 0.f, ref1 = 0.f, all0 = 0.f, all1 = 0.f;
#pragma unroll
            for (int s = 0; s < 8; ++s) { const f32x2 t2 = *(const LAS f32x2*)(base + OFF_SEG + (s * 128 + k0) * 4);
                if (s < w) { off0 += t2[0]; off1 += t2[1]; }
                if (s < 4) { ref0 += t2[0]; ref1 += t2[1]; }
                all0 += t2[0]; all1 += t2[1]; }
            float kh0[4], kh1[4];
#pragma unroll
            for (int i = 0; i < 4; ++i) {
                const float b0 = off0 + cs0[i], b1 = off1 + cs1[i];
                const float q0 = qv0[i] * __expf(b0 - ref0), q1 = qv1[i] * __expf(b1 - ref1);
                kh0[i] = kv0[i] * __expf(ref0 - b0); kh1[i] = kv1[i] * __expf(ref1 - b1);
                const int t = 4 * w + i;
                *(LAS unsigned*)(base + OFF_QT + t * QS + k0 * 2) = pk2(q0, q1);
                *(LAS unsigned*)(base + OFF_KH + t * QS + k0 * 2) = pk2(kh0[i], kh1[i]);
            }
            *(LAS u32x2*)(base + OFF_KT + k0 * TS + 8 * w) = (u32x2){pk2(kh0[0], kh0[1]), pk2(kh0[2], kh0[3])};
            *(LAS u32x2*)(base + OFF_KT + (k0 + 1) * TS + 8 * w) = (u32x2){pk2(kh1[0], kh1[1]), pk2(kh1[2], kh1[3])};
            *(LAS u32x2*)(base + OFF_VT + k0 * TS + 8 * w) = (u32x2){(rv[0] & 0xffffu) | (rv[1] << 16), (rv[2] & 0xffffu) | (rv[3] << 16)};
            *(LAS u32x2*)(base + OFF_VT + (k0 + 1) * TS + 8 * w) = (u32x2){(rv[0] >> 16) | (rv[1] & 0xffff0000u), (rv[2] >> 16) | (rv[3] & 0xffff0000u)};
            if (w == 0) {
                *(LAS f32x2*)(base + OFF_EREF + k0 * 4) = (f32x2){__expf(ref0), __expf(ref1)};
                *(LAS f32x2*)(base + OFF_ELR + k0 * 4) = (f32x2){__expf(all0 - ref0), __expf(all1 - ref1)};
            }
            __syncthreads();
            if (c + 1 < 64) {
                const bf16_t* nb = PA + ((size_t)b * SEQ + (c + 1) * 32 + 4 * w) * 3072 + h * 128 + k0;
#pragma unroll
                for (int i = 0; i < 4; ++i) { rq[i] = *(const unsigned*)(nb + (size_t)i * 3072); rf[i] = *(const unsigned*)(nb + (size_t)i * 3072 + 1024); rv[i] = *(const unsigned*)(nb + (size_t)i * 3072 + 2048); }
            }
            bf16x8 qf[2][4], kf[2][4];
#pragma unroll
            for (int tt = 0; tt < 2; ++tt)
#pragma unroll
                for (int m = 0; m < 4; ++m) {
                    const LAS unsigned char* pq = base + OFF_QT + (16 * tt + fr) * QS + (32 * m + 4 * g) * 2;
                    const u32x2 lo = *(const LAS u32x2*)pq, hi = *(const LAS u32x2*)(pq + 32);
                    qf[tt][m] = __builtin_bit_cast(bf16x8, (u32x4){lo[0], lo[1], hi[0], hi[1]});
                    const LAS unsigned char* pk = base + OFF_KH + (16 * tt + fr) * QS + (32 * m + 4 * g) * 2;
                    const u32x2 lo2 = *(const LAS u32x2*)pk, hi2 = *(const LAS u32x2*)(pk + 32);
                    kf[tt][m] = __builtin_bit_cast(bf16x8, (u32x4){lo2[0], lo2[1], hi2[0], hi2[1]});
                }
            f32x4 PT00 = {0.f, 0.f, 0.f, 0.f}, PT01 = {0.f, 0.f, 0.f, 0.f}, PT11 = {0.f, 0.f, 0.f, 0.f};
#pragma unroll
            for (int m = 0; m < 4; ++m) {
                PT00 = __builtin_amdgcn_mfma_f32_16x16x32_bf16(kf[0][m], qf[0][m], PT00, 0, 0, 0);
                PT01 = __builtin_amdgcn_mfma_f32_16x16x32_bf16(kf[0][m], qf[1][m], PT01, 0, 0, 0);
                PT11 = __builtin_amdgcn_mfma_f32_16x16x32_bf16(kf[1][m], qf[1][m], PT11, 0, 0, 0);
            }
#pragma unroll
            for (int r = 0; r < 4; ++r) { if (4 * g + r > fr) { PT00[r] = 0.f; PT11[r] = 0.f; } }
            const bf16x8 pa0 = __builtin_bit_cast(bf16x8, (u32x4){pk2(PT00[0], PT00[1]), pk2(PT00[2], PT00[3]), 0u, 0u});
            const bf16x8 pa1 = __builtin_bit_cast(bf16x8, (u32x4){pk2(PT01[0], PT01[1]), pk2(PT01[2], PT01[3]), pk2(PT11[0], PT11[1]), pk2(PT11[2], PT11[3])});
            const LAS unsigned char* vrow = base + OFF_VT + (16 * w + fr) * TS;
            const u32x2 vpa = *(const LAS u32x2*)(vrow + 8 * g), vpb = *(const LAS u32x2*)(vrow + 32 + 8 * g);
            const u32x2 vna = *(const LAS u32x2*)(vrow + 16 * g), vnb = *(const LAS u32x2*)(vrow + 16 * g + 8);
            const bf16x8 vperm = __builtin_bit_cast(bf16x8, (u32x4){vpa[0], vpa[1], vpb[0], vpb[1]});
            const bf16x8 vnat = __builtin_bit_cast(bf16x8, (u32x4){vna[0], vna[1], vnb[0], vnb[1]});
#pragma unroll
            for (int kt = 0; kt < 8; ++kt) { const f32x4 e = *(const LAS f32x4*)(base + OFF_EREF + (16 * kt + 4 * g) * 4); S[kt] = S[kt] * e; }
            f32x4 O0 = {0.f, 0.f, 0.f, 0.f}, O1 = {0.f, 0.f, 0.f, 0.f};
#pragma unroll
            for (int m = 0; m < 4; ++m) {
                const bf16x8 sf = __builtin_bit_cast(bf16x8, (u32x4){pk2(S[2 * m][0], S[2 * m][1]), pk2(S[2 * m][2], S[2 * m][3]), pk2(S[2 * m + 1][0], S[2 * m + 1][1]), pk2(S[2 * m + 1][2], S[2 * m + 1][3])});
                O0 = __builtin_amdgcn_mfma_f32_16x16x32_bf16(qf[0][m], sf, O0, 0, 0, 0);
                O1 = __builtin_amdgcn_mfma_f32_16x16x32_bf16(qf[1][m], sf, O1, 0, 0, 0);
            }
            O0 = __builtin_amdgcn_mfma_f32_16x16x32_bf16(pa0, vperm, O0, 0, 0, 0);
            O1 = __builtin_amdgcn_mfma_f32_16x16x32_bf16(pa1, vperm, O1, 0, 0, 0);
#pragma unroll
            for (int kt = 0; kt < 8; ++kt) {
                const LAS unsigned char* krow = base + OFF_KT + (16 * kt + fr) * TS + 16 * g;
                const u32x2 ka = *(const LAS u32x2*)krow, kb = *(const LAS u32x2*)(krow + 8);
                const bf16x8 ktf = __builtin_bit_cast(bf16x8, (u32x4){ka[0], ka[1], kb[0], kb[1]});
                S[kt] = __builtin_amdgcn_mfma_f32_16x16x32_bf16(ktf, vnat, S[kt], 0, 0, 0);
            }
#pragma unroll
            for (int kt = 0; kt < 8; ++kt) { const f32x4 e = *(const LAS f32x4*)(base + OFF_ELR + (16 * kt + 4 * g) * 4); S[kt] = S[kt] * e; }
            bf16_t* orow = ORAW + ((size_t)b * SEQ + c * 32 + 4 * g) * D + h * 128 + 16 * w + fr;
#pragma unroll
            for (int r = 0; r < 4; ++r) { orow[(size_t)r * D] = (bf16_t)(pk2(O0[r], 0.f) & 0xffffu); orow[(size_t)(16 + r) * D] = (bf16_t)(pk2(O1[r], 0.f) & 0xffffu); }
        }
        __syncthreads();
    }
}

__device__ __forceinline__ void phase_s5(const KP& p, LAS unsigned char* lds, int l, int G, size_t ys_off) {
    const int tid = opaque_tid(), lane = tid & 63, w = __builtin_amdgcn_readfirstlane(tid >> 6), fr = lane & 15, g = lane >> 4;
    const int gw = blockIdx.x * 8 + w, ngw = G * 8;
    constexpr int BUS = 132;
    LAS float* BU = (LAS float*)(lds + w * 16896);
    LAS unsigned char* XI = (LAS unsigned char*)BU;
    const bf16_t* PB = (const bf16_t*)(p.ws + WS_R0);
    const bf16x8 zero8 = {0, 0, 0, 0, 0, 0, 0, 0};
    for (int unit = gw; unit < BATCH * 64; unit += ngw) {
        const int b = unit >> 6, grp = unit & 63, lg = l * 64 + grp;
        const bf16_t* BOP = (const bf16_t*)(p.ws + WS_BOP) + (size_t)lg * 128 * 16;
        const bf16_t* COP = (const bf16_t*)(p.ws + WS_COP) + (size_t)lg * 16 * 128;
        bf16x8 bfrag[8], cfrag[4], dfrag;
#pragma unroll
        for (int nt = 0; nt < 8; ++nt) bfrag[nt] = (g < 2) ? *(const bf16x8*)(BOP + (size_t)(16 * nt + fr) * 16 + 8 * g) : zero8;
#pragma unroll
        for (int ks = 0; ks < 4; ++ks) cfrag[ks] = DBG_S5_NOSSM ? zero8 : *(const bf16x8*)(COP + (size_t)fr * 128 + 32 * ks + 8 * g);
        {
            const unsigned dbits = pk2(p.in[I_S5D][l * 1024 + grp * 16 + fr], 0.f) & 0xffffu;
#pragma unroll
            for (int j = 0; j < 8; ++j) dfrag[j] = (g < 2 && (8 * g + j) == fr) ? (short)dbits : (short)0;
        }
        const float ar = ((const float*)(p.ws + WS_ABAR))[2 * ((size_t)lg * 64 + lane)], ai = ((const float*)(p.ws + WS_ABAR))[2 * ((size_t)lg * 64 + lane) + 1];
        const float nai = -ai; float xr = 0.f, xi = 0.f; unsigned hBU = 0u, hXI = 0u, hY = 0u;
        const bf16_t* ub = PB + ((size_t)b * SEQ) * 4096 + 1024 + grp * 16;
        bf16_t* yb_ = (bf16_t*)(p.ws + ys_off) + ((size_t)b * SEQ) * D + grp * 16;
        bf16x8 unext[2];
#pragma unroll
        for (int tt = 0; tt < 2; ++tt) unext[tt] = (g < 2) ? *(const bf16x8*)(ub + (size_t)(16 * tt + fr) * 4096 + 8 * g) : zero8;
        const bool cvt_next = (l + 1 < DEPTH);
        const float* tsrc = ((lane < 32) ? p.in[I_PU] : p.in[I_PV]) + (size_t)(l + 1 < DEPTH ? l + 1 : l) * 16384 * 1024 + 4 * (lane & 31);
        unsigned char* tdst = p.ws + ((lane < 32) ? WS_U : WS_V) + (size_t)((l + 1) & 1) * TAB_BYTES + 4 * (lane & 31);
        const float tscale = (lane < 32) ? U_SCALE : V_SCALE;
        for (int t0 = 0; t0 < SEQ; t0 += 32) {
            const int item = unit * 64 + (t0 >> 5), te = item >> 3, tsl = item & 7;
            f32x4 tv = {0.f, 0.f, 0.f, 0.f}; if (cvt_next) tv = *(const f32x4*)(tsrc + (size_t)te * 1024 + tsl * 128);
            bf16x8 ufrag[2];
#pragma unroll
            for (int tt = 0; tt < 2; ++tt) { ufrag[tt] = unext[tt]; if (t0 + 32 < SEQ) unext[tt] = (g < 2) ? *(const bf16x8*)(ub + (size_t)(t0 + 32 + 16 * tt + fr) * 4096 + 8 * g) : zero8; }
#pragma unroll
            for (int tt = 0; tt < 2; ++tt)
#pragma unroll
                for (int nt = 0; nt < 8; ++nt) {
                    const f32x4 a = __builtin_amdgcn_mfma_f32_16x16x32_bf16(ufrag[tt], bfrag[nt], (f32x4){0.f, 0.f, 0.f, 0.f}, 0, 0, 0);
#pragma unroll
                    for (int r = 0; r < 4; ++r) BU[(16 * tt + 4 * g + r) * BUS + 16 * nt + fr] = a[r];
                }
            LDS_WAIT();
#pragma unroll
            for (int t = 0; t < 32; ++t) {
                const f32x2 bb = *(const LAS f32x2*)(BU + t * BUS + 2 * lane); hBU += __float_as_uint(bb[0]) * 3u + __float_as_uint(bb[1]);
                float t1, t2, nr, ni;
                asm("v_fma_f32 %0, %1, %2, %3" : "=v"(t1) : "v"(nai), "v"(xi), "v"(bb[0]));
                asm("v_fma_f32 %0, %1, %2, %3" : "=v"(t2) : "v"(ai), "v"(xr), "v"(bb[1]));
                asm("v_fma_f32 %0, %1, %2, %3" : "=v"(nr) : "v"(ar), "v"(xr), "v"(t1));
                asm("v_fma_f32 %0, %1, %2, %3" : "=v"(ni) : "v"(ar), "v"(xi), "v"(t2));
                xr = nr; xi = ni;
                { const unsigned pv = pk2(nr, ni); hXI += pv; *(LAS unsigned*)(XI + t * (BUS * 4) + lane * 4) = pv; }
            }
            LDS_WAIT();
#pragma unroll
            for (int tt = 0; tt < 2; ++tt) {
                f32x4 y = {0.f, 0.f, 0.f, 0.f};
#pragma unroll
                for (int ks = 0; ks < 4; ++ks) {
                    const bf16x8 xf = *(const LAS bf16x8*)(XI + (16 * tt + fr) * (BUS * 4) + (32 * ks + 8 * g) * 2);
                    y = __builtin_amdgcn_mfma_f32_16x16x32_bf16(xf, cfrag[ks], y, 0, 0, 0);
                }
                y = __builtin_amdgcn_mfma_f32_16x16x32_bf16(ufrag[tt], dfrag, y, 0, 0, 0);
#pragma unroll
                for (int r = 0; r < 4; ++r) { const unsigned yv = pk2(fgelu(y[r]), 0.f) & 0xffffu; hY += yv * (unsigned)(r + 1); yb_[(size_t)(t0 + 16 * tt + 4 * g + r) * D + fr] = (bf16_t)yv; }
            }
            LDS_WAIT();
            if (cvt_next) { int w8 = 0; w8 = __builtin_amdgcn_cvt_pk_fp8_f32(tv[0] * tscale, tv[1] * tscale, w8, false); w8 = __builtin_amdgcn_cvt_pk_fp8_f32(tv[2] * tscale, tv[3] * tscale, w8, true);
                *(unsigned*)(tdst + ((size_t)tsl * 16384 + te) * 128) = (unsigned)w8; }
        }
        if (DBG_SELFCHECK) { for (int o = 1; o < 64; o <<= 1) { hBU += __shfl_xor((int)hBU, o); hXI += __shfl_xor((int)hXI, o); hY += __shfl_xor((int)hY, o); }
            unsigned* hs = (unsigned*)(p.ws + WS_CTL) + 65536 + (ys_off == WS_YS ? 0 : 8192) + unit * 4; unsigned hA = __float_as_uint(ar) * 7u + __float_as_uint(ai); for (int o = 1; o < 64; o <<= 1) hA += __shfl_xor((int)hA, o); if (lane == 0) { hs[0] = hBU; hs[1] = hXI; hs[2] = hA; } }
    }
    const bf16_t* ORAW = (const bf16_t*)(p.ws + WS_OR); float* SSQ = (float*)(p.ws + WS_SSQ);
    for (int row = gw; row < M; row += ngw) {
        const u32x4 a = *(const u32x4*)(ORAW + (size_t)row * D + 8 * lane), c2 = *(const u32x4*)(ORAW + (size_t)row * D + 512 + 8 * lane);
        float s0 = 0.f, s1 = 0.f;
#pragma unroll
        for (int j = 0; j < 4; ++j) { const float x0 = bflo(a[j]), x1 = bfhi(a[j]), y0 = bflo(c2[j]), y1 = bfhi(c2[j]); s0 += x0 * x0 + x1 * x1; s1 += y0 * y0 + y1 * y1; }
#pragma unroll
        for (int o = 1; o < 16; o <<= 1) { s0 += __shfl_xor(s0, o); s1 += __shfl_xor(s1, o); }
        if (fr == 0) { SSQ[(size_t)row * 8 + g] = s0; SSQ[(size_t)row * 8 + 4 + g] = s1; }
    }
}

__device__ __forceinline__ unsigned fkey(float f) { const unsigned u = __float_as_uint(f); return u ^ ((unsigned)((int)u >> 31) | 0x80000000u); }
__device__ __forceinline__ float kval(unsigned k) { const unsigned u = (k & 0x80000000u) ? (k ^ 0x80000000u) : ~k; return __uint_as_float(u); }
#define CE_DESC(a, b) do { const unsigned _mx = (a) > (b) ? (a) : (b), _mn = (a) > (b) ? (b) : (a); (a) = _mx; (b) = _mn; } while (0)
__device__ __forceinline__ void sort16_desc(unsigned (&a)[16]) {
#pragma unroll
    for (int kk = 1; kk <= 4; ++kk)
#pragma unroll
        for (int jj = kk - 1; jj >= 0; --jj)
#pragma unroll
            for (int i = 0; i < 16; ++i) { const int k = 1 << kk, j = 1 << jj, l2 = i ^ j;
                if (l2 > i) { if ((i & k) == 0) CE_DESC(a[i], a[l2]); else CE_DESC(a[l2], a[i]); } }
}
__device__ __forceinline__ void merge_top16(unsigned (&a)[16], const unsigned (&b)[16]) {
#pragma unroll
    for (int i = 0; i < 16; ++i) a[i] = a[i] > b[15 - i] ? a[i] : b[15 - i];
#pragma unroll
    for (int jj = 3; jj >= 0; --jj)
#pragma unroll
        for (int i = 0; i < 16; ++i) { const int j = 1 << jj, l2 = i ^ j; if (l2 > i) CE_DESC(a[i], a[l2]); }
}
__device__ __forceinline__ void phase_topk(const KP& p, LAS unsigned char* lds, int G) {
    const int tid = opaque_tid(), lane = tid & 63, w = __builtin_amdgcn_readfirstlane(tid >> 6), hh = lane >> 5;
    const int gw = blockIdx.x * 8 + w, ngw = G * 8;
    const bf16_t* Q = (const bf16_t*)(p.ws + WS_R0); const bf16_t* KEYS = (const bf16_t*)(p.ws + WS_KEYS);
    unsigned* SEL = (unsigned*)(p.ws + WS_SEL);
    LAS unsigned char* tab = lds + w * 2048 + lane * 32;
    const int CI[50] = {0,0,0,0,0,0,0,0,0,0,0,0,0,0,0,0, 1,1,1,1,1,1,1,1, 2,2,2,2,2, 3,3,3,3, 4,4,4, 5,5, 6,6, 7,7, 8,9,10,11,12,13,14,15};
    const int CJ[50] = {0,1,2,3,4,5,6,7,8,9,10,11,12,13,14,15, 0,1,2,3,4,5,6,7, 0,1,2,3,4, 0,1,2,3, 0,1,2, 0,1, 0,1, 0,1, 0,0,0,0,0,0,0,0};
    LAS unsigned char* kimg = lds + 16384;
    for (int h = 0; h < 8; ++h) {
      __syncthreads();
#pragma unroll
      for (int i = 0; i < 8; ++i) { const int ch = tid + 512 * i, row = ch >> 4, c16 = ch & 15;
          *(LAS u32x4*)(kimg + row * 272 + c16 * 16) = *(const u32x4*)(KEYS + (size_t)(h * 256 + row) * 128 + c16 * 8); }
      __syncthreads();
      for (int tg = gw; tg < 2048; tg += ngw) {
        const int t = tg * 32 + (lane & 31);
        unsigned top[2][16];
#pragma unroll
        for (int pp = 0; pp < 2; ++pp) {
            bf16x8 qf[8];
#pragma unroll
            for (int ks = 0; ks < 8; ++ks) qf[ks] = *(const bf16x8*)(Q + ((size_t)((((tg * 8 + h) * 2 + pp) * 8 + ks) * 64 + lane)) * 8);
            const LAS unsigned char* kb = kimg + (pp * 128 + (lane & 31)) * 272 + 16 * hh;
#pragma unroll
            for (int nt = 0; nt < 4; ++nt) {
                f32x16 acc;
#pragma unroll
                for (int i = 0; i < 16; ++i) acc[i] = 0.f;
#pragma unroll
                for (int ks = 0; ks < 8; ++ks) { const bf16x8 kf = *(const LAS bf16x8*)(kb + (32 * nt) * 272 + 32 * ks);
                    acc = __builtin_amdgcn_mfma_f32_32x32x16_bf16(kf, qf[ks], acc, 0, 0, 0); }
                unsigned ky[16];
#pragma unroll
                for (int r = 0; r < 16; ++r) ky[r] = (fkey(acc[r]) & ~127u) | (unsigned)(32 * nt + (r & 3) + 8 * (r >> 2)) | (unsigned)(4 * hh);
                sort16_desc(ky);
                if (nt == 0) {
#pragma unroll
                    for (int i = 0; i < 16; ++i) top[pp][i] = ky[i];
                } else merge_top16(top[pp], ky);
            }
            unsigned other[16];
#pragma unroll
            for (int i = 0; i < 16; ++i) other[i] = (unsigned)__shfl_xor((int)top[pp][i], 32);
            merge_top16(top[pp], other);
        }
        float sa[16], sb[16];
#pragma unroll
        for (int i = 0; i < 16; ++i) { sa[i] = kval(top[0][i] & ~127u); sb[i] = kval(top[1][i] & ~127u); }
        unsigned c0[16], c1[16];
#pragma unroll
        for (int s = 0; s < 32; ++s) {
            unsigned key = 0u;
            if (s < 25) {
                const float v0 = sa[CI[s]] + sb[CJ[s]], v1 = sa[CI[25 + s]] + sb[CJ[25 + s]];
                const unsigned k0 = (fkey(v0) & ~255u) | (unsigned)(CI[s] * 16 + CJ[s]), k1 = (fkey(v1) & ~255u) | (unsigned)(CI[25 + s] * 16 + CJ[25 + s]);
                key = hh ? k1 : k0;
            }
            if (s < 16) c0[s] = key; else c1[s - 16] = key;
        }
        sort16_desc(c0); sort16_desc(c1); merge_top16(c0, c1);
#pragma unroll
        for (int i = 0; i < 16; ++i) c1[i] = (unsigned)__shfl_xor((int)c0[i], 32);
        merge_top16(c0, c1);
        {
            u32x4 wa, wb;
#pragma unroll
            for (int q4 = 0; q4 < 4; ++q4) {
                wa[q4] = (top[0][4 * q4] & 127u) | ((top[0][4 * q4 + 1] & 127u) << 8) | ((top[0][4 * q4 + 2] & 127u) << 16) | ((top[0][4 * q4 + 3] & 127u) << 24);
                wb[q4] = (top[1][4 * q4] & 127u) | ((top[1][4 * q4 + 1] & 127u) << 8) | ((top[1][4 * q4 + 2] & 127u) << 16) | ((top[1][4 * q4 + 3] & 127u) << 24);
            }
            *(LAS u32x4*)tab = wa; *(LAS u32x4*)(tab + 16) = wb;
        }
        float ev[16], esum = 0.f; const float vmax = kval(c0[0] & ~255u);
#pragma unroll
        for (int k = 0; k < 16; ++k) { ev[k] = __expf(kval(c0[k] & ~255u) - vmax); esum += ev[k]; }
        const float rs = 1.0f / esum;
        LDS_WAIT();
        unsigned outw[8]; const unsigned hmask = hh ? 0xffffffffu : 0u;
#pragma unroll
        for (int kk = 0; kk < 8; ++kk) {
            const unsigned key = c0[kk] ^ ((c0[kk] ^ c0[8 + kk]) & hmask); const float e = __uint_as_float(__float_as_uint(ev[kk]) ^ ((__float_as_uint(ev[kk]) ^ __float_as_uint(ev[8 + kk])) & hmask));
            const unsigned code = key & 255u, ia = tab[code >> 4], ib = tab[16 + (code & 15u)];
            outw[kk] = (pk2(0.f, e * rs) & 0xffff0000u) | (ia * 128u + ib);
        }
        u32x4* dst = (u32x4*)(SEL + (size_t)t * 128 + h * 16 + hh * 8);
        dst[0] = (u32x4){outw[0], outw[1], outw[2], outw[3]}; dst[1] = (u32x4){outw[4], outw[5], outw[6], outw[7]};
        LDS_WAIT();
      }
    }
    __syncthreads();
}

__device__ __forceinline__ void fp8x4_to_f32(unsigned w, float& a, float& b, float& c, float& d) {
    const f32x2 lo = __builtin_amdgcn_cvt_pk_f32_fp8((int)w, false), hi = __builtin_amdgcn_cvt_pk_f32_fp8((int)w, true); a = lo[0]; b = lo[1]; c = hi[0]; d = hi[1];
}
struct XSlice { int sl, rank, nloc; };
__device__ __forceinline__ XSlice xslice_of_block(const KP& p, volatile LAS unsigned* MISC, int G) {
    unsigned* bar = (unsigned*)(p.ws + WS_CTL) + 4096; unsigned cnt[8]; unsigned tot = 0; bool ok = true;
#pragma unroll
    for (int j = 0; j < 8; ++j) { cnt[j] = xb_ld(&bar[XB_XCNT(j)]); tot += cnt[j]; ok = ok && (cnt[j] > 0u); }
    ok = ok && (tot == (unsigned)G);
    XSlice x;
    if (ok) { const unsigned myx = MISC[16]; x.sl = (int)myx; x.rank = (int)MISC[17]; x.nloc = (int)cnt[myx & 7u]; }
    else { x.sl = (int)(blockIdx.x & 7); x.rank = (int)(blockIdx.x >> 3); x.nloc = (G - x.sl + 7) >> 3; }
    x.sl = __builtin_amdgcn_readfirstlane(x.sl); x.rank = __builtin_amdgcn_readfirstlane(x.rank); x.nloc = __builtin_amdgcn_readfirstlane(x.nloc);
    return x;
}
__device__ __forceinline__ float dot16_fp8(const u32x4 u, const float (&hf)[16]) {
    float d = 0.f;
#pragma unroll
    for (int j = 0; j < 4; ++j) { float f0, f1, f2, f3; fp8x4_to_f32(u[j], f0, f1, f2, f3);
        d = __builtin_fmaf(f0, hf[4 * j], d); d = __builtin_fmaf(f1, hf[4 * j + 1], d); d = __builtin_fmaf(f2, hf[4 * j + 2], d); d = __builtin_fmaf(f3, hf[4 * j + 3], d); }
    return d;
}
typedef __bf16 bf16v8 __attribute__((ext_vector_type(8)));
__device__ __forceinline__ float dot16_fp8_bf16(const u32x4 u, const bf16v8 h0, const bf16v8 h1) {
    float d0 = 0.f, d1 = 0.f;
    d0 = __builtin_amdgcn_fdot2_f32_bf16(__builtin_amdgcn_cvt_scalef32_pk_bf16_fp8(u[0], 1.0f, false), __builtin_shufflevector(h0, h0, 0, 1), d0, false);
    d1 = __builtin_amdgcn_fdot2_f32_bf16(__builtin_amdgcn_cvt_scalef32_pk_bf16_fp8(u[0], 1.0f, true),  __builtin_shufflevector(h0, h0, 2, 3), d1, false);
    d0 = __builtin_amdgcn_fdot2_f32_bf16(__builtin_amdgcn_cvt_scalef32_pk_bf16_fp8(u[1], 1.0f, false), __builtin_shufflevector(h0, h0, 4, 5), d0, false);
    d1 = __builtin_amdgcn_fdot2_f32_bf16(__builtin_amdgcn_cvt_scalef32_pk_bf16_fp8(u[1], 1.0f, true),  __builtin_shufflevector(h0, h0, 6, 7), d1, false);
    d0 = __builtin_amdgcn_fdot2_f32_bf16(__builtin_amdgcn_cvt_scalef32_pk_bf16_fp8(u[2], 1.0f, false), __builtin_shufflevector(h1, h1, 0, 1), d0, false);
    d1 = __builtin_amdgcn_fdot2_f32_bf16(__builtin_amdgcn_cvt_scalef32_pk_bf16_fp8(u[2], 1.0f, true),  __builtin_shufflevector(h1, h1, 2, 3), d1, false);
    d0 = __builtin_amdgcn_fdot2_f32_bf16(__builtin_amdgcn_cvt_scalef32_pk_bf16_fp8(u[3], 1.0f, false), __builtin_shufflevector(h1, h1, 4, 5), d0, false);
    d1 = __builtin_amdgcn_fdot2_f32_bf16(__builtin_amdgcn_cvt_scalef32_pk_bf16_fp8(u[3], 1.0f, true),  __builtin_shufflevector(h1, h1, 6, 7), d1, false);
    return d0 + d1;
}
__device__ __forceinline__ float dpp_sum8(float d) {
    d += __uint_as_float(__builtin_amdgcn_update_dpp(0, __float_as_uint(d), 0xB1, 0xF, 0xF, true));
    d += __uint_as_float(__builtin_amdgcn_update_dpp(0, __float_as_uint(d), 0x4E, 0xF, 0xF, true));
    d += __uint_as_float(__builtin_amdgcn_update_dpp(0, __float_as_uint(d), 0x141, 0xF, 0xF, true));
    return d;
}
__device__ __forceinline__ void phase_expert_u(const KP& p, LAS unsigned char* lds, volatile LAS unsigned* MISC, int l, int G) {
    const int tid = opaque_tid(), lane = tid & 63, w = __builtin_amdgcn_readfirstlane(tid >> 6), j = lane >> 3, c = lane & 7;
    const XSlice xs = xslice_of_block(p, MISC, G);
    const bf16_t* H2 = (const bf16_t*)(p.ws + WS_H); const unsigned char* Us = p.ws + WS_U + (size_t)(l & 1) * TAB_BYTES + (size_t)xs.sl * 16384 * 128;
    const unsigned* SEL = (const unsigned*)(p.ws + WS_SEL); unsigned* PDu = (unsigned*)(p.ws + WS_R0) + (size_t)xs.sl * M * 64;
    const int t0 = xs.rank * 8 + w, tstep = xs.nloc * 8;
    LAS unsigned char* ring = lds + w * 17920;
    LAS unsigned char* selb = ring + 16384; LAS unsigned char* hbuf = ring + 16384 + 1024;
    const int tlast = t0 + ((M - 1 - t0) / tstep) * tstep;
#define E1_CL(t) ((t) <= tlast ? (t) : tlast)
#define E1_DMA_SEL(t, par) do { const unsigned* sp = SEL + (size_t)E1_CL(t) * 128 + lane; \
            __builtin_amdgcn_global_load_lds(sp, (LAS unsigned*)(selb + (par) * 512), 4, 0, 0); __builtin_amdgcn_global_load_lds(sp + 64, (LAS unsigned*)(selb + (par) * 512 + 256), 4, 0, 0); } while (0)
#define E1_DMA_H(t, par) do { __builtin_amdgcn_global_load_lds((const unsigned*)(H2 + (size_t)E1_CL(t) * D + xs.sl * 128) + lane, (LAS unsigned*)(hbuf + (par) * 256), 4, 0, 0); } while (0)
#define E1_DMA_ROW(i, idxv) do { __builtin_amdgcn_global_load_lds((const unsigned*)(Us + (size_t)((idxv) & 0x3fffu) * 128 + 16 * c), (LAS unsigned*)(ring + (i) * 1024), 16, 0, 0); } while (0)
    if (t0 < M) {
        E1_DMA_SEL(t0, 0); E1_DMA_SEL(t0 + tstep, 1); E1_DMA_H(t0, 0);
        asm volatile("s_waitcnt vmcnt(0)" ::: "memory");
        { u32x4 s0[4];
#pragma unroll
          for (int q = 0; q < 4; ++q) s0[q] = *(const LAS u32x4*)(selb + (16 * j + 4 * q) * 4);
#pragma unroll
          for (int i = 0; i < 16; ++i) E1_DMA_ROW(i, s0[i >> 2][i & 3]); }
        { PDu[(size_t)t0 * 64 + 8 * j + (c >> 1) + 4 * (c & 1)] = 0u; }
        int par = 0;
        for (int tok = t0; tok < M; tok += tstep, par ^= 1) {
            E1_DMA_SEL(tok + 2 * tstep, par); E1_DMA_H(tok + tstep, par ^ 1);
            asm volatile("s_waitcnt vmcnt(19)" ::: "memory");
            u32x4 sn[4];
#pragma unroll
            for (int q = 0; q < 4; ++q) sn[q] = *(const LAS u32x4*)(selb + (par ^ 1) * 512 + (16 * j + 4 * q) * 4);
            const bf16v8 hb0 = *(const LAS bf16v8*)(hbuf + par * 256 + 32 * c), hb1 = *(const LAS bf16v8*)(hbuf + par * 256 + 32 * c + 16);
            float pd0 = 0.f, pd1 = 0.f;
#pragma unroll
            for (int i0 = 0; i0 < 16; i0 += 4) {
                asm volatile("s_waitcnt vmcnt(16)" ::: "memory");
                u32x4 row[4];
#pragma unroll
                for (int r = 0; r < 4; ++r) row[r] = *(const LAS u32x4*)(ring + (i0 + r) * 1024 + 16 * lane);
                asm volatile("s_waitcnt lgkmcnt(0)" ::: "memory");
#pragma unroll
                for (int r = 0; r < 4; ++r) E1_DMA_ROW(i0 + r, sn[(i0 + r) >> 2][(i0 + r) & 3]);
#pragma unroll
                for (int r = 0; r < 4; ++r) { const int i = i0 + r; const float d = dpp_sum8(dot16_fp8_bf16(row[r], hb0, hb1));
                    if (i < 8) pd0 = (c == i) ? d : pd0; else pd1 = (c == i - 8) ? d : pd1; }
            }
            { const float nb0 = __uint_as_float(__builtin_amdgcn_update_dpp(0, __float_as_uint(pd0), 0xB1, 0xF, 0xF, true)), nb1 = __uint_as_float(__builtin_amdgcn_update_dpp(0, __float_as_uint(pd1), 0xB1, 0xF, 0xF, true));
              PDu[(size_t)tok * 64 + 8 * j + (c >> 1) + 4 * (c & 1)] = (c & 1) ? pk2(nb1, pd1) : pk2(pd0, nb0); }
        }
        asm volatile("s_waitcnt vmcnt(0)" ::: "memory");
    }
#undef E1_CL
#undef E1_DMA_SEL
#undef E1_DMA_H
#undef E1_DMA_ROW
}
__device__ __forceinline__ void phase_expert_w(const KP& p, int G) {
    const int tid = opaque_tid(), lane = tid & 63, w = __builtin_amdgcn_readfirstlane(tid >> 6);
    const int gw = blockIdx.x * 8 + w, ngw = G * 8;
    unsigned* SEL = (unsigned*)(p.ws + WS_SEL); const unsigned* PDu = (const unsigned*)(p.ws + WS_R0);
    for (int tok = gw; tok < M; tok += ngw) {
        f32x2 d = {0.f, 0.f};
#pragma unroll
        for (int sl = 0; sl < 8; ++sl) { const unsigned pw = PDu[((size_t)sl * M + tok) * 64 + lane]; d[0] += bflo(pw); d[1] += bfhi(pw); }
        u32x2* sp = (u32x2*)(SEL + (size_t)tok * 128 + 2 * lane); const u32x2 s2 = *sp;
        const float w0 = __uint_as_float(s2[0] & 0xffff0000u) * fgelu(d[0] * (1.0f / U_SCALE)) * (1.0f / V_SCALE);
        const float w1 = __uint_as_float(s2[1] & 0xffff0000u) * fgelu(d[1] * (1.0f / U_SCALE)) * (1.0f / V_SCALE);
        u32x2 o; o[0] = (pk2(0.f, w0) & 0xffff0000u) | (s2[0] & 0x3fffu); o[1] = (pk2(0.f, w1) & 0xffff0000u) | (s2[1] & 0x3fffu);
        *sp = o;
    }
}
__device__ __forceinline__ void phase_expert_v(const KP& p, LAS unsigned char* lds, volatile LAS unsigned* MISC, int l, int G) {
    const int tid = opaque_tid(), lane = tid & 63, w = __builtin_amdgcn_readfirstlane(tid >> 6), j = lane >> 3, c = lane & 7;
    const XSlice xs = xslice_of_block(p, MISC, G);
    const unsigned char* Vs = p.ws + WS_V + (size_t)(l & 1) * TAB_BYTES + (size_t)xs.sl * 16384 * 128;
    const unsigned* SEL = (const unsigned*)(p.ws + WS_SEL);
    const float* g2 = (const float*)(p.ws + WS_MOD) + (size_t)l * 32 * NMODC + 5120;
    const bf16_t* X = (const bf16_t*)p.out; bf16_t* XO = (l == DEPTH - 1) ? (bf16_t*)(p.ws + WS_YS) : (bf16_t*)p.out;
    const int t0 = xs.rank * 8 + w, tstep = xs.nloc * 8;
    const bool b3 = (lane & 8) != 0;
    LAS unsigned char* ring = lds + w * 17920; LAS unsigned char* selb = ring + 16384;
    const int tlast = t0 + ((M - 1 - t0) / tstep) * tstep;
#define E2_CL(t) ((t) <= tlast ? (t) : tlast)
#define E2_DMA_SEL(t, par) do { const unsigned* sp = SEL + (size_t)E2_CL(t) * 128 + lane; \
            __builtin_amdgcn_global_load_lds(sp, (LAS unsigned*)(selb + (par) * 512), 4, 0, 0); __builtin_amdgcn_global_load_lds(sp + 64, (LAS unsigned*)(selb + (par) * 512 + 256), 4, 0, 0); } while (0)
#define E2_DMA_ROW(i, idxv) do { __builtin_amdgcn_global_load_lds((const unsigned*)(Vs + (size_t)((idxv) & 0x3fffu) * 128 + 16 * c), (LAS unsigned*)(ring + (i) * 1024), 16, 0, 0); } while (0)
    if (t0 < M) {
        E2_DMA_SEL(t0, 0); E2_DMA_SEL(t0 + tstep, 1);
        asm volatile("s_waitcnt vmcnt(0)" ::: "memory");
        u32x4 sc[4];
#pragma unroll
        for (int q = 0; q < 4; ++q) sc[q] = *(const LAS u32x4*)(selb + (16 * j + 4 * q) * 4);
#pragma unroll
        for (int i = 0; i < 16; ++i) E2_DMA_ROW(i, sc[i >> 2][i & 3]);
        LAS float* xbuf = (LAS float*)(ring + 16384 + 1024);
        { const bf16_t* xd = X + (size_t)t0 * D + xs.sl * 128 + 16 * c + 2 * j; __builtin_amdgcn_global_load_lds((const unsigned*)xd, (LAS unsigned*)xbuf, 4, 0, 0); }
        int par = 0, bcur = -1; f32x2 gv = {0.f, 0.f};
        for (int tok = t0; tok < M; tok += tstep, par ^= 1) {
            const int dim = xs.sl * 128 + 16 * c + 2 * j;
            const size_t xo = (size_t)tok * D + dim;
            if ((tok >> 11) != bcur) { bcur = tok >> 11; const f32x2 gl = *(const f32x2*)(g2 + (size_t)bcur * NMODC + dim); asm volatile("s_waitcnt vmcnt(0)" ::: "memory"); gv[0] = gl[0] * 1.0f; gv[1] = gl[1] * 1.0f; asm volatile("" : "+v"(gv)); }
            E2_DMA_SEL(tok + 2 * tstep, par);
            __builtin_amdgcn_global_load_lds((const unsigned*)(X + xo), (LAS unsigned*)xbuf, 4, 0, 0);
            asm volatile("s_waitcnt vmcnt(20)" ::: "memory");
            u32x4 sn[4];
#pragma unroll
            for (int q = 0; q < 4; ++q) sn[q] = *(const LAS u32x4*)(selb + (par ^ 1) * 512 + (16 * j + 4 * q) * 4);
            f32x2 o2[8];
#pragma unroll
            for (int q = 0; q < 8; ++q) o2[q] = (f32x2){0.f, 0.f};
#pragma unroll
            for (int i0 = 0; i0 < 16; i0 += 4) {
                asm volatile("s_waitcnt vmcnt(16)" ::: "memory");
                u32x4 row[4];
#pragma unroll
                for (int r = 0; r < 4; ++r) row[r] = *(const LAS u32x4*)(ring + (i0 + r) * 1024 + 16 * lane);
                asm volatile("s_waitcnt lgkmcnt(0)" ::: "memory");
#pragma unroll
                for (int r = 0; r < 4; ++r) E2_DMA_ROW(i0 + r, sn[(i0 + r) >> 2][(i0 + r) & 3]);
                {
                    const u32x2 wA = {sc[i0 >> 2][0], sc[i0 >> 2][1]}, wB = {sc[i0 >> 2][2], sc[i0 >> 2][3]};
#pragma unroll
                    for (int r = 0; r < 4; ++r)
#pragma unroll
                        for (int q = 0; q < 4; ++q) { const f32x2 lo = __builtin_amdgcn_cvt_pk_f32_fp8((int)row[r][q], false), hi = __builtin_amdgcn_cvt_pk_f32_fp8((int)row[r][q], true);
                            if (r & 1) { asm("v_pk_fma_f32 %0, %1, %2, %0 op_sel:[1,0,0] op_sel_hi:[1,1,1]" : "+v"(o2[2 * q]) : "v"(r < 2 ? wA : wB), "v"(lo));
                                         asm("v_pk_fma_f32 %0, %1, %2, %0 op_sel:[1,0,0] op_sel_hi:[1,1,1]" : "+v"(o2[2 * q + 1]) : "v"(r < 2 ? wA : wB), "v"(hi)); }
                            else       { asm("v_pk_fma_f32 %0, %1, %2, %0 op_sel:[0,0,0] op_sel_hi:[0,1,1]" : "+v"(o2[2 * q]) : "v"(r < 2 ? wA : wB), "v"(lo));
                                         asm("v_pk_fma_f32 %0, %1, %2, %0 op_sel:[0,0,0] op_sel_hi:[0,1,1]" : "+v"(o2[2 * q + 1]) : "v"(r < 2 ? wA : wB), "v"(hi)); } }
                }
            }
            float o[16];
#pragma unroll
            for (int q = 0; q < 8; ++q) { o[2 * q] = o2[q][0]; o[2 * q + 1] = o2[q][1]; }
            float r8[8], r4[4], r2[2];
#pragma unroll
            for (int k = 0; k < 8; ++k) { const u32x2 sw = __builtin_amdgcn_permlane32_swap(__float_as_uint(o[k]), __float_as_uint(o[8 + k]), false, false); r8[k] = __uint_as_float(sw[0]) + __uint_as_float(sw[1]); }
#pragma unroll
            for (int k = 0; k < 4; ++k) { const u32x2 sw = __builtin_amdgcn_permlane16_swap(__float_as_uint(r8[k]), __float_as_uint(r8[4 + k]), false, false); r4[k] = __uint_as_float(sw[0]) + __uint_as_float(sw[1]); }
#pragma unroll
            for (int k = 0; k < 2; ++k) { const float keep = b3 ? r4[2 + k] : r4[k], send = b3 ? r4[k] : r4[2 + k];
                r2[k] = keep + __uint_as_float(__builtin_amdgcn_update_dpp(0, __float_as_uint(send), 0x128, 0xF, 0xF, true)); }
            asm volatile("s_waitcnt vmcnt(16)" ::: "memory");
            { const unsigned xw = __float_as_uint(xbuf[lane]); *(unsigned*)(XO + xo) = pk2(bflo(xw) + gv[0] * r2[0], bfhi(xw) + gv[1] * r2[1]); }
#pragma unroll
            for (int q = 0; q < 4; ++q) sc[q] = sn[q];
        }
        asm volatile("s_waitcnt vmcnt(0)" ::: "memory");
    }
#undef E2_CL
#undef E2_DMA_SEL
#undef E2_DMA_ROW
}

__device__ __forceinline__ void phase_final(const KP& p, int G) {
    const int tid = opaque_tid(), lane = tid & 63, w = __builtin_amdgcn_readfirstlane(tid >> 6);
    const int gw = blockIdx.x * 8 + w, ngw = G * 8;
    const float* fg = p.in[I_FG];
    for (int r0 = gw * 4; r0 < M; r0 += ngw * 4) {
        f32x4 v[4][4]; float ss[4];
#pragma unroll
        for (int i = 0; i < 4; ++i) { const u32x2* xr = (const u32x2*)((const bf16_t*)(p.ws + WS_YS) + (size_t)(r0 + i) * D) + lane;
#pragma unroll
            for (int j = 0; j < 4; ++j) { const u32x2 xw = xr[64 * j]; v[i][j] = (f32x4){bflo(xw[0]), bfhi(xw[0]), bflo(xw[1]), bfhi(xw[1])}; } }
#pragma unroll
        for (int i = 0; i < 4; ++i) { float t = 0.f;
#pragma unroll
            for (int j = 0; j < 4; ++j) t += (v[i][j][0] * v[i][j][0] + v[i][j][1] * v[i][j][1]) + (v[i][j][2] * v[i][j][2] + v[i][j][3] * v[i][j][3]);
            ss[i] = t; }
#pragma unroll
        for (int o = 1; o < 64; o <<= 1) {
#pragma unroll
            for (int i = 0; i < 4; ++i) ss[i] += __shfl_xor(ss[i], o); }
#pragma unroll
        for (int j = 0; j < 4; ++j) { const f32x4 g4 = *(const f32x4*)(fg + 256 * j + 4 * lane);
#pragma unroll
            for (int i = 0; i < 4; ++i) { const float rstd = __builtin_amdgcn_rsqf(ss[i] * (1.0f / D) + EPS); ((f32x4*)(p.out + (size_t)(r0 + i) * D) + lane)[64 * j] = v[i][j] * rstd * g4; } }
    }
}

__global__ void __launch_bounds__(512, 2) mk_fwd(KP p_) {
    extern __shared__ __attribute__((aligned(16))) unsigned char lds_raw[];
    LAS unsigned char* lds = (LAS unsigned char*)lds_raw;
    const int tid = threadIdx.x, G = gridDim.x;
    volatile LAS unsigned* MISC = (volatile LAS unsigned*)(lds + MISC_OFF);
    for (int i = tid; i < LDS_BYTES / 4; i += 512) ((LAS unsigned*)lds)[i] = 0u;
    __syncthreads();
    XcdBarrier bar = xcd_barrier_post((unsigned*)(p_.ws + WS_CTL) + 4096, MISC + 8);
    if (tid == 0) { const unsigned myx = xb_xcc_id(); MISC[16] = myx; MISC[17] = xb_add((unsigned*)(p_.ws + WS_CTL) + 8192 + 64 * (myx & 15u), 1u); }
    __syncthreads();
    const int lo = p_.gp_lo, hi = p_.gp_hi;
#ifndef PH_MASK
#define PH_MASK 0xFFFFF
#endif
#define IN(k) (lo <= (k) && (k) < hi)
#define EN(b) ((PH_MASK >> (b)) & 1)
#ifndef PH_REPEAT
#define PH_REPEAT 0
#endif
#define NREP(b) (((PH_REPEAT >> (b)) & 1) ? 2 : 1)
#define SEAM(k) do { if ((k) + 1 < hi) xcd_barrier(bar); } while (0)
    if (EN(12) && IN(GP_SETUP)) { const KP p = load_kp(); phase_setup(p, lds, G); SEAM(GP_SETUP); }
    for (int l = 0; l < DEPTH; ++l) {
        const int g0 = 1 + l * NPH;
        if (EN(0) && IN(g0 + 0)) { _Pragma("nounroll") for (int rep = 0; rep < NREP(0); ++rep) { const KP p = load_kp(); phase_conv_norm1(p, lds, l, G); } SEAM(g0 + 0); }
        if (EN(1) && IN(g0 + 1)) { const KP p = load_kp();
            pg8::Gemm g{(const bf16_t*)(p.ws + WS_H), (const bf16_t*)(p.ws + WS_WIN), M, 3072, D / 2, D / 2, D / 2}; pg8::StaticOrder S; S.init(M, 3072, G, (int)blockIdx.x);
            pg8::EpiStoreBf16 E{(bf16_t*)(p.ws + WS_R0), 3072, 1.0f / (WIN_SCALE * HIN_SCALE)};
            _Pragma("nounroll") for (int rep = 0; rep < NREP(1); ++rep) pg8::gemm_phase<pg8::EpiStoreBf16, pg8::StaticOrder, false, true, true>(lds, g, S, E);
            SEAM(g0 + 1);
        }
        if (EN(2) && IN(g0 + 2)) { _Pragma("nounroll") for (int rep = 0; rep < NREP(2); ++rep) { const KP p = load_kp(); phase_hgrn2(p, lds, l, G); } SEAM(g0 + 2); }
        if (EN(3) && IN(g0 + 3)) { const KP p = load_kp();
            pg8::Gemm g{(const bf16_t*)(p.ws + WS_H), (const bf16_t*)(p.ws + WS_WIN) + (size_t)3072 * (D / 2), M, 4096, D / 2, D / 2, D / 2}; pg8::StaticOrder S; S.init(M, 4096, G, (int)blockIdx.x);
            pg8::EpiStoreBf16 E{(bf16_t*)(p.ws + WS_R0), 4096, 1.0f / (WIN_SCALE * HIN_SCALE)};
            _Pragma("nounroll") for (int rep = 0; rep < NREP(3); ++rep) pg8::gemm_phase<pg8::EpiStoreBf16, pg8::StaticOrder, false, true, true>(lds, g, S, E);
            SEAM(g0 + 3);
        }
        #if DBG_SELFCHECK
        if (EN(4) && IN(g0 + 4)) {
#pragma nounroll
            for (int rep = 0; rep < 2; ++rep) { const KP p = load_kp(); size_t yo = rep ? WS_H : WS_YS; asm volatile("" : "+s"(yo)); phase_s5(p, lds, l, G, yo); SEAM(g0 + 4); }
            const KP p = load_kp();
            const unsigned* a = (const unsigned*)(p.ws + WS_YS); const unsigned* b2 = (const unsigned*)(p.ws + WS_H); unsigned bad = 0;
            for (size_t i = (size_t)blockIdx.x * 512 + opaque_tid(); i < (size_t)M * D / 2; i += (size_t)G * 512) bad += (a[i] != b2[i]) ? 1u : 0u;
            if (bad) atomicAdd((unsigned*)(p.ws + WS_CTL) + 64, bad);
            { const unsigned* h1 = (const unsigned*)(p.ws + WS_CTL) + 65536; const unsigned* h2 = h1 + 8192; const int u2 = blockIdx.x * 512 + opaque_tid();
              if (u2 < 2048) { if (h1[u2 * 4] != h2[u2 * 4]) atomicAdd((unsigned*)(p.ws + WS_CTL) + 128, 1u); if (h1[u2 * 4 + 1] != h2[u2 * 4 + 1]) atomicAdd((unsigned*)(p.ws + WS_CTL) + 192, 1u); if (h1[u2 * 4 + 2] != h2[u2 * 4 + 2]) atomicAdd((unsigned*)(p.ws + WS_CTL) + 256, 1u); } }
            SEAM(g0 + 4); }
#else
        if (EN(4) && IN(g0 + 4)) { _Pragma("nounroll") for (int rep = 0; rep < NREP(4); ++rep) { const KP p = load_kp(); phase_s5(p, lds, l, G, WS_YS); } SEAM(g0 + 4); }
#endif
        if (EN(5) && IN(g0 + 5)) { const KP p = load_kp();
            pg8::Gemm g{(const bf16_t*)(p.ws + WS_YS), (const bf16_t*)(p.ws + WS_WGLU), M, D, D, D, D}; pg8::StaticOrder S; S.init(M, D, G, (int)blockIdx.x);
            pg8::EpiGlu E{(const bf16_t*)(p.ws + WS_R0), (const bf16_t*)(p.ws + WS_YS), (const bf16_t*)(p.ws + WS_OR), (const float*)(p.ws + WS_SSQ), p.in[I_HNG] + l * 128, p.in[I_GLUB] + l * D, (bf16_t*)(p.ws + WS_H)};
            _Pragma("nounroll") for (int rep = 0; rep < NREP(5); ++rep) pg8::gemm_phase<pg8::EpiGlu, pg8::StaticOrder, true, true>(lds, g, S, E);
            SEAM(g0 + 5);
        }
        if (EN(6) && IN(g0 + 6)) { const KP p = load_kp();
            pg8::Gemm g{(const bf16_t*)(p.ws + WS_H), (const bf16_t*)(p.ws + WS_WOUT), M, D, D / 2, D / 2, D / 2}; pg8::StaticOrder S; S.init(M, D, G, (int)blockIdx.x);
            pg8::EpiStoreBf16 E{(bf16_t*)(p.ws + WS_OR), D, 1.0f / (WO_SCALE * MG_SCALE)};
            pg8::gemm_phase<pg8::EpiStoreBf16, pg8::StaticOrder, false, true, true>(lds, g, S, E);
            SEAM(g0 + 6);
        }
        if (EN(7) && IN(g0 + 7)) { const KP p = load_kp();
            const int t2 = opaque_tid(), lane = t2 & 63, wave = __builtin_amdgcn_readfirstlane(t2 >> 6);
            if (l == 0) resid_norm_rows<false>(p.in[I_X], (bf16_t*)p.out, (const bf16_t*)(p.ws + WS_OR), (bf16_t*)(p.ws + WS_H), p.in[I_N2G] + l * D, (const float*)(p.ws + WS_MOD) + (size_t)l * 32 * NMODC, blockIdx.x * 8 + wave, G * 8, lane);
            else resid_norm_rows<true>(p.out, (bf16_t*)p.out, (const bf16_t*)(p.ws + WS_OR), (bf16_t*)(p.ws + WS_H), p.in[I_N2G] + l * D, (const float*)(p.ws + WS_MOD) + (size_t)l * 32 * NMODC, blockIdx.x * 8 + wave, G * 8, lane);
            SEAM(g0 + 7);
        }
        if (EN(8) && IN(g0 + 8)) { const KP p = load_kp();
            pg8::Gemm g{(const bf16_t*)(p.ws + WS_H), (const bf16_t*)(p.ws + WS_WQ), M, 2048, D, D, D}; pg8::StaticOrder S; S.init(M, 2048, G, (int)blockIdx.x);
            pg8::EpiStoreQ E{(bf16_t*)(p.ws + WS_R0)};
            _Pragma("nounroll") for (int rep = 0; rep < NREP(8); ++rep) pg8::gemm_phase<pg8::EpiStoreQ, pg8::StaticOrder, true, true>(lds, g, S, E);
            SEAM(g0 + 8);
        }
        if (EN(9) && IN(g0 + 9)) { _Pragma("nounroll") for (int rep = 0; rep < NREP(9); ++rep) { const KP p = load_kp(); phase_topk(p, lds, G); } SEAM(g0 + 9); }
        if (EN(10) && IN(g0 + 10)) {
            { const KP p = load_kp(); phase_expert_u(p, lds, MISC, l, G); } xcd_barrier(bar);
            { const KP p = load_kp(); phase_expert_w(p, G); } xcd_barrier(bar);
            { const KP p = load_kp(); phase_expert_v(p, lds, MISC, l, G); }
            SEAM(g0 + 10); }
    }
    if (EN(13) && IN(GP_FINAL)) { const KP p = load_kp(); phase_final(p, G); }
#undef IN
#undef EN
#undef NREP
#undef SEAM
}

extern "C" void kernel_launch(void* const* d_in, const int* in_sizes, int n_in, void* d_out, int out_size, void* d_ws, size_t ws_size, hipStream_t stream) {
    static int grid = 0;
    if (grid == 0) {
        if (n_in != 25 || out_size != M * D || ws_size < WS_END) { fprintf(stderr, "kernel_launch: unexpected shapes (n_in %d, out %d, ws %zu < %zu)\n", n_in, out_size, ws_size, (size_t)WS_END); grid = -1; return; }
        int dev = 0, cus = 0, per_cu = 0;
        if (hipGetDevice(&dev) != hipSuccess || hipDeviceGetAttribute(&cus, hipDeviceAttributeMultiprocessorCount, dev) != hipSuccess) { grid = -1; return; }
        if (hipFuncSetAttribute((const void*)mk_fwd, hipFuncAttributeMaxDynamicSharedMemorySize, LDS_BYTES) != hipSuccess) { fprintf(stderr, "kernel_launch: hipFuncSetAttribute failed\n"); grid = -1; return; }
        if (hipOccupancyMaxActiveBlocksPerMultiprocessor(&per_cu, (const void*)mk_fwd, 512, LDS_BYTES) != hipSuccess || per_cu < 1) fprintf(stderr, "kernel_launch: occupancy query says %d\n", per_cu);
        (void)hipGetLastError();
        grid = cus;
    }
    if (grid < 0) return;
    (void)hipMemsetAsync((char*)d_ws + WS_CTL, 0, CTL_ZERO_BYTES, stream);
    KP a{};
    for (int i = 0; i < 25; ++i) a.in[i] = (const float*)d_in[i];
    a.out = (float*)d_out; a.ws = (unsigned char*)d_ws;
#if MK_LAUNCHES == 1
    a.gp_lo = 0; a.gp_hi = GP_END;
    hipLaunchKernelGGL(mk_fwd, dim3(grid), dim3(512), LDS_BYTES, stream, a);
#else
    for (int gp = 0; gp < GP_END; ++gp) { a.gp_lo = gp; a.gp_hi = gp + 1; hipLaunchKernelGGL(mk_fwd, dim3(grid), dim3(512), LDS_BYTES, stream, a); }
#endif
}
```

```cpp
#include <hip/hip_runtime.h>
#include <cstdio>
#include <cstdint>

#define DBG_HASHSEL 0
#define DBG_H2_FROM_INPUT 0
#define DBG_NO_YA 0
#define DBG_NO_YB 0
#define DBG_NO_ACC 0
#define DBG_NO_GB 0
#define DBG_S5_NOSSM 0
#define DBG_S5_NOREC 0
#define DBG_SELFCHECK 0
#ifndef MK_LAUNCHES
#define MK_LAUNCHES 1
#endif

#define LAS __attribute__((address_space(3)))
typedef unsigned short bf16_t;
typedef short bf16x8 __attribute__((ext_vector_type(8)));
typedef float f32x2 __attribute__((ext_vector_type(2)));
typedef float f32x4 __attribute__((ext_vector_type(4)));
typedef float f32x16 __attribute__((ext_vector_type(16)));
typedef unsigned u32x2 __attribute__((ext_vector_type(2)));
typedef unsigned u32x4 __attribute__((ext_vector_type(4)));
typedef __bf16 bf16v2 __attribute__((ext_vector_type(2)));
typedef int i32x8 __attribute__((ext_vector_type(8)));
typedef int i32x4 __attribute__((ext_vector_type(4)));

constexpr int D = 1024, BATCH = 32, SEQ = 2048, DEPTH = 4, M = BATCH * SEQ;
constexpr int INC = 7168, NMODC = 6 * D;
constexpr int NPH = 11, GP_SETUP = 0, GP_FINAL = 1 + DEPTH * NPH, GP_END = GP_FINAL + 1;
constexpr float EPS = 1e-6f;
constexpr float U_SCALE = 64.0f, V_SCALE = 4.0f;
constexpr size_t TAB_BYTES = (size_t)16384 * 1024;
constexpr float WIN_SCALE = 64.0f, HIN_SCALE = 4.0f;
constexpr float WO_SCALE = 64.0f, MG_SCALE = 8.0f;

constexpr size_t MiB = 1u << 20;
constexpr size_t WS_CTL = 0, CTL_ZERO_BYTES = 1 * MiB;
constexpr size_t WS_MOD = 1 * MiB;
constexpr size_t WS_LB = 4 * MiB;
constexpr size_t WS_ABAR = 4 * MiB + 65536;
constexpr size_t WS_BOP = 5 * MiB;
constexpr size_t WS_COP = 6 * MiB;
constexpr size_t WS_WIN = 8 * MiB;
constexpr size_t WS_WGLU = 22 * MiB;
constexpr size_t WS_WOUT = 24 * MiB;
constexpr size_t WS_WQ = 26 * MiB;
constexpr size_t WS_KEYS = 30 * MiB;
constexpr size_t WS_U = 32 * MiB;
constexpr size_t WS_V = 64 * MiB;
constexpr size_t WS_H = 96 * MiB;
constexpr size_t WS_OR = 224 * MiB;
constexpr size_t WS_SSQ = 352 * MiB;
constexpr size_t WS_R0 = 354 * MiB;
constexpr size_t WS_SEL = WS_R0 + 256 * MiB;
constexpr size_t WS_YS = WS_R0 + 512 * MiB;
constexpr size_t WS_END = WS_YS + 128 * MiB;

constexpr int LDS_BYTES = 147456;
constexpr int MISC_OFF = LDS_BYTES - 256;

__device__ __forceinline__ unsigned pk2(float lo, float hi) { f32x2 v = {lo, hi}; bf16v2 r = __builtin_convertvector(v, bf16v2); return __builtin_bit_cast(unsigned, r); }
__device__ __forceinline__ float bflo(unsigned w) { return __uint_as_float(w << 16); }
__device__ __forceinline__ float bfhi(unsigned w) { return __uint_as_float(w & 0xffff0000u); }
__device__ __forceinline__ float fsigmoid(float x) { return __builtin_amdgcn_rcpf(1.0f + __expf(-x)); }
__device__ __forceinline__ float fsilu(float x) { return x * fsigmoid(x); }
__device__ __forceinline__ float fgelu(float x) { return x * fsigmoid(1.5957691216f * (x + 0.044715f * x * x * x)); }
__device__ __forceinline__ float wave_sum(float v) {
#pragma unroll
    for (int o = 1; o < 64; o <<= 1) v += __shfl_xor(v, o);
    return v;
}
#define LDS_WAIT() asm volatile("s_waitcnt lgkmcnt(0)" ::: "memory")
__device__ __forceinline__ float dpp_sum8(float d);
__device__ __forceinline__ int opaque_tid() { int t = threadIdx.x; asm volatile("" : "+v"(t)); return t; }

namespace pg8 {
#define PG8_LAS __attribute__((address_space(3)))
constexpr int BM = 256, BK = 64, HALF = 128, HTB = HALF * BK * 2, STAGE_BYTES = 8 * HTB, NXCD = 8, WGM = 8;
__host__ __device__ __forceinline__ int lds_byte(int r, int c) { const int st = (r >> 4) * 2 + (c >> 5), rr = r & 15, cc = c & 31, ob = rr * 64 + cc * 2; return st * 1024 + (ob ^ (((ob >> 9) & 1) << 5)); }
__host__ __device__ __forceinline__ void stage_rc(int b, int& R, int& C) { const int st = b / 1024, sb = b % 1024, swz = sb ^ (((sb >> 9) & 1) << 5); R = (st >> 1) * 16 + swz / 64; C = (st & 1) * 32 + (swz % 64) / 2; }
__host__ __device__ __forceinline__ int perm32(int rho) { const int n = rho >> 4, i = rho & 15; return 8 * (i >> 2) + 4 * n + (i & 3); }
struct Unit { int pm, pn; };
struct Gemm { const bf16_t* A; const bf16_t* Bt; int M, N, K, lda, ldb; };
struct StaticOrder {
    int nM, nN, nwg, G, c;
    __host__ __device__ void init(int M_, int N_, int G_, int c_) { nM = M_ / BM; nN = N_ / BM; nwg = nM * nN; G = G_; c = c_; }
    __host__ __device__ bool next(int i, Unit& u) const {
        const long L = (long)i * G + c; if (L >= nwg) return false;
        int wgid = (int)L; { const int q = nwg / NXCD, r = nwg % NXCD, xcd = wgid % NXCD, off = wgid / NXCD; wgid = (xcd < r ? xcd * (q + 1) : r * (q + 1) + (xcd - r) * q) + off; }
        const int nig = WGM * nN, gid = wgid / nig, fm = gid * WGM, gsz = (nM - fm) < WGM ? (nM - fm) : WGM;
        u.pm = fm + ((wgid % nig) % gsz); u.pn = (wgid % nig) / gsz; return true;
    }
    __device__ __forceinline__ void a_ready(const Unit&) const {}
    __device__ __forceinline__ void done(const Unit&) const {}
};
template <class Epi, class Sched, bool ALIGN_EPI = false, bool SP2 = false, bool F8 = false>
__device__ __forceinline__ void gemm_phase(PG8_LAS unsigned char* lds, const Gemm g, const Sched& S, const Epi& E) {
    const int tid = opaque_tid(), wid = __builtin_amdgcn_readfirstlane(tid >> 6), lane = tid & 63, wr = wid >> 2, wc = wid & 3, fr = lane & 15, fq = lane >> 4;
    const int K = g.K, nt = K / BK;
    unsigned voffA[2], voffB[2];
#pragma unroll
    for (int i = 0; i < 2; ++i) { int R, C; stage_rc(tid * 16 + i * 8192, R, C); const int Rb = Epi::PERM ? ((R & ~31) + perm32(R & 31)) : R;
        voffA[i] = (unsigned)(R * g.lda + C) * 2u; voffB[i] = (unsigned)(Rb * g.ldb + C) * 2u; }
    const size_t kstep = (size_t)(BK * 2);
    const size_t hstepA = (size_t)HALF * g.lda * 2, hstepB = (size_t)HALF * g.ldb * 2;
    const size_t tstepA = 2 * hstepA, tstepB = 2 * hstepB;
    const unsigned ldsw = (unsigned)wid * 1024u;
    const int aoff = lds_byte(wr * 64 + fr, fq * 8), boff = lds_byte(wc * 32 + fr, fq * 8);
#define PG8_SA(b, h) (((b) * 2 + (h)) * HTB)
#define PG8_SB(b, h) ((4 + (b) * 2 + (h)) * HTB)
#define PG8_STAGE(bufoff, gbase, voff) do { _Pragma("unroll") for (int _i = 0; _i < 2; ++_i) \
        __builtin_amdgcn_global_load_lds((const unsigned*)((const char*)(gbase) + (voff)[_i]), (PG8_LAS unsigned*)(lds + (bufoff) + ldsw + _i * 8192), 16, 0, 0); } while (0)
#define PG8_LD8(p) __builtin_shufflevector(*(const PG8_LAS i32x4*)(p), *(const PG8_LAS i32x4*)((p) + 1024), 0, 1, 2, 3, 4, 5, 6, 7)
#define PG8_LDA(dst, b, h) do { if constexpr (F8) { _Pragma("unroll") for (int m = 0; m < 4; ++m) dst##8[m] = PG8_LD8(lds + PG8_SA(b, h) + aoff + m * 2048); } \
        else { _Pragma("unroll") for (int m = 0; m < 4; ++m) _Pragma("unroll") for (int k = 0; k < 2; ++k) dst[m][k] = *(const PG8_LAS bf16x8*)(lds + PG8_SA(b, h) + aoff + m * 2048 + k * 1024); } } while (0)
#define PG8_LDB(dst, b, h) do { if constexpr (F8) { _Pragma("unroll") for (int n = 0; n < 2; ++n) dst##8[n] = PG8_LD8(lds + PG8_SB(b, h) + boff + n * 2048); } \
        else { _Pragma("unroll") for (int n = 0; n < 2; ++n) _Pragma("unroll") for (int k = 0; k < 2; ++k) dst[n][k] = *(const PG8_LAS bf16x8*)(lds + PG8_SB(b, h) + boff + n * 2048 + k * 1024); } } while (0)
#define PG8_MMA(ai, bj, At, Bt) do { __builtin_amdgcn_s_setprio(1); _Pragma("unroll") for (int m = 0; m < 4; ++m) _Pragma("unroll") for (int n = 0; n < 2; ++n) { \
        if constexpr (F8) {   \
            acc[ai][bj][m][n] = __builtin_amdgcn_mfma_scale_f32_16x16x128_f8f6f4(Bt##8[n], At##8[m], acc[ai][bj][m][n], 0, 0, 0, 0x7f7f7f7f, 0, 0x7f7f7f7f); \
        } else { _Pragma("unroll") for (int k = 0; k < 2; ++k) acc[ai][bj][m][n] = __builtin_amdgcn_mfma_f32_16x16x32_bf16(Bt[n][k], At[m][k], acc[ai][bj][m][n], 0, 0, 0); } } \
        __builtin_amdgcn_s_setprio(0); } while (0)
#define PG8_WAIT_V(n) asm volatile("s_waitcnt vmcnt(" #n ")" ::: "memory")
#define PG8_WAIT_L(n) asm volatile("s_waitcnt lgkmcnt(" #n ")" ::: "memory")
#define PG8_BAR __builtin_amdgcn_s_barrier()
#define PG8_SCHED __builtin_amdgcn_sched_barrier(0)
    Unit cur, nxt; int ui = 0;
    if (!S.next(0, cur)) return;
    f32x4 acc[2][2][4][2];
#pragma unroll
    for (int a = 0; a < 2; ++a)
#pragma unroll
        for (int b = 0; b < 2; ++b)
#pragma unroll
            for (int m = 0; m < 4; ++m)
#pragma unroll
                for (int n = 0; n < 2; ++n) acc[a][b][m][n] = (f32x4){0.f, 0.f, 0.f, 0.f};
    bf16x8 At[4][2], B0[2][2], B1[2][2]; i32x8 At8[4], B08[2], B18[2];
    const char* cA = (const char*)g.A + (size_t)cur.pm * tstepA; const char* cB = (const char*)g.Bt + (size_t)cur.pn * tstepB;
    S.a_ready(cur);
    if constexpr (SP2) {
        PG8_STAGE(PG8_SB(0, 0), cB, voffB); PG8_STAGE(PG8_SB(0, 1), cB + hstepB, voffB); PG8_STAGE(PG8_SA(0, 0), cA, voffA); PG8_STAGE(PG8_SA(0, 1), cA + hstepA, voffA);
        if (wr == 1) PG8_BAR;
        PG8_WAIT_V(2); PG8_BAR;
        PG8_STAGE(PG8_SB(1, 0), cB + kstep, voffB); PG8_STAGE(PG8_SA(1, 0), cA + kstep, voffA); PG8_STAGE(PG8_SB(1, 1), cB + hstepB + kstep, voffB);
        PG8_WAIT_V(6); PG8_BAR;
    } else {
        PG8_STAGE(PG8_SB(0, 0), cB, voffB); PG8_STAGE(PG8_SA(0, 0), cA, voffA); PG8_STAGE(PG8_SB(0, 1), cB + hstepB, voffB); PG8_STAGE(PG8_SA(0, 1), cA + hstepA, voffA);
        if (wr == 1) PG8_BAR;
        PG8_WAIT_V(4); PG8_BAR;
        PG8_STAGE(PG8_SB(1, 0), cB + kstep, voffB); PG8_STAGE(PG8_SA(1, 0), cA + kstep, voffA); PG8_STAGE(PG8_SB(1, 1), cB + hstepB + kstep, voffB);
        PG8_WAIT_V(6); PG8_BAR;
    }
    for (;;) {
        const bool has_next = S.next(ui + 1, nxt);
        const char* nA = has_next ? (const char*)g.A + (size_t)nxt.pm * tstepA : cA; const char* nB = has_next ? (const char*)g.Bt + (size_t)nxt.pn * tstepB : cB;
        for (int t = 0; t < nt; t += 2) {
            const bool last = (t == nt - 2);
            const char* a1 = cA + (size_t)(t + 1) * kstep;
            const char* a2 = last ? nA : cA + (size_t)(t + 2) * kstep; const char* b2 = last ? nB : cB + (size_t)(t + 2) * kstep;
            const char* a3 = a2 + kstep; const char* b3 = b2 + kstep;
            if (last && has_next) S.a_ready(nxt);
            if constexpr (SP2) {
            PG8_LDB(B0, 0, 0); PG8_LDB(B1, 0, 1); PG8_SCHED; PG8_LDA(At, 0, 0); PG8_STAGE(PG8_SA(1, 1), a1 + hstepA, voffA);
            PG8_WAIT_V(8); PG8_WAIT_L(0); PG8_BAR; PG8_MMA(0, 0, At, B0); PG8_MMA(0, 1, At, B1); PG8_BAR; PG8_SCHED;
            PG8_LDA(At, 0, 1); PG8_STAGE(PG8_SB(0, 0), b2, voffB); PG8_STAGE(PG8_SB(0, 1), b2 + hstepB, voffB); PG8_STAGE(PG8_SA(0, 0), a2, voffA);
            PG8_WAIT_V(8); PG8_WAIT_L(0); PG8_BAR; PG8_MMA(1, 0, At, B0); PG8_MMA(1, 1, At, B1); PG8_BAR; PG8_SCHED;
            PG8_LDB(B0, 1, 0); PG8_LDB(B1, 1, 1); PG8_SCHED; PG8_LDA(At, 1, 0); PG8_STAGE(PG8_SA(0, 1), a2 + hstepA, voffA);
            PG8_WAIT_V(8); PG8_WAIT_L(0); PG8_BAR; PG8_MMA(0, 0, At, B0); PG8_MMA(0, 1, At, B1); PG8_BAR; PG8_SCHED;
            PG8_LDA(At, 1, 1); PG8_STAGE(PG8_SB(1, 0), b3, voffB); PG8_STAGE(PG8_SB(1, 1), b3 + hstepB, voffB); PG8_STAGE(PG8_SA(1, 0), a3, voffA);
            PG8_WAIT_V(8); PG8_WAIT_L(0); PG8_BAR; PG8_MMA(1, 0, At, B0); PG8_MMA(1, 1, At, B1); PG8_BAR; PG8_SCHED;
            } else {
            PG8_LDB(B0, 0, 0); PG8_SCHED; PG8_LDA(At, 0, 0); PG8_STAGE(PG8_SA(1, 1), a1 + hstepA, voffA);
            PG8_WAIT_L(8); PG8_BAR; PG8_WAIT_L(0); PG8_MMA(0, 0, At, B0); PG8_BAR; PG8_SCHED;
            PG8_LDB(B1, 0, 1); PG8_STAGE(PG8_SB(0, 0), b2, voffB);
            PG8_BAR; PG8_WAIT_L(0); PG8_MMA(0, 1, At, B1); PG8_BAR;
            PG8_LDA(At, 0, 1); PG8_STAGE(PG8_SA(0, 0), a2, voffA);
            PG8_BAR; PG8_WAIT_L(0); PG8_MMA(1, 0, At, B0); PG8_BAR; PG8_SCHED;
            PG8_STAGE(PG8_SB(0, 1), b2 + hstepB, voffB);
            PG8_WAIT_V(6); PG8_BAR; PG8_MMA(1, 1, At, B1); PG8_BAR;
            PG8_LDB(B0, 1, 0); PG8_SCHED; PG8_LDA(At, 1, 0); PG8_STAGE(PG8_SA(0, 1), a2 + hstepA, voffA);
            PG8_WAIT_L(8); PG8_BAR; PG8_WAIT_L(0); PG8_MMA(0, 0, At, B0); PG8_BAR; PG8_SCHED;
            PG8_LDB(B1, 1, 1); PG8_STAGE(PG8_SB(1, 0), b3, voffB);
            PG8_BAR; PG8_WAIT_L(0); PG8_MMA(0, 1, At, B1); PG8_BAR;
            PG8_LDA(At, 1, 1); PG8_STAGE(PG8_SA(1, 0), a3, voffA);
            PG8_BAR; PG8_WAIT_L(0); PG8_MMA(1, 0, At, B0); PG8_BAR; PG8_SCHED;
            PG8_STAGE(PG8_SB(1, 1), b3 + hstepB, voffB);
            PG8_WAIT_V(6); PG8_BAR; PG8_MMA(1, 1, At, B1); PG8_BAR;
            }
        }
        if constexpr (ALIGN_EPI) { if (wr == 0) PG8_BAR; }
        E(acc, cur, wr, wc, fr, fq);
        if (!has_next) break;
#pragma unroll
        for (int a = 0; a < 2; ++a)
#pragma unroll
            for (int b = 0; b < 2; ++b)
#pragma unroll
                for (int m = 0; m < 4; ++m)
#pragma unroll
                    for (int n = 0; n < 2; ++n) acc[a][b][m][n] = (f32x4){0.f, 0.f, 0.f, 0.f};
        cur = nxt; cA = nA; cB = nB; ++ui;
        if constexpr (ALIGN_EPI) { if (wr == 1) PG8_BAR; }
    }
    PG8_WAIT_V(0);
    if constexpr (!ALIGN_EPI) { if (wr == 0) PG8_BAR; }
    PG8_BAR;
#undef PG8_SA
#undef PG8_SB
#undef PG8_STAGE
#undef PG8_LDA
#undef PG8_LD8
#undef PG8_LDB
#undef PG8_MMA
#undef PG8_WAIT_V
#undef PG8_WAIT_L
#undef PG8_BAR
#undef PG8_SCHED
}

struct EpiStoreBf16 {
    static constexpr bool PERM = true;
    bf16_t* O; int ldc; float scale;
    __device__ __forceinline__ void operator()(const f32x4 (&acc)[2][2][4][2], const Unit& u, int wr, int wc, int fr, int fq) const {
        const int row0 = u.pm * BM + wr * 64 + fr, col0 = u.pn * BM + wc * 32 + 8 * fq;
#pragma unroll
        for (int ai = 0; ai < 2; ++ai)
#pragma unroll
            for (int m = 0; m < 4; ++m) { bf16_t* rowp = O + (size_t)(row0 + ai * HALF + m * 16) * ldc + col0;
#pragma unroll
                for (int bj = 0; bj < 2; ++bj) { const f32x4 v0 = acc[ai][bj][m][0] * scale, v1 = acc[ai][bj][m][1] * scale;
                    u32x4 w; w.x = pk2(v0[0], v0[1]); w.y = pk2(v0[2], v0[3]); w.z = pk2(v1[0], v1[1]); w.w = pk2(v1[2], v1[3]);
                    *(u32x4*)(rowp + bj * HALF) = w; } }
    }
};
struct EpiStoreQ {
    static constexpr bool PERM = true;
    bf16_t* O;
    __device__ __forceinline__ void operator()(const f32x4 (&acc)[2][2][4][2], const Unit& u, int wr, int wc, int fr, int fq) const {
        const int row0 = u.pm * BM + wr * 64 + fr, col0 = u.pn * BM + wc * 32 + 8 * fq;
#pragma unroll
        for (int ai = 0; ai < 2; ++ai)
#pragma unroll
            for (int m = 0; m < 4; ++m) { const int row = row0 + ai * HALF + m * 16, tg = row >> 5, t = row & 31;
#pragma unroll
                for (int bj = 0; bj < 2; ++bj) { const int c0 = col0 + bj * HALF, h = c0 >> 8, pp = (c0 >> 7) & 1, cc = c0 & 127, ks = cc >> 4, hh = (cc >> 3) & 1;
                    const f32x4 v0 = acc[ai][bj][m][0], v1 = acc[ai][bj][m][1];
                    u32x4 w; w.x = pk2(v0[0], v0[1]); w.y = pk2(v0[2], v0[3]); w.z = pk2(v1[0], v1[1]); w.w = pk2(v1[2], v1[3]);
                    *(u32x4*)(O + ((size_t)((((tg * 8 + h) * 2 + pp) * 8 + ks) * 64 + hh * 32 + t)) * 8) = w; } }
    }
};
struct EpiWout {
    static constexpr bool PERM = false;
    const float* xs; float* out; const float* g1;
    __device__ __forceinline__ void operator()(const f32x4 (&acc)[2][2][4][2], const Unit& u, int wr, int wc, int fr, int fq) const {
        const int row0 = u.pm * BM + wr * 64 + fr, col0 = u.pn * BM + wc * 32 + 4 * fq;
        const int b = (u.pm * BM) >> 11;
        f32x4 gv[2][2];
#pragma unroll
        for (int bj = 0; bj < 2; ++bj)
#pragma unroll
            for (int n = 0; n < 2; ++n) gv[bj][n] = *(const f32x4*)(g1 + (size_t)b * NMODC + col0 + bj * HALF + n * 16);
#pragma unroll
        for (int ai = 0; ai < 2; ++ai)
#pragma unroll
            for (int m = 0; m < 4; ++m) { const size_t off = (size_t)(row0 + ai * HALF + m * 16) * D + col0;
#pragma unroll
                for (int bj = 0; bj < 2; ++bj)
#pragma unroll
                    for (int n = 0; n < 2; ++n) { const f32x4 xv = *(const f32x4*)(xs + off + bj * HALF + n * 16);
                        *(f32x4*)(out + off + bj * HALF + n * 16) = xv + gv[bj][n] * acc[ai][bj][m][n]; } }
    }
};
struct EpiGlu {
    static constexpr bool PERM = true;
    const bf16_t* PB; const bf16_t* YS; const bf16_t* ORAW; const float* SSQ; const float* ng; const float* gb_; bf16_t* O;
    __device__ __forceinline__ void operator()(const f32x4 (&acc)[2][2][4][2], const Unit& u, int wr, int wc, int fr, int fq) const {
        const int row0 = u.pm * BM + wr * 64 + fr, col0 = u.pn * BM + wc * 32 + 8 * fq;
#pragma unroll
        for (int bj = 0; bj < 2; ++bj) {
            const int c = col0 + bj * HALF, head = c >> 7;
            const f32x4 n0 = *(const f32x4*)(ng + (c & 127)), n1 = *(const f32x4*)(ng + (c & 127) + 4);
            const f32x4 b0 = *(const f32x4*)(gb_ + c), b1 = *(const f32x4*)(gb_ + c + 4);
            const float ngv[8] = {n0[0], n0[1], n0[2], n0[3], n1[0], n1[1], n1[2], n1[3]};
            const float bbv[8] = {b0[0], b0[1], b0[2], b0[3], b1[0], b1[1], b1[2], b1[3]};
#pragma unroll
            for (int ai = 0; ai < 2; ++ai)
#pragma unroll
                for (int m = 0; m < 4; ++m) {
                    const int row = row0 + ai * HALF + m * 16;
                    const bf16_t* pb = PB + (size_t)row * 4096 + c;
                    const u32x4 og = *(const u32x4*)(pb), ys = *(const u32x4*)(YS + (size_t)row * D + c), ga = *(const u32x4*)(pb + 2048), gb = *(const u32x4*)(pb + 3072);
                    const u32x4 orw = *(const u32x4*)(ORAW + (size_t)row * D + c);
                    const float rstd = __builtin_amdgcn_rsqf(SSQ[(size_t)row * 8 + head] * (1.0f / 128.0f) + EPS);
                    const f32x4 a0 = acc[ai][bj][m][0], a1 = acc[ai][bj][m][1];
                    const float av[8] = {a0[0], a0[1], a0[2], a0[3], a1[0], a1[1], a1[2], a1[3]};
                    float res[8];
#pragma unroll
                    for (int j = 0; j < 8; ++j) {
                        const unsigned wog = og[j >> 1], wys = ys[j >> 1], wga = ga[j >> 1], wgb = gb[j >> 1], wor = orw[j >> 1];
                        const float fog = (j & 1) ? bfhi(wog) : bflo(wog), fys = (j & 1) ? bfhi(wys) : bflo(wys), fga = (j & 1) ? bfhi(wga) : bflo(wga),
                                    fgb = (j & 1) ? bfhi(wgb) : bflo(wgb), fo = (j & 1) ? bfhi(wor) : bflo(wor);
                        const float ya = fo * rstd * ngv[j] * fsilu(fog);
                        const float yb = fys * fsigmoid((DBG_NO_ACC ? 0.f : av[j]) + bbv[j]);
                        res[j] = (DBG_NO_YA ? 0.f : fsigmoid(fga) * ya) + (DBG_NO_YB ? 0.f : (DBG_NO_GB ? 0.5f : fsigmoid(fgb)) * yb);
                    }
                    int w0 = 0, w1 = 0;
                    w0 = __builtin_amdgcn_cvt_pk_fp8_f32(res[0] * MG_SCALE, res[1] * MG_SCALE, w0, false); w0 = __builtin_amdgcn_cvt_pk_fp8_f32(res[2] * MG_SCALE, res[3] * MG_SCALE, w0, true);
                    w1 = __builtin_amdgcn_cvt_pk_fp8_f32(res[4] * MG_SCALE, res[5] * MG_SCALE, w1, false); w1 = __builtin_amdgcn_cvt_pk_fp8_f32(res[6] * MG_SCALE, res[7] * MG_SCALE, w1, true);
                    *(u32x2*)((unsigned char*)O + (size_t)row * D + c) = (u32x2){(unsigned)w0, (unsigned)w1};
                }
        }
    }
};
}

#define XB_TMO      128
#define XB_XCNT(j)  (256  + 64 * (j))
#define XB_XSUB(j)  (1280 + 64 * (j))
#define XB_XGEN(j)  (2304 + 64 * (j))
#define XB_TOP      3328
#define XB_TOPGEN   3392
#define XCD_BAR_WORDS 3456
#define XB_SPIN_CAP (1u << 25)
__device__ __forceinline__ unsigned xb_ld(unsigned* p)              { return __hip_atomic_load(p, __ATOMIC_RELAXED, __HIP_MEMORY_SCOPE_AGENT); }
__device__ __forceinline__ unsigned xb_add(unsigned* p, unsigned v) { return __hip_atomic_fetch_add(p, v, __ATOMIC_RELAXED, __HIP_MEMORY_SCOPE_AGENT); }
__device__ __forceinline__ unsigned xb_xcc_id() { return (unsigned)__builtin_amdgcn_s_getreg((3 << 11) | 20) & 0xFu; }
#define XB_SPIN(cond, bar) do { unsigned _sp = 0; while (cond) { __builtin_amdgcn_s_sleep(1); \
    if ((++_sp & 255u) == 0u) { if (xb_ld(&(bar)[XB_TMO])) break; if (_sp > XB_SPIN_CAP) { atomicAdd(&(bar)[XB_TMO], 1u); break; } } } } while (0)
struct XcdBarrier { unsigned* bar; unsigned x; volatile LAS unsigned* st; };
__device__ __forceinline__ XcdBarrier xcd_barrier_post(unsigned* bar, volatile LAS unsigned* st) {
    XcdBarrier b; b.bar = bar; b.x = xb_xcc_id(); b.st = st;
    if (threadIdx.x == 0) (void)xb_add(&bar[XB_XCNT(b.x)], 1u);
    return b;
}
__device__ __forceinline__ void xcd_barrier_complete(unsigned* bar, unsigned x, unsigned& nloc, unsigned& nx) {
    const unsigned G = gridDim.x * gridDim.y * gridDim.z;
    unsigned sum, cnt, mine, sp = 0u;
    for (;;) {
        sum = 0u; cnt = 0u; mine = 0u;
#pragma unroll
        for (unsigned j = 0; j < 16; ++j) { const unsigned c = xb_ld(&bar[XB_XCNT(j)]); sum += c; cnt += (c > 0u) ? 1u : 0u; mine = (j == x) ? c : mine; }
        if (sum == G) break;
        __builtin_amdgcn_s_sleep(1);
        if ((++sp & 255u) == 0u) { if (xb_ld(&bar[XB_TMO])) break; if (sp > XB_SPIN_CAP) { atomicAdd(&bar[XB_TMO], 1u); break; } }
    }
    nloc = mine > 0u ? mine : 1u; nx = cnt > 0u ? cnt : 1u;
}
__device__ __forceinline__ void xcd_barrier(const XcdBarrier& b) {
    asm volatile("s_waitcnt vmcnt(0)" ::: "memory");
    __syncthreads();
    if (threadIdx.x == 0) {
        unsigned* bar = b.bar;
        __builtin_amdgcn_s_waitcnt(0);
        unsigned nloc = b.st[0], nx = b.st[1];
        if (nloc == 0u) { xcd_barrier_complete(bar, b.x, nloc, nx); b.st[0] = nloc; b.st[1] = nx; }
        const unsigned old = xb_add(&bar[XB_XSUB(b.x)], 1u);
        const unsigned gen = old / nloc;
        if (old + 1u == (gen + 1u) * nloc) {
            __builtin_amdgcn_fence(__ATOMIC_RELEASE, "agent");
            asm volatile("s_waitcnt vmcnt(0)" ::: "memory");
            const unsigned og = xb_add(&bar[XB_TOP], 1u);
            const unsigned tg = og / nx;
            if (og + 1u == (tg + 1u) * nx) xb_add(&bar[XB_TOPGEN], 1u);
            else XB_SPIN(xb_ld(&bar[XB_TOPGEN]) == tg, bar);
            __builtin_amdgcn_fence(__ATOMIC_ACQUIRE, "agent");
            xb_add(&bar[XB_XGEN(b.x)], 1u);
            asm volatile("s_waitcnt vmcnt(0)" ::: "memory");
        } else {
            XB_SPIN(xb_ld(&bar[XB_XGEN(b.x)]) == gen, bar);
            __builtin_amdgcn_fence(__ATOMIC_ACQUIRE, "agent");
            asm volatile("s_waitcnt vmcnt(0)" ::: "memory");
        }
    }
    __syncthreads();
}

struct KP { const float* in[25]; float* out; unsigned char* ws; int gp_lo, gp_hi; };
enum { I_X = 0, I_C, I_ADAW, I_ADAB, I_N1G, I_N2G, I_WIN, I_LBL, I_HNG, I_ARE, I_AIM, I_LDT, I_BRE, I_BIM, I_CRE, I_CIM, I_S5D, I_GLUW, I_GLUB, I_WOUT, I_WQ, I_SUBK, I_PU, I_PV, I_FG };

typedef const KP __attribute__((address_space(4)))* kp_cptr;
__device__ __forceinline__ KP load_kp() {
#if defined(__HIP_DEVICE_COMPILE__)
    unsigned long long a = (unsigned long long)__builtin_amdgcn_kernarg_segment_ptr(); asm volatile("" : "+s"(a)); return *(kp_cptr)a;
#else
    return KP{};
#endif
}

__device__ __forceinline__ void phase_setup(const KP& p, LAS unsigned char* lds, int G) {
    const int tid = opaque_tid();
    {
        LAS float* cact = (LAS float*)lds;
        for (int it = blockIdx.x; it < 4 * 48; it += G) {
            for (int i = tid; i < 32 * 1024; i += 512) cact[i] = fsilu(p.in[I_C][i]);
            __syncthreads();
            const int l = it / 48, cb = it % 48, col = cb * 128 + (tid & 127), bg = tid >> 7;
            const float* W = p.in[I_ADAW] + (size_t)l * D * NMODC + col;
            float acc[8];
#pragma unroll
            for (int j = 0; j < 8; ++j) acc[j] = 0.f;
            for (int k4 = 0; k4 < 256; ++k4) {
                const float w0 = W[(size_t)(4 * k4 + 0) * NMODC], w1 = W[(size_t)(4 * k4 + 1) * NMODC], w2 = W[(size_t)(4 * k4 + 2) * NMODC], w3 = W[(size_t)(4 * k4 + 3) * NMODC];
#pragma unroll
                for (int j = 0; j < 8; ++j) { const f32x4 c4 = *(const LAS f32x4*)(cact + (8 * bg + j) * 1024 + 4 * k4); acc[j] += c4[0] * w0 + c4[1] * w1 + c4[2] * w2 + c4[3] * w3; }
            }
            float* MOD = (float*)(p.ws + WS_MOD);
            const float bias = p.in[I_ADAB][l * NMODC + col];
#pragma unroll
            for (int j = 0; j < 8; ++j) MOD[((size_t)l * 32 + 8 * bg + j) * NMODC + col] = acc[j] + bias;
            __syncthreads();
        }
    }
    const int gtid = blockIdx.x * 512 + tid;
    if (gtid < 1024) {
        const float* lg = p.in[I_LBL]; float v[4], mx = -1e30f;
#pragma unroll
        for (int l = 0; l < 4; ++l) { v[l] = lg[l * 1024 + gtid]; mx = fmaxf(mx, v[l]); }
        float s = 0.f;
#pragma unroll
        for (int l = 0; l < 4; ++l) { v[l] = __expf(v[l] - mx); s += v[l]; }
        float* LB = (float*)(p.ws + WS_LB); float cum = 0.f; const float first = v[0] / s;
#pragma unroll
        for (int l = 0; l < 4; ++l) { cum += v[l] / s; LB[l * 1024 + gtid] = (l == 0) ? 0.f : (cum - first); }
    }
    if (gtid >= 1024 && gtid < 1024 + 16384) {
        const int id = gtid - 1024, lg = id >> 6, pp = id & 63;
        const float a_re = p.in[I_ARE][id], a_im = p.in[I_AIM][id];
        const float step = expf(p.in[I_LDT][lg]);
        const float mag = expf(step * a_re), ang = step * a_im;
        const float ab_re = mag * cosf(ang), ab_im = mag * sinf(ang);
        const float den = a_re * a_re + a_im * a_im;
        const float z_re = ((ab_re - 1.0f) * a_re + ab_im * a_im) / den;
        const float z_im = (ab_im * a_re - (ab_re - 1.0f) * a_im) / den;
        float* ABAR = (float*)(p.ws + WS_ABAR); ABAR[2 * id] = ab_re; ABAR[2 * id + 1] = ab_im;
        bf16_t* BOP = (bf16_t*)(p.ws + WS_BOP); bf16_t* COP = (bf16_t*)(p.ws + WS_COP);
        const float* bre = p.in[I_BRE] + (size_t)id * 16; const float* bim = p.in[I_BIM] + (size_t)id * 16;
#pragma unroll
        for (int c = 0; c < 16; ++c) {
            const float br = bre[c], bi = bim[c];
            const float rr = z_re * br - z_im * bi, ii = z_re * bi + z_im * br;
            BOP[((size_t)lg * 128 + 2 * pp) * 16 + c] = (bf16_t)(pk2(rr, 0.f) & 0xffffu);
            BOP[((size_t)lg * 128 + 2 * pp + 1) * 16 + c] = (bf16_t)(pk2(ii, 0.f) & 0xffffu);
            const float cr = p.in[I_CRE][((size_t)lg * 16 + c) * 64 + pp], ci = p.in[I_CIM][((size_t)lg * 16 + c) * 64 + pp];
            COP[((size_t)lg * 16 + c) * 128 + 2 * pp] = (bf16_t)(pk2(cr, 0.f) & 0xffffu);
            COP[((size_t)lg * 16 + c) * 128 + 2 * pp + 1] = (bf16_t)(pk2(-ci, 0.f) & 0xffffu);
        }
    }
}

__device__ __forceinline__ void transpose_item(const float* W, int K, int N, bf16_t* WT, LAS float* scr, int item, int lane) {
    const int nblk = N / 32, kb = item / nblk, nb = item % nblk, k0 = 64 * kb, n0 = 32 * nb;
#pragma unroll 8
    for (int i = 0; i < 32; ++i) { const int kk = 2 * i + (lane >> 5); scr[kk * 33 + (lane & 31)] = W[(size_t)(k0 + kk) * N + n0 + (lane & 31)]; }
    LDS_WAIT();
    const int c = lane & 7;
#pragma unroll
    for (int j = 0; j < 4; ++j) { const int n = (lane >> 3) + 8 * j; const LAS float* s = scr + (8 * c) * 33 + n;
        u32x4 o; o.x = pk2(s[0 * 33], s[1 * 33]); o.y = pk2(s[2 * 33], s[3 * 33]); o.z = pk2(s[4 * 33], s[5 * 33]); o.w = pk2(s[6 * 33], s[7 * 33]);
        *(u32x4*)(WT + (size_t)(n0 + n) * K + k0 + 8 * c) = o; }
    LDS_WAIT();
}
__device__ __forceinline__ void cvt_f32_fp8(const float* src, unsigned char* dst, size_t n4, size_t gtid, size_t nthr, float scale) {
    for (size_t i = gtid; i < n4; i += nthr) { const f32x4 v = ((const f32x4*)src)[i] * scale; int w = 0;
        w = __builtin_amdgcn_cvt_pk_fp8_f32(v[0], v[1], w, false); w = __builtin_amdgcn_cvt_pk_fp8_f32(v[2], v[3], w, true); ((unsigned*)dst)[i] = (unsigned)w; }
}
__device__ __forceinline__ void cvt_f32_fp8_sliced(const float* src, unsigned char* dst, size_t gtid, size_t nthr, float scale) {
    for (size_t i = gtid; i < (size_t)16384 * 64; i += nthr) {
        const size_t e = i >> 6; const int sl = (int)(i & 63) >> 3, c = (int)(i & 7);
        const f32x4* sp = (const f32x4*)(src + e * 1024 + sl * 128 + c * 16); u32x4 o;
#pragma unroll
        for (int q = 0; q < 4; ++q) { const f32x4 v = sp[q] * scale; int w = 0; w = __builtin_amdgcn_cvt_pk_fp8_f32(v[0], v[1], w, false); w = __builtin_amdgcn_cvt_pk_fp8_f32(v[2], v[3], w, true); o[q] = (unsigned)w; }
        *(u32x4*)(dst + ((size_t)sl * 16384 + e) * 128 + c * 16) = o;
    }
}
__device__ __forceinline__ void transpose_item_fp8(const float* W, int K, int N, unsigned char* WT, LAS float* scr, int item, int lane, float scale) {
    const int nblk = N / 32, kb = item / nblk, nb = item % nblk, k0 = 64 * kb, n0 = 32 * nb;
#pragma unroll 8
    for (int i = 0; i < 32; ++i) { const int kk = 2 * i + (lane >> 5); scr[kk * 33 + (lane & 31)] = W[(size_t)(k0 + kk) * N + n0 + (lane & 31)]; }
    LDS_WAIT();
    const int c = lane & 7;
#pragma unroll
    for (int j = 0; j < 4; ++j) { const int n = (lane >> 3) + 8 * j; const LAS float* sp = scr + (8 * c) * 33 + n;
        int w0 = 0, w1 = 0;
        w0 = __builtin_amdgcn_cvt_pk_fp8_f32(sp[0 * 33] * scale, sp[1 * 33] * scale, w0, false); w0 = __builtin_amdgcn_cvt_pk_fp8_f32(sp[2 * 33] * scale, sp[3 * 33] * scale, w0, true);
        w1 = __builtin_amdgcn_cvt_pk_fp8_f32(sp[4 * 33] * scale, sp[5 * 33] * scale, w1, false); w1 = __builtin_amdgcn_cvt_pk_fp8_f32(sp[6 * 33] * scale, sp[7 * 33] * scale, w1, true);
        *(u32x2*)(WT + (size_t)(n0 + n) * K + k0 + 8 * c) = (u32x2){(unsigned)w0, (unsigned)w1}; }
    LDS_WAIT();
}
__device__ __forceinline__ void cvt_f32_bf16(const float* src, bf16_t* dst, size_t n4, size_t gtid, size_t nthr) {
    for (size_t i = gtid; i < n4; i += nthr) { const f32x4 v = ((const f32x4*)src)[i]; u32x2 o; o.x = pk2(v[0], v[1]); o.y = pk2(v[2], v[3]); ((u32x2*)dst)[i] = o; }
}
template <bool F8OUT, bool XBF>
__device__ __forceinline__ void norm_rows(const float* xsrc, bf16_t* hdst, const float* gain, const float* mod_l, int sh_off, int sc_off, int gw, int ngw, int lane) {
    for (int r0 = gw * 4; r0 < M; r0 += ngw * 4) {
        const int b = r0 >> 11;
        f32x4 v[4][4]; float ss[4];
#pragma unroll
        for (int i = 0; i < 4; ++i) {
            if constexpr (XBF) { const u32x2* xr = (const u32x2*)((const bf16_t*)xsrc + (size_t)(r0 + i) * D) + lane;
#pragma unroll
                for (int j = 0; j < 4; ++j) { const u32x2 xw = xr[64 * j]; v[i][j] = (f32x4){bflo(xw[0]), bfhi(xw[0]), bflo(xw[1]), bfhi(xw[1])}; } }
            else { const f32x4* xr = (const f32x4*)(xsrc + (size_t)(r0 + i) * D) + lane;
#pragma unroll
                for (int j = 0; j < 4; ++j) v[i][j] = xr[64 * j]; } }
#pragma unroll
        for (int i = 0; i < 4; ++i) { float t = 0.f;
#pragma unroll
            for (int j = 0; j < 4; ++j) t += (v[i][j][0] * v[i][j][0] + v[i][j][1] * v[i][j][1]) + (v[i][j][2] * v[i][j][2] + v[i][j][3] * v[i][j][3]);
            ss[i] = t; }
#pragma unroll
        for (int o = 1; o < 64; o <<= 1) {
#pragma unroll
            for (int i = 0; i < 4; ++i) ss[i] += __shfl_xor(ss[i], o); }
        const float* mb = mod_l + (size_t)b * NMODC;
#pragma unroll
        for (int j = 0; j < 4; ++j) { const int col = 256 * j + 4 * lane;
            const f32x4 g4 = *(const f32x4*)(gain + col), sc = *(const f32x4*)(mb + sc_off + col), sh = *(const f32x4*)(mb + sh_off + col);
            const f32x4 gs = g4 * (sc + 1.0f);
#pragma unroll
            for (int i = 0; i < 4; ++i) { const float rstd = __builtin_amdgcn_rsqf(ss[i] * (1.0f / D) + EPS);
                const f32x4 h = v[i][j] * rstd * gs + sh;
                if constexpr (F8OUT) { int w8 = 0; w8 = __builtin_amdgcn_cvt_pk_fp8_f32(h[0] * HIN_SCALE, h[1] * HIN_SCALE, w8, false); w8 = __builtin_amdgcn_cvt_pk_fp8_f32(h[2] * HIN_SCALE, h[3] * HIN_SCALE, w8, true);
                    *(unsigned*)((unsigned char*)hdst + (size_t)(r0 + i) * D + col) = (unsigned)w8; }
                else { u32x2 o; o.x = pk2(h[0], h[1]); o.y = pk2(h[2], h[3]); *(u32x2*)(hdst + (size_t)(r0 + i) * D + col) = o; } } }
    }
}
template <bool XBF>
__device__ __forceinline__ void resid_norm_rows(const float* xsrc, bf16_t* xdst, const bf16_t* delta, bf16_t* hdst, const float* gain, const float* mod_l, int gw, int ngw, int lane) {
    for (int r0 = gw * 4; r0 < M; r0 += ngw * 4) {
        const int b = r0 >> 11; const float* mb = mod_l + (size_t)b * NMODC;
        f32x4 v[4][4]; u32x2 dl[4][4]; float ss[4];
#pragma unroll
        for (int i = 0; i < 4; ++i) { const u32x2* dp = (const u32x2*)(delta + (size_t)(r0 + i) * D) + lane;
            if constexpr (XBF) { const u32x2* xr = (const u32x2*)((const bf16_t*)xsrc + (size_t)(r0 + i) * D) + lane;
#pragma unroll
                for (int j = 0; j < 4; ++j) { const u32x2 xw = xr[64 * j]; v[i][j] = (f32x4){bflo(xw[0]), bfhi(xw[0]), bflo(xw[1]), bfhi(xw[1])}; dl[i][j] = dp[64 * j]; } }
            else { const f32x4* xr = (const f32x4*)(xsrc + (size_t)(r0 + i) * D) + lane;
#pragma unroll
                for (int j = 0; j < 4; ++j) { v[i][j] = xr[64 * j]; dl[i][j] = dp[64 * j]; } } }
#pragma unroll
        for (int j = 0; j < 4; ++j) { const f32x4 g1 = *(const f32x4*)(mb + 2048 + 256 * j + 4 * lane);
#pragma unroll
            for (int i = 0; i < 4; ++i) { const f32x4 dv = {bflo(dl[i][j][0]), bfhi(dl[i][j][0]), bflo(dl[i][j][1]), bfhi(dl[i][j][1])}; v[i][j] = v[i][j] + g1 * dv;
                ((u32x2*)(xdst + (size_t)(r0 + i) * D) + lane)[64 * j] = (u32x2){pk2(v[i][j][0], v[i][j][1]), pk2(v[i][j][2], v[i][j][3])}; } }
#pragma unroll
        for (int i = 0; i < 4; ++i) { float t = 0.f;
#pragma unroll
            for (int j = 0; j < 4; ++j) t += (v[i][j][0] * v[i][j][0] + v[i][j][1] * v[i][j][1]) + (v[i][j][2] * v[i][j][2] + v[i][j][3] * v[i][j][3]);
            ss[i] = t; }
#pragma unroll
        for (int o = 1; o < 64; o <<= 1) {
#pragma unroll
            for (int i = 0; i < 4; ++i) ss[i] += __shfl_xor(ss[i], o); }
#pragma unroll
        for (int j = 0; j < 4; ++j) { const int col = 256 * j + 4 * lane;
            const f32x4 g4 = *(const f32x4*)(gain + col), sc = *(const f32x4*)(mb + 4096 + col), sh = *(const f32x4*)(mb + 3072 + col);
            const f32x4 gs = g4 * (sc + 1.0f);
#pragma unroll
            for (int i = 0; i < 4; ++i) { const float rstd = __builtin_amdgcn_rsqf(ss[i] * (1.0f / D) + EPS);
                const f32x4 h = v[i][j] * rstd * gs + sh; u32x2 o; o.x = pk2(h[0], h[1]); o.y = pk2(h[2], h[3]); *(u32x2*)(hdst + (size_t)(r0 + i) * D + col) = o; } }
    }
}
__device__ __forceinline__ void phase_conv_norm1(const KP& p, LAS unsigned char* lds, int l, int G) {
    const int tid = opaque_tid(), lane = tid & 63, wave = __builtin_amdgcn_readfirstlane(tid >> 6);
    const int gw = blockIdx.x * 8 + wave, ngw = G * 8;
    LAS float* scr = (LAS float*)(lds + wave * 8448);
    constexpr int I_IN = 16 * (INC / 32), I_G = 16 * 32, I_O = 16 * 32, I_Q = 16 * 64, NIT = I_IN + I_G + I_O + I_Q;
    for (int it = gw; it < NIT; it += ngw) {
        int r = it;
        if (r < I_IN) { transpose_item_fp8(p.in[I_WIN] + (size_t)l * D * INC, D, INC, p.ws + WS_WIN, scr, r, lane, WIN_SCALE); continue; } r -= I_IN;
        if (r < I_G) { transpose_item(p.in[I_GLUW] + (size_t)l * D * D, D, D, (bf16_t*)(p.ws + WS_WGLU), scr, r, lane); continue; } r -= I_G;
        if (r < I_O) { transpose_item_fp8(p.in[I_WOUT] + (size_t)l * D * D, D, D, p.ws + WS_WOUT, scr, r, lane, WO_SCALE); continue; } r -= I_O;
        transpose_item(p.in[I_WQ] + (size_t)l * D * 2048, D, 2048, (bf16_t*)(p.ws + WS_WQ), scr, r, lane);
    }
    const size_t gtid = (size_t)blockIdx.x * 512 + tid, nthr = (size_t)G * 512;
    cvt_f32_bf16(p.in[I_SUBK] + (size_t)l * 262144, (bf16_t*)(p.ws + WS_KEYS), 262144 / 4, gtid, nthr);
    if (l == 0) {
        cvt_f32_fp8_sliced(p.in[I_PU], p.ws + WS_U, gtid, nthr, U_SCALE);
        cvt_f32_fp8_sliced(p.in[I_PV], p.ws + WS_V, gtid, nthr, V_SCALE); }
    if (l == 0) norm_rows<true, false>(p.in[I_X], (bf16_t*)(p.ws + WS_H), p.in[I_N1G] + l * D, (const float*)(p.ws + WS_MOD) + (size_t)l * 32 * NMODC, 0, 1024, gw, ngw, lane);
    else norm_rows<true, true>(p.out, (bf16_t*)(p.ws + WS_H), p.in[I_N1G] + l * D, (const float*)(p.ws + WS_MOD) + (size_t)l * 32 * NMODC, 0, 1024, gw, ngw, lane);
}

__device__ __forceinline__ void phase_hgrn2(const KP& p, LAS unsigned char* lds, int l, int G) {
    const int tid = opaque_tid(), lane = tid & 63, w = __builtin_amdgcn_readfirstlane(tid >> 6), fr = lane & 15, g = lane >> 4;
    constexpr int QS = 272, TS = 72;
    constexpr int OFF_QT = 0, OFF_KH = 8704, OFF_KT = 17408, OFF_VT = 26624, OFF_EREF = 35840, OFF_ELR = 36352, OFF_SEG = 36864, PBUF = 40960;
    const bf16_t* PA = (const bf16_t*)(p.ws + WS_R0);
    bf16_t* ORAW = (bf16_t*)(p.ws + WS_OR);
    const float* LB = (const float*)(p.ws + WS_LB) + l * 1024;
    for (int unit = blockIdx.x; unit < 256; unit += G) {
        const int b = unit >> 3, h = unit & 7, k0 = 2 * lane;
        const float lb0 = LB[h * 128 + k0], lb1 = LB[h * 128 + k0 + 1];
        const float om0 = 1.0f - lb0, om1 = 1.0f - lb1;
        f32x4 S[8];
#pragma unroll
        for (int kt = 0; kt < 8; ++kt) S[kt] = (f32x4){0.f, 0.f, 0.f, 0.f};
        unsigned rq[4], rf[4], rv[4];
        {
            const bf16_t* base = PA + ((size_t)b * SEQ + 4 * w) * 3072 + h * 128 + k0;
#pragma unroll
            for (int i = 0; i < 4; ++i) { rq[i] = *(const unsigned*)(base + (size_t)i * 3072); rf[i] = *(const unsigned*)(base + (size_t)i * 3072 + 1024); rv[i] = *(const unsigned*)(base + (size_t)i * 3072 + 2048); }
        }
        for (int c = 0; c < 64; ++c) {
            LAS unsigned char* base = lds + (c & 1) * PBUF;
            float cs0[4], cs1[4], qv0[4], qv1[4], kv0[4], kv1[4];
            float run0 = 0.f, run1 = 0.f;
#pragma unroll
            for (int i = 0; i < 4; ++i) {
                const float fp0 = bflo(rf[i]), fp1 = bfhi(rf[i]);
                const float s0 = fsigmoid(fp0), s1 = fsigmoid(fp1);
                run0 += __logf(lb0 + om0 * s0); run1 += __logf(lb1 + om1 * s1);
                cs0[i] = run0; cs1[i] = run1;
                kv0[i] = om0 * (1.0f - s0); kv1[i] = om1 * (1.0f - s1);
                qv0[i] = fsilu(bflo(rq[i])); qv1[i] = fsilu(bfhi(rq[i]));
            }
            *(LAS f32x2*)(base + OFF_SEG + (w * 128 + k0) * 4) = (f32x2){run0, run1};
            __syncthreads();
            float off0 = 0.f, off1 = 0.f, ref0 = 0.f, ref1 = 0.f, all0 = 0.f, all1 = 0.f;
#pragma unroll
            for (int s = 0; s < 8; ++s) { const f32x2 t2 = *(const LAS f32x2*)(base + OFF_SEG + (s * 128 + k0) * 4);
                if (s < w) { off0 += t2[0]; off1 += t2[1]; }
                if (s < 4) { ref0 += t2[0]; ref1 += t2[1]; }
                all0 += t2[0]; all1 += t2[1]; }
            float kh0[4], kh1[4];
#pragma unroll
            for (int i = 0; i < 4; ++i) {
                const float b0 = off0 + cs0[i], b1 = off1 + cs1[i];
                const float q0 = qv0[i] * __expf(b0 - ref0), q1 = qv1[i] * __expf(b1 - ref1);
                kh0[i] = kv0[i] * __expf(ref0 - b0); kh1[i] = kv1[i] * __expf(ref1 - b1);
                const int t = 4 * w + i;
                *(LAS unsigned*)(base + OFF_QT + t * QS + k0 * 2) = pk2(q0, q1);
                *(LAS unsigned*)(base + OFF_KH + t * QS + k0 * 2) = pk2(kh0[i], kh1[i]);
            }
            *(LAS u32x2*)(base + OFF_KT + k0 * TS + 8 * w) = (u32x2){pk2(kh0[0], kh0[1]), pk2(kh0[2], kh0[3])};
            *(LAS u32x2*)(base + OFF_KT + (k0 + 1) * TS + 8 * w) = (u32x2){pk2(kh1[0], kh1[1]), pk2(kh1[2], kh1[3])};
            *(LAS u32x2*)(base + OFF_VT + k0 * TS + 8 * w) = (u32x2){(rv[0] & 0xffffu) | (rv[1] << 16), (rv[2] & 0xffffu) | (rv[3] << 16)};
            *(LAS u32x2*)(base + OFF_VT + (k0 + 1) * TS + 8 * w) = (u32x2){(rv[0] >> 16) | (rv[1] & 0xffff0000u), (rv[2] >> 16) | (rv[3] & 0xffff0000u)};
            if (w == 0) {
                *(LAS f32x2*)(base + OFF_EREF + k0 * 4) = (f32x2){__expf(ref0), __expf(ref1)};
                *(LAS f32x2*)(base + OFF_ELR + k0 * 4) = (f32x2){__expf(all0 - ref0), __expf(all1 - ref1)};
            }
            __syncthreads();
            if (c + 1 < 64) {
                const bf16_t* nb = PA + ((size_t)b * SEQ + (c + 1) * 32 + 4 * w) * 3072 + h * 128 + k0;
#pragma unroll
                for (int i = 0; i < 4; ++i) { rq[i] = *(const unsigned*)(nb + (size_t)i * 3072); rf[i] = *(const unsigned*)(nb + (size_t)i * 3072 + 1024); rv[i] = *(const unsigned*)(nb + (size_t)i * 3072 + 2048); }
            }
            bf16x8 qf[2][4], kf[2][4];
#pragma unroll
            for (int tt = 0; tt < 2; ++tt)
#pragma unroll
                for (int m = 0; m < 4; ++m) {
                    const LAS unsigned char* pq = base + OFF_QT + (16 * tt + fr) * QS + (32 * m + 4 * g) * 2;
                    const u32x2 lo = *(const LAS u32x2*)pq, hi = *(const LAS u32x2*)(pq + 32);
                    qf[tt][m] = __builtin_bit_cast(bf16x8, (u32x4){lo[0], lo[1], hi[0], hi[1]});
                    const LAS unsigned char* pk = base + OFF_KH + (16 * tt + fr) * QS + (32 * m + 4 * g) * 2;
                    const u32x2 lo2 = *(const LAS u32x2*)pk, hi2 = *(const LAS u32x2*)(pk + 32);
                    kf[tt][m] = __builtin_bit_cast(bf16x8, (u32x4){lo2[0], lo2[1], hi2[0], hi2[1]});
                }
            f32x4 PT00 = {0.f, 0.f, 0.f, 0.f}, PT01 = {0.f, 0.f, 0.f, 0.f}, PT11 = {0.f, 0.f, 0.f, 0.f};
#pragma unroll
            for (int m = 0; m < 4; ++m) {
                PT00 = __builtin_amdgcn_mfma_f32_16x16x32_bf16(kf[0][m], qf[0][m], PT00, 0, 0, 0);
                PT01 = __builtin_amdgcn_mfma_f32_16x16x32_bf16(kf[0][m], qf[1][m], PT01, 0, 0, 0);
                PT11 = __builtin_amdgcn_mfma_f32_16x16x32_bf16(kf[1][m], qf[1][m], PT11, 0, 0, 0);
            }
#pragma unroll
            for (int r = 0; r < 4; ++r) { if (4 * g + r > fr) { PT00[r] = 0.f; PT11[r] = 0.f; } }
            const bf16x8 pa0 = __builtin_bit_cast(bf16x8, (u32x4){pk2(PT00[0], PT00[1]), pk2(PT00[2], PT00[3]), 0u, 0u});
            const bf16x8 pa1 = __builtin_bit_cast(bf16x8, (u32x4){pk2(PT01[0], PT01[1]), pk2(PT01[2], PT01[3]), pk2(PT11[0], PT11[1]), pk2(PT11[2], PT11[3])});
            const LAS unsigned char* vrow = base + OFF_VT + (16 * w + fr) * TS;
            const u32x2 vpa = *(const LAS u32x2*)(vrow + 8 * g), vpb = *(const LAS u32x2*)(vrow + 32 + 8 * g);
            const u32x2 vna = *(const LAS u32x2*)(vrow + 16 * g), vnb = *(const LAS u32x2*)(vrow + 16 * g + 8);
            const bf16x8 vperm = __builtin_bit_cast(bf16x8, (u32x4){vpa[0], vpa[1], vpb[0], vpb[1]});
            const bf16x8 vnat = __builtin_bit_cast(bf16x8, (u32x4){vna[0], vna[1], vnb[0], vnb[1]});
#pragma unroll
            for (int kt = 0; kt < 8; ++kt) { const f32x4 e = *(const LAS f32x4*)(base + OFF_EREF + (16 * kt + 4 * g) * 4); S[kt] = S[kt] * e; }
            f32x4 O0 = {0.f, 0.f, 0.f, 0.f}, O1 = {0.f, 0.f, 0.f, 0.f};
#pragma unroll
            for (int m = 0; m < 4; ++m) {
                const bf16x8 sf = __builtin_bit_cast(bf16x8, (u32x4){pk2(S[2 * m][0], S[2 * m][1]), pk2(S[2 * m][2], S[2 * m][3]), pk2(S[2 * m + 1][0], S[2 * m + 1][1]), pk2(S[2 * m + 1][2], S[2 * m + 1][3])});
                O0 = __builtin_amdgcn_mfma_f32_16x16x32_bf16(qf[0][m], sf, O0, 0, 0, 0);
                O1 = __builtin_amdgcn_mfma_f32_16x16x32_bf16(qf[1][m], sf, O1, 0, 0, 0);
            }
            O0 = __builtin_amdgcn_mfma_f32_16x16x32_bf16(pa0, vperm, O0, 0, 0, 0);
            O1 = __builtin_amdgcn_mfma_f32_16x16x32_bf16(pa1, vperm, O1, 0, 0, 0);
#pragma unroll
            for (int kt = 0; kt < 8; ++kt) {
                const LAS unsigned char* krow = base + OFF_KT + (16 * kt + fr) * TS + 16 * g;
                const u32x2 ka = *(const LAS u32x2*)krow, kb = *(const LAS u32x2*)(krow + 8);
                const bf16x8 ktf = __builtin_bit_cast(bf16x8, (u32x4){ka[0], ka[1], kb[0], kb[1]});
                S[kt] = __builtin_amdgcn_mfma_f32_16x16x32_bf16(ktf, vnat, S[kt], 0, 0, 0);
            }
#pragma unroll
            for (int kt = 0; kt < 8; ++kt) { const f32x4 e = *(const LAS f32x4*)(base + OFF_ELR + (16 * kt + 4 * g) * 4); S[kt] = S[kt] * e; }
            bf16_t* orow = ORAW + ((size_t)b * SEQ + c * 32 + 4 * g) * D + h * 128 + 16 * w + fr;
#pragma unroll
            for (int r = 0; r < 4; ++r) { orow[(size_t)r * D] = (bf16_t)(pk2(O0[r], 0.f) & 0xffffu); orow[(size_t)(16 + r) * D] = (bf16_t)(pk2(O1[r], 0.f) & 0xffffu); }
        }
        __syncthreads();
    }
}

__device__ __forceinline__ void phase_s5(const KP& p, LAS unsigned char* lds, int l, int G, size_t ys_off) {
    const int tid = opaque_tid(), lane = tid & 63, w = __builtin_amdgcn_readfirstlane(tid >> 6), fr = lane & 15, g = lane >> 4;
    const int gw = blockIdx.x * 8 + w, ngw = G * 8;
    constexpr int BUS = 132;
    LAS float* BU = (LAS float*)(lds + w * 16896);
    LAS unsigned char* XI = (LAS unsigned char*)BU;
    const bf16_t* PB = (const bf16_t*)(p.ws + WS_R0);
    const bf16x8 zero8 = {0, 0, 0, 0, 0, 0, 0, 0};
    const bf16_t* ORAWs = (const bf16_t*)(p.ws + WS_OR); float* SSQs = (float*)(p.ws + WS_SSQ);
    for (int unit = gw; unit < BATCH * 64; unit += ngw) {
        const int b = unit >> 6, grp = unit & 63, lg = l * 64 + grp;
        const bf16_t* BOP = (const bf16_t*)(p.ws + WS_BOP) + (size_t)lg * 128 * 16;
        const bf16_t* COP = (const bf16_t*)(p.ws + WS_COP) + (size_t)lg * 16 * 128;
        bf16x8 bfrag[8], cfrag[4], dfrag;
#pragma unroll
        for (int nt = 0; nt < 8; ++nt) bfrag[nt] = (g < 2) ? *(const bf16x8*)(BOP + (size_t)(16 * nt + fr) * 16 + 8 * g) : zero8;
#pragma unroll
        for (int ks = 0; ks < 4; ++ks) cfrag[ks] = DBG_S5_NOSSM ? zero8 : *(const bf16x8*)(COP + (size_t)fr * 128 + 32 * ks + 8 * g);
        {
            const unsigned dbits = pk2(p.in[I_S5D][l * 1024 + grp * 16 + fr], 0.f) & 0xffffu;
#pragma unroll
            for (int j = 0; j < 8; ++j) dfrag[j] = (g < 2 && (8 * g + j) == fr) ? (short)dbits : (short)0;
        }
        const float ar = ((const float*)(p.ws + WS_ABAR))[2 * ((size_t)lg * 64 + lane)], ai = ((const float*)(p.ws + WS_ABAR))[2 * ((size_t)lg * 64 + lane) + 1];
        const float nai = -ai; float xr = 0.f, xi = 0.f; unsigned hBU = 0u, hXI = 0u, hY = 0u;
        const bf16_t* ub = PB + ((size_t)b * SEQ) * 4096 + 1024 + grp * 16;
        bf16_t* yb_ = (bf16_t*)(p.ws + ys_off) + ((size_t)b * SEQ) * D + grp * 16;
        bf16x8 unext[2];
#pragma unroll
        for (int tt = 0; tt < 2; ++tt) unext[tt] = (g < 2) ? *(const bf16x8*)(ub + (size_t)(16 * tt + fr) * 4096 + 8 * g) : zero8;
        const bool cvt_next = (l + 1 < DEPTH);
        const float* tsrc = ((lane < 32) ? p.in[I_PU] : p.in[I_PV]) + (size_t)(l + 1 < DEPTH ? l + 1 : l) * 16384 * 1024 + 4 * (lane & 31);
        unsigned char* tdst = p.ws + ((lane < 32) ? WS_U : WS_V) + (size_t)((l + 1) & 1) * TAB_BYTES + 4 * (lane & 31);
        const float tscale = (lane < 32) ? U_SCALE : V_SCALE;
        for (int t0 = 0; t0 < SEQ; t0 += 32) {
            const int item = unit * 64 + (t0 >> 5), te = item >> 3, tsl = item & 7;
            f32x4 tv = {0.f, 0.f, 0.f, 0.f}; if (cvt_next) tv = *(const f32x4*)(tsrc + (size_t)te * 1024 + tsl * 128);
            const bool ssq_it = ((t0 >> 5) & 1) == 0; const int srow = item >> 1;
            u32x4 sa = {0u, 0u, 0u, 0u}, sc2 = {0u, 0u, 0u, 0u};
            if (ssq_it) { sa = *(const u32x4*)(ORAWs + (size_t)srow * D + 8 * lane); sc2 = *(const u32x4*)(ORAWs + (size_t)srow * D + 512 + 8 * lane); }
            bf16x8 ufrag[2];
#pragma unroll
            for (int tt = 0; tt < 2; ++tt) { ufrag[tt] = unext[tt]; if (t0 + 32 < SEQ) unext[tt] = (g < 2) ? *(const bf16x8*)(ub + (size_t)(t0 + 32 + 16 * tt + fr) * 4096 + 8 * g) : zero8; }
#pragma unroll
            for (int tt = 0; tt < 2; ++tt)
#pragma unroll
                for (int nt = 0; nt < 8; ++nt) {
                    const f32x4 a = __builtin_amdgcn_mfma_f32_16x16x32_bf16(ufrag[tt], bfrag[nt], (f32x4){0.f, 0.f, 0.f, 0.f}, 0, 0, 0);
#pragma unroll
                    for (int r = 0; r < 4; ++r) BU[(16 * tt + 4 * g + r) * BUS + 16 * nt + fr] = a[r];
                }
            LDS_WAIT();
#pragma unroll
            for (int t = 0; t < 32; ++t) {
                const f32x2 bb = *(const LAS f32x2*)(BU + t * BUS + 2 * lane); hBU += __float_as_uint(bb[0]) * 3u + __float_as_uint(bb[1]);
                float t1, t2, nr, ni;
                asm("v_fma_f32 %0, %1, %2, %3" : "=v"(t1) : "v"(nai), "v"(xi), "v"(bb[0]));
                asm("v_fma_f32 %0, %1, %2, %3" : "=v"(t2) : "v"(ai), "v"(xr), "v"(bb[1]));
                asm("v_fma_f32 %0, %1, %2, %3" : "=v"(nr) : "v"(ar), "v"(xr), "v"(t1));
                asm("v_fma_f32 %0, %1, %2, %3" : "=v"(ni) : "v"(ar), "v"(xi), "v"(t2));
                xr = nr; xi = ni;
                { const unsigned pv = pk2(nr, ni); hXI += pv; *(LAS unsigned*)(XI + t * (BUS * 4) + lane * 4) = pv; }
            }
            LDS_WAIT();
#pragma unroll
            for (int tt = 0; tt < 2; ++tt) {
                f32x4 y = {0.f, 0.f, 0.f, 0.f};
#pragma unroll
                for (int ks = 0; ks < 4; ++ks) {
                    const bf16x8 xf = *(const LAS bf16x8*)(XI + (16 * tt + fr) * (BUS * 4) + (32 * ks + 8 * g) * 2);
                    y = __builtin_amdgcn_mfma_f32_16x16x32_bf16(xf, cfrag[ks], y, 0, 0, 0);
                }
                y = __builtin_amdgcn_mfma_f32_16x16x32_bf16(ufrag[tt], dfrag, y, 0, 0, 0);
#pragma unroll
                for (int r = 0; r < 4; ++r) { const unsigned yv = pk2(fgelu(y[r]), 0.f) & 0xffffu; hY += yv * (unsigned)(r + 1); yb_[(size_t)(t0 + 16 * tt + 4 * g + r) * D + fr] = (bf16_t)yv; }
            }
            LDS_WAIT();
            if (ssq_it) { float s0 = 0.f, s1 = 0.f;
#pragma unroll
                for (int j = 0; j < 4; ++j) { const float x0 = bflo(sa[j]), x1 = bfhi(sa[j]), y0 = bflo(sc2[j]), y1 = bfhi(sc2[j]); s0 += x0 * x0 + x1 * x1; s1 += y0 * y0 + y1 * y1; }
                { s0 = dpp_sum8(s0); s1 = dpp_sum8(s1);
                  s0 += __uint_as_float(__builtin_amdgcn_update_dpp(0, __float_as_uint(s0), 0x140, 0xF, 0xF, true)); s1 += __uint_as_float(__builtin_amdgcn_update_dpp(0, __float_as_uint(s1), 0x140, 0xF, 0xF, true)); }
                if (fr == 0) { SSQs[(size_t)srow * 8 + g] = s0; SSQs[(size_t)srow * 8 + 4 + g] = s1; } }
            if (cvt_next) { int w8 = 0; w8 = __builtin_amdgcn_cvt_pk_fp8_f32(tv[0] * tscale, tv[1] * tscale, w8, false); w8 = __builtin_amdgcn_cvt_pk_fp8_f32(tv[2] * tscale, tv[3] * tscale, w8, true);
                *(unsigned*)(tdst + ((size_t)tsl * 16384 + te) * 128) = (unsigned)w8; }
        }
        if (DBG_SELFCHECK) { for (int o = 1; o < 64; o <<= 1) { hBU += __shfl_xor((int)hBU, o); hXI += __shfl_xor((int)hXI, o); hY += __shfl_xor((int)hY, o); }
            unsigned* hs = (unsigned*)(p.ws + WS_CTL) + 65536 + (ys_off == WS_YS ? 0 : 8192) + unit * 4; unsigned hA = __float_as_uint(ar) * 7u + __float_as_uint(ai); for (int o = 1; o < 64; o <<= 1) hA += __shfl_xor((int)hA, o); if (lane == 0) { hs[0] = hBU; hs[1] = hXI; hs[2] = hA; } }
    }
}

__device__ __forceinline__ unsigned fkey(float f) { const unsigned u = __float_as_uint(f); return u ^ ((unsigned)((int)u >> 31) | 0x80000000u); }
__device__ __forceinline__ float kval(unsigned k) { const unsigned u = (k & 0x80000000u) ? (k ^ 0x80000000u) : ~k; return __uint_as_float(u); }
#define CE_DESC(a, b) do { const unsigned _mx = (a) > (b) ? (a) : (b), _mn = (a) > (b) ? (b) : (a); (a) = _mx; (b) = _mn; } while (0)
__device__ __forceinline__ void sort16_desc(unsigned (&a)[16]) {
#pragma unroll
    for (int kk = 1; kk <= 4; ++kk)
#pragma unroll
        for (int jj = kk - 1; jj >= 0; --jj)
#pragma unroll
            for (int i = 0; i < 16; ++i) { const int k = 1 << kk, j = 1 << jj, l2 = i ^ j;
                if (l2 > i) { if ((i & k) == 0) CE_DESC(a[i], a[l2]); else CE_DESC(a[l2], a[i]); } }
}
__device__ __forceinline__ void merge_top16(unsigned (&a)[16], const unsigned (&b)[16]) {
#pragma unroll
    for (int i = 0; i < 16; ++i) a[i] = a[i] > b[15 - i] ? a[i] : b[15 - i];
#pragma unroll
    for (int jj = 3; jj >= 0; --jj)
#pragma unroll
        for (int i = 0; i < 16; ++i) { const int j = 1 << jj, l2 = i ^ j; if (l2 > i) CE_DESC(a[i], a[l2]); }
}
__device__ __forceinline__ void phase_topk(const KP& p, LAS unsigned char* lds, int G) {
    const int tid = opaque_tid(), lane = tid & 63, w = __builtin_amdgcn_readfirstlane(tid >> 6), hh = lane >> 5;
    const int gw = blockIdx.x * 8 + w, ngw = G * 8;
    const bf16_t* Q = (const bf16_t*)(p.ws + WS_R0); const bf16_t* KEYS = (const bf16_t*)(p.ws + WS_KEYS);
    unsigned* SEL = (unsigned*)(p.ws + WS_SEL);
    LAS unsigned char* tab = lds + w * 2048 + lane * 32;
    const int CI[50] = {0,0,0,0,0,0,0,0,0,0,0,0,0,0,0,0, 1,1,1,1,1,1,1,1, 2,2,2,2,2, 3,3,3,3, 4,4,4, 5,5, 6,6, 7,7, 8,9,10,11,12,13,14,15};
    const int CJ[50] = {0,1,2,3,4,5,6,7,8,9,10,11,12,13,14,15, 0,1,2,3,4,5,6,7, 0,1,2,3,4, 0,1,2,3, 0,1,2, 0,1, 0,1, 0,1, 0,0,0,0,0,0,0,0};
    LAS unsigned char* kimg = lds + 16384;
    for (int h = 0; h < 8; ++h) {
      __syncthreads();
#pragma unroll
      for (int i = 0; i < 8; ++i) { const int ch = tid + 512 * i, row = ch >> 4, c16 = ch & 15;
          *(LAS u32x4*)(kimg + row * 272 + c16 * 16) = *(const u32x4*)(KEYS + (size_t)(h * 256 + row) * 128 + c16 * 8); }
      __syncthreads();
      for (int tg = gw; tg < 2048; tg += ngw) {
        const int t = tg * 32 + (lane & 31);
        unsigned top[2][16];
#pragma unroll
        for (int pp = 0; pp < 2; ++pp) {
            bf16x8 qf[8];
#pragma unroll
            for (int ks = 0; ks < 8; ++ks) qf[ks] = *(const bf16x8*)(Q + ((size_t)((((tg * 8 + h) * 2 + pp) * 8 + ks) * 64 + lane)) * 8);
            const LAS unsigned char* kb = kimg + (pp * 128 + (lane & 31)) * 272 + 16 * hh;
#pragma unroll
            for (int nt = 0; nt < 4; ++nt) {
                f32x16 acc;
#pragma unroll
                for (int i = 0; i < 16; ++i) acc[i] = 0.f;
#pragma unroll
                for (int ks = 0; ks < 8; ++ks) { const bf16x8 kf = *(const LAS bf16x8*)(kb + (32 * nt) * 272 + 32 * ks);
                    acc = __builtin_amdgcn_mfma_f32_32x32x16_bf16(kf, qf[ks], acc, 0, 0, 0); }
                unsigned ky[16];
#pragma unroll
                for (int r = 0; r < 16; ++r) ky[r] = (fkey(acc[r]) & ~127u) | (unsigned)(32 * nt + (r & 3) + 8 * (r >> 2)) | (unsigned)(4 * hh);
                sort16_desc(ky);
                if (nt == 0) {
#pragma unroll
                    for (int i = 0; i < 16; ++i) top[pp][i] = ky[i];
                } else merge_top16(top[pp], ky);
            }
            unsigned other[16];
#pragma unroll
            for (int i = 0; i < 16; ++i) other[i] = (unsigned)__shfl_xor((int)top[pp][i], 32);
            merge_top16(top[pp], other);
        }
        float sa[16], sb[16];
#pragma unroll
        for (int i = 0; i < 16; ++i) { sa[i] = kval(top[0][i] & ~127u); sb[i] = kval(top[1][i] & ~127u); }
        unsigned c0[16], c1[16];
#pragma unroll
        for (int s = 0; s < 32; ++s) {
            unsigned key = 0u;
            if (s < 25) {
                const float v0 = sa[CI[s]] + sb[CJ[s]], v1 = sa[CI[25 + s]] + sb[CJ[25 + s]];
                const unsigned k0 = (fkey(v0) & ~255u) | (unsigned)(CI[s] * 16 + CJ[s]), k1 = (fkey(v1) & ~255u) | (unsigned)(CI[25 + s] * 16 + CJ[25 + s]);
                key = hh ? k1 : k0;
            }
            if (s < 16) c0[s] = key; else c1[s - 16] = key;
        }
        sort16_desc(c0); sort16_desc(c1); merge_top16(c0, c1);
#pragma unroll
        for (int i = 0; i < 16; ++i) c1[i] = (unsigned)__shfl_xor((int)c0[i], 32);
        merge_top16(c0, c1);
        {
            u32x4 wa, wb;
#pragma unroll
            for (int q4 = 0; q4 < 4; ++q4) {
                wa[q4] = (top[0][4 * q4] & 127u) | ((top[0][4 * q4 + 1] & 127u) << 8) | ((top[0][4 * q4 + 2] & 127u) << 16) | ((top[0][4 * q4 + 3] & 127u) << 24);
                wb[q4] = (top[1][4 * q4] & 127u) | ((top[1][4 * q4 + 1] & 127u) << 8) | ((top[1][4 * q4 + 2] & 127u) << 16) | ((top[1][4 * q4 + 3] & 127u) << 24);
            }
            *(LAS u32x4*)tab = wa; *(LAS u32x4*)(tab + 16) = wb;
        }
        float ev[16], esum = 0.f; const float vmax = kval(c0[0] & ~255u);
#pragma unroll
        for (int k = 0; k < 16; ++k) { ev[k] = __expf(kval(c0[k] & ~255u) - vmax); esum += ev[k]; }
        const float rs = 1.0f / esum;
        LDS_WAIT();
        unsigned outw[8]; const unsigned hmask = hh ? 0xffffffffu : 0u;
#pragma unroll
        for (int kk = 0; kk < 8; ++kk) {
            const unsigned key = c0[kk] ^ ((c0[kk] ^ c0[8 + kk]) & hmask); const float e = __uint_as_float(__float_as_uint(ev[kk]) ^ ((__float_as_uint(ev[kk]) ^ __float_as_uint(ev[8 + kk])) & hmask));
            const unsigned code = key & 255u, ia = tab[code >> 4], ib = tab[16 + (code & 15u)];
            outw[kk] = (pk2(0.f, e * rs) & 0xffff0000u) | (ia * 128u + ib);
        }
        u32x4* dst = (u32x4*)(SEL + (size_t)t * 128 + h * 16 + hh * 8);
        dst[0] = (u32x4){outw[0], outw[1], outw[2], outw[3]}; dst[1] = (u32x4){outw[4], outw[5], outw[6], outw[7]};
        LDS_WAIT();
      }
    }
    __syncthreads();
}

__device__ __forceinline__ void fp8x4_to_f32(unsigned w, float& a, float& b, float& c, float& d) {
    const f32x2 lo = __builtin_amdgcn_cvt_pk_f32_fp8((int)w, false), hi = __builtin_amdgcn_cvt_pk_f32_fp8((int)w, true); a = lo[0]; b = lo[1]; c = hi[0]; d = hi[1];
}
struct XSlice { int sl, rank, nloc; };
__device__ __forceinline__ XSlice xslice_of_block(const KP& p, volatile LAS unsigned* MISC, int G) {
    unsigned* bar = (unsigned*)(p.ws + WS_CTL) + 4096; unsigned cnt[8]; unsigned tot = 0; bool ok = true;
#pragma unroll
    for (int j = 0; j < 8; ++j) { cnt[j] = xb_ld(&bar[XB_XCNT(j)]); tot += cnt[j]; ok = ok && (cnt[j] > 0u); }
    ok = ok && (tot == (unsigned)G);
    XSlice x;
    if (ok) { const unsigned myx = MISC[16]; x.sl = (int)myx; x.rank = (int)MISC[17]; x.nloc = (int)cnt[myx & 7u]; }
    else { x.sl = (int)(blockIdx.x & 7); x.rank = (int)(blockIdx.x >> 3); x.nloc = (G - x.sl + 7) >> 3; }
    x.sl = __builtin_amdgcn_readfirstlane(x.sl); x.rank = __builtin_amdgcn_readfirstlane(x.rank); x.nloc = __builtin_amdgcn_readfirstlane(x.nloc);
    return x;
}
__device__ __forceinline__ float dot16_fp8(const u32x4 u, const float (&hf)[16]) {
    float d = 0.f;
#pragma unroll
    for (int j = 0; j < 4; ++j) { float f0, f1, f2, f3; fp8x4_to_f32(u[j], f0, f1, f2, f3);
        d = __builtin_fmaf(f0, hf[4 * j], d); d = __builtin_fmaf(f1, hf[4 * j + 1], d); d = __builtin_fmaf(f2, hf[4 * j + 2], d); d = __builtin_fmaf(f3, hf[4 * j + 3], d); }
    return d;
}
typedef __bf16 bf16v8 __attribute__((ext_vector_type(8)));
__device__ __forceinline__ float dot16_fp8_bf16(const u32x4 u, const bf16v8 h0, const bf16v8 h1) {
    float d0 = 0.f, d1 = 0.f;
    d0 = __builtin_amdgcn_fdot2_f32_bf16(__builtin_amdgcn_cvt_scalef32_pk_bf16_fp8(u[0], 1.0f, false), __builtin_shufflevector(h0, h0, 0, 1), d0, false);
    d1 = __builtin_amdgcn_fdot2_f32_bf16(__builtin_amdgcn_cvt_scalef32_pk_bf16_fp8(u[0], 1.0f, true),  __builtin_shufflevector(h0, h0, 2, 3), d1, false);
    d0 = __builtin_amdgcn_fdot2_f32_bf16(__builtin_amdgcn_cvt_scalef32_pk_bf16_fp8(u[1], 1.0f, false), __builtin_shufflevector(h0, h0, 4, 5), d0, false);
    d1 = __builtin_amdgcn_fdot2_f32_bf16(__builtin_amdgcn_cvt_scalef32_pk_bf16_fp8(u[1], 1.0f, true),  __builtin_shufflevector(h0, h0, 6, 7), d1, false);
    d0 = __builtin_amdgcn_fdot2_f32_bf16(__builtin_amdgcn_cvt_scalef32_pk_bf16_fp8(u[2], 1.0f, false), __builtin_shufflevector(h1, h1, 0, 1), d0, false);
    d1 = __builtin_amdgcn_fdot2_f32_bf16(__builtin_amdgcn_cvt_scalef32_pk_bf16_fp8(u[2], 1.0f, true),  __builtin_shufflevector(h1, h1, 2, 3), d1, false);
    d0 = __builtin_amdgcn_fdot2_f32_bf16(__builtin_amdgcn_cvt_scalef32_pk_bf16_fp8(u[3], 1.0f, false), __builtin_shufflevector(h1, h1, 4, 5), d0, false);
    d1 = __builtin_amdgcn_fdot2_f32_bf16(__builtin_amdgcn_cvt_scalef32_pk_bf16_fp8(u[3], 1.0f, true),  __builtin_shufflevector(h1, h1, 6, 7), d1, false);
    return d0 + d1;
}
__device__ __forceinline__ float dpp_sum8(float d) {
    d += __uint_as_float(__builtin_amdgcn_update_dpp(0, __float_as_uint(d), 0xB1, 0xF, 0xF, true));
    d += __uint_as_float(__builtin_amdgcn_update_dpp(0, __float_as_uint(d), 0x4E, 0xF, 0xF, true));
    d += __uint_as_float(__builtin_amdgcn_update_dpp(0, __float_as_uint(d), 0x141, 0xF, 0xF, true));
    return d;
}
__device__ __forceinline__ void phase_expert_u(const KP& p, LAS unsigned char* lds, volatile LAS unsigned* MISC, int l, int G) {
    const int tid = opaque_tid(), lane = tid & 63, w = __builtin_amdgcn_readfirstlane(tid >> 6), j = lane >> 3, c = lane & 7;
    const XSlice xs = xslice_of_block(p, MISC, G);
    const bf16_t* H2 = (const bf16_t*)(p.ws + WS_H); const unsigned char* Us = p.ws + WS_U + (size_t)(l & 1) * TAB_BYTES + (size_t)xs.sl * 16384 * 128;
    const unsigned* SEL = (const unsigned*)(p.ws + WS_SEL); unsigned* PDu = (unsigned*)(p.ws + WS_R0) + (size_t)xs.sl * M * 64;
    const int t0 = xs.rank * 8 + w, tstep = xs.nloc * 8;
    LAS unsigned char* ring = lds + w * 17920;
    LAS unsigned char* selb = ring + 16384; LAS unsigned char* hbuf = ring + 16384 + 1024;
    const int tlast = t0 + ((M - 1 - t0) / tstep) * tstep;
#define E1_CL(t) ((t) <= tlast ? (t) : tlast)
#define E1_DMA_SEL(t, par) do { const unsigned* sp = SEL + (size_t)E1_CL(t) * 128 + lane; \
            __builtin_amdgcn_global_load_lds(sp, (LAS unsigned*)(selb + (par) * 512), 4, 0, 0); __builtin_amdgcn_global_load_lds(sp + 64, (LAS unsigned*)(selb + (par) * 512 + 256), 4, 0, 0); } while (0)
#define E1_DMA_H(t, par) do { __builtin_amdgcn_global_load_lds((const unsigned*)(H2 + (size_t)E1_CL(t) * D + xs.sl * 128) + lane, (LAS unsigned*)(hbuf + (par) * 256), 4, 0, 0); } while (0)
#define E1_DMA_ROW(i, idxv) do { __builtin_amdgcn_global_load_lds((const unsigned*)(Us + (size_t)((idxv) & 0x3fffu) * 128 + 16 * c), (LAS unsigned*)(ring + (i) * 1024), 16, 0, 0); } while (0)
    if (t0 < M) {
        E1_DMA_SEL(t0, 0); E1_DMA_SEL(t0 + tstep, 1); E1_DMA_H(t0, 0);
        asm volatile("s_waitcnt vmcnt(0)" ::: "memory");
        { u32x4 s0[4];
#pragma unroll
          for (int q = 0; q < 4; ++q) s0[q] = *(const LAS u32x4*)(selb + (16 * j + 4 * q) * 4);
#pragma unroll
          for (int i = 0; i < 16; ++i) E1_DMA_ROW(i, s0[i >> 2][i & 3]); }
        { PDu[(size_t)t0 * 64 + 8 * j + (c >> 1) + 4 * (c & 1)] = 0u; }
        int par = 0;
        for (int tok = t0; tok < M; tok += tstep, par ^= 1) {
            E1_DMA_SEL(tok + 2 * tstep, par); E1_DMA_H(tok + tstep, par ^ 1);
            asm volatile("s_waitcnt vmcnt(19)" ::: "memory");
            u32x4 sn[4];
#pragma unroll
            for (int q = 0; q < 4; ++q) sn[q] = *(const LAS u32x4*)(selb + (par ^ 1) * 512 + (16 * j + 4 * q) * 4);
            const bf16v8 hb0 = *(const LAS bf16v8*)(hbuf + par * 256 + 32 * c), hb1 = *(const LAS bf16v8*)(hbuf + par * 256 + 32 * c + 16);
            float pd0 = 0.f, pd1 = 0.f;
#pragma unroll
            for (int i0 = 0; i0 < 16; i0 += 4) {
                asm volatile("s_waitcnt vmcnt(16)" ::: "memory");
                u32x4 row[4];
#pragma unroll
                for (int r = 0; r < 4; ++r) row[r] = *(const LAS u32x4*)(ring + (i0 + r) * 1024 + 16 * lane);
                asm volatile("s_waitcnt lgkmcnt(0)" ::: "memory");
#pragma unroll
                for (int r = 0; r < 4; ++r) E1_DMA_ROW(i0 + r, sn[(i0 + r) >> 2][(i0 + r) & 3]);
#pragma unroll
                for (int r = 0; r < 4; ++r) { const int i = i0 + r; const float d = dpp_sum8(dot16_fp8_bf16(row[r], hb0, hb1));
                    if (i < 8) pd0 = (c == i) ? d : pd0; else pd1 = (c == i - 8) ? d : pd1; }
            }
            { const float nb0 = __uint_as_float(__builtin_amdgcn_update_dpp(0, __float_as_uint(pd0), 0xB1, 0xF, 0xF, true)), nb1 = __uint_as_float(__builtin_amdgcn_update_dpp(0, __float_as_uint(pd1), 0xB1, 0xF, 0xF, true));
              PDu[(size_t)tok * 64 + 8 * j + (c >> 1) + 4 * (c & 1)] = (c & 1) ? pk2(nb1, pd1) : pk2(pd0, nb0); }
        }
        asm volatile("s_waitcnt vmcnt(0)" ::: "memory");
    }
#undef E1_CL
#undef E1_DMA_SEL
#undef E1_DMA_H
#undef E1_DMA_ROW
}
__device__ __forceinline__ void phase_expert_w(const KP& p, int G) {
    const int tid = opaque_tid(), lane = tid & 63, w = __builtin_amdgcn_readfirstlane(tid >> 6);
    const int gw = blockIdx.x * 8 + w, ngw = G * 8;
    unsigned* SEL = (unsigned*)(p.ws + WS_SEL); const unsigned* PDu = (const unsigned*)(p.ws + WS_R0);
    for (int tok = gw; tok < M; tok += ngw) {
        f32x2 d = {0.f, 0.f};
#pragma unroll
        for (int sl = 0; sl < 8; ++sl) { const unsigned pw = PDu[((size_t)sl * M + tok) * 64 + lane]; d[0] += bflo(pw); d[1] += bfhi(pw); }
        u32x2* sp = (u32x2*)(SEL + (size_t)tok * 128 + 2 * lane); const u32x2 s2 = *sp;
        const float w0 = __uint_as_float(s2[0] & 0xffff0000u) * fgelu(d[0] * (1.0f / U_SCALE)) * (1.0f / V_SCALE);
        const float w1 = __uint_as_float(s2[1] & 0xffff0000u) * fgelu(d[1] * (1.0f / U_SCALE)) * (1.0f / V_SCALE);
        u32x2 o; o[0] = (pk2(0.f, w0) & 0xffff0000u) | (s2[0] & 0x3fffu); o[1] = (pk2(0.f, w1) & 0xffff0000u) | (s2[1] & 0x3fffu);
        *sp = o;
    }
}
__device__ __forceinline__ void phase_expert_v(const KP& p, LAS unsigned char* lds, volatile LAS unsigned* MISC, int l, int G) {
    const int tid = opaque_tid(), lane = tid & 63, w = __builtin_amdgcn_readfirstlane(tid >> 6), j = lane >> 3, c = lane & 7;
    const XSlice xs = xslice_of_block(p, MISC, G);
    const unsigned char* Vs = p.ws + WS_V + (size_t)(l & 1) * TAB_BYTES + (size_t)xs.sl * 16384 * 128;
    const unsigned* SEL = (const unsigned*)(p.ws + WS_SEL);
    const float* g2 = (const float*)(p.ws + WS_MOD) + (size_t)l * 32 * NMODC + 5120;
    const bf16_t* X = (const bf16_t*)p.out; bf16_t* XO = (l == DEPTH - 1) ? (bf16_t*)(p.ws + WS_YS) : (bf16_t*)p.out;
    const int t0 = xs.rank * 8 + w, tstep = xs.nloc * 8;
    const bool b3 = (lane & 8) != 0;
    LAS unsigned char* ring = lds + w * 17920; LAS unsigned char* selb = ring + 16384;
    const int tlast = t0 + ((M - 1 - t0) / tstep) * tstep;
#define E2_CL(t) ((t) <= tlast ? (t) : tlast)
#define E2_DMA_SEL(t, par) do { const unsigned* sp = SEL + (size_t)E2_CL(t) * 128 + lane; \
            __builtin_amdgcn_global_load_lds(sp, (LAS unsigned*)(selb + (par) * 512), 4, 0, 0); __builtin_amdgcn_global_load_lds(sp + 64, (LAS unsigned*)(selb + (par) * 512 + 256), 4, 0, 0); } while (0)
#define E2_DMA_ROW(i, idxv) do { __builtin_amdgcn_global_load_lds((const unsigned*)(Vs + (size_t)((idxv) & 0x3fffu) * 128 + 16 * c), (LAS unsigned*)(ring + (i) * 1024), 16, 0, 0); } while (0)
    if (t0 < M) {
        E2_DMA_SEL(t0, 0); E2_DMA_SEL(t0 + tstep, 1);
        asm volatile("s_waitcnt vmcnt(0)" ::: "memory");
        u32x4 sc[4];
#pragma unroll
        for (int q = 0; q < 4; ++q) sc[q] = *(const LAS u32x4*)(selb + (16 * j + 4 * q) * 4);
#pragma unroll
        for (int i = 0; i < 16; ++i) E2_DMA_ROW(i, sc[i >> 2][i & 3]);
        LAS float* xbuf = (LAS float*)(ring + 16384 + 1024);
        { const bf16_t* xd = X + (size_t)t0 * D + xs.sl * 128 + 16 * c + 2 * j; __builtin_amdgcn_global_load_lds((const unsigned*)xd, (LAS unsigned*)xbuf, 4, 0, 0); }
        int par = 0, bcur = -1; f32x2 gv = {0.f, 0.f};
        for (int tok = t0; tok < M; tok += tstep, par ^= 1) {
            const int dim = xs.sl * 128 + 16 * c + 2 * j;
            const size_t xo = (size_t)tok * D + dim;
            if ((tok >> 11) != bcur) { bcur = tok >> 11; const f32x2 gl = *(const f32x2*)(g2 + (size_t)bcur * NMODC + dim); asm volatile("s_waitcnt vmcnt(0)" ::: "memory"); gv[0] = gl[0] * 1.0f; gv[1] = gl[1] * 1.0f; asm volatile("" : "+v"(gv)); }
            E2_DMA_SEL(tok + 2 * tstep, par);
            __builtin_amdgcn_global_load_lds((const unsigned*)(X + xo), (LAS unsigned*)xbuf, 4, 0, 0);
            asm volatile("s_waitcnt vmcnt(20)" ::: "memory");
            u32x4 sn[4];
#pragma unroll
            for (int q = 0; q < 4; ++q) sn[q] = *(const LAS u32x4*)(selb + (par ^ 1) * 512 + (16 * j + 4 * q) * 4);
            f32x2 o2[8];
#pragma unroll
            for (int q = 0; q < 8; ++q) o2[q] = (f32x2){0.f, 0.f};
#pragma unroll
            for (int i0 = 0; i0 < 16; i0 += 4) {
                asm volatile("s_waitcnt vmcnt(16)" ::: "memory");
                u32x4 row[4];
#pragma unroll
                for (int r = 0; r < 4; ++r) row[r] = *(const LAS u32x4*)(ring + (i0 + r) * 1024 + 16 * lane);
                asm volatile("s_waitcnt lgkmcnt(0)" ::: "memory");
#pragma unroll
                for (int r = 0; r < 4; ++r) E2_DMA_ROW(i0 + r, sn[(i0 + r) >> 2][(i0 + r) & 3]);
                {
                    const u32x2 wA = {sc[i0 >> 2][0], sc[i0 >> 2][1]}, wB = {sc[i0 >> 2][2], sc[i0 >> 2][3]};
#pragma unroll
                    for (int r = 0; r < 4; ++r)
#pragma unroll
                        for (int q = 0; q < 4; ++q) { const f32x2 lo = __builtin_amdgcn_cvt_pk_f32_fp8((int)row[r][q], false), hi = __builtin_amdgcn_cvt_pk_f32_fp8((int)row[r][q], true);
                            if (r & 1) { asm("v_pk_fma_f32 %0, %1, %2, %0 op_sel:[1,0,0] op_sel_hi:[1,1,1]" : "+v"(o2[2 * q]) : "v"(r < 2 ? wA : wB), "v"(lo));
                                         asm("v_pk_fma_f32 %0, %1, %2, %0 op_sel:[1,0,0] op_sel_hi:[1,1,1]" : "+v"(o2[2 * q + 1]) : "v"(r < 2 ? wA : wB), "v"(hi)); }
                            else       { asm("v_pk_fma_f32 %0, %1, %2, %0 op_sel:[0,0,0] op_sel_hi:[0,1,1]" : "+v"(o2[2 * q]) : "v"(r < 2 ? wA : wB), "v"(lo));
                                         asm("v_pk_fma_f32 %0, %1, %2, %0 op_sel:[0,0,0] op_sel_hi:[0,1,1]" : "+v"(o2[2 * q + 1]) : "v"(r < 2 ? wA : wB), "v"(hi)); } }
                }
            }
            float o[16];
#pragma unroll
            for (int q = 0; q < 8; ++q) { o[2 * q] = o2[q][0]; o[2 * q + 1] = o2[q][1]; }
            float r8[8], r4[4], r2[2];
#pragma unroll
            for (int k = 0; k < 8; ++k) { const u32x2 sw = __builtin_amdgcn_permlane32_swap(__float_as_uint(o[k]), __float_as_uint(o[8 + k]), false, false); r8[k] = __uint_as_float(sw[0]) + __uint_as_float(sw[1]); }
#pragma unroll
            for (int k = 0; k < 4; ++k) { const u32x2 sw = __builtin_amdgcn_permlane16_swap(__float_as_uint(r8[k]), __float_as_uint(r8[4 + k]), false, false); r4[k] = __uint_as_float(sw[0]) + __uint_as_float(sw[1]); }
#pragma unroll
            for (int k = 0; k < 2; ++k) { const float keep = b3 ? r4[2 + k] : r4[k], send = b3 ? r4[k] : r4[2 + k];
                r2[k] = keep + __uint_as_float(__builtin_amdgcn_update_dpp(0, __float_as_uint(send), 0x128, 0xF, 0xF, true)); }
            asm volatile("s_waitcnt vmcnt(16)" ::: "memory");
            { const unsigned xw = __float_as_uint(xbuf[lane]); *(unsigned*)(XO + xo) = pk2(bflo(xw) + gv[0] * r2[0], bfhi(xw) + gv[1] * r2[1]); }
#pragma unroll
            for (int q = 0; q < 4; ++q) sc[q] = sn[q];
        }
        asm volatile("s_waitcnt vmcnt(0)" ::: "memory");
    }
#undef E2_CL
#undef E2_DMA_SEL
#undef E2_DMA_ROW
}

__device__ __forceinline__ void phase_final(const KP& p, int G) {
    const int tid = opaque_tid(), lane = tid & 63, w = __builtin_amdgcn_readfirstlane(tid >> 6);
    const int gw = blockIdx.x * 8 + w, ngw = G * 8;
    const float* fg = p.in[I_FG];
    for (int r0 = gw * 4; r0 < M; r0 += ngw * 4) {
        f32x4 v[4][4]; float ss[4];
#pragma unroll
        for (int i = 0; i < 4; ++i) { const u32x2* xr = (const u32x2*)((const bf16_t*)(p.ws + WS_YS) + (size_t)(r0 + i) * D) + lane;
#pragma unroll
            for (int j = 0; j < 4; ++j) { const u32x2 xw = xr[64 * j]; v[i][j] = (f32x4){bflo(xw[0]), bfhi(xw[0]), bflo(xw[1]), bfhi(xw[1])}; } }
#pragma unroll
        for (int i = 0; i < 4; ++i) { float t = 0.f;
#pragma unroll
            for (int j = 0; j < 4; ++j) t += (v[i][j][0] * v[i][j][0] + v[i][j][1] * v[i][j][1]) + (v[i][j][2] * v[i][j][2] + v[i][j][3] * v[i][j][3]);
            ss[i] = t; }
#pragma unroll
        for (int o = 1; o < 64; o <<= 1) {
#pragma unroll
            for (int i = 0; i < 4; ++i) ss[i] += __shfl_xor(ss[i], o); }
#pragma unroll
        for (int j = 0; j < 4; ++j) { const f32x4 g4 = *(const f32x4*)(fg + 256 * j + 4 * lane);
#pragma unroll
            for (int i = 0; i < 4; ++i) { const float rstd = __builtin_amdgcn_rsqf(ss[i] * (1.0f / D) + EPS); ((f32x4*)(p.out + (size_t)(r0 + i) * D) + lane)[64 * j] = v[i][j] * rstd * g4; } }
    }
}

__global__ void __launch_bounds__(512, 2) mk_fwd(KP p_) {
    extern __shared__ __attribute__((aligned(16))) unsigned char lds_raw[];
    LAS unsigned char* lds = (LAS unsigned char*)lds_raw;
    const int tid = threadIdx.x, G = gridDim.x;
    volatile LAS unsigned* MISC = (volatile LAS unsigned*)(lds + MISC_OFF);
    for (int i = tid; i < LDS_BYTES / 4; i += 512) ((LAS unsigned*)lds)[i] = 0u;
    __syncthreads();
    XcdBarrier bar = xcd_barrier_post((unsigned*)(p_.ws + WS_CTL) + 4096, MISC + 8);
    if (tid == 0) { const unsigned myx = xb_xcc_id(); MISC[16] = myx; MISC[17] = xb_add((unsigned*)(p_.ws + WS_CTL) + 8192 + 64 * (myx & 15u), 1u); }
    __syncthreads();
    const int lo = p_.gp_lo, hi = p_.gp_hi;
#ifndef PH_MASK
#define PH_MASK 0xFFFFF
#endif
#define IN(k) (lo <= (k) && (k) < hi)
#define EN(b) ((PH_MASK >> (b)) & 1)
#ifndef PH_REPEAT
#define PH_REPEAT 0
#endif
#define NREP(b) (((PH_REPEAT >> (b)) & 1) ? 2 : 1)
#define SEAM(k) do { if ((k) + 1 < hi) xcd_barrier(bar); } while (0)
    if (EN(12) && IN(GP_SETUP)) { const KP p = load_kp(); phase_setup(p, lds, G); SEAM(GP_SETUP); }
    for (int l = 0; l < DEPTH; ++l) {
        const int g0 = 1 + l * NPH;
        if (EN(0) && IN(g0 + 0)) { _Pragma("nounroll") for (int rep = 0; rep < NREP(0); ++rep) { const KP p = load_kp(); phase_conv_norm1(p, lds, l, G); } SEAM(g0 + 0); }
        if (EN(1) && IN(g0 + 1)) { const KP p = load_kp();
            pg8::Gemm g{(const bf16_t*)(p.ws + WS_H), (const bf16_t*)(p.ws + WS_WIN), M, 3072, D / 2, D / 2, D / 2}; pg8::StaticOrder S; S.init(M, 3072, G, (int)blockIdx.x);
            pg8::EpiStoreBf16 E{(bf16_t*)(p.ws + WS_R0), 3072, 1.0f / (WIN_SCALE * HIN_SCALE)};
            _Pragma("nounroll") for (int rep = 0; rep < NREP(1); ++rep) pg8::gemm_phase<pg8::EpiStoreBf16, pg8::StaticOrder, false, true, true>(lds, g, S, E);
            SEAM(g0 + 1);
        }
        if (EN(2) && IN(g0 + 2)) { _Pragma("nounroll") for (int rep = 0; rep < NREP(2); ++rep) { const KP p = load_kp(); phase_hgrn2(p, lds, l, G); } SEAM(g0 + 2); }
        if (EN(3) && IN(g0 + 3)) { const KP p = load_kp();
            pg8::Gemm g{(const bf16_t*)(p.ws + WS_H), (const bf16_t*)(p.ws + WS_WIN) + (size_t)3072 * (D / 2), M, 4096, D / 2, D / 2, D / 2}; pg8::StaticOrder S; S.init(M, 4096, G, (int)blockIdx.x);
            pg8::EpiStoreBf16 E{(bf16_t*)(p.ws + WS_R0), 4096, 1.0f / (WIN_SCALE * HIN_SCALE)};
            _Pragma("nounroll") for (int rep = 0; rep < NREP(3); ++rep) pg8::gemm_phase<pg8::EpiStoreBf16, pg8::StaticOrder, false, true, true>(lds, g, S, E);
            SEAM(g0 + 3);
        }
        #if DBG_SELFCHECK
        if (EN(4) && IN(g0 + 4)) {
#pragma nounroll
            for (int rep = 0; rep < 2; ++rep) { const KP p = load_kp(); size_t yo = rep ? WS_H : WS_YS; asm volatile("" : "+s"(yo)); phase_s5(p, lds, l, G, yo); SEAM(g0 + 4); }
            const KP p = load_kp();
            const unsigned* a = (const unsigned*)(p.ws + WS_YS); const unsigned* b2 = (const unsigned*)(p.ws + WS_H); unsigned bad = 0;
            for (size_t i = (size_t)blockIdx.x * 512 + opaque_tid(); i < (size_t)M * D / 2; i += (size_t)G * 512) bad += (a[i] != b2[i]) ? 1u : 0u;
            if (bad) atomicAdd((unsigned*)(p.ws + WS_CTL) + 64, bad);
            { const unsigned* h1 = (const unsigned*)(p.ws + WS_CTL) + 65536; const unsigned* h2 = h1 + 8192; const int u2 = blockIdx.x * 512 + opaque_tid();
              if (u2 < 2048) { if (h1[u2 * 4] != h2[u2 * 4]) atomicAdd((unsigned*)(p.ws + WS_CTL) + 128, 1u); if (h1[u2 * 4 + 1] != h2[u2 * 4 + 1]) atomicAdd((unsigned*)(p.ws + WS_CTL) + 192, 1u); if (h1[u2 * 4 + 2] != h2[u2 * 4 + 2]) atomicAdd((unsigned*)(p.ws + WS_CTL) + 256, 1u); } }
            SEAM(g0 + 4); }
#else
        if (EN(4) && IN(g0 + 4)) { _Pragma("nounroll") for (int rep = 0; rep < NREP(4); ++rep) { const KP p = load_kp(); phase_s5(p, lds, l, G, WS_YS); } SEAM(g0 + 4); }
#endif
        if (EN(5) && IN(g0 + 5)) { const KP p = load_kp();
            pg8::Gemm g{(const bf16_t*)(p.ws + WS_YS), (const bf16_t*)(p.ws + WS_WGLU), M, D, D, D, D}; pg8::StaticOrder S; S.init(M, D, G, (int)blockIdx.x);
            pg8::EpiGlu E{(const bf16_t*)(p.ws + WS_R0), (const bf16_t*)(p.ws + WS_YS), (const bf16_t*)(p.ws + WS_OR), (const float*)(p.ws + WS_SSQ), p.in[I_HNG] + l * 128, p.in[I_GLUB] + l * D, (bf16_t*)(p.ws + WS_H)};
            _Pragma("nounroll") for (int rep = 0; rep < NREP(5); ++rep) pg8::gemm_phase<pg8::EpiGlu, pg8::StaticOrder, true, true>(lds, g, S, E);
            SEAM(g0 + 5);
        }
        if (EN(6) && IN(g0 + 6)) { const KP p = load_kp();
            pg8::Gemm g{(const bf16_t*)(p.ws + WS_H), (const bf16_t*)(p.ws + WS_WOUT), M, D, D / 2, D / 2, D / 2}; pg8::StaticOrder S; S.init(M, D, G, (int)blockIdx.x);
            pg8::EpiStoreBf16 E{(bf16_t*)(p.ws + WS_OR), D, 1.0f / (WO_SCALE * MG_SCALE)};
            pg8::gemm_phase<pg8::EpiStoreBf16, pg8::StaticOrder, false, true, true>(lds, g, S, E);
            SEAM(g0 + 6);
        }
        if (EN(7) && IN(g0 + 7)) { const KP p = load_kp();
            const int t2 = opaque_tid(), lane = t2 & 63, wave = __builtin_amdgcn_readfirstlane(t2 >> 6);
            if (l == 0) resid_norm_rows<false>(p.in[I_X], (bf16_t*)p.out, (const bf16_t*)(p.ws + WS_OR), (bf16_t*)(p.ws + WS_H), p.in[I_N2G] + l * D, (const float*)(p.ws + WS_MOD) + (size_t)l * 32 * NMODC, blockIdx.x * 8 + wave, G * 8, lane);
            else resid_norm_rows<true>(p.out, (bf16_t*)p.out, (const bf16_t*)(p.ws + WS_OR), (bf16_t*)(p.ws + WS_H), p.in[I_N2G] + l * D, (const float*)(p.ws + WS_MOD) + (size_t)l * 32 * NMODC, blockIdx.x * 8 + wave, G * 8, lane);
            SEAM(g0 + 7);
        }
        if (EN(8) && IN(g0 + 8)) { const KP p = load_kp();
            pg8::Gemm g{(const bf16_t*)(p.ws + WS_H), (const bf16_t*)(p.ws + WS_WQ), M, 2048, D, D, D}; pg8::StaticOrder S; S.init(M, 2048, G, (int)blockIdx.x);
            pg8::EpiStoreQ E{(bf16_t*)(p.ws + WS_R0)};
            _Pragma("nounroll") for (int rep = 0; rep < NREP(8); ++rep) pg8::gemm_phase<pg8::EpiStoreQ, pg8::StaticOrder, true, true>(lds, g, S, E);
            SEAM(g0 + 8);
        }
        if (EN(9) && IN(g0 + 9)) { _Pragma("nounroll") for (int rep = 0; rep < NREP(9); ++rep) { const KP p = load_kp(); phase_topk(p, lds, G); } SEAM(g0 + 9); }
        if (EN(10) && IN(g0 + 10)) {
            { const KP p = load_kp(); phase_expert_u(p, lds, MISC, l, G); } xcd_barrier(bar);
            { const KP p = load_kp(); phase_expert_w(p, G); } xcd_barrier(bar);
            { const KP p = load_kp(); phase_expert_v(p, lds, MISC, l, G); }
            SEAM(g0 + 10); }
    }
    if (EN(13) && IN(GP_FINAL)) { const KP p = load_kp(); phase_final(p, G); }
#undef IN
#undef EN
#undef NREP
#undef SEAM
}

extern "C" void kernel_launch(void* const* d_in, const int* in_sizes, int n_in, void* d_out, int out_size, void* d_ws, size_t ws_size, hipStream_t stream) {
    static int grid = 0;
    if (grid == 0) {
        if (n_in != 25 || out_size != M * D || ws_size < WS_END) { fprintf(stderr, "kernel_launch: unexpected shapes (n_in %d, out %d, ws %zu < %zu)\n", n_in, out_size, ws_size, (size_t)WS_END); grid = -1; return; }
        int dev = 0, cus = 0, per_cu = 0;
        if (hipGetDevice(&dev) != hipSuccess || hipDeviceGetAttribute(&cus, hipDeviceAttributeMultiprocessorCount, dev) != hipSuccess) { grid = -1; return; }
        if (hipFuncSetAttribute((const void*)mk_fwd, hipFuncAttributeMaxDynamicSharedMemorySize, LDS_BYTES) != hipSuccess) { fprintf(stderr, "kernel_launch: hipFuncSetAttribute failed\n"); grid = -1; return; }
        if (hipOccupancyMaxActiveBlocksPerMultiprocessor(&per_cu, (const void*)mk_fwd, 512, LDS_BYTES) != hipSuccess || per_cu < 1) fprintf(stderr, "kernel_launch: occupancy query says %d\n", per_cu);
        (void)hipGetLastError();
        grid = cus;
    }
    if (grid < 0) return;
    (void)hipMemsetAsync((char*)d_ws + WS_CTL, 0, CTL_ZERO_BYTES, stream);
    KP a{};
    for (int i = 0; i < 25; ++i) a.in[i] = (const float*)d_in[i];
    a.out = (float*)d_out; a.ws = (unsigned char*)d_ws;
#if MK_LAUNCHES == 1
    a.gp_lo = 0; a.gp_hi = GP_END;
    hipLaunchKernelGGL(mk_fwd, dim3(grid), dim3(512), LDS_BYTES, stream, a);
#else
    for (int gp = 0; gp < GP_END; ++gp) { a.gp_lo = gp; a.gp_hi = gp + 1; hipLaunchKernelGGL(mk_fwd, dim3(grid), dim3(512), LDS_BYTES, stream, a); }
#endif
}
```

```cpp
#include <hip/hip_runtime.h>
#include <cstdio>
#include <cstdint>

#define DBG_HASHSEL 0
#define DBG_H2_FROM_INPUT 0
#define DBG_NO_YA 0
#define DBG_NO_YB 0
#define DBG_NO_ACC 0
#define DBG_NO_GB 0
#define DBG_S5_NOSSM 0
#define DBG_S5_NOREC 0
#define DBG_SELFCHECK 0
#ifndef MK_LAUNCHES
#define MK_LAUNCHES 1
#endif

#define LAS __attribute__((address_space(3)))
typedef unsigned short bf16_t;
typedef short bf16x8 __attribute__((ext_vector_type(8)));
typedef float f32x2 __attribute__((ext_vector_type(2)));
typedef float f32x4 __attribute__((ext_vector_type(4)));
typedef float f32x16 __attribute__((ext_vector_type(16)));
typedef unsigned u32x2 __attribute__((ext_vector_type(2)));
typedef unsigned u32x4 __attribute__((ext_vector_type(4)));
typedef __bf16 bf16v2 __attribute__((ext_vector_type(2)));
typedef int i32x8 __attribute__((ext_vector_type(8)));
typedef int i32x4 __attribute__((ext_vector_type(4)));

constexpr int D = 1024, BATCH = 32, SEQ = 2048, DEPTH = 4, M = BATCH * SEQ;
constexpr int INC = 7168, NMODC = 6 * D;
constexpr int NPH = 11, GP_SETUP = 0, GP_FINAL = 1 + DEPTH * NPH, GP_END = GP_FINAL + 1;
constexpr float EPS = 1e-6f;
constexpr float U_SCALE = 64.0f, V_SCALE = 4.0f;
constexpr size_t TAB_BYTES = (size_t)16384 * 1024;
constexpr float WIN_SCALE = 64.0f, HIN_SCALE = 4.0f;
constexpr float WO_SCALE = 64.0f, MG_SCALE = 8.0f;

constexpr size_t MiB = 1u << 20;
constexpr size_t WS_CTL = 0, CTL_ZERO_BYTES = 1 * MiB;
constexpr size_t WS_MOD = 1 * MiB;
constexpr size_t WS_LB = 4 * MiB;
constexpr size_t WS_ABAR = 4 * MiB + 65536;
constexpr size_t WS_BOP = 5 * MiB;
constexpr size_t WS_COP = 6 * MiB;
constexpr size_t WS_WIN = 8 * MiB;
constexpr size_t WS_WGLU = 22 * MiB;
constexpr size_t WS_WOUT = 24 * MiB;
constexpr size_t WS_WQ = 26 * MiB;
constexpr size_t WS_KEYS = 30 * MiB;
constexpr size_t WS_U = 32 * MiB;
constexpr size_t WS_V = 64 * MiB;
constexpr size_t WS_H = 96 * MiB;
constexpr size_t WS_OR = 224 * MiB;
constexpr size_t WS_SSQ = 352 * MiB;
constexpr size_t WS_R0 = 354 * MiB;
constexpr size_t WS_SEL = WS_R0 + 256 * MiB;
constexpr size_t WS_YS = WS_R0 + 512 * MiB;
constexpr size_t WS_END = WS_YS + 128 * MiB;

constexpr int LDS_BYTES = 147456;
constexpr int MISC_OFF = LDS_BYTES - 256;

__device__ __forceinline__ unsigned pk2(float lo, float hi) { f32x2 v = {lo, hi}; bf16v2 r = __builtin_convertvector(v, bf16v2); return __builtin_bit_cast(unsigned, r); }
__device__ __forceinline__ float bflo(unsigned w) { return __uint_as_float(w << 16); }
__device__ __forceinline__ float bfhi(unsigned w) { return __uint_as_float(w & 0xffff0000u); }
__device__ __forceinline__ float fsigmoid(float x) { return __builtin_amdgcn_rcpf(1.0f + __expf(-x)); }
__device__ __forceinline__ float fsilu(float x) { return x * fsigmoid(x); }
__device__ __forceinline__ float fgelu(float x) { return x * fsigmoid(1.5957691216f * (x + 0.044715f * x * x * x)); }
__device__ __forceinline__ float wave_sum(float v) {
#pragma unroll
    for (int o = 1; o < 64; o <<= 1) v += __shfl_xor(v, o);
    return v;
}
#define LDS_WAIT() asm volatile("s_waitcnt lgkmcnt(0)" ::: "memory")
__device__ __forceinline__ float dpp_sum8(float d);
__device__ __forceinline__ int opaque_tid() { int t = threadIdx.x; asm volatile("" : "+v"(t)); return t; }

namespace pg8 {
#define PG8_LAS __attribute__((address_space(3)))
constexpr int BM = 256, BK = 64, HALF = 128, HTB = HALF * BK * 2, STAGE_BYTES = 8 * HTB, NXCD = 8, WGM = 8;
__host__ __device__ __forceinline__ int lds_byte(int r, int c) { const int st = (r >> 4) * 2 + (c >> 5), rr = r & 15, cc = c & 31, ob = rr * 64 + cc * 2; return st * 1024 + (ob ^ (((ob >> 9) & 1) << 5)); }
__host__ __device__ __forceinline__ void stage_rc(int b, int& R, int& C) { const int st = b / 1024, sb = b % 1024, swz = sb ^ (((sb >> 9) & 1) << 5); R = (st >> 1) * 16 + swz / 64; C = (st & 1) * 32 + (swz % 64) / 2; }
__host__ __device__ __forceinline__ int perm32(int rho) { const int n = rho >> 4, i = rho & 15; return 8 * (i >> 2) + 4 * n + (i & 3); }
struct Unit { int pm, pn; };
struct Gemm { const bf16_t* A; const bf16_t* Bt; int M, N, K, lda, ldb; };
struct StaticOrder {
    int nM, nN, nwg, G, c;
    __host__ __device__ void init(int M_, int N_, int G_, int c_) { nM = M_ / BM; nN = N_ / BM; nwg = nM * nN; G = G_; c = c_; }
    __host__ __device__ bool next(int i, Unit& u) const {
        const long L = (long)i * G + c; if (L >= nwg) return false;
        int wgid = (int)L; { const int q = nwg / NXCD, r = nwg % NXCD, xcd = wgid % NXCD, off = wgid / NXCD; wgid = (xcd < r ? xcd * (q + 1) : r * (q + 1) + (xcd - r) * q) + off; }
        const int nig = WGM * nN, gid = wgid / nig, fm = gid * WGM, gsz = (nM - fm) < WGM ? (nM - fm) : WGM;
        u.pm = fm + ((wgid % nig) % gsz); u.pn = (wgid % nig) / gsz; return true;
    }
    __device__ __forceinline__ void a_ready(const Unit&) const {}
    __device__ __forceinline__ void done(const Unit&) const {}
};
template <class Epi, class Sched, bool ALIGN_EPI = false, bool SP2 = false, bool F8 = false>
__device__ __forceinline__ void gemm_phase(PG8_LAS unsigned char* lds, const Gemm g, const Sched& S, const Epi& E) {
    const int tid = opaque_tid(), wid = __builtin_amdgcn_readfirstlane(tid >> 6), lane = tid & 63, wr = wid >> 2, wc = wid & 3, fr = lane & 15, fq = lane >> 4;
    const int K = g.K, nt = K / BK;
    unsigned voffA[2], voffB[2];
#pragma unroll
    for (int i = 0; i < 2; ++i) { int R, C; stage_rc(tid * 16 + i * 8192, R, C); const int Rb = Epi::PERM ? ((R & ~31) + perm32(R & 31)) : R;
        voffA[i] = (unsigned)(R * g.lda + C) * 2u; voffB[i] = (unsigned)(Rb * g.ldb + C) * 2u; }
    const size_t kstep = (size_t)(BK * 2);
    const size_t hstepA = (size_t)HALF * g.lda * 2, hstepB = (size_t)HALF * g.ldb * 2;
    const size_t tstepA = 2 * hstepA, tstepB = 2 * hstepB;
    const unsigned ldsw = (unsigned)wid * 1024u;
    const int aoff = lds_byte(wr * 64 + fr, fq * 8), boff = lds_byte(wc * 32 + fr, fq * 8);
#define PG8_SA(b, h) (((b) * 2 + (h)) * HTB)
#define PG8_SB(b, h) ((4 + (b) * 2 + (h)) * HTB)
#define PG8_STAGE(bufoff, gbase, voff) do { _Pragma("unroll") for (int _i = 0; _i < 2; ++_i) \
        __builtin_amdgcn_global_load_lds((const unsigned*)((const char*)(gbase) + (voff)[_i]), (PG8_LAS unsigned*)(lds + (bufoff) + ldsw + _i * 8192), 16, 0, 0); } while (0)
#define PG8_LD8(p) __builtin_shufflevector(*(const PG8_LAS i32x4*)(p), *(const PG8_LAS i32x4*)((p) + 1024), 0, 1, 2, 3, 4, 5, 6, 7)
#define PG8_LDA(dst, b, h) do { if constexpr (F8) { _Pragma("unroll") for (int m = 0; m < 4; ++m) dst##8[m] = PG8_LD8(lds + PG8_SA(b, h) + aoff + m * 2048); } \
        else { _Pragma("unroll") for (int m = 0; m < 4; ++m) _Pragma("unroll") for (int k = 0; k < 2; ++k) dst[m][k] = *(const PG8_LAS bf16x8*)(lds + PG8_SA(b, h) + aoff + m * 2048 + k * 1024); } } while (0)
#define PG8_LDB(dst, b, h) do { if constexpr (F8) { _Pragma("unroll") for (int n = 0; n < 2; ++n) dst##8[n] = PG8_LD8(lds + PG8_SB(b, h) + boff + n * 2048); } \
        else { _Pragma("unroll") for (int n = 0; n < 2; ++n) _Pragma("unroll") for (int k = 0; k < 2; ++k) dst[n][k] = *(const PG8_LAS bf16x8*)(lds + PG8_SB(b, h) + boff + n * 2048 + k * 1024); } } while (0)
#define PG8_MMA(ai, bj, At, Bt) do { __builtin_amdgcn_s_setprio(1); _Pragma("unroll") for (int m = 0; m < 4; ++m) _Pragma("unroll") for (int n = 0; n < 2; ++n) { \
        if constexpr (F8) {   \
            acc[ai][bj][m][n] = __builtin_amdgcn_mfma_scale_f32_16x16x128_f8f6f4(Bt##8[n], At##8[m], acc[ai][bj][m][n], 0, 0, 0, 0x7f7f7f7f, 0, 0x7f7f7f7f); \
        } else { _Pragma("unroll") for (int k = 0; k < 2; ++k) acc[ai][bj][m][n] = __builtin_amdgcn_mfma_f32_16x16x32_bf16(Bt[n][k], At[m][k], acc[ai][bj][m][n], 0, 0, 0); } } \
        __builtin_amdgcn_s_setprio(0); } while (0)
#define PG8_WAIT_V(n) asm volatile("s_waitcnt vmcnt(" #n ")" ::: "memory")
#define PG8_WAIT_L(n) asm volatile("s_waitcnt lgkmcnt(" #n ")" ::: "memory")
#define PG8_BAR __builtin_amdgcn_s_barrier()
#define PG8_SCHED __builtin_amdgcn_sched_barrier(0)
    Unit cur, nxt; int ui = 0;
    if (!S.next(0, cur)) return;
    f32x4 acc[2][2][4][2];
#pragma unroll
    for (int a = 0; a < 2; ++a)
#pragma unroll
        for (int b = 0; b < 2; ++b)
#pragma unroll
            for (int m = 0; m < 4; ++m)
#pragma unroll
                for (int n = 0; n < 2; ++n) acc[a][b][m][n] = (f32x4){0.f, 0.f, 0.f, 0.f};
    bf16x8 At[4][2], B0[2][2], B1[2][2]; i32x8 At8[4], B08[2], B18[2];
    const char* cA = (const char*)g.A + (size_t)cur.pm * tstepA; const char* cB = (const char*)g.Bt + (size_t)cur.pn * tstepB;
    S.a_ready(cur);
    if constexpr (SP2) {
        PG8_STAGE(PG8_SB(0, 0), cB, voffB); PG8_STAGE(PG8_SB(0, 1), cB + hstepB, voffB); PG8_STAGE(PG8_SA(0, 0), cA, voffA); PG8_STAGE(PG8_SA(0, 1), cA + hstepA, voffA);
        if (wr == 1) PG8_BAR;
        PG8_WAIT_V(2); PG8_BAR;
        PG8_STAGE(PG8_SB(1, 0), cB + kstep, voffB); PG8_STAGE(PG8_SA(1, 0), cA + kstep, voffA); PG8_STAGE(PG8_SB(1, 1), cB + hstepB + kstep, voffB);
        PG8_WAIT_V(6); PG8_BAR;
    } else {
        PG8_STAGE(PG8_SB(0, 0), cB, voffB); PG8_STAGE(PG8_SA(0, 0), cA, voffA); PG8_STAGE(PG8_SB(0, 1), cB + hstepB, voffB); PG8_STAGE(PG8_SA(0, 1), cA + hstepA, voffA);
        if (wr == 1) PG8_BAR;
        PG8_WAIT_V(4); PG8_BAR;
        PG8_STAGE(PG8_SB(1, 0), cB + kstep, voffB); PG8_STAGE(PG8_SA(1, 0), cA + kstep, voffA); PG8_STAGE(PG8_SB(1, 1), cB + hstepB + kstep, voffB);
        PG8_WAIT_V(6); PG8_BAR;
    }
    for (;;) {
        const bool has_next = S.next(ui + 1, nxt);
        const char* nA = has_next ? (const char*)g.A + (size_t)nxt.pm * tstepA : cA; const char* nB = has_next ? (const char*)g.Bt + (size_t)nxt.pn * tstepB : cB;
        for (int t = 0; t < nt; t += 2) {
            const bool last = (t == nt - 2);
            const char* a1 = cA + (size_t)(t + 1) * kstep;
            const char* a2 = last ? nA : cA + (size_t)(t + 2) * kstep; const char* b2 = last ? nB : cB + (size_t)(t + 2) * kstep;
            const char* a3 = a2 + kstep; const char* b3 = b2 + kstep;
            if (last && has_next) S.a_ready(nxt);
            if constexpr (SP2) {
            PG8_LDB(B0, 0, 0); PG8_LDB(B1, 0, 1); PG8_SCHED; PG8_LDA(At, 0, 0); PG8_STAGE(PG8_SA(1, 1), a1 + hstepA, voffA);
            PG8_WAIT_V(8); PG8_WAIT_L(0); PG8_BAR; PG8_MMA(0, 0, At, B0); PG8_MMA(0, 1, At, B1); PG8_BAR; PG8_SCHED;
            PG8_LDA(At, 0, 1); PG8_STAGE(PG8_SB(0, 0), b2, voffB); PG8_STAGE(PG8_SB(0, 1), b2 + hstepB, voffB); PG8_STAGE(PG8_SA(0, 0), a2, voffA);
            PG8_WAIT_V(8); PG8_WAIT_L(0); PG8_BAR; PG8_MMA(1, 0, At, B0); PG8_MMA(1, 1, At, B1); PG8_BAR; PG8_SCHED;
            PG8_LDB(B0, 1, 0); PG8_LDB(B1, 1, 1); PG8_SCHED; PG8_LDA(At, 1, 0); PG8_STAGE(PG8_SA(0, 1), a2 + hstepA, voffA);
            PG8_WAIT_V(8); PG8_WAIT_L(0); PG8_BAR; PG8_MMA(0, 0, At, B0); PG8_MMA(0, 1, At, B1); PG8_BAR; PG8_SCHED;
            PG8_LDA(At, 1, 1); PG8_STAGE(PG8_SB(1, 0), b3, voffB); PG8_STAGE(PG8_SB(1, 1), b3 + hstepB, voffB); PG8_STAGE(PG8_SA(1, 0), a3, voffA);
            PG8_WAIT_V(8); PG8_WAIT_L(0); PG8_BAR; PG8_MMA(1, 0, At, B0); PG8_MMA(1, 1, At, B1); PG8_BAR; PG8_SCHED;
            } else {
            PG8_LDB(B0, 0, 0); PG8_SCHED; PG8_LDA(At, 0, 0); PG8_STAGE(PG8_SA(1, 1), a1 + hstepA, voffA);
            PG8_WAIT_L(8); PG8_BAR; PG8_WAIT_L(0); PG8_MMA(0, 0, At, B0); PG8_BAR; PG8_SCHED;
            PG8_LDB(B1, 0, 1); PG8_STAGE(PG8_SB(0, 0), b2, voffB);
            PG8_BAR; PG8_WAIT_L(0); PG8_MMA(0, 1, At, B1); PG8_BAR;
            PG8_LDA(At, 0, 1); PG8_STAGE(PG8_SA(0, 0), a2, voffA);
            PG8_BAR; PG8_WAIT_L(0); PG8_MMA(1, 0, At, B0); PG8_BAR; PG8_SCHED;
            PG8_STAGE(PG8_SB(0, 1), b2 + hstepB, voffB);
            PG8_WAIT_V(6); PG8_BAR; PG8_MMA(1, 1, At, B1); PG8_BAR;
            PG8_LDB(B0, 1, 0); PG8_SCHED; PG8_LDA(At, 1, 0); PG8_STAGE(PG8_SA(0, 1), a2 + hstepA, voffA);
            PG8_WAIT_L(8); PG8_BAR; PG8_WAIT_L(0); PG8_MMA(0, 0, At, B0); PG8_BAR; PG8_SCHED;
            PG8_LDB(B1, 1, 1); PG8_STAGE(PG8_SB(1, 0), b3, voffB);
            PG8_BAR; PG8_WAIT_L(0); PG8_MMA(0, 1, At, B1); PG8_BAR;
            PG8_LDA(At, 1, 1); PG8_STAGE(PG8_SA(1, 0), a3, voffA);
            PG8_BAR; PG8_WAIT_L(0); PG8_MMA(1, 0, At, B0); PG8_BAR; PG8_SCHED;
            PG8_STAGE(PG8_SB(1, 1), b3 + hstepB, voffB);
            PG8_WAIT_V(6); PG8_BAR; PG8_MMA(1, 1, At, B1); PG8_BAR;
            }
        }
        if constexpr (ALIGN_EPI) { if (wr == 0) PG8_BAR; }
        E(acc, cur, wr, wc, fr, fq);
        if (!has_next) break;
#pragma unroll
        for (int a = 0; a < 2; ++a)
#pragma unroll
            for (int b = 0; b < 2; ++b)
#pragma unroll
                for (int m = 0; m < 4; ++m)
#pragma unroll
                    for (int n = 0; n < 2; ++n) acc[a][b][m][n] = (f32x4){0.f, 0.f, 0.f, 0.f};
        cur = nxt; cA = nA; cB = nB; ++ui;
        if constexpr (ALIGN_EPI) { if (wr == 1) PG8_BAR; }
    }
    PG8_WAIT_V(0);
    if constexpr (!ALIGN_EPI) { if (wr == 0) PG8_BAR; }
    PG8_BAR;
#undef PG8_SA
#undef PG8_SB
#undef PG8_STAGE
#undef PG8_LDA
#undef PG8_LD8
#undef PG8_LDB
#undef PG8_MMA
#undef PG8_WAIT_V
#undef PG8_WAIT_L
#undef PG8_BAR
#undef PG8_SCHED
}

struct EpiStoreBf16 {
    static constexpr bool PERM = true;
    bf16_t* O; int ldc; float scale;
    __device__ __forceinline__ void operator()(const f32x4 (&acc)[2][2][4][2], const Unit& u, int wr, int wc, int fr, int fq) const {
        const int row0 = u.pm * BM + wr * 64 + fr, col0 = u.pn * BM + wc * 32 + 8 * fq;
#pragma unroll
        for (int ai = 0; ai < 2; ++ai)
#pragma unroll
            for (int m = 0; m < 4; ++m) { bf16_t* rowp = O + (size_t)(row0 + ai * HALF + m * 16) * ldc + col0;
#pragma unroll
                for (int bj = 0; bj < 2; ++bj) { const f32x4 v0 = acc[ai][bj][m][0] * scale, v1 = acc[ai][bj][m][1] * scale;
                    u32x4 w; w.x = pk2(v0[0], v0[1]); w.y = pk2(v0[2], v0[3]); w.z = pk2(v1[0], v1[1]); w.w = pk2(v1[2], v1[3]);
                    *(u32x4*)(rowp + bj * HALF) = w; } }
    }
};
struct EpiStoreQ {
    static constexpr bool PERM = true;
    bf16_t* O;
    __device__ __forceinline__ void operator()(const f32x4 (&acc)[2][2][4][2], const Unit& u, int wr, int wc, int fr, int fq) const {
        const int row0 = u.pm * BM + wr * 64 + fr, col0 = u.pn * BM + wc * 32 + 8 * fq;
#pragma unroll
        for (int ai = 0; ai < 2; ++ai)
#pragma unroll
            for (int m = 0; m < 4; ++m) { const int row = row0 + ai * HALF + m * 16, tg = row >> 5, t = row & 31;
#pragma unroll
                for (int bj = 0; bj < 2; ++bj) { const int c0 = col0 + bj * HALF, h = c0 >> 8, pp = (c0 >> 7) & 1, cc = c0 & 127, ks = cc >> 4, hh = (cc >> 3) & 1;
                    const f32x4 v0 = acc[ai][bj][m][0], v1 = acc[ai][bj][m][1];
                    u32x4 w; w.x = pk2(v0[0], v0[1]); w.y = pk2(v0[2], v0[3]); w.z = pk2(v1[0], v1[1]); w.w = pk2(v1[2], v1[3]);
                    *(u32x4*)(O + ((size_t)((((tg * 8 + h) * 2 + pp) * 8 + ks) * 64 + hh * 32 + t)) * 8) = w; } }
    }
};
struct EpiWout {
    static constexpr bool PERM = false;
    const float* xs; float* out; const float* g1;
    __device__ __forceinline__ void operator()(const f32x4 (&acc)[2][2][4][2], const Unit& u, int wr, int wc, int fr, int fq) const {
        const int row0 = u.pm * BM + wr * 64 + fr, col0 = u.pn * BM + wc * 32 + 4 * fq;
        const int b = (u.pm * BM) >> 11;
        f32x4 gv[2][2];
#pragma unroll
        for (int bj = 0; bj < 2; ++bj)
#pragma unroll
            for (int n = 0; n < 2; ++n) gv[bj][n] = *(const f32x4*)(g1 + (size_t)b * NMODC + col0 + bj * HALF + n * 16);
#pragma unroll
        for (int ai = 0; ai < 2; ++ai)
#pragma unroll
            for (int m = 0; m < 4; ++m) { const size_t off = (size_t)(row0 + ai * HALF + m * 16) * D + col0;
#pragma unroll
                for (int bj = 0; bj < 2; ++bj)
#pragma unroll
                    for (int n = 0; n < 2; ++n) { const f32x4 xv = *(const f32x4*)(xs + off + bj * HALF + n * 16);
                        *(f32x4*)(out + off + bj * HALF + n * 16) = xv + gv[bj][n] * acc[ai][bj][m][n]; } }
    }
};
struct EpiGlu {
    static constexpr bool PERM = true;
    const bf16_t* PB; const bf16_t* YS; const bf16_t* ORAW; const float* SSQ; const float* ng; const float* gb_; bf16_t* O;
    __device__ __forceinline__ void operator()(const f32x4 (&acc)[2][2][4][2], const Unit& u, int wr, int wc, int fr, int fq) const {
        const int row0 = u.pm * BM + wr * 64 + fr, col0 = u.pn * BM + wc * 32 + 8 * fq;
#pragma unroll
        for (int bj = 0; bj < 2; ++bj) {
            const int c = col0 + bj * HALF, head = c >> 7;
            const f32x4 n0 = *(const f32x4*)(ng + (c & 127)), n1 = *(const f32x4*)(ng + (c & 127) + 4);
            const f32x4 b0 = *(const f32x4*)(gb_ + c), b1 = *(const f32x4*)(gb_ + c + 4);
            const float ngv[8] = {n0[0], n0[1], n0[2], n0[3], n1[0], n1[1], n1[2], n1[3]};
            const float bbv[8] = {b0[0], b0[1], b0[2], b0[3], b1[0], b1[1], b1[2], b1[3]};
#pragma unroll
            for (int ai = 0; ai < 2; ++ai)
#pragma unroll
                for (int m = 0; m < 4; ++m) {
                    const int row = row0 + ai * HALF + m * 16;
                    const bf16_t* pb = PB + (size_t)row * 4096 + c;
                    const u32x4 og = *(const u32x4*)(pb), ys = *(const u32x4*)(YS + (size_t)row * D + c), ga = *(const u32x4*)(pb + 2048), gb = *(const u32x4*)(pb + 3072);
                    const u32x4 orw = *(const u32x4*)(ORAW + (size_t)row * D + c);
                    const float rstd = __builtin_amdgcn_rsqf(SSQ[(size_t)row * 8 + head] * (1.0f / 128.0f) + EPS);
                    const f32x4 a0 = acc[ai][bj][m][0], a1 = acc[ai][bj][m][1];
                    const float av[8] = {a0[0], a0[1], a0[2], a0[3], a1[0], a1[1], a1[2], a1[3]};
                    float res[8];
#pragma unroll
                    for (int j = 0; j < 8; ++j) {
                        const unsigned wog = og[j >> 1], wys = ys[j >> 1], wga = ga[j >> 1], wgb = gb[j >> 1], wor = orw[j >> 1];
                        const float fog = (j & 1) ? bfhi(wog) : bflo(wog), fys = (j & 1) ? bfhi(wys) : bflo(wys), fga = (j & 1) ? bfhi(wga) : bflo(wga),
                                    fgb = (j & 1) ? bfhi(wgb) : bflo(wgb), fo = (j & 1) ? bfhi(wor) : bflo(wor);
                        const float ya = fo * rstd * ngv[j] * fsilu(fog);
                        const float yb = fys * fsigmoid((DBG_NO_ACC ? 0.f : av[j]) + bbv[j]);
                        res[j] = (DBG_NO_YA ? 0.f : fsigmoid(fga) * ya) + (DBG_NO_YB ? 0.f : (DBG_NO_GB ? 0.5f : fsigmoid(fgb)) * yb);
                    }
                    int w0 = 0, w1 = 0;
                    w0 = __builtin_amdgcn_cvt_pk_fp8_f32(res[0] * MG_SCALE, res[1] * MG_SCALE, w0, false); w0 = __builtin_amdgcn_cvt_pk_fp8_f32(res[2] * MG_SCALE, res[3] * MG_SCALE, w0, true);
                    w1 = __builtin_amdgcn_cvt_pk_fp8_f32(res[4] * MG_SCALE, res[5] * MG_SCALE, w1, false); w1 = __builtin_amdgcn_cvt_pk_fp8_f32(res[6] * MG_SCALE, res[7] * MG_SCALE, w1, true);
                    *(u32x2*)((unsigned char*)O + (size_t)row * D + c) = (u32x2){(unsigned)w0, (unsigned)w1};
                }
        }
    }
};
}

#define XB_TMO      128
#define XB_XCNT(j)  (256  + 64 * (j))
#define XB_XSUB(j)  (1280 + 64 * (j))
#define XB_XGEN(j)  (2304 + 64 * (j))
#define XB_TOP      3328
#define XB_TOPGEN   3392
#define XCD_BAR_WORDS 3456
#define XB_SPIN_CAP (1u << 25)
__device__ __forceinline__ unsigned xb_ld(unsigned* p)              { return __hip_atomic_load(p, __ATOMIC_RELAXED, __HIP_MEMORY_SCOPE_AGENT); }
__device__ __forceinline__ unsigned xb_add(unsigned* p, unsigned v) { return __hip_atomic_fetch_add(p, v, __ATOMIC_RELAXED, __HIP_MEMORY_SCOPE_AGENT); }
__device__ __forceinline__ unsigned xb_xcc_id() { return (unsigned)__builtin_amdgcn_s_getreg((3 << 11) | 20) & 0xFu; }
#define XB_SPIN(cond, bar) do { unsigned _sp = 0; while (cond) { __builtin_amdgcn_s_sleep(1); \
    if ((++_sp & 255u) == 0u) { if (xb_ld(&(bar)[XB_TMO])) break; if (_sp > XB_SPIN_CAP) { atomicAdd(&(bar)[XB_TMO], 1u); break; } } } } while (0)
struct XcdBarrier { unsigned* bar; unsigned x; volatile LAS unsigned* st; };
__device__ __forceinline__ XcdBarrier xcd_barrier_post(unsigned* bar, volatile LAS unsigned* st) {
    XcdBarrier b; b.bar = bar; b.x = xb_xcc_id(); b.st = st;
    if (threadIdx.x == 0) (void)xb_add(&bar[XB_XCNT(b.x)], 1u);
    return b;
}
__device__ __forceinline__ void xcd_barrier_complete(unsigned* bar, unsigned x, unsigned& nloc, unsigned& nx) {
    const unsigned G = gridDim.x * gridDim.y * gridDim.z;
    unsigned sum, cnt, mine, sp = 0u;
    for (;;) {
        sum = 0u; cnt = 0u; mine = 0u;
#pragma unroll
        for (unsigned j = 0; j < 16; ++j) { const unsigned c = xb_ld(&bar[XB_XCNT(j)]); sum += c; cnt += (c > 0u) ? 1u : 0u; mine = (j == x) ? c : mine; }
        if (sum == G) break;
        __builtin_amdgcn_s_sleep(1);
        if ((++sp & 255u) == 0u) { if (xb_ld(&bar[XB_TMO])) break; if (sp > XB_SPIN_CAP) { atomicAdd(&bar[XB_TMO], 1u); break; } }
    }
    nloc = mine > 0u ? mine : 1u; nx = cnt > 0u ? cnt : 1u;
}
__device__ __forceinline__ void xcd_barrier(const XcdBarrier& b) {
    asm volatile("s_waitcnt vmcnt(0)" ::: "memory");
    __syncthreads();
    if (threadIdx.x == 0) {
        unsigned* bar = b.bar;
        __builtin_amdgcn_s_waitcnt(0);
        unsigned nloc = b.st[0], nx = b.st[1];
        if (nloc == 0u) { xcd_barrier_complete(bar, b.x, nloc, nx); b.st[0] = nloc; b.st[1] = nx; }
        const unsigned old = xb_add(&bar[XB_XSUB(b.x)], 1u);
        const unsigned gen = old / nloc;
        if (old + 1u == (gen + 1u) * nloc) {
            __builtin_amdgcn_fence(__ATOMIC_RELEASE, "agent");
            asm volatile("s_waitcnt vmcnt(0)" ::: "memory");
            const unsigned og = xb_add(&bar[XB_TOP], 1u);
            const unsigned tg = og / nx;
            if (og + 1u == (tg + 1u) * nx) xb_add(&bar[XB_TOPGEN], 1u);
            else XB_SPIN(xb_ld(&bar[XB_TOPGEN]) == tg, bar);
            __builtin_amdgcn_fence(__ATOMIC_ACQUIRE, "agent");
            xb_add(&bar[XB_XGEN(b.x)], 1u);
            asm volatile("s_waitcnt vmcnt(0)" ::: "memory");
        } else {
            XB_SPIN(xb_ld(&bar[XB_XGEN(b.x)]) == gen, bar);
            __builtin_amdgcn_fence(__ATOMIC_ACQUIRE, "agent");
            asm volatile("s_waitcnt vmcnt(0)" ::: "memory");
        }
    }
    __syncthreads();
}

struct KP { const float* in[25]; float* out; unsigned char* ws; int gp_lo, gp_hi; };
enum { I_X = 0, I_C, I_ADAW, I_ADAB, I_N1G, I_N2G, I_WIN, I_LBL, I_HNG, I_ARE, I_AIM, I_LDT, I_BRE, I_BIM, I_CRE, I_CIM, I_S5D, I_GLUW, I_GLUB, I_WOUT, I_WQ, I_SUBK, I_PU, I_PV, I_FG };

typedef const KP __attribute__((address_space(4)))* kp_cptr;
__device__ __forceinline__ KP load_kp() {
#if defined(__HIP_DEVICE_COMPILE__)
    unsigned long long a = (unsigned long long)__builtin_amdgcn_kernarg_segment_ptr(); asm volatile("" : "+s"(a)); return *(kp_cptr)a;
#else
    return KP{};
#endif
}

__device__ __forceinline__ void phase_setup(const KP& p, LAS unsigned char* lds, int G) {
    const int tid = opaque_tid();
    {
        LAS float* cact = (LAS float*)lds;
        for (int it = blockIdx.x; it < 4 * 48; it += G) {
            for (int i = tid; i < 32 * 1024; i += 512) cact[i] = fsilu(p.in[I_C][i]);
            __syncthreads();
            const int l = it / 48, cb = it % 48, col = cb * 128 + (tid & 127), bg = tid >> 7;
            const float* W = p.in[I_ADAW] + (size_t)l * D * NMODC + col;
            float acc[8];
#pragma unroll
            for (int j = 0; j < 8; ++j) acc[j] = 0.f;
            for (int k4 = 0; k4 < 256; ++k4) {
                const float w0 = W[(size_t)(4 * k4 + 0) * NMODC], w1 = W[(size_t)(4 * k4 + 1) * NMODC], w2 = W[(size_t)(4 * k4 + 2) * NMODC], w3 = W[(size_t)(4 * k4 + 3) * NMODC];
#pragma unroll
                for (int j = 0; j < 8; ++j) { const f32x4 c4 = *(const LAS f32x4*)(cact + (8 * bg + j) * 1024 + 4 * k4); acc[j] += c4[0] * w0 + c4[1] * w1 + c4[2] * w2 + c4[3] * w3; }
            }
            float* MOD = (float*)(p.ws + WS_MOD);
            const float bias = p.in[I_ADAB][l * NMODC + col];
#pragma unroll
            for (int j = 0; j < 8; ++j) MOD[((size_t)l * 32 + 8 * bg + j) * NMODC + col] = acc[j] + bias;
            __syncthreads();
        }
    }
    const int gtid = blockIdx.x * 512 + tid;
    if (gtid < 1024) {
        const float* lg = p.in[I_LBL]; float v[4], mx = -1e30f;
#pragma unroll
        for (int l = 0; l < 4; ++l) { v[l] = lg[l * 1024 + gtid]; mx = fmaxf(mx, v[l]); }
        float s = 0.f;
#pragma unroll
        for (int l = 0; l < 4; ++l) { v[l] = __expf(v[l] - mx); s += v[l]; }
        float* LB = (float*)(p.ws + WS_LB); float cum = 0.f; const float first = v[0] / s;
#pragma unroll
        for (int l = 0; l < 4; ++l) { cum += v[l] / s; LB[l * 1024 + gtid] = (l == 0) ? 0.f : (cum - first); }
    }
    if (gtid >= 1024 && gtid < 1024 + 16384) {
        const int id = gtid - 1024, lg = id >> 6, pp = id & 63;
        const float a_re = p.in[I_ARE][id], a_im = p.in[I_AIM][id];
        const float step = expf(p.in[I_LDT][lg]);
        const float mag = expf(step * a_re), ang = step * a_im;
        const float ab_re = mag * cosf(ang), ab_im = mag * sinf(ang);
        const float den = a_re * a_re + a_im * a_im;
        const float z_re = ((ab_re - 1.0f) * a_re + ab_im * a_im) / den;
        const float z_im = (ab_im * a_re - (ab_re - 1.0f) * a_im) / den;
        float* ABAR = (float*)(p.ws + WS_ABAR); ABAR[2 * id] = ab_re; ABAR[2 * id + 1] = ab_im;
        bf16_t* BOP = (bf16_t*)(p.ws + WS_BOP); bf16_t* COP = (bf16_t*)(p.ws + WS_COP);
        const float* bre = p.in[I_BRE] + (size_t)id * 16; const float* bim = p.in[I_BIM] + (size_t)id * 16;
#pragma unroll
        for (int c = 0; c < 16; ++c) {
            const float br = bre[c], bi = bim[c];
            const float rr = z_re * br - z_im * bi, ii = z_re * bi + z_im * br;
            BOP[((size_t)lg * 128 + 2 * pp) * 16 + c] = (bf16_t)(pk2(rr, 0.f) & 0xffffu);
            BOP[((size_t)lg * 128 + 2 * pp + 1) * 16 + c] = (bf16_t)(pk2(ii, 0.f) & 0xffffu);
            const float cr = p.in[I_CRE][((size_t)lg * 16 + c) * 64 + pp], ci = p.in[I_CIM][((size_t)lg * 16 + c) * 64 + pp];
            COP[((size_t)lg * 16 + c) * 128 + 2 * pp] = (bf16_t)(pk2(cr, 0.f) & 0xffffu);
            COP[((size_t)lg * 16 + c) * 128 + 2 * pp + 1] = (bf16_t)(pk2(-ci, 0.f) & 0xffffu);
        }
    }
}

__device__ __forceinline__ void transpose_item(const float* W, int K, int N, bf16_t* WT, LAS float* scr, int item, int lane) {
    const int nblk = N / 32, kb = item / nblk, nb = item % nblk, k0 = 64 * kb, n0 = 32 * nb;
#pragma unroll 8
    for (int i = 0; i < 32; ++i) { const int kk = 2 * i + (lane >> 5); scr[kk * 33 + (lane & 31)] = W[(size_t)(k0 + kk) * N + n0 + (lane & 31)]; }
    LDS_WAIT();
    const int c = lane & 7;
#pragma unroll
    for (int j = 0; j < 4; ++j) { const int n = (lane >> 3) + 8 * j; const LAS float* s = scr + (8 * c) * 33 + n;
        u32x4 o; o.x = pk2(s[0 * 33], s[1 * 33]); o.y = pk2(s[2 * 33], s[3 * 33]); o.z = pk2(s[4 * 33], s[5 * 33]); o.w = pk2(s[6 * 33], s[7 * 33]);
        *(u32x4*)(WT + (size_t)(n0 + n) * K + k0 + 8 * c) = o; }
    LDS_WAIT();
}
__device__ __forceinline__ void cvt_f32_fp8(const float* src, unsigned char* dst, size_t n4, size_t gtid, size_t nthr, float scale) {
    for (size_t i = gtid; i < n4; i += nthr) { const f32x4 v = ((const f32x4*)src)[i] * scale; int w = 0;
        w = __builtin_amdgcn_cvt_pk_fp8_f32(v[0], v[1], w, false); w = __builtin_amdgcn_cvt_pk_fp8_f32(v[2], v[3], w, true); ((unsigned*)dst)[i] = (unsigned)w; }
}
__device__ __forceinline__ void cvt_f32_fp8_sliced(const float* src, unsigned char* dst, size_t gtid, size_t nthr, float scale) {
    for (size_t i = gtid; i < (size_t)16384 * 64; i += nthr) {
        const size_t e = i >> 6; const int sl = (int)(i & 63) >> 3, c = (int)(i & 7);
        const f32x4* sp = (const f32x4*)(src + e * 1024 + sl * 128 + c * 16); u32x4 o;
#pragma unroll
        for (int q = 0; q < 4; ++q) { const f32x4 v = sp[q] * scale; int w = 0; w = __builtin_amdgcn_cvt_pk_fp8_f32(v[0], v[1], w, false); w = __builtin_amdgcn_cvt_pk_fp8_f32(v[2], v[3], w, true); o[q] = (unsigned)w; }
        *(u32x4*)(dst + ((size_t)sl * 16384 + e) * 128 + c * 16) = o;
    }
}
__device__ __forceinline__ void transpose_item_fp8(const float* W, int K, int N, unsigned char* WT, LAS float* scr, int item, int lane, float scale) {
    const int nblk = N / 32, kb = item / nblk, nb = item % nblk, k0 = 64 * kb, n0 = 32 * nb;
#pragma unroll 8
    for (int i = 0; i < 32; ++i) { const int kk = 2 * i + (lane >> 5); scr[kk * 33 + (lane & 31)] = W[(size_t)(k0 + kk) * N + n0 + (lane & 31)]; }
    LDS_WAIT();
    const int c = lane & 7;
#pragma unroll
    for (int j = 0; j < 4; ++j) { const int n = (lane >> 3) + 8 * j; const LAS float* sp = scr + (8 * c) * 33 + n;
        int w0 = 0, w1 = 0;
        w0 = __builtin_amdgcn_cvt_pk_fp8_f32(sp[0 * 33] * scale, sp[1 * 33] * scale, w0, false); w0 = __builtin_amdgcn_cvt_pk_fp8_f32(sp[2 * 33] * scale, sp[3 * 33] * scale, w0, true);
        w1 = __builtin_amdgcn_cvt_pk_fp8_f32(sp[4 * 33] * scale, sp[5 * 33] * scale, w1, false); w1 = __builtin_amdgcn_cvt_pk_fp8_f32(sp[6 * 33] * scale, sp[7 * 33] * scale, w1, true);
        *(u32x2*)(WT + (size_t)(n0 + n) * K + k0 + 8 * c) = (u32x2){(unsigned)w0, (unsigned)w1}; }
    LDS_WAIT();
}
__device__ __forceinline__ void cvt_f32_bf16(const float* src, bf16_t* dst, size_t n4, size_t gtid, size_t nthr) {
    for (size_t i = gtid; i < n4; i += nthr) { const f32x4 v = ((const f32x4*)src)[i]; u32x2 o; o.x = pk2(v[0], v[1]); o.y = pk2(v[2], v[3]); ((u32x2*)dst)[i] = o; }
}
template <bool F8OUT, bool XBF>
__device__ __forceinline__ void norm_rows(const float* xsrc, bf16_t* hdst, const float* gain, const float* mod_l, int sh_off, int sc_off, int gw, int ngw, int lane) {
    for (int r0 = gw * 4; r0 < M; r0 += ngw * 4) {
        const int b = r0 >> 11;
        f32x4 v[4][4]; float ss[4];
#pragma unroll
        for (int i = 0; i < 4; ++i) {
            if constexpr (XBF) { const u32x2* xr = (const u32x2*)((const bf16_t*)xsrc + (size_t)(r0 + i) * D) + lane;
#pragma unroll
                for (int j = 0; j < 4; ++j) { const u32x2 xw = xr[64 * j]; v[i][j] = (f32x4){bflo(xw[0]), bfhi(xw[0]), bflo(xw[1]), bfhi(xw[1])}; } }
            else { const f32x4* xr = (const f32x4*)(xsrc + (size_t)(r0 + i) * D) + lane;
#pragma unroll
                for (int j = 0; j < 4; ++j) v[i][j] = xr[64 * j]; } }
#pragma unroll
        for (int i = 0; i < 4; ++i) { float t = 0.f;
#pragma unroll
            for (int j = 0; j < 4; ++j) t += (v[i][j][0] * v[i][j][0] + v[i][j][1] * v[i][j][1]) + (v[i][j][2] * v[i][j][2] + v[i][j][3] * v[i][j][3]);
            ss[i] = t; }
#pragma unroll
        for (int o = 1; o < 64; o <<= 1) {
#pragma unroll
            for (int i = 0; i < 4; ++i) ss[i] += __shfl_xor(ss[i], o); }
        const float* mb = mod_l + (size_t)b * NMODC;
#pragma unroll
        for (int j = 0; j < 4; ++j) { const int col = 256 * j + 4 * lane;
            const f32x4 g4 = *(const f32x4*)(gain + col), sc = *(const f32x4*)(mb + sc_off + col), sh = *(const f32x4*)(mb + sh_off + col);
            const f32x4 gs = g4 * (sc + 1.0f);
#pragma unroll
            for (int i = 0; i < 4; ++i) { const float rstd = __builtin_amdgcn_rsqf(ss[i] * (1.0f / D) + EPS);
                const f32x4 h = v[i][j] * rstd * gs + sh;
                if constexpr (F8OUT) { int w8 = 0; w8 = __builtin_amdgcn_cvt_pk_fp8_f32(h[0] * HIN_SCALE, h[1] * HIN_SCALE, w8, false); w8 = __builtin_amdgcn_cvt_pk_fp8_f32(h[2] * HIN_SCALE, h[3] * HIN_SCALE, w8, true);
                    *(unsigned*)((unsigned char*)hdst + (size_t)(r0 + i) * D + col) = (unsigned)w8; }
                else { u32x2 o; o.x = pk2(h[0], h[1]); o.y = pk2(h[2], h[3]); *(u32x2*)(hdst + (size_t)(r0 + i) * D + col) = o; } } }
    }
}
template <bool XBF>
__device__ __forceinline__ void resid_norm_rows(const float* xsrc, bf16_t* xdst, const bf16_t* delta, bf16_t* hdst, const float* gain, const float* mod_l, int gw, int ngw, int lane) {
    for (int r0 = gw * 4; r0 < M; r0 += ngw * 4) {
        const int b = r0 >> 11; const float* mb = mod_l + (size_t)b * NMODC;
        f32x4 v[4][4]; u32x2 dl[4][4]; float ss[4];
#pragma unroll
        for (int i = 0; i < 4; ++i) { const u32x2* dp = (const u32x2*)(delta + (size_t)(r0 + i) * D) + lane;
            if constexpr (XBF) { const u32x2* xr = (const u32x2*)((const bf16_t*)xsrc + (size_t)(r0 + i) * D) + lane;
#pragma unroll
                for (int j = 0; j < 4; ++j) { const u32x2 xw = xr[64 * j]; v[i][j] = (f32x4){bflo(xw[0]), bfhi(xw[0]), bflo(xw[1]), bfhi(xw[1])}; dl[i][j] = dp[64 * j]; } }
            else { const f32x4* xr = (const f32x4*)(xsrc + (size_t)(r0 + i) * D) + lane;
#pragma unroll
                for (int j = 0; j < 4; ++j) { v[i][j] = xr[64 * j]; dl[i][j] = dp[64 * j]; } } }
#pragma unroll
        for (int j = 0; j < 4; ++j) { const f32x4 g1 = *(const f32x4*)(mb + 2048 + 256 * j + 4 * lane);
#pragma unroll
            for (int i = 0; i < 4; ++i) { const f32x4 dv = {bflo(dl[i][j][0]), bfhi(dl[i][j][0]), bflo(dl[i][j][1]), bfhi(dl[i][j][1])}; v[i][j] = v[i][j] + g1 * dv;
                ((u32x2*)(xdst + (size_t)(r0 + i) * D) + lane)[64 * j] = (u32x2){pk2(v[i][j][0], v[i][j][1]), pk2(v[i][j][2], v[i][j][3])}; } }
#pragma unroll
        for (int i = 0; i < 4; ++i) { float t = 0.f;
#pragma unroll
            for (int j = 0; j < 4; ++j) t += (v[i][j][0] * v[i][j][0] + v[i][j][1] * v[i][j][1]) + (v[i][j][2] * v[i][j][2] + v[i][j][3] * v[i][j][3]);
            ss[i] = t; }
#pragma unroll
        for (int o = 1; o < 64; o <<= 1) {
#pragma unroll
            for (int i = 0; i < 4; ++i) ss[i] += __shfl_xor(ss[i], o); }
#pragma unroll
        for (int j = 0; j < 4; ++j) { const int col = 256 * j + 4 * lane;
            const f32x4 g4 = *(const f32x4*)(gain + col), sc = *(const f32x4*)(mb + 4096 + col), sh = *(const f32x4*)(mb + 3072 + col);
            const f32x4 gs = g4 * (sc + 1.0f);
#pragma unroll
            for (int i = 0; i < 4; ++i) { const float rstd = __builtin_amdgcn_rsqf(ss[i] * (1.0f / D) + EPS);
                const f32x4 h = v[i][j] * rstd * gs + sh; u32x2 o; o.x = pk2(h[0], h[1]); o.y = pk2(h[2], h[3]); *(u32x2*)(hdst + (size_t)(r0 + i) * D + col) = o; } }
    }
}
__device__ __forceinline__ void phase_conv_norm1(const KP& p, LAS unsigned char* lds, int l, int G) {
    const int tid = opaque_tid(), lane = tid & 63, wave = __builtin_amdgcn_readfirstlane(tid >> 6);
    const int gw = blockIdx.x * 8 + wave, ngw = G * 8;
    LAS float* scr = (LAS float*)(lds + wave * 8448);
    constexpr int I_IN = 16 * (INC / 32), I_G = 16 * 32, I_O = 16 * 32, I_Q = 16 * 64, NIT = I_IN + I_G + I_O + I_Q;
    for (int it = gw; it < NIT; it += ngw) {
        int r = it;
        if (r < I_IN) { transpose_item_fp8(p.in[I_WIN] + (size_t)l * D * INC, D, INC, p.ws + WS_WIN, scr, r, lane, WIN_SCALE); continue; } r -= I_IN;
        if (r < I_G) { transpose_item(p.in[I_GLUW] + (size_t)l * D * D, D, D, (bf16_t*)(p.ws + WS_WGLU), scr, r, lane); continue; } r -= I_G;
        if (r < I_O) { transpose_item_fp8(p.in[I_WOUT] + (size_t)l * D * D, D, D, p.ws + WS_WOUT, scr, r, lane, WO_SCALE); continue; } r -= I_O;
        transpose_item(p.in[I_WQ] + (size_t)l * D * 2048, D, 2048, (bf16_t*)(p.ws + WS_WQ), scr, r, lane);
    }
    const size_t gtid = (size_t)blockIdx.x * 512 + tid, nthr = (size_t)G * 512;
    cvt_f32_bf16(p.in[I_SUBK] + (size_t)l * 262144, (bf16_t*)(p.ws + WS_KEYS), 262144 / 4, gtid, nthr);
    if (l == 0) {
        cvt_f32_fp8_sliced(p.in[I_PU], p.ws + WS_U, gtid, nthr, U_SCALE);
        cvt_f32_fp8_sliced(p.in[I_PV], p.ws + WS_V, gtid, nthr, V_SCALE); }
    if (l == 0) norm_rows<true, false>(p.in[I_X], (bf16_t*)(p.ws + WS_H), p.in[I_N1G] + l * D, (const float*)(p.ws + WS_MOD) + (size_t)l * 32 * NMODC, 0, 1024, gw, ngw, lane);
    else norm_rows<true, true>(p.out, (bf16_t*)(p.ws + WS_H), p.in[I_N1G] + l * D, (const float*)(p.ws + WS_MOD) + (size_t)l * 32 * NMODC, 0, 1024, gw, ngw, lane);
}

__device__ __forceinline__ void phase_hgrn2(const KP& p, LAS unsigned char* lds, int l, int G) {
    const int tid = opaque_tid(), lane = tid & 63, w = __builtin_amdgcn_readfirstlane(tid >> 6), fr = lane & 15, g = lane >> 4;
    constexpr int QS = 272, TS = 72;
    constexpr int OFF_QT = 0, OFF_KH = 8704, OFF_KT = 17408, OFF_VT = 26624, OFF_EREF = 35840, OFF_ELR = 36352, OFF_SEG = 36864, PBUF = 40960;
    const bf16_t* PA = (const bf16_t*)(p.ws + WS_R0);
    bf16_t* ORAW = (bf16_t*)(p.ws + WS_OR);
    const float* LB = (const float*)(p.ws + WS_LB) + l * 1024;
    for (int unit = blockIdx.x; unit < 256; unit += G) {
        const int b = unit >> 3, h = unit & 7, k0 = 2 * lane;
        const float lb0 = LB[h * 128 + k0], lb1 = LB[h * 128 + k0 + 1];
        const float om0 = 1.0f - lb0, om1 = 1.0f - lb1;
        f32x4 S[8];
#pragma unroll
        for (int kt = 0; kt < 8; ++kt) S[kt] = (f32x4){0.f, 0.f, 0.f, 0.f};
        unsigned rq[4], rf[4], rv[4];
        {
            const bf16_t* base = PA + ((size_t)b * SEQ + 4 * w) * 3072 + h * 128 + k0;
#pragma unroll
            for (int i = 0; i < 4; ++i) { rq[i] = *(const unsigned*)(base + (size_t)i * 3072); rf[i] = *(const unsigned*)(base + (size_t)i * 3072 + 1024); rv[i] = *(const unsigned*)(base + (size_t)i * 3072 + 2048); }
        }
        for (int c = 0; c < 64; ++c) {
            LAS unsigned char* base = lds + (c & 1) * PBUF;
            float cs0[4], cs1[4], qv0[4], qv1[4], kv0[4], kv1[4];
            float run0 = 0.f, run1 = 0.f;
#pragma unroll
            for (int i = 0; i < 4; ++i) {
                const float fp0 = bflo(rf[i]), fp1 = bfhi(rf[i]);
                const float s0 = fsigmoid(fp0), s1 = fsigmoid(fp1);
                run0 += __logf(lb0 + om0 * s0); run1 += __logf(lb1 + om1 * s1);
                cs0[i] = run0; cs1[i] = run1;
                kv0[i] = om0 * (1.0f - s0); kv1[i] = om1 * (1.0f - s1);
                qv0[i] = fsilu(bflo(rq[i])); qv1[i] = fsilu(bfhi(rq[i]));
            }
            *(LAS f32x2*)(base + OFF_SEG + (w * 128 + k0) * 4) = (f32x2){run0, run1};
            __syncthreads();
            float off0 = 0.f, off1 = 0.f, ref0 = 0.f, ref1 = 0.f, all0 = 0.f, all1 = 0.f;
#pragma unroll
            for (int s = 0; s < 8; ++s) { const f32x2 t2 = *(const LAS f32x2*)(base + OFF_SEG + (s * 128 + k0) * 4);
                if (s < w) { off0 += t2[0]; off1 += t2[1]; }
                if (s < 4) { ref0 += t2[0]; ref1 += t2[1]; }
                all0 += t2[0]; all1 += t2[1]; }
            float kh0[4], kh1[4];
#pragma unroll
            for (int i = 0; i < 4; ++i) {
                const float b0 = off0 + cs0[i], b1 = off1 + cs1[i];
                const float q0 = qv0[i] * __expf(b0 - ref0), q1 = qv1[i] * __expf(b1 - ref1);
                kh0[i] = kv0[i] * __expf(ref0 - b0); kh1[i] = kv1[i] * __expf(ref1 - b1);
                const int t = 4 * w + i;
                *(LAS unsigned*)(base + OFF_QT + t * QS + k0 * 2) = pk2(q0, q1);
                *(LAS unsigned*)(base + OFF_KH + t * QS + k0 * 2) = pk2(kh0[i], kh1[i]);
            }
            *(LAS u32x2*)(base + OFF_KT + k0 * TS + 8 * w) = (u32x2){pk2(kh0[0], kh0[1]), pk2(kh0[2], kh0[3])};
            *(LAS u32x2*)(base + OFF_KT + (k0 + 1) * TS + 8 * w) = (u32x2){pk2(kh1[0], kh1[1]), pk2(kh1[2], kh1[3])};
            *(LAS u32x2*)(base + OFF_VT + k0 * TS + 8 * w) = (u32x2){(rv[0] & 0xffffu) | (rv[1] << 16), (rv[2] & 0xffffu) | (rv[3] << 16)};
            *(LAS u32x2*)(base + OFF_VT + (k0 + 1) * TS + 8 * w) = (u32x2){(rv[0] >> 16) | (rv[1] & 0xffff0000u), (rv[2] >> 16) | (rv[3] & 0xffff0000u)};
            if (w == 0) {
                *(LAS f32x2*)(base + OFF_EREF + k0 * 4) = (f32x2){__expf(ref0), __expf(ref1)};
                *(LAS f32x2*)(base + OFF_ELR + k0 * 4) = (f32x2){__expf(all0 - ref0), __expf(all1 - ref1)};
            }
            __syncthreads();
            if (c + 1 < 64) {
                const bf16_t* nb = PA + ((size_t)b * SEQ + (c + 1) * 32 + 4 * w) * 3072 + h * 128 + k0;
#pragma unroll
                for (int i = 0; i < 4; ++i) { rq[i] = *(const unsigned*)(nb + (size_t)i * 3072); rf[i] = *(const unsigned*)(nb + (size_t)i * 3072 + 1024); rv[i] = *(const unsigned*)(nb + (size_t)i * 3072 + 2048); }
            }
            bf16x8 qf[2][4], kf[2][4];
#pragma unroll
            for (int tt = 0; tt < 2; ++tt)
#pragma unroll
                for (int m = 0; m < 4; ++m) {
                    const LAS unsigned char* pq = base + OFF_QT + (16 * tt + fr) * QS + (32 * m + 4 * g) * 2;
                    const u32x2 lo = *(const LAS u32x2*)pq, hi = *(const LAS u32x2*)(pq + 32);
                    qf[tt][m] = __builtin_bit_cast(bf16x8, (u32x4){lo[0], lo[1], hi[0], hi[1]});
                    const LAS unsigned char* pk = base + OFF_KH + (16 * tt + fr) * QS + (32 * m + 4 * g) * 2;
                    const u32x2 lo2 = *(const LAS u32x2*)pk, hi2 = *(const LAS u32x2*)(pk + 32);
                    kf[tt][m] = __builtin_bit_cast(bf16x8, (u32x4){lo2[0], lo2[1], hi2[0], hi2[1]});
                }
            f32x4 PT00 = {0.f, 0.f, 0.f, 0.f}, PT01 = {0.f, 0.f, 0.f, 0.f}, PT11 = {0.f, 0.f, 0.f, 0.f};
#pragma unroll
            for (int m = 0; m < 4; ++m) {
                PT00 = __builtin_amdgcn_mfma_f32_16x16x32_bf16(kf[0][m], qf[0][m], PT00, 0, 0, 0);
                PT01 = __builtin_amdgcn_mfma_f32_16x16x32_bf16(kf[0][m], qf[1][m], PT01, 0, 0, 0);
                PT11 = __builtin_amdgcn_mfma_f32_16x16x32_bf16(kf[1][m], qf[1][m], PT11, 0, 0, 0);
            }
#pragma unroll
            for (int r = 0; r < 4; ++r) { if (4 * g + r > fr) { PT00[r] = 0.f; PT11[r] = 0.f; } }
            const bf16x8 pa0 = __builtin_bit_cast(bf16x8, (u32x4){pk2(PT00[0], PT00[1]), pk2(PT00[2], PT00[3]), 0u, 0u});
            const bf16x8 pa1 = __builtin_bit_cast(bf16x8, (u32x4){pk2(PT01[0], PT01[1]), pk2(PT01[2], PT01[3]), pk2(PT11[0], PT11[1]), pk2(PT11[2], PT11[3])});
            const LAS unsigned char* vrow = base + OFF_VT + (16 * w + fr) * TS;
            const u32x2 vpa = *(const LAS u32x2*)(vrow + 8 * g), vpb = *(const LAS u32x2*)(vrow + 32 + 8 * g);
            const u32x2 vna = *(const LAS u32x2*)(vrow + 16 * g), vnb = *(const LAS u32x2*)(vrow + 16 * g + 8);
            const bf16x8 vperm = __builtin_bit_cast(bf16x8, (u32x4){vpa[0], vpa[1], vpb[0], vpb[1]});
            const bf16x8 vnat = __builtin_bit_cast(bf16x8, (u32x4){vna[0], vna[1], vnb[0], vnb[1]});
#pragma unroll
            for (int kt = 0; kt < 8; ++kt) { const f32x4 e = *(const LAS f32x4*)(base + OFF_EREF + (16 * kt + 4 * g) * 4); S[kt] = S[kt] * e; }
            f32x4 O0 = {0.f, 0.f, 0.f, 0.f}, O1 = {0.f, 0.f, 0.f, 0.f};
#pragma unroll
            for (int m = 0; m < 4; ++m) {
                const bf16x8 sf = __builtin_bit_cast(bf16x8, (u32x4){pk2(S[2 * m][0], S[2 * m][1]), pk2(S[2 * m][2], S[2 * m][3]), pk2(S[2 * m + 1][0], S[2 * m + 1][1]), pk2(S[2 * m + 1][2], S[2 * m + 1][3])});
                O0 = __builtin_amdgcn_mfma_f32_16x16x32_bf16(qf[0][m], sf, O0, 0, 0, 0);
                O1 = __builtin_amdgcn_mfma_f32_16x16x32_bf16(qf[1][m], sf, O1, 0, 0, 0);
            }
            O0 = __builtin_amdgcn_mfma_f32_16x16x32_bf16(pa0, vperm, O0, 0, 0, 0);
            O1 = __builtin_amdgcn_mfma_f32_16x16x32_bf16(pa1, vperm, O1, 0, 0, 0);
#pragma unroll
            for (int kt = 0; kt < 8; ++kt) {
                const LAS unsigned char* krow = base + OFF_KT + (16 * kt + fr) * TS + 16 * g;
                const u32x2 ka = *(const LAS u32x2*)krow, kb = *(const LAS u32x2*)(krow + 8);
                const bf16x8 ktf = __builtin_bit_cast(bf16x8, (u32x4){ka[0], ka[1], kb[0], kb[1]});
                S[kt] = __builtin_amdgcn_mfma_f32_16x16x32_bf16(ktf, vnat, S[kt], 0, 0, 0);
            }
#pragma unroll
            for (int kt = 0; kt < 8; ++kt) { const f32x4 e = *(const LAS f32x4*)(base + OFF_ELR + (16 * kt + 4 * g) * 4); S[kt] = S[kt] * e; }
            bf16_t* orow = ORAW + ((size_t)b * SEQ + c * 32 + 4 * g) * D + h * 128 + 16 * w + fr;
#pragma unroll
            for (int r = 0; r < 4; ++r) { orow[(size_t)r * D] = (bf16_t)(pk2(O0[r], 0.f) & 0xffffu); orow[(size_t)(16 + r) * D] = (bf16_t)(pk2(O1[r], 0.f) & 0xffffu); }
        }
        __syncthreads();
    }
}

__device__ __forceinline__ void phase_s5(const KP& p, LAS unsigned char* lds, int l, int G, size_t ys_off) {
    const int tid = opaque_tid(), lane = tid & 63, w = __builtin_amdgcn_readfirstlane(tid >> 6), fr = lane & 15, g = lane >> 4;
    const int gw = blockIdx.x * 8 + w, ngw = G * 8;
    constexpr int BUS = 132;
    LAS float* BU = (LAS float*)(lds + w * 16896);
    LAS unsigned char* XI = (LAS unsigned char*)BU;
    const bf16_t* PB = (const bf16_t*)(p.ws + WS_R0);
    const bf16x8 zero8 = {0, 0, 0, 0, 0, 0, 0, 0};
    const bf16_t* ORAWs = (const bf16_t*)(p.ws + WS_OR); float* SSQs = (float*)(p.ws + WS_SSQ);
    for (int unit = gw; unit < BATCH * 64; unit += ngw) {
        const int b = unit >> 6, grp = unit & 63, lg = l * 64 + grp;
        const bf16_t* BOP = (const bf16_t*)(p.ws + WS_BOP) + (size_t)lg * 128 * 16;
        const bf16_t* COP = (const bf16_t*)(p.ws + WS_COP) + (size_t)lg * 16 * 128;
        bf16x8 bfrag[8], cfrag[4], dfrag;
#pragma unroll
        for (int nt = 0; nt < 8; ++nt) bfrag[nt] = (g < 2) ? *(const bf16x8*)(BOP + (size_t)(16 * nt + fr) * 16 + 8 * g) : zero8;
#pragma unroll
        for (int ks = 0; ks < 4; ++ks) cfrag[ks] = DBG_S5_NOSSM ? zero8 : *(const bf16x8*)(COP + (size_t)fr * 128 + 32 * ks + 8 * g);
        {
            const unsigned dbits = pk2(p.in[I_S5D][l * 1024 + grp * 16 + fr], 0.f) & 0xffffu;
#pragma unroll
            for (int j = 0; j < 8; ++j) dfrag[j] = (g < 2 && (8 * g + j) == fr) ? (short)dbits : (short)0;
        }
        const float ar = ((const float*)(p.ws + WS_ABAR))[2 * ((size_t)lg * 64 + lane)], ai = ((const float*)(p.ws + WS_ABAR))[2 * ((size_t)lg * 64 + lane) + 1];
        const float nai = -ai; float xr = 0.f, xi = 0.f; unsigned hBU = 0u, hXI = 0u, hY = 0u;
        const bf16_t* ub = PB + ((size_t)b * SEQ) * 4096 + 1024 + grp * 16;
        bf16_t* yb_ = (bf16_t*)(p.ws + ys_off) + ((size_t)b * SEQ) * D + grp * 16;
        bf16x8 unext[2];
#pragma unroll
        for (int tt = 0; tt < 2; ++tt) unext[tt] = (g < 2) ? *(const bf16x8*)(ub + (size_t)(16 * tt + fr) * 4096 + 8 * g) : zero8;
        const bool cvt_next = (l + 1 < DEPTH);
        const float* tsrc = ((lane < 32) ? p.in[I_PU] : p.in[I_PV]) + (size_t)(l + 1 < DEPTH ? l + 1 : l) * 16384 * 1024 + 4 * (lane & 31);
        unsigned char* tdst = p.ws + ((lane < 32) ? WS_U : WS_V) + (size_t)((l + 1) & 1) * TAB_BYTES + 4 * (lane & 31);
        const float tscale = (lane < 32) ? U_SCALE : V_SCALE;
        for (int t0 = 0; t0 < SEQ; t0 += 32) {
            const int item = unit * 64 + (t0 >> 5), te = item >> 3, tsl = item & 7;
            f32x4 tv = {0.f, 0.f, 0.f, 0.f}; if (cvt_next) tv = *(const f32x4*)(tsrc + (size_t)te * 1024 + tsl * 128);
            const bool ssq_it = ((t0 >> 5) & 1) == 0; const int srow = item >> 1;
            u32x4 sa = {0u, 0u, 0u, 0u}, sc2 = {0u, 0u, 0u, 0u};
            if (ssq_it) { sa = *(const u32x4*)(ORAWs + (size_t)srow * D + 8 * lane); sc2 = *(const u32x4*)(ORAWs + (size_t)srow * D + 512 + 8 * lane); }
            bf16x8 ufrag[2];
#pragma unroll
            for (int tt = 0; tt < 2; ++tt) { ufrag[tt] = unext[tt]; if (t0 + 32 < SEQ) unext[tt] = (g < 2) ? *(const bf16x8*)(ub + (size_t)(t0 + 32 + 16 * tt + fr) * 4096 + 8 * g) : zero8; }
#pragma unroll
            for (int tt = 0; tt < 2; ++tt)
#pragma unroll
                for (int nt = 0; nt < 8; ++nt) {
                    const f32x4 a = __builtin_amdgcn_mfma_f32_16x16x32_bf16(ufrag[tt], bfrag[nt], (f32x4){0.f, 0.f, 0.f, 0.f}, 0, 0, 0);
#pragma unroll
                    for (int r = 0; r < 4; ++r) BU[(16 * tt + 4 * g + r) * BUS + 16 * nt + fr] = a[r];
                }
            LDS_WAIT();
#pragma unroll
            for (int t = 0; t < 32; ++t) {
                const f32x2 bb = *(const LAS f32x2*)(BU + t * BUS + 2 * lane); hBU += __float_as_uint(bb[0]) * 3u + __float_as_uint(bb[1]);
                float t1, t2, nr, ni;
                asm("v_fma_f32 %0, %1, %2, %3" : "=v"(t1) : "v"(nai), "v"(xi), "v"(bb[0]));
                asm("v_fma_f32 %0, %1, %2, %3" : "=v"(t2) : "v"(ai), "v"(xr), "v"(bb[1]));
                asm("v_fma_f32 %0, %1, %2, %3" : "=v"(nr) : "v"(ar), "v"(xr), "v"(t1));
                asm("v_fma_f32 %0, %1, %2, %3" : "=v"(ni) : "v"(ar), "v"(xi), "v"(t2));
                xr = nr; xi = ni;
                { const unsigned pv = pk2(nr, ni); hXI += pv; *(LAS unsigned*)(XI + t * (BUS * 4) + lane * 4) = pv; }
            }
            LDS_WAIT();
#pragma unroll
            for (int tt = 0; tt < 2; ++tt) {
                f32x4 y = {0.f, 0.f, 0.f, 0.f};
#pragma unroll
                for (int ks = 0; ks < 4; ++ks) {
                    const bf16x8 xf = *(const LAS bf16x8*)(XI + (16 * tt + fr) * (BUS * 4) + (32 * ks + 8 * g) * 2);
                    y = __builtin_amdgcn_mfma_f32_16x16x32_bf16(xf, cfrag[ks], y, 0, 0, 0);
                }
                y = __builtin_amdgcn_mfma_f32_16x16x32_bf16(ufrag[tt], dfrag, y, 0, 0, 0);
#pragma unroll
                for (int r = 0; r < 4; ++r) { const unsigned yv = pk2(fgelu(y[r]), 0.f) & 0xffffu; hY += yv * (unsigned)(r + 1); yb_[(size_t)(t0 + 16 * tt + 4 * g + r) * D + fr] = (bf16_t)yv; }
            }
            LDS_WAIT();
            if (ssq_it) { float s0 = 0.f, s1 = 0.f;
#pragma unroll
                for (int j = 0; j < 4; ++j) { const float x0 = bflo(sa[j]), x1 = bfhi(sa[j]), y0 = bflo(sc2[j]), y1 = bfhi(sc2[j]); s0 += x0 * x0 + x1 * x1; s1 += y0 * y0 + y1 * y1; }
                { s0 = dpp_sum8(s0); s1 = dpp_sum8(s1);
                  s0 += __uint_as_float(__builtin_amdgcn_update_dpp(0, __float_as_uint(s0), 0x140, 0xF, 0xF, true)); s1 += __uint_as_float(__builtin_amdgcn_update_dpp(0, __float_as_uint(s1), 0x140, 0xF, 0xF, true)); }
                if (fr == 0) { SSQs[(size_t)srow * 8 + g] = s0; SSQs[(size_t)srow * 8 + 4 + g] = s1; } }
            if (cvt_next) { int w8 = 0; w8 = __builtin_amdgcn_cvt_pk_fp8_f32(tv[0] * tscale, tv[1] * tscale, w8, false); w8 = __builtin_amdgcn_cvt_pk_fp8_f32(tv[2] * tscale, tv[3] * tscale, w8, true);
                *(unsigned*)(tdst + ((size_t)tsl * 16384 + te) * 128) = (unsigned)w8; }
        }
        if (DBG_SELFCHECK) { for (int o = 1; o < 64; o <<= 1) { hBU += __shfl_xor((int)hBU, o); hXI += __shfl_xor((int)hXI, o); hY += __shfl_xor((int)hY, o); }
            unsigned* hs = (unsigned*)(p.ws + WS_CTL) + 65536 + (ys_off == WS_YS ? 0 : 8192) + unit * 4; unsigned hA = __float_as_uint(ar) * 7u + __float_as_uint(ai); for (int o = 1; o < 64; o <<= 1) hA += __shfl_xor((int)hA, o); if (lane == 0) { hs[0] = hBU; hs[1] = hXI; hs[2] = hA; } }
    }
}

__device__ __forceinline__ unsigned fkey(float f) { const unsigned u = __float_as_uint(f); return u ^ ((unsigned)((int)u >> 31) | 0x80000000u); }
__device__ __forceinline__ float kval(unsigned k) { const unsigned u = (k & 0x80000000u) ? (k ^ 0x80000000u) : ~k; return __uint_as_float(u); }
#define CE_DESC(a, b) do { const unsigned _mx = (a) > (b) ? (a) : (b), _mn = (a) > (b) ? (b) : (a); (a) = _mx; (b) = _mn; } while (0)
__device__ __forceinline__ void sort16_desc(unsigned (&a)[16]) {
#pragma unroll
    for (int kk = 1; kk <= 4; ++kk)
#pragma unroll
        for (int jj = kk - 1; jj >= 0; --jj)
#pragma unroll
            for (int i = 0; i < 16; ++i) { const int k = 1 << kk, j = 1 << jj, l2 = i ^ j;
                if (l2 > i) { if ((i & k) == 0) CE_DESC(a[i], a[l2]); else CE_DESC(a[l2], a[i]); } }
}
__device__ __forceinline__ void merge_top16(unsigned (&a)[16], const unsigned (&b)[16]) {
#pragma unroll
    for (int i = 0; i < 16; ++i) a[i] = a[i] > b[15 - i] ? a[i] : b[15 - i];
#pragma unroll
    for (int jj = 3; jj >= 0; --jj)
#pragma unroll
        for (int i = 0; i < 16; ++i) { const int j = 1 << jj, l2 = i ^ j; if (l2 > i) CE_DESC(a[i], a[l2]); }
}
__device__ __forceinline__ void phase_topk(const KP& p, LAS unsigned char* lds, int G) {
    const int tid = opaque_tid(), lane = tid & 63, w = __builtin_amdgcn_readfirstlane(tid >> 6), hh = lane >> 5;
    const int gw = blockIdx.x * 8 + w, ngw = G * 8;
    const bf16_t* Q = (const bf16_t*)(p.ws + WS_R0); const bf16_t* KEYS = (const bf16_t*)(p.ws + WS_KEYS);
    unsigned* SEL = (unsigned*)(p.ws + WS_SEL);
    LAS unsigned char* tab = lds + w * 2048 + lane * 32;
    const int CI[50] = {0,0,0,0,0,0,0,0,0,0,0,0,0,0,0,0, 1,1,1,1,1,1,1,1, 2,2,2,2,2, 3,3,3,3, 4,4,4, 5,5, 6,6, 7,7, 8,9,10,11,12,13,14,15};
    const int CJ[50] = {0,1,2,3,4,5,6,7,8,9,10,11,12,13,14,15, 0,1,2,3,4,5,6,7, 0,1,2,3,4, 0,1,2,3, 0,1,2, 0,1, 0,1, 0,1, 0,0,0,0,0,0,0,0};
    LAS unsigned char* kimg = lds + 16384;
    for (int h = 0; h < 8; ++h) {
      __syncthreads();
#pragma unroll
      for (int i = 0; i < 8; ++i) { const int ch = tid + 512 * i, row = ch >> 4, c16 = ch & 15;
          *(LAS u32x4*)(kimg + row * 272 + c16 * 16) = *(const u32x4*)(KEYS + (size_t)(h * 256 + row) * 128 + c16 * 8); }
      __syncthreads();
      for (int tg = gw; tg < 2048; tg += ngw) {
        const int t = tg * 32 + (lane & 31);
        unsigned top[2][16];
#pragma unroll
        for (int pp = 0; pp < 2; ++pp) {
            bf16x8 qf[8];
#pragma unroll
            for (int ks = 0; ks < 8; ++ks) qf[ks] = *(const bf16x8*)(Q + ((size_t)((((tg * 8 + h) * 2 + pp) * 8 + ks) * 64 + lane)) * 8);
            const LAS unsigned char* kb = kimg + (pp * 128 + (lane & 31)) * 272 + 16 * hh;
#pragma unroll
            for (int nt = 0; nt < 4; ++nt) {
                f32x16 acc;
#pragma unroll
                for (int i = 0; i < 16; ++i) acc[i] = 0.f;
#pragma unroll
                for (int ks = 0; ks < 8; ++ks) { const bf16x8 kf = *(const LAS bf16x8*)(kb + (32 * nt) * 272 + 32 * ks);
                    acc = __builtin_amdgcn_mfma_f32_32x32x16_bf16(kf, qf[ks], acc, 0, 0, 0); }
                unsigned ky[16];
#pragma unroll
                for (int r = 0; r < 16; ++r) ky[r] = (fkey(acc[r]) & ~127u) | (unsigned)(32 * nt + (r & 3) + 8 * (r >> 2)) | (unsigned)(4 * hh);
                sort16_desc(ky);
                if (nt == 0) {
#pragma unroll
                    for (int i = 0; i < 16; ++i) top[pp][i] = ky[i];
                } else merge_top16(top[pp], ky);
            }
            unsigned other[16];
#pragma unroll
            for (int i = 0; i < 16; ++i) { const u32x2 sw_ = __builtin_amdgcn_permlane32_swap(top[pp][i], top[pp][i], false, false); other[i] = hh ? sw_[0] : sw_[1]; }
            merge_top16(top[pp], other);
        }
        float sa[16], sb[16];
#pragma unroll
        for (int i = 0; i < 16; ++i) { sa[i] = kval(top[0][i] & ~127u); sb[i] = kval(top[1][i] & ~127u); }
        unsigned c0[16], c1[16];
#pragma unroll
        for (int s = 0; s < 32; ++s) {
            unsigned key = 0u;
            if (s < 25) {
                const float v0 = sa[CI[s]] + sb[CJ[s]], v1 = sa[CI[25 + s]] + sb[CJ[25 + s]];
                const unsigned k0 = (fkey(v0) & ~255u) | (unsigned)(CI[s] * 16 + CJ[s]), k1 = (fkey(v1) & ~255u) | (unsigned)(CI[25 + s] * 16 + CJ[25 + s]);
                key = hh ? k1 : k0;
            }
            if (s < 16) c0[s] = key; else c1[s - 16] = key;
        }
        sort16_desc(c0); sort16_desc(c1); merge_top16(c0, c1);
#pragma unroll
        for (int i = 0; i < 16; ++i) { const u32x2 sw_ = __builtin_amdgcn_permlane32_swap(c0[i], c0[i], false, false); c1[i] = hh ? sw_[0] : sw_[1]; }
        merge_top16(c0, c1);
        {
            u32x4 wa, wb;
#pragma unroll
            for (int q4 = 0; q4 < 4; ++q4) {
                wa[q4] = (top[0][4 * q4] & 127u) | ((top[0][4 * q4 + 1] & 127u) << 8) | ((top[0][4 * q4 + 2] & 127u) << 16) | ((top[0][4 * q4 + 3] & 127u) << 24);
                wb[q4] = (top[1][4 * q4] & 127u) | ((top[1][4 * q4 + 1] & 127u) << 8) | ((top[1][4 * q4 + 2] & 127u) << 16) | ((top[1][4 * q4 + 3] & 127u) << 24);
            }
            *(LAS u32x4*)tab = wa; *(LAS u32x4*)(tab + 16) = wb;
        }
        float ev[16], esum = 0.f; const float vmax = kval(c0[0] & ~255u);
#pragma unroll
        for (int k = 0; k < 16; ++k) { ev[k] = __expf(kval(c0[k] & ~255u) - vmax); esum += ev[k]; }
        const float rs = 1.0f / esum;
        LDS_WAIT();
        unsigned outw[8]; const unsigned hmask = hh ? 0xffffffffu : 0u;
#pragma unroll
        for (int kk = 0; kk < 8; ++kk) {
            const unsigned key = c0[kk] ^ ((c0[kk] ^ c0[8 + kk]) & hmask); const float e = __uint_as_float(__float_as_uint(ev[kk]) ^ ((__float_as_uint(ev[kk]) ^ __float_as_uint(ev[8 + kk])) & hmask));
            const unsigned code = key & 255u, ia = tab[code >> 4], ib = tab[16 + (code & 15u)];
            outw[kk] = (pk2(0.f, e * rs) & 0xffff0000u) | (ia * 128u + ib);
        }
        u32x4* dst = (u32x4*)(SEL + (size_t)t * 128 + h * 16 + hh * 8);
        dst[0] = (u32x4){outw[0], outw[1], outw[2], outw[3]}; dst[1] = (u32x4){outw[4], outw[5], outw[6], outw[7]};
        LDS_WAIT();
      }
    }
    __syncthreads();
}

__device__ __forceinline__ void fp8x4_to_f32(unsigned w, float& a, float& b, float& c, float& d) {
    const f32x2 lo = __builtin_amdgcn_cvt_pk_f32_fp8((int)w, false), hi = __builtin_amdgcn_cvt_pk_f32_fp8((int)w, true); a = lo[0]; b = lo[1]; c = hi[0]; d = hi[1];
}
struct XSlice { int sl, rank, nloc; };
__device__ __forceinline__ XSlice xslice_of_block(const KP& p, volatile LAS unsigned* MISC, int G) {
    unsigned* bar = (unsigned*)(p.ws + WS_CTL) + 4096; unsigned cnt[8]; unsigned tot = 0; bool ok = true;
#pragma unroll
    for (int j = 0; j < 8; ++j) { cnt[j] = xb_ld(&bar[XB_XCNT(j)]); tot += cnt[j]; ok = ok && (cnt[j] > 0u); }
    ok = ok && (tot == (unsigned)G);
    XSlice x;
    if (ok) { const unsigned myx = MISC[16]; x.sl = (int)myx; x.rank = (int)MISC[17]; x.nloc = (int)cnt[myx & 7u]; }
    else { x.sl = (int)(blockIdx.x & 7); x.rank = (int)(blockIdx.x >> 3); x.nloc = (G - x.sl + 7) >> 3; }
    x.sl = __builtin_amdgcn_readfirstlane(x.sl); x.rank = __builtin_amdgcn_readfirstlane(x.rank); x.nloc = __builtin_amdgcn_readfirstlane(x.nloc);
    return x;
}
__device__ __forceinline__ float dot16_fp8(const u32x4 u, const float (&hf)[16]) {
    float d = 0.f;
#pragma unroll
    for (int j = 0; j < 4; ++j) { float f0, f1, f2, f3; fp8x4_to_f32(u[j], f0, f1, f2, f3);
        d = __builtin_fmaf(f0, hf[4 * j], d); d = __builtin_fmaf(f1, hf[4 * j + 1], d); d = __builtin_fmaf(f2, hf[4 * j + 2], d); d = __builtin_fmaf(f3, hf[4 * j + 3], d); }
    return d;
}
typedef __bf16 bf16v8 __attribute__((ext_vector_type(8)));
__device__ __forceinline__ float dot16_fp8_bf16(const u32x4 u, const bf16v8 h0, const bf16v8 h1) {
    float d0 = 0.f, d1 = 0.f;
    d0 = __builtin_amdgcn_fdot2_f32_bf16(__builtin_amdgcn_cvt_scalef32_pk_bf16_fp8(u[0], 1.0f, false), __builtin_shufflevector(h0, h0, 0, 1), d0, false);
    d1 = __builtin_amdgcn_fdot2_f32_bf16(__builtin_amdgcn_cvt_scalef32_pk_bf16_fp8(u[0], 1.0f, true),  __builtin_shufflevector(h0, h0, 2, 3), d1, false);
    d0 = __builtin_amdgcn_fdot2_f32_bf16(__builtin_amdgcn_cvt_scalef32_pk_bf16_fp8(u[1], 1.0f, false), __builtin_shufflevector(h0, h0, 4, 5), d0, false);
    d1 = __builtin_amdgcn_fdot2_f32_bf16(__builtin_amdgcn_cvt_scalef32_pk_bf16_fp8(u[1], 1.0f, true),  __builtin_shufflevector(h0, h0, 6, 7), d1, false);
    d0 = __builtin_amdgcn_fdot2_f32_bf16(__builtin_amdgcn_cvt_scalef32_pk_bf16_fp8(u[2], 1.0f, false), __builtin_shufflevector(h1, h1, 0, 1), d0, false);
    d1 = __builtin_amdgcn_fdot2_f32_bf16(__builtin_amdgcn_cvt_scalef32_pk_bf16_fp8(u[2], 1.0f, true),  __builtin_shufflevector(h1, h1, 2, 3), d1, false);
    d0 = __builtin_amdgcn_fdot2_f32_bf16(__builtin_amdgcn_cvt_scalef32_pk_bf16_fp8(u[3], 1.0f, false), __builtin_shufflevector(h1, h1, 4, 5), d0, false);
    d1 = __builtin_amdgcn_fdot2_f32_bf16(__builtin_amdgcn_cvt_scalef32_pk_bf16_fp8(u[3], 1.0f, true),  __builtin_shufflevector(h1, h1, 6, 7), d1, false);
    return d0 + d1;
}
__device__ __forceinline__ float dpp_sum8(float d) {
    d += __uint_as_float(__builtin_amdgcn_update_dpp(0, __float_as_uint(d), 0xB1, 0xF, 0xF, true));
    d += __uint_as_float(__builtin_amdgcn_update_dpp(0, __float_as_uint(d), 0x4E, 0xF, 0xF, true));
    d += __uint_as_float(__builtin_amdgcn_update_dpp(0, __float_as_uint(d), 0x141, 0xF, 0xF, true));
    return d;
}
__device__ __forceinline__ void phase_expert_u(const KP& p, LAS unsigned char* lds, volatile LAS unsigned* MISC, int l, int G) {
    const int tid = opaque_tid(), lane = tid & 63, w = __builtin_amdgcn_readfirstlane(tid >> 6), j = lane >> 3, c = lane & 7;
    const XSlice xs = xslice_of_block(p, MISC, G);
    const bf16_t* H2 = (const bf16_t*)(p.ws + WS_H); const unsigned char* Us = p.ws + WS_U + (size_t)(l & 1) * TAB_BYTES + (size_t)xs.sl * 16384 * 128;
    const unsigned* SEL = (const unsigned*)(p.ws + WS_SEL); unsigned* PDu = (unsigned*)(p.ws + WS_R0) + (size_t)xs.sl * M * 64;
    const int t0 = xs.rank * 8 + w, tstep = xs.nloc * 8;
    LAS unsigned char* ring = lds + w * 17920;
    LAS unsigned char* selb = ring + 16384; LAS unsigned char* hbuf = ring + 16384 + 1024;
    const int tlast = t0 + ((M - 1 - t0) / tstep) * tstep;
#define E1_CL(t) ((t) <= tlast ? (t) : tlast)
#define E1_DMA_SEL(t, par) do { const unsigned* sp = SEL + (size_t)E1_CL(t) * 128 + lane; \
            __builtin_amdgcn_global_load_lds(sp, (LAS unsigned*)(selb + (par) * 512), 4, 0, 0); __builtin_amdgcn_global_load_lds(sp + 64, (LAS unsigned*)(selb + (par) * 512 + 256), 4, 0, 0); } while (0)
#define E1_DMA_H(t, par) do { __builtin_amdgcn_global_load_lds((const unsigned*)(H2 + (size_t)E1_CL(t) * D + xs.sl * 128) + lane, (LAS unsigned*)(hbuf + (par) * 256), 4, 0, 0); } while (0)
#define E1_DMA_ROW(i, idxv) do { __builtin_amdgcn_global_load_lds((const unsigned*)(Us + (size_t)((idxv) & 0x3fffu) * 128 + 16 * c), (LAS unsigned*)(ring + (i) * 1024), 16, 0, 0); } while (0)
    if (t0 < M) {
        E1_DMA_SEL(t0, 0); E1_DMA_SEL(t0 + tstep, 1); E1_DMA_H(t0, 0);
        asm volatile("s_waitcnt vmcnt(0)" ::: "memory");
        { u32x4 s0[4];
#pragma unroll
          for (int q = 0; q < 4; ++q) s0[q] = *(const LAS u32x4*)(selb + (16 * j + 4 * q) * 4);
#pragma unroll
          for (int i = 0; i < 16; ++i) E1_DMA_ROW(i, s0[i >> 2][i & 3]); }
        { PDu[(size_t)t0 * 64 + 8 * j + (c >> 1) + 4 * (c & 1)] = 0u; }
        int par = 0;
        for (int tok = t0; tok < M; tok += tstep, par ^= 1) {
            E1_DMA_SEL(tok + 2 * tstep, par); E1_DMA_H(tok + tstep, par ^ 1);
            asm volatile("s_waitcnt vmcnt(19)" ::: "memory");
            u32x4 sn[4];
#pragma unroll
            for (int q = 0; q < 4; ++q) sn[q] = *(const LAS u32x4*)(selb + (par ^ 1) * 512 + (16 * j + 4 * q) * 4);
            const bf16v8 hb0 = *(const LAS bf16v8*)(hbuf + par * 256 + 32 * c), hb1 = *(const LAS bf16v8*)(hbuf + par * 256 + 32 * c + 16);
            float pd0 = 0.f, pd1 = 0.f;
#pragma unroll
            for (int i0 = 0; i0 < 16; i0 += 4) {
                asm volatile("s_waitcnt vmcnt(16)" ::: "memory");
                u32x4 row[4];
#pragma unroll
                for (int r = 0; r < 4; ++r) row[r] = *(const LAS u32x4*)(ring + (i0 + r) * 1024 + 16 * lane);
                asm volatile("s_waitcnt lgkmcnt(0)" ::: "memory");
#pragma unroll
                for (int r = 0; r < 4; ++r) E1_DMA_ROW(i0 + r, sn[(i0 + r) >> 2][(i0 + r) & 3]);
#pragma unroll
                for (int r = 0; r < 4; ++r) { const int i = i0 + r; const float d = dpp_sum8(dot16_fp8_bf16(row[r], hb0, hb1));
                    if (i < 8) pd0 = (c == i) ? d : pd0; else pd1 = (c == i - 8) ? d : pd1; }
            }
            { const float nb0 = __uint_as_float(__builtin_amdgcn_update_dpp(0, __float_as_uint(pd0), 0xB1, 0xF, 0xF, true)), nb1 = __uint_as_float(__builtin_amdgcn_update_dpp(0, __float_as_uint(pd1), 0xB1, 0xF, 0xF, true));
              PDu[(size_t)tok * 64 + 8 * j + (c >> 1) + 4 * (c & 1)] = (c & 1) ? pk2(nb1, pd1) : pk2(pd0, nb0); }
        }
        asm volatile("s_waitcnt vmcnt(0)" ::: "memory");
    }
#undef E1_CL
#undef E1_DMA_SEL
#undef E1_DMA_H
#undef E1_DMA_ROW
}
__device__ __forceinline__ void phase_expert_w(const KP& p, int G) {
    const int tid = opaque_tid(), lane = tid & 63, w = __builtin_amdgcn_readfirstlane(tid >> 6);
    const int gw = blockIdx.x * 8 + w, ngw = G * 8;
    unsigned* SEL = (unsigned*)(p.ws + WS_SEL); const unsigned* PDu = (const unsigned*)(p.ws + WS_R0);
    for (int tok = gw; tok < M; tok += ngw) {
        f32x2 d = {0.f, 0.f};
#pragma unroll
        for (int sl = 0; sl < 8; ++sl) { const unsigned pw = PDu[((size_t)sl * M + tok) * 64 + lane]; d[0] += bflo(pw); d[1] += bfhi(pw); }
        u32x2* sp = (u32x2*)(SEL + (size_t)tok * 128 + 2 * lane); const u32x2 s2 = *sp;
        const float w0 = __uint_as_float(s2[0] & 0xffff0000u) * fgelu(d[0] * (1.0f / U_SCALE)) * (1.0f / V_SCALE);
        const float w1 = __uint_as_float(s2[1] & 0xffff0000u) * fgelu(d[1] * (1.0f / U_SCALE)) * (1.0f / V_SCALE);
        u32x2 o; o[0] = (pk2(0.f, w0) & 0xffff0000u) | (s2[0] & 0x3fffu); o[1] = (pk2(0.f, w1) & 0xffff0000u) | (s2[1] & 0x3fffu);
        *sp = o;
    }
}
__device__ __forceinline__ void phase_expert_v(const KP& p, LAS unsigned char* lds, volatile LAS unsigned* MISC, int l, int G) {
    const int tid = opaque_tid(), lane = tid & 63, w = __builtin_amdgcn_readfirstlane(tid >> 6), j = lane >> 3, c = lane & 7;
    const XSlice xs = xslice_of_block(p, MISC, G);
    const unsigned char* Vs = p.ws + WS_V + (size_t)(l & 1) * TAB_BYTES + (size_t)xs.sl * 16384 * 128;
    const unsigned* SEL = (const unsigned*)(p.ws + WS_SEL);
    const float* g2 = (const float*)(p.ws + WS_MOD) + (size_t)l * 32 * NMODC + 5120;
    const bf16_t* X = (const bf16_t*)p.out; bf16_t* XO = (l == DEPTH - 1) ? (bf16_t*)(p.ws + WS_YS) : (bf16_t*)p.out;
    const int t0 = xs.rank * 8 + w, tstep = xs.nloc * 8;
    const bool b3 = (lane & 8) != 0;
    LAS unsigned char* ring = lds + w * 17920; LAS unsigned char* selb = ring + 16384;
    const int tlast = t0 + ((M - 1 - t0) / tstep) * tstep;
#define E2_CL(t) ((t) <= tlast ? (t) : tlast)
#define E2_DMA_SEL(t, par) do { const unsigned* sp = SEL + (size_t)E2_CL(t) * 128 + lane; \
            __builtin_amdgcn_global_load_lds(sp, (LAS unsigned*)(selb + (par) * 512), 4, 0, 0); __builtin_amdgcn_global_load_lds(sp + 64, (LAS unsigned*)(selb + (par) * 512 + 256), 4, 0, 0); } while (0)
#define E2_DMA_ROW(i, idxv) do { __builtin_amdgcn_global_load_lds((const unsigned*)(Vs + (size_t)((idxv) & 0x3fffu) * 128 + 16 * c), (LAS unsigned*)(ring + (i) * 1024), 16, 0, 0); } while (0)
    if (t0 < M) {
        E2_DMA_SEL(t0, 0); E2_DMA_SEL(t0 + tstep, 1);
        asm volatile("s_waitcnt vmcnt(0)" ::: "memory");
        u32x4 sc[4];
#pragma unroll
        for (int q = 0; q < 4; ++q) sc[q] = *(const LAS u32x4*)(selb + (16 * j + 4 * q) * 4);
#pragma unroll
        for (int i = 0; i < 16; ++i) E2_DMA_ROW(i, sc[i >> 2][i & 3]);
        LAS float* xbuf = (LAS float*)(ring + 16384 + 1024);
        { const bf16_t* xd = X + (size_t)t0 * D + xs.sl * 128 + 16 * c + 2 * j; __builtin_amdgcn_global_load_lds((const unsigned*)xd, (LAS unsigned*)xbuf, 4, 0, 0); }
        int par = 0, bcur = -1; f32x2 gv = {0.f, 0.f};
        for (int tok = t0; tok < M; tok += tstep, par ^= 1) {
            const int dim = xs.sl * 128 + 16 * c + 2 * j;
            const size_t xo = (size_t)tok * D + dim;
            if ((tok >> 11) != bcur) { bcur = tok >> 11; const f32x2 gl = *(const f32x2*)(g2 + (size_t)bcur * NMODC + dim); asm volatile("s_waitcnt vmcnt(0)" ::: "memory"); gv[0] = gl[0] * 1.0f; gv[1] = gl[1] * 1.0f; asm volatile("" : "+v"(gv)); }
            E2_DMA_SEL(tok + 2 * tstep, par);
            __builtin_amdgcn_global_load_lds((const unsigned*)(X + xo), (LAS unsigned*)xbuf, 4, 0, 0);
            asm volatile("s_waitcnt vmcnt(20)" ::: "memory");
            u32x4 sn[4];
#pragma unroll
            for (int q = 0; q < 4; ++q) sn[q] = *(const LAS u32x4*)(selb + (par ^ 1) * 512 + (16 * j + 4 * q) * 4);
            f32x2 o2[8];
#pragma unroll
            for (int q = 0; q < 8; ++q) o2[q] = (f32x2){0.f, 0.f};
#pragma unroll
            for (int i0 = 0; i0 < 16; i0 += 4) {
                asm volatile("s_waitcnt vmcnt(16)" ::: "memory");
                u32x4 row[4];
#pragma unroll
                for (int r = 0; r < 4; ++r) row[r] = *(const LAS u32x4*)(ring + (i0 + r) * 1024 + 16 * lane);
                asm volatile("s_waitcnt lgkmcnt(0)" ::: "memory");
#pragma unroll
                for (int r = 0; r < 4; ++r) E2_DMA_ROW(i0 + r, sn[(i0 + r) >> 2][(i0 + r) & 3]);
                {
                    const u32x2 wA = {sc[i0 >> 2][0], sc[i0 >> 2][1]}, wB = {sc[i0 >> 2][2], sc[i0 >> 2][3]};
#pragma unroll
                    for (int r = 0; r < 4; ++r)
#pragma unroll
                        for (int q = 0; q < 4; ++q) { const f32x2 lo = __builtin_amdgcn_cvt_pk_f32_fp8((int)row[r][q], false), hi = __builtin_amdgcn_cvt_pk_f32_fp8((int)row[r][q], true);
                            if (r & 1) { asm("v_pk_fma_f32 %0, %1, %2, %0 op_sel:[1,0,0] op_sel_hi:[1,1,1]" : "+v"(o2[2 * q]) : "v"(r < 2 ? wA : wB), "v"(lo));
                                         asm("v_pk_fma_f32 %0, %1, %2, %0 op_sel:[1,0,0] op_sel_hi:[1,1,1]" : "+v"(o2[2 * q + 1]) : "v"(r < 2 ? wA : wB), "v"(hi)); }
                            else       { asm("v_pk_fma_f32 %0, %1, %2, %0 op_sel:[0,0,0] op_sel_hi:[0,1,1]" : "+v"(o2[2 * q]) : "v"(r < 2 ? wA : wB), "v"(lo));
                                         asm("v_pk_fma_f32 %0, %1, %2, %0 op_sel:[0,0,0] op_sel_hi:[0,1,1]" : "+v"(o2[2 * q + 1]) : "v"(r < 2 ? wA : wB), "v"(hi)); } }
                }
            }
            float o[16];
#pragma unroll
            for (int q = 0; q < 8; ++q) { o[2 * q] = o2[q][0]; o[2 * q + 1] = o2[q][1]; }
            float r8[8], r4[4], r2[2];
#pragma unroll
            for (int k = 0; k < 8; ++k) { const u32x2 sw = __builtin_amdgcn_permlane32_swap(__float_as_uint(o[k]), __float_as_uint(o[8 + k]), false, false); r8[k] = __uint_as_float(sw[0]) + __uint_as_float(sw[1]); }
#pragma unroll
            for (int k = 0; k < 4; ++k) { const u32x2 sw = __builtin_amdgcn_permlane16_swap(__float_as_uint(r8[k]), __float_as_uint(r8[4 + k]), false, false); r4[k] = __uint_as_float(sw[0]) + __uint_as_float(sw[1]); }
#pragma unroll
            for (int k = 0; k < 2; ++k) { const float keep = b3 ? r4[2 + k] : r4[k], send = b3 ? r4[k] : r4[2 + k];
                r2[k] = keep + __uint_as_float(__builtin_amdgcn_update_dpp(0, __float_as_uint(send), 0x128, 0xF, 0xF, true)); }
            asm volatile("s_waitcnt vmcnt(16)" ::: "memory");
            { const unsigned xw = __float_as_uint(xbuf[lane]); *(unsigned*)(XO + xo) = pk2(bflo(xw) + gv[0] * r2[0], bfhi(xw) + gv[1] * r2[1]); }
#pragma unroll
            for (int q = 0; q < 4; ++q) sc[q] = sn[q];
        }
        asm volatile("s_waitcnt vmcnt(0)" ::: "memory");
    }
#undef E2_CL
#undef E2_DMA_SEL
#undef E2_DMA_ROW
}

__device__ __forceinline__ void phase_final(const KP& p, int G) {
    const int tid = opaque_tid(), lane = tid & 63, w = __builtin_amdgcn_readfirstlane(tid >> 6);
    const int gw = blockIdx.x * 8 + w, ngw = G * 8;
    const float* fg = p.in[I_FG];
    for (int r0 = gw * 4; r0 < M; r0 += ngw * 4) {
        f32x4 v[4][4]; float ss[4];
#pragma unroll
        for (int i = 0; i < 4; ++i) { const u32x2* xr = (const u32x2*)((const bf16_t*)(p.ws + WS_YS) + (size_t)(r0 + i) * D) + lane;
#pragma unroll
            for (int j = 0; j < 4; ++j) { const u32x2 xw = xr[64 * j]; v[i][j] = (f32x4){bflo(xw[0]), bfhi(xw[0]), bflo(xw[1]), bfhi(xw[1])}; } }
#pragma unroll
        for (int i = 0; i < 4; ++i) { float t = 0.f;
#pragma unroll
            for (int j = 0; j < 4; ++j) t += (v[i][j][0] * v[i][j][0] + v[i][j][1] * v[i][j][1]) + (v[i][j][2] * v[i][j][2] + v[i][j][3] * v[i][j][3]);
            ss[i] = t; }
#pragma unroll
        for (int o = 1; o < 64; o <<= 1) {
#pragma unroll
            for (int i = 0; i < 4; ++i) ss[i] += __shfl_xor(ss[i], o); }
#pragma unroll
        for (int j = 0; j < 4; ++j) { const f32x4 g4 = *(const f32x4*)(fg + 256 * j + 4 * lane);
#pragma unroll
            for (int i = 0; i < 4; ++i) { const float rstd = __builtin_amdgcn_rsqf(ss[i] * (1.0f / D) + EPS); ((f32x4*)(p.out + (size_t)(r0 + i) * D) + lane)[64 * j] = v[i][j] * rstd * g4; } }
    }
}

__global__ void __launch_bounds__(512, 2) mk_fwd(KP p_) {
    extern __shared__ __attribute__((aligned(16))) unsigned char lds_raw[];
    LAS unsigned char* lds = (LAS unsigned char*)lds_raw;
    const int tid = threadIdx.x, G = gridDim.x;
    volatile LAS unsigned* MISC = (volatile LAS unsigned*)(lds + MISC_OFF);
    for (int i = tid; i < LDS_BYTES / 4; i += 512) ((LAS unsigned*)lds)[i] = 0u;
    __syncthreads();
    XcdBarrier bar = xcd_barrier_post((unsigned*)(p_.ws + WS_CTL) + 4096, MISC + 8);
    if (tid == 0) { const unsigned myx = xb_xcc_id(); MISC[16] = myx; MISC[17] = xb_add((unsigned*)(p_.ws + WS_CTL) + 8192 + 64 * (myx & 15u), 1u); }
    __syncthreads();
    const int lo = p_.gp_lo, hi = p_.gp_hi;
#ifndef PH_MASK
#define PH_MASK 0xFFFFF
#endif
#define IN(k) (lo <= (k) && (k) < hi)
#define EN(b) ((PH_MASK >> (b)) & 1)
#ifndef PH_REPEAT
#define PH_REPEAT 0
#endif
#define NREP(b) (((PH_REPEAT >> (b)) & 1) ? 2 : 1)
#define SEAM(k) do { if ((k) + 1 < hi) xcd_barrier(bar); } while (0)
    if (EN(12) && IN(GP_SETUP)) { const KP p = load_kp(); phase_setup(p, lds, G); SEAM(GP_SETUP); }
    for (int l = 0; l < DEPTH; ++l) {
        const int g0 = 1 + l * NPH;
        if (EN(0) && IN(g0 + 0)) { _Pragma("nounroll") for (int rep = 0; rep < NREP(0); ++rep) { const KP p = load_kp(); phase_conv_norm1(p, lds, l, G); } SEAM(g0 + 0); }
        if (EN(1) && IN(g0 + 1)) { const KP p = load_kp();
            pg8::Gemm g{(const bf16_t*)(p.ws + WS_H), (const bf16_t*)(p.ws + WS_WIN), M, 3072, D / 2, D / 2, D / 2}; pg8::StaticOrder S; S.init(M, 3072, G, (int)blockIdx.x);
            pg8::EpiStoreBf16 E{(bf16_t*)(p.ws + WS_R0), 3072, 1.0f / (WIN_SCALE * HIN_SCALE)};
            _Pragma("nounroll") for (int rep = 0; rep < NREP(1); ++rep) pg8::gemm_phase<pg8::EpiStoreBf16, pg8::StaticOrder, false, true, true>(lds, g, S, E);
            SEAM(g0 + 1);
        }
        if (EN(2) && IN(g0 + 2)) { _Pragma("nounroll") for (int rep = 0; rep < NREP(2); ++rep) { const KP p = load_kp(); phase_hgrn2(p, lds, l, G); } SEAM(g0 + 2); }
        if (EN(3) && IN(g0 + 3)) { const KP p = load_kp();
            pg8::Gemm g{(const bf16_t*)(p.ws + WS_H), (const bf16_t*)(p.ws + WS_WIN) + (size_t)3072 * (D / 2), M, 4096, D / 2, D / 2, D / 2}; pg8::StaticOrder S; S.init(M, 4096, G, (int)blockIdx.x);
            pg8::EpiStoreBf16 E{(bf16_t*)(p.ws + WS_R0), 4096, 1.0f / (WIN_SCALE * HIN_SCALE)};
            _Pragma("nounroll") for (int rep = 0; rep < NREP(3); ++rep) pg8::gemm_phase<pg8::EpiStoreBf16, pg8::StaticOrder, false, true, true>(lds, g, S, E);
            SEAM(g0 + 3);
        }
        #if DBG_SELFCHECK
        if (EN(4) && IN(g0 + 4)) {
#pragma nounroll
            for (int rep = 0; rep < 2; ++rep) { const KP p = load_kp(); size_t yo = rep ? WS_H : WS_YS; asm volatile("" : "+s"(yo)); phase_s5(p, lds, l, G, yo); SEAM(g0 + 4); }
            const KP p = load_kp();
            const unsigned* a = (const unsigned*)(p.ws + WS_YS); const unsigned* b2 = (const unsigned*)(p.ws + WS_H); unsigned bad = 0;
            for (size_t i = (size_t)blockIdx.x * 512 + opaque_tid(); i < (size_t)M * D / 2; i += (size_t)G * 512) bad += (a[i] != b2[i]) ? 1u : 0u;
            if (bad) atomicAdd((unsigned*)(p.ws + WS_CTL) + 64, bad);
            { const unsigned* h1 = (const unsigned*)(p.ws + WS_CTL) + 65536; const unsigned* h2 = h1 + 8192; const int u2 = blockIdx.x * 512 + opaque_tid();
              if (u2 < 2048) { if (h1[u2 * 4] != h2[u2 * 4]) atomicAdd((unsigned*)(p.ws + WS_CTL) + 128, 1u); if (h1[u2 * 4 + 1] != h2[u2 * 4 + 1]) atomicAdd((unsigned*)(p.ws + WS_CTL) + 192, 1u); if (h1[u2 * 4 + 2] != h2[u2 * 4 + 2]) atomicAdd((unsigned*)(p.ws + WS_CTL) + 256, 1u); } }
            SEAM(g0 + 4); }
#else
        if (EN(4) && IN(g0 + 4)) { _Pragma("nounroll") for (int rep = 0; rep < NREP(4); ++rep) { const KP p = load_kp(); phase_s5(p, lds, l, G, WS_YS); } SEAM(g0 + 4); }
#endif
        if (EN(5) && IN(g0 + 5)) { const KP p = load_kp();
            pg8::Gemm g{(const bf16_t*)(p.ws + WS_YS), (const bf16_t*)(p.ws + WS_WGLU), M, D, D, D, D}; pg8::StaticOrder S; S.init(M, D, G, (int)blockIdx.x);
            pg8::EpiGlu E{(const bf16_t*)(p.ws + WS_R0), (const bf16_t*)(p.ws + WS_YS), (const bf16_t*)(p.ws + WS_OR), (const float*)(p.ws + WS_SSQ), p.in[I_HNG] + l * 128, p.in[I_GLUB] + l * D, (bf16_t*)(p.ws + WS_H)};
            _Pragma("nounroll") for (int rep = 0; rep < NREP(5); ++rep) pg8::gemm_phase<pg8::EpiGlu, pg8::StaticOrder, true, true>(lds, g, S, E);
            SEAM(g0 + 5);
        }
        if (EN(6) && IN(g0 + 6)) { const KP p = load_kp();
            pg8::Gemm g{(const bf16_t*)(p.ws + WS_H), (const bf16_t*)(p.ws + WS_WOUT), M, D, D / 2, D / 2, D / 2}; pg8::StaticOrder S; S.init(M, D, G, (int)blockIdx.x);
            pg8::EpiStoreBf16 E{(bf16_t*)(p.ws + WS_OR), D, 1.0f / (WO_SCALE * MG_SCALE)};
            pg8::gemm_phase<pg8::EpiStoreBf16, pg8::StaticOrder, false, true, true>(lds, g, S, E);
            SEAM(g0 + 6);
        }
        if (EN(7) && IN(g0 + 7)) { const KP p = load_kp();
            const int t2 = opaque_tid(), lane = t2 & 63, wave = __builtin_amdgcn_readfirstlane(t2 >> 6);
            if (l == 0) resid_norm_rows<false>(p.in[I_X], (bf16_t*)p.out, (const bf16_t*)(p.ws + WS_OR), (bf16_t*)(p.ws + WS_H), p.in[I_N2G] + l * D, (const float*)(p.ws + WS_MOD) + (size_t)l * 32 * NMODC, blockIdx.x * 8 + wave, G * 8, lane);
            else resid_norm_rows<true>(p.out, (bf16_t*)p.out, (const bf16_t*)(p.ws + WS_OR), (bf16_t*)(p.ws + WS_H), p.in[I_N2G] + l * D, (const float*)(p.ws + WS_MOD) + (size_t)l * 32 * NMODC, blockIdx.x * 8 + wave, G * 8, lane);
            SEAM(g0 + 7);
        }
        if (EN(8) && IN(g0 + 8)) { const KP p = load_kp();
            pg8::Gemm g{(const bf16_t*)(p.ws + WS_H), (const bf16_t*)(p.ws + WS_WQ), M, 2048, D, D, D}; pg8::StaticOrder S; S.init(M, 2048, G, (int)blockIdx.x);
            pg8::EpiStoreQ E{(bf16_t*)(p.ws + WS_R0)};
            _Pragma("nounroll") for (int rep = 0; rep < NREP(8); ++rep) pg8::gemm_phase<pg8::EpiStoreQ, pg8::StaticOrder, true, true>(lds, g, S, E);
            SEAM(g0 + 8);
        }
        if (EN(9) && IN(g0 + 9)) { _Pragma("nounroll") for (int rep = 0; rep < NREP(9); ++rep) { const KP p = load_kp(); phase_topk(p, lds, G); } SEAM(g0 + 9); }
        if (EN(10) && IN(g0 + 10)) {
            { const KP p = load_kp(); phase_expert_u(p, lds, MISC, l, G); } xcd_barrier(bar);
            { const KP p = load_kp(); phase_expert_w(p, G); } xcd_barrier(bar);
            { const KP p = load_kp(); phase_expert_v(p, lds, MISC, l, G); }
            SEAM(g0 + 10); }
    }
    if (EN(13) && IN(GP_FINAL)) { const KP p = load_kp(); phase_final(p, G); }
#undef IN
#undef EN
#undef NREP
#undef SEAM
}

extern "C" void kernel_launch(void* const* d_in, const int* in_sizes, int n_in, void* d_out, int out_size, void* d_ws, size_t ws_size, hipStream_t stream) {
    static int grid = 0;
    if (grid == 0) {
        if (n_in != 25 || out_size != M * D || ws_size < WS_END) { fprintf(stderr, "kernel_launch: unexpected shapes (n_in %d, out %d, ws %zu < %zu)\n", n_in, out_size, ws_size, (size_t)WS_END); grid = -1; return; }
        int dev = 0, cus = 0, per_cu = 0;
        if (hipGetDevice(&dev) != hipSuccess || hipDeviceGetAttribute(&cus, hipDeviceAttributeMultiprocessorCount, dev) != hipSuccess) { grid = -1; return; }
        if (hipFuncSetAttribute((const void*)mk_fwd, hipFuncAttributeMaxDynamicSharedMemorySize, LDS_BYTES) != hipSuccess) { fprintf(stderr, "kernel_launch: hipFuncSetAttribute failed\n"); grid = -1; return; }
        if (hipOccupancyMaxActiveBlocksPerMultiprocessor(&per_cu, (const void*)mk_fwd, 512, LDS_BYTES) != hipSuccess || per_cu < 1) fprintf(stderr, "kernel_launch: occupancy query says %d\n", per_cu);
        (void)hipGetLastError();
        grid = cus;
    }
    if (grid < 0) return;
    (void)hipMemsetAsync((char*)d_ws + WS_CTL, 0, CTL_ZERO_BYTES, stream);
    KP a{};
    for (int i = 0; i < 25; ++i) a.in[i] = (const float*)d_in[i];
    a.out = (float*)d_out; a.ws = (unsigned char*)d_ws;
#if MK_LAUNCHES == 1
    a.gp_lo = 0; a.gp_hi = GP_END;
    hipLaunchKernelGGL(mk_fwd, dim3(grid), dim3(512), LDS_BYTES, stream, a);
#else
    for (int gp = 0; gp < GP_END; ++gp) { a.gp_lo = gp; a.gp_hi = gp + 1; hipLaunchKernelGGL(mk_fwd, dim3(grid), dim3(512), LDS_BYTES, stream, a); }
#endif
}
```

```cpp
#include <hip/hip_runtime.h>
#include <cstdio>
#include <cstdint>

#define DBG_HASHSEL 0
#define DBG_H2_FROM_INPUT 0
#define DBG_NO_YA 0
#define DBG_NO_YB 0
#define DBG_NO_ACC 0
#define DBG_NO_GB 0
#define DBG_S5_NOSSM 0
#define DBG_S5_NOREC 0
#define DBG_SELFCHECK 0
#ifndef MK_LAUNCHES
#define MK_LAUNCHES 1
#endif

#define LAS __attribute__((address_space(3)))
typedef unsigned short bf16_t;
typedef short bf16x8 __attribute__((ext_vector_type(8)));
typedef float f32x2 __attribute__((ext_vector_type(2)));
typedef float f32x4 __attribute__((ext_vector_type(4)));
typedef float f32x16 __attribute__((ext_vector_type(16)));
typedef unsigned u32x2 __attribute__((ext_vector_type(2)));
typedef unsigned u32x4 __attribute__((ext_vector_type(4)));
typedef __bf16 bf16v2 __attribute__((ext_vector_type(2)));
typedef int i32x8 __attribute__((ext_vector_type(8)));
typedef int i32x4 __attribute__((ext_vector_type(4)));

constexpr int D = 1024, BATCH = 32, SEQ = 2048, DEPTH = 4, M = BATCH * SEQ;
constexpr int INC = 7168, NMODC = 6 * D;
constexpr int NPH = 11, GP_SETUP = 0, GP_FINAL = 1 + DEPTH * NPH, GP_END = GP_FINAL + 1;
constexpr float EPS = 1e-6f;
constexpr float U_SCALE = 64.0f, V_SCALE = 4.0f;
constexpr size_t TAB_BYTES = (size_t)16384 * 1024;
constexpr float WIN_SCALE = 64.0f, HIN_SCALE = 4.0f;
constexpr float WO_SCALE = 64.0f, MG_SCALE = 8.0f;

constexpr size_t MiB = 1u << 20;
constexpr size_t WS_CTL = 0, CTL_ZERO_BYTES = 1 * MiB;
constexpr size_t WS_MOD = 1 * MiB;
constexpr size_t WS_LB = 4 * MiB;
constexpr size_t WS_ABAR = 4 * MiB + 65536;
constexpr size_t WS_BOP = 5 * MiB;
constexpr size_t WS_COP = 6 * MiB;
constexpr size_t WS_WIN = 8 * MiB;
constexpr size_t WS_WGLU = 22 * MiB;
constexpr size_t WS_WOUT = 24 * MiB;
constexpr size_t WS_WQ = 26 * MiB;
constexpr size_t WS_KEYS = 30 * MiB;
constexpr size_t WS_U = 32 * MiB;
constexpr size_t WS_V = 64 * MiB;
constexpr size_t WS_H = 96 * MiB;
constexpr size_t WS_OR = 224 * MiB;
constexpr size_t WS_SSQ = 352 * MiB;
constexpr size_t WS_R0 = 354 * MiB;
constexpr size_t WS_SEL = WS_R0 + 256 * MiB;
constexpr size_t WS_YS = WS_R0 + 512 * MiB;
constexpr size_t WS_END = WS_YS + 128 * MiB;

constexpr int LDS_BYTES = 147456;
constexpr int MISC_OFF = LDS_BYTES - 256;

__device__ __forceinline__ unsigned pk2(float lo, float hi) { f32x2 v = {lo, hi}; bf16v2 r = __builtin_convertvector(v, bf16v2); return __builtin_bit_cast(unsigned, r); }
__device__ __forceinline__ float bflo(unsigned w) { return __uint_as_float(w << 16); }
__device__ __forceinline__ float bfhi(unsigned w) { return __uint_as_float(w & 0xffff0000u); }
__device__ __forceinline__ float fsigmoid(float x) { return __builtin_amdgcn_rcpf(1.0f + __expf(-x)); }
__device__ __forceinline__ float fsilu(float x) { return x * fsigmoid(x); }
__device__ __forceinline__ float fgelu(float x) { return x * fsigmoid(1.5957691216f * (x + 0.044715f * x * x * x)); }
__device__ __forceinline__ float wave_sum(float v) {
#pragma unroll
    for (int o = 1; o < 64; o <<= 1) v += __shfl_xor(v, o);
    return v;
}
#define LDS_WAIT() asm volatile("s_waitcnt lgkmcnt(0)" ::: "memory")
__device__ __forceinline__ float dpp_sum8(float d);
__device__ __forceinline__ int opaque_tid() { int t = threadIdx.x; asm volatile("" : "+v"(t)); return t; }

namespace pg8 {
#define PG8_LAS __attribute__((address_space(3)))
constexpr int BM = 256, BK = 64, HALF = 128, HTB = HALF * BK * 2, STAGE_BYTES = 8 * HTB, NXCD = 8, WGM = 8;
__host__ __device__ __forceinline__ int lds_byte(int r, int c) { const int st = (r >> 4) * 2 + (c >> 5), rr = r & 15, cc = c & 31, ob = rr * 64 + cc * 2; return st * 1024 + (ob ^ (((ob >> 9) & 1) << 5)); }
__host__ __device__ __forceinline__ void stage_rc(int b, int& R, int& C) { const int st = b / 1024, sb = b % 1024, swz = sb ^ (((sb >> 9) & 1) << 5); R = (st >> 1) * 16 + swz / 64; C = (st & 1) * 32 + (swz % 64) / 2; }
__host__ __device__ __forceinline__ int perm32(int rho) { const int n = rho >> 4, i = rho & 15; return 8 * (i >> 2) + 4 * n + (i & 3); }
struct Unit { int pm, pn; };
struct Gemm { const bf16_t* A; const bf16_t* Bt; int M, N, K, lda, ldb; };
struct StaticOrder {
    int nM, nN, nwg, G, c;
    __host__ __device__ void init(int M_, int N_, int G_, int c_) { nM = M_ / BM; nN = N_ / BM; nwg = nM * nN; G = G_; c = c_; }
    __host__ __device__ bool next(int i, Unit& u) const {
        const long L = (long)i * G + c; if (L >= nwg) return false;
        int wgid = (int)L; { const int q = nwg / NXCD, r = nwg % NXCD, xcd = wgid % NXCD, off = wgid / NXCD; wgid = (xcd < r ? xcd * (q + 1) : r * (q + 1) + (xcd - r) * q) + off; }
        const int nig = WGM * nN, gid = wgid / nig, fm = gid * WGM, gsz = (nM - fm) < WGM ? (nM - fm) : WGM;
        u.pm = fm + ((wgid % nig) % gsz); u.pn = (wgid % nig) / gsz; return true;
    }
    __device__ __forceinline__ void a_ready(const Unit&) const {}
    __device__ __forceinline__ void done(const Unit&) const {}
};
template <class Epi, class Sched, bool ALIGN_EPI = false, bool SP2 = false, bool F8 = false>
__device__ __forceinline__ void gemm_phase(PG8_LAS unsigned char* lds, const Gemm g, const Sched& S, const Epi& E) {
    const int tid = opaque_tid(), wid = __builtin_amdgcn_readfirstlane(tid >> 6), lane = tid & 63, wr = wid >> 2, wc = wid & 3, fr = lane & 15, fq = lane >> 4;
    const int K = g.K, nt = K / BK;
    unsigned voffA[2], voffB[2];
#pragma unroll
    for (int i = 0; i < 2; ++i) { int R, C; stage_rc(tid * 16 + i * 8192, R, C); const int Rb = Epi::PERM ? ((R & ~31) + perm32(R & 31)) : R;
        voffA[i] = (unsigned)(R * g.lda + C) * 2u; voffB[i] = (unsigned)(Rb * g.ldb + C) * 2u; }
    const size_t kstep = (size_t)(BK * 2);
    const size_t hstepA = (size_t)HALF * g.lda * 2, hstepB = (size_t)HALF * g.ldb * 2;
    const size_t tstepA = 2 * hstepA, tstepB = 2 * hstepB;
    const unsigned ldsw = (unsigned)wid * 1024u;
    const int aoff = lds_byte(wr * 64 + fr, fq * 8), boff = lds_byte(wc * 32 + fr, fq * 8);
#define PG8_SA(b, h) (((b) * 2 + (h)) * HTB)
#define PG8_SB(b, h) ((4 + (b) * 2 + (h)) * HTB)
#define PG8_STAGE(bufoff, gbase, voff) do { _Pragma("unroll") for (int _i = 0; _i < 2; ++_i) \
        __builtin_amdgcn_global_load_lds((const unsigned*)((const char*)(gbase) + (voff)[_i]), (PG8_LAS unsigned*)(lds + (bufoff) + ldsw + _i * 8192), 16, 0, 0); } while (0)
#define PG8_LD8(p) __builtin_shufflevector(*(const PG8_LAS i32x4*)(p), *(const PG8_LAS i32x4*)((p) + 1024), 0, 1, 2, 3, 4, 5, 6, 7)
#define PG8_LDA(dst, b, h) do { if constexpr (F8) { _Pragma("unroll") for (int m = 0; m < 4; ++m) dst##8[m] = PG8_LD8(lds + PG8_SA(b, h) + aoff + m * 2048); } \
        else { _Pragma("unroll") for (int m = 0; m < 4; ++m) _Pragma("unroll") for (int k = 0; k < 2; ++k) dst[m][k] = *(const PG8_LAS bf16x8*)(lds + PG8_SA(b, h) + aoff + m * 2048 + k * 1024); } } while (0)
#define PG8_LDB(dst, b, h) do { if constexpr (F8) { _Pragma("unroll") for (int n = 0; n < 2; ++n) dst##8[n] = PG8_LD8(lds + PG8_SB(b, h) + boff + n * 2048); } \
        else { _Pragma("unroll") for (int n = 0; n < 2; ++n) _Pragma("unroll") for (int k = 0; k < 2; ++k) dst[n][k] = *(const PG8_LAS bf16x8*)(lds + PG8_SB(b, h) + boff + n * 2048 + k * 1024); } } while (0)
#define PG8_MMA(ai, bj, At, Bt) do { __builtin_amdgcn_s_setprio(1); _Pragma("unroll") for (int m = 0; m < 4; ++m) _Pragma("unroll") for (int n = 0; n < 2; ++n) { \
        if constexpr (F8) {   \
            acc[ai][bj][m][n] = __builtin_amdgcn_mfma_scale_f32_16x16x128_f8f6f4(Bt##8[n], At##8[m], acc[ai][bj][m][n], 0, 0, 0, 0x7f7f7f7f, 0, 0x7f7f7f7f); \
        } else { _Pragma("unroll") for (int k = 0; k < 2; ++k) acc[ai][bj][m][n] = __builtin_amdgcn_mfma_f32_16x16x32_bf16(Bt[n][k], At[m][k], acc[ai][bj][m][n], 0, 0, 0); } } \
        __builtin_amdgcn_s_setprio(0); } while (0)
#define PG8_WAIT_V(n) asm volatile("s_waitcnt vmcnt(" #n ")" ::: "memory")
#define PG8_WAIT_L(n) asm volatile("s_waitcnt lgkmcnt(" #n ")" ::: "memory")
#define PG8_BAR __builtin_amdgcn_s_barrier()
#define PG8_SCHED __builtin_amdgcn_sched_barrier(0)
    Unit cur, nxt; int ui = 0;
    if (!S.next(0, cur)) return;
    f32x4 acc[2][2][4][2];
#pragma unroll
    for (int a = 0; a < 2; ++a)
#pragma unroll
        for (int b = 0; b < 2; ++b)
#pragma unroll
            for (int m = 0; m < 4; ++m)
#pragma unroll
                for (int n = 0; n < 2; ++n) acc[a][b][m][n] = (f32x4){0.f, 0.f, 0.f, 0.f};
    bf16x8 At[4][2], B0[2][2], B1[2][2]; i32x8 At8[4], B08[2], B18[2];
    const char* cA = (const char*)g.A + (size_t)cur.pm * tstepA; const char* cB = (const char*)g.Bt + (size_t)cur.pn * tstepB;
    S.a_ready(cur);
    if constexpr (SP2) {
        PG8_STAGE(PG8_SB(0, 0), cB, voffB); PG8_STAGE(PG8_SB(0, 1), cB + hstepB, voffB); PG8_STAGE(PG8_SA(0, 0), cA, voffA); PG8_STAGE(PG8_SA(0, 1), cA + hstepA, voffA);
        if (wr == 1) PG8_BAR;
        PG8_WAIT_V(2); PG8_BAR;
        PG8_STAGE(PG8_SB(1, 0), cB + kstep, voffB); PG8_STAGE(PG8_SA(1, 0), cA + kstep, voffA); PG8_STAGE(PG8_SB(1, 1), cB + hstepB + kstep, voffB);
        PG8_WAIT_V(6); PG8_BAR;
    } else {
        PG8_STAGE(PG8_SB(0, 0), cB, voffB); PG8_STAGE(PG8_SA(0, 0), cA, voffA); PG8_STAGE(PG8_SB(0, 1), cB + hstepB, voffB); PG8_STAGE(PG8_SA(0, 1), cA + hstepA, voffA);
        if (wr == 1) PG8_BAR;
        PG8_WAIT_V(4); PG8_BAR;
        PG8_STAGE(PG8_SB(1, 0), cB + kstep, voffB); PG8_STAGE(PG8_SA(1, 0), cA + kstep, voffA); PG8_STAGE(PG8_SB(1, 1), cB + hstepB + kstep, voffB);
        PG8_WAIT_V(6); PG8_BAR;
    }
    for (;;) {
        const bool has_next = S.next(ui + 1, nxt);
        const char* nA = has_next ? (const char*)g.A + (size_t)nxt.pm * tstepA : cA; const char* nB = has_next ? (const char*)g.Bt + (size_t)nxt.pn * tstepB : cB;
        for (int t = 0; t < nt; t += 2) {
            const bool last = (t == nt - 2);
            const char* a1 = cA + (size_t)(t + 1) * kstep;
            const char* a2 = last ? nA : cA + (size_t)(t + 2) * kstep; const char* b2 = last ? nB : cB + (size_t)(t + 2) * kstep;
            const char* a3 = a2 + kstep; const char* b3 = b2 + kstep;
            if (last && has_next) S.a_ready(nxt);
            if constexpr (SP2) {
            PG8_LDB(B0, 0, 0); PG8_LDB(B1, 0, 1); PG8_SCHED; PG8_LDA(At, 0, 0); PG8_STAGE(PG8_SA(1, 1), a1 + hstepA, voffA);
            PG8_WAIT_V(8); PG8_WAIT_L(0); PG8_BAR; PG8_MMA(0, 0, At, B0); PG8_MMA(0, 1, At, B1); PG8_BAR; PG8_SCHED;
            PG8_LDA(At, 0, 1); PG8_STAGE(PG8_SB(0, 0), b2, voffB); PG8_STAGE(PG8_SB(0, 1), b2 + hstepB, voffB); PG8_STAGE(PG8_SA(0, 0), a2, voffA);
            PG8_WAIT_V(8); PG8_WAIT_L(0); PG8_BAR; PG8_MMA(1, 0, At, B0); PG8_MMA(1, 1, At, B1); PG8_BAR; PG8_SCHED;
            PG8_LDB(B0, 1, 0); PG8_LDB(B1, 1, 1); PG8_SCHED; PG8_LDA(At, 1, 0); PG8_STAGE(PG8_SA(0, 1), a2 + hstepA, voffA);
            PG8_WAIT_V(8); PG8_WAIT_L(0); PG8_BAR; PG8_MMA(0, 0, At, B0); PG8_MMA(0, 1, At, B1); PG8_BAR; PG8_SCHED;
            PG8_LDA(At, 1, 1); PG8_STAGE(PG8_SB(1, 0), b3, voffB); PG8_STAGE(PG8_SB(1, 1), b3 + hstepB, voffB); PG8_STAGE(PG8_SA(1, 0), a3, voffA);
            PG8_WAIT_V(8); PG8_WAIT_L(0); PG8_BAR; PG8_MMA(1, 0, At, B0); PG8_MMA(1, 1, At, B1); PG8_BAR; PG8_SCHED;
            } else {
            PG8_LDB(B0, 0, 0); PG8_SCHED; PG8_LDA(At, 0, 0); PG8_STAGE(PG8_SA(1, 1), a1 + hstepA, voffA);
            PG8_WAIT_L(8); PG8_BAR; PG8_WAIT_L(0); PG8_MMA(0, 0, At, B0); PG8_BAR; PG8_SCHED;
            PG8_LDB(B1, 0, 1); PG8_STAGE(PG8_SB(0, 0), b2, voffB);
            PG8_BAR; PG8_WAIT_L(0); PG8_MMA(0, 1, At, B1); PG8_BAR;
            PG8_LDA(At, 0, 1); PG8_STAGE(PG8_SA(0, 0), a2, voffA);
            PG8_BAR; PG8_WAIT_L(0); PG8_MMA(1, 0, At, B0); PG8_BAR; PG8_SCHED;
            PG8_STAGE(PG8_SB(0, 1), b2 + hstepB, voffB);
            PG8_WAIT_V(6); PG8_BAR; PG8_MMA(1, 1, At, B1); PG8_BAR;
            PG8_LDB(B0, 1, 0); PG8_SCHED; PG8_LDA(At, 1, 0); PG8_STAGE(PG8_SA(0, 1), a2 + hstepA, voffA);
            PG8_WAIT_L(8); PG8_BAR; PG8_WAIT_L(0); PG8_MMA(0, 0, At, B0); PG8_BAR; PG8_SCHED;
            PG8_LDB(B1, 1, 1); PG8_STAGE(PG8_SB(1, 0), b3, voffB);
            PG8_BAR; PG8_WAIT_L(0); PG8_MMA(0, 1, At, B1); PG8_BAR;
            PG8_LDA(At, 1, 1); PG8_STAGE(PG8_SA(1, 0), a3, voffA);
            PG8_BAR; PG8_WAIT_L(0); PG8_MMA(1, 0, At, B0); PG8_BAR; PG8_SCHED;
            PG8_STAGE(PG8_SB(1, 1), b3 + hstepB, voffB);
            PG8_WAIT_V(6); PG8_BAR; PG8_MMA(1, 1, At, B1); PG8_BAR;
            }
        }
        if constexpr (ALIGN_EPI) { if (wr == 0) PG8_BAR; }
        E(acc, cur, wr, wc, fr, fq);
        if (!has_next) break;
#pragma unroll
        for (int a = 0; a < 2; ++a)
#pragma unroll
            for (int b = 0; b < 2; ++b)
#pragma unroll
                for (int m = 0; m < 4; ++m)
#pragma unroll
                    for (int n = 0; n < 2; ++n) acc[a][b][m][n] = (f32x4){0.f, 0.f, 0.f, 0.f};
        cur = nxt; cA = nA; cB = nB; ++ui;
        if constexpr (ALIGN_EPI) { if (wr == 1) PG8_BAR; }
    }
    PG8_WAIT_V(0);
    if constexpr (!ALIGN_EPI) { if (wr == 0) PG8_BAR; }
    PG8_BAR;
#undef PG8_SA
#undef PG8_SB
#undef PG8_STAGE
#undef PG8_LDA
#undef PG8_LD8
#undef PG8_LDB
#undef PG8_MMA
#undef PG8_WAIT_V
#undef PG8_WAIT_L
#undef PG8_BAR
#undef PG8_SCHED
}

struct EpiStoreBf16 {
    static constexpr bool PERM = true;
    bf16_t* O; int ldc; float scale;
    __device__ __forceinline__ void operator()(const f32x4 (&acc)[2][2][4][2], const Unit& u, int wr, int wc, int fr, int fq) const {
        const int row0 = u.pm * BM + wr * 64 + fr, col0 = u.pn * BM + wc * 32 + 8 * fq;
#pragma unroll
        for (int ai = 0; ai < 2; ++ai)
#pragma unroll
            for (int m = 0; m < 4; ++m) { bf16_t* rowp = O + (size_t)(row0 + ai * HALF + m * 16) * ldc + col0;
#pragma unroll
                for (int bj = 0; bj < 2; ++bj) { const f32x4 v0 = acc[ai][bj][m][0] * scale, v1 = acc[ai][bj][m][1] * scale;
                    u32x4 w; w.x = pk2(v0[0], v0[1]); w.y = pk2(v0[2], v0[3]); w.z = pk2(v1[0], v1[1]); w.w = pk2(v1[2], v1[3]);
                    *(u32x4*)(rowp + bj * HALF) = w; } }
    }
};
struct EpiStoreQ {
    static constexpr bool PERM = true;
    bf16_t* O;
    __device__ __forceinline__ void operator()(const f32x4 (&acc)[2][2][4][2], const Unit& u, int wr, int wc, int fr, int fq) const {
        const int row0 = u.pm * BM + wr * 64 + fr, col0 = u.pn * BM + wc * 32 + 8 * fq;
#pragma unroll
        for (int ai = 0; ai < 2; ++ai)
#pragma unroll
            for (int m = 0; m < 4; ++m) { const int row = row0 + ai * HALF + m * 16, tg = row >> 5, t = row & 31;
#pragma unroll
                for (int bj = 0; bj < 2; ++bj) { const int c0 = col0 + bj * HALF, h = c0 >> 8, pp = (c0 >> 7) & 1, cc = c0 & 127, ks = cc >> 4, hh = (cc >> 3) & 1;
                    const f32x4 v0 = acc[ai][bj][m][0], v1 = acc[ai][bj][m][1];
                    u32x4 w; w.x = pk2(v0[0], v0[1]); w.y = pk2(v0[2], v0[3]); w.z = pk2(v1[0], v1[1]); w.w = pk2(v1[2], v1[3]);
                    *(u32x4*)(O + ((size_t)((((tg * 8 + h) * 2 + pp) * 8 + ks) * 64 + hh * 32 + t)) * 8) = w; } }
    }
};
struct EpiWout {
    static constexpr bool PERM = false;
    const float* xs; float* out; const float* g1;
    __device__ __forceinline__ void operator()(const f32x4 (&acc)[2][2][4][2], const Unit& u, int wr, int wc, int fr, int fq) const {
        const int row0 = u.pm * BM + wr * 64 + fr, col0 = u.pn * BM + wc * 32 + 4 * fq;
        const int b = (u.pm * BM) >> 11;
        f32x4 gv[2][2];
#pragma unroll
        for (int bj = 0; bj < 2; ++bj)
#pragma unroll
            for (int n = 0; n < 2; ++n) gv[bj][n] = *(const f32x4*)(g1 + (size_t)b * NMODC + col0 + bj * HALF + n * 16);
#pragma unroll
        for (int ai = 0; ai < 2; ++ai)
#pragma unroll
            for (int m = 0; m < 4; ++m) { const size_t off = (size_t)(row0 + ai * HALF + m * 16) * D + col0;
#pragma unroll
                for (int bj = 0; bj < 2; ++bj)
#pragma unroll
                    for (int n = 0; n < 2; ++n) { const f32x4 xv = *(const f32x4*)(xs + off + bj * HALF + n * 16);
                        *(f32x4*)(out + off + bj * HALF + n * 16) = xv + gv[bj][n] * acc[ai][bj][m][n]; } }
    }
};
struct EpiGlu {
    static constexpr bool PERM = true;
    const bf16_t* PB; const bf16_t* YS; const bf16_t* ORAW; const float* SSQ; const float* ng; const float* gb_; bf16_t* O;
    __device__ __forceinline__ void operator()(const f32x4 (&acc)[2][2][4][2], const Unit& u, int wr, int wc, int fr, int fq) const {
        const int row0 = u.pm * BM + wr * 64 + fr, col0 = u.pn * BM + wc * 32 + 8 * fq;
#pragma unroll
        for (int bj = 0; bj < 2; ++bj) {
            const int c = col0 + bj * HALF, head = c >> 7;
            const f32x4 n0 = *(const f32x4*)(ng + (c & 127)), n1 = *(const f32x4*)(ng + (c & 127) + 4);
            const f32x4 b0 = *(const f32x4*)(gb_ + c), b1 = *(const f32x4*)(gb_ + c + 4);
            const float ngv[8] = {n0[0], n0[1], n0[2], n0[3], n1[0], n1[1], n1[2], n1[3]};
            const float bbv[8] = {b0[0], b0[1], b0[2], b0[3], b1[0], b1[1], b1[2], b1[3]};
#pragma unroll
            for (int ai = 0; ai < 2; ++ai)
#pragma unroll
                for (int m = 0; m < 4; ++m) {
                    const int row = row0 + ai * HALF + m * 16;
                    const bf16_t* pb = PB + (size_t)row * 4096 + c;
                    const u32x4 og = *(const u32x4*)(pb), ys = *(const u32x4*)(YS + (size_t)row * D + c), ga = *(const u32x4*)(pb + 2048), gb = *(const u32x4*)(pb + 3072);
                    const u32x4 orw = *(const u32x4*)(ORAW + (size_t)row * D + c);
                    const float rstd = __builtin_amdgcn_rsqf(SSQ[(size_t)row * 8 + head] * (1.0f / 128.0f) + EPS);
                    const f32x4 a0 = acc[ai][bj][m][0], a1 = acc[ai][bj][m][1];
                    const float av[8] = {a0[0], a0[1], a0[2], a0[3], a1[0], a1[1], a1[2], a1[3]};
                    float res[8];
#pragma unroll
                    for (int j = 0; j < 8; ++j) {
                        const unsigned wog = og[j >> 1], wys = ys[j >> 1], wga = ga[j >> 1], wgb = gb[j >> 1], wor = orw[j >> 1];
                        const float fog = (j & 1) ? bfhi(wog) : bflo(wog), fys = (j & 1) ? bfhi(wys) : bflo(wys), fga = (j & 1) ? bfhi(wga) : bflo(wga),
                                    fgb = (j & 1) ? bfhi(wgb) : bflo(wgb), fo = (j & 1) ? bfhi(wor) : bflo(wor);
                        const float ya = fo * rstd * ngv[j] * fsilu(fog);
                        const float yb = fys * fsigmoid((DBG_NO_ACC ? 0.f : av[j]) + bbv[j]);
                        res[j] = (DBG_NO_YA ? 0.f : fsigmoid(fga) * ya) + (DBG_NO_YB ? 0.f : (DBG_NO_GB ? 0.5f : fsigmoid(fgb)) * yb);
                    }
                    int w0 = 0, w1 = 0;
                    w0 = __builtin_amdgcn_cvt_pk_fp8_f32(res[0] * MG_SCALE, res[1] * MG_SCALE, w0, false); w0 = __builtin_amdgcn_cvt_pk_fp8_f32(res[2] * MG_SCALE, res[3] * MG_SCALE, w0, true);
                    w1 = __builtin_amdgcn_cvt_pk_fp8_f32(res[4] * MG_SCALE, res[5] * MG_SCALE, w1, false); w1 = __builtin_amdgcn_cvt_pk_fp8_f32(res[6] * MG_SCALE, res[7] * MG_SCALE, w1, true);
                    *(u32x2*)((unsigned char*)O + (size_t)row * D + c) = (u32x2){(unsigned)w0, (unsigned)w1};
                }
        }
    }
};
}

#define XB_TMO      128
#define XB_XCNT(j)  (256  + 64 * (j))
#define XB_XSUB(j)  (1280 + 64 * (j))
#define XB_XGEN(j)  (2304 + 64 * (j))
#define XB_TOP      3328
#define XB_TOPGEN   3392
#define XCD_BAR_WORDS 3456
#define XB_SPIN_CAP (1u << 25)
__device__ __forceinline__ unsigned xb_ld(unsigned* p)              { return __hip_atomic_load(p, __ATOMIC_RELAXED, __HIP_MEMORY_SCOPE_AGENT); }
__device__ __forceinline__ unsigned xb_add(unsigned* p, unsigned v) { return __hip_atomic_fetch_add(p, v, __ATOMIC_RELAXED, __HIP_MEMORY_SCOPE_AGENT); }
__device__ __forceinline__ unsigned xb_xcc_id() { return (unsigned)__builtin_amdgcn_s_getreg((3 << 11) | 20) & 0xFu; }
#define XB_SPIN(cond, bar) do { unsigned _sp = 0; while (cond) { __builtin_amdgcn_s_sleep(1); \
    if ((++_sp & 255u) == 0u) { if (xb_ld(&(bar)[XB_TMO])) break; if (_sp > XB_SPIN_CAP) { atomicAdd(&(bar)[XB_TMO], 1u); break; } } } } while (0)
struct XcdBarrier { unsigned* bar; unsigned x; volatile LAS unsigned* st; };
__device__ __forceinline__ XcdBarrier xcd_barrier_post(unsigned* bar, volatile LAS unsigned* st) {
    XcdBarrier b; b.bar = bar; b.x = xb_xcc_id(); b.st = st;
    if (threadIdx.x == 0) (void)xb_add(&bar[XB_XCNT(b.x)], 1u);
    return b;
}
__device__ __forceinline__ void xcd_barrier_complete(unsigned* bar, unsigned x, unsigned& nloc, unsigned& nx) {
    const unsigned G = gridDim.x * gridDim.y * gridDim.z;
    unsigned sum, cnt, mine, sp = 0u;
    for (;;) {
        sum = 0u; cnt = 0u; mine = 0u;
#pragma unroll
        for (unsigned j = 0; j < 16; ++j) { const unsigned c = xb_ld(&bar[XB_XCNT(j)]); sum += c; cnt += (c > 0u) ? 1u : 0u; mine = (j == x) ? c : mine; }
        if (sum == G) break;
        __builtin_amdgcn_s_sleep(1);
        if ((++sp & 255u) == 0u) { if (xb_ld(&bar[XB_TMO])) break; if (sp > XB_SPIN_CAP) { atomicAdd(&bar[XB_TMO], 1u); break; } }
    }
    nloc = mine > 0u ? mine : 1u; nx = cnt > 0u ? cnt : 1u;
}
__device__ __forceinline__ void xcd_barrier(const XcdBarrier& b) {
    asm volatile("s_waitcnt vmcnt(0)" ::: "memory");
    __syncthreads();
    if (threadIdx.x == 0) {
        unsigned* bar = b.bar;
        __builtin_amdgcn_s_waitcnt(0);
        unsigned nloc = b.st[0], nx = b.st[1];
        if (nloc == 0u) { xcd_barrier_complete(bar, b.x, nloc, nx); b.st[0] = nloc; b.st[1] = nx; }
        const unsigned old = xb_add(&bar[XB_XSUB(b.x)], 1u);
        const unsigned gen = old / nloc;
        if (old + 1u == (gen + 1u) * nloc) {
            __builtin_amdgcn_fence(__ATOMIC_RELEASE, "agent");
            asm volatile("s_waitcnt vmcnt(0)" ::: "memory");
            const unsigned og = xb_add(&bar[XB_TOP], 1u);
            const unsigned tg = og / nx;
            if (og + 1u == (tg + 1u) * nx) xb_add(&bar[XB_TOPGEN], 1u);
            else XB_SPIN(xb_ld(&bar[XB_TOPGEN]) == tg, bar);
            __builtin_amdgcn_fence(__ATOMIC_ACQUIRE, "agent");
            xb_add(&bar[XB_XGEN(b.x)], 1u);
            asm volatile("s_waitcnt vmcnt(0)" ::: "memory");
        } else {
            XB_SPIN(xb_ld(&bar[XB_XGEN(b.x)]) == gen, bar);
            __builtin_amdgcn_fence(__ATOMIC_ACQUIRE, "agent");
            asm volatile("s_waitcnt vmcnt(0)" ::: "memory");
        }
    }
    __syncthreads();
}

struct KP { const float* in[25]; float* out; unsigned char* ws; int gp_lo, gp_hi; };
enum { I_X = 0, I_C, I_ADAW, I_ADAB, I_N1G, I_N2G, I_WIN, I_LBL, I_HNG, I_ARE, I_AIM, I_LDT, I_BRE, I_BIM, I_CRE, I_CIM, I_S5D, I_GLUW, I_GLUB, I_WOUT, I_WQ, I_SUBK, I_PU, I_PV, I_FG };

typedef const KP __attribute__((address_space(4)))* kp_cptr;
__device__ __forceinline__ KP load_kp() {
#if defined(__HIP_DEVICE_COMPILE__)
    unsigned long long a = (unsigned long long)__builtin_amdgcn_kernarg_segment_ptr(); asm volatile("" : "+s"(a)); return *(kp_cptr)a;
#else
    return KP{};
#endif
}

__device__ __forceinline__ void phase_setup(const KP& p, LAS unsigned char* lds, int G) {
    const int tid = opaque_tid();
    {
        LAS float* cact = (LAS float*)lds;
        for (int it = blockIdx.x; it < 4 * 48; it += G) {
            for (int i = tid; i < 32 * 1024; i += 512) cact[i] = fsilu(p.in[I_C][i]);
            __syncthreads();
            const int l = it / 48, cb = it % 48, col = cb * 128 + (tid & 127), bg = tid >> 7;
            const float* W = p.in[I_ADAW] + (size_t)l * D * NMODC + col;
            float acc[8];
#pragma unroll
            for (int j = 0; j < 8; ++j) acc[j] = 0.f;
            for (int k4 = 0; k4 < 256; ++k4) {
                const float w0 = W[(size_t)(4 * k4 + 0) * NMODC], w1 = W[(size_t)(4 * k4 + 1) * NMODC], w2 = W[(size_t)(4 * k4 + 2) * NMODC], w3 = W[(size_t)(4 * k4 + 3) * NMODC];
#pragma unroll
                for (int j = 0; j < 8; ++j) { const f32x4 c4 = *(const LAS f32x4*)(cact + (8 * bg + j) * 1024 + 4 * k4); acc[j] += c4[0] * w0 + c4[1] * w1 + c4[2] * w2 + c4[3] * w3; }
            }
            float* MOD = (float*)(p.ws + WS_MOD);
            const float bias = p.in[I_ADAB][l * NMODC + col];
#pragma unroll
            for (int j = 0; j < 8; ++j) MOD[((size_t)l * 32 + 8 * bg + j) * NMODC + col] = acc[j] + bias;
            __syncthreads();
        }
    }
    const int gtid = blockIdx.x * 512 + tid;
    if (gtid < 1024) {
        const float* lg = p.in[I_LBL]; float v[4], mx = -1e30f;
#pragma unroll
        for (int l = 0; l < 4; ++l) { v[l] = lg[l * 1024 + gtid]; mx = fmaxf(mx, v[l]); }
        float s = 0.f;
#pragma unroll
        for (int l = 0; l < 4; ++l) { v[l] = __expf(v[l] - mx); s += v[l]; }
        float* LB = (float*)(p.ws + WS_LB); float cum = 0.f; const float first = v[0] / s;
#pragma unroll
        for (int l = 0; l < 4; ++l) { cum += v[l] / s; LB[l * 1024 + gtid] = (l == 0) ? 0.f : (cum - first); }
    }
    if (gtid >= 1024 && gtid < 1024 + 16384) {
        const int id = gtid - 1024, lg = id >> 6, pp = id & 63;
        const float a_re = p.in[I_ARE][id], a_im = p.in[I_AIM][id];
        const float step = expf(p.in[I_LDT][lg]);
        const float mag = expf(step * a_re), ang = step * a_im;
        const float ab_re = mag * cosf(ang), ab_im = mag * sinf(ang);
        const float den = a_re * a_re + a_im * a_im;
        const float z_re = ((ab_re - 1.0f) * a_re + ab_im * a_im) / den;
        const float z_im = (ab_im * a_re - (ab_re - 1.0f) * a_im) / den;
        float* ABAR = (float*)(p.ws + WS_ABAR); ABAR[2 * id] = ab_re; ABAR[2 * id + 1] = ab_im;
        bf16_t* BOP = (bf16_t*)(p.ws + WS_BOP); bf16_t* COP = (bf16_t*)(p.ws + WS_COP);
        const float* bre = p.in[I_BRE] + (size_t)id * 16; const float* bim = p.in[I_BIM] + (size_t)id * 16;
#pragma unroll
        for (int c = 0; c < 16; ++c) {
            const float br = bre[c], bi = bim[c];
            const float rr = z_re * br - z_im * bi, ii = z_re * bi + z_im * br;
            BOP[((size_t)lg * 128 + 2 * pp) * 16 + c] = (bf16_t)(pk2(rr, 0.f) & 0xffffu);
            BOP[((size_t)lg * 128 + 2 * pp + 1) * 16 + c] = (bf16_t)(pk2(ii, 0.f) & 0xffffu);
            const float cr = p.in[I_CRE][((size_t)lg * 16 + c) * 64 + pp], ci = p.in[I_CIM][((size_t)lg * 16 + c) * 64 + pp];
            COP[((size_t)lg * 16 + c) * 128 + 2 * pp] = (bf16_t)(pk2(cr, 0.f) & 0xffffu);
            COP[((size_t)lg * 16 + c) * 128 + 2 * pp + 1] = (bf16_t)(pk2(-ci, 0.f) & 0xffffu);
        }
    }
}

__device__ __forceinline__ void transpose_item(const float* W, int K, int N, bf16_t* WT, LAS float* scr, int item, int lane) {
    const int nblk = N / 32, kb = item / nblk, nb = item % nblk, k0 = 64 * kb, n0 = 32 * nb;
#pragma unroll 8
    for (int i = 0; i < 32; ++i) { const int kk = 2 * i + (lane >> 5); scr[kk * 33 + (lane & 31)] = W[(size_t)(k0 + kk) * N + n0 + (lane & 31)]; }
    LDS_WAIT();
    const int c = lane & 7;
#pragma unroll
    for (int j = 0; j < 4; ++j) { const int n = (lane >> 3) + 8 * j; const LAS float* s = scr + (8 * c) * 33 + n;
        u32x4 o; o.x = pk2(s[0 * 33], s[1 * 33]); o.y = pk2(s[2 * 33], s[3 * 33]); o.z = pk2(s[4 * 33], s[5 * 33]); o.w = pk2(s[6 * 33], s[7 * 33]);
        *(u32x4*)(WT + (size_t)(n0 + n) * K + k0 + 8 * c) = o; }
    LDS_WAIT();
}
__device__ __forceinline__ void cvt_f32_fp8(const float* src, unsigned char* dst, size_t n4, size_t gtid, size_t nthr, float scale) {
    for (size_t i = gtid; i < n4; i += nthr) { const f32x4 v = ((const f32x4*)src)[i] * scale; int w = 0;
        w = __builtin_amdgcn_cvt_pk_fp8_f32(v[0], v[1], w, false); w = __builtin_amdgcn_cvt_pk_fp8_f32(v[2], v[3], w, true); ((unsigned*)dst)[i] = (unsigned)w; }
}
__device__ __forceinline__ void cvt_f32_fp8_sliced(const float* src, unsigned char* dst, size_t gtid, size_t nthr, float scale) {
    for (size_t i = gtid; i < (size_t)16384 * 64; i += nthr) {
        const size_t e = i >> 6; const int sl = (int)(i & 63) >> 3, c = (int)(i & 7);
        const f32x4* sp = (const f32x4*)(src + e * 1024 + sl * 128 + c * 16); u32x4 o;
#pragma unroll
        for (int q = 0; q < 4; ++q) { const f32x4 v = sp[q] * scale; int w = 0; w = __builtin_amdgcn_cvt_pk_fp8_f32(v[0], v[1], w, false); w = __builtin_amdgcn_cvt_pk_fp8_f32(v[2], v[3], w, true); o[q] = (unsigned)w; }
        *(u32x4*)(dst + ((size_t)sl * 16384 + e) * 128 + c * 16) = o;
    }
}
__device__ __forceinline__ void transpose_item_fp8(const float* W, int K, int N, unsigned char* WT, LAS float* scr, int item, int lane, float scale) {
    const int nblk = N / 32, kb = item / nblk, nb = item % nblk, k0 = 64 * kb, n0 = 32 * nb;
#pragma unroll 8
    for (int i = 0; i < 32; ++i) { const int kk = 2 * i + (lane >> 5); scr[kk * 33 + (lane & 31)] = W[(size_t)(k0 + kk) * N + n0 + (lane & 31)]; }
    LDS_WAIT();
    const int c = lane & 7;
#pragma unroll
    for (int j = 0; j < 4; ++j) { const int n = (lane >> 3) + 8 * j; const LAS float* sp = scr + (8 * c) * 33 + n;
        int w0 = 0, w1 = 0;
        w0 = __builtin_amdgcn_cvt_pk_fp8_f32(sp[0 * 33] * scale, sp[1 * 33] * scale, w0, false); w0 = __builtin_amdgcn_cvt_pk_fp8_f32(sp[2 * 33] * scale, sp[3 * 33] * scale, w0, true);
        w1 = __builtin_amdgcn_cvt_pk_fp8_f32(sp[4 * 33] * scale, sp[5 * 33] * scale, w1, false); w1 = __builtin_amdgcn_cvt_pk_fp8_f32(sp[6 * 33] * scale, sp[7 * 33] * scale, w1, true);
        *(u32x2*)(WT + (size_t)(n0 + n) * K + k0 + 8 * c) = (u32x2){(unsigned)w0, (unsigned)w1}; }
    LDS_WAIT();
}
__device__ __forceinline__ void cvt_f32_bf16(const float* src, bf16_t* dst, size_t n4, size_t gtid, size_t nthr) {
    for (size_t i = gtid; i < n4; i += nthr) { const f32x4 v = ((const f32x4*)src)[i]; u32x2 o; o.x = pk2(v[0], v[1]); o.y = pk2(v[2], v[3]); ((u32x2*)dst)[i] = o; }
}
template <bool F8OUT, bool XBF>
__device__ __forceinline__ void norm_rows(const float* xsrc, bf16_t* hdst, const float* gain, const float* mod_l, int sh_off, int sc_off, int gw, int ngw, int lane) {
    for (int r0 = gw * 4; r0 < M; r0 += ngw * 4) {
        const int b = r0 >> 11;
        f32x4 v[4][4]; float ss[4];
#pragma unroll
        for (int i = 0; i < 4; ++i) {
            if constexpr (XBF) { const u32x2* xr = (const u32x2*)((const bf16_t*)xsrc + (size_t)(r0 + i) * D) + lane;
#pragma unroll
                for (int j = 0; j < 4; ++j) { const u32x2 xw = xr[64 * j]; v[i][j] = (f32x4){bflo(xw[0]), bfhi(xw[0]), bflo(xw[1]), bfhi(xw[1])}; } }
            else { const f32x4* xr = (const f32x4*)(xsrc + (size_t)(r0 + i) * D) + lane;
#pragma unroll
                for (int j = 0; j < 4; ++j) v[i][j] = xr[64 * j]; } }
#pragma unroll
        for (int i = 0; i < 4; ++i) { float t = 0.f;
#pragma unroll
            for (int j = 0; j < 4; ++j) t += (v[i][j][0] * v[i][j][0] + v[i][j][1] * v[i][j][1]) + (v[i][j][2] * v[i][j][2] + v[i][j][3] * v[i][j][3]);
            ss[i] = t; }
#pragma unroll
        for (int o = 1; o < 64; o <<= 1) {
#pragma unroll
            for (int i = 0; i < 4; ++i) ss[i] += __shfl_xor(ss[i], o); }
        const float* mb = mod_l + (size_t)b * NMODC;
#pragma unroll
        for (int j = 0; j < 4; ++j) { const int col = 256 * j + 4 * lane;
            const f32x4 g4 = *(const f32x4*)(gain + col), sc = *(const f32x4*)(mb + sc_off + col), sh = *(const f32x4*)(mb + sh_off + col);
            const f32x4 gs = g4 * (sc + 1.0f);
#pragma unroll
            for (int i = 0; i < 4; ++i) { const float rstd = __builtin_amdgcn_rsqf(ss[i] * (1.0f / D) + EPS);
                const f32x4 h = v[i][j] * rstd * gs + sh;
                if constexpr (F8OUT) { int w8 = 0; w8 = __builtin_amdgcn_cvt_pk_fp8_f32(h[0] * HIN_SCALE, h[1] * HIN_SCALE, w8, false); w8 = __builtin_amdgcn_cvt_pk_fp8_f32(h[2] * HIN_SCALE, h[3] * HIN_SCALE, w8, true);
                    *(unsigned*)((unsigned char*)hdst + (size_t)(r0 + i) * D + col) = (unsigned)w8; }
                else { u32x2 o; o.x = pk2(h[0], h[1]); o.y = pk2(h[2], h[3]); *(u32x2*)(hdst + (size_t)(r0 + i) * D + col) = o; } } }
    }
}
template <bool XBF>
__device__ __forceinline__ void resid_norm_rows(const float* xsrc, bf16_t* xdst, const bf16_t* delta, bf16_t* hdst, const float* gain, const float* mod_l, int gw, int ngw, int lane) {
    for (int r0 = gw * 4; r0 < M; r0 += ngw * 4) {
        const int b = r0 >> 11; const float* mb = mod_l + (size_t)b * NMODC;
        f32x4 v[4][4]; u32x2 dl[4][4]; float ss[4];
#pragma unroll
        for (int i = 0; i < 4; ++i) { const u32x2* dp = (const u32x2*)(delta + (size_t)(r0 + i) * D) + lane;
            if constexpr (XBF) { const u32x2* xr = (const u32x2*)((const bf16_t*)xsrc + (size_t)(r0 + i) * D) + lane;
#pragma unroll
                for (int j = 0; j < 4; ++j) { const u32x2 xw = xr[64 * j]; v[i][j] = (f32x4){bflo(xw[0]), bfhi(xw[0]), bflo(xw[1]), bfhi(xw[1])}; dl[i][j] = dp[64 * j]; } }
            else { const f32x4* xr = (const f32x4*)(xsrc + (size_t)(r0 + i) * D) + lane;
#pragma unroll
                for (int j = 0; j < 4; ++j) { v[i][j] = xr[64 * j]; dl[i][j] = dp[64 * j]; } } }
#pragma unroll
        for (int j = 0; j < 4; ++j) { const f32x4 g1 = *(const f32x4*)(mb + 2048 + 256 * j + 4 * lane);
#pragma unroll
            for (int i = 0; i < 4; ++i) { const f32x4 dv = {bflo(dl[i][j][0]), bfhi(dl[i][j][0]), bflo(dl[i][j][1]), bfhi(dl[i][j][1])}; v[i][j] = v[i][j] + g1 * dv;
                ((u32x2*)(xdst + (size_t)(r0 + i) * D) + lane)[64 * j] = (u32x2){pk2(v[i][j][0], v[i][j][1]), pk2(v[i][j][2], v[i][j][3])}; } }
#pragma unroll
        for (int i = 0; i < 4; ++i) { float t = 0.f;
#pragma unroll
            for (int j = 0; j < 4; ++j) t += (v[i][j][0] * v[i][j][0] + v[i][j][1] * v[i][j][1]) + (v[i][j][2] * v[i][j][2] + v[i][j][3] * v[i][j][3]);
            ss[i] = t; }
#pragma unroll
        for (int o = 1; o < 64; o <<= 1) {
#pragma unroll
            for (int i = 0; i < 4; ++i) ss[i] += __shfl_xor(ss[i], o); }
#pragma unroll
        for (int j = 0; j < 4; ++j) { const int col = 256 * j + 4 * lane;
            const f32x4 g4 = *(const f32x4*)(gain + col), sc = *(const f32x4*)(mb + 4096 + col), sh = *(const f32x4*)(mb + 3072 + col);
            const f32x4 gs = g4 * (sc + 1.0f);
#pragma unroll
            for (int i = 0; i < 4; ++i) { const float rstd = __builtin_amdgcn_rsqf(ss[i] * (1.0f / D) + EPS);
                const f32x4 h = v[i][j] * rstd * gs + sh; u32x2 o; o.x = pk2(h[0], h[1]); o.y = pk2(h[2], h[3]); *(u32x2*)(hdst + (size_t)(r0 + i) * D + col) = o; } }
    }
}
__device__ __forceinline__ void phase_conv_norm1(const KP& p, LAS unsigned char* lds, int l, int G) {
    const int tid = opaque_tid(), lane = tid & 63, wave = __builtin_amdgcn_readfirstlane(tid >> 6);
    const int gw = blockIdx.x * 8 + wave, ngw = G * 8;
    LAS float* scr = (LAS float*)(lds + wave * 8448);
    constexpr int I_IN = 16 * (INC / 32), I_G = 16 * 32, I_O = 16 * 32, I_Q = 16 * 64, NIT = I_IN + I_G + I_O + I_Q;
    for (int it = gw; it < NIT; it += ngw) {
        int r = it;
        if (r < I_IN) { transpose_item_fp8(p.in[I_WIN] + (size_t)l * D * INC, D, INC, p.ws + WS_WIN, scr, r, lane, WIN_SCALE); continue; } r -= I_IN;
        if (r < I_G) { transpose_item(p.in[I_GLUW] + (size_t)l * D * D, D, D, (bf16_t*)(p.ws + WS_WGLU), scr, r, lane); continue; } r -= I_G;
        if (r < I_O) { transpose_item_fp8(p.in[I_WOUT] + (size_t)l * D * D, D, D, p.ws + WS_WOUT, scr, r, lane, WO_SCALE); continue; } r -= I_O;
        transpose_item(p.in[I_WQ] + (size_t)l * D * 2048, D, 2048, (bf16_t*)(p.ws + WS_WQ), scr, r, lane);
    }
    const size_t gtid = (size_t)blockIdx.x * 512 + tid, nthr = (size_t)G * 512;
    cvt_f32_bf16(p.in[I_SUBK] + (size_t)l * 262144, (bf16_t*)(p.ws + WS_KEYS), 262144 / 4, gtid, nthr);
    if (l == 0) {
        cvt_f32_fp8_sliced(p.in[I_PU], p.ws + WS_U, gtid, nthr, U_SCALE);
        cvt_f32_fp8_sliced(p.in[I_PV], p.ws + WS_V, gtid, nthr, V_SCALE); }
    if (l == 0) norm_rows<true, false>(p.in[I_X], (bf16_t*)(p.ws + WS_H), p.in[I_N1G] + l * D, (const float*)(p.ws + WS_MOD) + (size_t)l * 32 * NMODC, 0, 1024, gw, ngw, lane);
    else norm_rows<true, true>(p.out, (bf16_t*)(p.ws + WS_H), p.in[I_N1G] + l * D, (const float*)(p.ws + WS_MOD) + (size_t)l * 32 * NMODC, 0, 1024, gw, ngw, lane);
}

__device__ __forceinline__ void phase_hgrn2(const KP& p, LAS unsigned char* lds, int l, int G) {
    const int tid = opaque_tid(), lane = tid & 63, w = __builtin_amdgcn_readfirstlane(tid >> 6), fr = lane & 15, g = lane >> 4;
    constexpr int QS = 272, TS = 72;
    constexpr int OFF_QT = 0, OFF_KH = 8704, OFF_KT = 17408, OFF_VT = 26624, OFF_EREF = 35840, OFF_ELR = 36352, OFF_SEG = 36864, PBUF = 40960;
    const bf16_t* PA = (const bf16_t*)(p.ws + WS_R0);
    bf16_t* ORAW = (bf16_t*)(p.ws + WS_OR);
    const float* LB = (const float*)(p.ws + WS_LB) + l * 1024;
    for (int unit = blockIdx.x; unit < 256; unit += G) {
        const int b = unit >> 3, h = unit & 7, k0 = 2 * lane;
        const float lb0 = LB[h * 128 + k0], lb1 = LB[h * 128 + k0 + 1];
        const float om0 = 1.0f - lb0, om1 = 1.0f - lb1;
        f32x4 S[8];
#pragma unroll
        for (int kt = 0; kt < 8; ++kt) S[kt] = (f32x4){0.f, 0.f, 0.f, 0.f};
        unsigned rq[4], rf[4], rv[4];
        {
            const bf16_t* base = PA + ((size_t)b * SEQ + 4 * w) * 3072 + h * 128 + k0;
#pragma unroll
            for (int i = 0; i < 4; ++i) { rq[i] = *(const unsigned*)(base + (size_t)i * 3072); rf[i] = *(const unsigned*)(base + (size_t)i * 3072 + 1024); rv[i] = *(const unsigned*)(base + (size_t)i * 3072 + 2048); }
        }
        for (int c = 0; c < 64; ++c) {
            LAS unsigned char* base = lds + (c & 1) * PBUF;
            float cs0[4], cs1[4], qv0[4], qv1[4], kv0[4], kv1[4];
            float run0 = 0.f, run1 = 0.f;
#pragma unroll
            for (int i = 0; i < 4; ++i) {
                const float fp0 = bflo(rf[i]), fp1 = bfhi(rf[i]);
                const float s0 = fsigmoid(fp0), s1 = fsigmoid(fp1);
                run0 += __logf(lb0 + om0 * s0); run1 += __logf(lb1 + om1 * s1);
                cs0[i] = run0; cs1[i] = run1;
                kv0[i] = om0 * (1.0f - s0); kv1[i] = om1 * (1.0f - s1);
                qv0[i] = fsilu(bflo(rq[i])); qv1[i] = fsilu(bfhi(rq[i]));
            }
            *(LAS f32x2*)(base + OFF_SEG + (w * 128 + k0) * 4) = (f32x2){run0, run1};
            __syncthreads();
            float off0 = 0.f, off1 = 0.f, ref0 = 0.f, ref1 = 0.f, all0 = 0.f, all1 = 0.f;
#pragma unroll
            for (int s = 0; s < 8; ++s) { const f32x2 t2 = *(const LAS f32x2*)(base + OFF_SEG + (s * 128 + k0) * 4);
                if (s < w) { off0 += t2[0]; off1 += t2[1]; }
                if (s < 4) { ref0 += t2[0]; ref1 += t2[1]; }
                all0 += t2[0]; all1 += t2[1]; }
            float kh0[4], kh1[4];
#pragma unroll
            for (int i = 0; i < 4; ++i) {
                const float b0 = off0 + cs0[i], b1 = off1 + cs1[i];
                const float q0 = qv0[i] * __expf(b0 - ref0), q1 = qv1[i] * __expf(b1 - ref1);
                kh0[i] = kv0[i] * __expf(ref0 - b0); kh1[i] = kv1[i] * __expf(ref1 - b1);
                const int t = 4 * w + i;
                *(LAS unsigned*)(base + OFF_QT + t * QS + k0 * 2) = pk2(q0, q1);
                *(LAS unsigned*)(base + OFF_KH + t * QS + k0 * 2) = pk2(kh0[i], kh1[i]);
            }
            *(LAS u32x2*)(base + OFF_KT + k0 * TS + 8 * w) = (u32x2){pk2(kh0[0], kh0[1]), pk2(kh0[2], kh0[3])};
            *(LAS u32x2*)(base + OFF_KT + (k0 + 1) * TS + 8 * w) = (u32x2){pk2(kh1[0], kh1[1]), pk2(kh1[2], kh1[3])};
            *(LAS u32x2*)(base + OFF_VT + k0 * TS + 8 * w) = (u32x2){(rv[0] & 0xffffu) | (rv[1] << 16), (rv[2] & 0xffffu) | (rv[3] << 16)};
            *(LAS u32x2*)(base + OFF_VT + (k0 + 1) * TS + 8 * w) = (u32x2){(rv[0] >> 16) | (rv[1] & 0xffff0000u), (rv[2] >> 16) | (rv[3] & 0xffff0000u)};
            if (w == 0) {
                *(LAS f32x2*)(base + OFF_EREF + k0 * 4) = (f32x2){__expf(ref0), __expf(ref1)};
                *(LAS f32x2*)(base + OFF_ELR + k0 * 4) = (f32x2){__expf(all0 - ref0), __expf(all1 - ref1)};
            }
            __syncthreads();
            if (c + 1 < 64) {
                const bf16_t* nb = PA + ((size_t)b * SEQ + (c + 1) * 32 + 4 * w) * 3072 + h * 128 + k0;
#pragma unroll
                for (int i = 0; i < 4; ++i) { rq[i] = *(const unsigned*)(nb + (size_t)i * 3072); rf[i] = *(const unsigned*)(nb + (size_t)i * 3072 + 1024); rv[i] = *(const unsigned*)(nb + (size_t)i * 3072 + 2048); }
            }
            bf16x8 qf[2][4], kf[2][4];
#pragma unroll
            for (int tt = 0; tt < 2; ++tt)
#pragma unroll
                for (int m = 0; m < 4; ++m) {
                    const LAS unsigned char* pq = base + OFF_QT + (16 * tt + fr) * QS + (32 * m + 4 * g) * 2;
                    const u32x2 lo = *(const LAS u32x2*)pq, hi = *(const LAS u32x2*)(pq + 32);
                    qf[tt][m] = __builtin_bit_cast(bf16x8, (u32x4){lo[0], lo[1], hi[0], hi[1]});
                    const LAS unsigned char* pk = base + OFF_KH + (16 * tt + fr) * QS + (32 * m + 4 * g) * 2;
                    const u32x2 lo2 = *(const LAS u32x2*)pk, hi2 = *(const LAS u32x2*)(pk + 32);
                    kf[tt][m] = __builtin_bit_cast(bf16x8, (u32x4){lo2[0], lo2[1], hi2[0], hi2[1]});
                }
            f32x4 PT00 = {0.f, 0.f, 0.f, 0.f}, PT01 = {0.f, 0.f, 0.f, 0.f}, PT11 = {0.f, 0.f, 0.f, 0.f};
#pragma unroll
            for (int m = 0; m < 4; ++m) {
                PT00 = __builtin_amdgcn_mfma_f32_16x16x32_bf16(kf[0][m], qf[0][m], PT00, 0, 0, 0);
                PT01 = __builtin_amdgcn_mfma_f32_16x16x32_bf16(kf[0][m], qf[1][m], PT01, 0, 0, 0);
                PT11 = __builtin_amdgcn_mfma_f32_16x16x32_bf16(kf[1][m], qf[1][m], PT11, 0, 0, 0);
            }
#pragma unroll
            for (int r = 0; r < 4; ++r) { if (4 * g + r > fr) { PT00[r] = 0.f; PT11[r] = 0.f; } }
            const bf16x8 pa0 = __builtin_bit_cast(bf16x8, (u32x4){pk2(PT00[0], PT00[1]), pk2(PT00[2], PT00[3]), 0u, 0u});
            const bf16x8 pa1 = __builtin_bit_cast(bf16x8, (u32x4){pk2(PT01[0], PT01[1]), pk2(PT01[2], PT01[3]), pk2(PT11[0], PT11[1]), pk2(PT11[2], PT11[3])});
            const LAS unsigned char* vrow = base + OFF_VT + (16 * w + fr) * TS;
            const u32x2 vpa = *(const LAS u32x2*)(vrow + 8 * g), vpb = *(const LAS u32x2*)(vrow + 32 + 8 * g);
            const u32x2 vna = *(const LAS u32x2*)(vrow + 16 * g), vnb = *(const LAS u32x2*)(vrow + 16 * g + 8);
            const bf16x8 vperm = __builtin_bit_cast(bf16x8, (u32x4){vpa[0], vpa[1], vpb[0], vpb[1]});
            const bf16x8 vnat = __builtin_bit_cast(bf16x8, (u32x4){vna[0], vna[1], vnb[0], vnb[1]});
#pragma unroll
            for (int kt = 0; kt < 8; ++kt) { const f32x4 e = *(const LAS f32x4*)(base + OFF_EREF + (16 * kt + 4 * g) * 4); S[kt] = S[kt] * e; }
            f32x4 O0 = {0.f, 0.f, 0.f, 0.f}, O1 = {0.f, 0.f, 0.f, 0.f};
#pragma unroll
            for (int m = 0; m < 4; ++m) {
                const bf16x8 sf = __builtin_bit_cast(bf16x8, (u32x4){pk2(S[2 * m][0], S[2 * m][1]), pk2(S[2 * m][2], S[2 * m][3]), pk2(S[2 * m + 1][0], S[2 * m + 1][1]), pk2(S[2 * m + 1][2], S[2 * m + 1][3])});
                O0 = __builtin_amdgcn_mfma_f32_16x16x32_bf16(qf[0][m], sf, O0, 0, 0, 0);
                O1 = __builtin_amdgcn_mfma_f32_16x16x32_bf16(qf[1][m], sf, O1, 0, 0, 0);
            }
            O0 = __builtin_amdgcn_mfma_f32_16x16x32_bf16(pa0, vperm, O0, 0, 0, 0);
            O1 = __builtin_amdgcn_mfma_f32_16x16x32_bf16(pa1, vperm, O1, 0, 0, 0);
#pragma unroll
            for (int kt = 0; kt < 8; ++kt) {
                const LAS unsigned char* krow = base + OFF_KT + (16 * kt + fr) * TS + 16 * g;
                const u32x2 ka = *(const LAS u32x2*)krow, kb = *(const LAS u32x2*)(krow + 8);
                const bf16x8 ktf = __builtin_bit_cast(bf16x8, (u32x4){ka[0], ka[1], kb[0], kb[1]});
                S[kt] = __builtin_amdgcn_mfma_f32_16x16x32_bf16(ktf, vnat, S[kt], 0, 0, 0);
            }
#pragma unroll
            for (int kt = 0; kt < 8; ++kt) { const f32x4 e = *(const LAS f32x4*)(base + OFF_ELR + (16 * kt + 4 * g) * 4); S[kt] = S[kt] * e; }
            bf16_t* orow = ORAW + ((size_t)b * SEQ + c * 32 + 4 * g) * D + h * 128 + 16 * w + fr;
#pragma unroll
            for (int r = 0; r < 4; ++r) { orow[(size_t)r * D] = (bf16_t)(pk2(O0[r], 0.f) & 0xffffu); orow[(size_t)(16 + r) * D] = (bf16_t)(pk2(O1[r], 0.f) & 0xffffu); }
        }
        __syncthreads();
    }
}

__device__ __forceinline__ void phase_s5(const KP& p, LAS unsigned char* lds, int l, int G, size_t ys_off) {
    const int tid = opaque_tid(), lane = tid & 63, w = __builtin_amdgcn_readfirstlane(tid >> 6), fr = lane & 15, g = lane >> 4;
    const int gw = blockIdx.x * 8 + w, ngw = G * 8;
    constexpr int BUS = 132;
    LAS float* BU = (LAS float*)(lds + w * 16896);
    LAS unsigned char* XI = (LAS unsigned char*)BU;
    const bf16_t* PB = (const bf16_t*)(p.ws + WS_R0);
    const bf16x8 zero8 = {0, 0, 0, 0, 0, 0, 0, 0};
    const bf16_t* ORAWs = (const bf16_t*)(p.ws + WS_OR); float* SSQs = (float*)(p.ws + WS_SSQ);
    for (int unit = gw; unit < BATCH * 64; unit += ngw) {
        const int b = unit >> 6, grp = unit & 63, lg = l * 64 + grp;
        const bf16_t* BOP = (const bf16_t*)(p.ws + WS_BOP) + (size_t)lg * 128 * 16;
        const bf16_t* COP = (const bf16_t*)(p.ws + WS_COP) + (size_t)lg * 16 * 128;
        bf16x8 bfrag[8], cfrag[4], dfrag;
#pragma unroll
        for (int nt = 0; nt < 8; ++nt) bfrag[nt] = (g < 2) ? *(const bf16x8*)(BOP + (size_t)(16 * nt + fr) * 16 + 8 * g) : zero8;
#pragma unroll
        for (int ks = 0; ks < 4; ++ks) cfrag[ks] = DBG_S5_NOSSM ? zero8 : *(const bf16x8*)(COP + (size_t)fr * 128 + 32 * ks + 8 * g);
        {
            const unsigned dbits = pk2(p.in[I_S5D][l * 1024 + grp * 16 + fr], 0.f) & 0xffffu;
#pragma unroll
            for (int j = 0; j < 8; ++j) dfrag[j] = (g < 2 && (8 * g + j) == fr) ? (short)dbits : (short)0;
        }
        const float ar = ((const float*)(p.ws + WS_ABAR))[2 * ((size_t)lg * 64 + lane)], ai = ((const float*)(p.ws + WS_ABAR))[2 * ((size_t)lg * 64 + lane) + 1];
        const float nai = -ai; float xr = 0.f, xi = 0.f; unsigned hBU = 0u, hXI = 0u, hY = 0u;
        const bf16_t* ub = PB + ((size_t)b * SEQ) * 4096 + 1024 + grp * 16;
        bf16_t* yb_ = (bf16_t*)(p.ws + ys_off) + ((size_t)b * SEQ) * D + grp * 16;
        bf16x8 unext[2];
#pragma unroll
        for (int tt = 0; tt < 2; ++tt) unext[tt] = (g < 2) ? *(const bf16x8*)(ub + (size_t)(16 * tt + fr) * 4096 + 8 * g) : zero8;
        const bool cvt_next = (l + 1 < DEPTH);
        const float* tsrc = ((lane < 32) ? p.in[I_PU] : p.in[I_PV]) + (size_t)(l + 1 < DEPTH ? l + 1 : l) * 16384 * 1024 + 4 * (lane & 31);
        unsigned char* tdst = p.ws + ((lane < 32) ? WS_U : WS_V) + (size_t)((l + 1) & 1) * TAB_BYTES + 4 * (lane & 31);
        const float tscale = (lane < 32) ? U_SCALE : V_SCALE;
        for (int t0 = 0; t0 < SEQ; t0 += 32) {
            const int item = unit * 64 + (t0 >> 5), te = item >> 3, tsl = item & 7;
            f32x4 tv = {0.f, 0.f, 0.f, 0.f}; if (cvt_next) tv = *(const f32x4*)(tsrc + (size_t)te * 1024 + tsl * 128);
            const bool ssq_it = ((t0 >> 5) & 1) == 0; const int srow = item >> 1;
            u32x4 sa = {0u, 0u, 0u, 0u}, sc2 = {0u, 0u, 0u, 0u};
            if (ssq_it) { sa = *(const u32x4*)(ORAWs + (size_t)srow * D + 8 * lane); sc2 = *(const u32x4*)(ORAWs + (size_t)srow * D + 512 + 8 * lane); }
            bf16x8 ufrag[2];
#pragma unroll
            for (int tt = 0; tt < 2; ++tt) { ufrag[tt] = unext[tt]; if (t0 + 32 < SEQ) unext[tt] = (g < 2) ? *(const bf16x8*)(ub + (size_t)(t0 + 32 + 16 * tt + fr) * 4096 + 8 * g) : zero8; }
#pragma unroll
            for (int tt = 0; tt < 2; ++tt)
#pragma unroll
                for (int nt = 0; nt < 8; ++nt) {
                    const f32x4 a = __builtin_amdgcn_mfma_f32_16x16x32_bf16(ufrag[tt], bfrag[nt], (f32x4){0.f, 0.f, 0.f, 0.f}, 0, 0, 0);
#pragma unroll
                    for (int r = 0; r < 4; ++r) BU[(16 * tt + 4 * g + r) * BUS + 16 * nt + fr] = a[r];
                }
            LDS_WAIT();
#pragma unroll
            for (int t = 0; t < 32; ++t) {
                const f32x2 bb = *(const LAS f32x2*)(BU + t * BUS + 2 * lane); hBU += __float_as_uint(bb[0]) * 3u + __float_as_uint(bb[1]);
                float t1, t2, nr, ni;
                asm("v_fma_f32 %0, %1, %2, %3" : "=v"(t1) : "v"(nai), "v"(xi), "v"(bb[0]));
                asm("v_fma_f32 %0, %1, %2, %3" : "=v"(t2) : "v"(ai), "v"(xr), "v"(bb[1]));
                asm("v_fma_f32 %0, %1, %2, %3" : "=v"(nr) : "v"(ar), "v"(xr), "v"(t1));
                asm("v_fma_f32 %0, %1, %2, %3" : "=v"(ni) : "v"(ar), "v"(xi), "v"(t2));
                xr = nr; xi = ni;
                { const unsigned pv = pk2(nr, ni); hXI += pv; *(LAS unsigned*)(XI + t * (BUS * 4) + lane * 4) = pv; }
            }
            LDS_WAIT();
#pragma unroll
            for (int tt = 0; tt < 2; ++tt) {
                f32x4 y = {0.f, 0.f, 0.f, 0.f};
#pragma unroll
                for (int ks = 0; ks < 4; ++ks) {
                    const bf16x8 xf = *(const LAS bf16x8*)(XI + (16 * tt + fr) * (BUS * 4) + (32 * ks + 8 * g) * 2);
                    y = __builtin_amdgcn_mfma_f32_16x16x32_bf16(xf, cfrag[ks], y, 0, 0, 0);
                }
                y = __builtin_amdgcn_mfma_f32_16x16x32_bf16(ufrag[tt], dfrag, y, 0, 0, 0);
#pragma unroll
                for (int r = 0; r < 4; ++r) { const unsigned yv = pk2(fgelu(y[r]), 0.f) & 0xffffu; hY += yv * (unsigned)(r + 1); yb_[(size_t)(t0 + 16 * tt + 4 * g + r) * D + fr] = (bf16_t)yv; }
            }
            LDS_WAIT();
            if (ssq_it) { float s0 = 0.f, s1 = 0.f;
#pragma unroll
                for (int j = 0; j < 4; ++j) { const float x0 = bflo(sa[j]), x1 = bfhi(sa[j]), y0 = bflo(sc2[j]), y1 = bfhi(sc2[j]); s0 += x0 * x0 + x1 * x1; s1 += y0 * y0 + y1 * y1; }
                { s0 = dpp_sum8(s0); s1 = dpp_sum8(s1);
                  s0 += __uint_as_float(__builtin_amdgcn_update_dpp(0, __float_as_uint(s0), 0x140, 0xF, 0xF, true)); s1 += __uint_as_float(__builtin_amdgcn_update_dpp(0, __float_as_uint(s1), 0x140, 0xF, 0xF, true)); }
                if (fr == 0) { SSQs[(size_t)srow * 8 + g] = s0; SSQs[(size_t)srow * 8 + 4 + g] = s1; } }
            if (cvt_next) { int w8 = 0; w8 = __builtin_amdgcn_cvt_pk_fp8_f32(tv[0] * tscale, tv[1] * tscale, w8, false); w8 = __builtin_amdgcn_cvt_pk_fp8_f32(tv[2] * tscale, tv[3] * tscale, w8, true);
                *(unsigned*)(tdst + ((size_t)tsl * 16384 + te) * 128) = (unsigned)w8; }
        }
        if (DBG_SELFCHECK) { for (int o = 1; o < 64; o <<= 1) { hBU += __shfl_xor((int)hBU, o); hXI += __shfl_xor((int)hXI, o); hY += __shfl_xor((int)hY, o); }
            unsigned* hs = (unsigned*)(p.ws + WS_CTL) + 65536 + (ys_off == WS_YS ? 0 : 8192) + unit * 4; unsigned hA = __float_as_uint(ar) * 7u + __float_as_uint(ai); for (int o = 1; o < 64; o <<= 1) hA += __shfl_xor((int)hA, o); if (lane == 0) { hs[0] = hBU; hs[1] = hXI; hs[2] = hA; } }
    }
}

__device__ __forceinline__ unsigned fkey(float f) { const unsigned u = __float_as_uint(f); return u ^ ((unsigned)((int)u >> 31) | 0x80000000u); }
__device__ __forceinline__ float kval(unsigned k) { const unsigned u = (k & 0x80000000u) ? (k ^ 0x80000000u) : ~k; return __uint_as_float(u); }
#define CE_DESC(a, b) do { const unsigned _mx = (a) > (b) ? (a) : (b), _mn = (a) > (b) ? (b) : (a); (a) = _mx; (b) = _mn; } while (0)
__device__ __forceinline__ void sort16_desc(unsigned (&a)[16]) {
#pragma unroll
    for (int kk = 1; kk <= 4; ++kk)
#pragma unroll
        for (int jj = kk - 1; jj >= 0; --jj)
#pragma unroll
            for (int i = 0; i < 16; ++i) { const int k = 1 << kk, j = 1 << jj, l2 = i ^ j;
                if (l2 > i) { if ((i & k) == 0) CE_DESC(a[i], a[l2]); else CE_DESC(a[l2], a[i]); } }
}
__device__ __forceinline__ void merge_top16(unsigned (&a)[16], const unsigned (&b)[16]) {
#pragma unroll
    for (int i = 0; i < 16; ++i) a[i] = a[i] > b[15 - i] ? a[i] : b[15 - i];
#pragma unroll
    for (int jj = 3; jj >= 0; --jj)
#pragma unroll
        for (int i = 0; i < 16; ++i) { const int j = 1 << jj, l2 = i ^ j; if (l2 > i) CE_DESC(a[i], a[l2]); }
}
__device__ __forceinline__ void phase_topk(const KP& p, LAS unsigned char* lds, int G) {
    const int tid = opaque_tid(), lane = tid & 63, w = __builtin_amdgcn_readfirstlane(tid >> 6), hh = lane >> 5;
    const int gw = blockIdx.x * 8 + w, ngw = G * 8;
    const bf16_t* Q = (const bf16_t*)(p.ws + WS_R0); const bf16_t* KEYS = (const bf16_t*)(p.ws + WS_KEYS);
    unsigned* SEL = (unsigned*)(p.ws + WS_SEL);
    LAS unsigned char* tab = lds + w * 2048 + lane * 32;
    const int CI[50] = {0,0,0,0,0,0,0,0,0,0,0,0,0,0,0,0, 1,1,1,1,1,1,1,1, 2,2,2,2,2, 3,3,3,3, 4,4,4, 5,5, 6,6, 7,7, 8,9,10,11,12,13,14,15};
    const int CJ[50] = {0,1,2,3,4,5,6,7,8,9,10,11,12,13,14,15, 0,1,2,3,4,5,6,7, 0,1,2,3,4, 0,1,2,3, 0,1,2, 0,1, 0,1, 0,1, 0,0,0,0,0,0,0,0};
    LAS unsigned char* kimg = lds + 16384;
    for (int h = 0; h < 8; ++h) {
      __syncthreads();
#pragma unroll
      for (int i = 0; i < 8; ++i) { const int ch = tid + 512 * i, row = ch >> 4, c16 = ch & 15;
          *(LAS u32x4*)(kimg + row * 272 + c16 * 16) = *(const u32x4*)(KEYS + (size_t)(h * 256 + row) * 128 + c16 * 8); }
      __syncthreads();
      for (int tg = gw; tg < 2048; tg += ngw) {
        const int t = tg * 32 + (lane & 31);
        unsigned top[2][16];
#pragma unroll
        for (int pp = 0; pp < 2; ++pp) {
            bf16x8 qf[8];
#pragma unroll
            for (int ks = 0; ks < 8; ++ks) qf[ks] = *(const bf16x8*)(Q + ((size_t)((((tg * 8 + h) * 2 + pp) * 8 + ks) * 64 + lane)) * 8);
            const LAS unsigned char* kb = kimg + (pp * 128 + (lane & 31)) * 272 + 16 * hh;
#pragma unroll
            for (int nt = 0; nt < 4; ++nt) {
                f32x16 acc;
#pragma unroll
                for (int i = 0; i < 16; ++i) acc[i] = 0.f;
#pragma unroll
                for (int ks = 0; ks < 8; ++ks) { const bf16x8 kf = *(const LAS bf16x8*)(kb + (32 * nt) * 272 + 32 * ks);
                    acc = __builtin_amdgcn_mfma_f32_32x32x16_bf16(kf, qf[ks], acc, 0, 0, 0); }
                unsigned ky[16];
#pragma unroll
                for (int r = 0; r < 16; ++r) ky[r] = (fkey(acc[r]) & ~127u) | (unsigned)(32 * nt + (r & 3) + 8 * (r >> 2)) | (unsigned)(4 * hh);
                sort16_desc(ky);
                if (nt == 0) {
#pragma unroll
                    for (int i = 0; i < 16; ++i) top[pp][i] = ky[i];
                } else merge_top16(top[pp], ky);
            }
            unsigned other[16];
#pragma unroll
            for (int i = 0; i < 16; ++i) { const u32x2 sw_ = __builtin_amdgcn_permlane32_swap(top[pp][i], top[pp][i], false, false); other[i] = hh ? sw_[0] : sw_[1]; }
            merge_top16(top[pp], other);
        }
        float sa[16], sb[16];
#pragma unroll
        for (int i = 0; i < 16; ++i) { sa[i] = kval(top[0][i] & ~127u); sb[i] = kval(top[1][i] & ~127u); }
        unsigned c0[16], c1[16];
#pragma unroll
        for (int s = 0; s < 32; ++s) {
            unsigned key = 0u;
            if (s < 25) {
                const float v0 = sa[CI[s]] + sb[CJ[s]], v1 = sa[CI[25 + s]] + sb[CJ[25 + s]];
                const unsigned k0 = (fkey(v0) & ~255u) | (unsigned)(CI[s] * 16 + CJ[s]), k1 = (fkey(v1) & ~255u) | (unsigned)(CI[25 + s] * 16 + CJ[25 + s]);
                key = hh ? k1 : k0;
            }
            if (s < 16) c0[s] = key; else c1[s - 16] = key;
        }
        sort16_desc(c0); sort16_desc(c1); merge_top16(c0, c1);
#pragma unroll
        for (int i = 0; i < 16; ++i) { const u32x2 sw_ = __builtin_amdgcn_permlane32_swap(c0[i], c0[i], false, false); c1[i] = hh ? sw_[0] : sw_[1]; }
        merge_top16(c0, c1);
        {
            u32x4 wa, wb;
#pragma unroll
            for (int q4 = 0; q4 < 4; ++q4) {
                wa[q4] = (top[0][4 * q4] & 127u) | ((top[0][4 * q4 + 1] & 127u) << 8) | ((top[0][4 * q4 + 2] & 127u) << 16) | ((top[0][4 * q4 + 3] & 127u) << 24);
                wb[q4] = (top[1][4 * q4] & 127u) | ((top[1][4 * q4 + 1] & 127u) << 8) | ((top[1][4 * q4 + 2] & 127u) << 16) | ((top[1][4 * q4 + 3] & 127u) << 24);
            }
            *(LAS u32x4*)tab = wa; *(LAS u32x4*)(tab + 16) = wb;
        }
        float ev[16], esum = 0.f; const float vmax = kval(c0[0] & ~255u);
#pragma unroll
        for (int k = 0; k < 16; ++k) { ev[k] = __expf(kval(c0[k] & ~255u) - vmax); esum += ev[k]; }
        const float rs = 1.0f / esum;
        LDS_WAIT();
        unsigned outw[8]; const unsigned hmask = hh ? 0xffffffffu : 0u;
#pragma unroll
        for (int kk = 0; kk < 8; ++kk) {
            const unsigned key = c0[kk] ^ ((c0[kk] ^ c0[8 + kk]) & hmask); const float e = __uint_as_float(__float_as_uint(ev[kk]) ^ ((__float_as_uint(ev[kk]) ^ __float_as_uint(ev[8 + kk])) & hmask));
            const unsigned code = key & 255u, ia = tab[code >> 4], ib = tab[16 + (code & 15u)];
            outw[kk] = (pk2(0.f, e * rs) & 0xffff0000u) | (ia * 128u + ib);
        }
        u32x4* dst = (u32x4*)(SEL + (size_t)t * 128 + h * 16 + hh * 8);
        dst[0] = (u32x4){outw[0], outw[1], outw[2], outw[3]}; dst[1] = (u32x4){outw[4], outw[5], outw[6], outw[7]};
        LDS_WAIT();
      }
    }
    __syncthreads();
}

__device__ __forceinline__ void fp8x4_to_f32(unsigned w, float& a, float& b, float& c, float& d) {
    const f32x2 lo = __builtin_amdgcn_cvt_pk_f32_fp8((int)w, false), hi = __builtin_amdgcn_cvt_pk_f32_fp8((int)w, true); a = lo[0]; b = lo[1]; c = hi[0]; d = hi[1];
}
struct XSlice { int sl, rank, nloc; };
__device__ __forceinline__ XSlice xslice_of_block(const KP& p, volatile LAS unsigned* MISC, int G) {
    unsigned* bar = (unsigned*)(p.ws + WS_CTL) + 4096; unsigned cnt[8]; unsigned tot = 0; bool ok = true;
#pragma unroll
    for (int j = 0; j < 8; ++j) { cnt[j] = xb_ld(&bar[XB_XCNT(j)]); tot += cnt[j]; ok = ok && (cnt[j] > 0u); }
    ok = ok && (tot == (unsigned)G);
    XSlice x;
    if (ok) { const unsigned myx = MISC[16]; x.sl = (int)myx; x.rank = (int)MISC[17]; x.nloc = (int)cnt[myx & 7u]; }
    else { x.sl = (int)(blockIdx.x & 7); x.rank = (int)(blockIdx.x >> 3); x.nloc = (G - x.sl + 7) >> 3; }
    x.sl = __builtin_amdgcn_readfirstlane(x.sl); x.rank = __builtin_amdgcn_readfirstlane(x.rank); x.nloc = __builtin_amdgcn_readfirstlane(x.nloc);
    return x;
}
__device__ __forceinline__ float dot16_fp8(const u32x4 u, const float (&hf)[16]) {
    float d = 0.f;
#pragma unroll
    for (int j = 0; j < 4; ++j) { float f0, f1, f2, f3; fp8x4_to_f32(u[j], f0, f1, f2, f3);
        d = __builtin_fmaf(f0, hf[4 * j], d); d = __builtin_fmaf(f1, hf[4 * j + 1], d); d = __builtin_fmaf(f2, hf[4 * j + 2], d); d = __builtin_fmaf(f3, hf[4 * j + 3], d); }
    return d;
}
typedef __bf16 bf16v8 __attribute__((ext_vector_type(8)));
__device__ __forceinline__ float dot16_fp8_bf16(const u32x4 u, const bf16v8 h0, const bf16v8 h1) {
    float d0 = 0.f, d1 = 0.f;
    d0 = __builtin_amdgcn_fdot2_f32_bf16(__builtin_amdgcn_cvt_scalef32_pk_bf16_fp8(u[0], 1.0f, false), __builtin_shufflevector(h0, h0, 0, 1), d0, false);
    d1 = __builtin_amdgcn_fdot2_f32_bf16(__builtin_amdgcn_cvt_scalef32_pk_bf16_fp8(u[0], 1.0f, true),  __builtin_shufflevector(h0, h0, 2, 3), d1, false);
    d0 = __builtin_amdgcn_fdot2_f32_bf16(__builtin_amdgcn_cvt_scalef32_pk_bf16_fp8(u[1], 1.0f, false), __builtin_shufflevector(h0, h0, 4, 5), d0, false);
    d1 = __builtin_amdgcn_fdot2_f32_bf16(__builtin_amdgcn_cvt_scalef32_pk_bf16_fp8(u[1], 1.0f, true),  __builtin_shufflevector(h0, h0, 6, 7), d1, false);
    d0 = __builtin_amdgcn_fdot2_f32_bf16(__builtin_amdgcn_cvt_scalef32_pk_bf16_fp8(u[2], 1.0f, false), __builtin_shufflevector(h1, h1, 0, 1), d0, false);
    d1 = __builtin_amdgcn_fdot2_f32_bf16(__builtin_amdgcn_cvt_scalef32_pk_bf16_fp8(u[2], 1.0f, true),  __builtin_shufflevector(h1, h1, 2, 3), d1, false);
    d0 = __builtin_amdgcn_fdot2_f32_bf16(__builtin_amdgcn_cvt_scalef32_pk_bf16_fp8(u[3], 1.0f, false), __builtin_shufflevector(h1, h1, 4, 5), d0, false);
    d1 = __builtin_amdgcn_fdot2_f32_bf16(__builtin_amdgcn_cvt_scalef32_pk_bf16_fp8(u[3], 1.0f, true),  __builtin_shufflevector(h1, h1, 6, 7), d1, false);
    return d0 + d1;
}
__device__ __forceinline__ float dpp_sum8(float d) {
    d += __uint_as_float(__builtin_amdgcn_update_dpp(0, __float_as_uint(d), 0xB1, 0xF, 0xF, true));
    d += __uint_as_float(__builtin_amdgcn_update_dpp(0, __float_as_uint(d), 0x4E, 0xF, 0xF, true));
    d += __uint_as_float(__builtin_amdgcn_update_dpp(0, __float_as_uint(d), 0x141, 0xF, 0xF, true));
    return d;
}
__device__ __forceinline__ void phase_expert_u(const KP& p, LAS unsigned char* lds, volatile LAS unsigned* MISC, int l, int G) {
    const int tid = opaque_tid(), lane = tid & 63, w = __builtin_amdgcn_readfirstlane(tid >> 6), j = lane >> 3, c = lane & 7;
    const XSlice xs = xslice_of_block(p, MISC, G);
    const bf16_t* H2 = (const bf16_t*)(p.ws + WS_H); const unsigned char* Us = p.ws + WS_U + (size_t)(l & 1) * TAB_BYTES + (size_t)xs.sl * 16384 * 128;
    const unsigned* SEL = (const unsigned*)(p.ws + WS_SEL); unsigned* PDu = (unsigned*)(p.ws + WS_R0) + (size_t)xs.sl * M * 64;
    const int t0 = xs.rank * 8 + w, tstep = xs.nloc * 8;
    LAS unsigned char* ring = lds + w * 17920;
    LAS unsigned char* selb = ring + 16384; LAS unsigned char* hbuf = ring + 16384 + 1024;
    const int tlast = t0 + ((M - 1 - t0) / tstep) * tstep;
#define E1_CL(t) ((t) <= tlast ? (t) : tlast)
#define E1_DMA_SEL(t, par) do { const unsigned* sp = SEL + (size_t)E1_CL(t) * 128 + lane; \
            __builtin_amdgcn_global_load_lds(sp, (LAS unsigned*)(selb + (par) * 512), 4, 0, 0); __builtin_amdgcn_global_load_lds(sp + 64, (LAS unsigned*)(selb + (par) * 512 + 256), 4, 0, 0); } while (0)
#define E1_DMA_H(t, par) do { __builtin_amdgcn_global_load_lds((const unsigned*)(H2 + (size_t)E1_CL(t) * D + xs.sl * 128) + lane, (LAS unsigned*)(hbuf + (par) * 256), 4, 0, 0); } while (0)
#define E1_DMA_ROW(i, idxv) do { __builtin_amdgcn_global_load_lds((const unsigned*)(Us + (size_t)((idxv) & 0x3fffu) * 128 + 16 * c), (LAS unsigned*)(ring + (i) * 1024), 16, 0, 0); } while (0)
    if (t0 < M) {
        E1_DMA_SEL(t0, 0); E1_DMA_SEL(t0 + tstep, 1); E1_DMA_H(t0, 0);
        asm volatile("s_waitcnt vmcnt(0)" ::: "memory");
        { u32x4 s0[4];
#pragma unroll
          for (int q = 0; q < 4; ++q) s0[q] = *(const LAS u32x4*)(selb + (16 * j + 4 * q) * 4);
#pragma unroll
          for (int i = 0; i < 16; ++i) E1_DMA_ROW(i, s0[i >> 2][i & 3]); }
        { PDu[(size_t)t0 * 64 + 8 * j + (c >> 1) + 4 * (c & 1)] = 0u; }
        int par = 0;
        for (int tok = t0; tok < M; tok += tstep, par ^= 1) {
            E1_DMA_SEL(tok + 2 * tstep, par); E1_DMA_H(tok + tstep, par ^ 1);
            asm volatile("s_waitcnt vmcnt(19)" ::: "memory");
            u32x4 sn[4];
#pragma unroll
            for (int q = 0; q < 4; ++q) sn[q] = *(const LAS u32x4*)(selb + (par ^ 1) * 512 + (16 * j + 4 * q) * 4);
            const bf16v8 hb0 = *(const LAS bf16v8*)(hbuf + par * 256 + 32 * c), hb1 = *(const LAS bf16v8*)(hbuf + par * 256 + 32 * c + 16);
            float pd0 = 0.f, pd1 = 0.f;
#pragma unroll
            for (int i0 = 0; i0 < 16; i0 += 4) {
                asm volatile("s_waitcnt vmcnt(16)" ::: "memory");
                u32x4 row[4];
#pragma unroll
                for (int r = 0; r < 4; ++r) row[r] = *(const LAS u32x4*)(ring + (i0 + r) * 1024 + 16 * lane);
                asm volatile("s_waitcnt lgkmcnt(0)" ::: "memory");
#pragma unroll
                for (int r = 0; r < 4; ++r) E1_DMA_ROW(i0 + r, sn[(i0 + r) >> 2][(i0 + r) & 3]);
#pragma unroll
                for (int r = 0; r < 4; ++r) { const int i = i0 + r; const float d = dpp_sum8(dot16_fp8_bf16(row[r], hb0, hb1));
                    if (i < 8) pd0 = (c == i) ? d : pd0; else pd1 = (c == i - 8) ? d : pd1; }
            }
            { const float nb0 = __uint_as_float(__builtin_amdgcn_update_dpp(0, __float_as_uint(pd0), 0xB1, 0xF, 0xF, true)), nb1 = __uint_as_float(__builtin_amdgcn_update_dpp(0, __float_as_uint(pd1), 0xB1, 0xF, 0xF, true));
              PDu[(size_t)tok * 64 + 8 * j + (c >> 1) + 4 * (c & 1)] = (c & 1) ? pk2(nb1, pd1) : pk2(pd0, nb0); }
        }
        asm volatile("s_waitcnt vmcnt(0)" ::: "memory");
    }
#undef E1_CL
#undef E1_DMA_SEL
#undef E1_DMA_H
#undef E1_DMA_ROW
}
__device__ __forceinline__ void phase_expert_w(const KP& p, int G) {
    const int tid = opaque_tid(), lane = tid & 63, w = __builtin_amdgcn_readfirstlane(tid >> 6);
    const int gw = blockIdx.x * 8 + w, ngw = G * 8;
    unsigned* SEL = (unsigned*)(p.ws + WS_SEL); const unsigned* PDu = (const unsigned*)(p.ws + WS_R0);
    for (int tok0 = gw; tok0 < M; tok0 += 4 * ngw) {
        unsigned pw[4][8]; u32x2 s2[4];
#pragma unroll
        for (int k = 0; k < 4; ++k) { const int tok = (tok0 + k * ngw < M) ? tok0 + k * ngw : tok0;
#pragma unroll
            for (int sl = 0; sl < 8; ++sl) pw[k][sl] = PDu[((size_t)sl * M + tok) * 64 + lane];
            s2[k] = *(const u32x2*)(SEL + (size_t)tok * 128 + 2 * lane); }
#pragma unroll
        for (int k = 0; k < 4; ++k) { const int tok = tok0 + k * ngw;
            f32x2 d = {0.f, 0.f};
#pragma unroll
            for (int sl = 0; sl < 8; ++sl) { d[0] += bflo(pw[k][sl]); d[1] += bfhi(pw[k][sl]); }
            const float w0 = __uint_as_float(s2[k][0] & 0xffff0000u) * fgelu(d[0] * (1.0f / U_SCALE)) * (1.0f / V_SCALE);
            const float w1 = __uint_as_float(s2[k][1] & 0xffff0000u) * fgelu(d[1] * (1.0f / U_SCALE)) * (1.0f / V_SCALE);
            u32x2 o; o[0] = (pk2(0.f, w0) & 0xffff0000u) | (s2[k][0] & 0x3fffu); o[1] = (pk2(0.f, w1) & 0xffff0000u) | (s2[k][1] & 0x3fffu);
            if (tok < M) *(u32x2*)(SEL + (size_t)tok * 128 + 2 * lane) = o; }
    }
}
__device__ __forceinline__ void phase_expert_v(const KP& p, LAS unsigned char* lds, volatile LAS unsigned* MISC, int l, int G) {
    const int tid = opaque_tid(), lane = tid & 63, w = __builtin_amdgcn_readfirstlane(tid >> 6), j = lane >> 3, c = lane & 7;
    const XSlice xs = xslice_of_block(p, MISC, G);
    const unsigned char* Vs = p.ws + WS_V + (size_t)(l & 1) * TAB_BYTES + (size_t)xs.sl * 16384 * 128;
    const unsigned* SEL = (const unsigned*)(p.ws + WS_SEL);
    const float* g2 = (const float*)(p.ws + WS_MOD) + (size_t)l * 32 * NMODC + 5120;
    const bf16_t* X = (const bf16_t*)p.out; bf16_t* XO = (l == DEPTH - 1) ? (bf16_t*)(p.ws + WS_YS) : (bf16_t*)p.out;
    const int t0 = xs.rank * 8 + w, tstep = xs.nloc * 8;
    const bool b3 = (lane & 8) != 0;
    LAS unsigned char* ring = lds + w * 17920; LAS unsigned char* selb = ring + 16384;
    const int tlast = t0 + ((M - 1 - t0) / tstep) * tstep;
#define E2_CL(t) ((t) <= tlast ? (t) : tlast)
#define E2_DMA_SEL(t, par) do { const unsigned* sp = SEL + (size_t)E2_CL(t) * 128 + lane; \
            __builtin_amdgcn_global_load_lds(sp, (LAS unsigned*)(selb + (par) * 512), 4, 0, 0); __builtin_amdgcn_global_load_lds(sp + 64, (LAS unsigned*)(selb + (par) * 512 + 256), 4, 0, 0); } while (0)
#define E2_DMA_ROW(i, idxv) do { __builtin_amdgcn_global_load_lds((const unsigned*)(Vs + (size_t)((idxv) & 0x3fffu) * 128 + 16 * c), (LAS unsigned*)(ring + (i) * 1024), 16, 0, 0); } while (0)
    if (t0 < M) {
        E2_DMA_SEL(t0, 0); E2_DMA_SEL(t0 + tstep, 1);
        asm volatile("s_waitcnt vmcnt(0)" ::: "memory");
        u32x4 sc[4];
#pragma unroll
        for (int q = 0; q < 4; ++q) sc[q] = *(const LAS u32x4*)(selb + (16 * j + 4 * q) * 4);
#pragma unroll
        for (int i = 0; i < 16; ++i) E2_DMA_ROW(i, sc[i >> 2][i & 3]);
        LAS float* xbuf = (LAS float*)(ring + 16384 + 1024);
        { const bf16_t* xd = X + (size_t)t0 * D + xs.sl * 128 + 16 * c + 2 * j; __builtin_amdgcn_global_load_lds((const unsigned*)xd, (LAS unsigned*)xbuf, 4, 0, 0); }
        int par = 0, bcur = -1; f32x2 gv = {0.f, 0.f};
        for (int tok = t0; tok < M; tok += tstep, par ^= 1) {
            const int dim = xs.sl * 128 + 16 * c + 2 * j;
            const size_t xo = (size_t)tok * D + dim;
            if ((tok >> 11) != bcur) { bcur = tok >> 11; const f32x2 gl = *(const f32x2*)(g2 + (size_t)bcur * NMODC + dim); asm volatile("s_waitcnt vmcnt(0)" ::: "memory"); gv[0] = gl[0] * 1.0f; gv[1] = gl[1] * 1.0f; asm volatile("" : "+v"(gv)); }
            E2_DMA_SEL(tok + 2 * tstep, par);
            __builtin_amdgcn_global_load_lds((const unsigned*)(X + xo), (LAS unsigned*)xbuf, 4, 0, 0);
            asm volatile("s_waitcnt vmcnt(20)" ::: "memory");
            u32x4 sn[4];
#pragma unroll
            for (int q = 0; q < 4; ++q) sn[q] = *(const LAS u32x4*)(selb + (par ^ 1) * 512 + (16 * j + 4 * q) * 4);
            f32x2 o2[8];
#pragma unroll
            for (int q = 0; q < 8; ++q) o2[q] = (f32x2){0.f, 0.f};
#pragma unroll
            for (int i0 = 0; i0 < 16; i0 += 4) {
                asm volatile("s_waitcnt vmcnt(16)" ::: "memory");
                u32x4 row[4];
#pragma unroll
                for (int r = 0; r < 4; ++r) row[r] = *(const LAS u32x4*)(ring + (i0 + r) * 1024 + 16 * lane);
                asm volatile("s_waitcnt lgkmcnt(0)" ::: "memory");
#pragma unroll
                for (int r = 0; r < 4; ++r) E2_DMA_ROW(i0 + r, sn[(i0 + r) >> 2][(i0 + r) & 3]);
                {
                    const u32x2 wA = {sc[i0 >> 2][0], sc[i0 >> 2][1]}, wB = {sc[i0 >> 2][2], sc[i0 >> 2][3]};
#pragma unroll
                    for (int r = 0; r < 4; ++r)
#pragma unroll
                        for (int q = 0; q < 4; ++q) { const f32x2 lo = __builtin_amdgcn_cvt_pk_f32_fp8((int)row[r][q], false), hi = __builtin_amdgcn_cvt_pk_f32_fp8((int)row[r][q], true);
                            if (r & 1) { asm("v_pk_fma_f32 %0, %1, %2, %0 op_sel:[1,0,0] op_sel_hi:[1,1,1]" : "+v"(o2[2 * q]) : "v"(r < 2 ? wA : wB), "v"(lo));
                                         asm("v_pk_fma_f32 %0, %1, %2, %0 op_sel:[1,0,0] op_sel_hi:[1,1,1]" : "+v"(o2[2 * q + 1]) : "v"(r < 2 ? wA : wB), "v"(hi)); }
                            else       { asm("v_pk_fma_f32 %0, %1, %2, %0 op_sel:[0,0,0] op_sel_hi:[0,1,1]" : "+v"(o2[2 * q]) : "v"(r < 2 ? wA : wB), "v"(lo));
                                         asm("v_pk_fma_f32 %0, %1, %2, %0 op_sel:[0,0,0] op_sel_hi:[0,1,1]" : "+v"(o2[2 * q + 1]) : "v"(r < 2 ? wA : wB), "v"(hi)); } }
                }
            }
            float o[16];
#pragma unroll
            for (int q = 0; q < 8; ++q) { o[2 * q] = o2[q][0]; o[2 * q + 1] = o2[q][1]; }
            float r8[8], r4[4], r2[2];
#pragma unroll
            for (int k = 0; k < 8; ++k) { const u32x2 sw = __builtin_amdgcn_permlane32_swap(__float_as_uint(o[k]), __float_as_uint(o[8 + k]), false, false); r8[k] = __uint_as_float(sw[0]) + __uint_as_float(sw[1]); }
#pragma unroll
            for (int k = 0; k < 4; ++k) { const u32x2 sw = __builtin_amdgcn_permlane16_swap(__float_as_uint(r8[k]), __float_as_uint(r8[4 + k]), false, false); r4[k] = __uint_as_float(sw[0]) + __uint_as_float(sw[1]); }
#pragma unroll
            for (int k = 0; k < 2; ++k) { const float keep = b3 ? r4[2 + k] : r4[k], send = b3 ? r4[k] : r4[2 + k];
                r2[k] = keep + __uint_as_float(__builtin_amdgcn_update_dpp(0, __float_as_uint(send), 0x128, 0xF, 0xF, true)); }
            asm volatile("s_waitcnt vmcnt(16)" ::: "memory");
            { const unsigned xw = __float_as_uint(xbuf[lane]); *(unsigned*)(XO + xo) = pk2(bflo(xw) + gv[0] * r2[0], bfhi(xw) + gv[1] * r2[1]); }
#pragma unroll
            for (int q = 0; q < 4; ++q) sc[q] = sn[q];
        }
        asm volatile("s_waitcnt vmcnt(0)" ::: "memory");
    }
#undef E2_CL
#undef E2_DMA_SEL
#undef E2_DMA_ROW
}

__device__ __forceinline__ void phase_final(const KP& p, int G) {
    const int tid = opaque_tid(), lane = tid & 63, w = __builtin_amdgcn_readfirstlane(tid >> 6);
    const int gw = blockIdx.x * 8 + w, ngw = G * 8;
    const float* fg = p.in[I_FG];
    for (int r0 = gw * 4; r0 < M; r0 += ngw * 4) {
        f32x4 v[4][4]; float ss[4];
#pragma unroll
        for (int i = 0; i < 4; ++i) { const u32x2* xr = (const u32x2*)((const bf16_t*)(p.ws + WS_YS) + (size_t)(r0 + i) * D) + lane;
#pragma unroll
            for (int j = 0; j < 4; ++j) { const u32x2 xw = xr[64 * j]; v[i][j] = (f32x4){bflo(xw[0]), bfhi(xw[0]), bflo(xw[1]), bfhi(xw[1])}; } }
#pragma unroll
        for (int i = 0; i < 4; ++i) { float t = 0.f;
#pragma unroll
            for (int j = 0; j < 4; ++j) t += (v[i][j][0] * v[i][j][0] + v[i][j][1] * v[i][j][1]) + (v[i][j][2] * v[i][j][2] + v[i][j][3] * v[i][j][3]);
            ss[i] = t; }
#pragma unroll
        for (int o = 1; o < 64; o <<= 1) {
#pragma unroll
            for (int i = 0; i < 4; ++i) ss[i] += __shfl_xor(ss[i], o); }
#pragma unroll
        for (int j = 0; j < 4; ++j) { const f32x4 g4 = *(const f32x4*)(fg + 256 * j + 4 * lane);
#pragma unroll
            for (int i = 0; i < 4; ++i) { const float rstd = __builtin_amdgcn_rsqf(ss[i] * (1.0f / D) + EPS); ((f32x4*)(p.out + (size_t)(r0 + i) * D) + lane)[64 * j] = v[i][j] * rstd * g4; } }
    }
}

__global__ void __launch_bounds__(512, 2) mk_fwd(KP p_) {
    extern __shared__ __attribute__((aligned(16))) unsigned char lds_raw[];
    LAS unsigned char* lds = (LAS unsigned char*)lds_raw;
    const int tid = threadIdx.x, G = gridDim.x;
    volatile LAS unsigned* MISC = (volatile LAS unsigned*)(lds + MISC_OFF);
    for (int i = tid; i < LDS_BYTES / 4; i += 512) ((LAS unsigned*)lds)[i] = 0u;
    __syncthreads();
    XcdBarrier bar = xcd_barrier_post((unsigned*)(p_.ws + WS_CTL) + 4096, MISC + 8);
    if (tid == 0) { const unsigned myx = xb_xcc_id(); MISC[16] = myx; MISC[17] = xb_add((unsigned*)(p_.ws + WS_CTL) + 8192 + 64 * (myx & 15u), 1u); }
    __syncthreads();
    const int lo = p_.gp_lo, hi = p_.gp_hi;
#ifndef PH_MASK
#define PH_MASK 0xFFFFF
#endif
#define IN(k) (lo <= (k) && (k) < hi)
#define EN(b) ((PH_MASK >> (b)) & 1)
#ifndef PH_REPEAT
#define PH_REPEAT 0
#endif
#define NREP(b) (((PH_REPEAT >> (b)) & 1) ? 2 : 1)
#define SEAM(k) do { if ((k) + 1 < hi) xcd_barrier(bar); } while (0)
    if (EN(12) && IN(GP_SETUP)) { const KP p = load_kp(); phase_setup(p, lds, G); SEAM(GP_SETUP); }
    for (int l = 0; l < DEPTH; ++l) {
        const int g0 = 1 + l * NPH;
        if (EN(0) && IN(g0 + 0)) { _Pragma("nounroll") for (int rep = 0; rep < NREP(0); ++rep) { const KP p = load_kp(); phase_conv_norm1(p, lds, l, G); } SEAM(g0 + 0); }
        if (EN(1) && IN(g0 + 1)) { const KP p = load_kp();
            pg8::Gemm g{(const bf16_t*)(p.ws + WS_H), (const bf16_t*)(p.ws + WS_WIN), M, 3072, D / 2, D / 2, D / 2}; pg8::StaticOrder S; S.init(M, 3072, G, (int)blockIdx.x);
            pg8::EpiStoreBf16 E{(bf16_t*)(p.ws + WS_R0), 3072, 1.0f / (WIN_SCALE * HIN_SCALE)};
            _Pragma("nounroll") for (int rep = 0; rep < NREP(1); ++rep) pg8::gemm_phase<pg8::EpiStoreBf16, pg8::StaticOrder, false, true, true>(lds, g, S, E);
            SEAM(g0 + 1);
        }
        if (EN(2) && IN(g0 + 2)) { _Pragma("nounroll") for (int rep = 0; rep < NREP(2); ++rep) { const KP p = load_kp(); phase_hgrn2(p, lds, l, G); } SEAM(g0 + 2); }
        if (EN(3) && IN(g0 + 3)) { const KP p = load_kp();
            pg8::Gemm g{(const bf16_t*)(p.ws + WS_H), (const bf16_t*)(p.ws + WS_WIN) + (size_t)3072 * (D / 2), M, 4096, D / 2, D / 2, D / 2}; pg8::StaticOrder S; S.init(M, 4096, G, (int)blockIdx.x);
            pg8::EpiStoreBf16 E{(bf16_t*)(p.ws + WS_R0), 4096, 1.0f / (WIN_SCALE * HIN_SCALE)};
            _Pragma("nounroll") for (int rep = 0; rep < NREP(3); ++rep) pg8::gemm_phase<pg8::EpiStoreBf16, pg8::StaticOrder, false, true, true>(lds, g, S, E);
            SEAM(g0 + 3);
        }
        #if DBG_SELFCHECK
        if (EN(4) && IN(g0 + 4)) {
#pragma nounroll
            for (int rep = 0; rep < 2; ++rep) { const KP p = load_kp(); size_t yo = rep ? WS_H : WS_YS; asm volatile("" : "+s"(yo)); phase_s5(p, lds, l, G, yo); SEAM(g0 + 4); }
            const KP p = load_kp();
            const unsigned* a = (const unsigned*)(p.ws + WS_YS); const unsigned* b2 = (const unsigned*)(p.ws + WS_H); unsigned bad = 0;
            for (size_t i = (size_t)blockIdx.x * 512 + opaque_tid(); i < (size_t)M * D / 2; i += (size_t)G * 512) bad += (a[i] != b2[i]) ? 1u : 0u;
            if (bad) atomicAdd((unsigned*)(p.ws + WS_CTL) + 64, bad);
            { const unsigned* h1 = (const unsigned*)(p.ws + WS_CTL) + 65536; const unsigned* h2 = h1 + 8192; const int u2 = blockIdx.x * 512 + opaque_tid();
              if (u2 < 2048) { if (h1[u2 * 4] != h2[u2 * 4]) atomicAdd((unsigned*)(p.ws + WS_CTL) + 128, 1u); if (h1[u2 * 4 + 1] != h2[u2 * 4 + 1]) atomicAdd((unsigned*)(p.ws + WS_CTL) + 192, 1u); if (h1[u2 * 4 + 2] != h2[u2 * 4 + 2]) atomicAdd((unsigned*)(p.ws + WS_CTL) + 256, 1u); } }
            SEAM(g0 + 4); }
#else
        if (EN(4) && IN(g0 + 4)) { _Pragma("nounroll") for (int rep = 0; rep < NREP(4); ++rep) { const KP p = load_kp(); phase_s5(p, lds, l, G, WS_YS); } SEAM(g0 + 4); }
#endif
        if (EN(5) && IN(g0 + 5)) { const KP p = load_kp();
            pg8::Gemm g{(const bf16_t*)(p.ws + WS_YS), (const bf16_t*)(p.ws + WS_WGLU), M, D, D, D, D}; pg8::StaticOrder S; S.init(M, D, G, (int)blockIdx.x);
            pg8::EpiGlu E{(const bf16_t*)(p.ws + WS_R0), (const bf16_t*)(p.ws + WS_YS), (const bf16_t*)(p.ws + WS_OR), (const float*)(p.ws + WS_SSQ), p.in[I_HNG] + l * 128, p.in[I_GLUB] + l * D, (bf16_t*)(p.ws + WS_H)};
            _Pragma("nounroll") for (int rep = 0; rep < NREP(5); ++rep) pg8::gemm_phase<pg8::EpiGlu, pg8::StaticOrder, true, true>(lds, g, S, E);
            SEAM(g0 + 5);
        }
        if (EN(6) && IN(g0 + 6)) { const KP p = load_kp();
            pg8::Gemm g{(const bf16_t*)(p.ws + WS_H), (const bf16_t*)(p.ws + WS_WOUT), M, D, D / 2, D / 2, D / 2}; pg8::StaticOrder S; S.init(M, D, G, (int)blockIdx.x);
            pg8::EpiStoreBf16 E{(bf16_t*)(p.ws + WS_OR), D, 1.0f / (WO_SCALE * MG_SCALE)};
            pg8::gemm_phase<pg8::EpiStoreBf16, pg8::StaticOrder, false, true, true>(lds, g, S, E);
            SEAM(g0 + 6);
        }
        if (EN(7) && IN(g0 + 7)) { const KP p = load_kp();
            const int t2 = opaque_tid(), lane = t2 & 63, wave = __builtin_amdgcn_readfirstlane(t2 >> 6);
            if (l == 0) resid_norm_rows<false>(p.in[I_X], (bf16_t*)p.out, (const bf16_t*)(p.ws + WS_OR), (bf16_t*)(p.ws + WS_H), p.in[I_N2G] + l * D, (const float*)(p.ws + WS_MOD) + (size_t)l * 32 * NMODC, blockIdx.x * 8 + wave, G * 8, lane);
            else resid_norm_rows<true>(p.out, (bf16_t*)p.out, (const bf16_t*)(p.ws + WS_OR), (bf16_t*)(p.ws + WS_H), p.in[I_N2G] + l * D, (const float*)(p.ws + WS_MOD) + (size_t)l * 32 * NMODC, blockIdx.x * 8 + wave, G * 8, lane);
            SEAM(g0 + 7);
        }
        if (EN(8) && IN(g0 + 8)) { const KP p = load_kp();
            pg8::Gemm g{(const bf16_t*)(p.ws + WS_H), (const bf16_t*)(p.ws + WS_WQ), M, 2048, D, D, D}; pg8::StaticOrder S; S.init(M, 2048, G, (int)blockIdx.x);
            pg8::EpiStoreQ E{(bf16_t*)(p.ws + WS_R0)};
            _Pragma("nounroll") for (int rep = 0; rep < NREP(8); ++rep) pg8::gemm_phase<pg8::EpiStoreQ, pg8::StaticOrder, true, true>(lds, g, S, E);
            SEAM(g0 + 8);
        }
        if (EN(9) && IN(g0 + 9)) { _Pragma("nounroll") for (int rep = 0; rep < NREP(9); ++rep) { const KP p = load_kp(); phase_topk(p, lds, G); } SEAM(g0 + 9); }
        if (EN(10) && IN(g0 + 10)) {
            { const KP p = load_kp(); phase_expert_u(p, lds, MISC, l, G); } xcd_barrier(bar);
            { const KP p = load_kp(); phase_expert_w(p, G); } xcd_barrier(bar);
            { const KP p = load_kp(); phase_expert_v(p, lds, MISC, l, G); }
            SEAM(g0 + 10); }
    }
    if (EN(13) && IN(GP_FINAL)) { const KP p = load_kp(); phase_final(p, G); }
#undef IN
#undef EN
#undef NREP
#undef SEAM
}

extern "C" void kernel_launch(void* const* d_in, const int* in_sizes, int n_in, void* d_out, int out_size, void* d_ws, size_t ws_size, hipStream_t stream) {
    static int grid = 0;
    if (grid == 0) {
        if (n_in != 25 || out_size != M * D || ws_size < WS_END) { fprintf(stderr, "kernel_launch: unexpected shapes (n_in %d, out %d, ws %zu < %zu)\n", n_in, out_size, ws_size, (size_t)WS_END); grid = -1; return; }
        int dev = 0, cus = 0, per_cu = 0;
        if (hipGetDevice(&dev) != hipSuccess || hipDeviceGetAttribute(&cus, hipDeviceAttributeMultiprocessorCount, dev) != hipSuccess) { grid = -1; return; }
        if (hipFuncSetAttribute((const void*)mk_fwd, hipFuncAttributeMaxDynamicSharedMemorySize, LDS_BYTES) != hipSuccess) { fprintf(stderr, "kernel_launch: hipFuncSetAttribute failed\n"); grid = -1; return; }
        if (hipOccupancyMaxActiveBlocksPerMultiprocessor(&per_cu, (const void*)mk_fwd, 512, LDS_BYTES) != hipSuccess || per_cu < 1) fprintf(stderr, "kernel_launch: occupancy query says %d\n", per_cu);
        (void)hipGetLastError();
        grid = cus;
    }
    if (grid < 0) return;
    (void)hipMemsetAsync((char*)d_ws + WS_CTL, 0, CTL_ZERO_BYTES, stream);
    KP a{};
    for (int i = 0; i < 25; ++i) a.in[i] = (const float*)d_in[i];
    a.out = (float*)d_out; a.ws = (unsigned char*)d_ws;
#if MK_LAUNCHES == 1
    a.gp_lo = 0; a.gp_hi = GP_END;
    hipLaunchKernelGGL(mk_fwd, dim3(grid), dim3(512), LDS_BYTES, stream, a);
#else
    for (int gp = 0; gp < GP_END; ++gp) { a.gp_lo = gp; a.gp_hi = gp + 1; hipLaunchKernelGGL(mk_fwd, dim3(grid), dim3(512), LDS_BYTES, stream, a); }
#endif
}
```

```cpp
#include <hip/hip_runtime.h>
#include <cstdio>
#include <cstdint>

#define DBG_HASHSEL 0
#define DBG_H2_FROM_INPUT 0
#define DBG_NO_YA 0
#define DBG_NO_YB 0
#define DBG_NO_ACC 0
#define DBG_NO_GB 0
#define DBG_S5_NOSSM 0
#define DBG_S5_NOREC 0
#define DBG_SELFCHECK 0
#ifndef MK_LAUNCHES
#define MK_LAUNCHES 1
#endif

#define LAS __attribute__((address_space(3)))
typedef unsigned short bf16_t;
typedef short bf16x8 __attribute__((ext_vector_type(8)));
typedef float f32x2 __attribute__((ext_vector_type(2)));
typedef float f32x4 __attribute__((ext_vector_type(4)));
typedef float f32x16 __attribute__((ext_vector_type(16)));
typedef unsigned u32x2 __attribute__((ext_vector_type(2)));
typedef unsigned u32x4 __attribute__((ext_vector_type(4)));
typedef __bf16 bf16v2 __attribute__((ext_vector_type(2)));
typedef int i32x8 __attribute__((ext_vector_type(8)));
typedef int i32x4 __attribute__((ext_vector_type(4)));

constexpr int D = 1024, BATCH = 32, SEQ = 2048, DEPTH = 4, M = BATCH * SEQ;
constexpr int INC = 7168, NMODC = 6 * D;
constexpr int NPH = 11, GP_SETUP = 0, GP_FINAL = 1 + DEPTH * NPH, GP_END = GP_FINAL + 1;
constexpr float EPS = 1e-6f;
constexpr float U_SCALE = 64.0f, V_SCALE = 4.0f;
constexpr size_t TAB_BYTES = (size_t)16384 * 1024;
constexpr float WIN_SCALE = 64.0f, HIN_SCALE = 4.0f;
constexpr float WO_SCALE = 64.0f, MG_SCALE = 8.0f;

constexpr size_t MiB = 1u << 20;
constexpr size_t WS_CTL = 0, CTL_ZERO_BYTES = 1 * MiB;
constexpr size_t WS_MOD = 1 * MiB;
constexpr size_t WS_LB = 4 * MiB;
constexpr size_t WS_ABAR = 4 * MiB + 65536;
constexpr size_t WS_BOP = 5 * MiB;
constexpr size_t WS_COP = 6 * MiB;
constexpr size_t WS_WIN = 8 * MiB;
constexpr size_t WS_WGLU = 22 * MiB;
constexpr size_t WS_WOUT = 24 * MiB;
constexpr size_t WS_WQ = 26 * MiB;
constexpr size_t WS_KEYS = 30 * MiB;
constexpr size_t WS_U = 32 * MiB;
constexpr size_t WS_V = 64 * MiB;
constexpr size_t WS_H = 96 * MiB;
constexpr size_t WS_OR = 224 * MiB;
constexpr size_t WS_SSQ = 352 * MiB;
constexpr size_t WS_R0 = 354 * MiB;
constexpr size_t WS_SEL = WS_R0 + 256 * MiB;
constexpr size_t WS_YS = WS_R0 + 512 * MiB;
constexpr size_t WS_END = WS_YS + 128 * MiB;

constexpr int LDS_BYTES = 147456;
constexpr int MISC_OFF = LDS_BYTES - 256;

__device__ __forceinline__ unsigned pk2(float lo, float hi) { f32x2 v = {lo, hi}; bf16v2 r = __builtin_convertvector(v, bf16v2); return __builtin_bit_cast(unsigned, r); }
__device__ __forceinline__ float bflo(unsigned w) { return __uint_as_float(w << 16); }
__device__ __forceinline__ float bfhi(unsigned w) { return __uint_as_float(w & 0xffff0000u); }
__device__ __forceinline__ float fsigmoid(float x) { return __builtin_amdgcn_rcpf(1.0f + __expf(-x)); }
__device__ __forceinline__ float fsilu(float x) { return x * fsigmoid(x); }
__device__ __forceinline__ float fgelu(float x) { return x * fsigmoid(1.5957691216f * (x + 0.044715f * x * x * x)); }
__device__ __forceinline__ float wave_sum(float v) {
#pragma unroll
    for (int o = 1; o < 64; o <<= 1) v += __shfl_xor(v, o);
    return v;
}
#define LDS_WAIT() asm volatile("s_waitcnt lgkmcnt(0)" ::: "memory")
__device__ __forceinline__ float dpp_sum8(float d);
__device__ __forceinline__ int opaque_tid() { int t = threadIdx.x; asm volatile("" : "+v"(t)); return t; }

namespace pg8 {
#define PG8_LAS __attribute__((address_space(3)))
constexpr int BM = 256, BK = 64, HALF = 128, HTB = HALF * BK * 2, STAGE_BYTES = 8 * HTB, NXCD = 8, WGM = 8;
__host__ __device__ __forceinline__ int lds_byte(int r, int c) { const int st = (r >> 4) * 2 + (c >> 5), rr = r & 15, cc = c & 31, ob = rr * 64 + cc * 2; return st * 1024 + (ob ^ (((ob >> 9) & 1) << 5)); }
__host__ __device__ __forceinline__ void stage_rc(int b, int& R, int& C) { const int st = b / 1024, sb = b % 1024, swz = sb ^ (((sb >> 9) & 1) << 5); R = (st >> 1) * 16 + swz / 64; C = (st & 1) * 32 + (swz % 64) / 2; }
__host__ __device__ __forceinline__ int perm32(int rho) { const int n = rho >> 4, i = rho & 15; return 8 * (i >> 2) + 4 * n + (i & 3); }
struct Unit { int pm, pn; };
struct Gemm { const bf16_t* A; const bf16_t* Bt; int M, N, K, lda, ldb; };
struct StaticOrder {
    int nM, nN, nwg, G, c;
    __host__ __device__ void init(int M_, int N_, int G_, int c_) { nM = M_ / BM; nN = N_ / BM; nwg = nM * nN; G = G_; c = c_; }
    __host__ __device__ bool next(int i, Unit& u) const {
        const long L = (long)i * G + c; if (L >= nwg) return false;
        int wgid = (int)L; { const int q = nwg / NXCD, r = nwg % NXCD, xcd = wgid % NXCD, off = wgid / NXCD; wgid = (xcd < r ? xcd * (q + 1) : r * (q + 1) + (xcd - r) * q) + off; }
        const int nig = WGM * nN, gid = wgid / nig, fm = gid * WGM, gsz = (nM - fm) < WGM ? (nM - fm) : WGM;
        u.pm = fm + ((wgid % nig) % gsz); u.pn = (wgid % nig) / gsz; return true;
    }
    __device__ __forceinline__ void a_ready(const Unit&) const {}
    __device__ __forceinline__ void done(const Unit&) const {}
};
template <class Epi, class Sched, bool ALIGN_EPI = false, bool SP2 = false, bool F8 = false>
__device__ __forceinline__ void gemm_phase(PG8_LAS unsigned char* lds, const Gemm g, const Sched& S, const Epi& E) {
    const int tid = opaque_tid(), wid = __builtin_amdgcn_readfirstlane(tid >> 6), lane = tid & 63, wr = wid >> 2, wc = wid & 3, fr = lane & 15, fq = lane >> 4;
    const int K = g.K, nt = K / BK;
    unsigned voffA[2], voffB[2];
#pragma unroll
    for (int i = 0; i < 2; ++i) { int R, C; stage_rc(tid * 16 + i * 8192, R, C); const int Rb = Epi::PERM ? ((R & ~31) + perm32(R & 31)) : R;
        voffA[i] = (unsigned)(R * g.lda + C) * 2u; voffB[i] = (unsigned)(Rb * g.ldb + C) * 2u; }
    const size_t kstep = (size_t)(BK * 2);
    const size_t hstepA = (size_t)HALF * g.lda * 2, hstepB = (size_t)HALF * g.ldb * 2;
    const size_t tstepA = 2 * hstepA, tstepB = 2 * hstepB;
    const unsigned ldsw = (unsigned)wid * 1024u;
    const int aoff = lds_byte(wr * 64 + fr, fq * 8), boff = lds_byte(wc * 32 + fr, fq * 8);
#define PG8_SA(b, h) (((b) * 2 + (h)) * HTB)
#define PG8_SB(b, h) ((4 + (b) * 2 + (h)) * HTB)
#define PG8_STAGE(bufoff, gbase, voff) do { _Pragma("unroll") for (int _i = 0; _i < 2; ++_i) \
        __builtin_amdgcn_global_load_lds((const unsigned*)((const char*)(gbase) + (voff)[_i]), (PG8_LAS unsigned*)(lds + (bufoff) + ldsw + _i * 8192), 16, 0, 0); } while (0)
#define PG8_LD8(p) __builtin_shufflevector(*(const PG8_LAS i32x4*)(p), *(const PG8_LAS i32x4*)((p) + 1024), 0, 1, 2, 3, 4, 5, 6, 7)
#define PG8_LDA(dst, b, h) do { if constexpr (F8) { _Pragma("unroll") for (int m = 0; m < 4; ++m) dst##8[m] = PG8_LD8(lds + PG8_SA(b, h) + aoff + m * 2048); } \
        else { _Pragma("unroll") for (int m = 0; m < 4; ++m) _Pragma("unroll") for (int k = 0; k < 2; ++k) dst[m][k] = *(const PG8_LAS bf16x8*)(lds + PG8_SA(b, h) + aoff + m * 2048 + k * 1024); } } while (0)
#define PG8_LDB(dst, b, h) do { if constexpr (F8) { _Pragma("unroll") for (int n = 0; n < 2; ++n) dst##8[n] = PG8_LD8(lds + PG8_SB(b, h) + boff + n * 2048); } \
        else { _Pragma("unroll") for (int n = 0; n < 2; ++n) _Pragma("unroll") for (int k = 0; k < 2; ++k) dst[n][k] = *(const PG8_LAS bf16x8*)(lds + PG8_SB(b, h) + boff + n * 2048 + k * 1024); } } while (0)
#define PG8_MMA(ai, bj, At, Bt) do { __builtin_amdgcn_s_setprio(1); _Pragma("unroll") for (int m = 0; m < 4; ++m) _Pragma("unroll") for (int n = 0; n < 2; ++n) { \
        if constexpr (F8) {   \
            acc[ai][bj][m][n] = __builtin_amdgcn_mfma_scale_f32_16x16x128_f8f6f4(Bt##8[n], At##8[m], acc[ai][bj][m][n], 0, 0, 0, 0x7f7f7f7f, 0, 0x7f7f7f7f); \
        } else { _Pragma("unroll") for (int k = 0; k < 2; ++k) acc[ai][bj][m][n] = __builtin_amdgcn_mfma_f32_16x16x32_bf16(Bt[n][k], At[m][k], acc[ai][bj][m][n], 0, 0, 0); } } \
        __builtin_amdgcn_s_setprio(0); } while (0)
#define PG8_WAIT_V(n) asm volatile("s_waitcnt vmcnt(" #n ")" ::: "memory")
#define PG8_WAIT_L(n) asm volatile("s_waitcnt lgkmcnt(" #n ")" ::: "memory")
#define PG8_BAR __builtin_amdgcn_s_barrier()
#define PG8_SCHED __builtin_amdgcn_sched_barrier(0)
    Unit cur, nxt; int ui = 0;
    if (!S.next(0, cur)) return;
    f32x4 acc[2][2][4][2];
#pragma unroll
    for (int a = 0; a < 2; ++a)
#pragma unroll
        for (int b = 0; b < 2; ++b)
#pragma unroll
            for (int m = 0; m < 4; ++m)
#pragma unroll
                for (int n = 0; n < 2; ++n) acc[a][b][m][n] = (f32x4){0.f, 0.f, 0.f, 0.f};
    bf16x8 At[4][2], B0[2][2], B1[2][2]; i32x8 At8[4], B08[2], B18[2];
    const char* cA = (const char*)g.A + (size_t)cur.pm * tstepA; const char* cB = (const char*)g.Bt + (size_t)cur.pn * tstepB;
    S.a_ready(cur);
    if constexpr (SP2) {
        PG8_STAGE(PG8_SB(0, 0), cB, voffB); PG8_STAGE(PG8_SB(0, 1), cB + hstepB, voffB); PG8_STAGE(PG8_SA(0, 0), cA, voffA); PG8_STAGE(PG8_SA(0, 1), cA + hstepA, voffA);
        if (wr == 1) PG8_BAR;
        PG8_WAIT_V(2); PG8_BAR;
        PG8_STAGE(PG8_SB(1, 0), cB + kstep, voffB); PG8_STAGE(PG8_SA(1, 0), cA + kstep, voffA); PG8_STAGE(PG8_SB(1, 1), cB + hstepB + kstep, voffB);
        PG8_WAIT_V(6); PG8_BAR;
    } else {
        PG8_STAGE(PG8_SB(0, 0), cB, voffB); PG8_STAGE(PG8_SA(0, 0), cA, voffA); PG8_STAGE(PG8_SB(0, 1), cB + hstepB, voffB); PG8_STAGE(PG8_SA(0, 1), cA + hstepA, voffA);
        if (wr == 1) PG8_BAR;
        PG8_WAIT_V(4); PG8_BAR;
        PG8_STAGE(PG8_SB(1, 0), cB + kstep, voffB); PG8_STAGE(PG8_SA(1, 0), cA + kstep, voffA); PG8_STAGE(PG8_SB(1, 1), cB + hstepB + kstep, voffB);
        PG8_WAIT_V(6); PG8_BAR;
    }
    for (;;) {
        const bool has_next = S.next(ui + 1, nxt);
        const char* nA = has_next ? (const char*)g.A + (size_t)nxt.pm * tstepA : cA; const char* nB = has_next ? (const char*)g.Bt + (size_t)nxt.pn * tstepB : cB;
        for (int t = 0; t < nt; t += 2) {
            const bool last = (t == nt - 2);
            const char* a1 = cA + (size_t)(t + 1) * kstep;
            const char* a2 = last ? nA : cA + (size_t)(t + 2) * kstep; const char* b2 = last ? nB : cB + (size_t)(t + 2) * kstep;
            const char* a3 = a2 + kstep; const char* b3 = b2 + kstep;
            if (last && has_next) S.a_ready(nxt);
            if constexpr (SP2) {
            PG8_LDB(B0, 0, 0); PG8_LDB(B1, 0, 1); PG8_SCHED; PG8_LDA(At, 0, 0); PG8_STAGE(PG8_SA(1, 1), a1 + hstepA, voffA);
            PG8_WAIT_V(8); PG8_WAIT_L(0); PG8_BAR; PG8_MMA(0, 0, At, B0); PG8_MMA(0, 1, At, B1); PG8_BAR; PG8_SCHED;
            PG8_LDA(At, 0, 1); PG8_STAGE(PG8_SB(0, 0), b2, voffB); PG8_STAGE(PG8_SB(0, 1), b2 + hstepB, voffB); PG8_STAGE(PG8_SA(0, 0), a2, voffA);
            PG8_WAIT_V(8); PG8_WAIT_L(0); PG8_BAR; PG8_MMA(1, 0, At, B0); PG8_MMA(1, 1, At, B1); PG8_BAR; PG8_SCHED;
            PG8_LDB(B0, 1, 0); PG8_LDB(B1, 1, 1); PG8_SCHED; PG8_LDA(At, 1, 0); PG8_STAGE(PG8_SA(0, 1), a2 + hstepA, voffA);
            PG8_WAIT_V(8); PG8_WAIT_L(0); PG8_BAR; PG8_MMA(0, 0, At, B0); PG8_MMA(0, 1, At, B1); PG8_BAR; PG8_SCHED;
            PG8_LDA(At, 1, 1); PG8_STAGE(PG8_SB(1, 0), b3, voffB); PG8_STAGE(PG8_SB(1, 1), b3 + hstepB, voffB); PG8_STAGE(PG8_SA(1, 0), a3, voffA);
            PG8_WAIT_V(8); PG8_WAIT_L(0); PG8_BAR; PG8_MMA(1, 0, At, B0); PG8_MMA(1, 1, At, B1); PG8_BAR; PG8_SCHED;
            } else {
            PG8_LDB(B0, 0, 0); PG8_SCHED; PG8_LDA(At, 0, 0); PG8_STAGE(PG8_SA(1, 1), a1 + hstepA, voffA);
            PG8_WAIT_L(8); PG8_BAR; PG8_WAIT_L(0); PG8_MMA(0, 0, At, B0); PG8_BAR; PG8_SCHED;
            PG8_LDB(B1, 0, 1); PG8_STAGE(PG8_SB(0, 0), b2, voffB);
            PG8_BAR; PG8_WAIT_L(0); PG8_MMA(0, 1, At, B1); PG8_BAR;
            PG8_LDA(At, 0, 1); PG8_STAGE(PG8_SA(0, 0), a2, voffA);
            PG8_BAR; PG8_WAIT_L(0); PG8_MMA(1, 0, At, B0); PG8_BAR; PG8_SCHED;
            PG8_STAGE(PG8_SB(0, 1), b2 + hstepB, voffB);
            PG8_WAIT_V(6); PG8_BAR; PG8_MMA(1, 1, At, B1); PG8_BAR;
            PG8_LDB(B0, 1, 0); PG8_SCHED; PG8_LDA(At, 1, 0); PG8_STAGE(PG8_SA(0, 1), a2 + hstepA, voffA);
            PG8_WAIT_L(8); PG8_BAR; PG8_WAIT_L(0); PG8_MMA(0, 0, At, B0); PG8_BAR; PG8_SCHED;
            PG8_LDB(B1, 1, 1); PG8_STAGE(PG8_SB(1, 0), b3, voffB);
            PG8_BAR; PG8_WAIT_L(0); PG8_MMA(0, 1, At, B1); PG8_BAR;
            PG8_LDA(At, 1, 1); PG8_STAGE(PG8_SA(1, 0), a3, voffA);
            PG8_BAR; PG8_WAIT_L(0); PG8_MMA(1, 0, At, B0); PG8_BAR; PG8_SCHED;
            PG8_STAGE(PG8_SB(1, 1), b3 + hstepB, voffB);
            PG8_WAIT_V(6); PG8_BAR; PG8_MMA(1, 1, At, B1); PG8_BAR;
            }
        }
        if constexpr (ALIGN_EPI) { if (wr == 0) PG8_BAR; }
        E(acc, cur, wr, wc, fr, fq);
        if (!has_next) break;
#pragma unroll
        for (int a = 0; a < 2; ++a)
#pragma unroll
            for (int b = 0; b < 2; ++b)
#pragma unroll
                for (int m = 0; m < 4; ++m)
#pragma unroll
                    for (int n = 0; n < 2; ++n) acc[a][b][m][n] = (f32x4){0.f, 0.f, 0.f, 0.f};
        cur = nxt; cA = nA; cB = nB; ++ui;
        if constexpr (ALIGN_EPI) { if (wr == 1) PG8_BAR; }
    }
    PG8_WAIT_V(0);
    if constexpr (!ALIGN_EPI) { if (wr == 0) PG8_BAR; }
    PG8_BAR;
#undef PG8_SA
#undef PG8_SB
#undef PG8_STAGE
#undef PG8_LDA
#undef PG8_LD8
#undef PG8_LDB
#undef PG8_MMA
#undef PG8_WAIT_V
#undef PG8_WAIT_L
#undef PG8_BAR
#undef PG8_SCHED
}

struct EpiStoreBf16 {
    static constexpr bool PERM = true;
    bf16_t* O; int ldc; float scale;
    __device__ __forceinline__ void operator()(const f32x4 (&acc)[2][2][4][2], const Unit& u, int wr, int wc, int fr, int fq) const {
        const int row0 = u.pm * BM + wr * 64 + fr, col0 = u.pn * BM + wc * 32 + 8 * fq;
#pragma unroll
        for (int ai = 0; ai < 2; ++ai)
#pragma unroll
            for (int m = 0; m < 4; ++m) { bf16_t* rowp = O + (size_t)(row0 + ai * HALF + m * 16) * ldc + col0;
#pragma unroll
                for (int bj = 0; bj < 2; ++bj) { const f32x4 v0 = acc[ai][bj][m][0] * scale, v1 = acc[ai][bj][m][1] * scale;
                    u32x4 w; w.x = pk2(v0[0], v0[1]); w.y = pk2(v0[2], v0[3]); w.z = pk2(v1[0], v1[1]); w.w = pk2(v1[2], v1[3]);
                    *(u32x4*)(rowp + bj * HALF) = w; } }
    }
};
struct EpiStoreQ {
    static constexpr bool PERM = true;
    bf16_t* O;
    __device__ __forceinline__ void operator()(const f32x4 (&acc)[2][2][4][2], const Unit& u, int wr, int wc, int fr, int fq) const {
        const int row0 = u.pm * BM + wr * 64 + fr, col0 = u.pn * BM + wc * 32 + 8 * fq;
#pragma unroll
        for (int ai = 0; ai < 2; ++ai)
#pragma unroll
            for (int m = 0; m < 4; ++m) { const int row = row0 + ai * HALF + m * 16, tg = row >> 5, t = row & 31;
#pragma unroll
                for (int bj = 0; bj < 2; ++bj) { const int c0 = col0 + bj * HALF, h = c0 >> 8, pp = (c0 >> 7) & 1, cc = c0 & 127, ks = cc >> 4, hh = (cc >> 3) & 1;
                    const f32x4 v0 = acc[ai][bj][m][0], v1 = acc[ai][bj][m][1];
                    u32x4 w; w.x = pk2(v0[0], v0[1]); w.y = pk2(v0[2], v0[3]); w.z = pk2(v1[0], v1[1]); w.w = pk2(v1[2], v1[3]);
                    *(u32x4*)(O + ((size_t)((((tg * 8 + h) * 2 + pp) * 8 + ks) * 64 + hh * 32 + t)) * 8) = w; } }
    }
};
struct EpiWout {
    static constexpr bool PERM = false;
    const float* xs; float* out; const float* g1;
    __device__ __forceinline__ void operator()(const f32x4 (&acc)[2][2][4][2], const Unit& u, int wr, int wc, int fr, int fq) const {
        const int row0 = u.pm * BM + wr * 64 + fr, col0 = u.pn * BM + wc * 32 + 4 * fq;
        const int b = (u.pm * BM) >> 11;
        f32x4 gv[2][2];
#pragma unroll
        for (int bj = 0; bj < 2; ++bj)
#pragma unroll
            for (int n = 0; n < 2; ++n) gv[bj][n] = *(const f32x4*)(g1 + (size_t)b * NMODC + col0 + bj * HALF + n * 16);
#pragma unroll
        for (int ai = 0; ai < 2; ++ai)
#pragma unroll
            for (int m = 0; m < 4; ++m) { const size_t off = (size_t)(row0 + ai * HALF + m * 16) * D + col0;
#pragma unroll
                for (int bj = 0; bj < 2; ++bj)
#pragma unroll
                    for (int n = 0; n < 2; ++n) { const f32x4 xv = *(const f32x4*)(xs + off + bj * HALF + n * 16);
                        *(f32x4*)(out + off + bj * HALF + n * 16) = xv + gv[bj][n] * acc[ai][bj][m][n]; } }
    }
};
struct EpiGlu {
    static constexpr bool PERM = true;
    const bf16_t* PB; const bf16_t* YS; const bf16_t* ORAW; const float* SSQ; const float* ng; const float* gb_; bf16_t* O;
    __device__ __forceinline__ void operator()(const f32x4 (&acc)[2][2][4][2], const Unit& u, int wr, int wc, int fr, int fq) const {
        const int row0 = u.pm * BM + wr * 64 + fr, col0 = u.pn * BM + wc * 32 + 8 * fq;
#pragma unroll
        for (int bj = 0; bj < 2; ++bj) {
            const int c = col0 + bj * HALF, head = c >> 7;
            const f32x4 n0 = *(const f32x4*)(ng + (c & 127)), n1 = *(const f32x4*)(ng + (c & 127) + 4);
            const f32x4 b0 = *(const f32x4*)(gb_ + c), b1 = *(const f32x4*)(gb_ + c + 4);
            const float ngv[8] = {n0[0], n0[1], n0[2], n0[3], n1[0], n1[1], n1[2], n1[3]};
            const float bbv[8] = {b0[0], b0[1], b0[2], b0[3], b1[0], b1[1], b1[2], b1[3]};
#pragma unroll
            for (int ai = 0; ai < 2; ++ai)
#pragma unroll
                for (int m = 0; m < 4; ++m) {
                    const int row = row0 + ai * HALF + m * 16;
                    const bf16_t* pb = PB + (size_t)row * 4096 + c;
                    const u32x4 og = *(const u32x4*)(pb), ys = *(const u32x4*)(YS + (size_t)row * D + c), ga = *(const u32x4*)(pb + 2048), gb = *(const u32x4*)(pb + 3072);
                    const u32x4 orw = *(const u32x4*)(ORAW + (size_t)row * D + c);
                    const float rstd = __builtin_amdgcn_rsqf(SSQ[(size_t)row * 8 + head] * (1.0f / 128.0f) + EPS);
                    const f32x4 a0 = acc[ai][bj][m][0], a1 = acc[ai][bj][m][1];
                    const float av[8] = {a0[0], a0[1], a0[2], a0[3], a1[0], a1[1], a1[2], a1[3]};
                    float res[8];
#pragma unroll
                    for (int j = 0; j < 8; ++j) {
                        const unsigned wog = og[j >> 1], wys = ys[j >> 1], wga = ga[j >> 1], wgb = gb[j >> 1], wor = orw[j >> 1];
                        const float fog = (j & 1) ? bfhi(wog) : bflo(wog), fys = (j & 1) ? bfhi(wys) : bflo(wys), fga = (j & 1) ? bfhi(wga) : bflo(wga),
                                    fgb = (j & 1) ? bfhi(wgb) : bflo(wgb), fo = (j & 1) ? bfhi(wor) : bflo(wor);
                        const float ya = fo * rstd * ngv[j] * fsilu(fog);
                        const float yb = fys * fsigmoid((DBG_NO_ACC ? 0.f : av[j]) + bbv[j]);
                        res[j] = (DBG_NO_YA ? 0.f : fsigmoid(fga) * ya) + (DBG_NO_YB ? 0.f : (DBG_NO_GB ? 0.5f : fsigmoid(fgb)) * yb);
                    }
                    int w0 = 0, w1 = 0;
                    w0 = __builtin_amdgcn_cvt_pk_fp8_f32(res[0] * MG_SCALE, res[1] * MG_SCALE, w0, false); w0 = __builtin_amdgcn_cvt_pk_fp8_f32(res[2] * MG_SCALE, res[3] * MG_SCALE, w0, true);
                    w1 = __builtin_amdgcn_cvt_pk_fp8_f32(res[4] * MG_SCALE, res[5] * MG_SCALE, w1, false); w1 = __builtin_amdgcn_cvt_pk_fp8_f32(res[6] * MG_SCALE, res[7] * MG_SCALE, w1, true);
                    *(u32x2*)((unsigned char*)O + (size_t)row * D + c) = (u32x2){(unsigned)w0, (unsigned)w1};
                }
        }
    }
};
}

#define XB_TMO      128
#define XB_XCNT(j)  (256  + 64 * (j))
#define XB_XSUB(j)  (1280 + 64 * (j))
#define XB_XGEN(j)  (2304 + 64 * (j))
#define XB_TOP      3328
#define XB_TOPGEN   3392
#define XCD_BAR_WORDS 3456
#define XB_SPIN_CAP (1u << 25)
__device__ __forceinline__ unsigned xb_ld(unsigned* p)              { return __hip_atomic_load(p, __ATOMIC_RELAXED, __HIP_MEMORY_SCOPE_AGENT); }
__device__ __forceinline__ unsigned xb_add(unsigned* p, unsigned v) { return __hip_atomic_fetch_add(p, v, __ATOMIC_RELAXED, __HIP_MEMORY_SCOPE_AGENT); }
__device__ __forceinline__ unsigned xb_xcc_id() { return (unsigned)__builtin_amdgcn_s_getreg((3 << 11) | 20) & 0xFu; }
#define XB_SPIN(cond, bar) do { unsigned _sp = 0; while (cond) { __builtin_amdgcn_s_sleep(1); \
    if ((++_sp & 255u) == 0u) { if (xb_ld(&(bar)[XB_TMO])) break; if (_sp > XB_SPIN_CAP) { atomicAdd(&(bar)[XB_TMO], 1u); break; } } } } while (0)
struct XcdBarrier { unsigned* bar; unsigned x; volatile LAS unsigned* st; };
__device__ __forceinline__ XcdBarrier xcd_barrier_post(unsigned* bar, volatile LAS unsigned* st) {
    XcdBarrier b; b.bar = bar; b.x = xb_xcc_id(); b.st = st;
    if (threadIdx.x == 0) (void)xb_add(&bar[XB_XCNT(b.x)], 1u);
    return b;
}
__device__ __forceinline__ void xcd_barrier_complete(unsigned* bar, unsigned x, unsigned& nloc, unsigned& nx) {
    const unsigned G = gridDim.x * gridDim.y * gridDim.z;
    unsigned sum, cnt, mine, sp = 0u;
    for (;;) {
        sum = 0u; cnt = 0u; mine = 0u;
#pragma unroll
        for (unsigned j = 0; j < 16; ++j) { const unsigned c = xb_ld(&bar[XB_XCNT(j)]); sum += c; cnt += (c > 0u) ? 1u : 0u; mine = (j == x) ? c : mine; }
        if (sum == G) break;
        __builtin_amdgcn_s_sleep(1);
        if ((++sp & 255u) == 0u) { if (xb_ld(&bar[XB_TMO])) break; if (sp > XB_SPIN_CAP) { atomicAdd(&bar[XB_TMO], 1u); break; } }
    }
    nloc = mine > 0u ? mine : 1u; nx = cnt > 0u ? cnt : 1u;
}
__device__ __forceinline__ void xcd_barrier(const XcdBarrier& b) {
    asm volatile("s_waitcnt vmcnt(0)" ::: "memory");
    __syncthreads();
    if (threadIdx.x == 0) {
        unsigned* bar = b.bar;
        __builtin_amdgcn_s_waitcnt(0);
        unsigned nloc = b.st[0], nx = b.st[1];
        if (nloc == 0u) { xcd_barrier_complete(bar, b.x, nloc, nx); b.st[0] = nloc; b.st[1] = nx; }
        const unsigned old = xb_add(&bar[XB_XSUB(b.x)], 1u);
        const unsigned gen = old / nloc;
        if (old + 1u == (gen + 1u) * nloc) {
            __builtin_amdgcn_fence(__ATOMIC_RELEASE, "agent");
            asm volatile("s_waitcnt vmcnt(0)" ::: "memory");
            const unsigned og = xb_add(&bar[XB_TOP], 1u);
            const unsigned tg = og / nx;
            if (og + 1u == (tg + 1u) * nx) xb_add(&bar[XB_TOPGEN], 1u);
            else XB_SPIN(xb_ld(&bar[XB_TOPGEN]) == tg, bar);
            __builtin_amdgcn_fence(__ATOMIC_ACQUIRE, "agent");
            xb_add(&bar[XB_XGEN(b.x)], 1u);
            asm volatile("s_waitcnt vmcnt(0)" ::: "memory");
        } else {
            XB_SPIN(xb_ld(&bar[XB_XGEN(b.x)]) == gen, bar);
            __builtin_amdgcn_fence(__ATOMIC_ACQUIRE, "agent");
            asm volatile("s_waitcnt vmcnt(0)" ::: "memory");
        }
    }
    __syncthreads();
}

struct KP { const float* in[25]; float* out; unsigned char* ws; int gp_lo, gp_hi; };
enum { I_X = 0, I_C, I_ADAW, I_ADAB, I_N1G, I_N2G, I_WIN, I_LBL, I_HNG, I_ARE, I_AIM, I_LDT, I_BRE, I_BIM, I_CRE, I_CIM, I_S5D, I_GLUW, I_GLUB, I_WOUT, I_WQ, I_SUBK, I_PU, I_PV, I_FG };

typedef const KP __attribute__((address_space(4)))* kp_cptr;
__device__ __forceinline__ KP load_kp() {
#if defined(__HIP_DEVICE_COMPILE__)
    unsigned long long a = (unsigned long long)__builtin_amdgcn_kernarg_segment_ptr(); asm volatile("" : "+s"(a)); return *(kp_cptr)a;
#else
    return KP{};
#endif
}

__device__ __forceinline__ void phase_setup(const KP& p, LAS unsigned char* lds, int G) {
    const int tid = opaque_tid();
    {
        LAS float* cact = (LAS float*)lds;
        for (int it = blockIdx.x; it < 4 * 48; it += G) {
#pragma unroll 1
            for (int i0 = 0; i0 < 64; i0 += 16) { float cv[16];
#pragma unroll
                for (int q = 0; q < 16; ++q) cv[q] = p.in[I_C][(i0 + q) * 512 + tid];
#pragma unroll
                for (int q = 0; q < 16; ++q) { const int i = (i0 + q) * 512 + tid; const int k_ = i & 1023, b_ = i >> 10; cact[k_ * 32 + ((((b_ >> 2) ^ (k_ & 7)) << 2) | (b_ & 3))] = fsilu(cv[q]); } }
            __syncthreads();
            const int l = it / 48, cb = it % 48, col = cb * 128 + (tid & 127), bg = tid >> 7;
            const float* W = p.in[I_ADAW] + (size_t)l * D * NMODC + col;
            f32x4 acc0 = {0.f, 0.f, 0.f, 0.f}, acc1 = {0.f, 0.f, 0.f, 0.f};
#pragma unroll 2
            for (int k4 = 0; k4 < 256; ++k4) {
                const float w0 = W[(size_t)(4 * k4 + 0) * NMODC], w1 = W[(size_t)(4 * k4 + 1) * NMODC], w2 = W[(size_t)(4 * k4 + 2) * NMODC], w3 = W[(size_t)(4 * k4 + 3) * NMODC];
#pragma unroll
                for (int kk = 0; kk < 4; ++kk) { const int k_ = 4 * k4 + kk; const float wv = kk == 0 ? w0 : (kk == 1 ? w1 : (kk == 2 ? w2 : w3));
                    acc0 += *(const LAS f32x4*)(cact + k_ * 32 + (((2 * bg) ^ (k_ & 7)) << 2)) * wv; acc1 += *(const LAS f32x4*)(cact + k_ * 32 + (((2 * bg + 1) ^ (k_ & 7)) << 2)) * wv; }
            }
            float* MOD = (float*)(p.ws + WS_MOD);
            const float bias = p.in[I_ADAB][l * NMODC + col];
#pragma unroll
            for (int j = 0; j < 4; ++j) { MOD[((size_t)l * 32 + 8 * bg + j) * NMODC + col] = acc0[j] + bias; MOD[((size_t)l * 32 + 8 * bg + 4 + j) * NMODC + col] = acc1[j] + bias; }
            __syncthreads();
        }
    }
    const int gtid = (G - 1 - (int)blockIdx.x) * 512 + tid;
    if (gtid < 1024) {
        const float* lg = p.in[I_LBL]; float v[4], mx = -1e30f;
#pragma unroll
        for (int l = 0; l < 4; ++l) { v[l] = lg[l * 1024 + gtid]; mx = fmaxf(mx, v[l]); }
        float s = 0.f;
#pragma unroll
        for (int l = 0; l < 4; ++l) { v[l] = __expf(v[l] - mx); s += v[l]; }
        float* LB = (float*)(p.ws + WS_LB); float cum = 0.f; const float first = v[0] / s;
#pragma unroll
        for (int l = 0; l < 4; ++l) { cum += v[l] / s; LB[l * 1024 + gtid] = (l == 0) ? 0.f : (cum - first); }
    }
    if (gtid >= 1024 && gtid < 1024 + 16384) {
        const int id = gtid - 1024, lg = id >> 6, pp = id & 63;
        const float a_re = p.in[I_ARE][id], a_im = p.in[I_AIM][id];
        const float step = expf(p.in[I_LDT][lg]);
        const float mag = expf(step * a_re), ang = step * a_im;
        const float ab_re = mag * cosf(ang), ab_im = mag * sinf(ang);
        const float den = a_re * a_re + a_im * a_im;
        const float z_re = ((ab_re - 1.0f) * a_re + ab_im * a_im) / den;
        const float z_im = (ab_im * a_re - (ab_re - 1.0f) * a_im) / den;
        float* ABAR = (float*)(p.ws + WS_ABAR); ABAR[2 * id] = ab_re; ABAR[2 * id + 1] = ab_im;
        bf16_t* BOP = (bf16_t*)(p.ws + WS_BOP); bf16_t* COP = (bf16_t*)(p.ws + WS_COP);
        const float* bre = p.in[I_BRE] + (size_t)id * 16; const float* bim = p.in[I_BIM] + (size_t)id * 16;
#pragma unroll
        for (int c = 0; c < 16; ++c) {
            const float br = bre[c], bi = bim[c];
            const float rr = z_re * br - z_im * bi, ii = z_re * bi + z_im * br;
            BOP[((size_t)lg * 128 + 2 * pp) * 16 + c] = (bf16_t)(pk2(rr, 0.f) & 0xffffu);
            BOP[((size_t)lg * 128 + 2 * pp + 1) * 16 + c] = (bf16_t)(pk2(ii, 0.f) & 0xffffu);
            const float cr = p.in[I_CRE][((size_t)lg * 16 + c) * 64 + pp], ci = p.in[I_CIM][((size_t)lg * 16 + c) * 64 + pp];
            COP[((size_t)lg * 16 + c) * 128 + 2 * pp] = (bf16_t)(pk2(cr, 0.f) & 0xffffu);
            COP[((size_t)lg * 16 + c) * 128 + 2 * pp + 1] = (bf16_t)(pk2(-ci, 0.f) & 0xffffu);
        }
    }
}

__device__ __forceinline__ void transpose_item(const float* W, int K, int N, bf16_t* WT, LAS float* scr, int item, int lane) {
    const int nblk = N / 32, kb = item / nblk, nb = item % nblk, k0 = 64 * kb, n0 = 32 * nb;
#pragma unroll 8
    for (int i = 0; i < 32; ++i) { const int kk = 2 * i + (lane >> 5); scr[kk * 33 + (lane & 31)] = W[(size_t)(k0 + kk) * N + n0 + (lane & 31)]; }
    LDS_WAIT();
    const int c = lane & 7;
#pragma unroll
    for (int j = 0; j < 4; ++j) { const int n = (lane >> 3) + 8 * j; const LAS float* s = scr + (8 * c) * 33 + n;
        u32x4 o; o.x = pk2(s[0 * 33], s[1 * 33]); o.y = pk2(s[2 * 33], s[3 * 33]); o.z = pk2(s[4 * 33], s[5 * 33]); o.w = pk2(s[6 * 33], s[7 * 33]);
        *(u32x4*)(WT + (size_t)(n0 + n) * K + k0 + 8 * c) = o; }
    LDS_WAIT();
}
__device__ __forceinline__ void cvt_f32_fp8(const float* src, unsigned char* dst, size_t n4, size_t gtid, size_t nthr, float scale) {
    for (size_t i = gtid; i < n4; i += nthr) { const f32x4 v = ((const f32x4*)src)[i] * scale; int w = 0;
        w = __builtin_amdgcn_cvt_pk_fp8_f32(v[0], v[1], w, false); w = __builtin_amdgcn_cvt_pk_fp8_f32(v[2], v[3], w, true); ((unsigned*)dst)[i] = (unsigned)w; }
}
__device__ __forceinline__ void cvt_f32_fp8_sliced(const float* src, unsigned char* dst, size_t gtid, size_t nthr, float scale) {
    for (size_t i = gtid; i < (size_t)16384 * 64; i += nthr) {
        const size_t e = i >> 6; const int sl = (int)(i & 63) >> 3, c = (int)(i & 7);
        const f32x4* sp = (const f32x4*)(src + e * 1024 + sl * 128 + c * 16); u32x4 o;
#pragma unroll
        for (int q = 0; q < 4; ++q) { const f32x4 v = sp[q] * scale; int w = 0; w = __builtin_amdgcn_cvt_pk_fp8_f32(v[0], v[1], w, false); w = __builtin_amdgcn_cvt_pk_fp8_f32(v[2], v[3], w, true); o[q] = (unsigned)w; }
        *(u32x4*)(dst + ((size_t)sl * 16384 + e) * 128 + c * 16) = o;
    }
}
__device__ __forceinline__ void transpose_item_fp8(const float* W, int K, int N, unsigned char* WT, LAS float* scr, int item, int lane, float scale) {
    const int nblk = N / 32, kb = item / nblk, nb = item % nblk, k0 = 64 * kb, n0 = 32 * nb;
#pragma unroll 8
    for (int i = 0; i < 32; ++i) { const int kk = 2 * i + (lane >> 5); scr[kk * 33 + (lane & 31)] = W[(size_t)(k0 + kk) * N + n0 + (lane & 31)]; }
    LDS_WAIT();
    const int c = lane & 7;
#pragma unroll
    for (int j = 0; j < 4; ++j) { const int n = (lane >> 3) + 8 * j; const LAS float* sp = scr + (8 * c) * 33 + n;
        int w0 = 0, w1 = 0;
        w0 = __builtin_amdgcn_cvt_pk_fp8_f32(sp[0 * 33] * scale, sp[1 * 33] * scale, w0, false); w0 = __builtin_amdgcn_cvt_pk_fp8_f32(sp[2 * 33] * scale, sp[3 * 33] * scale, w0, true);
        w1 = __builtin_amdgcn_cvt_pk_fp8_f32(sp[4 * 33] * scale, sp[5 * 33] * scale, w1, false); w1 = __builtin_amdgcn_cvt_pk_fp8_f32(sp[6 * 33] * scale, sp[7 * 33] * scale, w1, true);
        *(u32x2*)(WT + (size_t)(n0 + n) * K + k0 + 8 * c) = (u32x2){(unsigned)w0, (unsigned)w1}; }
    LDS_WAIT();
}
__device__ __forceinline__ void cvt_f32_bf16(const float* src, bf16_t* dst, size_t n4, size_t gtid, size_t nthr) {
    for (size_t i = gtid; i < n4; i += nthr) { const f32x4 v = ((const f32x4*)src)[i]; u32x2 o; o.x = pk2(v[0], v[1]); o.y = pk2(v[2], v[3]); ((u32x2*)dst)[i] = o; }
}
template <bool F8OUT, bool XBF>
__device__ __forceinline__ void norm_rows(const float* xsrc, bf16_t* hdst, const float* gain, const float* mod_l, int sh_off, int sc_off, int gw, int ngw, int lane) {
    for (int r0 = gw * 4; r0 < M; r0 += ngw * 4) {
        const int b = r0 >> 11;
        f32x4 v[4][4]; float ss[4];
#pragma unroll
        for (int i = 0; i < 4; ++i) {
            if constexpr (XBF) { const u32x2* xr = (const u32x2*)((const bf16_t*)xsrc + (size_t)(r0 + i) * D) + lane;
#pragma unroll
                for (int j = 0; j < 4; ++j) { const u32x2 xw = xr[64 * j]; v[i][j] = (f32x4){bflo(xw[0]), bfhi(xw[0]), bflo(xw[1]), bfhi(xw[1])}; } }
            else { const f32x4* xr = (const f32x4*)(xsrc + (size_t)(r0 + i) * D) + lane;
#pragma unroll
                for (int j = 0; j < 4; ++j) v[i][j] = xr[64 * j]; } }
#pragma unroll
        for (int i = 0; i < 4; ++i) { float t = 0.f;
#pragma unroll
            for (int j = 0; j < 4; ++j) t += (v[i][j][0] * v[i][j][0] + v[i][j][1] * v[i][j][1]) + (v[i][j][2] * v[i][j][2] + v[i][j][3] * v[i][j][3]);
            ss[i] = t; }
#pragma unroll
        for (int o = 1; o < 64; o <<= 1) {
#pragma unroll
            for (int i = 0; i < 4; ++i) ss[i] += __shfl_xor(ss[i], o); }
        const float* mb = mod_l + (size_t)b * NMODC;
#pragma unroll
        for (int j = 0; j < 4; ++j) { const int col = 256 * j + 4 * lane;
            const f32x4 g4 = *(const f32x4*)(gain + col), sc = *(const f32x4*)(mb + sc_off + col), sh = *(const f32x4*)(mb + sh_off + col);
            const f32x4 gs = g4 * (sc + 1.0f);
#pragma unroll
            for (int i = 0; i < 4; ++i) { const float rstd = __builtin_amdgcn_rsqf(ss[i] * (1.0f / D) + EPS);
                const f32x4 h = v[i][j] * rstd * gs + sh;
                if constexpr (F8OUT) { int w8 = 0; w8 = __builtin_amdgcn_cvt_pk_fp8_f32(h[0] * HIN_SCALE, h[1] * HIN_SCALE, w8, false); w8 = __builtin_amdgcn_cvt_pk_fp8_f32(h[2] * HIN_SCALE, h[3] * HIN_SCALE, w8, true);
                    *(unsigned*)((unsigned char*)hdst + (size_t)(r0 + i) * D + col) = (unsigned)w8; }
                else { u32x2 o; o.x = pk2(h[0], h[1]); o.y = pk2(h[2], h[3]); *(u32x2*)(hdst + (size_t)(r0 + i) * D + col) = o; } } }
    }
}
template <bool XBF>
__device__ __forceinline__ void resid_norm_rows(const float* xsrc, bf16_t* xdst, const bf16_t* delta, bf16_t* hdst, const float* gain, const float* mod_l, int gw, int ngw, int lane) {
    for (int r0 = gw * 4; r0 < M; r0 += ngw * 4) {
        const int b = r0 >> 11; const float* mb = mod_l + (size_t)b * NMODC;
        f32x4 v[4][4]; u32x2 dl[4][4]; float ss[4];
#pragma unroll
        for (int i = 0; i < 4; ++i) { const u32x2* dp = (const u32x2*)(delta + (size_t)(r0 + i) * D) + lane;
            if constexpr (XBF) { const u32x2* xr = (const u32x2*)((const bf16_t*)xsrc + (size_t)(r0 + i) * D) + lane;
#pragma unroll
                for (int j = 0; j < 4; ++j) { const u32x2 xw = xr[64 * j]; v[i][j] = (f32x4){bflo(xw[0]), bfhi(xw[0]), bflo(xw[1]), bfhi(xw[1])}; dl[i][j] = dp[64 * j]; } }
            else { const f32x4* xr = (const f32x4*)(xsrc + (size_t)(r0 + i) * D) + lane;
#pragma unroll
                for (int j = 0; j < 4; ++j) { v[i][j] = xr[64 * j]; dl[i][j] = dp[64 * j]; } } }
#pragma unroll
        for (int j = 0; j < 4; ++j) { const f32x4 g1 = *(const f32x4*)(mb + 2048 + 256 * j + 4 * lane);
#pragma unroll
            for (int i = 0; i < 4; ++i) { const f32x4 dv = {bflo(dl[i][j][0]), bfhi(dl[i][j][0]), bflo(dl[i][j][1]), bfhi(dl[i][j][1])}; v[i][j] = v[i][j] + g1 * dv;
                ((u32x2*)(xdst + (size_t)(r0 + i) * D) + lane)[64 * j] = (u32x2){pk2(v[i][j][0], v[i][j][1]), pk2(v[i][j][2], v[i][j][3])}; } }
#pragma unroll
        for (int i = 0; i < 4; ++i) { float t = 0.f;
#pragma unroll
            for (int j = 0; j < 4; ++j) t += (v[i][j][0] * v[i][j][0] + v[i][j][1] * v[i][j][1]) + (v[i][j][2] * v[i][j][2] + v[i][j][3] * v[i][j][3]);
            ss[i] = t; }
#pragma unroll
        for (int o = 1; o < 64; o <<= 1) {
#pragma unroll
            for (int i = 0; i < 4; ++i) ss[i] += __shfl_xor(ss[i], o); }
#pragma unroll
        for (int j = 0; j < 4; ++j) { const int col = 256 * j + 4 * lane;
            const f32x4 g4 = *(const f32x4*)(gain + col), sc = *(const f32x4*)(mb + 4096 + col), sh = *(const f32x4*)(mb + 3072 + col);
            const f32x4 gs = g4 * (sc + 1.0f);
#pragma unroll
            for (int i = 0; i < 4; ++i) { const float rstd = __builtin_amdgcn_rsqf(ss[i] * (1.0f / D) + EPS);
                const f32x4 h = v[i][j] * rstd * gs + sh; u32x2 o; o.x = pk2(h[0], h[1]); o.y = pk2(h[2], h[3]); *(u32x2*)(hdst + (size_t)(r0 + i) * D + col) = o; } }
    }
}
__device__ __forceinline__ void phase_conv_norm1(const KP& p, LAS unsigned char* lds, int l, int G) {
    const int tid = opaque_tid(), lane = tid & 63, wave = __builtin_amdgcn_readfirstlane(tid >> 6);
    const int gw = blockIdx.x * 8 + wave, ngw = G * 8;
    LAS float* scr = (LAS float*)(lds + wave * 8448);
    constexpr int I_IN = 16 * (INC / 32), I_G = 16 * 32, I_O = 16 * 32, I_Q = 16 * 64, NIT = I_IN + I_G + I_O + I_Q;
    for (int it = gw; it < NIT; it += ngw) {
        int r = it;
        if (r < I_IN) { transpose_item_fp8(p.in[I_WIN] + (size_t)l * D * INC, D, INC, p.ws + WS_WIN, scr, r, lane, WIN_SCALE); continue; } r -= I_IN;
        if (r < I_G) { transpose_item(p.in[I_GLUW] + (size_t)l * D * D, D, D, (bf16_t*)(p.ws + WS_WGLU), scr, r, lane); continue; } r -= I_G;
        if (r < I_O) { transpose_item_fp8(p.in[I_WOUT] + (size_t)l * D * D, D, D, p.ws + WS_WOUT, scr, r, lane, WO_SCALE); continue; } r -= I_O;
        transpose_item(p.in[I_WQ] + (size_t)l * D * 2048, D, 2048, (bf16_t*)(p.ws + WS_WQ), scr, r, lane);
    }
    const size_t gtid = (size_t)blockIdx.x * 512 + tid, nthr = (size_t)G * 512;
    cvt_f32_bf16(p.in[I_SUBK] + (size_t)l * 262144, (bf16_t*)(p.ws + WS_KEYS), 262144 / 4, gtid, nthr);
    if (l == 0) {
        cvt_f32_fp8_sliced(p.in[I_PU], p.ws + WS_U, gtid, nthr, U_SCALE);
        cvt_f32_fp8_sliced(p.in[I_PV], p.ws + WS_V, gtid, nthr, V_SCALE); }
    if (l == 0) norm_rows<true, false>(p.in[I_X], (bf16_t*)(p.ws + WS_H), p.in[I_N1G] + l * D, (const float*)(p.ws + WS_MOD) + (size_t)l * 32 * NMODC, 0, 1024, gw, ngw, lane);
    else norm_rows<true, true>(p.out, (bf16_t*)(p.ws + WS_H), p.in[I_N1G] + l * D, (const float*)(p.ws + WS_MOD) + (size_t)l * 32 * NMODC, 0, 1024, gw, ngw, lane);
}

__device__ __forceinline__ void phase_hgrn2(const KP& p, LAS unsigned char* lds, int l, int G) {
    const int tid = opaque_tid(), lane = tid & 63, w = __builtin_amdgcn_readfirstlane(tid >> 6), fr = lane & 15, g = lane >> 4;
    constexpr int QS = 272, TS = 72;
    constexpr int OFF_QT = 0, OFF_KH = 8704, OFF_KT = 17408, OFF_VT = 26624, OFF_EREF = 35840, OFF_ELR = 36352, OFF_SEG = 36864, PBUF = 40960;
    const bf16_t* PA = (const bf16_t*)(p.ws + WS_R0);
    bf16_t* ORAW = (bf16_t*)(p.ws + WS_OR);
    const float* LB = (const float*)(p.ws + WS_LB) + l * 1024;
    for (int unit = blockIdx.x; unit < 256; unit += G) {
        const int b = unit >> 3, h = unit & 7, k0 = 2 * lane;
        const float lb0 = LB[h * 128 + k0], lb1 = LB[h * 128 + k0 + 1];
        const float om0 = 1.0f - lb0, om1 = 1.0f - lb1;
        f32x4 S[8];
#pragma unroll
        for (int kt = 0; kt < 8; ++kt) S[kt] = (f32x4){0.f, 0.f, 0.f, 0.f};
        unsigned rq[4], rf[4], rv[4];
        {
            const bf16_t* base = PA + ((size_t)b * SEQ + 4 * w) * 3072 + h * 128 + k0;
#pragma unroll
            for (int i = 0; i < 4; ++i) { rq[i] = *(const unsigned*)(base + (size_t)i * 3072); rf[i] = *(const unsigned*)(base + (size_t)i * 3072 + 1024); rv[i] = *(const unsigned*)(base + (size_t)i * 3072 + 2048); }
        }
        for (int c = 0; c < 64; ++c) {
            LAS unsigned char* base = lds + (c & 1) * PBUF;
            float cs0[4], cs1[4], qv0[4], qv1[4], kv0[4], kv1[4];
            float run0 = 0.f, run1 = 0.f;
#pragma unroll
            for (int i = 0; i < 4; ++i) {
                const float fp0 = bflo(rf[i]), fp1 = bfhi(rf[i]);
                const float s0 = fsigmoid(fp0), s1 = fsigmoid(fp1);
                run0 += __logf(lb0 + om0 * s0); run1 += __logf(lb1 + om1 * s1);
                cs0[i] = run0; cs1[i] = run1;
                kv0[i] = om0 * (1.0f - s0); kv1[i] = om1 * (1.0f - s1);
                qv0[i] = fsilu(bflo(rq[i])); qv1[i] = fsilu(bfhi(rq[i]));
            }
            *(LAS f32x2*)(base + OFF_SEG + (w * 128 + k0) * 4) = (f32x2){run0, run1};
            __syncthreads();
            float off0 = 0.f, off1 = 0.f, ref0 = 0.f, ref1 = 0.f, all0 = 0.f, all1 = 0.f;
#pragma unroll
            for (int s = 0; s < 8; ++s) { const f32x2 t2 = *(const LAS f32x2*)(base + OFF_SEG + (s * 128 + k0) * 4);
                if (s < w) { off0 += t2[0]; off1 += t2[1]; }
                if (s < 4) { ref0 += t2[0]; ref1 += t2[1]; }
                all0 += t2[0]; all1 += t2[1]; }
            float kh0[4], kh1[4];
#pragma unroll
            for (int i = 0; i < 4; ++i) {
                const float b0 = off0 + cs0[i], b1 = off1 + cs1[i];
                const float q0 = qv0[i] * __expf(b0 - ref0), q1 = qv1[i] * __expf(b1 - ref1);
                kh0[i] = kv0[i] * __expf(ref0 - b0); kh1[i] = kv1[i] * __expf(ref1 - b1);
                const int t = 4 * w + i;
                *(LAS unsigned*)(base + OFF_QT + t * QS + k0 * 2) = pk2(q0, q1);
                *(LAS unsigned*)(base + OFF_KH + t * QS + k0 * 2) = pk2(kh0[i], kh1[i]);
            }
            *(LAS u32x2*)(base + OFF_KT + k0 * TS + 8 * w) = (u32x2){pk2(kh0[0], kh0[1]), pk2(kh0[2], kh0[3])};
            *(LAS u32x2*)(base + OFF_KT + (k0 + 1) * TS + 8 * w) = (u32x2){pk2(kh1[0], kh1[1]), pk2(kh1[2], kh1[3])};
            *(LAS u32x2*)(base + OFF_VT + k0 * TS + 8 * w) = (u32x2){(rv[0] & 0xffffu) | (rv[1] << 16), (rv[2] & 0xffffu) | (rv[3] << 16)};
            *(LAS u32x2*)(base + OFF_VT + (k0 + 1) * TS + 8 * w) = (u32x2){(rv[0] >> 16) | (rv[1] & 0xffff0000u), (rv[2] >> 16) | (rv[3] & 0xffff0000u)};
            if (w == 0) {
                *(LAS f32x2*)(base + OFF_EREF + k0 * 4) = (f32x2){__expf(ref0), __expf(ref1)};
                *(LAS f32x2*)(base + OFF_ELR + k0 * 4) = (f32x2){__expf(all0 - ref0), __expf(all1 - ref1)};
            }
            __syncthreads();
            if (c + 1 < 64) {
                const bf16_t* nb = PA + ((size_t)b * SEQ + (c + 1) * 32 + 4 * w) * 3072 + h * 128 + k0;
#pragma unroll
                for (int i = 0; i < 4; ++i) { rq[i] = *(const unsigned*)(nb + (size_t)i * 3072); rf[i] = *(const unsigned*)(nb + (size_t)i * 3072 + 1024); rv[i] = *(const unsigned*)(nb + (size_t)i * 3072 + 2048); }
            }
            bf16x8 qf[2][4], kf[2][4];
#pragma unroll
            for (int tt = 0; tt < 2; ++tt)
#pragma unroll
                for (int m = 0; m < 4; ++m) {
                    const LAS unsigned char* pq = base + OFF_QT + (16 * tt + fr) * QS + (32 * m + 4 * g) * 2;
                    const u32x2 lo = *(const LAS u32x2*)pq, hi = *(const LAS u32x2*)(pq + 32);
                    qf[tt][m] = __builtin_bit_cast(bf16x8, (u32x4){lo[0], lo[1], hi[0], hi[1]});
                    const LAS unsigned char* pk = base + OFF_KH + (16 * tt + fr) * QS + (32 * m + 4 * g) * 2;
                    const u32x2 lo2 = *(const LAS u32x2*)pk, hi2 = *(const LAS u32x2*)(pk + 32);
                    kf[tt][m] = __builtin_bit_cast(bf16x8, (u32x4){lo2[0], lo2[1], hi2[0], hi2[1]});
                }
            f32x4 PT00 = {0.f, 0.f, 0.f, 0.f}, PT01 = {0.f, 0.f, 0.f, 0.f}, PT11 = {0.f, 0.f, 0.f, 0.f};
#pragma unroll
            for (int m = 0; m < 4; ++m) {
                PT00 = __builtin_amdgcn_mfma_f32_16x16x32_bf16(kf[0][m], qf[0][m], PT00, 0, 0, 0);
                PT01 = __builtin_amdgcn_mfma_f32_16x16x32_bf16(kf[0][m], qf[1][m], PT01, 0, 0, 0);
                PT11 = __builtin_amdgcn_mfma_f32_16x16x32_bf16(kf[1][m], qf[1][m], PT11, 0, 0, 0);
            }
#pragma unroll
            for (int r = 0; r < 4; ++r) { if (4 * g + r > fr) { PT00[r] = 0.f; PT11[r] = 0.f; } }
            const bf16x8 pa0 = __builtin_bit_cast(bf16x8, (u32x4){pk2(PT00[0], PT00[1]), pk2(PT00[2], PT00[3]), 0u, 0u});
            const bf16x8 pa1 = __builtin_bit_cast(bf16x8, (u32x4){pk2(PT01[0], PT01[1]), pk2(PT01[2], PT01[3]), pk2(PT11[0], PT11[1]), pk2(PT11[2], PT11[3])});
            const LAS unsigned char* vrow = base + OFF_VT + (16 * w + fr) * TS;
            const u32x2 vpa = *(const LAS u32x2*)(vrow + 8 * g), vpb = *(const LAS u32x2*)(vrow + 32 + 8 * g);
            const u32x2 vna = *(const LAS u32x2*)(vrow + 16 * g), vnb = *(const LAS u32x2*)(vrow + 16 * g + 8);
            const bf16x8 vperm = __builtin_bit_cast(bf16x8, (u32x4){vpa[0], vpa[1], vpb[0], vpb[1]});
            const bf16x8 vnat = __builtin_bit_cast(bf16x8, (u32x4){vna[0], vna[1], vnb[0], vnb[1]});
#pragma unroll
            for (int kt = 0; kt < 8; ++kt) { const f32x4 e = *(const LAS f32x4*)(base + OFF_EREF + (16 * kt + 4 * g) * 4); S[kt] = S[kt] * e; }
            f32x4 O0 = {0.f, 0.f, 0.f, 0.f}, O1 = {0.f, 0.f, 0.f, 0.f};
#pragma unroll
            for (int m = 0; m < 4; ++m) {
                const bf16x8 sf = __builtin_bit_cast(bf16x8, (u32x4){pk2(S[2 * m][0], S[2 * m][1]), pk2(S[2 * m][2], S[2 * m][3]), pk2(S[2 * m + 1][0], S[2 * m + 1][1]), pk2(S[2 * m + 1][2], S[2 * m + 1][3])});
                O0 = __builtin_amdgcn_mfma_f32_16x16x32_bf16(qf[0][m], sf, O0, 0, 0, 0);
                O1 = __builtin_amdgcn_mfma_f32_16x16x32_bf16(qf[1][m], sf, O1, 0, 0, 0);
            }
            O0 = __builtin_amdgcn_mfma_f32_16x16x32_bf16(pa0, vperm, O0, 0, 0, 0);
            O1 = __builtin_amdgcn_mfma_f32_16x16x32_bf16(pa1, vperm, O1, 0, 0, 0);
#pragma unroll
            for (int kt = 0; kt < 8; ++kt) {
                const LAS unsigned char* krow = base + OFF_KT + (16 * kt + fr) * TS + 16 * g;
                const u32x2 ka = *(const LAS u32x2*)krow, kb = *(const LAS u32x2*)(krow + 8);
                const bf16x8 ktf = __builtin_bit_cast(bf16x8, (u32x4){ka[0], ka[1], kb[0], kb[1]});
                S[kt] = __builtin_amdgcn_mfma_f32_16x16x32_bf16(ktf, vnat, S[kt], 0, 0, 0);
            }
#pragma unroll
            for (int kt = 0; kt < 8; ++kt) { const f32x4 e = *(const LAS f32x4*)(base + OFF_ELR + (16 * kt + 4 * g) * 4); S[kt] = S[kt] * e; }
            bf16_t* orow = ORAW + ((size_t)b * SEQ + c * 32 + 4 * g) * D + h * 128 + 16 * w + fr;
#pragma unroll
            for (int r = 0; r < 4; ++r) { orow[(size_t)r * D] = (bf16_t)(pk2(O0[r], 0.f) & 0xffffu); orow[(size_t)(16 + r) * D] = (bf16_t)(pk2(O1[r], 0.f) & 0xffffu); }
        }
        __syncthreads();
    }
}

__device__ __forceinline__ void phase_s5(const KP& p, LAS unsigned char* lds, int l, int G, size_t ys_off) {
    const int tid = opaque_tid(), lane = tid & 63, w = __builtin_amdgcn_readfirstlane(tid >> 6), fr = lane & 15, g = lane >> 4;
    const int gw = blockIdx.x * 8 + w, ngw = G * 8;
    constexpr int BUS = 132;
    LAS float* BU = (LAS float*)(lds + w * 16896);
    LAS unsigned char* XI = (LAS unsigned char*)BU;
    const bf16_t* PB = (const bf16_t*)(p.ws + WS_R0);
    const bf16x8 zero8 = {0, 0, 0, 0, 0, 0, 0, 0};
    const bf16_t* ORAWs = (const bf16_t*)(p.ws + WS_OR); float* SSQs = (float*)(p.ws + WS_SSQ);
    for (int unit = gw; unit < BATCH * 64; unit += ngw) {
        const int b = unit >> 6, grp = unit & 63, lg = l * 64 + grp;
        const bf16_t* BOP = (const bf16_t*)(p.ws + WS_BOP) + (size_t)lg * 128 * 16;
        const bf16_t* COP = (const bf16_t*)(p.ws + WS_COP) + (size_t)lg * 16 * 128;
        bf16x8 bfrag[8], cfrag[4], dfrag;
#pragma unroll
        for (int nt = 0; nt < 8; ++nt) bfrag[nt] = (g < 2) ? *(const bf16x8*)(BOP + (size_t)(16 * nt + fr) * 16 + 8 * g) : zero8;
#pragma unroll
        for (int ks = 0; ks < 4; ++ks) cfrag[ks] = DBG_S5_NOSSM ? zero8 : *(const bf16x8*)(COP + (size_t)fr * 128 + 32 * ks + 8 * g);
        {
            const unsigned dbits = pk2(p.in[I_S5D][l * 1024 + grp * 16 + fr], 0.f) & 0xffffu;
#pragma unroll
            for (int j = 0; j < 8; ++j) dfrag[j] = (g < 2 && (8 * g + j) == fr) ? (short)dbits : (short)0;
        }
        const float ar = ((const float*)(p.ws + WS_ABAR))[2 * ((size_t)lg * 64 + lane)], ai = ((const float*)(p.ws + WS_ABAR))[2 * ((size_t)lg * 64 + lane) + 1];
        const float nai = -ai; float xr = 0.f, xi = 0.f; unsigned hBU = 0u, hXI = 0u, hY = 0u;
        const bf16_t* ub = PB + ((size_t)b * SEQ) * 4096 + 1024 + grp * 16;
        bf16_t* yb_ = (bf16_t*)(p.ws + ys_off) + ((size_t)b * SEQ) * D + grp * 16;
        bf16x8 unext[2];
#pragma unroll
        for (int tt = 0; tt < 2; ++tt) unext[tt] = (g < 2) ? *(const bf16x8*)(ub + (size_t)(16 * tt + fr) * 4096 + 8 * g) : zero8;
        const bool cvt_next = (l + 1 < DEPTH);
        const float* tsrc = ((lane < 32) ? p.in[I_PU] : p.in[I_PV]) + (size_t)(l + 1 < DEPTH ? l + 1 : l) * 16384 * 1024 + 4 * (lane & 31);
        unsigned char* tdst = p.ws + ((lane < 32) ? WS_U : WS_V) + (size_t)((l + 1) & 1) * TAB_BYTES + 4 * (lane & 31);
        const float tscale = (lane < 32) ? U_SCALE : V_SCALE;
        for (int t0 = 0; t0 < SEQ; t0 += 32) {
            const int item = unit * 64 + (t0 >> 5), te = item >> 3, tsl = item & 7;
            f32x4 tv = {0.f, 0.f, 0.f, 0.f}; if (cvt_next) tv = *(const f32x4*)(tsrc + (size_t)te * 1024 + tsl * 128);
            const bool ssq_it = ((t0 >> 5) & 1) == 0; const int srow = item >> 1;
            u32x4 sa = {0u, 0u, 0u, 0u}, sc2 = {0u, 0u, 0u, 0u};
            if (ssq_it) { sa = *(const u32x4*)(ORAWs + (size_t)srow * D + 8 * lane); sc2 = *(const u32x4*)(ORAWs + (size_t)srow * D + 512 + 8 * lane); }
            bf16x8 ufrag[2];
#pragma unroll
            for (int tt = 0; tt < 2; ++tt) { ufrag[tt] = unext[tt]; if (t0 + 32 < SEQ) unext[tt] = (g < 2) ? *(const bf16x8*)(ub + (size_t)(t0 + 32 + 16 * tt + fr) * 4096 + 8 * g) : zero8; }
#pragma unroll
            for (int tt = 0; tt < 2; ++tt)
#pragma unroll
                for (int nt = 0; nt < 8; ++nt) {
                    const f32x4 a = __builtin_amdgcn_mfma_f32_16x16x32_bf16(ufrag[tt], bfrag[nt], (f32x4){0.f, 0.f, 0.f, 0.f}, 0, 0, 0);
#pragma unroll
                    for (int r = 0; r < 4; ++r) BU[(16 * tt + 4 * g + r) * BUS + 16 * nt + fr] = a[r];
                }
            LDS_WAIT();
#pragma unroll
            for (int t = 0; t < 32; ++t) {
                const f32x2 bb = *(const LAS f32x2*)(BU + t * BUS + 2 * lane); hBU += __float_as_uint(bb[0]) * 3u + __float_as_uint(bb[1]);
                float t1, t2, nr, ni;
                asm("v_fma_f32 %0, %1, %2, %3" : "=v"(t1) : "v"(nai), "v"(xi), "v"(bb[0]));
                asm("v_fma_f32 %0, %1, %2, %3" : "=v"(t2) : "v"(ai), "v"(xr), "v"(bb[1]));
                asm("v_fma_f32 %0, %1, %2, %3" : "=v"(nr) : "v"(ar), "v"(xr), "v"(t1));
                asm("v_fma_f32 %0, %1, %2, %3" : "=v"(ni) : "v"(ar), "v"(xi), "v"(t2));
                xr = nr; xi = ni;
                { const unsigned pv = pk2(nr, ni); hXI += pv; *(LAS unsigned*)(XI + t * (BUS * 4) + lane * 4) = pv; }
            }
            LDS_WAIT();
#pragma unroll
            for (int tt = 0; tt < 2; ++tt) {
                f32x4 y = {0.f, 0.f, 0.f, 0.f};
#pragma unroll
                for (int ks = 0; ks < 4; ++ks) {
                    const bf16x8 xf = *(const LAS bf16x8*)(XI + (16 * tt + fr) * (BUS * 4) + (32 * ks + 8 * g) * 2);
                    y = __builtin_amdgcn_mfma_f32_16x16x32_bf16(xf, cfrag[ks], y, 0, 0, 0);
                }
                y = __builtin_amdgcn_mfma_f32_16x16x32_bf16(ufrag[tt], dfrag, y, 0, 0, 0);
#pragma unroll
                for (int r = 0; r < 4; ++r) { const unsigned yv = pk2(fgelu(y[r]), 0.f) & 0xffffu; hY += yv * (unsigned)(r + 1); yb_[(size_t)(t0 + 16 * tt + 4 * g + r) * D + fr] = (bf16_t)yv; }
            }
            LDS_WAIT();
            if (ssq_it) { float s0 = 0.f, s1 = 0.f;
#pragma unroll
                for (int j = 0; j < 4; ++j) { const float x0 = bflo(sa[j]), x1 = bfhi(sa[j]), y0 = bflo(sc2[j]), y1 = bfhi(sc2[j]); s0 += x0 * x0 + x1 * x1; s1 += y0 * y0 + y1 * y1; }
                { s0 = dpp_sum8(s0); s1 = dpp_sum8(s1);
                  s0 += __uint_as_float(__builtin_amdgcn_update_dpp(0, __float_as_uint(s0), 0x140, 0xF, 0xF, true)); s1 += __uint_as_float(__builtin_amdgcn_update_dpp(0, __float_as_uint(s1), 0x140, 0xF, 0xF, true)); }
                if (fr == 0) { SSQs[(size_t)srow * 8 + g] = s0; SSQs[(size_t)srow * 8 + 4 + g] = s1; } }
            if (cvt_next) { int w8 = 0; w8 = __builtin_amdgcn_cvt_pk_fp8_f32(tv[0] * tscale, tv[1] * tscale, w8, false); w8 = __builtin_amdgcn_cvt_pk_fp8_f32(tv[2] * tscale, tv[3] * tscale, w8, true);
                *(unsigned*)(tdst + ((size_t)tsl * 16384 + te) * 128) = (unsigned)w8; }
        }
        if (DBG_SELFCHECK) { for (int o = 1; o < 64; o <<= 1) { hBU += __shfl_xor((int)hBU, o); hXI += __shfl_xor((int)hXI, o); hY += __shfl_xor((int)hY, o); }
            unsigned* hs = (unsigned*)(p.ws + WS_CTL) + 65536 + (ys_off == WS_YS ? 0 : 8192) + unit * 4; unsigned hA = __float_as_uint(ar) * 7u + __float_as_uint(ai); for (int o = 1; o < 64; o <<= 1) hA += __shfl_xor((int)hA, o); if (lane == 0) { hs[0] = hBU; hs[1] = hXI; hs[2] = hA; } }
    }
}

__device__ __forceinline__ unsigned fkey(float f) { const unsigned u = __float_as_uint(f); return u ^ ((unsigned)((int)u >> 31) | 0x80000000u); }
__device__ __forceinline__ float kval(unsigned k) { const unsigned u = (k & 0x80000000u) ? (k ^ 0x80000000u) : ~k; return __uint_as_float(u); }
#define CE_DESC(a, b) do { const unsigned _mx = (a) > (b) ? (a) : (b), _mn = (a) > (b) ? (b) : (a); (a) = _mx; (b) = _mn; } while (0)
__device__ __forceinline__ void sort16_desc(unsigned (&a)[16]) {
#pragma unroll
    for (int kk = 1; kk <= 4; ++kk)
#pragma unroll
        for (int jj = kk - 1; jj >= 0; --jj)
#pragma unroll
            for (int i = 0; i < 16; ++i) { const int k = 1 << kk, j = 1 << jj, l2 = i ^ j;
                if (l2 > i) { if ((i & k) == 0) CE_DESC(a[i], a[l2]); else CE_DESC(a[l2], a[i]); } }
}
__device__ __forceinline__ void merge_top16(unsigned (&a)[16], const unsigned (&b)[16]) {
#pragma unroll
    for (int i = 0; i < 16; ++i) a[i] = a[i] > b[15 - i] ? a[i] : b[15 - i];
#pragma unroll
    for (int jj = 3; jj >= 0; --jj)
#pragma unroll
        for (int i = 0; i < 16; ++i) { const int j = 1 << jj, l2 = i ^ j; if (l2 > i) CE_DESC(a[i], a[l2]); }
}
__device__ __forceinline__ void phase_topk(const KP& p, LAS unsigned char* lds, int G) {
    const int tid = opaque_tid(), lane = tid & 63, w = __builtin_amdgcn_readfirstlane(tid >> 6), hh = lane >> 5;
    const int gw = blockIdx.x * 8 + w, ngw = G * 8;
    const bf16_t* Q = (const bf16_t*)(p.ws + WS_R0); const bf16_t* KEYS = (const bf16_t*)(p.ws + WS_KEYS);
    unsigned* SEL = (unsigned*)(p.ws + WS_SEL);
    LAS unsigned char* tab = lds + w * 2048 + lane * 32;
    const int CI[50] = {0,0,0,0,0,0,0,0,0,0,0,0,0,0,0,0, 1,1,1,1,1,1,1,1, 2,2,2,2,2, 3,3,3,3, 4,4,4, 5,5, 6,6, 7,7, 8,9,10,11,12,13,14,15};
    const int CJ[50] = {0,1,2,3,4,5,6,7,8,9,10,11,12,13,14,15, 0,1,2,3,4,5,6,7, 0,1,2,3,4, 0,1,2,3, 0,1,2, 0,1, 0,1, 0,1, 0,0,0,0,0,0,0,0};
    LAS unsigned char* kimg = lds + 16384;
    for (int h = 0; h < 8; ++h) {
      __syncthreads();
#pragma unroll
      for (int i = 0; i < 8; ++i) { const int ch = tid + 512 * i, row = ch >> 4, c16 = ch & 15;
          *(LAS u32x4*)(kimg + row * 272 + c16 * 16) = *(const u32x4*)(KEYS + (size_t)(h * 256 + row) * 128 + c16 * 8); }
      __syncthreads();
      for (int tg = gw; tg < 2048; tg += ngw) {
        const int t = tg * 32 + (lane & 31);
        unsigned top[2][16];
#pragma unroll
        for (int pp = 0; pp < 2; ++pp) {
            bf16x8 qf[8];
#pragma unroll
            for (int ks = 0; ks < 8; ++ks) qf[ks] = *(const bf16x8*)(Q + ((size_t)((((tg * 8 + h) * 2 + pp) * 8 + ks) * 64 + lane)) * 8);
            const LAS unsigned char* kb = kimg + (pp * 128 + (lane & 31)) * 272 + 16 * hh;
#pragma unroll
            for (int nt = 0; nt < 4; ++nt) {
                f32x16 acc;
#pragma unroll
                for (int i = 0; i < 16; ++i) acc[i] = 0.f;
#pragma unroll
                for (int ks = 0; ks < 8; ++ks) { const bf16x8 kf = *(const LAS bf16x8*)(kb + (32 * nt) * 272 + 32 * ks);
                    acc = __builtin_amdgcn_mfma_f32_32x32x16_bf16(kf, qf[ks], acc, 0, 0, 0); }
                unsigned ky[16];
#pragma unroll
                for (int r = 0; r < 16; ++r) ky[r] = (fkey(acc[r]) & ~127u) | (unsigned)(32 * nt + (r & 3) + 8 * (r >> 2)) | (unsigned)(4 * hh);
                sort16_desc(ky);
                if (nt == 0) {
#pragma unroll
                    for (int i = 0; i < 16; ++i) top[pp][i] = ky[i];
                } else merge_top16(top[pp], ky);
            }
            unsigned other[16];
#pragma unroll
            for (int i = 0; i < 16; ++i) { const u32x2 sw_ = __builtin_amdgcn_permlane32_swap(top[pp][i], top[pp][i], false, false); other[i] = hh ? sw_[0] : sw_[1]; }
            merge_top16(top[pp], other);
        }
        float sa[16], sb[16];
#pragma unroll
        for (int i = 0; i < 16; ++i) { sa[i] = kval(top[0][i] & ~127u); sb[i] = kval(top[1][i] & ~127u); }
        unsigned c0[16], c1[16];
#pragma unroll
        for (int s = 0; s < 32; ++s) {
            unsigned key = 0u;
            if (s < 25) {
                const float v0 = sa[CI[s]] + sb[CJ[s]], v1 = sa[CI[25 + s]] + sb[CJ[25 + s]];
                const unsigned k0 = (fkey(v0) & ~255u) | (unsigned)(CI[s] * 16 + CJ[s]), k1 = (fkey(v1) & ~255u) | (unsigned)(CI[25 + s] * 16 + CJ[25 + s]);
                key = hh ? k1 : k0;
            }
            if (s < 16) c0[s] = key; else c1[s - 16] = key;
        }
        sort16_desc(c0); sort16_desc(c1); merge_top16(c0, c1);
#pragma unroll
        for (int i = 0; i < 16; ++i) { const u32x2 sw_ = __builtin_amdgcn_permlane32_swap(c0[i], c0[i], false, false); c1[i] = hh ? sw_[0] : sw_[1]; }
        merge_top16(c0, c1);
        {
            u32x4 wa, wb;
#pragma unroll
            for (int q4 = 0; q4 < 4; ++q4) {
                wa[q4] = (top[0][4 * q4] & 127u) | ((top[0][4 * q4 + 1] & 127u) << 8) | ((top[0][4 * q4 + 2] & 127u) << 16) | ((top[0][4 * q4 + 3] & 127u) << 24);
                wb[q4] = (top[1][4 * q4] & 127u) | ((top[1][4 * q4 + 1] & 127u) << 8) | ((top[1][4 * q4 + 2] & 127u) << 16) | ((top[1][4 * q4 + 3] & 127u) << 24);
            }
            *(LAS u32x4*)tab = wa; *(LAS u32x4*)(tab + 16) = wb;
        }
        float ev[16], esum = 0.f; const float vmax = kval(c0[0] & ~255u);
#pragma unroll
        for (int k = 0; k < 16; ++k) { ev[k] = __expf(kval(c0[k] & ~255u) - vmax); esum += ev[k]; }
        const float rs = 1.0f / esum;
        LDS_WAIT();
        unsigned outw[8]; const unsigned hmask = hh ? 0xffffffffu : 0u;
#pragma unroll
        for (int kk = 0; kk < 8; ++kk) {
            const unsigned key = c0[kk] ^ ((c0[kk] ^ c0[8 + kk]) & hmask); const float e = __uint_as_float(__float_as_uint(ev[kk]) ^ ((__float_as_uint(ev[kk]) ^ __float_as_uint(ev[8 + kk])) & hmask));
            const unsigned code = key & 255u, ia = tab[code >> 4], ib = tab[16 + (code & 15u)];
            outw[kk] = (pk2(0.f, e * rs) & 0xffff0000u) | (ia * 128u + ib);
        }
        u32x4* dst = (u32x4*)(SEL + (size_t)t * 128 + h * 16 + hh * 8);
        dst[0] = (u32x4){outw[0], outw[1], outw[2], outw[3]}; dst[1] = (u32x4){outw[4], outw[5], outw[6], outw[7]};
        LDS_WAIT();
      }
    }
    __syncthreads();
}

__device__ __forceinline__ void fp8x4_to_f32(unsigned w, float& a, float& b, float& c, float& d) {
    const f32x2 lo = __builtin_amdgcn_cvt_pk_f32_fp8((int)w, false), hi = __builtin_amdgcn_cvt_pk_f32_fp8((int)w, true); a = lo[0]; b = lo[1]; c = hi[0]; d = hi[1];
}
struct XSlice { int sl, rank, nloc; };
__device__ __forceinline__ XSlice xslice_of_block(const KP& p, volatile LAS unsigned* MISC, int G) {
    unsigned* bar = (unsigned*)(p.ws + WS_CTL) + 4096; unsigned cnt[8]; unsigned tot = 0; bool ok = true;
#pragma unroll
    for (int j = 0; j < 8; ++j) { cnt[j] = xb_ld(&bar[XB_XCNT(j)]); tot += cnt[j]; ok = ok && (cnt[j] > 0u); }
    ok = ok && (tot == (unsigned)G);
    XSlice x;
    if (ok) { const unsigned myx = MISC[16]; x.sl = (int)myx; x.rank = (int)MISC[17]; x.nloc = (int)cnt[myx & 7u]; }
    else { x.sl = (int)(blockIdx.x & 7); x.rank = (int)(blockIdx.x >> 3); x.nloc = (G - x.sl + 7) >> 3; }
    x.sl = __builtin_amdgcn_readfirstlane(x.sl); x.rank = __builtin_amdgcn_readfirstlane(x.rank); x.nloc = __builtin_amdgcn_readfirstlane(x.nloc);
    return x;
}
__device__ __forceinline__ float dot16_fp8(const u32x4 u, const float (&hf)[16]) {
    float d = 0.f;
#pragma unroll
    for (int j = 0; j < 4; ++j) { float f0, f1, f2, f3; fp8x4_to_f32(u[j], f0, f1, f2, f3);
        d = __builtin_fmaf(f0, hf[4 * j], d); d = __builtin_fmaf(f1, hf[4 * j + 1], d); d = __builtin_fmaf(f2, hf[4 * j + 2], d); d = __builtin_fmaf(f3, hf[4 * j + 3], d); }
    return d;
}
typedef __bf16 bf16v8 __attribute__((ext_vector_type(8)));
__device__ __forceinline__ float dot16_fp8_bf16(const u32x4 u, const bf16v8 h0, const bf16v8 h1) {
    float d0 = 0.f, d1 = 0.f;
    d0 = __builtin_amdgcn_fdot2_f32_bf16(__builtin_amdgcn_cvt_scalef32_pk_bf16_fp8(u[0], 1.0f, false), __builtin_shufflevector(h0, h0, 0, 1), d0, false);
    d1 = __builtin_amdgcn_fdot2_f32_bf16(__builtin_amdgcn_cvt_scalef32_pk_bf16_fp8(u[0], 1.0f, true),  __builtin_shufflevector(h0, h0, 2, 3), d1, false);
    d0 = __builtin_amdgcn_fdot2_f32_bf16(__builtin_amdgcn_cvt_scalef32_pk_bf16_fp8(u[1], 1.0f, false), __builtin_shufflevector(h0, h0, 4, 5), d0, false);
    d1 = __builtin_amdgcn_fdot2_f32_bf16(__builtin_amdgcn_cvt_scalef32_pk_bf16_fp8(u[1], 1.0f, true),  __builtin_shufflevector(h0, h0, 6, 7), d1, false);
    d0 = __builtin_amdgcn_fdot2_f32_bf16(__builtin_amdgcn_cvt_scalef32_pk_bf16_fp8(u[2], 1.0f, false), __builtin_shufflevector(h1, h1, 0, 1), d0, false);
    d1 = __builtin_amdgcn_fdot2_f32_bf16(__builtin_amdgcn_cvt_scalef32_pk_bf16_fp8(u[2], 1.0f, true),  __builtin_shufflevector(h1, h1, 2, 3), d1, false);
    d0 = __builtin_amdgcn_fdot2_f32_bf16(__builtin_amdgcn_cvt_scalef32_pk_bf16_fp8(u[3], 1.0f, false), __builtin_shufflevector(h1, h1, 4, 5), d0, false);
    d1 = __builtin_amdgcn_fdot2_f32_bf16(__builtin_amdgcn_cvt_scalef32_pk_bf16_fp8(u[3], 1.0f, true),  __builtin_shufflevector(h1, h1, 6, 7), d1, false);
    return d0 + d1;
}
__device__ __forceinline__ float dpp_sum8(float d) {
    d += __uint_as_float(__builtin_amdgcn_update_dpp(0, __float_as_uint(d), 0xB1, 0xF, 0xF, true));
    d += __uint_as_float(__builtin_amdgcn_update_dpp(0, __float_as_uint(d), 0x4E, 0xF, 0xF, true));
    d += __uint_as_float(__builtin_amdgcn_update_dpp(0, __float_as_uint(d), 0x141, 0xF, 0xF, true));
    return d;
}
__device__ __forceinline__ void phase_expert_u(const KP& p, LAS unsigned char* lds, volatile LAS unsigned* MISC, int l, int G) {
    const int tid = opaque_tid(), lane = tid & 63, w = __builtin_amdgcn_readfirstlane(tid >> 6), j = lane >> 3, c = lane & 7;
    const XSlice xs = xslice_of_block(p, MISC, G);
    const bf16_t* H2 = (const bf16_t*)(p.ws + WS_H); const unsigned char* Us = p.ws + WS_U + (size_t)(l & 1) * TAB_BYTES + (size_t)xs.sl * 16384 * 128;
    const unsigned* SEL = (const unsigned*)(p.ws + WS_SEL); unsigned* PDu = (unsigned*)(p.ws + WS_R0) + (size_t)xs.sl * M * 64;
    const int t0 = xs.rank * 8 + w, tstep = xs.nloc * 8;
    LAS unsigned char* ring = lds + w * 17920;
    LAS unsigned char* selb = ring + 16384; LAS unsigned char* hbuf = ring + 16384 + 1024;
    const int tlast = t0 + ((M - 1 - t0) / tstep) * tstep;
#define E1_CL(t) ((t) <= tlast ? (t) : tlast)
#define E1_DMA_SEL(t, par) do { const unsigned* sp = SEL + (size_t)E1_CL(t) * 128 + lane; \
            __builtin_amdgcn_global_load_lds(sp, (LAS unsigned*)(selb + (par) * 512), 4, 0, 0); __builtin_amdgcn_global_load_lds(sp + 64, (LAS unsigned*)(selb + (par) * 512 + 256), 4, 0, 0); } while (0)
#define E1_DMA_H(t, par) do { __builtin_amdgcn_global_load_lds((const unsigned*)(H2 + (size_t)E1_CL(t) * D + xs.sl * 128) + lane, (LAS unsigned*)(hbuf + (par) * 256), 4, 0, 0); } while (0)
#define E1_DMA_ROW(i, idxv) do { __builtin_amdgcn_global_load_lds((const unsigned*)(Us + (size_t)((idxv) & 0x3fffu) * 128 + 16 * c), (LAS unsigned*)(ring + (i) * 1024), 16, 0, 0); } while (0)
    if (t0 < M) {
        E1_DMA_SEL(t0, 0); E1_DMA_SEL(t0 + tstep, 1); E1_DMA_H(t0, 0);
        asm volatile("s_waitcnt vmcnt(0)" ::: "memory");
        { u32x4 s0[4];
#pragma unroll
          for (int q = 0; q < 4; ++q) s0[q] = *(const LAS u32x4*)(selb + (16 * j + 4 * q) * 4);
#pragma unroll
          for (int i = 0; i < 16; ++i) E1_DMA_ROW(i, s0[i >> 2][i & 3]); }
        { PDu[(size_t)t0 * 64 + 8 * j + (c >> 1) + 4 * (c & 1)] = 0u; }
        int par = 0;
        for (int tok = t0; tok < M; tok += tstep, par ^= 1) {
            E1_DMA_SEL(tok + 2 * tstep, par); E1_DMA_H(tok + tstep, par ^ 1);
            asm volatile("s_waitcnt vmcnt(19)" ::: "memory");
            u32x4 sn[4];
#pragma unroll
            for (int q = 0; q < 4; ++q) sn[q] = *(const LAS u32x4*)(selb + (par ^ 1) * 512 + (16 * j + 4 * q) * 4);
            const bf16v8 hb0 = *(const LAS bf16v8*)(hbuf + par * 256 + 32 * c), hb1 = *(const LAS bf16v8*)(hbuf + par * 256 + 32 * c + 16);
            float pd0 = 0.f, pd1 = 0.f;
#pragma unroll
            for (int i0 = 0; i0 < 16; i0 += 4) {
                asm volatile("s_waitcnt vmcnt(16)" ::: "memory");
                u32x4 row[4];
#pragma unroll
                for (int r = 0; r < 4; ++r) row[r] = *(const LAS u32x4*)(ring + (i0 + r) * 1024 + 16 * lane);
                asm volatile("s_waitcnt lgkmcnt(0)" ::: "memory");
#pragma unroll
                for (int r = 0; r < 4; ++r) E1_DMA_ROW(i0 + r, sn[(i0 + r) >> 2][(i0 + r) & 3]);
#pragma unroll
                for (int r = 0; r < 4; ++r) { const int i = i0 + r; const float d = dpp_sum8(dot16_fp8_bf16(row[r], hb0, hb1));
                    if (i < 8) pd0 = (c == i) ? d : pd0; else pd1 = (c == i - 8) ? d : pd1; }
            }
            { const float nb0 = __uint_as_float(__builtin_amdgcn_update_dpp(0, __float_as_uint(pd0), 0xB1, 0xF, 0xF, true)), nb1 = __uint_as_float(__builtin_amdgcn_update_dpp(0, __float_as_uint(pd1), 0xB1, 0xF, 0xF, true));
              PDu[(size_t)tok * 64 + 8 * j + (c >> 1) + 4 * (c & 1)] = (c & 1) ? pk2(nb1, pd1) : pk2(pd0, nb0); }
        }
        asm volatile("s_waitcnt vmcnt(0)" ::: "memory");
    }
#undef E1_CL
#undef E1_DMA_SEL
#undef E1_DMA_H
#undef E1_DMA_ROW
}
__device__ __forceinline__ void phase_expert_w(const KP& p, int G) {
    const int tid = opaque_tid(), lane = tid & 63, w = __builtin_amdgcn_readfirstlane(tid >> 6);
    const int gw = blockIdx.x * 8 + w, ngw = G * 8;
    unsigned* SEL = (unsigned*)(p.ws + WS_SEL); const unsigned* PDu = (const unsigned*)(p.ws + WS_R0);
    for (int tok0 = gw; tok0 < M; tok0 += 4 * ngw) {
        unsigned pw[4][8]; u32x2 s2[4];
#pragma unroll
        for (int k = 0; k < 4; ++k) { const int tok = (tok0 + k * ngw < M) ? tok0 + k * ngw : tok0;
#pragma unroll
            for (int sl = 0; sl < 8; ++sl) pw[k][sl] = PDu[((size_t)sl * M + tok) * 64 + lane];
            s2[k] = *(const u32x2*)(SEL + (size_t)tok * 128 + 2 * lane); }
#pragma unroll
        for (int k = 0; k < 4; ++k) { const int tok = tok0 + k * ngw;
            f32x2 d = {0.f, 0.f};
#pragma unroll
            for (int sl = 0; sl < 8; ++sl) { d[0] += bflo(pw[k][sl]); d[1] += bfhi(pw[k][sl]); }
            const float w0 = __uint_as_float(s2[k][0] & 0xffff0000u) * fgelu(d[0] * (1.0f / U_SCALE)) * (1.0f / V_SCALE);
            const float w1 = __uint_as_float(s2[k][1] & 0xffff0000u) * fgelu(d[1] * (1.0f / U_SCALE)) * (1.0f / V_SCALE);
            u32x2 o; o[0] = (pk2(0.f, w0) & 0xffff0000u) | (s2[k][0] & 0x3fffu); o[1] = (pk2(0.f, w1) & 0xffff0000u) | (s2[k][1] & 0x3fffu);
            if (tok < M) *(u32x2*)(SEL + (size_t)tok * 128 + 2 * lane) = o; }
    }
}
__device__ __forceinline__ void phase_expert_v(const KP& p, LAS unsigned char* lds, volatile LAS unsigned* MISC, int l, int G) {
    const int tid = opaque_tid(), lane = tid & 63, w = __builtin_amdgcn_readfirstlane(tid >> 6), j = lane >> 3, c = lane & 7;
    const XSlice xs = xslice_of_block(p, MISC, G);
    const unsigned char* Vs = p.ws + WS_V + (size_t)(l & 1) * TAB_BYTES + (size_t)xs.sl * 16384 * 128;
    const unsigned* SEL = (const unsigned*)(p.ws + WS_SEL);
    const float* g2 = (const float*)(p.ws + WS_MOD) + (size_t)l * 32 * NMODC + 5120;
    const bf16_t* X = (const bf16_t*)p.out; bf16_t* XO = (l == DEPTH - 1) ? (bf16_t*)(p.ws + WS_YS) : (bf16_t*)p.out;
    const int t0 = xs.rank * 8 + w, tstep = xs.nloc * 8;
    const bool b3 = (lane & 8) != 0;
    LAS unsigned char* ring = lds + w * 17920; LAS unsigned char* selb = ring + 16384;
    const int tlast = t0 + ((M - 1 - t0) / tstep) * tstep;
#define E2_CL(t) ((t) <= tlast ? (t) : tlast)
#define E2_DMA_SEL(t, par) do { const unsigned* sp = SEL + (size_t)E2_CL(t) * 128 + lane; \
            __builtin_amdgcn_global_load_lds(sp, (LAS unsigned*)(selb + (par) * 512), 4, 0, 0); __builtin_amdgcn_global_load_lds(sp + 64, (LAS unsigned*)(selb + (par) * 512 + 256), 4, 0, 0); } while (0)
#define E2_DMA_ROW(i, idxv) do { __builtin_amdgcn_global_load_lds((const unsigned*)(Vs + (size_t)((idxv) & 0x3fffu) * 128 + 16 * c), (LAS unsigned*)(ring + (i) * 1024), 16, 0, 0); } while (0)
    if (t0 < M) {
        E2_DMA_SEL(t0, 0); E2_DMA_SEL(t0 + tstep, 1);
        asm volatile("s_waitcnt vmcnt(0)" ::: "memory");
        u32x4 sc[4];
#pragma unroll
        for (int q = 0; q < 4; ++q) sc[q] = *(const LAS u32x4*)(selb + (16 * j + 4 * q) * 4);
#pragma unroll
        for (int i = 0; i < 16; ++i) E2_DMA_ROW(i, sc[i >> 2][i & 3]);
        LAS float* xbuf = (LAS float*)(ring + 16384 + 1024);
        { const bf16_t* xd = X + (size_t)t0 * D + xs.sl * 128 + 16 * c + 2 * j; __builtin_amdgcn_global_load_lds((const unsigned*)xd, (LAS unsigned*)xbuf, 4, 0, 0); }
        int par = 0, bcur = -1; f32x2 gv = {0.f, 0.f};
        for (int tok = t0; tok < M; tok += tstep, par ^= 1) {
            const int dim = xs.sl * 128 + 16 * c + 2 * j;
            const size_t xo = (size_t)tok * D + dim;
            if ((tok >> 11) != bcur) { bcur = tok >> 11; const f32x2 gl = *(const f32x2*)(g2 + (size_t)bcur * NMODC + dim); asm volatile("s_waitcnt vmcnt(0)" ::: "memory"); gv[0] = gl[0] * 1.0f; gv[1] = gl[1] * 1.0f; asm volatile("" : "+v"(gv)); }
            E2_DMA_SEL(tok + 2 * tstep, par);
            __builtin_amdgcn_global_load_lds((const unsigned*)(X + xo), (LAS unsigned*)xbuf, 4, 0, 0);
            asm volatile("s_waitcnt vmcnt(20)" ::: "memory");
            u32x4 sn[4];
#pragma unroll
            for (int q = 0; q < 4; ++q) sn[q] = *(const LAS u32x4*)(selb + (par ^ 1) * 512 + (16 * j + 4 * q) * 4);
            f32x2 o2[8];
#pragma unroll
            for (int q = 0; q < 8; ++q) o2[q] = (f32x2){0.f, 0.f};
#pragma unroll
            for (int i0 = 0; i0 < 16; i0 += 4) {
                asm volatile("s_waitcnt vmcnt(16)" ::: "memory");
                u32x4 row[4];
#pragma unroll
                for (int r = 0; r < 4; ++r) row[r] = *(const LAS u32x4*)(ring + (i0 + r) * 1024 + 16 * lane);
                asm volatile("s_waitcnt lgkmcnt(0)" ::: "memory");
#pragma unroll
                for (int r = 0; r < 4; ++r) E2_DMA_ROW(i0 + r, sn[(i0 + r) >> 2][(i0 + r) & 3]);
                {
                    const u32x2 wA = {sc[i0 >> 2][0], sc[i0 >> 2][1]}, wB = {sc[i0 >> 2][2], sc[i0 >> 2][3]};
#pragma unroll
                    for (int r = 0; r < 4; ++r)
#pragma unroll
                        for (int q = 0; q < 4; ++q) { const f32x2 lo = __builtin_amdgcn_cvt_pk_f32_fp8((int)row[r][q], false), hi = __builtin_amdgcn_cvt_pk_f32_fp8((int)row[r][q], true);
                            if (r & 1) { asm("v_pk_fma_f32 %0, %1, %2, %0 op_sel:[1,0,0] op_sel_hi:[1,1,1]" : "+v"(o2[2 * q]) : "v"(r < 2 ? wA : wB), "v"(lo));
                                         asm("v_pk_fma_f32 %0, %1, %2, %0 op_sel:[1,0,0] op_sel_hi:[1,1,1]" : "+v"(o2[2 * q + 1]) : "v"(r < 2 ? wA : wB), "v"(hi)); }
                            else       { asm("v_pk_fma_f32 %0, %1, %2, %0 op_sel:[0,0,0] op_sel_hi:[0,1,1]" : "+v"(o2[2 * q]) : "v"(r < 2 ? wA : wB), "v"(lo));
                                         asm("v_pk_fma_f32 %0, %1, %2, %0 op_sel:[0,0,0] op_sel_hi:[0,1,1]" : "+v"(o2[2 * q + 1]) : "v"(r < 2 ? wA : wB), "v"(hi)); } }
                }
            }
            float o[16];
#pragma unroll
            for (int q = 0; q < 8; ++q) { o[2 * q] = o2[q][0]; o[2 * q + 1] = o2[q][1]; }
            float r8[8], r4[4], r2[2];
#pragma unroll
            for (int k = 0; k < 8; ++k) { const u32x2 sw = __builtin_amdgcn_permlane32_swap(__float_as_uint(o[k]), __float_as_uint(o[8 + k]), false, false); r8[k] = __uint_as_float(sw[0]) + __uint_as_float(sw[1]); }
#pragma unroll
            for (int k = 0; k < 4; ++k) { const u32x2 sw = __builtin_amdgcn_permlane16_swap(__float_as_uint(r8[k]), __float_as_uint(r8[4 + k]), false, false); r4[k] = __uint_as_float(sw[0]) + __uint_as_float(sw[1]); }
#pragma unroll
            for (int k = 0; k < 2; ++k) { const float keep = b3 ? r4[2 + k] : r4[k], send = b3 ? r4[k] : r4[2 + k];
                r2[k] = keep + __uint_as_float(__builtin_amdgcn_update_dpp(0, __float_as_uint(send), 0x128, 0xF, 0xF, true)); }
            asm volatile("s_waitcnt vmcnt(16)" ::: "memory");
            { const unsigned xw = __float_as_uint(xbuf[lane]); *(unsigned*)(XO + xo) = pk2(bflo(xw) + gv[0] * r2[0], bfhi(xw) + gv[1] * r2[1]); }
#pragma unroll
            for (int q = 0; q < 4; ++q) sc[q] = sn[q];
        }
        asm volatile("s_waitcnt vmcnt(0)" ::: "memory");
    }
#undef E2_CL
#undef E2_DMA_SEL
#undef E2_DMA_ROW
}

__device__ __forceinline__ void phase_final(const KP& p, int G) {
    const int tid = opaque_tid(), lane = tid & 63, w = __builtin_amdgcn_readfirstlane(tid >> 6);
    const int gw = blockIdx.x * 8 + w, ngw = G * 8;
    const float* fg = p.in[I_FG];
    for (int r0 = gw * 4; r0 < M; r0 += ngw * 4) {
        f32x4 v[4][4]; float ss[4];
#pragma unroll
        for (int i = 0; i < 4; ++i) { const u32x2* xr = (const u32x2*)((const bf16_t*)(p.ws + WS_YS) + (size_t)(r0 + i) * D) + lane;
#pragma unroll
            for (int j = 0; j < 4; ++j) { const u32x2 xw = xr[64 * j]; v[i][j] = (f32x4){bflo(xw[0]), bfhi(xw[0]), bflo(xw[1]), bfhi(xw[1])}; } }
#pragma unroll
        for (int i = 0; i < 4; ++i) { float t = 0.f;
#pragma unroll
            for (int j = 0; j < 4; ++j) t += (v[i][j][0] * v[i][j][0] + v[i][j][1] * v[i][j][1]) + (v[i][j][2] * v[i][j][2] + v[i][j][3] * v[i][j][3]);
            ss[i] = t; }
#pragma unroll
        for (int o = 1; o < 64; o <<= 1) {
#pragma unroll
            for (int i = 0; i < 4; ++i) ss[i] += __shfl_xor(ss[i], o); }
#pragma unroll
        for (int j = 0; j < 4; ++j) { const f32x4 g4 = *(const f32x4*)(fg + 256 * j + 4 * lane);
#pragma unroll
            for (int i = 0; i < 4; ++i) { const float rstd = __builtin_amdgcn_rsqf(ss[i] * (1.0f / D) + EPS); ((f32x4*)(p.out + (size_t)(r0 + i) * D) + lane)[64 * j] = v[i][j] * rstd * g4; } }
    }
}

__global__ void __launch_bounds__(512, 2) mk_fwd(KP p_) {
    extern __shared__ __attribute__((aligned(16))) unsigned char lds_raw[];
    LAS unsigned char* lds = (LAS unsigned char*)lds_raw;
    const int tid = threadIdx.x, G = gridDim.x;
    volatile LAS unsigned* MISC = (volatile LAS unsigned*)(lds + MISC_OFF);
    for (int i = tid; i < LDS_BYTES / 4; i += 512) ((LAS unsigned*)lds)[i] = 0u;
    __syncthreads();
    XcdBarrier bar = xcd_barrier_post((unsigned*)(p_.ws + WS_CTL) + 4096, MISC + 8);
    if (tid == 0) { const unsigned myx = xb_xcc_id(); MISC[16] = myx; MISC[17] = xb_add((unsigned*)(p_.ws + WS_CTL) + 8192 + 64 * (myx & 15u), 1u); }
    __syncthreads();
    const int lo = p_.gp_lo, hi = p_.gp_hi;
#ifndef PH_MASK
#define PH_MASK 0xFFFFF
#endif
#define IN(k) (lo <= (k) && (k) < hi)
#define EN(b) ((PH_MASK >> (b)) & 1)
#ifndef PH_REPEAT
#define PH_REPEAT 0
#endif
#define NREP(b) (((PH_REPEAT >> (b)) & 1) ? 2 : 1)
#define SEAM(k) do { if ((k) + 1 < hi) xcd_barrier(bar); } while (0)
    if (EN(12) && IN(GP_SETUP)) { const KP p = load_kp(); phase_setup(p, lds, G); SEAM(GP_SETUP); }
    for (int l = 0; l < DEPTH; ++l) {
        const int g0 = 1 + l * NPH;
        if (EN(0) && IN(g0 + 0)) { _Pragma("nounroll") for (int rep = 0; rep < NREP(0); ++rep) { const KP p = load_kp(); phase_conv_norm1(p, lds, l, G); } SEAM(g0 + 0); }
        if (EN(1) && IN(g0 + 1)) { const KP p = load_kp();
            pg8::Gemm g{(const bf16_t*)(p.ws + WS_H), (const bf16_t*)(p.ws + WS_WIN), M, 3072, D / 2, D / 2, D / 2}; pg8::StaticOrder S; S.init(M, 3072, G, (int)blockIdx.x);
            pg8::EpiStoreBf16 E{(bf16_t*)(p.ws + WS_R0), 3072, 1.0f / (WIN_SCALE * HIN_SCALE)};
            _Pragma("nounroll") for (int rep = 0; rep < NREP(1); ++rep) pg8::gemm_phase<pg8::EpiStoreBf16, pg8::StaticOrder, false, true, true>(lds, g, S, E);
            SEAM(g0 + 1);
        }
        if (EN(2) && IN(g0 + 2)) { _Pragma("nounroll") for (int rep = 0; rep < NREP(2); ++rep) { const KP p = load_kp(); phase_hgrn2(p, lds, l, G); } SEAM(g0 + 2); }
        if (EN(3) && IN(g0 + 3)) { const KP p = load_kp();
            pg8::Gemm g{(const bf16_t*)(p.ws + WS_H), (const bf16_t*)(p.ws + WS_WIN) + (size_t)3072 * (D / 2), M, 4096, D / 2, D / 2, D / 2}; pg8::StaticOrder S; S.init(M, 4096, G, (int)blockIdx.x);
            pg8::EpiStoreBf16 E{(bf16_t*)(p.ws + WS_R0), 4096, 1.0f / (WIN_SCALE * HIN_SCALE)};
            _Pragma("nounroll") for (int rep = 0; rep < NREP(3); ++rep) pg8::gemm_phase<pg8::EpiStoreBf16, pg8::StaticOrder, false, true, true>(lds, g, S, E);
            SEAM(g0 + 3);
        }
        #if DBG_SELFCHECK
        if (EN(4) && IN(g0 + 4)) {
#pragma nounroll
            for (int rep = 0; rep < 2; ++rep) { const KP p = load_kp(); size_t yo = rep ? WS_H : WS_YS; asm volatile("" : "+s"(yo)); phase_s5(p, lds, l, G, yo); SEAM(g0 + 4); }
            const KP p = load_kp();
            const unsigned* a = (const unsigned*)(p.ws + WS_YS); const unsigned* b2 = (const unsigned*)(p.ws + WS_H); unsigned bad = 0;
            for (size_t i = (size_t)blockIdx.x * 512 + opaque_tid(); i < (size_t)M * D / 2; i += (size_t)G * 512) bad += (a[i] != b2[i]) ? 1u : 0u;
            if (bad) atomicAdd((unsigned*)(p.ws + WS_CTL) + 64, bad);
            { const unsigned* h1 = (const unsigned*)(p.ws + WS_CTL) + 65536; const unsigned* h2 = h1 + 8192; const int u2 = blockIdx.x * 512 + opaque_tid();
              if (u2 < 2048) { if (h1[u2 * 4] != h2[u2 * 4]) atomicAdd((unsigned*)(p.ws + WS_CTL) + 128, 1u); if (h1[u2 * 4 + 1] != h2[u2 * 4 + 1]) atomicAdd((unsigned*)(p.ws + WS_CTL) + 192, 1u); if (h1[u2 * 4 + 2] != h2[u2 * 4 + 2]) atomicAdd((unsigned*)(p.ws + WS_CTL) + 256, 1u); } }
            SEAM(g0 + 4); }
#else
        if (EN(4) && IN(g0 + 4)) { _Pragma("nounroll") for (int rep = 0; rep < NREP(4); ++rep) { const KP p = load_kp(); phase_s5(p, lds, l, G, WS_YS); } SEAM(g0 + 4); }
#endif
        if (EN(5) && IN(g0 + 5)) { const KP p = load_kp();
            pg8::Gemm g{(const bf16_t*)(p.ws + WS_YS), (const bf16_t*)(p.ws + WS_WGLU), M, D, D, D, D}; pg8::StaticOrder S; S.init(M, D, G, (int)blockIdx.x);
            pg8::EpiGlu E{(const bf16_t*)(p.ws + WS_R0), (const bf16_t*)(p.ws + WS_YS), (const bf16_t*)(p.ws + WS_OR), (const float*)(p.ws + WS_SSQ), p.in[I_HNG] + l * 128, p.in[I_GLUB] + l * D, (bf16_t*)(p.ws + WS_H)};
            _Pragma("nounroll") for (int rep = 0; rep < NREP(5); ++rep) pg8::gemm_phase<pg8::EpiGlu, pg8::StaticOrder, true, true>(lds, g, S, E);
            SEAM(g0 + 5);
        }
        if (EN(6) && IN(g0 + 6)) { const KP p = load_kp();
            pg8::Gemm g{(const bf16_t*)(p.ws + WS_H), (const bf16_t*)(p.ws + WS_WOUT), M, D, D / 2, D / 2, D / 2}; pg8::StaticOrder S; S.init(M, D, G, (int)blockIdx.x);
            pg8::EpiStoreBf16 E{(bf16_t*)(p.ws + WS_OR), D, 1.0f / (WO_SCALE * MG_SCALE)};
            pg8::gemm_phase<pg8::EpiStoreBf16, pg8::StaticOrder, false, true, true>(lds, g, S, E);
            SEAM(g0 + 6);
        }
        if (EN(7) && IN(g0 + 7)) { const KP p = load_kp();
            const int t2 = opaque_tid(), lane = t2 & 63, wave = __builtin_amdgcn_readfirstlane(t2 >> 6);
            if (l == 0) resid_norm_rows<false>(p.in[I_X], (bf16_t*)p.out, (const bf16_t*)(p.ws + WS_OR), (bf16_t*)(p.ws + WS_H), p.in[I_N2G] + l * D, (const float*)(p.ws + WS_MOD) + (size_t)l * 32 * NMODC, blockIdx.x * 8 + wave, G * 8, lane);
            else resid_norm_rows<true>(p.out, (bf16_t*)p.out, (const bf16_t*)(p.ws + WS_OR), (bf16_t*)(p.ws + WS_H), p.in[I_N2G] + l * D, (const float*)(p.ws + WS_MOD) + (size_t)l * 32 * NMODC, blockIdx.x * 8 + wave, G * 8, lane);
            SEAM(g0 + 7);
        }
        if (EN(8) && IN(g0 + 8)) { const KP p = load_kp();
            pg8::Gemm g{(const bf16_t*)(p.ws + WS_H), (const bf16_t*)(p.ws + WS_WQ), M, 2048, D, D, D}; pg8::StaticOrder S; S.init(M, 2048, G, (int)blockIdx.x);
            pg8::EpiStoreQ E{(bf16_t*)(p.ws + WS_R0)};
            _Pragma("nounroll") for (int rep = 0; rep < NREP(8); ++rep) pg8::gemm_phase<pg8::EpiStoreQ, pg8::StaticOrder, true, true>(lds, g, S, E);
            SEAM(g0 + 8);
        }
        if (EN(9) && IN(g0 + 9)) { _Pragma("nounroll") for (int rep = 0; rep < NREP(9); ++rep) { const KP p = load_kp(); phase_topk(p, lds, G); } SEAM(g0 + 9); }
        if (EN(10) && IN(g0 + 10)) {
            { const KP p = load_kp(); phase_expert_u(p, lds, MISC, l, G); } xcd_barrier(bar);
            { const KP p = load_kp(); phase_expert_w(p, G); } xcd_barrier(bar);
            { const KP p = load_kp(); phase_expert_v(p, lds, MISC, l, G); }
            SEAM(g0 + 10); }
    }
    if (EN(13) && IN(GP_FINAL)) { const KP p = load_kp(); phase_final(p, G); }
#undef IN
#undef EN
#undef NREP
#undef SEAM
}

extern "C" void kernel_launch(void* const* d_in, const int* in_sizes, int n_in, void* d_out, int out_size, void* d_ws, size_t ws_size, hipStream_t stream) {
    static int grid = 0;
    if (grid == 0) {
        if (n_in != 25 || out_size != M * D || ws_size < WS_END) { fprintf(stderr, "kernel_launch: unexpected shapes (n_in %d, out %d, ws %zu < %zu)\n", n_in, out_size, ws_size, (size_t)WS_END); grid = -1; return; }
        int dev = 0, cus = 0, per_cu = 0;
        if (hipGetDevice(&dev) != hipSuccess || hipDeviceGetAttribute(&cus, hipDeviceAttributeMultiprocessorCount, dev) != hipSuccess) { grid = -1; return; }
        if (hipFuncSetAttribute((const void*)mk_fwd, hipFuncAttributeMaxDynamicSharedMemorySize, LDS_BYTES) != hipSuccess) { fprintf(stderr, "kernel_launch: hipFuncSetAttribute failed\n"); grid = -1; return; }
        if (hipOccupancyMaxActiveBlocksPerMultiprocessor(&per_cu, (const void*)mk_fwd, 512, LDS_BYTES) != hipSuccess || per_cu < 1) fprintf(stderr, "kernel_launch: occupancy query says %d\n", per_cu);
        (void)hipGetLastError();
        grid = cus;
    }
    if (grid < 0) return;
    (void)hipMemsetAsync((char*)d_ws + WS_CTL, 0, CTL_ZERO_BYTES, stream);
    KP a{};
    for (int i = 0; i < 25; ++i) a.in[i] = (const float*)d_in[i];
    a.out = (float*)d_out; a.ws = (unsigned char*)d_ws;
#if MK_LAUNCHES == 1
    a.gp_lo = 0; a.gp_hi = GP_END;
    hipLaunchKernelGGL(mk_fwd, dim3(grid), dim3(512), LDS_BYTES, stream, a);
#else
    for (int gp = 0; gp < GP_END; ++gp) { a.gp_lo = gp; a.gp_hi = gp + 1; hipLaunchKernelGGL(mk_fwd, dim3(grid), dim3(512), LDS_BYTES, stream, a); }
#endif
}
```

```cpp
#include <hip/hip_runtime.h>
#include <cstdio>
#include <cstdint>

#define DBG_HASHSEL 0
#define DBG_H2_FROM_INPUT 0
#define DBG_NO_YA 0
#define DBG_NO_YB 0
#define DBG_NO_ACC 0
#define DBG_NO_GB 0
#define DBG_S5_NOSSM 0
#define DBG_S5_NOREC 0
#define DBG_SELFCHECK 0
#ifndef MK_LAUNCHES
#define MK_LAUNCHES 1
#endif

#define LAS __attribute__((address_space(3)))
typedef unsigned short bf16_t;
typedef short bf16x8 __attribute__((ext_vector_type(8)));
typedef float f32x2 __attribute__((ext_vector_type(2)));
typedef float f32x4 __attribute__((ext_vector_type(4)));
typedef float f32x16 __attribute__((ext_vector_type(16)));
typedef unsigned u32x2 __attribute__((ext_vector_type(2)));
typedef unsigned u32x4 __attribute__((ext_vector_type(4)));
typedef __bf16 bf16v2 __attribute__((ext_vector_type(2)));
typedef int i32x8 __attribute__((ext_vector_type(8)));
typedef int i32x4 __attribute__((ext_vector_type(4)));

constexpr int D = 1024, BATCH = 32, SEQ = 2048, DEPTH = 4, M = BATCH * SEQ;
constexpr int INC = 7168, NMODC = 6 * D;
constexpr int NPH = 11, GP_SETUP = 0, GP_FINAL = 1 + DEPTH * NPH, GP_END = GP_FINAL + 1;
constexpr float EPS = 1e-6f;
constexpr float U_SCALE = 64.0f, V_SCALE = 4.0f;
constexpr size_t TAB_BYTES = (size_t)16384 * 1024;
constexpr float WIN_SCALE = 64.0f, HIN_SCALE = 4.0f;
constexpr float X_SCALE = 8.0f;
constexpr float WO_SCALE = 64.0f, MG_SCALE = 8.0f;

constexpr size_t MiB = 1u << 20;
constexpr size_t WS_CTL = 0, CTL_ZERO_BYTES = 1 * MiB;
constexpr size_t WS_MOD = 1 * MiB;
constexpr size_t WS_LB = 4 * MiB;
constexpr size_t WS_ABAR = 4 * MiB + 65536;
constexpr size_t WS_BOP = 5 * MiB;
constexpr size_t WS_COP = 6 * MiB;
constexpr size_t WS_WIN = 8 * MiB;
constexpr size_t WS_WGLU = 22 * MiB;
constexpr size_t WS_WOUT = 24 * MiB;
constexpr size_t WS_WQ = 26 * MiB;
constexpr size_t WS_KEYS = 30 * MiB;
constexpr size_t WS_U = 32 * MiB;
constexpr size_t WS_V = 64 * MiB;
constexpr size_t WS_H = 96 * MiB;
constexpr size_t WS_OR = 224 * MiB;
constexpr size_t WS_SSQ = 352 * MiB;
constexpr size_t WS_R0 = 354 * MiB;
constexpr size_t WS_SEL = WS_R0 + 256 * MiB;
constexpr size_t WS_XF8 = WS_R0 + 352 * MiB;
constexpr size_t WS_YS = WS_R0 + 512 * MiB;
constexpr size_t WS_END = WS_YS + 128 * MiB;

constexpr int LDS_BYTES = 147456;
constexpr int MISC_OFF = LDS_BYTES - 256;

__device__ __forceinline__ unsigned pk2(float lo, float hi) { f32x2 v = {lo, hi}; bf16v2 r = __builtin_convertvector(v, bf16v2); return __builtin_bit_cast(unsigned, r); }
__device__ __forceinline__ float bflo(unsigned w) { return __uint_as_float(w << 16); }
__device__ __forceinline__ float bfhi(unsigned w) { return __uint_as_float(w & 0xffff0000u); }
__device__ __forceinline__ float fsigmoid(float x) { return __builtin_amdgcn_rcpf(1.0f + __expf(-x)); }
__device__ __forceinline__ float fsilu(float x) { return x * fsigmoid(x); }
__device__ __forceinline__ float fgelu(float x) { return x * fsigmoid(1.5957691216f * (x + 0.044715f * x * x * x)); }
__device__ __forceinline__ float wave_sum(float v) {
#pragma unroll
    for (int o = 1; o < 64; o <<= 1) v += __shfl_xor(v, o);
    return v;
}
#define LDS_WAIT() asm volatile("s_waitcnt lgkmcnt(0)" ::: "memory")
__device__ __forceinline__ float dpp_sum8(float d);
__device__ __forceinline__ int opaque_tid() { int t = threadIdx.x; asm volatile("" : "+v"(t)); return t; }

namespace pg8 {
#define PG8_LAS __attribute__((address_space(3)))
constexpr int BM = 256, BK = 64, HALF = 128, HTB = HALF * BK * 2, STAGE_BYTES = 8 * HTB, NXCD = 8, WGM = 8;
__host__ __device__ __forceinline__ int lds_byte(int r, int c) { const int st = (r >> 4) * 2 + (c >> 5), rr = r & 15, cc = c & 31, ob = rr * 64 + cc * 2; return st * 1024 + (ob ^ (((ob >> 9) & 1) << 5)); }
__host__ __device__ __forceinline__ void stage_rc(int b, int& R, int& C) { const int st = b / 1024, sb = b % 1024, swz = sb ^ (((sb >> 9) & 1) << 5); R = (st >> 1) * 16 + swz / 64; C = (st & 1) * 32 + (swz % 64) / 2; }
__host__ __device__ __forceinline__ int perm32(int rho) { const int n = rho >> 4, i = rho & 15; return 8 * (i >> 2) + 4 * n + (i & 3); }
struct Unit { int pm, pn; };
struct Gemm { const bf16_t* A; const bf16_t* Bt; int M, N, K, lda, ldb; };
struct StaticOrder {
    int nM, nN, nwg, G, c;
    __host__ __device__ void init(int M_, int N_, int G_, int c_) { nM = M_ / BM; nN = N_ / BM; nwg = nM * nN; G = G_; c = c_; }
    __host__ __device__ bool next(int i, Unit& u) const {
        const long L = (long)i * G + c; if (L >= nwg) return false;
        int wgid = (int)L; { const int q = nwg / NXCD, r = nwg % NXCD, xcd = wgid % NXCD, off = wgid / NXCD; wgid = (xcd < r ? xcd * (q + 1) : r * (q + 1) + (xcd - r) * q) + off; }
        const int nig = WGM * nN, gid = wgid / nig, fm = gid * WGM, gsz = (nM - fm) < WGM ? (nM - fm) : WGM;
        u.pm = fm + ((wgid % nig) % gsz); u.pn = (wgid % nig) / gsz; return true;
    }
    __device__ __forceinline__ void a_ready(const Unit&) const {}
    __device__ __forceinline__ void done(const Unit&) const {}
};
template <class Epi, class Sched, bool ALIGN_EPI = false, bool SP2 = false, bool F8 = false>
__device__ __forceinline__ void gemm_phase(PG8_LAS unsigned char* lds, const Gemm g, const Sched& S, const Epi& E) {
    const int tid = opaque_tid(), wid = __builtin_amdgcn_readfirstlane(tid >> 6), lane = tid & 63, wr = wid >> 2, wc = wid & 3, fr = lane & 15, fq = lane >> 4;
    const int K = g.K, nt = K / BK;
    unsigned voffA[2], voffB[2];
#pragma unroll
    for (int i = 0; i < 2; ++i) { int R, C; stage_rc(tid * 16 + i * 8192, R, C); const int Rb = Epi::PERM ? ((R & ~31) + perm32(R & 31)) : R;
        voffA[i] = (unsigned)(R * g.lda + C) * 2u; voffB[i] = (unsigned)(Rb * g.ldb + C) * 2u; }
    const size_t kstep = (size_t)(BK * 2);
    const size_t hstepA = (size_t)HALF * g.lda * 2, hstepB = (size_t)HALF * g.ldb * 2;
    const size_t tstepA = 2 * hstepA, tstepB = 2 * hstepB;
    const unsigned ldsw = (unsigned)wid * 1024u;
    const int aoff = lds_byte(wr * 64 + fr, fq * 8), boff = lds_byte(wc * 32 + fr, fq * 8);
#define PG8_SA(b, h) (((b) * 2 + (h)) * HTB)
#define PG8_SB(b, h) ((4 + (b) * 2 + (h)) * HTB)
#define PG8_STAGE(bufoff, gbase, voff) do { _Pragma("unroll") for (int _i = 0; _i < 2; ++_i) \
        __builtin_amdgcn_global_load_lds((const unsigned*)((const char*)(gbase) + (voff)[_i]), (PG8_LAS unsigned*)(lds + (bufoff) + ldsw + _i * 8192), 16, 0, 0); } while (0)
#define PG8_LD8(p) __builtin_shufflevector(*(const PG8_LAS i32x4*)(p), *(const PG8_LAS i32x4*)((p) + 1024), 0, 1, 2, 3, 4, 5, 6, 7)
#define PG8_LDA(dst, b, h) do { if constexpr (F8) { _Pragma("unroll") for (int m = 0; m < 4; ++m) dst##8[m] = PG8_LD8(lds + PG8_SA(b, h) + aoff + m * 2048); } \
        else { _Pragma("unroll") for (int m = 0; m < 4; ++m) _Pragma("unroll") for (int k = 0; k < 2; ++k) dst[m][k] = *(const PG8_LAS bf16x8*)(lds + PG8_SA(b, h) + aoff + m * 2048 + k * 1024); } } while (0)
#define PG8_LDB(dst, b, h) do { if constexpr (F8) { _Pragma("unroll") for (int n = 0; n < 2; ++n) dst##8[n] = PG8_LD8(lds + PG8_SB(b, h) + boff + n * 2048); } \
        else { _Pragma("unroll") for (int n = 0; n < 2; ++n) _Pragma("unroll") for (int k = 0; k < 2; ++k) dst[n][k] = *(const PG8_LAS bf16x8*)(lds + PG8_SB(b, h) + boff + n * 2048 + k * 1024); } } while (0)
#define PG8_MMA(ai, bj, At, Bt) do { __builtin_amdgcn_s_setprio(1); _Pragma("unroll") for (int m = 0; m < 4; ++m) _Pragma("unroll") for (int n = 0; n < 2; ++n) { \
        if constexpr (F8) {   \
            acc[ai][bj][m][n] = __builtin_amdgcn_mfma_scale_f32_16x16x128_f8f6f4(Bt##8[n], At##8[m], acc[ai][bj][m][n], 0, 0, 0, 0x7f7f7f7f, 0, 0x7f7f7f7f); \
        } else { _Pragma("unroll") for (int k = 0; k < 2; ++k) acc[ai][bj][m][n] = __builtin_amdgcn_mfma_f32_16x16x32_bf16(Bt[n][k], At[m][k], acc[ai][bj][m][n], 0, 0, 0); } } \
        __builtin_amdgcn_s_setprio(0); } while (0)
#define PG8_WAIT_V(n) asm volatile("s_waitcnt vmcnt(" #n ")" ::: "memory")
#define PG8_WAIT_L(n) asm volatile("s_waitcnt lgkmcnt(" #n ")" ::: "memory")
#define PG8_BAR __builtin_amdgcn_s_barrier()
#define PG8_SCHED __builtin_amdgcn_sched_barrier(0)
    Unit cur, nxt; int ui = 0;
    if (!S.next(0, cur)) return;
    f32x4 acc[2][2][4][2];
#pragma unroll
    for (int a = 0; a < 2; ++a)
#pragma unroll
        for (int b = 0; b < 2; ++b)
#pragma unroll
            for (int m = 0; m < 4; ++m)
#pragma unroll
                for (int n = 0; n < 2; ++n) acc[a][b][m][n] = (f32x4){0.f, 0.f, 0.f, 0.f};
    bf16x8 At[4][2], B0[2][2], B1[2][2]; i32x8 At8[4], B08[2], B18[2];
    const char* cA = (const char*)g.A + (size_t)cur.pm * tstepA; const char* cB = (const char*)g.Bt + (size_t)cur.pn * tstepB;
    S.a_ready(cur);
    if constexpr (SP2) {
        PG8_STAGE(PG8_SB(0, 0), cB, voffB); PG8_STAGE(PG8_SB(0, 1), cB + hstepB, voffB); PG8_STAGE(PG8_SA(0, 0), cA, voffA); PG8_STAGE(PG8_SA(0, 1), cA + hstepA, voffA);
        if (wr == 1) PG8_BAR;
        PG8_WAIT_V(2); PG8_BAR;
        PG8_STAGE(PG8_SB(1, 0), cB + kstep, voffB); PG8_STAGE(PG8_SA(1, 0), cA + kstep, voffA); PG8_STAGE(PG8_SB(1, 1), cB + hstepB + kstep, voffB);
        PG8_WAIT_V(6); PG8_BAR;
    } else {
        PG8_STAGE(PG8_SB(0, 0), cB, voffB); PG8_STAGE(PG8_SA(0, 0), cA, voffA); PG8_STAGE(PG8_SB(0, 1), cB + hstepB, voffB); PG8_STAGE(PG8_SA(0, 1), cA + hstepA, voffA);
        if (wr == 1) PG8_BAR;
        PG8_WAIT_V(4); PG8_BAR;
        PG8_STAGE(PG8_SB(1, 0), cB + kstep, voffB); PG8_STAGE(PG8_SA(1, 0), cA + kstep, voffA); PG8_STAGE(PG8_SB(1, 1), cB + hstepB + kstep, voffB);
        PG8_WAIT_V(6); PG8_BAR;
    }
    for (;;) {
        const bool has_next = S.next(ui + 1, nxt);
        const char* nA = has_next ? (const char*)g.A + (size_t)nxt.pm * tstepA : cA; const char* nB = has_next ? (const char*)g.Bt + (size_t)nxt.pn * tstepB : cB;
        for (int t = 0; t < nt; t += 2) {
            const bool last = (t == nt - 2);
            const char* a1 = cA + (size_t)(t + 1) * kstep;
            const char* a2 = last ? nA : cA + (size_t)(t + 2) * kstep; const char* b2 = last ? nB : cB + (size_t)(t + 2) * kstep;
            const char* a3 = a2 + kstep; const char* b3 = b2 + kstep;
            if (last && has_next) S.a_ready(nxt);
            if constexpr (SP2) {
            PG8_LDB(B0, 0, 0); PG8_LDB(B1, 0, 1); PG8_SCHED; PG8_LDA(At, 0, 0); PG8_STAGE(PG8_SA(1, 1), a1 + hstepA, voffA);
            PG8_WAIT_V(8); PG8_WAIT_L(0); PG8_BAR; PG8_MMA(0, 0, At, B0); PG8_MMA(0, 1, At, B1); PG8_BAR; PG8_SCHED;
            PG8_LDA(At, 0, 1); PG8_STAGE(PG8_SB(0, 0), b2, voffB); PG8_STAGE(PG8_SB(0, 1), b2 + hstepB, voffB); PG8_STAGE(PG8_SA(0, 0), a2, voffA);
            PG8_WAIT_V(8); PG8_WAIT_L(0); PG8_BAR; PG8_MMA(1, 0, At, B0); PG8_MMA(1, 1, At, B1); PG8_BAR; PG8_SCHED;
            PG8_LDB(B0, 1, 0); PG8_LDB(B1, 1, 1); PG8_SCHED; PG8_LDA(At, 1, 0); PG8_STAGE(PG8_SA(0, 1), a2 + hstepA, voffA);
            PG8_WAIT_V(8); PG8_WAIT_L(0); PG8_BAR; PG8_MMA(0, 0, At, B0); PG8_MMA(0, 1, At, B1); PG8_BAR; PG8_SCHED;
            PG8_LDA(At, 1, 1); PG8_STAGE(PG8_SB(1, 0), b3, voffB); PG8_STAGE(PG8_SB(1, 1), b3 + hstepB, voffB); PG8_STAGE(PG8_SA(1, 0), a3, voffA);
            PG8_WAIT_V(8); PG8_WAIT_L(0); PG8_BAR; PG8_MMA(1, 0, At, B0); PG8_MMA(1, 1, At, B1); PG8_BAR; PG8_SCHED;
            } else {
            PG8_LDB(B0, 0, 0); PG8_SCHED; PG8_LDA(At, 0, 0); PG8_STAGE(PG8_SA(1, 1), a1 + hstepA, voffA);
            PG8_WAIT_L(8); PG8_BAR; PG8_WAIT_L(0); PG8_MMA(0, 0, At, B0); PG8_BAR; PG8_SCHED;
            PG8_LDB(B1, 0, 1); PG8_STAGE(PG8_SB(0, 0), b2, voffB);
            PG8_BAR; PG8_WAIT_L(0); PG8_MMA(0, 1, At, B1); PG8_BAR;
            PG8_LDA(At, 0, 1); PG8_STAGE(PG8_SA(0, 0), a2, voffA);
            PG8_BAR; PG8_WAIT_L(0); PG8_MMA(1, 0, At, B0); PG8_BAR; PG8_SCHED;
            PG8_STAGE(PG8_SB(0, 1), b2 + hstepB, voffB);
            PG8_WAIT_V(6); PG8_BAR; PG8_MMA(1, 1, At, B1); PG8_BAR;
            PG8_LDB(B0, 1, 0); PG8_SCHED; PG8_LDA(At, 1, 0); PG8_STAGE(PG8_SA(0, 1), a2 + hstepA, voffA);
            PG8_WAIT_L(8); PG8_BAR; PG8_WAIT_L(0); PG8_MMA(0, 0, At, B0); PG8_BAR; PG8_SCHED;
            PG8_LDB(B1, 1, 1); PG8_STAGE(PG8_SB(1, 0), b3, voffB);
            PG8_BAR; PG8_WAIT_L(0); PG8_MMA(0, 1, At, B1); PG8_BAR;
            PG8_LDA(At, 1, 1); PG8_STAGE(PG8_SA(1, 0), a3, voffA);
            PG8_BAR; PG8_WAIT_L(0); PG8_MMA(1, 0, At, B0); PG8_BAR; PG8_SCHED;
            PG8_STAGE(PG8_SB(1, 1), b3 + hstepB, voffB);
            PG8_WAIT_V(6); PG8_BAR; PG8_MMA(1, 1, At, B1); PG8_BAR;
            }
        }
        if constexpr (ALIGN_EPI) { if (wr == 0) PG8_BAR; }
        E(acc, cur, wr, wc, fr, fq);
        if (!has_next) break;
#pragma unroll
        for (int a = 0; a < 2; ++a)
#pragma unroll
            for (int b = 0; b < 2; ++b)
#pragma unroll
                for (int m = 0; m < 4; ++m)
#pragma unroll
                    for (int n = 0; n < 2; ++n) acc[a][b][m][n] = (f32x4){0.f, 0.f, 0.f, 0.f};
        cur = nxt; cA = nA; cB = nB; ++ui;
        if constexpr (ALIGN_EPI) { if (wr == 1) PG8_BAR; }
    }
    PG8_WAIT_V(0);
    if constexpr (!ALIGN_EPI) { if (wr == 0) PG8_BAR; }
    PG8_BAR;
#undef PG8_SA
#undef PG8_SB
#undef PG8_STAGE
#undef PG8_LDA
#undef PG8_LD8
#undef PG8_LDB
#undef PG8_MMA
#undef PG8_WAIT_V
#undef PG8_WAIT_L
#undef PG8_BAR
#undef PG8_SCHED
}

struct EpiStoreBf16 {
    static constexpr bool PERM = true;
    bf16_t* O; int ldc; float scale;
    __device__ __forceinline__ void operator()(const f32x4 (&acc)[2][2][4][2], const Unit& u, int wr, int wc, int fr, int fq) const {
        const int row0 = u.pm * BM + wr * 64 + fr, col0 = u.pn * BM + wc * 32 + 8 * fq;
#pragma unroll
        for (int ai = 0; ai < 2; ++ai)
#pragma unroll
            for (int m = 0; m < 4; ++m) { bf16_t* rowp = O + (size_t)(row0 + ai * HALF + m * 16) * ldc + col0;
#pragma unroll
                for (int bj = 0; bj < 2; ++bj) { const f32x4 v0 = acc[ai][bj][m][0] * scale, v1 = acc[ai][bj][m][1] * scale;
                    u32x4 w; w.x = pk2(v0[0], v0[1]); w.y = pk2(v0[2], v0[3]); w.z = pk2(v1[0], v1[1]); w.w = pk2(v1[2], v1[3]);
                    *(u32x4*)(rowp + bj * HALF) = w; } }
    }
};
struct EpiStoreQ {
    static constexpr bool PERM = true;
    bf16_t* O;
    __device__ __forceinline__ void operator()(const f32x4 (&acc)[2][2][4][2], const Unit& u, int wr, int wc, int fr, int fq) const {
        const int row0 = u.pm * BM + wr * 64 + fr, col0 = u.pn * BM + wc * 32 + 8 * fq;
#pragma unroll
        for (int ai = 0; ai < 2; ++ai)
#pragma unroll
            for (int m = 0; m < 4; ++m) { const int row = row0 + ai * HALF + m * 16, tg = row >> 5, t = row & 31;
#pragma unroll
                for (int bj = 0; bj < 2; ++bj) { const int c0 = col0 + bj * HALF, h = c0 >> 8, pp = (c0 >> 7) & 1, cc = c0 & 127, ks = cc >> 4, hh = (cc >> 3) & 1;
                    const f32x4 v0 = acc[ai][bj][m][0], v1 = acc[ai][bj][m][1];
                    u32x4 w; w.x = pk2(v0[0], v0[1]); w.y = pk2(v0[2], v0[3]); w.z = pk2(v1[0], v1[1]); w.w = pk2(v1[2], v1[3]);
                    *(u32x4*)(O + ((size_t)((((tg * 8 + h) * 2 + pp) * 8 + ks) * 64 + hh * 32 + t)) * 8) = w; } }
    }
};
struct EpiWout {
    static constexpr bool PERM = false;
    const float* xs; float* out; const float* g1;
    __device__ __forceinline__ void operator()(const f32x4 (&acc)[2][2][4][2], const Unit& u, int wr, int wc, int fr, int fq) const {
        const int row0 = u.pm * BM + wr * 64 + fr, col0 = u.pn * BM + wc * 32 + 4 * fq;
        const int b = (u.pm * BM) >> 11;
        f32x4 gv[2][2];
#pragma unroll
        for (int bj = 0; bj < 2; ++bj)
#pragma unroll
            for (int n = 0; n < 2; ++n) gv[bj][n] = *(const f32x4*)(g1 + (size_t)b * NMODC + col0 + bj * HALF + n * 16);
#pragma unroll
        for (int ai = 0; ai < 2; ++ai)
#pragma unroll
            for (int m = 0; m < 4; ++m) { const size_t off = (size_t)(row0 + ai * HALF + m * 16) * D + col0;
#pragma unroll
                for (int bj = 0; bj < 2; ++bj)
#pragma unroll
                    for (int n = 0; n < 2; ++n) { const f32x4 xv = *(const f32x4*)(xs + off + bj * HALF + n * 16);
                        *(f32x4*)(out + off + bj * HALF + n * 16) = xv + gv[bj][n] * acc[ai][bj][m][n]; } }
    }
};
struct EpiGlu {
    static constexpr bool PERM = true;
    const bf16_t* PB; const bf16_t* YS; const bf16_t* ORAW; const float* SSQ; const float* ng; const float* gb_; bf16_t* O;
    __device__ __forceinline__ void operator()(const f32x4 (&acc)[2][2][4][2], const Unit& u, int wr, int wc, int fr, int fq) const {
        const int row0 = u.pm * BM + wr * 64 + fr, col0 = u.pn * BM + wc * 32 + 8 * fq;
#pragma unroll
        for (int bj = 0; bj < 2; ++bj) {
            const int c = col0 + bj * HALF, head = c >> 7;
            const f32x4 n0 = *(const f32x4*)(ng + (c & 127)), n1 = *(const f32x4*)(ng + (c & 127) + 4);
            const f32x4 b0 = *(const f32x4*)(gb_ + c), b1 = *(const f32x4*)(gb_ + c + 4);
            const float ngv[8] = {n0[0], n0[1], n0[2], n0[3], n1[0], n1[1], n1[2], n1[3]};
            const float bbv[8] = {b0[0], b0[1], b0[2], b0[3], b1[0], b1[1], b1[2], b1[3]};
#pragma unroll
            for (int ai = 0; ai < 2; ++ai)
#pragma unroll
                for (int m = 0; m < 4; ++m) {
                    const int row = row0 + ai * HALF + m * 16;
                    const bf16_t* pb = PB + (size_t)row * 4096 + c;
                    const u32x4 og = *(const u32x4*)(pb), ys = *(const u32x4*)(YS + (size_t)row * D + c), ga = *(const u32x4*)(pb + 2048), gb = *(const u32x4*)(pb + 3072);
                    const u32x4 orw = *(const u32x4*)(ORAW + (size_t)row * D + c);
                    const float rstd = __builtin_amdgcn_rsqf(SSQ[(size_t)row * 8 + head] * (1.0f / 128.0f) + EPS);
                    const f32x4 a0 = acc[ai][bj][m][0], a1 = acc[ai][bj][m][1];
                    const float av[8] = {a0[0], a0[1], a0[2], a0[3], a1[0], a1[1], a1[2], a1[3]};
                    float res[8];
#pragma unroll
                    for (int j = 0; j < 8; ++j) {
                        const unsigned wog = og[j >> 1], wys = ys[j >> 1], wga = ga[j >> 1], wgb = gb[j >> 1], wor = orw[j >> 1];
                        const float fog = (j & 1) ? bfhi(wog) : bflo(wog), fys = (j & 1) ? bfhi(wys) : bflo(wys), fga = (j & 1) ? bfhi(wga) : bflo(wga),
                                    fgb = (j & 1) ? bfhi(wgb) : bflo(wgb), fo = (j & 1) ? bfhi(wor) : bflo(wor);
                        const float ya = fo * rstd * ngv[j] * fsilu(fog);
                        const float yb = fys * fsigmoid((DBG_NO_ACC ? 0.f : av[j]) + bbv[j]);
                        res[j] = (DBG_NO_YA ? 0.f : fsigmoid(fga) * ya) + (DBG_NO_YB ? 0.f : (DBG_NO_GB ? 0.5f : fsigmoid(fgb)) * yb);
                    }
                    int w0 = 0, w1 = 0;
                    w0 = __builtin_amdgcn_cvt_pk_fp8_f32(res[0] * MG_SCALE, res[1] * MG_SCALE, w0, false); w0 = __builtin_amdgcn_cvt_pk_fp8_f32(res[2] * MG_SCALE, res[3] * MG_SCALE, w0, true);
                    w1 = __builtin_amdgcn_cvt_pk_fp8_f32(res[4] * MG_SCALE, res[5] * MG_SCALE, w1, false); w1 = __builtin_amdgcn_cvt_pk_fp8_f32(res[6] * MG_SCALE, res[7] * MG_SCALE, w1, true);
                    *(u32x2*)((unsigned char*)O + (size_t)row * D + c) = (u32x2){(unsigned)w0, (unsigned)w1};
                }
        }
    }
};
}

#define XB_TMO      128
#define XB_XCNT(j)  (256  + 64 * (j))
#define XB_XSUB(j)  (1280 + 64 * (j))
#define XB_XGEN(j)  (2304 + 64 * (j))
#define XB_TOP      3328
#define XB_TOPGEN   3392
#define XCD_BAR_WORDS 3456
#define XB_SPIN_CAP (1u << 25)
__device__ __forceinline__ unsigned xb_ld(unsigned* p)              { return __hip_atomic_load(p, __ATOMIC_RELAXED, __HIP_MEMORY_SCOPE_AGENT); }
__device__ __forceinline__ unsigned xb_add(unsigned* p, unsigned v) { return __hip_atomic_fetch_add(p, v, __ATOMIC_RELAXED, __HIP_MEMORY_SCOPE_AGENT); }
__device__ __forceinline__ unsigned xb_xcc_id() { return (unsigned)__builtin_amdgcn_s_getreg((3 << 11) | 20) & 0xFu; }
#define XB_SPIN(cond, bar) do { unsigned _sp = 0; while (cond) { __builtin_amdgcn_s_sleep(1); \
    if ((++_sp & 255u) == 0u) { if (xb_ld(&(bar)[XB_TMO])) break; if (_sp > XB_SPIN_CAP) { atomicAdd(&(bar)[XB_TMO], 1u); break; } } } } while (0)
struct XcdBarrier { unsigned* bar; unsigned x; volatile LAS unsigned* st; };
__device__ __forceinline__ XcdBarrier xcd_barrier_post(unsigned* bar, volatile LAS unsigned* st) {
    XcdBarrier b; b.bar = bar; b.x = xb_xcc_id(); b.st = st;
    if (threadIdx.x == 0) (void)xb_add(&bar[XB_XCNT(b.x)], 1u);
    return b;
}
__device__ __forceinline__ void xcd_barrier_complete(unsigned* bar, unsigned x, unsigned& nloc, unsigned& nx) {
    const unsigned G = gridDim.x * gridDim.y * gridDim.z;
    unsigned sum, cnt, mine, sp = 0u;
    for (;;) {
        sum = 0u; cnt = 0u; mine = 0u;
#pragma unroll
        for (unsigned j = 0; j < 16; ++j) { const unsigned c = xb_ld(&bar[XB_XCNT(j)]); sum += c; cnt += (c > 0u) ? 1u : 0u; mine = (j == x) ? c : mine; }
        if (sum == G) break;
        __builtin_amdgcn_s_sleep(1);
        if ((++sp & 255u) == 0u) { if (xb_ld(&bar[XB_TMO])) break; if (sp > XB_SPIN_CAP) { atomicAdd(&bar[XB_TMO], 1u); break; } }
    }
    nloc = mine > 0u ? mine : 1u; nx = cnt > 0u ? cnt : 1u;
}
__device__ __forceinline__ void xcd_barrier(const XcdBarrier& b) {
    asm volatile("s_waitcnt vmcnt(0)" ::: "memory");
    __syncthreads();
    if (threadIdx.x == 0) {
        unsigned* bar = b.bar;
        __builtin_amdgcn_s_waitcnt(0);
        unsigned nloc = b.st[0], nx = b.st[1];
        if (nloc == 0u) { xcd_barrier_complete(bar, b.x, nloc, nx); b.st[0] = nloc; b.st[1] = nx; }
        const unsigned old = xb_add(&bar[XB_XSUB(b.x)], 1u);
        const unsigned gen = old / nloc;
        if (old + 1u == (gen + 1u) * nloc) {
            __builtin_amdgcn_fence(__ATOMIC_RELEASE, "agent");
            asm volatile("s_waitcnt vmcnt(0)" ::: "memory");
            const unsigned og = xb_add(&bar[XB_TOP], 1u);
            const unsigned tg = og / nx;
            if (og + 1u == (tg + 1u) * nx) xb_add(&bar[XB_TOPGEN], 1u);
            else XB_SPIN(xb_ld(&bar[XB_TOPGEN]) == tg, bar);
            __builtin_amdgcn_fence(__ATOMIC_ACQUIRE, "agent");
            xb_add(&bar[XB_XGEN(b.x)], 1u);
            asm volatile("s_waitcnt vmcnt(0)" ::: "memory");
        } else {
            XB_SPIN(xb_ld(&bar[XB_XGEN(b.x)]) == gen, bar);
            __builtin_amdgcn_fence(__ATOMIC_ACQUIRE, "agent");
            asm volatile("s_waitcnt vmcnt(0)" ::: "memory");
        }
    }
    __syncthreads();
}

struct KP { const float* in[25]; float* out; unsigned char* ws; int gp_lo, gp_hi; };
enum { I_X = 0, I_C, I_ADAW, I_ADAB, I_N1G, I_N2G, I_WIN, I_LBL, I_HNG, I_ARE, I_AIM, I_LDT, I_BRE, I_BIM, I_CRE, I_CIM, I_S5D, I_GLUW, I_GLUB, I_WOUT, I_WQ, I_SUBK, I_PU, I_PV, I_FG };

typedef const KP __attribute__((address_space(4)))* kp_cptr;
__device__ __forceinline__ KP load_kp() {
#if defined(__HIP_DEVICE_COMPILE__)
    unsigned long long a = (unsigned long long)__builtin_amdgcn_kernarg_segment_ptr(); asm volatile("" : "+s"(a)); return *(kp_cptr)a;
#else
    return KP{};
#endif
}

__device__ __forceinline__ void phase_setup(const KP& p, LAS unsigned char* lds, int G) {
    const int tid = opaque_tid();
    {
        LAS float* cact = (LAS float*)lds;
        for (int it = blockIdx.x; it < 4 * 48; it += G) {
#pragma unroll 1
            for (int i0 = 0; i0 < 64; i0 += 16) { float cv[16];
#pragma unroll
                for (int q = 0; q < 16; ++q) cv[q] = p.in[I_C][(i0 + q) * 512 + tid];
#pragma unroll
                for (int q = 0; q < 16; ++q) { const int i = (i0 + q) * 512 + tid; const int k_ = i & 1023, b_ = i >> 10; cact[k_ * 32 + ((((b_ >> 2) ^ (k_ & 7)) << 2) | (b_ & 3))] = fsilu(cv[q]); } }
            __syncthreads();
            const int l = it / 48, cb = it % 48, col = cb * 128 + (tid & 127), bg = tid >> 7;
            const float* W = p.in[I_ADAW] + (size_t)l * D * NMODC + col;
            f32x4 acc0 = {0.f, 0.f, 0.f, 0.f}, acc1 = {0.f, 0.f, 0.f, 0.f};
#pragma unroll 2
            for (int k4 = 0; k4 < 256; ++k4) {
                const float w0 = W[(size_t)(4 * k4 + 0) * NMODC], w1 = W[(size_t)(4 * k4 + 1) * NMODC], w2 = W[(size_t)(4 * k4 + 2) * NMODC], w3 = W[(size_t)(4 * k4 + 3) * NMODC];
#pragma unroll
                for (int kk = 0; kk < 4; ++kk) { const int k_ = 4 * k4 + kk; const float wv = kk == 0 ? w0 : (kk == 1 ? w1 : (kk == 2 ? w2 : w3));
                    acc0 += *(const LAS f32x4*)(cact + k_ * 32 + (((2 * bg) ^ (k_ & 7)) << 2)) * wv; acc1 += *(const LAS f32x4*)(cact + k_ * 32 + (((2 * bg + 1) ^ (k_ & 7)) << 2)) * wv; }
            }
            float* MOD = (float*)(p.ws + WS_MOD);
            const float bias = p.in[I_ADAB][l * NMODC + col];
#pragma unroll
            for (int j = 0; j < 4; ++j) { MOD[((size_t)l * 32 + 8 * bg + j) * NMODC + col] = acc0[j] + bias; MOD[((size_t)l * 32 + 8 * bg + 4 + j) * NMODC + col] = acc1[j] + bias; }
            __syncthreads();
        }
    }
    const int gtid = (G - 1 - (int)blockIdx.x) * 512 + tid;
    if (gtid < 1024) {
        const float* lg = p.in[I_LBL]; float v[4], mx = -1e30f;
#pragma unroll
        for (int l = 0; l < 4; ++l) { v[l] = lg[l * 1024 + gtid]; mx = fmaxf(mx, v[l]); }
        float s = 0.f;
#pragma unroll
        for (int l = 0; l < 4; ++l) { v[l] = __expf(v[l] - mx); s += v[l]; }
        float* LB = (float*)(p.ws + WS_LB); float cum = 0.f; const float first = v[0] / s;
#pragma unroll
        for (int l = 0; l < 4; ++l) { cum += v[l] / s; LB[l * 1024 + gtid] = (l == 0) ? 0.f : (cum - first); }
    }
    if (gtid >= 1024 && gtid < 1024 + 16384) {
        const int id = gtid - 1024, lg = id >> 6, pp = id & 63;
        const float a_re = p.in[I_ARE][id], a_im = p.in[I_AIM][id];
        const float step = expf(p.in[I_LDT][lg]);
        const float mag = expf(step * a_re), ang = step * a_im;
        const float ab_re = mag * cosf(ang), ab_im = mag * sinf(ang);
        const float den = a_re * a_re + a_im * a_im;
        const float z_re = ((ab_re - 1.0f) * a_re + ab_im * a_im) / den;
        const float z_im = (ab_im * a_re - (ab_re - 1.0f) * a_im) / den;
        float* ABAR = (float*)(p.ws + WS_ABAR); ABAR[2 * id] = ab_re; ABAR[2 * id + 1] = ab_im;
        bf16_t* BOP = (bf16_t*)(p.ws + WS_BOP); bf16_t* COP = (bf16_t*)(p.ws + WS_COP);
        const float* bre = p.in[I_BRE] + (size_t)id * 16; const float* bim = p.in[I_BIM] + (size_t)id * 16;
#pragma unroll
        for (int c = 0; c < 16; ++c) {
            const float br = bre[c], bi = bim[c];
            const float rr = z_re * br - z_im * bi, ii = z_re * bi + z_im * br;
            BOP[((size_t)lg * 128 + 2 * pp) * 16 + c] = (bf16_t)(pk2(rr, 0.f) & 0xffffu);
            BOP[((size_t)lg * 128 + 2 * pp + 1) * 16 + c] = (bf16_t)(pk2(ii, 0.f) & 0xffffu);
            const float cr = p.in[I_CRE][((size_t)lg * 16 + c) * 64 + pp], ci = p.in[I_CIM][((size_t)lg * 16 + c) * 64 + pp];
            COP[((size_t)lg * 16 + c) * 128 + 2 * pp] = (bf16_t)(pk2(cr, 0.f) & 0xffffu);
            COP[((size_t)lg * 16 + c) * 128 + 2 * pp + 1] = (bf16_t)(pk2(-ci, 0.f) & 0xffffu);
        }
    }
}

__device__ __forceinline__ void transpose_item(const float* W, int K, int N, bf16_t* WT, LAS float* scr, int item, int lane) {
    const int nblk = N / 32, kb = item / nblk, nb = item % nblk, k0 = 64 * kb, n0 = 32 * nb;
#pragma unroll 8
    for (int i = 0; i < 32; ++i) { const int kk = 2 * i + (lane >> 5); scr[kk * 33 + (lane & 31)] = W[(size_t)(k0 + kk) * N + n0 + (lane & 31)]; }
    LDS_WAIT();
    const int c = lane & 7;
#pragma unroll
    for (int j = 0; j < 4; ++j) { const int n = (lane >> 3) + 8 * j; const LAS float* s = scr + (8 * c) * 33 + n;
        u32x4 o; o.x = pk2(s[0 * 33], s[1 * 33]); o.y = pk2(s[2 * 33], s[3 * 33]); o.z = pk2(s[4 * 33], s[5 * 33]); o.w = pk2(s[6 * 33], s[7 * 33]);
        *(u32x4*)(WT + (size_t)(n0 + n) * K + k0 + 8 * c) = o; }
    LDS_WAIT();
}
__device__ __forceinline__ void cvt_f32_fp8(const float* src, unsigned char* dst, size_t n4, size_t gtid, size_t nthr, float scale) {
    for (size_t i = gtid; i < n4; i += nthr) { const f32x4 v = ((const f32x4*)src)[i] * scale; int w = 0;
        w = __builtin_amdgcn_cvt_pk_fp8_f32(v[0], v[1], w, false); w = __builtin_amdgcn_cvt_pk_fp8_f32(v[2], v[3], w, true); ((unsigned*)dst)[i] = (unsigned)w; }
}
__device__ __forceinline__ void cvt_f32_fp8_sliced(const float* src, unsigned char* dst, size_t gtid, size_t nthr, float scale) {
    for (size_t i = gtid; i < (size_t)16384 * 64; i += nthr) {
        const size_t e = i >> 6; const int sl = (int)(i & 63) >> 3, c = (int)(i & 7);
        const f32x4* sp = (const f32x4*)(src + e * 1024 + sl * 128 + c * 16); u32x4 o;
#pragma unroll
        for (int q = 0; q < 4; ++q) { const f32x4 v = sp[q] * scale; int w = 0; w = __builtin_amdgcn_cvt_pk_fp8_f32(v[0], v[1], w, false); w = __builtin_amdgcn_cvt_pk_fp8_f32(v[2], v[3], w, true); o[q] = (unsigned)w; }
        *(u32x4*)(dst + ((size_t)sl * 16384 + e) * 128 + c * 16) = o;
    }
}
__device__ __forceinline__ void transpose_item_fp8(const float* W, int K, int N, unsigned char* WT, LAS float* scr, int item, int lane, float scale) {
    const int nblk = N / 32, kb = item / nblk, nb = item % nblk, k0 = 64 * kb, n0 = 32 * nb;
#pragma unroll 8
    for (int i = 0; i < 32; ++i) { const int kk = 2 * i + (lane >> 5); scr[kk * 33 + (lane & 31)] = W[(size_t)(k0 + kk) * N + n0 + (lane & 31)]; }
    LDS_WAIT();
    const int c = lane & 7;
#pragma unroll
    for (int j = 0; j < 4; ++j) { const int n = (lane >> 3) + 8 * j; const LAS float* sp = scr + (8 * c) * 33 + n;
        int w0 = 0, w1 = 0;
        w0 = __builtin_amdgcn_cvt_pk_fp8_f32(sp[0 * 33] * scale, sp[1 * 33] * scale, w0, false); w0 = __builtin_amdgcn_cvt_pk_fp8_f32(sp[2 * 33] * scale, sp[3 * 33] * scale, w0, true);
        w1 = __builtin_amdgcn_cvt_pk_fp8_f32(sp[4 * 33] * scale, sp[5 * 33] * scale, w1, false); w1 = __builtin_amdgcn_cvt_pk_fp8_f32(sp[6 * 33] * scale, sp[7 * 33] * scale, w1, true);
        *(u32x2*)(WT + (size_t)(n0 + n) * K + k0 + 8 * c) = (u32x2){(unsigned)w0, (unsigned)w1}; }
    LDS_WAIT();
}
__device__ __forceinline__ void cvt_f32_bf16(const float* src, bf16_t* dst, size_t n4, size_t gtid, size_t nthr) {
    for (size_t i = gtid; i < n4; i += nthr) { const f32x4 v = ((const f32x4*)src)[i]; u32x2 o; o.x = pk2(v[0], v[1]); o.y = pk2(v[2], v[3]); ((u32x2*)dst)[i] = o; }
}
template <bool F8OUT, bool XBF>
__device__ __forceinline__ void norm_rows(const float* xsrc, bf16_t* hdst, const float* gain, const float* mod_l, int sh_off, int sc_off, int gw, int ngw, int lane) {
    for (int r0 = gw * 4; r0 < M; r0 += ngw * 4) {
        const int b = r0 >> 11;
        f32x4 v[4][4]; float ss[4];
#pragma unroll
        for (int i = 0; i < 4; ++i) {
            if constexpr (XBF) { const u32x2* xr = (const u32x2*)((const bf16_t*)xsrc + (size_t)(r0 + i) * D) + lane;
#pragma unroll
                for (int j = 0; j < 4; ++j) { const u32x2 xw = xr[64 * j]; v[i][j] = (f32x4){bflo(xw[0]), bfhi(xw[0]), bflo(xw[1]), bfhi(xw[1])}; } }
            else { const f32x4* xr = (const f32x4*)(xsrc + (size_t)(r0 + i) * D) + lane;
#pragma unroll
                for (int j = 0; j < 4; ++j) v[i][j] = xr[64 * j]; } }
#pragma unroll
        for (int i = 0; i < 4; ++i) { float t = 0.f;
#pragma unroll
            for (int j = 0; j < 4; ++j) t += (v[i][j][0] * v[i][j][0] + v[i][j][1] * v[i][j][1]) + (v[i][j][2] * v[i][j][2] + v[i][j][3] * v[i][j][3]);
            ss[i] = t; }
#pragma unroll
        for (int o = 1; o < 64; o <<= 1) {
#pragma unroll
            for (int i = 0; i < 4; ++i) ss[i] += __shfl_xor(ss[i], o); }
        const float* mb = mod_l + (size_t)b * NMODC;
#pragma unroll
        for (int j = 0; j < 4; ++j) { const int col = 256 * j + 4 * lane;
            const f32x4 g4 = *(const f32x4*)(gain + col), sc = *(const f32x4*)(mb + sc_off + col), sh = *(const f32x4*)(mb + sh_off + col);
            const f32x4 gs = g4 * (sc + 1.0f);
#pragma unroll
            for (int i = 0; i < 4; ++i) { const float rstd = __builtin_amdgcn_rsqf(ss[i] * (1.0f / D) + EPS);
                const f32x4 h = v[i][j] * rstd * gs + sh;
                if constexpr (F8OUT) { int w8 = 0; w8 = __builtin_amdgcn_cvt_pk_fp8_f32(h[0] * HIN_SCALE, h[1] * HIN_SCALE, w8, false); w8 = __builtin_amdgcn_cvt_pk_fp8_f32(h[2] * HIN_SCALE, h[3] * HIN_SCALE, w8, true);
                    *(unsigned*)((unsigned char*)hdst + (size_t)(r0 + i) * D + col) = (unsigned)w8; }
                else { u32x2 o; o.x = pk2(h[0], h[1]); o.y = pk2(h[2], h[3]); *(u32x2*)(hdst + (size_t)(r0 + i) * D + col) = o; } } }
    }
}
template <bool XBF>
__device__ __forceinline__ void resid_norm_rows(const float* xsrc, bf16_t* xdst, const bf16_t* delta, bf16_t* hdst, unsigned char* xf8, const float* gain, const float* mod_l, int gw, int ngw, int lane) {
    for (int r0 = gw * 4; r0 < M; r0 += ngw * 4) {
        const int b = r0 >> 11; const float* mb = mod_l + (size_t)b * NMODC;
        f32x4 v[4][4]; u32x2 dl[4][4]; float ss[4];
#pragma unroll
        for (int i = 0; i < 4; ++i) { const u32x2* dp = (const u32x2*)(delta + (size_t)(r0 + i) * D) + lane;
            if constexpr (XBF) { const u32x2* xr = (const u32x2*)((const bf16_t*)xsrc + (size_t)(r0 + i) * D) + lane;
#pragma unroll
                for (int j = 0; j < 4; ++j) { const u32x2 xw = xr[64 * j]; v[i][j] = (f32x4){bflo(xw[0]), bfhi(xw[0]), bflo(xw[1]), bfhi(xw[1])}; dl[i][j] = dp[64 * j]; } }
            else { const f32x4* xr = (const f32x4*)(xsrc + (size_t)(r0 + i) * D) + lane;
#pragma unroll
                for (int j = 0; j < 4; ++j) { v[i][j] = xr[64 * j]; dl[i][j] = dp[64 * j]; } } }
#pragma unroll
        for (int j = 0; j < 4; ++j) { const f32x4 g1 = *(const f32x4*)(mb + 2048 + 256 * j + 4 * lane);
#pragma unroll
            for (int i = 0; i < 4; ++i) { const f32x4 dv = {bflo(dl[i][j][0]), bfhi(dl[i][j][0]), bflo(dl[i][j][1]), bfhi(dl[i][j][1])}; v[i][j] = v[i][j] + g1 * dv;
                ((u32x2*)(xdst + (size_t)(r0 + i) * D) + lane)[64 * j] = (u32x2){pk2(v[i][j][0], v[i][j][1]), pk2(v[i][j][2], v[i][j][3])}; } }
#pragma unroll
        for (int i = 0; i < 4; ++i) { float t = 0.f;
#pragma unroll
            for (int j = 0; j < 4; ++j) t += (v[i][j][0] * v[i][j][0] + v[i][j][1] * v[i][j][1]) + (v[i][j][2] * v[i][j][2] + v[i][j][3] * v[i][j][3]);
            ss[i] = t; }
#pragma unroll
        for (int o = 1; o < 64; o <<= 1) {
#pragma unroll
            for (int i = 0; i < 4; ++i) ss[i] += __shfl_xor(ss[i], o); }
#pragma unroll
        for (int j = 0; j < 4; ++j) { const int col = 256 * j + 4 * lane;
            const f32x4 g4 = *(const f32x4*)(gain + col), sc = *(const f32x4*)(mb + 4096 + col), sh = *(const f32x4*)(mb + 3072 + col);
            const f32x4 gs = g4 * (sc + 1.0f);
#pragma unroll
            for (int i = 0; i < 4; ++i) { const float rstd = __builtin_amdgcn_rsqf(ss[i] * (1.0f / D) + EPS);
                const f32x4 h = v[i][j] * rstd * gs + sh; u32x2 o; o.x = pk2(h[0], h[1]); o.y = pk2(h[2], h[3]); *(u32x2*)(hdst + (size_t)(r0 + i) * D + col) = o;
                int w8 = 0; w8 = __builtin_amdgcn_cvt_pk_fp8_f32(h[0] * X_SCALE, h[1] * X_SCALE, w8, false); w8 = __builtin_amdgcn_cvt_pk_fp8_f32(h[2] * X_SCALE, h[3] * X_SCALE, w8, true);
                *(unsigned*)(xf8 + ((size_t)(col >> 7) * M + (r0 + i)) * 128 + (col & 127)) = (unsigned)w8; } }
    }
}
__device__ __forceinline__ void phase_conv_norm1(const KP& p, LAS unsigned char* lds, int l, int G) {
    const int tid = opaque_tid(), lane = tid & 63, wave = __builtin_amdgcn_readfirstlane(tid >> 6);
    const int gw = blockIdx.x * 8 + wave, ngw = G * 8;
    LAS float* scr = (LAS float*)(lds + wave * 8448);
    constexpr int I_IN = 16 * (INC / 32), I_G = 16 * 32, I_O = 16 * 32, I_Q = 16 * 64, NIT = I_IN + I_G + I_O + I_Q;
    for (int it = gw; it < NIT; it += ngw) {
        int r = it;
        if (r < I_IN) { transpose_item_fp8(p.in[I_WIN] + (size_t)l * D * INC, D, INC, p.ws + WS_WIN, scr, r, lane, WIN_SCALE); continue; } r -= I_IN;
        if (r < I_G) { transpose_item(p.in[I_GLUW] + (size_t)l * D * D, D, D, (bf16_t*)(p.ws + WS_WGLU), scr, r, lane); continue; } r -= I_G;
        if (r < I_O) { transpose_item_fp8(p.in[I_WOUT] + (size_t)l * D * D, D, D, p.ws + WS_WOUT, scr, r, lane, WO_SCALE); continue; } r -= I_O;
        transpose_item(p.in[I_WQ] + (size_t)l * D * 2048, D, 2048, (bf16_t*)(p.ws + WS_WQ), scr, r, lane);
    }
    const size_t gtid = (size_t)blockIdx.x * 512 + tid, nthr = (size_t)G * 512;
    cvt_f32_bf16(p.in[I_SUBK] + (size_t)l * 262144, (bf16_t*)(p.ws + WS_KEYS), 262144 / 4, gtid, nthr);
    if (l == 0) {
        cvt_f32_fp8_sliced(p.in[I_PU], p.ws + WS_U, gtid, nthr, U_SCALE);
        cvt_f32_fp8_sliced(p.in[I_PV], p.ws + WS_V, gtid, nthr, V_SCALE); }
    if (l == 0) norm_rows<true, false>(p.in[I_X], (bf16_t*)(p.ws + WS_H), p.in[I_N1G] + l * D, (const float*)(p.ws + WS_MOD) + (size_t)l * 32 * NMODC, 0, 1024, gw, ngw, lane);
    else norm_rows<true, true>(p.out, (bf16_t*)(p.ws + WS_H), p.in[I_N1G] + l * D, (const float*)(p.ws + WS_MOD) + (size_t)l * 32 * NMODC, 0, 1024, gw, ngw, lane);
}

__device__ __forceinline__ void phase_hgrn2(const KP& p, LAS unsigned char* lds, int l, int G) {
    const int tid = opaque_tid(), lane = tid & 63, w = __builtin_amdgcn_readfirstlane(tid >> 6), fr = lane & 15, g = lane >> 4;
    constexpr int QS = 272, TS = 72;
    constexpr int OFF_QT = 0, OFF_KH = 8704, OFF_KT = 17408, OFF_VT = 26624, OFF_EREF = 35840, OFF_ELR = 36352, OFF_SEG = 36864, PBUF = 40960;
    const bf16_t* PA = (const bf16_t*)(p.ws + WS_R0);
    bf16_t* ORAW = (bf16_t*)(p.ws + WS_OR);
    const float* LB = (const float*)(p.ws + WS_LB) + l * 1024;
    for (int unit = blockIdx.x; unit < 256; unit += G) {
        const int b = unit >> 3, h = unit & 7, k0 = 2 * lane;
        const float lb0 = LB[h * 128 + k0], lb1 = LB[h * 128 + k0 + 1];
        const float om0 = 1.0f - lb0, om1 = 1.0f - lb1;
        f32x4 S[8];
#pragma unroll
        for (int kt = 0; kt < 8; ++kt) S[kt] = (f32x4){0.f, 0.f, 0.f, 0.f};
        unsigned rq[4], rf[4], rv[4];
        {
            const bf16_t* base = PA + ((size_t)b * SEQ + 4 * w) * 3072 + h * 128 + k0;
#pragma unroll
            for (int i = 0; i < 4; ++i) { rq[i] = *(const unsigned*)(base + (size_t)i * 3072); rf[i] = *(const unsigned*)(base + (size_t)i * 3072 + 1024); rv[i] = *(const unsigned*)(base + (size_t)i * 3072 + 2048); }
        }
        for (int c = 0; c < 64; ++c) {
            LAS unsigned char* base = lds + (c & 1) * PBUF;
            float cs0[4], cs1[4], qv0[4], qv1[4], kv0[4], kv1[4];
            float run0 = 0.f, run1 = 0.f;
#pragma unroll
            for (int i = 0; i < 4; ++i) {
                const float fp0 = bflo(rf[i]), fp1 = bfhi(rf[i]);
                const float s0 = fsigmoid(fp0), s1 = fsigmoid(fp1);
                run0 += __logf(lb0 + om0 * s0); run1 += __logf(lb1 + om1 * s1);
                cs0[i] = run0; cs1[i] = run1;
                kv0[i] = om0 * (1.0f - s0); kv1[i] = om1 * (1.0f - s1);
                qv0[i] = fsilu(bflo(rq[i])); qv1[i] = fsilu(bfhi(rq[i]));
            }
            *(LAS f32x2*)(base + OFF_SEG + (w * 128 + k0) * 4) = (f32x2){run0, run1};
            __syncthreads();
            float off0 = 0.f, off1 = 0.f, ref0 = 0.f, ref1 = 0.f, all0 = 0.f, all1 = 0.f;
#pragma unroll
            for (int s = 0; s < 8; ++s) { const f32x2 t2 = *(const LAS f32x2*)(base + OFF_SEG + (s * 128 + k0) * 4);
                if (s < w) { off0 += t2[0]; off1 += t2[1]; }
                if (s < 4) { ref0 += t2[0]; ref1 += t2[1]; }
                all0 += t2[0]; all1 += t2[1]; }
            float kh0[4], kh1[4];
#pragma unroll
            for (int i = 0; i < 4; ++i) {
                const float b0 = off0 + cs0[i], b1 = off1 + cs1[i];
                const float q0 = qv0[i] * __expf(b0 - ref0), q1 = qv1[i] * __expf(b1 - ref1);
                kh0[i] = kv0[i] * __expf(ref0 - b0); kh1[i] = kv1[i] * __expf(ref1 - b1);
                const int t = 4 * w + i;
                *(LAS unsigned*)(base + OFF_QT + t * QS + k0 * 2) = pk2(q0, q1);
                *(LAS unsigned*)(base + OFF_KH + t * QS + k0 * 2) = pk2(kh0[i], kh1[i]);
            }
            *(LAS u32x2*)(base + OFF_KT + k0 * TS + 8 * w) = (u32x2){pk2(kh0[0], kh0[1]), pk2(kh0[2], kh0[3])};
            *(LAS u32x2*)(base + OFF_KT + (k0 + 1) * TS + 8 * w) = (u32x2){pk2(kh1[0], kh1[1]), pk2(kh1[2], kh1[3])};
            *(LAS u32x2*)(base + OFF_VT + k0 * TS + 8 * w) = (u32x2){(rv[0] & 0xffffu) | (rv[1] << 16), (rv[2] & 0xffffu) | (rv[3] << 16)};
            *(LAS u32x2*)(base + OFF_VT + (k0 + 1) * TS + 8 * w) = (u32x2){(rv[0] >> 16) | (rv[1] & 0xffff0000u), (rv[2] >> 16) | (rv[3] & 0xffff0000u)};
            if (w == 0) {
                *(LAS f32x2*)(base + OFF_EREF + k0 * 4) = (f32x2){__expf(ref0), __expf(ref1)};
                *(LAS f32x2*)(base + OFF_ELR + k0 * 4) = (f32x2){__expf(all0 - ref0), __expf(all1 - ref1)};
            }
            __syncthreads();
            if (c + 1 < 64) {
                const bf16_t* nb = PA + ((size_t)b * SEQ + (c + 1) * 32 + 4 * w) * 3072 + h * 128 + k0;
#pragma unroll
                for (int i = 0; i < 4; ++i) { rq[i] = *(const unsigned*)(nb + (size_t)i * 3072); rf[i] = *(const unsigned*)(nb + (size_t)i * 3072 + 1024); rv[i] = *(const unsigned*)(nb + (size_t)i * 3072 + 2048); }
            }
            bf16x8 qf[2][4], kf[2][4];
#pragma unroll
            for (int tt = 0; tt < 2; ++tt)
#pragma unroll
                for (int m = 0; m < 4; ++m) {
                    const LAS unsigned char* pq = base + OFF_QT + (16 * tt + fr) * QS + (32 * m + 4 * g) * 2;
                    const u32x2 lo = *(const LAS u32x2*)pq, hi = *(const LAS u32x2*)(pq + 32);
                    qf[tt][m] = __builtin_bit_cast(bf16x8, (u32x4){lo[0], lo[1], hi[0], hi[1]});
                    const LAS unsigned char* pk = base + OFF_KH + (16 * tt + fr) * QS + (32 * m + 4 * g) * 2;
                    const u32x2 lo2 = *(const LAS u32x2*)pk, hi2 = *(const LAS u32x2*)(pk + 32);
                    kf[tt][m] = __builtin_bit_cast(bf16x8, (u32x4){lo2[0], lo2[1], hi2[0], hi2[1]});
                }
            f32x4 PT00 = {0.f, 0.f, 0.f, 0.f}, PT01 = {0.f, 0.f, 0.f, 0.f}, PT11 = {0.f, 0.f, 0.f, 0.f};
#pragma unroll
            for (int m = 0; m < 4; ++m) {
                PT00 = __builtin_amdgcn_mfma_f32_16x16x32_bf16(kf[0][m], qf[0][m], PT00, 0, 0, 0);
                PT01 = __builtin_amdgcn_mfma_f32_16x16x32_bf16(kf[0][m], qf[1][m], PT01, 0, 0, 0);
                PT11 = __builtin_amdgcn_mfma_f32_16x16x32_bf16(kf[1][m], qf[1][m], PT11, 0, 0, 0);
            }
#pragma unroll
            for (int r = 0; r < 4; ++r) { if (4 * g + r > fr) { PT00[r] = 0.f; PT11[r] = 0.f; } }
            const bf16x8 pa0 = __builtin_bit_cast(bf16x8, (u32x4){pk2(PT00[0], PT00[1]), pk2(PT00[2], PT00[3]), 0u, 0u});
            const bf16x8 pa1 = __builtin_bit_cast(bf16x8, (u32x4){pk2(PT01[0], PT01[1]), pk2(PT01[2], PT01[3]), pk2(PT11[0], PT11[1]), pk2(PT11[2], PT11[3])});
            const LAS unsigned char* vrow = base + OFF_VT + (16 * w + fr) * TS;
            const u32x2 vpa = *(const LAS u32x2*)(vrow + 8 * g), vpb = *(const LAS u32x2*)(vrow + 32 + 8 * g);
            const u32x2 vna = *(const LAS u32x2*)(vrow + 16 * g), vnb = *(const LAS u32x2*)(vrow + 16 * g + 8);
            const bf16x8 vperm = __builtin_bit_cast(bf16x8, (u32x4){vpa[0], vpa[1], vpb[0], vpb[1]});
            const bf16x8 vnat = __builtin_bit_cast(bf16x8, (u32x4){vna[0], vna[1], vnb[0], vnb[1]});
#pragma unroll
            for (int kt = 0; kt < 8; ++kt) { const f32x4 e = *(const LAS f32x4*)(base + OFF_EREF + (16 * kt + 4 * g) * 4); S[kt] = S[kt] * e; }
            f32x4 O0 = {0.f, 0.f, 0.f, 0.f}, O1 = {0.f, 0.f, 0.f, 0.f};
#pragma unroll
            for (int m = 0; m < 4; ++m) {
                const bf16x8 sf = __builtin_bit_cast(bf16x8, (u32x4){pk2(S[2 * m][0], S[2 * m][1]), pk2(S[2 * m][2], S[2 * m][3]), pk2(S[2 * m + 1][0], S[2 * m + 1][1]), pk2(S[2 * m + 1][2], S[2 * m + 1][3])});
                O0 = __builtin_amdgcn_mfma_f32_16x16x32_bf16(qf[0][m], sf, O0, 0, 0, 0);
                O1 = __builtin_amdgcn_mfma_f32_16x16x32_bf16(qf[1][m], sf, O1, 0, 0, 0);
            }
            O0 = __builtin_amdgcn_mfma_f32_16x16x32_bf16(pa0, vperm, O0, 0, 0, 0);
            O1 = __builtin_amdgcn_mfma_f32_16x16x32_bf16(pa1, vperm, O1, 0, 0, 0);
#pragma unroll
            for (int kt = 0; kt < 8; ++kt) {
                const LAS unsigned char* krow = base + OFF_KT + (16 * kt + fr) * TS + 16 * g;
                const u32x2 ka = *(const LAS u32x2*)krow, kb = *(const LAS u32x2*)(krow + 8);
                const bf16x8 ktf = __builtin_bit_cast(bf16x8, (u32x4){ka[0], ka[1], kb[0], kb[1]});
                S[kt] = __builtin_amdgcn_mfma_f32_16x16x32_bf16(ktf, vnat, S[kt], 0, 0, 0);
            }
#pragma unroll
            for (int kt = 0; kt < 8; ++kt) { const f32x4 e = *(const LAS f32x4*)(base + OFF_ELR + (16 * kt + 4 * g) * 4); S[kt] = S[kt] * e; }
            bf16_t* orow = ORAW + ((size_t)b * SEQ + c * 32 + 4 * g) * D + h * 128 + 16 * w + fr;
#pragma unroll
            for (int r = 0; r < 4; ++r) { orow[(size_t)r * D] = (bf16_t)(pk2(O0[r], 0.f) & 0xffffu); orow[(size_t)(16 + r) * D] = (bf16_t)(pk2(O1[r], 0.f) & 0xffffu); }
        }
        __syncthreads();
    }
}

__device__ __forceinline__ void phase_s5(const KP& p, LAS unsigned char* lds, int l, int G, size_t ys_off) {
    const int tid = opaque_tid(), lane = tid & 63, w = __builtin_amdgcn_readfirstlane(tid >> 6), fr = lane & 15, g = lane >> 4;
    const int gw = blockIdx.x * 8 + w, ngw = G * 8;
    constexpr int BUS = 132;
    LAS float* BU = (LAS float*)(lds + w * 16896);
    LAS unsigned char* XI = (LAS unsigned char*)BU;
    const bf16_t* PB = (const bf16_t*)(p.ws + WS_R0);
    const bf16x8 zero8 = {0, 0, 0, 0, 0, 0, 0, 0};
    const bf16_t* ORAWs = (const bf16_t*)(p.ws + WS_OR); float* SSQs = (float*)(p.ws + WS_SSQ);
    for (int unit = gw; unit < BATCH * 64; unit += ngw) {
        const int b = unit >> 6, grp = unit & 63, lg = l * 64 + grp;
        const bf16_t* BOP = (const bf16_t*)(p.ws + WS_BOP) + (size_t)lg * 128 * 16;
        const bf16_t* COP = (const bf16_t*)(p.ws + WS_COP) + (size_t)lg * 16 * 128;
        bf16x8 bfrag[8], cfrag[4], dfrag;
#pragma unroll
        for (int nt = 0; nt < 8; ++nt) bfrag[nt] = (g < 2) ? *(const bf16x8*)(BOP + (size_t)(16 * nt + fr) * 16 + 8 * g) : zero8;
#pragma unroll
        for (int ks = 0; ks < 4; ++ks) cfrag[ks] = DBG_S5_NOSSM ? zero8 : *(const bf16x8*)(COP + (size_t)fr * 128 + 32 * ks + 8 * g);
        {
            const unsigned dbits = pk2(p.in[I_S5D][l * 1024 + grp * 16 + fr], 0.f) & 0xffffu;
#pragma unroll
            for (int j = 0; j < 8; ++j) dfrag[j] = (g < 2 && (8 * g + j) == fr) ? (short)dbits : (short)0;
        }
        const float ar = ((const float*)(p.ws + WS_ABAR))[2 * ((size_t)lg * 64 + lane)], ai = ((const float*)(p.ws + WS_ABAR))[2 * ((size_t)lg * 64 + lane) + 1];
        const float nai = -ai; float xr = 0.f, xi = 0.f; unsigned hBU = 0u, hXI = 0u, hY = 0u;
        const bf16_t* ub = PB + ((size_t)b * SEQ) * 4096 + 1024 + grp * 16;
        bf16_t* yb_ = (bf16_t*)(p.ws + ys_off) + ((size_t)b * SEQ) * D + grp * 16;
        bf16x8 unext[2];
#pragma unroll
        for (int tt = 0; tt < 2; ++tt) unext[tt] = (g < 2) ? *(const bf16x8*)(ub + (size_t)(16 * tt + fr) * 4096 + 8 * g) : zero8;
        const bool cvt_next = (l + 1 < DEPTH);
        const float* tsrc = ((lane < 32) ? p.in[I_PU] : p.in[I_PV]) + (size_t)(l + 1 < DEPTH ? l + 1 : l) * 16384 * 1024 + 4 * (lane & 31);
        unsigned char* tdst = p.ws + ((lane < 32) ? WS_U : WS_V) + (size_t)((l + 1) & 1) * TAB_BYTES + 4 * (lane & 31);
        const float tscale = (lane < 32) ? U_SCALE : V_SCALE;
        for (int t0 = 0; t0 < SEQ; t0 += 32) {
            const int item = unit * 64 + (t0 >> 5), te = item >> 3, tsl = item & 7;
            f32x4 tv = {0.f, 0.f, 0.f, 0.f}; if (cvt_next) tv = *(const f32x4*)(tsrc + (size_t)te * 1024 + tsl * 128);
            const bool ssq_it = ((t0 >> 5) & 1) == 0; const int srow = item >> 1;
            u32x4 sa = {0u, 0u, 0u, 0u}, sc2 = {0u, 0u, 0u, 0u};
            if (ssq_it) { sa = *(const u32x4*)(ORAWs + (size_t)srow * D + 8 * lane); sc2 = *(const u32x4*)(ORAWs + (size_t)srow * D + 512 + 8 * lane); }
            bf16x8 ufrag[2];
#pragma unroll
            for (int tt = 0; tt < 2; ++tt) { ufrag[tt] = unext[tt]; if (t0 + 32 < SEQ) unext[tt] = (g < 2) ? *(const bf16x8*)(ub + (size_t)(t0 + 32 + 16 * tt + fr) * 4096 + 8 * g) : zero8; }
#pragma unroll
            for (int tt = 0; tt < 2; ++tt)
#pragma unroll
                for (int nt = 0; nt < 8; ++nt) {
                    const f32x4 a = __builtin_amdgcn_mfma_f32_16x16x32_bf16(ufrag[tt], bfrag[nt], (f32x4){0.f, 0.f, 0.f, 0.f}, 0, 0, 0);
#pragma unroll
                    for (int r = 0; r < 4; ++r) BU[(16 * tt + 4 * g + r) * BUS + 16 * nt + fr] = a[r];
                }
            LDS_WAIT();
#pragma unroll
            for (int t = 0; t < 32; ++t) {
                const f32x2 bb = *(const LAS f32x2*)(BU + t * BUS + 2 * lane); hBU += __float_as_uint(bb[0]) * 3u + __float_as_uint(bb[1]);
                float t1, t2, nr, ni;
                asm("v_fma_f32 %0, %1, %2, %3" : "=v"(t1) : "v"(nai), "v"(xi), "v"(bb[0]));
                asm("v_fma_f32 %0, %1, %2, %3" : "=v"(t2) : "v"(ai), "v"(xr), "v"(bb[1]));
                asm("v_fma_f32 %0, %1, %2, %3" : "=v"(nr) : "v"(ar), "v"(xr), "v"(t1));
                asm("v_fma_f32 %0, %1, %2, %3" : "=v"(ni) : "v"(ar), "v"(xi), "v"(t2));
                xr = nr; xi = ni;
                { const unsigned pv = pk2(nr, ni); hXI += pv; *(LAS unsigned*)(XI + t * (BUS * 4) + lane * 4) = pv; }
            }
            LDS_WAIT();
#pragma unroll
            for (int tt = 0; tt < 2; ++tt) {
                f32x4 y = {0.f, 0.f, 0.f, 0.f};
#pragma unroll
                for (int ks = 0; ks < 4; ++ks) {
                    const bf16x8 xf = *(const LAS bf16x8*)(XI + (16 * tt + fr) * (BUS * 4) + (32 * ks + 8 * g) * 2);
                    y = __builtin_amdgcn_mfma_f32_16x16x32_bf16(xf, cfrag[ks], y, 0, 0, 0);
                }
                y = __builtin_amdgcn_mfma_f32_16x16x32_bf16(ufrag[tt], dfrag, y, 0, 0, 0);
#pragma unroll
                for (int r = 0; r < 4; ++r) { const unsigned yv = pk2(fgelu(y[r]), 0.f) & 0xffffu; hY += yv * (unsigned)(r + 1); yb_[(size_t)(t0 + 16 * tt + 4 * g + r) * D + fr] = (bf16_t)yv; }
            }
            LDS_WAIT();
            if (ssq_it) { float s0 = 0.f, s1 = 0.f;
#pragma unroll
                for (int j = 0; j < 4; ++j) { const float x0 = bflo(sa[j]), x1 = bfhi(sa[j]), y0 = bflo(sc2[j]), y1 = bfhi(sc2[j]); s0 += x0 * x0 + x1 * x1; s1 += y0 * y0 + y1 * y1; }
                { s0 = dpp_sum8(s0); s1 = dpp_sum8(s1);
                  s0 += __uint_as_float(__builtin_amdgcn_update_dpp(0, __float_as_uint(s0), 0x140, 0xF, 0xF, true)); s1 += __uint_as_float(__builtin_amdgcn_update_dpp(0, __float_as_uint(s1), 0x140, 0xF, 0xF, true)); }
                if (fr == 0) { SSQs[(size_t)srow * 8 + g] = s0; SSQs[(size_t)srow * 8 + 4 + g] = s1; } }
            if (cvt_next) { int w8 = 0; w8 = __builtin_amdgcn_cvt_pk_fp8_f32(tv[0] * tscale, tv[1] * tscale, w8, false); w8 = __builtin_amdgcn_cvt_pk_fp8_f32(tv[2] * tscale, tv[3] * tscale, w8, true);
                *(unsigned*)(tdst + ((size_t)tsl * 16384 + te) * 128) = (unsigned)w8; }
        }
        if (DBG_SELFCHECK) { for (int o = 1; o < 64; o <<= 1) { hBU += __shfl_xor((int)hBU, o); hXI += __shfl_xor((int)hXI, o); hY += __shfl_xor((int)hY, o); }
            unsigned* hs = (unsigned*)(p.ws + WS_CTL) + 65536 + (ys_off == WS_YS ? 0 : 8192) + unit * 4; unsigned hA = __float_as_uint(ar) * 7u + __float_as_uint(ai); for (int o = 1; o < 64; o <<= 1) hA += __shfl_xor((int)hA, o); if (lane == 0) { hs[0] = hBU; hs[1] = hXI; hs[2] = hA; } }
    }
}

__device__ __forceinline__ unsigned fkey(float f) { const unsigned u = __float_as_uint(f); return u ^ ((unsigned)((int)u >> 31) | 0x80000000u); }
__device__ __forceinline__ float kval(unsigned k) { const unsigned u = (k & 0x80000000u) ? (k ^ 0x80000000u) : ~k; return __uint_as_float(u); }
#define CE_DESC(a, b) do { const unsigned _mx = (a) > (b) ? (a) : (b), _mn = (a) > (b) ? (b) : (a); (a) = _mx; (b) = _mn; } while (0)
__device__ __forceinline__ void sort16_desc(unsigned (&a)[16]) {
#pragma unroll
    for (int kk = 1; kk <= 4; ++kk)
#pragma unroll
        for (int jj = kk - 1; jj >= 0; --jj)
#pragma unroll
            for (int i = 0; i < 16; ++i) { const int k = 1 << kk, j = 1 << jj, l2 = i ^ j;
                if (l2 > i) { if ((i & k) == 0) CE_DESC(a[i], a[l2]); else CE_DESC(a[l2], a[i]); } }
}
__device__ __forceinline__ void merge_top16(unsigned (&a)[16], const unsigned (&b)[16]) {
#pragma unroll
    for (int i = 0; i < 16; ++i) a[i] = a[i] > b[15 - i] ? a[i] : b[15 - i];
#pragma unroll
    for (int jj = 3; jj >= 0; --jj)
#pragma unroll
        for (int i = 0; i < 16; ++i) { const int j = 1 << jj, l2 = i ^ j; if (l2 > i) CE_DESC(a[i], a[l2]); }
}
__device__ __forceinline__ void phase_topk(const KP& p, LAS unsigned char* lds, int G) {
    const int tid = opaque_tid(), lane = tid & 63, w = __builtin_amdgcn_readfirstlane(tid >> 6), hh = lane >> 5;
    const int gw = blockIdx.x * 8 + w, ngw = G * 8;
    const bf16_t* Q = (const bf16_t*)(p.ws + WS_R0); const bf16_t* KEYS = (const bf16_t*)(p.ws + WS_KEYS);
    unsigned* SEL = (unsigned*)(p.ws + WS_SEL);
    LAS unsigned char* tab = lds + w * 2048 + lane * 32;
    const int CI[50] = {0,0,0,0,0,0,0,0,0,0,0,0,0,0,0,0, 1,1,1,1,1,1,1,1, 2,2,2,2,2, 3,3,3,3, 4,4,4, 5,5, 6,6, 7,7, 8,9,10,11,12,13,14,15};
    const int CJ[50] = {0,1,2,3,4,5,6,7,8,9,10,11,12,13,14,15, 0,1,2,3,4,5,6,7, 0,1,2,3,4, 0,1,2,3, 0,1,2, 0,1, 0,1, 0,1, 0,0,0,0,0,0,0,0};
    LAS unsigned char* kimg = lds + 16384;
    for (int h = 0; h < 8; ++h) {
      __syncthreads();
#pragma unroll
      for (int i = 0; i < 8; ++i) { const int ch = tid + 512 * i, row = ch >> 4, c16 = ch & 15;
          *(LAS u32x4*)(kimg + row * 272 + c16 * 16) = *(const u32x4*)(KEYS + (size_t)(h * 256 + row) * 128 + c16 * 8); }
      __syncthreads();
      for (int tg = gw; tg < 2048; tg += ngw) {
        const int t = tg * 32 + (lane & 31);
        unsigned top[2][16];
#pragma unroll
        for (int pp = 0; pp < 2; ++pp) {
            bf16x8 qf[8];
#pragma unroll
            for (int ks = 0; ks < 8; ++ks) qf[ks] = *(const bf16x8*)(Q + ((size_t)((((tg * 8 + h) * 2 + pp) * 8 + ks) * 64 + lane)) * 8);
            const LAS unsigned char* kb = kimg + (pp * 128 + (lane & 31)) * 272 + 16 * hh;
#pragma unroll
            for (int nt = 0; nt < 4; ++nt) {
                f32x16 acc;
#pragma unroll
                for (int i = 0; i < 16; ++i) acc[i] = 0.f;
#pragma unroll
                for (int ks = 0; ks < 8; ++ks) { const bf16x8 kf = *(const LAS bf16x8*)(kb + (32 * nt) * 272 + 32 * ks);
                    acc = __builtin_amdgcn_mfma_f32_32x32x16_bf16(kf, qf[ks], acc, 0, 0, 0); }
                unsigned ky[16];
#pragma unroll
                for (int r = 0; r < 16; ++r) ky[r] = (fkey(acc[r]) & ~127u) | (unsigned)(32 * nt + (r & 3) + 8 * (r >> 2)) | (unsigned)(4 * hh);
                sort16_desc(ky);
                if (nt == 0) {
#pragma unroll
                    for (int i = 0; i < 16; ++i) top[pp][i] = ky[i];
                } else merge_top16(top[pp], ky);
            }
            unsigned other[16];
#pragma unroll
            for (int i = 0; i < 16; ++i) { const u32x2 sw_ = __builtin_amdgcn_permlane32_swap(top[pp][i], top[pp][i], false, false); other[i] = hh ? sw_[0] : sw_[1]; }
            merge_top16(top[pp], other);
        }
        float sa[16], sb[16];
#pragma unroll
        for (int i = 0; i < 16; ++i) { sa[i] = kval(top[0][i] & ~127u); sb[i] = kval(top[1][i] & ~127u); }
        unsigned c0[16], c1[16];
#pragma unroll
        for (int s = 0; s < 32; ++s) {
            unsigned key = 0u;
            if (s < 25) {
                const float v0 = sa[CI[s]] + sb[CJ[s]], v1 = sa[CI[25 + s]] + sb[CJ[25 + s]];
                const unsigned k0 = (fkey(v0) & ~255u) | (unsigned)(CI[s] * 16 + CJ[s]), k1 = (fkey(v1) & ~255u) | (unsigned)(CI[25 + s] * 16 + CJ[25 + s]);
                key = hh ? k1 : k0;
            }
            if (s < 16) c0[s] = key; else c1[s - 16] = key;
        }
        sort16_desc(c0); sort16_desc(c1); merge_top16(c0, c1);
#pragma unroll
        for (int i = 0; i < 16; ++i) { const u32x2 sw_ = __builtin_amdgcn_permlane32_swap(c0[i], c0[i], false, false); c1[i] = hh ? sw_[0] : sw_[1]; }
        merge_top16(c0, c1);
        {
            u32x4 wa, wb;
#pragma unroll
            for (int q4 = 0; q4 < 4; ++q4) {
                wa[q4] = (top[0][4 * q4] & 127u) | ((top[0][4 * q4 + 1] & 127u) << 8) | ((top[0][4 * q4 + 2] & 127u) << 16) | ((top[0][4 * q4 + 3] & 127u) << 24);
                wb[q4] = (top[1][4 * q4] & 127u) | ((top[1][4 * q4 + 1] & 127u) << 8) | ((top[1][4 * q4 + 2] & 127u) << 16) | ((top[1][4 * q4 + 3] & 127u) << 24);
            }
            *(LAS u32x4*)tab = wa; *(LAS u32x4*)(tab + 16) = wb;
        }
        float ev[16], esum = 0.f; const float vmax = kval(c0[0] & ~255u);
#pragma unroll
        for (int k = 0; k < 16; ++k) { ev[k] = __expf(kval(c0[k] & ~255u) - vmax); esum += ev[k]; }
        const float rs = 1.0f / esum;
        LDS_WAIT();
        unsigned outw[8]; const unsigned hmask = hh ? 0xffffffffu : 0u;
#pragma unroll
        for (int kk = 0; kk < 8; ++kk) {
            const unsigned key = c0[kk] ^ ((c0[kk] ^ c0[8 + kk]) & hmask); const float e = __uint_as_float(__float_as_uint(ev[kk]) ^ ((__float_as_uint(ev[kk]) ^ __float_as_uint(ev[8 + kk])) & hmask));
            const unsigned code = key & 255u, ia = tab[code >> 4], ib = tab[16 + (code & 15u)];
            outw[kk] = (pk2(0.f, e * rs) & 0xffff0000u) | (ia * 128u + ib);
        }
        u32x4* dst = (u32x4*)(SEL + (size_t)t * 128 + h * 16 + hh * 8);
        dst[0] = (u32x4){outw[0], outw[1], outw[2], outw[3]}; dst[1] = (u32x4){outw[4], outw[5], outw[6], outw[7]};
        LDS_WAIT();
      }
    }
    __syncthreads();
}

__device__ __forceinline__ void fp8x4_to_f32(unsigned w, float& a, float& b, float& c, float& d) {
    const f32x2 lo = __builtin_amdgcn_cvt_pk_f32_fp8((int)w, false), hi = __builtin_amdgcn_cvt_pk_f32_fp8((int)w, true); a = lo[0]; b = lo[1]; c = hi[0]; d = hi[1];
}
struct XSlice { int sl, rank, nloc; };
__device__ __forceinline__ XSlice xslice_of_block(const KP& p, volatile LAS unsigned* MISC, int G) {
    unsigned* bar = (unsigned*)(p.ws + WS_CTL) + 4096; unsigned cnt[8]; unsigned tot = 0; bool ok = true;
#pragma unroll
    for (int j = 0; j < 8; ++j) { cnt[j] = xb_ld(&bar[XB_XCNT(j)]); tot += cnt[j]; ok = ok && (cnt[j] > 0u); }
    ok = ok && (tot == (unsigned)G);
    XSlice x;
    if (ok) { const unsigned myx = MISC[16]; x.sl = (int)myx; x.rank = (int)MISC[17]; x.nloc = (int)cnt[myx & 7u]; }
    else { x.sl = (int)(blockIdx.x & 7); x.rank = (int)(blockIdx.x >> 3); x.nloc = (G - x.sl + 7) >> 3; }
    x.sl = __builtin_amdgcn_readfirstlane(x.sl); x.rank = __builtin_amdgcn_readfirstlane(x.rank); x.nloc = __builtin_amdgcn_readfirstlane(x.nloc);
    return x;
}
__device__ __forceinline__ float dot16_fp8(const u32x4 u, const float (&hf)[16]) {
    float d = 0.f;
#pragma unroll
    for (int j = 0; j < 4; ++j) { float f0, f1, f2, f3; fp8x4_to_f32(u[j], f0, f1, f2, f3);
        d = __builtin_fmaf(f0, hf[4 * j], d); d = __builtin_fmaf(f1, hf[4 * j + 1], d); d = __builtin_fmaf(f2, hf[4 * j + 2], d); d = __builtin_fmaf(f3, hf[4 * j + 3], d); }
    return d;
}
typedef __bf16 bf16v8 __attribute__((ext_vector_type(8)));
__device__ __forceinline__ float dot16_fp8_bf16(const u32x4 u, const bf16v8 h0, const bf16v8 h1) {
    float d0 = 0.f, d1 = 0.f;
    d0 = __builtin_amdgcn_fdot2_f32_bf16(__builtin_amdgcn_cvt_scalef32_pk_bf16_fp8(u[0], 1.0f, false), __builtin_shufflevector(h0, h0, 0, 1), d0, false);
    d1 = __builtin_amdgcn_fdot2_f32_bf16(__builtin_amdgcn_cvt_scalef32_pk_bf16_fp8(u[0], 1.0f, true),  __builtin_shufflevector(h0, h0, 2, 3), d1, false);
    d0 = __builtin_amdgcn_fdot2_f32_bf16(__builtin_amdgcn_cvt_scalef32_pk_bf16_fp8(u[1], 1.0f, false), __builtin_shufflevector(h0, h0, 4, 5), d0, false);
    d1 = __builtin_amdgcn_fdot2_f32_bf16(__builtin_amdgcn_cvt_scalef32_pk_bf16_fp8(u[1], 1.0f, true),  __builtin_shufflevector(h0, h0, 6, 7), d1, false);
    d0 = __builtin_amdgcn_fdot2_f32_bf16(__builtin_amdgcn_cvt_scalef32_pk_bf16_fp8(u[2], 1.0f, false), __builtin_shufflevector(h1, h1, 0, 1), d0, false);
    d1 = __builtin_amdgcn_fdot2_f32_bf16(__builtin_amdgcn_cvt_scalef32_pk_bf16_fp8(u[2], 1.0f, true),  __builtin_shufflevector(h1, h1, 2, 3), d1, false);
    d0 = __builtin_amdgcn_fdot2_f32_bf16(__builtin_amdgcn_cvt_scalef32_pk_bf16_fp8(u[3], 1.0f, false), __builtin_shufflevector(h1, h1, 4, 5), d0, false);
    d1 = __builtin_amdgcn_fdot2_f32_bf16(__builtin_amdgcn_cvt_scalef32_pk_bf16_fp8(u[3], 1.0f, true),  __builtin_shufflevector(h1, h1, 6, 7), d1, false);
    return d0 + d1;
}
__device__ __forceinline__ float dpp_sum8(float d) {
    d += __uint_as_float(__builtin_amdgcn_update_dpp(0, __float_as_uint(d), 0xB1, 0xF, 0xF, true));
    d += __uint_as_float(__builtin_amdgcn_update_dpp(0, __float_as_uint(d), 0x4E, 0xF, 0xF, true));
    d += __uint_as_float(__builtin_amdgcn_update_dpp(0, __float_as_uint(d), 0x141, 0xF, 0xF, true));
    return d;
}
__device__ __forceinline__ void phase_expert_u(const KP& p, LAS unsigned char* lds, volatile LAS unsigned* MISC, int l, int G) {
    const int tid = opaque_tid(), lane = tid & 63, w = __builtin_amdgcn_readfirstlane(tid >> 6), j = lane >> 3, c = lane & 7, i16 = lane & 15, kq = lane >> 4;
    const XSlice xs = xslice_of_block(p, MISC, G);
    const unsigned char* XF = p.ws + WS_XF8 + (size_t)xs.sl * M * 128; const unsigned char* Us = p.ws + WS_U + (size_t)(l & 1) * TAB_BYTES + (size_t)xs.sl * 16384 * 128;
    const unsigned* SEL = (const unsigned*)(p.ws + WS_SEL); unsigned* PDu = (unsigned*)(p.ws + WS_R0) + (size_t)xs.sl * M * 64;
    const int t0 = xs.rank * 8 + w, tstep = xs.nloc * 8;
    LAS unsigned char* ring = lds + w * 18176;
    LAS unsigned char* selb = ring + 16384; LAS unsigned char* hbuf = ring + 16384 + 1024; LAS unsigned char* pdscr = ring + 16384 + 1024 + 512;
    const int tlast = t0 + ((M - 1 - t0) / tstep) * tstep;
    const int ai = (int)((0x5172023724663367ull >> (4 * i16)) & 7ull);
    const int ch0 = (ai ^ (2 * kq)) & 7, ch1 = ch0 ^ 1;
    const int rowoff = (i16 >> 3) * 1024 + (i16 & 7) * 128;
    const bool diag = kq == (i16 >> 2);
    LAS unsigned short* pdw = (LAS unsigned short*)pdscr + 16 * (i16 & 7) + (i16 >> 3);
#define E1_CL(t) ((t) <= tlast ? (t) : tlast)
#define E1_DMA_SEL(t, par) do { const unsigned* sp = SEL + (size_t)E1_CL(t) * 128 + lane; \
            __builtin_amdgcn_global_load_lds(sp, (LAS unsigned*)(selb + (par) * 512), 4, 0, 0); __builtin_amdgcn_global_load_lds(sp + 64, (LAS unsigned*)(selb + (par) * 512 + 256), 4, 0, 0); } while (0)
#define E1_DMA_H(t, par) do { __builtin_amdgcn_global_load_lds((const unsigned*)(XF + (size_t)E1_CL(t) * 128) + lane, (LAS unsigned*)(hbuf + (par) * 256), 4, 0, 0); } while (0)
#define E1_DMA_ROW(i, idxv) do { __builtin_amdgcn_global_load_lds((const unsigned*)(Us + (size_t)((idxv) & 0x3fffu) * 128 + 16 * c), (LAS unsigned*)(ring + (i) * 1024), 16, 0, 0); } while (0)
    if (t0 < M) {
        E1_DMA_SEL(t0, 0); E1_DMA_SEL(t0 + tstep, 1); E1_DMA_H(t0, 0);
        asm volatile("s_waitcnt vmcnt(0)" ::: "memory");
        { u32x4 s0[4];
#pragma unroll
          for (int q = 0; q < 4; ++q) s0[q] = *(const LAS u32x4*)(selb + (16 * j + 4 * q) * 4);
#pragma unroll
          for (int i = 0; i < 16; ++i) E1_DMA_ROW(i, s0[i >> 2][i & 3]); }
        { PDu[(size_t)t0 * 64 + lane] = 0u; }
        int par = 0;
        for (int tok = t0; tok < M; tok += tstep, par ^= 1) {
            E1_DMA_SEL(tok + 2 * tstep, par); E1_DMA_H(tok + tstep, par ^ 1);
            asm volatile("s_waitcnt vmcnt(19)" ::: "memory");
            u32x4 sn[4];
#pragma unroll
            for (int q = 0; q < 4; ++q) sn[q] = *(const LAS u32x4*)(selb + (par ^ 1) * 512 + (16 * j + 4 * q) * 4);
            const i32x4 xb0 = *(const LAS i32x4*)(hbuf + par * 256 + 16 * ch0), xb1 = *(const LAS i32x4*)(hbuf + par * 256 + 16 * ch1);
            const i32x8 B = __builtin_shufflevector(xb0, xb1, 0, 1, 2, 3, 4, 5, 6, 7);
#pragma unroll
            for (int i0 = 0; i0 < 16; i0 += 4) {
                asm volatile("s_waitcnt vmcnt(16)" ::: "memory");
                const LAS unsigned char* rb = ring + i0 * 1024 + rowoff;
                const i32x4 a0 = *(const LAS i32x4*)(rb + 16 * ch0), a1 = *(const LAS i32x4*)(rb + 16 * ch1), a2 = *(const LAS i32x4*)(rb + 2048 + 16 * ch0), a3 = *(const LAS i32x4*)(rb + 2048 + 16 * ch1);
                asm volatile("s_waitcnt lgkmcnt(0)" ::: "memory");
#pragma unroll
                for (int r = 0; r < 4; ++r) E1_DMA_ROW(i0 + r, sn[(i0 + r) >> 2][(i0 + r) & 3]);
                const f32x4 z = {0.f, 0.f, 0.f, 0.f};
                const f32x4 d0 = __builtin_amdgcn_mfma_scale_f32_16x16x128_f8f6f4(__builtin_shufflevector(a0, a1, 0, 1, 2, 3, 4, 5, 6, 7), B, z, 0, 0, 0, 0x7f7f7f7f, 0, 0x7f7f7f7f);
                const f32x4 d1 = __builtin_amdgcn_mfma_scale_f32_16x16x128_f8f6f4(__builtin_shufflevector(a2, a3, 0, 1, 2, 3, 4, 5, 6, 7), B, z, 0, 0, 0, 0x7f7f7f7f, 0, 0x7f7f7f7f);
                const float v0 = (i16 & 2) ? ((i16 & 1) ? d0[3] : d0[2]) : ((i16 & 1) ? d0[1] : d0[0]), v1 = (i16 & 2) ? ((i16 & 1) ? d1[3] : d1[2]) : ((i16 & 1) ? d1[1] : d1[0]);
                if (diag) { pdw[i0] = (unsigned short)(pk2(v0, 0.f) & 0xffffu); pdw[i0 + 2] = (unsigned short)(pk2(v1, 0.f) & 0xffffu); }
            }
            asm volatile("s_waitcnt lgkmcnt(0)" ::: "memory");
            PDu[(size_t)tok * 64 + lane] = *(const LAS unsigned*)(pdscr + 4 * lane);
        }
        asm volatile("s_waitcnt vmcnt(0)" ::: "memory");
    }
#undef E1_CL
#undef E1_DMA_SEL
#undef E1_DMA_H
#undef E1_DMA_ROW
}
__device__ __forceinline__ void phase_expert_w(const KP& p, int G) {
    const int tid = opaque_tid(), lane = tid & 63, w = __builtin_amdgcn_readfirstlane(tid >> 6);
    const int gw = blockIdx.x * 8 + w, ngw = G * 8;
    unsigned* SEL = (unsigned*)(p.ws + WS_SEL); const unsigned* PDu = (const unsigned*)(p.ws + WS_R0);
    for (int tok0 = gw; tok0 < M; tok0 += 4 * ngw) {
        unsigned pw[4][8]; u32x2 s2[4];
#pragma unroll
        for (int k = 0; k < 4; ++k) { const int tok = (tok0 + k * ngw < M) ? tok0 + k * ngw : tok0;
#pragma unroll
            for (int sl = 0; sl < 8; ++sl) pw[k][sl] = PDu[((size_t)sl * M + tok) * 64 + lane];
            s2[k] = *(const u32x2*)(SEL + (size_t)tok * 128 + 2 * lane); }
#pragma unroll
        for (int k = 0; k < 4; ++k) { const int tok = tok0 + k * ngw;
            f32x2 d = {0.f, 0.f};
#pragma unroll
            for (int sl = 0; sl < 8; ++sl) { d[0] += bflo(pw[k][sl]); d[1] += bfhi(pw[k][sl]); }
            const float w0 = __uint_as_float(s2[k][0] & 0xffff0000u) * fgelu(d[0] * (1.0f / (U_SCALE * X_SCALE))) * (1.0f / V_SCALE);
            const float w1 = __uint_as_float(s2[k][1] & 0xffff0000u) * fgelu(d[1] * (1.0f / (U_SCALE * X_SCALE))) * (1.0f / V_SCALE);
            u32x2 o; o[0] = (pk2(0.f, w0) & 0xffff0000u) | (s2[k][0] & 0x3fffu); o[1] = (pk2(0.f, w1) & 0xffff0000u) | (s2[k][1] & 0x3fffu);
            if (tok < M) *(u32x2*)(SEL + (size_t)tok * 128 + 2 * lane) = o; }
    }
}
__device__ __forceinline__ void phase_expert_v(const KP& p, LAS unsigned char* lds, volatile LAS unsigned* MISC, int l, int G) {
    const int tid = opaque_tid(), lane = tid & 63, w = __builtin_amdgcn_readfirstlane(tid >> 6), j = lane >> 3, c = lane & 7;
    const XSlice xs = xslice_of_block(p, MISC, G);
    const unsigned char* Vs = p.ws + WS_V + (size_t)(l & 1) * TAB_BYTES + (size_t)xs.sl * 16384 * 128;
    const unsigned* SEL = (const unsigned*)(p.ws + WS_SEL);
    const float* g2 = (const float*)(p.ws + WS_MOD) + (size_t)l * 32 * NMODC + 5120;
    const bf16_t* X = (const bf16_t*)p.out; bf16_t* XO = (l == DEPTH - 1) ? (bf16_t*)(p.ws + WS_YS) : (bf16_t*)p.out;
    const int t0 = xs.rank * 8 + w, tstep = xs.nloc * 8;
    const bool b3 = (lane & 8) != 0;
    LAS unsigned char* ring = lds + w * 17920; LAS unsigned char* selb = ring + 16384;
    const int tlast = t0 + ((M - 1 - t0) / tstep) * tstep;
#define E2_CL(t) ((t) <= tlast ? (t) : tlast)
#define E2_DMA_SEL(t, par) do { const unsigned* sp = SEL + (size_t)E2_CL(t) * 128 + lane; \
            __builtin_amdgcn_global_load_lds(sp, (LAS unsigned*)(selb + (par) * 512), 4, 0, 0); __builtin_amdgcn_global_load_lds(sp + 64, (LAS unsigned*)(selb + (par) * 512 + 256), 4, 0, 0); } while (0)
#define E2_DMA_ROW(i, idxv) do { __builtin_amdgcn_global_load_lds((const unsigned*)(Vs + (size_t)((idxv) & 0x3fffu) * 128 + 16 * c), (LAS unsigned*)(ring + (i) * 1024), 16, 0, 0); } while (0)
    if (t0 < M) {
        E2_DMA_SEL(t0, 0); E2_DMA_SEL(t0 + tstep, 1);
        asm volatile("s_waitcnt vmcnt(0)" ::: "memory");
        u32x4 sc[4];
#pragma unroll
        for (int q = 0; q < 4; ++q) sc[q] = *(const LAS u32x4*)(selb + (16 * j + 4 * q) * 4);
#pragma unroll
        for (int i = 0; i < 16; ++i) E2_DMA_ROW(i, sc[i >> 2][i & 3]);
        LAS float* xbuf = (LAS float*)(ring + 16384 + 1024);
        { const bf16_t* xd = X + (size_t)t0 * D + xs.sl * 128 + 16 * c + 2 * j; __builtin_amdgcn_global_load_lds((const unsigned*)xd, (LAS unsigned*)xbuf, 4, 0, 0); }
        int par = 0, bcur = -1; f32x2 gv = {0.f, 0.f};
        for (int tok = t0; tok < M; tok += tstep, par ^= 1) {
            const int dim = xs.sl * 128 + 16 * c + 2 * j;
            const size_t xo = (size_t)tok * D + dim;
            if ((tok >> 11) != bcur) { bcur = tok >> 11; const f32x2 gl = *(const f32x2*)(g2 + (size_t)bcur * NMODC + dim); asm volatile("s_waitcnt vmcnt(0)" ::: "memory"); gv[0] = gl[0] * 1.0f; gv[1] = gl[1] * 1.0f; asm volatile("" : "+v"(gv)); }
            E2_DMA_SEL(tok + 2 * tstep, par);
            __builtin_amdgcn_global_load_lds((const unsigned*)(X + xo), (LAS unsigned*)xbuf, 4, 0, 0);
            asm volatile("s_waitcnt vmcnt(20)" ::: "memory");
            u32x4 sn[4];
#pragma unroll
            for (int q = 0; q < 4; ++q) sn[q] = *(const LAS u32x4*)(selb + (par ^ 1) * 512 + (16 * j + 4 * q) * 4);
            f32x2 o2[8];
#pragma unroll
            for (int q = 0; q < 8; ++q) o2[q] = (f32x2){0.f, 0.f};
#pragma unroll
            for (int i0 = 0; i0 < 16; i0 += 4) {
                asm volatile("s_waitcnt vmcnt(16)" ::: "memory");
                u32x4 row[4];
#pragma unroll
                for (int r = 0; r < 4; ++r) row[r] = *(const LAS u32x4*)(ring + (i0 + r) * 1024 + 16 * lane);
                asm volatile("s_waitcnt lgkmcnt(0)" ::: "memory");
#pragma unroll
                for (int r = 0; r < 4; ++r) E2_DMA_ROW(i0 + r, sn[(i0 + r) >> 2][(i0 + r) & 3]);
                {
                    const u32x2 wA = {sc[i0 >> 2][0], sc[i0 >> 2][1]}, wB = {sc[i0 >> 2][2], sc[i0 >> 2][3]};
#pragma unroll
                    for (int r = 0; r < 4; ++r)
#pragma unroll
                        for (int q = 0; q < 4; ++q) { const f32x2 lo = __builtin_amdgcn_cvt_pk_f32_fp8((int)row[r][q], false), hi = __builtin_amdgcn_cvt_pk_f32_fp8((int)row[r][q], true);
                            if (r & 1) { asm("v_pk_fma_f32 %0, %1, %2, %0 op_sel:[1,0,0] op_sel_hi:[1,1,1]" : "+v"(o2[2 * q]) : "v"(r < 2 ? wA : wB), "v"(lo));
                                         asm("v_pk_fma_f32 %0, %1, %2, %0 op_sel:[1,0,0] op_sel_hi:[1,1,1]" : "+v"(o2[2 * q + 1]) : "v"(r < 2 ? wA : wB), "v"(hi)); }
                            else       { asm("v_pk_fma_f32 %0, %1, %2, %0 op_sel:[0,0,0] op_sel_hi:[0,1,1]" : "+v"(o2[2 * q]) : "v"(r < 2 ? wA : wB), "v"(lo));
                                         asm("v_pk_fma_f32 %0, %1, %2, %0 op_sel:[0,0,0] op_sel_hi:[0,1,1]" : "+v"(o2[2 * q + 1]) : "v"(r < 2 ? wA : wB), "v"(hi)); } }
                }
            }
            float o[16];
#pragma unroll
            for (int q = 0; q < 8; ++q) { o[2 * q] = o2[q][0]; o[2 * q + 1] = o2[q][1]; }
            float r8[8], r4[4], r2[2];
#pragma unroll
            for (int k = 0; k < 8; ++k) { const u32x2 sw = __builtin_amdgcn_permlane32_swap(__float_as_uint(o[k]), __float_as_uint(o[8 + k]), false, false); r8[k] = __uint_as_float(sw[0]) + __uint_as_float(sw[1]); }
#pragma unroll
            for (int k = 0; k < 4; ++k) { const u32x2 sw = __builtin_amdgcn_permlane16_swap(__float_as_uint(r8[k]), __float_as_uint(r8[4 + k]), false, false); r4[k] = __uint_as_float(sw[0]) + __uint_as_float(sw[1]); }
#pragma unroll
            for (int k = 0; k < 2; ++k) { const float keep = b3 ? r4[2 + k] : r4[k], send = b3 ? r4[k] : r4[2 + k];
                r2[k] = keep + __uint_as_float(__builtin_amdgcn_update_dpp(0, __float_as_uint(send), 0x128, 0xF, 0xF, true)); }
            asm volatile("s_waitcnt vmcnt(16)" ::: "memory");
            { const unsigned xw = __float_as_uint(xbuf[lane]); *(unsigned*)(XO + xo) = pk2(bflo(xw) + gv[0] * r2[0], bfhi(xw) + gv[1] * r2[1]); }
#pragma unroll
            for (int q = 0; q < 4; ++q) sc[q] = sn[q];
        }
        asm volatile("s_waitcnt vmcnt(0)" ::: "memory");
    }
#undef E2_CL
#undef E2_DMA_SEL
#undef E2_DMA_ROW
}

__device__ __forceinline__ void phase_final(const KP& p, int G) {
    const int tid = opaque_tid(), lane = tid & 63, w = __builtin_amdgcn_readfirstlane(tid >> 6);
    const int gw = blockIdx.x * 8 + w, ngw = G * 8;
    const float* fg = p.in[I_FG];
    for (int r0 = gw * 4; r0 < M; r0 += ngw * 4) {
        f32x4 v[4][4]; float ss[4];
#pragma unroll
        for (int i = 0; i < 4; ++i) { const u32x2* xr = (const u32x2*)((const bf16_t*)(p.ws + WS_YS) + (size_t)(r0 + i) * D) + lane;
#pragma unroll
            for (int j = 0; j < 4; ++j) { const u32x2 xw = xr[64 * j]; v[i][j] = (f32x4){bflo(xw[0]), bfhi(xw[0]), bflo(xw[1]), bfhi(xw[1])}; } }
#pragma unroll
        for (int i = 0; i < 4; ++i) { float t = 0.f;
#pragma unroll
            for (int j = 0; j < 4; ++j) t += (v[i][j][0] * v[i][j][0] + v[i][j][1] * v[i][j][1]) + (v[i][j][2] * v[i][j][2] + v[i][j][3] * v[i][j][3]);
            ss[i] = t; }
#pragma unroll
        for (int o = 1; o < 64; o <<= 1) {
#pragma unroll
            for (int i = 0; i < 4; ++i) ss[i] += __shfl_xor(ss[i], o); }
#pragma unroll
        for (int j = 0; j < 4; ++j) { const f32x4 g4 = *(const f32x4*)(fg + 256 * j + 4 * lane);
#pragma unroll
            for (int i = 0; i < 4; ++i) { const float rstd = __builtin_amdgcn_rsqf(ss[i] * (1.0f / D) + EPS); ((f32x4*)(p.out + (size_t)(r0 + i) * D) + lane)[64 * j] = v[i][j] * rstd * g4; } }
    }
}

__global__ void __launch_bounds__(512, 2) mk_fwd(KP p_) {
    extern __shared__ __attribute__((aligned(16))) unsigned char lds_raw[];
    LAS unsigned char* lds = (LAS unsigned char*)lds_raw;
    const int tid = threadIdx.x, G = gridDim.x;
    volatile LAS unsigned* MISC = (volatile LAS unsigned*)(lds + MISC_OFF);
    for (int i = tid; i < LDS_BYTES / 4; i += 512) ((LAS unsigned*)lds)[i] = 0u;
    __syncthreads();
    XcdBarrier bar = xcd_barrier_post((unsigned*)(p_.ws + WS_CTL) + 4096, MISC + 8);
    if (tid == 0) { const unsigned myx = xb_xcc_id(); MISC[16] = myx; MISC[17] = xb_add((unsigned*)(p_.ws + WS_CTL) + 8192 + 64 * (myx & 15u), 1u); }
    __syncthreads();
    const int lo = p_.gp_lo, hi = p_.gp_hi;
#ifndef PH_MASK
#define PH_MASK 0xFFFFF
#endif
#define IN(k) (lo <= (k) && (k) < hi)
#define EN(b) ((PH_MASK >> (b)) & 1)
#ifndef PH_REPEAT
#define PH_REPEAT 0
#endif
#define NREP(b) (((PH_REPEAT >> (b)) & 1) ? 2 : 1)
#define SEAM(k) do { if ((k) + 1 < hi) xcd_barrier(bar); } while (0)
    if (EN(12) && IN(GP_SETUP)) { const KP p = load_kp(); phase_setup(p, lds, G); SEAM(GP_SETUP); }
    for (int l = 0; l < DEPTH; ++l) {
        const int g0 = 1 + l * NPH;
        if (EN(0) && IN(g0 + 0)) { _Pragma("nounroll") for (int rep = 0; rep < NREP(0); ++rep) { const KP p = load_kp(); phase_conv_norm1(p, lds, l, G); } SEAM(g0 + 0); }
        if (EN(1) && IN(g0 + 1)) { const KP p = load_kp();
            pg8::Gemm g{(const bf16_t*)(p.ws + WS_H), (const bf16_t*)(p.ws + WS_WIN), M, 3072, D / 2, D / 2, D / 2}; pg8::StaticOrder S; S.init(M, 3072, G, (int)blockIdx.x);
            pg8::EpiStoreBf16 E{(bf16_t*)(p.ws + WS_R0), 3072, 1.0f / (WIN_SCALE * HIN_SCALE)};
            _Pragma("nounroll") for (int rep = 0; rep < NREP(1); ++rep) pg8::gemm_phase<pg8::EpiStoreBf16, pg8::StaticOrder, false, true, true>(lds, g, S, E);
            SEAM(g0 + 1);
        }
        if (EN(2) && IN(g0 + 2)) { _Pragma("nounroll") for (int rep = 0; rep < NREP(2); ++rep) { const KP p = load_kp(); phase_hgrn2(p, lds, l, G); } SEAM(g0 + 2); }
        if (EN(3) && IN(g0 + 3)) { const KP p = load_kp();
            pg8::Gemm g{(const bf16_t*)(p.ws + WS_H), (const bf16_t*)(p.ws + WS_WIN) + (size_t)3072 * (D / 2), M, 4096, D / 2, D / 2, D / 2}; pg8::StaticOrder S; S.init(M, 4096, G, (int)blockIdx.x);
            pg8::EpiStoreBf16 E{(bf16_t*)(p.ws + WS_R0), 4096, 1.0f / (WIN_SCALE * HIN_SCALE)};
            _Pragma("nounroll") for (int rep = 0; rep < NREP(3); ++rep) pg8::gemm_phase<pg8::EpiStoreBf16, pg8::StaticOrder, false, true, true>(lds, g, S, E);
            SEAM(g0 + 3);
        }
        #if DBG_SELFCHECK
        if (EN(4) && IN(g0 + 4)) {
#pragma nounroll
            for (int rep = 0; rep < 2; ++rep) { const KP p = load_kp(); size_t yo = rep ? WS_H : WS_YS; asm volatile("" : "+s"(yo)); phase_s5(p, lds, l, G, yo); SEAM(g0 + 4); }
            const KP p = load_kp();
            const unsigned* a = (const unsigned*)(p.ws + WS_YS); const unsigned* b2 = (const unsigned*)(p.ws + WS_H); unsigned bad = 0;
            for (size_t i = (size_t)blockIdx.x * 512 + opaque_tid(); i < (size_t)M * D / 2; i += (size_t)G * 512) bad += (a[i] != b2[i]) ? 1u : 0u;
            if (bad) atomicAdd((unsigned*)(p.ws + WS_CTL) + 64, bad);
            { const unsigned* h1 = (const unsigned*)(p.ws + WS_CTL) + 65536; const unsigned* h2 = h1 + 8192; const int u2 = blockIdx.x * 512 + opaque_tid();
              if (u2 < 2048) { if (h1[u2 * 4] != h2[u2 * 4]) atomicAdd((unsigned*)(p.ws + WS_CTL) + 128, 1u); if (h1[u2 * 4 + 1] != h2[u2 * 4 + 1]) atomicAdd((unsigned*)(p.ws + WS_CTL) + 192, 1u); if (h1[u2 * 4 + 2] != h2[u2 * 4 + 2]) atomicAdd((unsigned*)(p.ws + WS_CTL) + 256, 1u); } }
            SEAM(g0 + 4); }
#else
        if (EN(4) && IN(g0 + 4)) { _Pragma("nounroll") for (int rep = 0; rep < NREP(4); ++rep) { const KP p = load_kp(); phase_s5(p, lds, l, G, WS_YS); } SEAM(g0 + 4); }
#endif
        if (EN(5) && IN(g0 + 5)) { const KP p = load_kp();
            pg8::Gemm g{(const bf16_t*)(p.ws + WS_YS), (const bf16_t*)(p.ws + WS_WGLU), M, D, D, D, D}; pg8::StaticOrder S; S.init(M, D, G, (int)blockIdx.x);
            pg8::EpiGlu E{(const bf16_t*)(p.ws + WS_R0), (const bf16_t*)(p.ws + WS_YS), (const bf16_t*)(p.ws + WS_OR), (const float*)(p.ws + WS_SSQ), p.in[I_HNG] + l * 128, p.in[I_GLUB] + l * D, (bf16_t*)(p.ws + WS_H)};
            _Pragma("nounroll") for (int rep = 0; rep < NREP(5); ++rep) pg8::gemm_phase<pg8::EpiGlu, pg8::StaticOrder, true, true>(lds, g, S, E);
            SEAM(g0 + 5);
        }
        if (EN(6) && IN(g0 + 6)) { const KP p = load_kp();
            pg8::Gemm g{(const bf16_t*)(p.ws + WS_H), (const bf16_t*)(p.ws + WS_WOUT), M, D, D / 2, D / 2, D / 2}; pg8::StaticOrder S; S.init(M, D, G, (int)blockIdx.x);
            pg8::EpiStoreBf16 E{(bf16_t*)(p.ws + WS_OR), D, 1.0f / (WO_SCALE * MG_SCALE)};
            pg8::gemm_phase<pg8::EpiStoreBf16, pg8::StaticOrder, false, true, true>(lds, g, S, E);
            SEAM(g0 + 6);
        }
        if (EN(7) && IN(g0 + 7)) { const KP p = load_kp();
            const int t2 = opaque_tid(), lane = t2 & 63, wave = __builtin_amdgcn_readfirstlane(t2 >> 6);
            if (l == 0) resid_norm_rows<false>(p.in[I_X], (bf16_t*)p.out, (const bf16_t*)(p.ws + WS_OR), (bf16_t*)(p.ws + WS_H), p.ws + WS_XF8, p.in[I_N2G] + l * D, (const float*)(p.ws + WS_MOD) + (size_t)l * 32 * NMODC, blockIdx.x * 8 + wave, G * 8, lane);
            else resid_norm_rows<true>(p.out, (bf16_t*)p.out, (const bf16_t*)(p.ws + WS_OR), (bf16_t*)(p.ws + WS_H), p.ws + WS_XF8, p.in[I_N2G] + l * D, (const float*)(p.ws + WS_MOD) + (size_t)l * 32 * NMODC, blockIdx.x * 8 + wave, G * 8, lane);
            SEAM(g0 + 7);
        }
        if (EN(8) && IN(g0 + 8)) { const KP p = load_kp();
            pg8::Gemm g{(const bf16_t*)(p.ws + WS_H), (const bf16_t*)(p.ws + WS_WQ), M, 2048, D, D, D}; pg8::StaticOrder S; S.init(M, 2048, G, (int)blockIdx.x);
            pg8::EpiStoreQ E{(bf16_t*)(p.ws + WS_R0)};
            _Pragma("nounroll") for (int rep = 0; rep < NREP(8); ++rep) pg8::gemm_phase<pg8::EpiStoreQ, pg8::StaticOrder, true, true>(lds, g, S, E);
            SEAM(g0 + 8);
        }
        if (EN(9) && IN(g0 + 9)) { _Pragma("nounroll") for (int rep = 0; rep < NREP(9); ++rep) { const KP p = load_kp(); phase_topk(p, lds, G); } SEAM(g0 + 9); }
        if (EN(10) && IN(g0 + 10)) {
            { const KP p = load_kp(); phase_expert_u(p, lds, MISC, l, G); } xcd_barrier(bar);
            { const KP p = load_kp(); phase_expert_w(p, G); } xcd_barrier(bar);
            { const KP p = load_kp(); phase_expert_v(p, lds, MISC, l, G); }
            SEAM(g0 + 10); }
    }
    if (EN(13) && IN(GP_FINAL)) { const KP p = load_kp(); phase_final(p, G); }
#undef IN
#undef EN
#undef NREP
#undef SEAM
}

extern "C" void kernel_launch(void* const* d_in, const int* in_sizes, int n_in, void* d_out, int out_size, void* d_ws, size_t ws_size, hipStream_t stream) {
    static int grid = 0;
    if (grid == 0) {
        if (n_in != 25 || out_size != M * D || ws_size < WS_END) { fprintf(stderr, "kernel_launch: unexpected shapes (n_in %d, out %d, ws %zu < %zu)\n", n_in, out_size, ws_size, (size_t)WS_END); grid = -1; return; }
        int dev = 0, cus = 0, per_cu = 0;
        if (hipGetDevice(&dev) != hipSuccess || hipDeviceGetAttribute(&cus, hipDeviceAttributeMultiprocessorCount, dev) != hipSuccess) { grid = -1; return; }
        if (hipFuncSetAttribute((const void*)mk_fwd, hipFuncAttributeMaxDynamicSharedMemorySize, LDS_BYTES) != hipSuccess) { fprintf(stderr, "kernel_launch: hipFuncSetAttribute failed\n"); grid = -1; return; }
        if (hipOccupancyMaxActiveBlocksPerMultiprocessor(&per_cu, (const void*)mk_fwd, 512, LDS_BYTES) != hipSuccess || per_cu < 1) fprintf(stderr, "kernel_launch: occupancy query says %d\n", per_cu);
        (void)hipGetLastError();
        grid = cus;
    }
    if (grid < 0) return;
    (void)hipMemsetAsync((char*)d_ws + WS_CTL, 0, CTL_ZERO_BYTES, stream);
    KP a{};
    for (int i = 0; i < 25; ++i) a.in[i] = (const float*)d_in[i];
    a.out = (float*)d_out; a.ws = (unsigned char*)d_ws;
#if MK_LAUNCHES == 1
    a.gp_lo = 0; a.gp_hi = GP_END;
    hipLaunchKernelGGL(mk_fwd, dim3(grid), dim3(512), LDS_BYTES, stream, a);
#else
    for (int gp = 0; gp < GP_END; ++gp) { a.gp_lo = gp; a.gp_hi = gp + 1; hipLaunchKernelGGL(mk_fwd, dim3(grid), dim3(512), LDS_BYTES, stream, a); }
#endif
}
```

```cpp
#include <hip/hip_runtime.h>
#include <cstdio>
#include <cstdint>

#define DBG_HASHSEL 0
#define DBG_H2_FROM_INPUT 0
#define DBG_NO_YA 0
#define DBG_NO_YB 0
#define DBG_NO_ACC 0
#define DBG_NO_GB 0
#define DBG_S5_NOSSM 0
#define DBG_S5_NOREC 0
#define DBG_SELFCHECK 0
#ifndef MK_LAUNCHES
#define MK_LAUNCHES 1
#endif

#define LAS __attribute__((address_space(3)))
typedef unsigned short bf16_t;
typedef short bf16x8 __attribute__((ext_vector_type(8)));
typedef float f32x2 __attribute__((ext_vector_type(2)));
typedef float f32x4 __attribute__((ext_vector_type(4)));
typedef float f32x16 __attribute__((ext_vector_type(16)));
typedef unsigned u32x2 __attribute__((ext_vector_type(2)));
typedef unsigned u32x4 __attribute__((ext_vector_type(4)));
typedef __bf16 bf16v2 __attribute__((ext_vector_type(2)));
typedef int i32x8 __attribute__((ext_vector_type(8)));
typedef int i32x4 __attribute__((ext_vector_type(4)));
typedef int i32x2 __attribute__((ext_vector_type(2)));

constexpr int D = 1024, BATCH = 32, SEQ = 2048, DEPTH = 4, M = BATCH * SEQ;
constexpr int INC = 7168, NMODC = 6 * D;
constexpr int NPH = 11, GP_SETUP = 0, GP_FINAL = 1 + DEPTH * NPH, GP_END = GP_FINAL + 1;
constexpr float EPS = 1e-6f;
constexpr float U_SCALE = 64.0f, V_SCALE = 4.0f;
constexpr size_t TAB_BYTES = (size_t)16384 * 1024;
constexpr float WIN_SCALE = 64.0f, HIN_SCALE = 4.0f;
constexpr float X_SCALE = 8.0f;
constexpr float W8_SCALE = 512.0f;
constexpr float WO_SCALE = 64.0f, MG_SCALE = 8.0f;

constexpr size_t MiB = 1u << 20;
constexpr size_t WS_CTL = 0, CTL_ZERO_BYTES = 1 * MiB;
constexpr size_t WS_MOD = 1 * MiB;
constexpr size_t WS_LB = 4 * MiB;
constexpr size_t WS_ABAR = 4 * MiB + 65536;
constexpr size_t WS_BOP = 5 * MiB;
constexpr size_t WS_COP = 6 * MiB;
constexpr size_t WS_WIN = 8 * MiB;
constexpr size_t WS_WGLU = 22 * MiB;
constexpr size_t WS_WOUT = 24 * MiB;
constexpr size_t WS_WQ = 26 * MiB;
constexpr size_t WS_KEYS = 30 * MiB;
constexpr size_t WS_U = 32 * MiB;
constexpr size_t WS_V = 64 * MiB;
constexpr size_t WS_H = 96 * MiB;
constexpr size_t WS_OR = 224 * MiB;
constexpr size_t WS_SSQ = 352 * MiB;
constexpr size_t WS_R0 = 354 * MiB;
constexpr size_t WS_SEL = WS_R0 + 256 * MiB;
constexpr size_t WS_XF8 = WS_R0 + 352 * MiB;
constexpr size_t WS_WF8 = WS_R0 + 416 * MiB;
constexpr size_t WS_YS = WS_R0 + 512 * MiB;
constexpr size_t WS_END = WS_YS + 128 * MiB;

constexpr int LDS_BYTES = 163840;
constexpr int MISC_OFF = LDS_BYTES - 256;

__device__ __forceinline__ unsigned pk2(float lo, float hi) { f32x2 v = {lo, hi}; bf16v2 r = __builtin_convertvector(v, bf16v2); return __builtin_bit_cast(unsigned, r); }
__device__ __forceinline__ float bflo(unsigned w) { return __uint_as_float(w << 16); }
__device__ __forceinline__ float bfhi(unsigned w) { return __uint_as_float(w & 0xffff0000u); }
__device__ __forceinline__ float fsigmoid(float x) { return __builtin_amdgcn_rcpf(1.0f + __expf(-x)); }
__device__ __forceinline__ float fsilu(float x) { return x * fsigmoid(x); }
__device__ __forceinline__ float fgelu(float x) { return x * fsigmoid(1.5957691216f * (x + 0.044715f * x * x * x)); }
__device__ __forceinline__ float wave_sum(float v) {
#pragma unroll
    for (int o = 1; o < 64; o <<= 1) v += __shfl_xor(v, o);
    return v;
}
#define LDS_WAIT() asm volatile("s_waitcnt lgkmcnt(0)" ::: "memory")
__device__ __forceinline__ float dpp_sum8(float d);
__device__ __forceinline__ int opaque_tid() { int t = threadIdx.x; asm volatile("" : "+v"(t)); return t; }

namespace pg8 {
#define PG8_LAS __attribute__((address_space(3)))
constexpr int BM = 256, BK = 64, HALF = 128, HTB = HALF * BK * 2, STAGE_BYTES = 8 * HTB, NXCD = 8, WGM = 8;
__host__ __device__ __forceinline__ int lds_byte(int r, int c) { const int st = (r >> 4) * 2 + (c >> 5), rr = r & 15, cc = c & 31, ob = rr * 64 + cc * 2; return st * 1024 + (ob ^ (((ob >> 9) & 1) << 5)); }
__host__ __device__ __forceinline__ void stage_rc(int b, int& R, int& C) { const int st = b / 1024, sb = b % 1024, swz = sb ^ (((sb >> 9) & 1) << 5); R = (st >> 1) * 16 + swz / 64; C = (st & 1) * 32 + (swz % 64) / 2; }
__host__ __device__ __forceinline__ int perm32(int rho) { const int n = rho >> 4, i = rho & 15; return 8 * (i >> 2) + 4 * n + (i & 3); }
struct Unit { int pm, pn; };
struct Gemm { const bf16_t* A; const bf16_t* Bt; int M, N, K, lda, ldb; };
struct StaticOrder {
    int nM, nN, nwg, G, c;
    __host__ __device__ void init(int M_, int N_, int G_, int c_) { nM = M_ / BM; nN = N_ / BM; nwg = nM * nN; G = G_; c = c_; }
    __host__ __device__ bool next(int i, Unit& u) const {
        const long L = (long)i * G + c; if (L >= nwg) return false;
        int wgid = (int)L; { const int q = nwg / NXCD, r = nwg % NXCD, xcd = wgid % NXCD, off = wgid / NXCD; wgid = (xcd < r ? xcd * (q + 1) : r * (q + 1) + (xcd - r) * q) + off; }
        const int nig = WGM * nN, gid = wgid / nig, fm = gid * WGM, gsz = (nM - fm) < WGM ? (nM - fm) : WGM;
        u.pm = fm + ((wgid % nig) % gsz); u.pn = (wgid % nig) / gsz; return true;
    }
    __device__ __forceinline__ void a_ready(const Unit&) const {}
    __device__ __forceinline__ void done(const Unit&) const {}
};
template <class Epi, class Sched, bool ALIGN_EPI = false, bool SP2 = false, bool F8 = false>
__device__ __forceinline__ void gemm_phase(PG8_LAS unsigned char* lds, const Gemm g, const Sched& S, const Epi& E) {
    const int tid = opaque_tid(), wid = __builtin_amdgcn_readfirstlane(tid >> 6), lane = tid & 63, wr = wid >> 2, wc = wid & 3, fr = lane & 15, fq = lane >> 4;
    const int K = g.K, nt = K / BK;
    unsigned voffA[2], voffB[2];
#pragma unroll
    for (int i = 0; i < 2; ++i) { int R, C; stage_rc(tid * 16 + i * 8192, R, C); const int Rb = Epi::PERM ? ((R & ~31) + perm32(R & 31)) : R;
        voffA[i] = (unsigned)(R * g.lda + C) * 2u; voffB[i] = (unsigned)(Rb * g.ldb + C) * 2u; }
    const size_t kstep = (size_t)(BK * 2);
    const size_t hstepA = (size_t)HALF * g.lda * 2, hstepB = (size_t)HALF * g.ldb * 2;
    const size_t tstepA = 2 * hstepA, tstepB = 2 * hstepB;
    const unsigned ldsw = (unsigned)wid * 1024u;
    const int aoff = lds_byte(wr * 64 + fr, fq * 8), boff = lds_byte(wc * 32 + fr, fq * 8);
#define PG8_SA(b, h) (((b) * 2 + (h)) * HTB)
#define PG8_SB(b, h) ((4 + (b) * 2 + (h)) * HTB)
#define PG8_STAGE(bufoff, gbase, voff) do { _Pragma("unroll") for (int _i = 0; _i < 2; ++_i) \
        __builtin_amdgcn_global_load_lds((const unsigned*)((const char*)(gbase) + (voff)[_i]), (PG8_LAS unsigned*)(lds + (bufoff) + ldsw + _i * 8192), 16, 0, 0); } while (0)
#define PG8_LD8(p) __builtin_shufflevector(*(const PG8_LAS i32x4*)(p), *(const PG8_LAS i32x4*)((p) + 1024), 0, 1, 2, 3, 4, 5, 6, 7)
#define PG8_LDA(dst, b, h) do { if constexpr (F8) { _Pragma("unroll") for (int m = 0; m < 4; ++m) dst##8[m] = PG8_LD8(lds + PG8_SA(b, h) + aoff + m * 2048); } \
        else { _Pragma("unroll") for (int m = 0; m < 4; ++m) _Pragma("unroll") for (int k = 0; k < 2; ++k) dst[m][k] = *(const PG8_LAS bf16x8*)(lds + PG8_SA(b, h) + aoff + m * 2048 + k * 1024); } } while (0)
#define PG8_LDB(dst, b, h) do { if constexpr (F8) { _Pragma("unroll") for (int n = 0; n < 2; ++n) dst##8[n] = PG8_LD8(lds + PG8_SB(b, h) + boff + n * 2048); } \
        else { _Pragma("unroll") for (int n = 0; n < 2; ++n) _Pragma("unroll") for (int k = 0; k < 2; ++k) dst[n][k] = *(const PG8_LAS bf16x8*)(lds + PG8_SB(b, h) + boff + n * 2048 + k * 1024); } } while (0)
#define PG8_MMA(ai, bj, At, Bt) do { __builtin_amdgcn_s_setprio(1); _Pragma("unroll") for (int m = 0; m < 4; ++m) _Pragma("unroll") for (int n = 0; n < 2; ++n) { \
        if constexpr (F8) {   \
            acc[ai][bj][m][n] = __builtin_amdgcn_mfma_scale_f32_16x16x128_f8f6f4(Bt##8[n], At##8[m], acc[ai][bj][m][n], 0, 0, 0, 0x7f7f7f7f, 0, 0x7f7f7f7f); \
        } else { _Pragma("unroll") for (int k = 0; k < 2; ++k) acc[ai][bj][m][n] = __builtin_amdgcn_mfma_f32_16x16x32_bf16(Bt[n][k], At[m][k], acc[ai][bj][m][n], 0, 0, 0); } } \
        __builtin_amdgcn_s_setprio(0); } while (0)
#define PG8_WAIT_V(n) asm volatile("s_waitcnt vmcnt(" #n ")" ::: "memory")
#define PG8_WAIT_L(n) asm volatile("s_waitcnt lgkmcnt(" #n ")" ::: "memory")
#define PG8_BAR __builtin_amdgcn_s_barrier()
#define PG8_SCHED __builtin_amdgcn_sched_barrier(0)
    Unit cur, nxt; int ui = 0;
    if (!S.next(0, cur)) return;
    f32x4 acc[2][2][4][2];
#pragma unroll
    for (int a = 0; a < 2; ++a)
#pragma unroll
        for (int b = 0; b < 2; ++b)
#pragma unroll
            for (int m = 0; m < 4; ++m)
#pragma unroll
                for (int n = 0; n < 2; ++n) acc[a][b][m][n] = (f32x4){0.f, 0.f, 0.f, 0.f};
    bf16x8 At[4][2], B0[2][2], B1[2][2]; i32x8 At8[4], B08[2], B18[2];
    const char* cA = (const char*)g.A + (size_t)cur.pm * tstepA; const char* cB = (const char*)g.Bt + (size_t)cur.pn * tstepB;
    S.a_ready(cur);
    if constexpr (SP2) {
        PG8_STAGE(PG8_SB(0, 0), cB, voffB); PG8_STAGE(PG8_SB(0, 1), cB + hstepB, voffB); PG8_STAGE(PG8_SA(0, 0), cA, voffA); PG8_STAGE(PG8_SA(0, 1), cA + hstepA, voffA);
        if (wr == 1) PG8_BAR;
        PG8_WAIT_V(2); PG8_BAR;
        PG8_STAGE(PG8_SB(1, 0), cB + kstep, voffB); PG8_STAGE(PG8_SA(1, 0), cA + kstep, voffA); PG8_STAGE(PG8_SB(1, 1), cB + hstepB + kstep, voffB);
        PG8_WAIT_V(6); PG8_BAR;
    } else {
        PG8_STAGE(PG8_SB(0, 0), cB, voffB); PG8_STAGE(PG8_SA(0, 0), cA, voffA); PG8_STAGE(PG8_SB(0, 1), cB + hstepB, voffB); PG8_STAGE(PG8_SA(0, 1), cA + hstepA, voffA);
        if (wr == 1) PG8_BAR;
        PG8_WAIT_V(4); PG8_BAR;
        PG8_STAGE(PG8_SB(1, 0), cB + kstep, voffB); PG8_STAGE(PG8_SA(1, 0), cA + kstep, voffA); PG8_STAGE(PG8_SB(1, 1), cB + hstepB + kstep, voffB);
        PG8_WAIT_V(6); PG8_BAR;
    }
    for (;;) {
        const bool has_next = S.next(ui + 1, nxt);
        const char* nA = has_next ? (const char*)g.A + (size_t)nxt.pm * tstepA : cA; const char* nB = has_next ? (const char*)g.Bt + (size_t)nxt.pn * tstepB : cB;
        for (int t = 0; t < nt; t += 2) {
            const bool last = (t == nt - 2);
            const char* a1 = cA + (size_t)(t + 1) * kstep;
            const char* a2 = last ? nA : cA + (size_t)(t + 2) * kstep; const char* b2 = last ? nB : cB + (size_t)(t + 2) * kstep;
            const char* a3 = a2 + kstep; const char* b3 = b2 + kstep;
            if (last && has_next) S.a_ready(nxt);
            if constexpr (SP2) {
            PG8_LDB(B0, 0, 0); PG8_LDB(B1, 0, 1); PG8_SCHED; PG8_LDA(At, 0, 0); PG8_STAGE(PG8_SA(1, 1), a1 + hstepA, voffA);
            PG8_WAIT_V(8); PG8_WAIT_L(0); PG8_BAR; PG8_MMA(0, 0, At, B0); PG8_MMA(0, 1, At, B1); PG8_BAR; PG8_SCHED;
            PG8_LDA(At, 0, 1); PG8_STAGE(PG8_SB(0, 0), b2, voffB); PG8_STAGE(PG8_SB(0, 1), b2 + hstepB, voffB); PG8_STAGE(PG8_SA(0, 0), a2, voffA);
            PG8_WAIT_V(8); PG8_WAIT_L(0); PG8_BAR; PG8_MMA(1, 0, At, B0); PG8_MMA(1, 1, At, B1); PG8_BAR; PG8_SCHED;
            PG8_LDB(B0, 1, 0); PG8_LDB(B1, 1, 1); PG8_SCHED; PG8_LDA(At, 1, 0); PG8_STAGE(PG8_SA(0, 1), a2 + hstepA, voffA);
            PG8_WAIT_V(8); PG8_WAIT_L(0); PG8_BAR; PG8_MMA(0, 0, At, B0); PG8_MMA(0, 1, At, B1); PG8_BAR; PG8_SCHED;
            PG8_LDA(At, 1, 1); PG8_STAGE(PG8_SB(1, 0), b3, voffB); PG8_STAGE(PG8_SB(1, 1), b3 + hstepB, voffB); PG8_STAGE(PG8_SA(1, 0), a3, voffA);
            PG8_WAIT_V(8); PG8_WAIT_L(0); PG8_BAR; PG8_MMA(1, 0, At, B0); PG8_MMA(1, 1, At, B1); PG8_BAR; PG8_SCHED;
            } else {
            PG8_LDB(B0, 0, 0); PG8_SCHED; PG8_LDA(At, 0, 0); PG8_STAGE(PG8_SA(1, 1), a1 + hstepA, voffA);
            PG8_WAIT_L(8); PG8_BAR; PG8_WAIT_L(0); PG8_MMA(0, 0, At, B0); PG8_BAR; PG8_SCHED;
            PG8_LDB(B1, 0, 1); PG8_STAGE(PG8_SB(0, 0), b2, voffB);
            PG8_BAR; PG8_WAIT_L(0); PG8_MMA(0, 1, At, B1); PG8_BAR;
            PG8_LDA(At, 0, 1); PG8_STAGE(PG8_SA(0, 0), a2, voffA);
            PG8_BAR; PG8_WAIT_L(0); PG8_MMA(1, 0, At, B0); PG8_BAR; PG8_SCHED;
            PG8_STAGE(PG8_SB(0, 1), b2 + hstepB, voffB);
            PG8_WAIT_V(6); PG8_BAR; PG8_MMA(1, 1, At, B1); PG8_BAR;
            PG8_LDB(B0, 1, 0); PG8_SCHED; PG8_LDA(At, 1, 0); PG8_STAGE(PG8_SA(0, 1), a2 + hstepA, voffA);
            PG8_WAIT_L(8); PG8_BAR; PG8_WAIT_L(0); PG8_MMA(0, 0, At, B0); PG8_BAR; PG8_SCHED;
            PG8_LDB(B1, 1, 1); PG8_STAGE(PG8_SB(1, 0), b3, voffB);
            PG8_BAR; PG8_WAIT_L(0); PG8_MMA(0, 1, At, B1); PG8_BAR;
            PG8_LDA(At, 1, 1); PG8_STAGE(PG8_SA(1, 0), a3, voffA);
            PG8_BAR; PG8_WAIT_L(0); PG8_MMA(1, 0, At, B0); PG8_BAR; PG8_SCHED;
            PG8_STAGE(PG8_SB(1, 1), b3 + hstepB, voffB);
            PG8_WAIT_V(6); PG8_BAR; PG8_MMA(1, 1, At, B1); PG8_BAR;
            }
        }
        if constexpr (ALIGN_EPI) { if (wr == 0) PG8_BAR; }
        E(acc, cur, wr, wc, fr, fq);
        if (!has_next) break;
#pragma unroll
        for (int a = 0; a < 2; ++a)
#pragma unroll
            for (int b = 0; b < 2; ++b)
#pragma unroll
                for (int m = 0; m < 4; ++m)
#pragma unroll
                    for (int n = 0; n < 2; ++n) acc[a][b][m][n] = (f32x4){0.f, 0.f, 0.f, 0.f};
        cur = nxt; cA = nA; cB = nB; ++ui;
        if constexpr (ALIGN_EPI) { if (wr == 1) PG8_BAR; }
    }
    PG8_WAIT_V(0);
    if constexpr (!ALIGN_EPI) { if (wr == 0) PG8_BAR; }
    PG8_BAR;
#undef PG8_SA
#undef PG8_SB
#undef PG8_STAGE
#undef PG8_LDA
#undef PG8_LD8
#undef PG8_LDB
#undef PG8_MMA
#undef PG8_WAIT_V
#undef PG8_WAIT_L
#undef PG8_BAR
#undef PG8_SCHED
}

struct EpiStoreBf16 {
    static constexpr bool PERM = true;
    bf16_t* O; int ldc; float scale;
    __device__ __forceinline__ void operator()(const f32x4 (&acc)[2][2][4][2], const Unit& u, int wr, int wc, int fr, int fq) const {
        const int row0 = u.pm * BM + wr * 64 + fr, col0 = u.pn * BM + wc * 32 + 8 * fq;
#pragma unroll
        for (int ai = 0; ai < 2; ++ai)
#pragma unroll
            for (int m = 0; m < 4; ++m) { bf16_t* rowp = O + (size_t)(row0 + ai * HALF + m * 16) * ldc + col0;
#pragma unroll
                for (int bj = 0; bj < 2; ++bj) { const f32x4 v0 = acc[ai][bj][m][0] * scale, v1 = acc[ai][bj][m][1] * scale;
                    u32x4 w; w.x = pk2(v0[0], v0[1]); w.y = pk2(v0[2], v0[3]); w.z = pk2(v1[0], v1[1]); w.w = pk2(v1[2], v1[3]);
                    *(u32x4*)(rowp + bj * HALF) = w; } }
    }
};
struct EpiStoreQ {
    static constexpr bool PERM = true;
    bf16_t* O;
    __device__ __forceinline__ void operator()(const f32x4 (&acc)[2][2][4][2], const Unit& u, int wr, int wc, int fr, int fq) const {
        const int row0 = u.pm * BM + wr * 64 + fr, col0 = u.pn * BM + wc * 32 + 8 * fq;
#pragma unroll
        for (int ai = 0; ai < 2; ++ai)
#pragma unroll
            for (int m = 0; m < 4; ++m) { const int row = row0 + ai * HALF + m * 16, tg = row >> 5, t = row & 31;
#pragma unroll
                for (int bj = 0; bj < 2; ++bj) { const int c0 = col0 + bj * HALF, h = c0 >> 8, pp = (c0 >> 7) & 1, cc = c0 & 127, ks = cc >> 4, hh = (cc >> 3) & 1;
                    const f32x4 v0 = acc[ai][bj][m][0], v1 = acc[ai][bj][m][1];
                    u32x4 w; w.x = pk2(v0[0], v0[1]); w.y = pk2(v0[2], v0[3]); w.z = pk2(v1[0], v1[1]); w.w = pk2(v1[2], v1[3]);
                    *(u32x4*)(O + ((size_t)((((tg * 8 + h) * 2 + pp) * 8 + ks) * 64 + hh * 32 + t)) * 8) = w; } }
    }
};
struct EpiWout {
    static constexpr bool PERM = false;
    const float* xs; float* out; const float* g1;
    __device__ __forceinline__ void operator()(const f32x4 (&acc)[2][2][4][2], const Unit& u, int wr, int wc, int fr, int fq) const {
        const int row0 = u.pm * BM + wr * 64 + fr, col0 = u.pn * BM + wc * 32 + 4 * fq;
        const int b = (u.pm * BM) >> 11;
        f32x4 gv[2][2];
#pragma unroll
        for (int bj = 0; bj < 2; ++bj)
#pragma unroll
            for (int n = 0; n < 2; ++n) gv[bj][n] = *(const f32x4*)(g1 + (size_t)b * NMODC + col0 + bj * HALF + n * 16);
#pragma unroll
        for (int ai = 0; ai < 2; ++ai)
#pragma unroll
            for (int m = 0; m < 4; ++m) { const size_t off = (size_t)(row0 + ai * HALF + m * 16) * D + col0;
#pragma unroll
                for (int bj = 0; bj < 2; ++bj)
#pragma unroll
                    for (int n = 0; n < 2; ++n) { const f32x4 xv = *(const f32x4*)(xs + off + bj * HALF + n * 16);
                        *(f32x4*)(out + off + bj * HALF + n * 16) = xv + gv[bj][n] * acc[ai][bj][m][n]; } }
    }
};
struct EpiGlu {
    static constexpr bool PERM = true;
    const bf16_t* PB; const bf16_t* YS; const bf16_t* ORAW; const float* SSQ; const float* ng; const float* gb_; bf16_t* O;
    __device__ __forceinline__ void operator()(const f32x4 (&acc)[2][2][4][2], const Unit& u, int wr, int wc, int fr, int fq) const {
        const int row0 = u.pm * BM + wr * 64 + fr, col0 = u.pn * BM + wc * 32 + 8 * fq;
#pragma unroll
        for (int bj = 0; bj < 2; ++bj) {
            const int c = col0 + bj * HALF, head = c >> 7;
            const f32x4 n0 = *(const f32x4*)(ng + (c & 127)), n1 = *(const f32x4*)(ng + (c & 127) + 4);
            const f32x4 b0 = *(const f32x4*)(gb_ + c), b1 = *(const f32x4*)(gb_ + c + 4);
            const float ngv[8] = {n0[0], n0[1], n0[2], n0[3], n1[0], n1[1], n1[2], n1[3]};
            const float bbv[8] = {b0[0], b0[1], b0[2], b0[3], b1[0], b1[1], b1[2], b1[3]};
#pragma unroll
            for (int ai = 0; ai < 2; ++ai)
#pragma unroll
                for (int m = 0; m < 4; ++m) {
                    const int row = row0 + ai * HALF + m * 16;
                    const bf16_t* pb = PB + (size_t)row * 4096 + c;
                    const u32x4 og = *(const u32x4*)(pb), ys = *(const u32x4*)(YS + (size_t)row * D + c), ga = *(const u32x4*)(pb + 2048), gb = *(const u32x4*)(pb + 3072);
                    const u32x4 orw = *(const u32x4*)(ORAW + (size_t)row * D + c);
                    const float rstd = __builtin_amdgcn_rsqf(SSQ[(size_t)row * 8 + head] * (1.0f / 128.0f) + EPS);
                    const f32x4 a0 = acc[ai][bj][m][0], a1 = acc[ai][bj][m][1];
                    const float av[8] = {a0[0], a0[1], a0[2], a0[3], a1[0], a1[1], a1[2], a1[3]};
                    float res[8];
#pragma unroll
                    for (int j = 0; j < 8; ++j) {
                        const unsigned wog = og[j >> 1], wys = ys[j >> 1], wga = ga[j >> 1], wgb = gb[j >> 1], wor = orw[j >> 1];
                        const float fog = (j & 1) ? bfhi(wog) : bflo(wog), fys = (j & 1) ? bfhi(wys) : bflo(wys), fga = (j & 1) ? bfhi(wga) : bflo(wga),
                                    fgb = (j & 1) ? bfhi(wgb) : bflo(wgb), fo = (j & 1) ? bfhi(wor) : bflo(wor);
                        const float ya = fo * rstd * ngv[j] * fsilu(fog);
                        const float yb = fys * fsigmoid((DBG_NO_ACC ? 0.f : av[j]) + bbv[j]);
                        res[j] = (DBG_NO_YA ? 0.f : fsigmoid(fga) * ya) + (DBG_NO_YB ? 0.f : (DBG_NO_GB ? 0.5f : fsigmoid(fgb)) * yb);
                    }
                    int w0 = 0, w1 = 0;
                    w0 = __builtin_amdgcn_cvt_pk_fp8_f32(res[0] * MG_SCALE, res[1] * MG_SCALE, w0, false); w0 = __builtin_amdgcn_cvt_pk_fp8_f32(res[2] * MG_SCALE, res[3] * MG_SCALE, w0, true);
                    w1 = __builtin_amdgcn_cvt_pk_fp8_f32(res[4] * MG_SCALE, res[5] * MG_SCALE, w1, false); w1 = __builtin_amdgcn_cvt_pk_fp8_f32(res[6] * MG_SCALE, res[7] * MG_SCALE, w1, true);
                    *(u32x2*)((unsigned char*)O + (size_t)row * D + c) = (u32x2){(unsigned)w0, (unsigned)w1};
                }
        }
    }
};
}

#define XB_TMO      128
#define XB_XCNT(j)  (256  + 64 * (j))
#define XB_XSUB(j)  (1280 + 64 * (j))
#define XB_XGEN(j)  (2304 + 64 * (j))
#define XB_TOP      3328
#define XB_TOPGEN   3392
#define XCD_BAR_WORDS 3456
#define XB_SPIN_CAP (1u << 25)
__device__ __forceinline__ unsigned xb_ld(unsigned* p)              { return __hip_atomic_load(p, __ATOMIC_RELAXED, __HIP_MEMORY_SCOPE_AGENT); }
__device__ __forceinline__ unsigned xb_add(unsigned* p, unsigned v) { return __hip_atomic_fetch_add(p, v, __ATOMIC_RELAXED, __HIP_MEMORY_SCOPE_AGENT); }
__device__ __forceinline__ unsigned xb_xcc_id() { return (unsigned)__builtin_amdgcn_s_getreg((3 << 11) | 20) & 0xFu; }
#define XB_SPIN(cond, bar) do { unsigned _sp = 0; while (cond) { __builtin_amdgcn_s_sleep(1); \
    if ((++_sp & 255u) == 0u) { if (xb_ld(&(bar)[XB_TMO])) break; if (_sp > XB_SPIN_CAP) { atomicAdd(&(bar)[XB_TMO], 1u); break; } } } } while (0)
struct XcdBarrier { unsigned* bar; unsigned x; volatile LAS unsigned* st; };
__device__ __forceinline__ XcdBarrier xcd_barrier_post(unsigned* bar, volatile LAS unsigned* st) {
    XcdBarrier b; b.bar = bar; b.x = xb_xcc_id(); b.st = st;
    if (threadIdx.x == 0) (void)xb_add(&bar[XB_XCNT(b.x)], 1u);
    return b;
}
__device__ __forceinline__ void xcd_barrier_complete(unsigned* bar, unsigned x, unsigned& nloc, unsigned& nx) {
    const unsigned G = gridDim.x * gridDim.y * gridDim.z;
    unsigned sum, cnt, mine, sp = 0u;
    for (;;) {
        sum = 0u; cnt = 0u; mine = 0u;
#pragma unroll
        for (unsigned j = 0; j < 16; ++j) { const unsigned c = xb_ld(&bar[XB_XCNT(j)]); sum += c; cnt += (c > 0u) ? 1u : 0u; mine = (j == x) ? c : mine; }
        if (sum == G) break;
        __builtin_amdgcn_s_sleep(1);
        if ((++sp & 255u) == 0u) { if (xb_ld(&bar[XB_TMO])) break; if (sp > XB_SPIN_CAP) { atomicAdd(&bar[XB_TMO], 1u); break; } }
    }
    nloc = mine > 0u ? mine : 1u; nx = cnt > 0u ? cnt : 1u;
}
__device__ __forceinline__ void xcd_barrier(const XcdBarrier& b) {
    asm volatile("s_waitcnt vmcnt(0)" ::: "memory");
    __syncthreads();
    if (threadIdx.x == 0) {
        unsigned* bar = b.bar;
        __builtin_amdgcn_s_waitcnt(0);
        unsigned nloc = b.st[0], nx = b.st[1];
        if (nloc == 0u) { xcd_barrier_complete(bar, b.x, nloc, nx); b.st[0] = nloc; b.st[1] = nx; }
        const unsigned old = xb_add(&bar[XB_XSUB(b.x)], 1u);
        const unsigned gen = old / nloc;
        if (old + 1u == (gen + 1u) * nloc) {
            __builtin_amdgcn_fence(__ATOMIC_RELEASE, "agent");
            asm volatile("s_waitcnt vmcnt(0)" ::: "memory");
            const unsigned og = xb_add(&bar[XB_TOP], 1u);
            const unsigned tg = og / nx;
            if (og + 1u == (tg + 1u) * nx) xb_add(&bar[XB_TOPGEN], 1u);
            else XB_SPIN(xb_ld(&bar[XB_TOPGEN]) == tg, bar);
            __builtin_amdgcn_fence(__ATOMIC_ACQUIRE, "agent");
            xb_add(&bar[XB_XGEN(b.x)], 1u);
            asm volatile("s_waitcnt vmcnt(0)" ::: "memory");
        } else {
            XB_SPIN(xb_ld(&bar[XB_XGEN(b.x)]) == gen, bar);
            __builtin_amdgcn_fence(__ATOMIC_ACQUIRE, "agent");
            asm volatile("s_waitcnt vmcnt(0)" ::: "memory");
        }
    }
    __syncthreads();
}

struct KP { const float* in[25]; float* out; unsigned char* ws; int gp_lo, gp_hi; };
enum { I_X = 0, I_C, I_ADAW, I_ADAB, I_N1G, I_N2G, I_WIN, I_LBL, I_HNG, I_ARE, I_AIM, I_LDT, I_BRE, I_BIM, I_CRE, I_CIM, I_S5D, I_GLUW, I_GLUB, I_WOUT, I_WQ, I_SUBK, I_PU, I_PV, I_FG };

typedef const KP __attribute__((address_space(4)))* kp_cptr;
__device__ __forceinline__ KP load_kp() {
#if defined(__HIP_DEVICE_COMPILE__)
    unsigned long long a = (unsigned long long)__builtin_amdgcn_kernarg_segment_ptr(); asm volatile("" : "+s"(a)); return *(kp_cptr)a;
#else
    return KP{};
#endif
}

__device__ __forceinline__ void phase_setup(const KP& p, LAS unsigned char* lds, int G) {
    const int tid = opaque_tid();
    {
        LAS float* cact = (LAS float*)lds;
        for (int it = blockIdx.x; it < 4 * 48; it += G) {
#pragma unroll 1
            for (int i0 = 0; i0 < 64; i0 += 16) { float cv[16];
#pragma unroll
                for (int q = 0; q < 16; ++q) cv[q] = p.in[I_C][(i0 + q) * 512 + tid];
#pragma unroll
                for (int q = 0; q < 16; ++q) { const int i = (i0 + q) * 512 + tid; const int k_ = i & 1023, b_ = i >> 10; cact[k_ * 32 + ((((b_ >> 2) ^ (k_ & 7)) << 2) | (b_ & 3))] = fsilu(cv[q]); } }
            __syncthreads();
            const int l = it / 48, cb = it % 48, col = cb * 128 + (tid & 127), bg = tid >> 7;
            const float* W = p.in[I_ADAW] + (size_t)l * D * NMODC + col;
            f32x4 acc0 = {0.f, 0.f, 0.f, 0.f}, acc1 = {0.f, 0.f, 0.f, 0.f};
#pragma unroll 2
            for (int k4 = 0; k4 < 256; ++k4) {
                const float w0 = W[(size_t)(4 * k4 + 0) * NMODC], w1 = W[(size_t)(4 * k4 + 1) * NMODC], w2 = W[(size_t)(4 * k4 + 2) * NMODC], w3 = W[(size_t)(4 * k4 + 3) * NMODC];
#pragma unroll
                for (int kk = 0; kk < 4; ++kk) { const int k_ = 4 * k4 + kk; const float wv = kk == 0 ? w0 : (kk == 1 ? w1 : (kk == 2 ? w2 : w3));
                    acc0 += *(const LAS f32x4*)(cact + k_ * 32 + (((2 * bg) ^ (k_ & 7)) << 2)) * wv; acc1 += *(const LAS f32x4*)(cact + k_ * 32 + (((2 * bg + 1) ^ (k_ & 7)) << 2)) * wv; }
            }
            float* MOD = (float*)(p.ws + WS_MOD);
            const float bias = p.in[I_ADAB][l * NMODC + col];
#pragma unroll
            for (int j = 0; j < 4; ++j) { MOD[((size_t)l * 32 + 8 * bg + j) * NMODC + col] = acc0[j] + bias; MOD[((size_t)l * 32 + 8 * bg + 4 + j) * NMODC + col] = acc1[j] + bias; }
            __syncthreads();
        }
    }
    const int gtid = (G - 1 - (int)blockIdx.x) * 512 + tid;
    if (gtid < 1024) {
        const float* lg = p.in[I_LBL]; float v[4], mx = -1e30f;
#pragma unroll
        for (int l = 0; l < 4; ++l) { v[l] = lg[l * 1024 + gtid]; mx = fmaxf(mx, v[l]); }
        float s = 0.f;
#pragma unroll
        for (int l = 0; l < 4; ++l) { v[l] = __expf(v[l] - mx); s += v[l]; }
        float* LB = (float*)(p.ws + WS_LB); float cum = 0.f; const float first = v[0] / s;
#pragma unroll
        for (int l = 0; l < 4; ++l) { cum += v[l] / s; LB[l * 1024 + gtid] = (l == 0) ? 0.f : (cum - first); }
    }
    if (gtid >= 1024 && gtid < 1024 + 16384) {
        const int id = gtid - 1024, lg = id >> 6, pp = id & 63;
        const float a_re = p.in[I_ARE][id], a_im = p.in[I_AIM][id];
        const float step = expf(p.in[I_LDT][lg]);
        const float mag = expf(step * a_re), ang = step * a_im;
        const float ab_re = mag * cosf(ang), ab_im = mag * sinf(ang);
        const float den = a_re * a_re + a_im * a_im;
        const float z_re = ((ab_re - 1.0f) * a_re + ab_im * a_im) / den;
        const float z_im = (ab_im * a_re - (ab_re - 1.0f) * a_im) / den;
        float* ABAR = (float*)(p.ws + WS_ABAR); ABAR[2 * id] = ab_re; ABAR[2 * id + 1] = ab_im;
        bf16_t* BOP = (bf16_t*)(p.ws + WS_BOP); bf16_t* COP = (bf16_t*)(p.ws + WS_COP);
        const float* bre = p.in[I_BRE] + (size_t)id * 16; const float* bim = p.in[I_BIM] + (size_t)id * 16;
#pragma unroll
        for (int c = 0; c < 16; ++c) {
            const float br = bre[c], bi = bim[c];
            const float rr = z_re * br - z_im * bi, ii = z_re * bi + z_im * br;
            BOP[((size_t)lg * 128 + 2 * pp) * 16 + c] = (bf16_t)(pk2(rr, 0.f) & 0xffffu);
            BOP[((size_t)lg * 128 + 2 * pp + 1) * 16 + c] = (bf16_t)(pk2(ii, 0.f) & 0xffffu);
            const float cr = p.in[I_CRE][((size_t)lg * 16 + c) * 64 + pp], ci = p.in[I_CIM][((size_t)lg * 16 + c) * 64 + pp];
            COP[((size_t)lg * 16 + c) * 128 + 2 * pp] = (bf16_t)(pk2(cr, 0.f) & 0xffffu);
            COP[((size_t)lg * 16 + c) * 128 + 2 * pp + 1] = (bf16_t)(pk2(-ci, 0.f) & 0xffffu);
        }
    }
}

__device__ __forceinline__ void transpose_item(const float* W, int K, int N, bf16_t* WT, LAS float* scr, int item, int lane) {
    const int nblk = N / 32, kb = item / nblk, nb = item % nblk, k0 = 64 * kb, n0 = 32 * nb;
#pragma unroll 8
    for (int i = 0; i < 32; ++i) { const int kk = 2 * i + (lane >> 5); scr[kk * 33 + (lane & 31)] = W[(size_t)(k0 + kk) * N + n0 + (lane & 31)]; }
    LDS_WAIT();
    const int c = lane & 7;
#pragma unroll
    for (int j = 0; j < 4; ++j) { const int n = (lane >> 3) + 8 * j; const LAS float* s = scr + (8 * c) * 33 + n;
        u32x4 o; o.x = pk2(s[0 * 33], s[1 * 33]); o.y = pk2(s[2 * 33], s[3 * 33]); o.z = pk2(s[4 * 33], s[5 * 33]); o.w = pk2(s[6 * 33], s[7 * 33]);
        *(u32x4*)(WT + (size_t)(n0 + n) * K + k0 + 8 * c) = o; }
    LDS_WAIT();
}
__device__ __forceinline__ void cvt_f32_fp8(const float* src, unsigned char* dst, size_t n4, size_t gtid, size_t nthr, float scale) {
    for (size_t i = gtid; i < n4; i += nthr) { const f32x4 v = ((const f32x4*)src)[i] * scale; int w = 0;
        w = __builtin_amdgcn_cvt_pk_fp8_f32(v[0], v[1], w, false); w = __builtin_amdgcn_cvt_pk_fp8_f32(v[2], v[3], w, true); ((unsigned*)dst)[i] = (unsigned)w; }
}
__device__ __forceinline__ void cvt_f32_fp8_sliced(const float* src, unsigned char* dst, size_t gtid, size_t nthr, float scale) {
    for (size_t i = gtid; i < (size_t)16384 * 64; i += nthr) {
        const size_t e = i >> 6; const int sl = (int)(i & 63) >> 3, c = (int)(i & 7);
        const f32x4* sp = (const f32x4*)(src + e * 1024 + sl * 128 + c * 16); u32x4 o;
#pragma unroll
        for (int q = 0; q < 4; ++q) { const f32x4 v = sp[q] * scale; int w = 0; w = __builtin_amdgcn_cvt_pk_fp8_f32(v[0], v[1], w, false); w = __builtin_amdgcn_cvt_pk_fp8_f32(v[2], v[3], w, true); o[q] = (unsigned)w; }
        *(u32x4*)(dst + ((size_t)sl * 16384 + e) * 128 + c * 16) = o;
    }
}
__device__ __forceinline__ void transpose_item_fp8(const float* W, int K, int N, unsigned char* WT, LAS float* scr, int item, int lane, float scale) {
    const int nblk = N / 32, kb = item / nblk, nb = item % nblk, k0 = 64 * kb, n0 = 32 * nb;
#pragma unroll 8
    for (int i = 0; i < 32; ++i) { const int kk = 2 * i + (lane >> 5); scr[kk * 33 + (lane & 31)] = W[(size_t)(k0 + kk) * N + n0 + (lane & 31)]; }
    LDS_WAIT();
    const int c = lane & 7;
#pragma unroll
    for (int j = 0; j < 4; ++j) { const int n = (lane >> 3) + 8 * j; const LAS float* sp = scr + (8 * c) * 33 + n;
        int w0 = 0, w1 = 0;
        w0 = __builtin_amdgcn_cvt_pk_fp8_f32(sp[0 * 33] * scale, sp[1 * 33] * scale, w0, false); w0 = __builtin_amdgcn_cvt_pk_fp8_f32(sp[2 * 33] * scale, sp[3 * 33] * scale, w0, true);
        w1 = __builtin_amdgcn_cvt_pk_fp8_f32(sp[4 * 33] * scale, sp[5 * 33] * scale, w1, false); w1 = __builtin_amdgcn_cvt_pk_fp8_f32(sp[6 * 33] * scale, sp[7 * 33] * scale, w1, true);
        *(u32x2*)(WT + (size_t)(n0 + n) * K + k0 + 8 * c) = (u32x2){(unsigned)w0, (unsigned)w1}; }
    LDS_WAIT();
}
__device__ __forceinline__ void cvt_f32_bf16(const float* src, bf16_t* dst, size_t n4, size_t gtid, size_t nthr) {
    for (size_t i = gtid; i < n4; i += nthr) { const f32x4 v = ((const f32x4*)src)[i]; u32x2 o; o.x = pk2(v[0], v[1]); o.y = pk2(v[2], v[3]); ((u32x2*)dst)[i] = o; }
}
template <bool F8OUT, bool XBF>
__device__ __forceinline__ void norm_rows(const float* xsrc, bf16_t* hdst, const float* gain, const float* mod_l, int sh_off, int sc_off, int gw, int ngw, int lane) {
    for (int r0 = gw * 4; r0 < M; r0 += ngw * 4) {
        const int b = r0 >> 11;
        f32x4 v[4][4]; float ss[4];
#pragma unroll
        for (int i = 0; i < 4; ++i) {
            if constexpr (XBF) { const u32x2* xr = (const u32x2*)((const bf16_t*)xsrc + (size_t)(r0 + i) * D) + lane;
#pragma unroll
                for (int j = 0; j < 4; ++j) { const u32x2 xw = xr[64 * j]; v[i][j] = (f32x4){bflo(xw[0]), bfhi(xw[0]), bflo(xw[1]), bfhi(xw[1])}; } }
            else { const f32x4* xr = (const f32x4*)(xsrc + (size_t)(r0 + i) * D) + lane;
#pragma unroll
                for (int j = 0; j < 4; ++j) v[i][j] = xr[64 * j]; } }
#pragma unroll
        for (int i = 0; i < 4; ++i) { float t = 0.f;
#pragma unroll
            for (int j = 0; j < 4; ++j) t += (v[i][j][0] * v[i][j][0] + v[i][j][1] * v[i][j][1]) + (v[i][j][2] * v[i][j][2] + v[i][j][3] * v[i][j][3]);
            ss[i] = t; }
#pragma unroll
        for (int o = 1; o < 64; o <<= 1) {
#pragma unroll
            for (int i = 0; i < 4; ++i) ss[i] += __shfl_xor(ss[i], o); }
        const float* mb = mod_l + (size_t)b * NMODC;
#pragma unroll
        for (int j = 0; j < 4; ++j) { const int col = 256 * j + 4 * lane;
            const f32x4 g4 = *(const f32x4*)(gain + col), sc = *(const f32x4*)(mb + sc_off + col), sh = *(const f32x4*)(mb + sh_off + col);
            const f32x4 gs = g4 * (sc + 1.0f);
#pragma unroll
            for (int i = 0; i < 4; ++i) { const float rstd = __builtin_amdgcn_rsqf(ss[i] * (1.0f / D) + EPS);
                const f32x4 h = v[i][j] * rstd * gs + sh;
                if constexpr (F8OUT) { int w8 = 0; w8 = __builtin_amdgcn_cvt_pk_fp8_f32(h[0] * HIN_SCALE, h[1] * HIN_SCALE, w8, false); w8 = __builtin_amdgcn_cvt_pk_fp8_f32(h[2] * HIN_SCALE, h[3] * HIN_SCALE, w8, true);
                    *(unsigned*)((unsigned char*)hdst + (size_t)(r0 + i) * D + col) = (unsigned)w8; }
                else { u32x2 o; o.x = pk2(h[0], h[1]); o.y = pk2(h[2], h[3]); *(u32x2*)(hdst + (size_t)(r0 + i) * D + col) = o; } } }
    }
}
template <bool XBF>
__device__ __forceinline__ void resid_norm_rows(const float* xsrc, bf16_t* xdst, const bf16_t* delta, bf16_t* hdst, unsigned char* xf8, const float* gain, const float* mod_l, int gw, int ngw, int lane) {
    for (int r0 = gw * 4; r0 < M; r0 += ngw * 4) {
        const int b = r0 >> 11; const float* mb = mod_l + (size_t)b * NMODC;
        f32x4 v[4][4]; u32x2 dl[4][4]; float ss[4];
#pragma unroll
        for (int i = 0; i < 4; ++i) { const u32x2* dp = (const u32x2*)(delta + (size_t)(r0 + i) * D) + lane;
            if constexpr (XBF) { const u32x2* xr = (const u32x2*)((const bf16_t*)xsrc + (size_t)(r0 + i) * D) + lane;
#pragma unroll
                for (int j = 0; j < 4; ++j) { const u32x2 xw = xr[64 * j]; v[i][j] = (f32x4){bflo(xw[0]), bfhi(xw[0]), bflo(xw[1]), bfhi(xw[1])}; dl[i][j] = dp[64 * j]; } }
            else { const f32x4* xr = (const f32x4*)(xsrc + (size_t)(r0 + i) * D) + lane;
#pragma unroll
                for (int j = 0; j < 4; ++j) { v[i][j] = xr[64 * j]; dl[i][j] = dp[64 * j]; } } }
#pragma unroll
        for (int j = 0; j < 4; ++j) { const f32x4 g1 = *(const f32x4*)(mb + 2048 + 256 * j + 4 * lane);
#pragma unroll
            for (int i = 0; i < 4; ++i) { const f32x4 dv = {bflo(dl[i][j][0]), bfhi(dl[i][j][0]), bflo(dl[i][j][1]), bfhi(dl[i][j][1])}; v[i][j] = v[i][j] + g1 * dv;
                ((u32x2*)(xdst + (size_t)(r0 + i) * D) + lane)[64 * j] = (u32x2){pk2(v[i][j][0], v[i][j][1]), pk2(v[i][j][2], v[i][j][3])}; } }
#pragma unroll
        for (int i = 0; i < 4; ++i) { float t = 0.f;
#pragma unroll
            for (int j = 0; j < 4; ++j) t += (v[i][j][0] * v[i][j][0] + v[i][j][1] * v[i][j][1]) + (v[i][j][2] * v[i][j][2] + v[i][j][3] * v[i][j][3]);
            ss[i] = t; }
#pragma unroll
        for (int o = 1; o < 64; o <<= 1) {
#pragma unroll
            for (int i = 0; i < 4; ++i) ss[i] += __shfl_xor(ss[i], o); }
#pragma unroll
        for (int j = 0; j < 4; ++j) { const int col = 256 * j + 4 * lane;
            const f32x4 g4 = *(const f32x4*)(gain + col), sc = *(const f32x4*)(mb + 4096 + col), sh = *(const f32x4*)(mb + 3072 + col);
            const f32x4 gs = g4 * (sc + 1.0f);
#pragma unroll
            for (int i = 0; i < 4; ++i) { const float rstd = __builtin_amdgcn_rsqf(ss[i] * (1.0f / D) + EPS);
                const f32x4 h = v[i][j] * rstd * gs + sh; u32x2 o; o.x = pk2(h[0], h[1]); o.y = pk2(h[2], h[3]); *(u32x2*)(hdst + (size_t)(r0 + i) * D + col) = o;
                int w8 = 0; w8 = __builtin_amdgcn_cvt_pk_fp8_f32(h[0] * X_SCALE, h[1] * X_SCALE, w8, false); w8 = __builtin_amdgcn_cvt_pk_fp8_f32(h[2] * X_SCALE, h[3] * X_SCALE, w8, true);
                *(unsigned*)(xf8 + ((size_t)(col >> 7) * M + (r0 + i)) * 128 + (col & 127)) = (unsigned)w8; } }
    }
}
__device__ __forceinline__ void phase_conv_norm1(const KP& p, LAS unsigned char* lds, int l, int G) {
    const int tid = opaque_tid(), lane = tid & 63, wave = __builtin_amdgcn_readfirstlane(tid >> 6);
    const int gw = blockIdx.x * 8 + wave, ngw = G * 8;
    LAS float* scr = (LAS float*)(lds + wave * 8448);
    constexpr int I_IN = 16 * (INC / 32), I_G = 16 * 32, I_O = 16 * 32, I_Q = 16 * 64, NIT = I_IN + I_G + I_O + I_Q;
    for (int it = gw; it < NIT; it += ngw) {
        int r = it;
        if (r < I_IN) { transpose_item_fp8(p.in[I_WIN] + (size_t)l * D * INC, D, INC, p.ws + WS_WIN, scr, r, lane, WIN_SCALE); continue; } r -= I_IN;
        if (r < I_G) { transpose_item(p.in[I_GLUW] + (size_t)l * D * D, D, D, (bf16_t*)(p.ws + WS_WGLU), scr, r, lane); continue; } r -= I_G;
        if (r < I_O) { transpose_item_fp8(p.in[I_WOUT] + (size_t)l * D * D, D, D, p.ws + WS_WOUT, scr, r, lane, WO_SCALE); continue; } r -= I_O;
        transpose_item(p.in[I_WQ] + (size_t)l * D * 2048, D, 2048, (bf16_t*)(p.ws + WS_WQ), scr, r, lane);
    }
    const size_t gtid = (size_t)blockIdx.x * 512 + tid, nthr = (size_t)G * 512;
    cvt_f32_bf16(p.in[I_SUBK] + (size_t)l * 262144, (bf16_t*)(p.ws + WS_KEYS), 262144 / 4, gtid, nthr);
    if (l == 0) {
        cvt_f32_fp8_sliced(p.in[I_PU], p.ws + WS_U, gtid, nthr, U_SCALE);
        cvt_f32_fp8_sliced(p.in[I_PV], p.ws + WS_V, gtid, nthr, V_SCALE); }
    if (l == 0) norm_rows<true, false>(p.in[I_X], (bf16_t*)(p.ws + WS_H), p.in[I_N1G] + l * D, (const float*)(p.ws + WS_MOD) + (size_t)l * 32 * NMODC, 0, 1024, gw, ngw, lane);
    else norm_rows<true, true>(p.out, (bf16_t*)(p.ws + WS_H), p.in[I_N1G] + l * D, (const float*)(p.ws + WS_MOD) + (size_t)l * 32 * NMODC, 0, 1024, gw, ngw, lane);
}

__device__ __forceinline__ void phase_hgrn2(const KP& p, LAS unsigned char* lds, int l, int G) {
    const int tid = opaque_tid(), lane = tid & 63, w = __builtin_amdgcn_readfirstlane(tid >> 6), fr = lane & 15, g = lane >> 4;
    constexpr int QS = 272, TS = 72;
    constexpr int OFF_QT = 0, OFF_KH = 8704, OFF_KT = 17408, OFF_VT = 26624, OFF_EREF = 35840, OFF_ELR = 36352, OFF_SEG = 36864, PBUF = 40960;
    const bf16_t* PA = (const bf16_t*)(p.ws + WS_R0);
    bf16_t* ORAW = (bf16_t*)(p.ws + WS_OR);
    const float* LB = (const float*)(p.ws + WS_LB) + l * 1024;
    for (int unit = blockIdx.x; unit < 256; unit += G) {
        const int b = unit >> 3, h = unit & 7, k0 = 2 * lane;
        const float lb0 = LB[h * 128 + k0], lb1 = LB[h * 128 + k0 + 1];
        const float om0 = 1.0f - lb0, om1 = 1.0f - lb1;
        f32x4 S[8];
#pragma unroll
        for (int kt = 0; kt < 8; ++kt) S[kt] = (f32x4){0.f, 0.f, 0.f, 0.f};
        unsigned rq[4], rf[4], rv[4];
        {
            const bf16_t* base = PA + ((size_t)b * SEQ + 4 * w) * 3072 + h * 128 + k0;
#pragma unroll
            for (int i = 0; i < 4; ++i) { rq[i] = *(const unsigned*)(base + (size_t)i * 3072); rf[i] = *(const unsigned*)(base + (size_t)i * 3072 + 1024); rv[i] = *(const unsigned*)(base + (size_t)i * 3072 + 2048); }
        }
        for (int c = 0; c < 64; ++c) {
            LAS unsigned char* base = lds + (c & 1) * PBUF;
            float cs0[4], cs1[4], qv0[4], qv1[4], kv0[4], kv1[4];
            float run0 = 0.f, run1 = 0.f;
#pragma unroll
            for (int i = 0; i < 4; ++i) {
                const float fp0 = bflo(rf[i]), fp1 = bfhi(rf[i]);
                const float s0 = fsigmoid(fp0), s1 = fsigmoid(fp1);
                run0 += __logf(lb0 + om0 * s0); run1 += __logf(lb1 + om1 * s1);
                cs0[i] = run0; cs1[i] = run1;
                kv0[i] = om0 * (1.0f - s0); kv1[i] = om1 * (1.0f - s1);
                qv0[i] = fsilu(bflo(rq[i])); qv1[i] = fsilu(bfhi(rq[i]));
            }
            *(LAS f32x2*)(base + OFF_SEG + (w * 128 + k0) * 4) = (f32x2){run0, run1};
            __syncthreads();
            float off0 = 0.f, off1 = 0.f, ref0 = 0.f, ref1 = 0.f, all0 = 0.f, all1 = 0.f;
#pragma unroll
            for (int s = 0; s < 8; ++s) { const f32x2 t2 = *(const LAS f32x2*)(base + OFF_SEG + (s * 128 + k0) * 4);
                if (s < w) { off0 += t2[0]; off1 += t2[1]; }
                if (s < 4) { ref0 += t2[0]; ref1 += t2[1]; }
                all0 += t2[0]; all1 += t2[1]; }
            float kh0[4], kh1[4];
#pragma unroll
            for (int i = 0; i < 4; ++i) {
                const float b0 = off0 + cs0[i], b1 = off1 + cs1[i];
                const float q0 = qv0[i] * __expf(b0 - ref0), q1 = qv1[i] * __expf(b1 - ref1);
                kh0[i] = kv0[i] * __expf(ref0 - b0); kh1[i] = kv1[i] * __expf(ref1 - b1);
                const int t = 4 * w + i;
                *(LAS unsigned*)(base + OFF_QT + t * QS + k0 * 2) = pk2(q0, q1);
                *(LAS unsigned*)(base + OFF_KH + t * QS + k0 * 2) = pk2(kh0[i], kh1[i]);
            }
            *(LAS u32x2*)(base + OFF_KT + k0 * TS + 8 * w) = (u32x2){pk2(kh0[0], kh0[1]), pk2(kh0[2], kh0[3])};
            *(LAS u32x2*)(base + OFF_KT + (k0 + 1) * TS + 8 * w) = (u32x2){pk2(kh1[0], kh1[1]), pk2(kh1[2], kh1[3])};
            *(LAS u32x2*)(base + OFF_VT + k0 * TS + 8 * w) = (u32x2){(rv[0] & 0xffffu) | (rv[1] << 16), (rv[2] & 0xffffu) | (rv[3] << 16)};
            *(LAS u32x2*)(base + OFF_VT + (k0 + 1) * TS + 8 * w) = (u32x2){(rv[0] >> 16) | (rv[1] & 0xffff0000u), (rv[2] >> 16) | (rv[3] & 0xffff0000u)};
            if (w == 0) {
                *(LAS f32x2*)(base + OFF_EREF + k0 * 4) = (f32x2){__expf(ref0), __expf(ref1)};
                *(LAS f32x2*)(base + OFF_ELR + k0 * 4) = (f32x2){__expf(all0 - ref0), __expf(all1 - ref1)};
            }
            __syncthreads();
            if (c + 1 < 64) {
                const bf16_t* nb = PA + ((size_t)b * SEQ + (c + 1) * 32 + 4 * w) * 3072 + h * 128 + k0;
#pragma unroll
                for (int i = 0; i < 4; ++i) { rq[i] = *(const unsigned*)(nb + (size_t)i * 3072); rf[i] = *(const unsigned*)(nb + (size_t)i * 3072 + 1024); rv[i] = *(const unsigned*)(nb + (size_t)i * 3072 + 2048); }
            }
            bf16x8 qf[2][4], kf[2][4];
#pragma unroll
            for (int tt = 0; tt < 2; ++tt)
#pragma unroll
                for (int m = 0; m < 4; ++m) {
                    const LAS unsigned char* pq = base + OFF_QT + (16 * tt + fr) * QS + (32 * m + 4 * g) * 2;
                    const u32x2 lo = *(const LAS u32x2*)pq, hi = *(const LAS u32x2*)(pq + 32);
                    qf[tt][m] = __builtin_bit_cast(bf16x8, (u32x4){lo[0], lo[1], hi[0], hi[1]});
                    const LAS unsigned char* pk = base + OFF_KH + (16 * tt + fr) * QS + (32 * m + 4 * g) * 2;
                    const u32x2 lo2 = *(const LAS u32x2*)pk, hi2 = *(const LAS u32x2*)(pk + 32);
                    kf[tt][m] = __builtin_bit_cast(bf16x8, (u32x4){lo2[0], lo2[1], hi2[0], hi2[1]});
                }
            f32x4 PT00 = {0.f, 0.f, 0.f, 0.f}, PT01 = {0.f, 0.f, 0.f, 0.f}, PT11 = {0.f, 0.f, 0.f, 0.f};
#pragma unroll
            for (int m = 0; m < 4; ++m) {
                PT00 = __builtin_amdgcn_mfma_f32_16x16x32_bf16(kf[0][m], qf[0][m], PT00, 0, 0, 0);
                PT01 = __builtin_amdgcn_mfma_f32_16x16x32_bf16(kf[0][m], qf[1][m], PT01, 0, 0, 0);
                PT11 = __builtin_amdgcn_mfma_f32_16x16x32_bf16(kf[1][m], qf[1][m], PT11, 0, 0, 0);
            }
#pragma unroll
            for (int r = 0; r < 4; ++r) { if (4 * g + r > fr) { PT00[r] = 0.f; PT11[r] = 0.f; } }
            const bf16x8 pa0 = __builtin_bit_cast(bf16x8, (u32x4){pk2(PT00[0], PT00[1]), pk2(PT00[2], PT00[3]), 0u, 0u});
            const bf16x8 pa1 = __builtin_bit_cast(bf16x8, (u32x4){pk2(PT01[0], PT01[1]), pk2(PT01[2], PT01[3]), pk2(PT11[0], PT11[1]), pk2(PT11[2], PT11[3])});
            const LAS unsigned char* vrow = base + OFF_VT + (16 * w + fr) * TS;
            const u32x2 vpa = *(const LAS u32x2*)(vrow + 8 * g), vpb = *(const LAS u32x2*)(vrow + 32 + 8 * g);
            const u32x2 vna = *(const LAS u32x2*)(vrow + 16 * g), vnb = *(const LAS u32x2*)(vrow + 16 * g + 8);
            const bf16x8 vperm = __builtin_bit_cast(bf16x8, (u32x4){vpa[0], vpa[1], vpb[0], vpb[1]});
            const bf16x8 vnat = __builtin_bit_cast(bf16x8, (u32x4){vna[0], vna[1], vnb[0], vnb[1]});
#pragma unroll
            for (int kt = 0; kt < 8; ++kt) { const f32x4 e = *(const LAS f32x4*)(base + OFF_EREF + (16 * kt + 4 * g) * 4); S[kt] = S[kt] * e; }
            f32x4 O0 = {0.f, 0.f, 0.f, 0.f}, O1 = {0.f, 0.f, 0.f, 0.f};
#pragma unroll
            for (int m = 0; m < 4; ++m) {
                const bf16x8 sf = __builtin_bit_cast(bf16x8, (u32x4){pk2(S[2 * m][0], S[2 * m][1]), pk2(S[2 * m][2], S[2 * m][3]), pk2(S[2 * m + 1][0], S[2 * m + 1][1]), pk2(S[2 * m + 1][2], S[2 * m + 1][3])});
                O0 = __builtin_amdgcn_mfma_f32_16x16x32_bf16(qf[0][m], sf, O0, 0, 0, 0);
                O1 = __builtin_amdgcn_mfma_f32_16x16x32_bf16(qf[1][m], sf, O1, 0, 0, 0);
            }
            O0 = __builtin_amdgcn_mfma_f32_16x16x32_bf16(pa0, vperm, O0, 0, 0, 0);
            O1 = __builtin_amdgcn_mfma_f32_16x16x32_bf16(pa1, vperm, O1, 0, 0, 0);
#pragma unroll
            for (int kt = 0; kt < 8; ++kt) {
                const LAS unsigned char* krow = base + OFF_KT + (16 * kt + fr) * TS + 16 * g;
                const u32x2 ka = *(const LAS u32x2*)krow, kb = *(const LAS u32x2*)(krow + 8);
                const bf16x8 ktf = __builtin_bit_cast(bf16x8, (u32x4){ka[0], ka[1], kb[0], kb[1]});
                S[kt] = __builtin_amdgcn_mfma_f32_16x16x32_bf16(ktf, vnat, S[kt], 0, 0, 0);
            }
#pragma unroll
            for (int kt = 0; kt < 8; ++kt) { const f32x4 e = *(const LAS f32x4*)(base + OFF_ELR + (16 * kt + 4 * g) * 4); S[kt] = S[kt] * e; }
            bf16_t* orow = ORAW + ((size_t)b * SEQ + c * 32 + 4 * g) * D + h * 128 + 16 * w + fr;
#pragma unroll
            for (int r = 0; r < 4; ++r) { orow[(size_t)r * D] = (bf16_t)(pk2(O0[r], 0.f) & 0xffffu); orow[(size_t)(16 + r) * D] = (bf16_t)(pk2(O1[r], 0.f) & 0xffffu); }
        }
        __syncthreads();
    }
}

__device__ __forceinline__ void phase_s5(const KP& p, LAS unsigned char* lds, int l, int G, size_t ys_off) {
    const int tid = opaque_tid(), lane = tid & 63, w = __builtin_amdgcn_readfirstlane(tid >> 6), fr = lane & 15, g = lane >> 4;
    const int gw = blockIdx.x * 8 + w, ngw = G * 8;
    constexpr int BUS = 132;
    LAS float* BU = (LAS float*)(lds + w * 16896);
    LAS unsigned char* XI = (LAS unsigned char*)BU;
    const bf16_t* PB = (const bf16_t*)(p.ws + WS_R0);
    const bf16x8 zero8 = {0, 0, 0, 0, 0, 0, 0, 0};
    const bf16_t* ORAWs = (const bf16_t*)(p.ws + WS_OR); float* SSQs = (float*)(p.ws + WS_SSQ);
    for (int unit = gw; unit < BATCH * 64; unit += ngw) {
        const int b = unit >> 6, grp = unit & 63, lg = l * 64 + grp;
        const bf16_t* BOP = (const bf16_t*)(p.ws + WS_BOP) + (size_t)lg * 128 * 16;
        const bf16_t* COP = (const bf16_t*)(p.ws + WS_COP) + (size_t)lg * 16 * 128;
        bf16x8 bfrag[8], cfrag[4], dfrag;
#pragma unroll
        for (int nt = 0; nt < 8; ++nt) bfrag[nt] = (g < 2) ? *(const bf16x8*)(BOP + (size_t)(16 * nt + fr) * 16 + 8 * g) : zero8;
#pragma unroll
        for (int ks = 0; ks < 4; ++ks) cfrag[ks] = DBG_S5_NOSSM ? zero8 : *(const bf16x8*)(COP + (size_t)fr * 128 + 32 * ks + 8 * g);
        {
            const unsigned dbits = pk2(p.in[I_S5D][l * 1024 + grp * 16 + fr], 0.f) & 0xffffu;
#pragma unroll
            for (int j = 0; j < 8; ++j) dfrag[j] = (g < 2 && (8 * g + j) == fr) ? (short)dbits : (short)0;
        }
        const float ar = ((const float*)(p.ws + WS_ABAR))[2 * ((size_t)lg * 64 + lane)], ai = ((const float*)(p.ws + WS_ABAR))[2 * ((size_t)lg * 64 + lane) + 1];
        const float nai = -ai; float xr = 0.f, xi = 0.f; unsigned hBU = 0u, hXI = 0u, hY = 0u;
        const bf16_t* ub = PB + ((size_t)b * SEQ) * 4096 + 1024 + grp * 16;
        bf16_t* yb_ = (bf16_t*)(p.ws + ys_off) + ((size_t)b * SEQ) * D + grp * 16;
        bf16x8 unext[2];
#pragma unroll
        for (int tt = 0; tt < 2; ++tt) unext[tt] = (g < 2) ? *(const bf16x8*)(ub + (size_t)(16 * tt + fr) * 4096 + 8 * g) : zero8;
        const bool cvt_next = (l + 1 < DEPTH);
        const float* tsrc = ((lane < 32) ? p.in[I_PU] : p.in[I_PV]) + (size_t)(l + 1 < DEPTH ? l + 1 : l) * 16384 * 1024 + 4 * (lane & 31);
        unsigned char* tdst = p.ws + ((lane < 32) ? WS_U : WS_V) + (size_t)((l + 1) & 1) * TAB_BYTES + 4 * (lane & 31);
        const float tscale = (lane < 32) ? U_SCALE : V_SCALE;
        for (int t0 = 0; t0 < SEQ; t0 += 32) {
            const int item = unit * 64 + (t0 >> 5), te = item >> 3, tsl = item & 7;
            f32x4 tv = {0.f, 0.f, 0.f, 0.f}; if (cvt_next) tv = *(const f32x4*)(tsrc + (size_t)te * 1024 + tsl * 128);
            const bool ssq_it = ((t0 >> 5) & 1) == 0; const int srow = item >> 1;
            u32x4 sa = {0u, 0u, 0u, 0u}, sc2 = {0u, 0u, 0u, 0u};
            if (ssq_it) { sa = *(const u32x4*)(ORAWs + (size_t)srow * D + 8 * lane); sc2 = *(const u32x4*)(ORAWs + (size_t)srow * D + 512 + 8 * lane); }
            bf16x8 ufrag[2];
#pragma unroll
            for (int tt = 0; tt < 2; ++tt) { ufrag[tt] = unext[tt]; if (t0 + 32 < SEQ) unext[tt] = (g < 2) ? *(const bf16x8*)(ub + (size_t)(t0 + 32 + 16 * tt + fr) * 4096 + 8 * g) : zero8; }
#pragma unroll
            for (int tt = 0; tt < 2; ++tt)
#pragma unroll
                for (int nt = 0; nt < 8; ++nt) {
                    const f32x4 a = __builtin_amdgcn_mfma_f32_16x16x32_bf16(ufrag[tt], bfrag[nt], (f32x4){0.f, 0.f, 0.f, 0.f}, 0, 0, 0);
#pragma unroll
                    for (int r = 0; r < 4; ++r) BU[(16 * tt + 4 * g + r) * BUS + 16 * nt + fr] = a[r];
                }
            LDS_WAIT();
#pragma unroll
            for (int t = 0; t < 32; ++t) {
                const f32x2 bb = *(const LAS f32x2*)(BU + t * BUS + 2 * lane); hBU += __float_as_uint(bb[0]) * 3u + __float_as_uint(bb[1]);
                float t1, t2, nr, ni;
                asm("v_fma_f32 %0, %1, %2, %3" : "=v"(t1) : "v"(nai), "v"(xi), "v"(bb[0]));
                asm("v_fma_f32 %0, %1, %2, %3" : "=v"(t2) : "v"(ai), "v"(xr), "v"(bb[1]));
                asm("v_fma_f32 %0, %1, %2, %3" : "=v"(nr) : "v"(ar), "v"(xr), "v"(t1));
                asm("v_fma_f32 %0, %1, %2, %3" : "=v"(ni) : "v"(ar), "v"(xi), "v"(t2));
                xr = nr; xi = ni;
                { const unsigned pv = pk2(nr, ni); hXI += pv; *(LAS unsigned*)(XI + t * (BUS * 4) + lane * 4) = pv; }
            }
            LDS_WAIT();
#pragma unroll
            for (int tt = 0; tt < 2; ++tt) {
                f32x4 y = {0.f, 0.f, 0.f, 0.f};
#pragma unroll
                for (int ks = 0; ks < 4; ++ks) {
                    const bf16x8 xf = *(const LAS bf16x8*)(XI + (16 * tt + fr) * (BUS * 4) + (32 * ks + 8 * g) * 2);
                    y = __builtin_amdgcn_mfma_f32_16x16x32_bf16(xf, cfrag[ks], y, 0, 0, 0);
                }
                y = __builtin_amdgcn_mfma_f32_16x16x32_bf16(ufrag[tt], dfrag, y, 0, 0, 0);
#pragma unroll
                for (int r = 0; r < 4; ++r) { const unsigned yv = pk2(fgelu(y[r]), 0.f) & 0xffffu; hY += yv * (unsigned)(r + 1); yb_[(size_t)(t0 + 16 * tt + 4 * g + r) * D + fr] = (bf16_t)yv; }
            }
            LDS_WAIT();
            if (ssq_it) { float s0 = 0.f, s1 = 0.f;
#pragma unroll
                for (int j = 0; j < 4; ++j) { const float x0 = bflo(sa[j]), x1 = bfhi(sa[j]), y0 = bflo(sc2[j]), y1 = bfhi(sc2[j]); s0 += x0 * x0 + x1 * x1; s1 += y0 * y0 + y1 * y1; }
                { s0 = dpp_sum8(s0); s1 = dpp_sum8(s1);
                  s0 += __uint_as_float(__builtin_amdgcn_update_dpp(0, __float_as_uint(s0), 0x140, 0xF, 0xF, true)); s1 += __uint_as_float(__builtin_amdgcn_update_dpp(0, __float_as_uint(s1), 0x140, 0xF, 0xF, true)); }
                if (fr == 0) { SSQs[(size_t)srow * 8 + g] = s0; SSQs[(size_t)srow * 8 + 4 + g] = s1; } }
            if (cvt_next) { int w8 = 0; w8 = __builtin_amdgcn_cvt_pk_fp8_f32(tv[0] * tscale, tv[1] * tscale, w8, false); w8 = __builtin_amdgcn_cvt_pk_fp8_f32(tv[2] * tscale, tv[3] * tscale, w8, true);
                *(unsigned*)(tdst + ((size_t)tsl * 16384 + te) * 128) = (unsigned)w8; }
        }
        if (DBG_SELFCHECK) { for (int o = 1; o < 64; o <<= 1) { hBU += __shfl_xor((int)hBU, o); hXI += __shfl_xor((int)hXI, o); hY += __shfl_xor((int)hY, o); }
            unsigned* hs = (unsigned*)(p.ws + WS_CTL) + 65536 + (ys_off == WS_YS ? 0 : 8192) + unit * 4; unsigned hA = __float_as_uint(ar) * 7u + __float_as_uint(ai); for (int o = 1; o < 64; o <<= 1) hA += __shfl_xor((int)hA, o); if (lane == 0) { hs[0] = hBU; hs[1] = hXI; hs[2] = hA; } }
    }
}

__device__ __forceinline__ unsigned fkey(float f) { const unsigned u = __float_as_uint(f); return u ^ ((unsigned)((int)u >> 31) | 0x80000000u); }
__device__ __forceinline__ float kval(unsigned k) { const unsigned u = (k & 0x80000000u) ? (k ^ 0x80000000u) : ~k; return __uint_as_float(u); }
#define CE_DESC(a, b) do { const unsigned _mx = (a) > (b) ? (a) : (b), _mn = (a) > (b) ? (b) : (a); (a) = _mx; (b) = _mn; } while (0)
__device__ __forceinline__ void sort16_desc(unsigned (&a)[16]) {
#pragma unroll
    for (int kk = 1; kk <= 4; ++kk)
#pragma unroll
        for (int jj = kk - 1; jj >= 0; --jj)
#pragma unroll
            for (int i = 0; i < 16; ++i) { const int k = 1 << kk, j = 1 << jj, l2 = i ^ j;
                if (l2 > i) { if ((i & k) == 0) CE_DESC(a[i], a[l2]); else CE_DESC(a[l2], a[i]); } }
}
__device__ __forceinline__ void merge_top16(unsigned (&a)[16], const unsigned (&b)[16]) {
#pragma unroll
    for (int i = 0; i < 16; ++i) a[i] = a[i] > b[15 - i] ? a[i] : b[15 - i];
#pragma unroll
    for (int jj = 3; jj >= 0; --jj)
#pragma unroll
        for (int i = 0; i < 16; ++i) { const int j = 1 << jj, l2 = i ^ j; if (l2 > i) CE_DESC(a[i], a[l2]); }
}
__device__ __forceinline__ void phase_topk(const KP& p, LAS unsigned char* lds, int G) {
    const int tid = opaque_tid(), lane = tid & 63, w = __builtin_amdgcn_readfirstlane(tid >> 6), hh = lane >> 5;
    const int gw = blockIdx.x * 8 + w, ngw = G * 8;
    const bf16_t* Q = (const bf16_t*)(p.ws + WS_R0); const bf16_t* KEYS = (const bf16_t*)(p.ws + WS_KEYS);
    unsigned* SEL = (unsigned*)(p.ws + WS_SEL);
    LAS unsigned char* tab = lds + w * 2048 + lane * 32;
    const int CI[50] = {0,0,0,0,0,0,0,0,0,0,0,0,0,0,0,0, 1,1,1,1,1,1,1,1, 2,2,2,2,2, 3,3,3,3, 4,4,4, 5,5, 6,6, 7,7, 8,9,10,11,12,13,14,15};
    const int CJ[50] = {0,1,2,3,4,5,6,7,8,9,10,11,12,13,14,15, 0,1,2,3,4,5,6,7, 0,1,2,3,4, 0,1,2,3, 0,1,2, 0,1, 0,1, 0,1, 0,0,0,0,0,0,0,0};
    LAS unsigned char* kimg = lds + 16384;
    for (int h = 0; h < 8; ++h) {
      __syncthreads();
#pragma unroll
      for (int i = 0; i < 8; ++i) { const int ch = tid + 512 * i, row = ch >> 4, c16 = ch & 15;
          *(LAS u32x4*)(kimg + row * 272 + c16 * 16) = *(const u32x4*)(KEYS + (size_t)(h * 256 + row) * 128 + c16 * 8); }
      __syncthreads();
      for (int tg = gw; tg < 2048; tg += ngw) {
        const int t = tg * 32 + (lane & 31);
        unsigned top[2][16];
#pragma unroll
        for (int pp = 0; pp < 2; ++pp) {
            bf16x8 qf[8];
#pragma unroll
            for (int ks = 0; ks < 8; ++ks) qf[ks] = *(const bf16x8*)(Q + ((size_t)((((tg * 8 + h) * 2 + pp) * 8 + ks) * 64 + lane)) * 8);
            const LAS unsigned char* kb = kimg + (pp * 128 + (lane & 31)) * 272 + 16 * hh;
#pragma unroll
            for (int nt = 0; nt < 4; ++nt) {
                f32x16 acc;
#pragma unroll
                for (int i = 0; i < 16; ++i) acc[i] = 0.f;
#pragma unroll
                for (int ks = 0; ks < 8; ++ks) { const bf16x8 kf = *(const LAS bf16x8*)(kb + (32 * nt) * 272 + 32 * ks);
                    acc = __builtin_amdgcn_mfma_f32_32x32x16_bf16(kf, qf[ks], acc, 0, 0, 0); }
                unsigned ky[16];
#pragma unroll
                for (int r = 0; r < 16; ++r) ky[r] = (fkey(acc[r]) & ~127u) | (unsigned)(32 * nt + (r & 3) + 8 * (r >> 2)) | (unsigned)(4 * hh);
                sort16_desc(ky);
                if (nt == 0) {
#pragma unroll
                    for (int i = 0; i < 16; ++i) top[pp][i] = ky[i];
                } else merge_top16(top[pp], ky);
            }
            unsigned other[16];
#pragma unroll
            for (int i = 0; i < 16; ++i) { const u32x2 sw_ = __builtin_amdgcn_permlane32_swap(top[pp][i], top[pp][i], false, false); other[i] = hh ? sw_[0] : sw_[1]; }
            merge_top16(top[pp], other);
        }
        float sa[16], sb[16];
#pragma unroll
        for (int i = 0; i < 16; ++i) { sa[i] = kval(top[0][i] & ~127u); sb[i] = kval(top[1][i] & ~127u); }
        unsigned c0[16], c1[16];
#pragma unroll
        for (int s = 0; s < 32; ++s) {
            unsigned key = 0u;
            if (s < 25) {
                const float v0 = sa[CI[s]] + sb[CJ[s]], v1 = sa[CI[25 + s]] + sb[CJ[25 + s]];
                const unsigned k0 = (fkey(v0) & ~255u) | (unsigned)(CI[s] * 16 + CJ[s]), k1 = (fkey(v1) & ~255u) | (unsigned)(CI[25 + s] * 16 + CJ[25 + s]);
                key = hh ? k1 : k0;
            }
            if (s < 16) c0[s] = key; else c1[s - 16] = key;
        }
        sort16_desc(c0); sort16_desc(c1); merge_top16(c0, c1);
#pragma unroll
        for (int i = 0; i < 16; ++i) { const u32x2 sw_ = __builtin_amdgcn_permlane32_swap(c0[i], c0[i], false, false); c1[i] = hh ? sw_[0] : sw_[1]; }
        merge_top16(c0, c1);
        {
            u32x4 wa, wb;
#pragma unroll
            for (int q4 = 0; q4 < 4; ++q4) {
                wa[q4] = (top[0][4 * q4] & 127u) | ((top[0][4 * q4 + 1] & 127u) << 8) | ((top[0][4 * q4 + 2] & 127u) << 16) | ((top[0][4 * q4 + 3] & 127u) << 24);
                wb[q4] = (top[1][4 * q4] & 127u) | ((top[1][4 * q4 + 1] & 127u) << 8) | ((top[1][4 * q4 + 2] & 127u) << 16) | ((top[1][4 * q4 + 3] & 127u) << 24);
            }
            *(LAS u32x4*)tab = wa; *(LAS u32x4*)(tab + 16) = wb;
        }
        float ev[16], esum = 0.f; const float vmax = kval(c0[0] & ~255u);
#pragma unroll
        for (int k = 0; k < 16; ++k) { ev[k] = __expf(kval(c0[k] & ~255u) - vmax); esum += ev[k]; }
        const float rs = 1.0f / esum;
        LDS_WAIT();
        unsigned outw[8]; const unsigned hmask = hh ? 0xffffffffu : 0u;
#pragma unroll
        for (int kk = 0; kk < 8; ++kk) {
            const unsigned key = c0[kk] ^ ((c0[kk] ^ c0[8 + kk]) & hmask); const float e = __uint_as_float(__float_as_uint(ev[kk]) ^ ((__float_as_uint(ev[kk]) ^ __float_as_uint(ev[8 + kk])) & hmask));
            const unsigned code = key & 255u, ia = tab[code >> 4], ib = tab[16 + (code & 15u)];
            outw[kk] = (pk2(0.f, e * rs) & 0xffff0000u) | (ia * 128u + ib);
        }
        u32x4* dst = (u32x4*)(SEL + (size_t)t * 128 + h * 16 + hh * 8);
        dst[0] = (u32x4){outw[0], outw[1], outw[2], outw[3]}; dst[1] = (u32x4){outw[4], outw[5], outw[6], outw[7]};
        LDS_WAIT();
      }
    }
    __syncthreads();
}

__device__ __forceinline__ void fp8x4_to_f32(unsigned w, float& a, float& b, float& c, float& d) {
    const f32x2 lo = __builtin_amdgcn_cvt_pk_f32_fp8((int)w, false), hi = __builtin_amdgcn_cvt_pk_f32_fp8((int)w, true); a = lo[0]; b = lo[1]; c = hi[0]; d = hi[1];
}
struct XSlice { int sl, rank, nloc; };
__device__ __forceinline__ XSlice xslice_of_block(const KP& p, volatile LAS unsigned* MISC, int G) {
    unsigned* bar = (unsigned*)(p.ws + WS_CTL) + 4096; unsigned cnt[8]; unsigned tot = 0; bool ok = true;
#pragma unroll
    for (int j = 0; j < 8; ++j) { cnt[j] = xb_ld(&bar[XB_XCNT(j)]); tot += cnt[j]; ok = ok && (cnt[j] > 0u); }
    ok = ok && (tot == (unsigned)G);
    XSlice x;
    if (ok) { const unsigned myx = MISC[16]; x.sl = (int)myx; x.rank = (int)MISC[17]; x.nloc = (int)cnt[myx & 7u]; }
    else { x.sl = (int)(blockIdx.x & 7); x.rank = (int)(blockIdx.x >> 3); x.nloc = (G - x.sl + 7) >> 3; }
    x.sl = __builtin_amdgcn_readfirstlane(x.sl); x.rank = __builtin_amdgcn_readfirstlane(x.rank); x.nloc = __builtin_amdgcn_readfirstlane(x.nloc);
    return x;
}
__device__ __forceinline__ float dot16_fp8(const u32x4 u, const float (&hf)[16]) {
    float d = 0.f;
#pragma unroll
    for (int j = 0; j < 4; ++j) { float f0, f1, f2, f3; fp8x4_to_f32(u[j], f0, f1, f2, f3);
        d = __builtin_fmaf(f0, hf[4 * j], d); d = __builtin_fmaf(f1, hf[4 * j + 1], d); d = __builtin_fmaf(f2, hf[4 * j + 2], d); d = __builtin_fmaf(f3, hf[4 * j + 3], d); }
    return d;
}
typedef __bf16 bf16v8 __attribute__((ext_vector_type(8)));
__device__ __forceinline__ float dot16_fp8_bf16(const u32x4 u, const bf16v8 h0, const bf16v8 h1) {
    float d0 = 0.f, d1 = 0.f;
    d0 = __builtin_amdgcn_fdot2_f32_bf16(__builtin_amdgcn_cvt_scalef32_pk_bf16_fp8(u[0], 1.0f, false), __builtin_shufflevector(h0, h0, 0, 1), d0, false);
    d1 = __builtin_amdgcn_fdot2_f32_bf16(__builtin_amdgcn_cvt_scalef32_pk_bf16_fp8(u[0], 1.0f, true),  __builtin_shufflevector(h0, h0, 2, 3), d1, false);
    d0 = __builtin_amdgcn_fdot2_f32_bf16(__builtin_amdgcn_cvt_scalef32_pk_bf16_fp8(u[1], 1.0f, false), __builtin_shufflevector(h0, h0, 4, 5), d0, false);
    d1 = __builtin_amdgcn_fdot2_f32_bf16(__builtin_amdgcn_cvt_scalef32_pk_bf16_fp8(u[1], 1.0f, true),  __builtin_shufflevector(h0, h0, 6, 7), d1, false);
    d0 = __builtin_amdgcn_fdot2_f32_bf16(__builtin_amdgcn_cvt_scalef32_pk_bf16_fp8(u[2], 1.0f, false), __builtin_shufflevector(h1, h1, 0, 1), d0, false);
    d1 = __builtin_amdgcn_fdot2_f32_bf16(__builtin_amdgcn_cvt_scalef32_pk_bf16_fp8(u[2], 1.0f, true),  __builtin_shufflevector(h1, h1, 2, 3), d1, false);
    d0 = __builtin_amdgcn_fdot2_f32_bf16(__builtin_amdgcn_cvt_scalef32_pk_bf16_fp8(u[3], 1.0f, false), __builtin_shufflevector(h1, h1, 4, 5), d0, false);
    d1 = __builtin_amdgcn_fdot2_f32_bf16(__builtin_amdgcn_cvt_scalef32_pk_bf16_fp8(u[3], 1.0f, true),  __builtin_shufflevector(h1, h1, 6, 7), d1, false);
    return d0 + d1;
}
__device__ __forceinline__ float dpp_sum8(float d) {
    d += __uint_as_float(__builtin_amdgcn_update_dpp(0, __float_as_uint(d), 0xB1, 0xF, 0xF, true));
    d += __uint_as_float(__builtin_amdgcn_update_dpp(0, __float_as_uint(d), 0x4E, 0xF, 0xF, true));
    d += __uint_as_float(__builtin_amdgcn_update_dpp(0, __float_as_uint(d), 0x141, 0xF, 0xF, true));
    return d;
}
__device__ __forceinline__ void phase_expert_u(const KP& p, LAS unsigned char* lds, volatile LAS unsigned* MISC, int l, int G) {
    const int tid = opaque_tid(), lane = tid & 63, w = __builtin_amdgcn_readfirstlane(tid >> 6), j = lane >> 3, c = lane & 7, i16 = lane & 15, kq = lane >> 4;
    const XSlice xs = xslice_of_block(p, MISC, G);
    const unsigned char* XF = p.ws + WS_XF8 + (size_t)xs.sl * M * 128; const unsigned char* Us = p.ws + WS_U + (size_t)(l & 1) * TAB_BYTES + (size_t)xs.sl * 16384 * 128;
    const unsigned* SEL = (const unsigned*)(p.ws + WS_SEL); unsigned* PDu = (unsigned*)(p.ws + WS_R0) + (size_t)xs.sl * M * 64;
    const int t0 = xs.rank * 8 + w, tstep = xs.nloc * 8;
    LAS unsigned char* ring = lds + w * 18176;
    LAS unsigned char* selb = ring + 16384; LAS unsigned char* hbuf = ring + 16384 + 1024; LAS unsigned char* pdscr = ring + 16384 + 1024 + 512;
    const int tlast = t0 + ((M - 1 - t0) / tstep) * tstep;
    const int ai = (int)((0x5172023724663367ull >> (4 * i16)) & 7ull);
    const int ch0 = (ai ^ (2 * kq)) & 7, ch1 = ch0 ^ 1;
    const int rowoff = (i16 >> 3) * 1024 + (i16 & 7) * 128;
    const bool diag = kq == (i16 >> 2);
    LAS unsigned short* pdw = (LAS unsigned short*)pdscr + 16 * (i16 & 7) + (i16 >> 3);
#define E1_CL(t) ((t) <= tlast ? (t) : tlast)
#define E1_DMA_SEL(t, par) do { const unsigned* sp = SEL + (size_t)E1_CL(t) * 128 + lane; \
            __builtin_amdgcn_global_load_lds(sp, (LAS unsigned*)(selb + (par) * 512), 4, 0, 0); __builtin_amdgcn_global_load_lds(sp + 64, (LAS unsigned*)(selb + (par) * 512 + 256), 4, 0, 0); } while (0)
#define E1_DMA_H(t, par) do { __builtin_amdgcn_global_load_lds((const unsigned*)(XF + (size_t)E1_CL(t) * 128) + lane, (LAS unsigned*)(hbuf + (par) * 256), 4, 0, 0); } while (0)
#define E1_DMA_ROW(i, idxv) do { __builtin_amdgcn_global_load_lds((const unsigned*)(Us + (size_t)((idxv) & 0x3fffu) * 128 + 16 * c), (LAS unsigned*)(ring + (i) * 1024), 16, 0, 0); } while (0)
    if (t0 < M) {
        E1_DMA_SEL(t0, 0); E1_DMA_SEL(t0 + tstep, 1); E1_DMA_H(t0, 0);
        asm volatile("s_waitcnt vmcnt(0)" ::: "memory");
        { u32x4 s0[4];
#pragma unroll
          for (int q = 0; q < 4; ++q) s0[q] = *(const LAS u32x4*)(selb + (16 * j + 4 * q) * 4);
#pragma unroll
          for (int i = 0; i < 16; ++i) E1_DMA_ROW(i, s0[i >> 2][i & 3]); }
        { PDu[(size_t)t0 * 64 + lane] = 0u; }
        int par = 0;
        for (int tok = t0; tok < M; tok += tstep, par ^= 1) {
            E1_DMA_SEL(tok + 2 * tstep, par); E1_DMA_H(tok + tstep, par ^ 1);
            asm volatile("s_waitcnt vmcnt(19)" ::: "memory");
            u32x4 sn[4];
#pragma unroll
            for (int q = 0; q < 4; ++q) sn[q] = *(const LAS u32x4*)(selb + (par ^ 1) * 512 + (16 * j + 4 * q) * 4);
            const i32x4 xb0 = *(const LAS i32x4*)(hbuf + par * 256 + 16 * ch0), xb1 = *(const LAS i32x4*)(hbuf + par * 256 + 16 * ch1);
            const i32x8 B = __builtin_shufflevector(xb0, xb1, 0, 1, 2, 3, 4, 5, 6, 7);
#pragma unroll
            for (int i0 = 0; i0 < 16; i0 += 4) {
                asm volatile("s_waitcnt vmcnt(16)" ::: "memory");
                const LAS unsigned char* rb = ring + i0 * 1024 + rowoff;
                const i32x4 a0 = *(const LAS i32x4*)(rb + 16 * ch0), a1 = *(const LAS i32x4*)(rb + 16 * ch1), a2 = *(const LAS i32x4*)(rb + 2048 + 16 * ch0), a3 = *(const LAS i32x4*)(rb + 2048 + 16 * ch1);
                asm volatile("s_waitcnt lgkmcnt(0)" ::: "memory");
#pragma unroll
                for (int r = 0; r < 4; ++r) E1_DMA_ROW(i0 + r, sn[(i0 + r) >> 2][(i0 + r) & 3]);
                const f32x4 z = {0.f, 0.f, 0.f, 0.f};
                const f32x4 d0 = __builtin_amdgcn_mfma_scale_f32_16x16x128_f8f6f4(__builtin_shufflevector(a0, a1, 0, 1, 2, 3, 4, 5, 6, 7), B, z, 0, 0, 0, 0x7f7f7f7f, 0, 0x7f7f7f7f);
                const f32x4 d1 = __builtin_amdgcn_mfma_scale_f32_16x16x128_f8f6f4(__builtin_shufflevector(a2, a3, 0, 1, 2, 3, 4, 5, 6, 7), B, z, 0, 0, 0, 0x7f7f7f7f, 0, 0x7f7f7f7f);
                const float v0 = (i16 & 2) ? ((i16 & 1) ? d0[3] : d0[2]) : ((i16 & 1) ? d0[1] : d0[0]), v1 = (i16 & 2) ? ((i16 & 1) ? d1[3] : d1[2]) : ((i16 & 1) ? d1[1] : d1[0]);
                if (diag) { pdw[i0] = (unsigned short)(pk2(v0, 0.f) & 0xffffu); pdw[i0 + 2] = (unsigned short)(pk2(v1, 0.f) & 0xffffu); }
            }
            asm volatile("s_waitcnt lgkmcnt(0)" ::: "memory");
            PDu[(size_t)tok * 64 + lane] = *(const LAS unsigned*)(pdscr + 4 * lane);
        }
        asm volatile("s_waitcnt vmcnt(0)" ::: "memory");
    }
#undef E1_CL
#undef E1_DMA_SEL
#undef E1_DMA_H
#undef E1_DMA_ROW
}
__device__ __forceinline__ void phase_expert_w(const KP& p, int G) {
    const int tid = opaque_tid(), lane = tid & 63, w = __builtin_amdgcn_readfirstlane(tid >> 6);
    const int gw = blockIdx.x * 8 + w, ngw = G * 8;
    unsigned* SEL = (unsigned*)(p.ws + WS_SEL); const unsigned* PDu = (const unsigned*)(p.ws + WS_R0);
    for (int tok0 = gw; tok0 < M; tok0 += 4 * ngw) {
        unsigned pw[4][8]; u32x2 s2[4];
#pragma unroll
        for (int k = 0; k < 4; ++k) { const int tok = (tok0 + k * ngw < M) ? tok0 + k * ngw : tok0;
#pragma unroll
            for (int sl = 0; sl < 8; ++sl) pw[k][sl] = PDu[((size_t)sl * M + tok) * 64 + lane];
            s2[k] = *(const u32x2*)(SEL + (size_t)tok * 128 + 2 * lane); }
#pragma unroll
        for (int k = 0; k < 4; ++k) { const int tok = tok0 + k * ngw;
            f32x2 d = {0.f, 0.f};
#pragma unroll
            for (int sl = 0; sl < 8; ++sl) { d[0] += bflo(pw[k][sl]); d[1] += bfhi(pw[k][sl]); }
            const float w0 = __uint_as_float(s2[k][0] & 0xffff0000u) * fgelu(d[0] * (1.0f / (U_SCALE * X_SCALE))) * (1.0f / V_SCALE);
            const float w1 = __uint_as_float(s2[k][1] & 0xffff0000u) * fgelu(d[1] * (1.0f / (U_SCALE * X_SCALE))) * (1.0f / V_SCALE);
            u32x2 o; o[0] = (pk2(0.f, w0) & 0xffff0000u) | (s2[k][0] & 0x3fffu); o[1] = (pk2(0.f, w1) & 0xffff0000u) | (s2[k][1] & 0x3fffu);
            if (tok < M) { *(u32x2*)(SEL + (size_t)tok * 128 + 2 * lane) = o;
                const int wq = __builtin_amdgcn_cvt_pk_fp8_f32(w0 * W8_SCALE, w1 * W8_SCALE, 0, false); const int s_ = (2 * lane) & 15, q_ = lane >> 3;
                unsigned char* wf = p.ws + WS_WF8 + (size_t)tok * 128 + 32 * (s_ >> 2) + 8 * (s_ & 3) + q_; wf[0] = (unsigned char)(wq & 255); wf[8] = (unsigned char)((wq >> 8) & 255); } }
    }
}
__device__ __forceinline__ void phase_expert_v(const KP& p, LAS unsigned char* lds, volatile LAS unsigned* MISC, int l, int G) {
    const int tid = opaque_tid(), lane = tid & 63, w = __builtin_amdgcn_readfirstlane(tid >> 6), j = lane >> 3, c = lane & 7, li = lane & 15, g = lane >> 4;
    const XSlice xs = xslice_of_block(p, MISC, G);
    const unsigned char* Vs = p.ws + WS_V + (size_t)(l & 1) * TAB_BYTES + (size_t)xs.sl * 16384 * 128;
    const unsigned* SEL = (const unsigned*)(p.ws + WS_SEL); const unsigned char* WF = p.ws + WS_WF8;
    const float* g2 = (const float*)(p.ws + WS_MOD) + (size_t)l * 32 * NMODC + 5120;
    const bf16_t* X = (const bf16_t*)p.out; bf16_t* XO = (l == DEPTH - 1) ? (bf16_t*)(p.ws + WS_YS) : (bf16_t*)p.out;
    const int t0 = xs.rank * 8 + w, tstep = xs.nloc * 8;
    LAS unsigned char* ring = lds + w * 19456; LAS unsigned char* selb = ring + 16384;
    LAS unsigned char* xbuf = ring + 16384 + 1024;
    LAS unsigned char* wbuf = ring + 16384 + 1024 + 256;
    LAS float* obuf = (LAS float*)(ring + 16384 + 1024 + 768);
    const int tlast = t0 + ((M - 1 - t0) / tstep) * tstep;
    int troff[8];
#pragma unroll
    for (int n = 0; n < 8; ++n) troff[n] = (li >> 1) * 128 + 16 * (n ^ (li >> 1) ^ (g & 1)) + 8 * (li & 1);
    const int dim = xs.sl * 128 + 2 * lane;
#define E2_CL(t) ((t) <= tlast ? (t) : tlast)
#define E2_DMA_SEL(t, par) do { const unsigned* sp = SEL + (size_t)E2_CL(t) * 128 + lane; \
            __builtin_amdgcn_global_load_lds(sp, (LAS unsigned*)(selb + (par) * 512), 4, 0, 0); __builtin_amdgcn_global_load_lds(sp + 64, (LAS unsigned*)(selb + (par) * 512 + 256), 4, 0, 0); } while (0)
#define E2_DMA_WF(t, par) __builtin_amdgcn_global_load_lds((const unsigned*)(WF + (size_t)E2_CL(t) * 128) + lane, (LAS unsigned*)(wbuf + (par) * 256), 4, 0, 0)
#define E2_DMA_ROW(s_, idxv) do { __builtin_amdgcn_global_load_lds((const unsigned*)(Vs + (size_t)((idxv) & 0x3fffu) * 128 + 16 * (c ^ j ^ (((s_) >> 2) & 1))), (LAS unsigned*)(ring + (s_) * 1024), 16, 0, 0); } while (0)
#define E2_SLOT(k) (4 * ((k) & 3) + ((k) >> 2))
    if (t0 < M) {
        E2_DMA_SEL(t0, 0); E2_DMA_SEL(t0 + tstep, 1); E2_DMA_WF(t0, 0);
        asm volatile("s_waitcnt vmcnt(0)" ::: "memory");
        { u32x4 sc[4];
#pragma unroll
          for (int q = 0; q < 4; ++q) sc[q] = *(const LAS u32x4*)(selb + (16 * j + 4 * q) * 4);
#pragma unroll
          for (int k = 0; k < 16; ++k) { const int s_ = E2_SLOT(k); E2_DMA_ROW(s_, sc[s_ >> 2][s_ & 3]); } }
        { __builtin_amdgcn_global_load_lds((const unsigned*)(X + (size_t)t0 * D + dim), (LAS unsigned*)xbuf, 4, 0, 0); }
        int par = 0, bcur = -1; f32x2 gv = {0.f, 0.f};
        for (int tok = t0; tok < M; tok += tstep, par ^= 1) {
            const size_t xo = (size_t)tok * D + dim;
            if ((tok >> 11) != bcur) { bcur = tok >> 11; const f32x2 gl = *(const f32x2*)(g2 + (size_t)bcur * NMODC + dim); asm volatile("s_waitcnt vmcnt(0)" ::: "memory"); gv[0] = gl[0] * (1.0f / W8_SCALE); gv[1] = gl[1] * (1.0f / W8_SCALE); asm volatile("" : "+v"(gv)); }
            E2_DMA_SEL(tok + 2 * tstep, par);
            __builtin_amdgcn_global_load_lds((const unsigned*)(X + xo), (LAS unsigned*)xbuf, 4, 0, 0);
            E2_DMA_WF(tok + tstep, par ^ 1);
            asm volatile("s_waitcnt vmcnt(21)" ::: "memory");
            u32x4 sn[4];
#pragma unroll
            for (int q = 0; q < 4; ++q) sn[q] = *(const LAS u32x4*)(selb + (par ^ 1) * 512 + (16 * j + 4 * q) * 4);
            i32x8 A;
            { const i32x4 wa = *(const LAS i32x4*)(wbuf + par * 256 + 32 * g), wb = *(const LAS i32x4*)(wbuf + par * 256 + 32 * g + 16);
#pragma unroll
              for (int q = 0; q < 4; ++q) { A[q] = (li == 0) ? wa[q] : 0; A[4 + q] = (li == 0) ? wb[q] : 0; } }
            int Bm[8][8];
#pragma unroll
            for (int t = 0; t < 4; ++t) {
                asm volatile("s_waitcnt vmcnt(17)" ::: "memory");
                const LAS unsigned char* sb = ring + (4 * g + t) * 1024;
#pragma unroll
                for (int n = 0; n < 8; ++n) { const i32x2 r2_ = __builtin_amdgcn_ds_read_tr8_b64_v2i32((LAS i32x2*)(sb + troff[n])); Bm[n][2 * t] = r2_[0]; Bm[n][2 * t + 1] = r2_[1]; }
                asm volatile("s_waitcnt lgkmcnt(0)" ::: "memory");
#pragma unroll
                for (int k = 4 * t; k < 4 * t + 4; ++k) { const int s_ = E2_SLOT(k); E2_DMA_ROW(s_, sn[s_ >> 2][s_ & 3]); }
            }
#pragma unroll
            for (int n = 0; n < 8; ++n) { const f32x4 z = {0.f, 0.f, 0.f, 0.f};
                const i32x8 Bv = {Bm[n][0], Bm[n][1], Bm[n][2], Bm[n][3], Bm[n][4], Bm[n][5], Bm[n][6], Bm[n][7]};
                f32x4 d = __builtin_amdgcn_mfma_scale_f32_16x16x128_f8f6f4(A, Bv, z, 0, 0, 0, 0x7f7f7f7f, 0, 0x7f7f7f7f);
                asm volatile("" : "+v"(d));
                const float d0_ = d[0] + 0.0f;
                if (g == 0) obuf[16 * n + li] = d0_; }
            asm volatile("s_waitcnt lgkmcnt(0)" ::: "memory");
            const f32x2 ov = *(const LAS f32x2*)(obuf + 2 * lane);
            asm volatile("s_waitcnt vmcnt(16)" ::: "memory");
            { const unsigned xw = *(const LAS unsigned*)(xbuf + 4 * lane); *(unsigned*)(XO + xo) = pk2(bflo(xw) + gv[0] * ov[0], bfhi(xw) + gv[1] * ov[1]); }
        }
        asm volatile("s_waitcnt vmcnt(0)" ::: "memory");
    }
#undef E2_CL
#undef E2_DMA_SEL
#undef E2_DMA_WF
#undef E2_DMA_ROW
#undef E2_SLOT
}

__device__ __forceinline__ void phase_final(const KP& p, int G) {
    const int tid = opaque_tid(), lane = tid & 63, w = __builtin_amdgcn_readfirstlane(tid >> 6);
    const int gw = blockIdx.x * 8 + w, ngw = G * 8;
    const float* fg = p.in[I_FG];
    for (int r0 = gw * 4; r0 < M; r0 += ngw * 4) {
        f32x4 v[4][4]; float ss[4];
#pragma unroll
        for (int i = 0; i < 4; ++i) { const u32x2* xr = (const u32x2*)((const bf16_t*)(p.ws + WS_YS) + (size_t)(r0 + i) * D) + lane;
#pragma unroll
            for (int j = 0; j < 4; ++j) { const u32x2 xw = xr[64 * j]; v[i][j] = (f32x4){bflo(xw[0]), bfhi(xw[0]), bflo(xw[1]), bfhi(xw[1])}; } }
#pragma unroll
        for (int i = 0; i < 4; ++i) { float t = 0.f;
#pragma unroll
            for (int j = 0; j < 4; ++j) t += (v[i][j][0] * v[i][j][0] + v[i][j][1] * v[i][j][1]) + (v[i][j][2] * v[i][j][2] + v[i][j][3] * v[i][j][3]);
            ss[i] = t; }
#pragma unroll
        for (int o = 1; o < 64; o <<= 1) {
#pragma unroll
            for (int i = 0; i < 4; ++i) ss[i] += __shfl_xor(ss[i], o); }
#pragma unroll
        for (int j = 0; j < 4; ++j) { const f32x4 g4 = *(const f32x4*)(fg + 256 * j + 4 * lane);
#pragma unroll
            for (int i = 0; i < 4; ++i) { const float rstd = __builtin_amdgcn_rsqf(ss[i] * (1.0f / D) + EPS); ((f32x4*)(p.out + (size_t)(r0 + i) * D) + lane)[64 * j] = v[i][j] * rstd * g4; } }
    }
}

__global__ void __launch_bounds__(512, 2) mk_fwd(KP p_) {
    extern __shared__ __attribute__((aligned(16))) unsigned char lds_raw[];
    LAS unsigned char* lds = (LAS unsigned char*)lds_raw;
    const int tid = threadIdx.x, G = gridDim.x;
    volatile LAS unsigned* MISC = (volatile LAS unsigned*)(lds + MISC_OFF);
    for (int i = tid; i < LDS_BYTES / 4; i += 512) ((LAS unsigned*)lds)[i] = 0u;
    __syncthreads();
    XcdBarrier bar = xcd_barrier_post((unsigned*)(p_.ws + WS_CTL) + 4096, MISC + 8);
    if (tid == 0) { const unsigned myx = xb_xcc_id(); MISC[16] = myx; MISC[17] = xb_add((unsigned*)(p_.ws + WS_CTL) + 8192 + 64 * (myx & 15u), 1u); }
    __syncthreads();
    const int lo = p_.gp_lo, hi = p_.gp_hi;
#ifndef PH_MASK
#define PH_MASK 0xFFFFF
#endif
#define IN(k) (lo <= (k) && (k) < hi)
#define EN(b) ((PH_MASK >> (b)) & 1)
#ifndef PH_REPEAT
#define PH_REPEAT 0
#endif
#define NREP(b) (((PH_REPEAT >> (b)) & 1) ? 2 : 1)
#define SEAM(k) do { if ((k) + 1 < hi) xcd_barrier(bar); } while (0)
    if (EN(12) && IN(GP_SETUP)) { const KP p = load_kp(); phase_setup(p, lds, G); SEAM(GP_SETUP); }
    for (int l = 0; l < DEPTH; ++l) {
        const int g0 = 1 + l * NPH;
        if (EN(0) && IN(g0 + 0)) { _Pragma("nounroll") for (int rep = 0; rep < NREP(0); ++rep) { const KP p = load_kp(); phase_conv_norm1(p, lds, l, G); } SEAM(g0 + 0); }
        if (EN(1) && IN(g0 + 1)) { const KP p = load_kp();
            pg8::Gemm g{(const bf16_t*)(p.ws + WS_H), (const bf16_t*)(p.ws + WS_WIN), M, 3072, D / 2, D / 2, D / 2}; pg8::StaticOrder S; S.init(M, 3072, G, (int)blockIdx.x);
            pg8::EpiStoreBf16 E{(bf16_t*)(p.ws + WS_R0), 3072, 1.0f / (WIN_SCALE * HIN_SCALE)};
            _Pragma("nounroll") for (int rep = 0; rep < NREP(1); ++rep) pg8::gemm_phase<pg8::EpiStoreBf16, pg8::StaticOrder, false, true, true>(lds, g, S, E);
            SEAM(g0 + 1);
        }
        if (EN(2) && IN(g0 + 2)) { _Pragma("nounroll") for (int rep = 0; rep < NREP(2); ++rep) { const KP p = load_kp(); phase_hgrn2(p, lds, l, G); } SEAM(g0 + 2); }
        if (EN(3) && IN(g0 + 3)) { const KP p = load_kp();
            pg8::Gemm g{(const bf16_t*)(p.ws + WS_H), (const bf16_t*)(p.ws + WS_WIN) + (size_t)3072 * (D / 2), M, 4096, D / 2, D / 2, D / 2}; pg8::StaticOrder S; S.init(M, 4096, G, (int)blockIdx.x);
            pg8::EpiStoreBf16 E{(bf16_t*)(p.ws + WS_R0), 4096, 1.0f / (WIN_SCALE * HIN_SCALE)};
            _Pragma("nounroll") for (int rep = 0; rep < NREP(3); ++rep) pg8::gemm_phase<pg8::EpiStoreBf16, pg8::StaticOrder, false, true, true>(lds, g, S, E);
            SEAM(g0 + 3);
        }
        #if DBG_SELFCHECK
        if (EN(4) && IN(g0 + 4)) {
#pragma nounroll
            for (int rep = 0; rep < 2; ++rep) { const KP p = load_kp(); size_t yo = rep ? WS_H : WS_YS; asm volatile("" : "+s"(yo)); phase_s5(p, lds, l, G, yo); SEAM(g0 + 4); }
            const KP p = load_kp();
            const unsigned* a = (const unsigned*)(p.ws + WS_YS); const unsigned* b2 = (const unsigned*)(p.ws + WS_H); unsigned bad = 0;
            for (size_t i = (size_t)blockIdx.x * 512 + opaque_tid(); i < (size_t)M * D / 2; i += (size_t)G * 512) bad += (a[i] != b2[i]) ? 1u : 0u;
            if (bad) atomicAdd((unsigned*)(p.ws + WS_CTL) + 64, bad);
            { const unsigned* h1 = (const unsigned*)(p.ws + WS_CTL) + 65536; const unsigned* h2 = h1 + 8192; const int u2 = blockIdx.x * 512 + opaque_tid();
              if (u2 < 2048) { if (h1[u2 * 4] != h2[u2 * 4]) atomicAdd((unsigned*)(p.ws + WS_CTL) + 128, 1u); if (h1[u2 * 4 + 1] != h2[u2 * 4 + 1]) atomicAdd((unsigned*)(p.ws + WS_CTL) + 192, 1u); if (h1[u2 * 4 + 2] != h2[u2 * 4 + 2]) atomicAdd((unsigned*)(p.ws + WS_CTL) + 256, 1u); } }
            SEAM(g0 + 4); }
#else
        if (EN(4) && IN(g0 + 4)) { _Pragma("nounroll") for (int rep = 0; rep < NREP(4); ++rep) { const KP p = load_kp(); phase_s5(p, lds, l, G, WS_YS); } SEAM(g0 + 4); }
#endif
        if (EN(5) && IN(g0 + 5)) { const KP p = load_kp();
            pg8::Gemm g{(const bf16_t*)(p.ws + WS_YS), (const bf16_t*)(p.ws + WS_WGLU), M, D, D, D, D}; pg8::StaticOrder S; S.init(M, D, G, (int)blockIdx.x);
            pg8::EpiGlu E{(const bf16_t*)(p.ws + WS_R0), (const bf16_t*)(p.ws + WS_YS), (const bf16_t*)(p.ws + WS_OR), (const float*)(p.ws + WS_SSQ), p.in[I_HNG] + l * 128, p.in[I_GLUB] + l * D, (bf16_t*)(p.ws + WS_H)};
            _Pragma("nounroll") for (int rep = 0; rep < NREP(5); ++rep) pg8::gemm_phase<pg8::EpiGlu, pg8::StaticOrder, true, true>(lds, g, S, E);
            SEAM(g0 + 5);
        }
        if (EN(6) && IN(g0 + 6)) { const KP p = load_kp();
            pg8::Gemm g{(const bf16_t*)(p.ws + WS_H), (const bf16_t*)(p.ws + WS_WOUT), M, D, D / 2, D / 2, D / 2}; pg8::StaticOrder S; S.init(M, D, G, (int)blockIdx.x);
            pg8::EpiStoreBf16 E{(bf16_t*)(p.ws + WS_OR), D, 1.0f / (WO_SCALE * MG_SCALE)};
            pg8::gemm_phase<pg8::EpiStoreBf16, pg8::StaticOrder, false, true, true>(lds, g, S, E);
            SEAM(g0 + 6);
        }
        if (EN(7) && IN(g0 + 7)) { const KP p = load_kp();
            const int t2 = opaque_tid(), lane = t2 & 63, wave = __builtin_amdgcn_readfirstlane(t2 >> 6);
            if (l == 0) resid_norm_rows<false>(p.in[I_X], (bf16_t*)p.out, (const bf16_t*)(p.ws + WS_OR), (bf16_t*)(p.ws + WS_H), p.ws + WS_XF8, p.in[I_N2G] + l * D, (const float*)(p.ws + WS_MOD) + (size_t)l * 32 * NMODC, blockIdx.x * 8 + wave, G * 8, lane);
            else resid_norm_rows<true>(p.out, (bf16_t*)p.out, (const bf16_t*)(p.ws + WS_OR), (bf16_t*)(p.ws + WS_H), p.ws + WS_XF8, p.in[I_N2G] + l * D, (const float*)(p.ws + WS_MOD) + (size_t)l * 32 * NMODC, blockIdx.x * 8 + wave, G * 8, lane);
            SEAM(g0 + 7);
        }
        if (EN(8) && IN(g0 + 8)) { const KP p = load_kp();
            pg8::Gemm g{(const bf16_t*)(p.ws + WS_H), (const bf16_t*)(p.ws + WS_WQ), M, 2048, D, D, D}; pg8::StaticOrder S; S.init(M, 2048, G, (int)blockIdx.x);
            pg8::EpiStoreQ E{(bf16_t*)(p.ws + WS_R0)};
            _Pragma("nounroll") for (int rep = 0; rep < NREP(8); ++rep) pg8::gemm_phase<pg8::EpiStoreQ, pg8::StaticOrder, true, true>(lds, g, S, E);
            SEAM(g0 + 8);
        }
        if (EN(9) && IN(g0 + 9)) { _Pragma("nounroll") for (int rep = 0; rep < NREP(9); ++rep) { const KP p = load_kp(); phase_topk(p, lds, G); } SEAM(g0 + 9); }
        if (EN(10) && IN(g0 + 10)) {
            { const KP p = load_kp(); phase_expert_u(p, lds, MISC, l, G); } xcd_barrier(bar);
            { const KP p = load_kp(); phase_expert_w(p, G); } xcd_barrier(bar);
            { const KP p = load_kp(); phase_expert_v(p, lds, MISC, l, G); }
            SEAM(g0 + 10); }
    }
    if (EN(13) && IN(GP_FINAL)) { const KP p = load_kp(); phase_final(p, G); }
#undef IN
#undef EN
#undef NREP
#undef SEAM
}

extern "C" void kernel_launch(void* const* d_in, const int* in_sizes, int n_in, void* d_out, int out_size, void* d_ws, size_t ws_size, hipStream_t stream) {
    static int grid = 0;
    if (grid == 0) {
        if (n_in != 25 || out_size != M * D || ws_size < WS_END) { fprintf(stderr, "kernel_launch: unexpected shapes (n_in %d, out %d, ws %zu < %zu)\n", n_in, out_size, ws_size, (size_t)WS_END); grid = -1; return; }
        int dev = 0, cus = 0, per_cu = 0;
        if (hipGetDevice(&dev) != hipSuccess || hipDeviceGetAttribute(&cus, hipDeviceAttributeMultiprocessorCount, dev) != hipSuccess) { grid = -1; return; }
        if (hipFuncSetAttribute((const void*)mk_fwd, hipFuncAttributeMaxDynamicSharedMemorySize, LDS_BYTES) != hipSuccess) { fprintf(stderr, "kernel_launch: hipFuncSetAttribute failed\n"); grid = -1; return; }
        if (hipOccupancyMaxActiveBlocksPerMultiprocessor(&per_cu, (const void*)mk_fwd, 512, LDS_BYTES) != hipSuccess || per_cu < 1) fprintf(stderr, "kernel_launch: occupancy query says %d\n", per_cu);
        (void)hipGetLastError();
        grid = cus;
    }
    if (grid < 0) return;
    (void)hipMemsetAsync((char*)d_ws + WS_CTL, 0, CTL_ZERO_BYTES, stream);
    KP a{};
    for (int i = 0; i < 25; ++i) a.in[i] = (const float*)d_in[i];
    a.out = (float*)d_out; a.ws = (unsigned char*)d_ws;
#if MK_LAUNCHES == 1
    a.gp_lo = 0; a.gp_hi = GP_END;
    hipLaunchKernelGGL(mk_fwd, dim3(grid), dim3(512), LDS_BYTES, stream, a);
#else
    for (int gp = 0; gp < GP_END; ++gp) { a.gp_lo = gp; a.gp_hi = gp + 1; hipLaunchKernelGGL(mk_fwd, dim3(grid), dim3(512), LDS_BYTES, stream, a); }
#endif
}
```

```cpp
#include <hip/hip_runtime.h>
#include <cstdio>
#include <cstdint>

#define DBG_HASHSEL 0
#define DBG_H2_FROM_INPUT 0
#define DBG_NO_YA 0
#define DBG_NO_YB 0
#define DBG_NO_ACC 0
#define DBG_NO_GB 0
#define DBG_S5_NOSSM 0
#define DBG_S5_NOREC 0
#define DBG_SELFCHECK 0
#ifndef MK_LAUNCHES
#define MK_LAUNCHES 1
#endif

#define LAS __attribute__((address_space(3)))
typedef unsigned short bf16_t;
typedef short bf16x8 __attribute__((ext_vector_type(8)));
typedef float f32x2 __attribute__((ext_vector_type(2)));
typedef float f32x4 __attribute__((ext_vector_type(4)));
typedef float f32x16 __attribute__((ext_vector_type(16)));
typedef unsigned u32x2 __attribute__((ext_vector_type(2)));
typedef unsigned u32x4 __attribute__((ext_vector_type(4)));
typedef __bf16 bf16v2 __attribute__((ext_vector_type(2)));
typedef int i32x8 __attribute__((ext_vector_type(8)));
typedef int i32x4 __attribute__((ext_vector_type(4)));
typedef int i32x2 __attribute__((ext_vector_type(2)));

constexpr int D = 1024, BATCH = 32, SEQ = 2048, DEPTH = 4, M = BATCH * SEQ;
constexpr int INC = 7168, NMODC = 6 * D;
constexpr int NPH = 11, GP_SETUP = 0, GP_FINAL = 1 + DEPTH * NPH, GP_END = GP_FINAL + 1;
constexpr float EPS = 1e-6f;
constexpr float U_SCALE = 64.0f, V_SCALE = 4.0f;
constexpr size_t TAB_BYTES = (size_t)16384 * 1024;
constexpr float WIN_SCALE = 64.0f, HIN_SCALE = 4.0f;
constexpr float X_SCALE = 8.0f;
constexpr float W8_SCALE = 512.0f;
constexpr float WO_SCALE = 64.0f, MG_SCALE = 8.0f;

constexpr size_t MiB = 1u << 20;
constexpr size_t WS_CTL = 0, CTL_ZERO_BYTES = 1 * MiB;
constexpr size_t WS_MOD = 1 * MiB;
constexpr size_t WS_LB = 4 * MiB;
constexpr size_t WS_ABAR = 4 * MiB + 65536;
constexpr size_t WS_BOP = 5 * MiB;
constexpr size_t WS_COP = 6 * MiB;
constexpr size_t WS_WIN = 8 * MiB;
constexpr size_t WS_WGLU = 22 * MiB;
constexpr size_t WS_WOUT = 24 * MiB;
constexpr size_t WS_WQ = 26 * MiB;
constexpr size_t WS_KEYS = 30 * MiB;
constexpr size_t WS_U = 32 * MiB;
constexpr size_t WS_V = 64 * MiB;
constexpr size_t WS_H = 96 * MiB;
constexpr size_t WS_OR = 224 * MiB;
constexpr size_t WS_SSQ = 352 * MiB;
constexpr size_t WS_R0 = 354 * MiB;
constexpr size_t WS_SEL = WS_R0 + 256 * MiB;
constexpr size_t WS_XF8 = WS_R0 + 352 * MiB;
constexpr size_t WS_WF8 = WS_R0 + 416 * MiB;
constexpr size_t WS_YS = WS_R0 + 512 * MiB;
constexpr size_t WS_END = WS_YS + 128 * MiB;

constexpr int LDS_BYTES = 163840;
constexpr int MISC_OFF = LDS_BYTES - 256;

__device__ __forceinline__ unsigned pk2(float lo, float hi) { f32x2 v = {lo, hi}; bf16v2 r = __builtin_convertvector(v, bf16v2); return __builtin_bit_cast(unsigned, r); }
__device__ __forceinline__ float bflo(unsigned w) { return __uint_as_float(w << 16); }
__device__ __forceinline__ float bfhi(unsigned w) { return __uint_as_float(w & 0xffff0000u); }
__device__ __forceinline__ float fsigmoid(float x) { return __builtin_amdgcn_rcpf(1.0f + __expf(-x)); }
__device__ __forceinline__ float fsilu(float x) { return x * fsigmoid(x); }
__device__ __forceinline__ float fgelu(float x) { return x * fsigmoid(1.5957691216f * (x + 0.044715f * x * x * x)); }
__device__ __forceinline__ float wave_sum(float v) {
#pragma unroll
    for (int o = 1; o < 64; o <<= 1) v += __shfl_xor(v, o);
    return v;
}
#define LDS_WAIT() asm volatile("s_waitcnt lgkmcnt(0)" ::: "memory")
__device__ __forceinline__ float dpp_sum8(float d);
__device__ __forceinline__ int opaque_tid() { int t = threadIdx.x; asm volatile("" : "+v"(t)); return t; }

namespace pg8 {
#define PG8_LAS __attribute__((address_space(3)))
constexpr int BM = 256, BK = 64, HALF = 128, HTB = HALF * BK * 2, STAGE_BYTES = 8 * HTB, NXCD = 8, WGM = 8;
__host__ __device__ __forceinline__ int lds_byte(int r, int c) { const int st = (r >> 4) * 2 + (c >> 5), rr = r & 15, cc = c & 31, ob = rr * 64 + cc * 2; return st * 1024 + (ob ^ (((ob >> 9) & 1) << 5)); }
__host__ __device__ __forceinline__ void stage_rc(int b, int& R, int& C) { const int st = b / 1024, sb = b % 1024, swz = sb ^ (((sb >> 9) & 1) << 5); R = (st >> 1) * 16 + swz / 64; C = (st & 1) * 32 + (swz % 64) / 2; }
__host__ __device__ __forceinline__ int perm32(int rho) { const int n = rho >> 4, i = rho & 15; return 8 * (i >> 2) + 4 * n + (i & 3); }
struct Unit { int pm, pn; };
struct Gemm { const bf16_t* A; const bf16_t* Bt; int M, N, K, lda, ldb; };
struct StaticOrder {
    int nM, nN, nwg, G, c;
    __host__ __device__ void init(int M_, int N_, int G_, int c_) { nM = M_ / BM; nN = N_ / BM; nwg = nM * nN; G = G_; c = c_; }
    __host__ __device__ bool next(int i, Unit& u) const {
        const long L = (long)i * G + c; if (L >= nwg) return false;
        int wgid = (int)L; { const int q = nwg / NXCD, r = nwg % NXCD, xcd = wgid % NXCD, off = wgid / NXCD; wgid = (xcd < r ? xcd * (q + 1) : r * (q + 1) + (xcd - r) * q) + off; }
        const int nig = WGM * nN, gid = wgid / nig, fm = gid * WGM, gsz = (nM - fm) < WGM ? (nM - fm) : WGM;
        u.pm = fm + ((wgid % nig) % gsz); u.pn = (wgid % nig) / gsz; return true;
    }
    __device__ __forceinline__ void a_ready(const Unit&) const {}
    __device__ __forceinline__ void done(const Unit&) const {}
};
template <class Epi, class Sched, bool ALIGN_EPI = false, bool SP2 = false, bool F8 = false>
__device__ __forceinline__ void gemm_phase(PG8_LAS unsigned char* lds, const Gemm g, const Sched& S, const Epi& E) {
    const int tid = opaque_tid(), wid = __builtin_amdgcn_readfirstlane(tid >> 6), lane = tid & 63, wr = wid >> 2, wc = wid & 3, fr = lane & 15, fq = lane >> 4;
    const int K = g.K, nt = K / BK;
    unsigned voffA[2], voffB[2];
#pragma unroll
    for (int i = 0; i < 2; ++i) { int R, C; stage_rc(tid * 16 + i * 8192, R, C); const int Rb = Epi::PERM ? ((R & ~31) + perm32(R & 31)) : R;
        voffA[i] = (unsigned)(R * g.lda + C) * 2u; voffB[i] = (unsigned)(Rb * g.ldb + C) * 2u; }
    const size_t kstep = (size_t)(BK * 2);
    const size_t hstepA = (size_t)HALF * g.lda * 2, hstepB = (size_t)HALF * g.ldb * 2;
    const size_t tstepA = 2 * hstepA, tstepB = 2 * hstepB;
    const unsigned ldsw = (unsigned)wid * 1024u;
    const int aoff = lds_byte(wr * 64 + fr, fq * 8), boff = lds_byte(wc * 32 + fr, fq * 8);
#define PG8_SA(b, h) (((b) * 2 + (h)) * HTB)
#define PG8_SB(b, h) ((4 + (b) * 2 + (h)) * HTB)
#define PG8_STAGE(bufoff, gbase, voff) do { _Pragma("unroll") for (int _i = 0; _i < 2; ++_i) \
        __builtin_amdgcn_global_load_lds((const unsigned*)((const char*)(gbase) + (voff)[_i]), (PG8_LAS unsigned*)(lds + (bufoff) + ldsw + _i * 8192), 16, 0, 0); } while (0)
#define PG8_LD8(p) __builtin_shufflevector(*(const PG8_LAS i32x4*)(p), *(const PG8_LAS i32x4*)((p) + 1024), 0, 1, 2, 3, 4, 5, 6, 7)
#define PG8_LDA(dst, b, h) do { if constexpr (F8) { _Pragma("unroll") for (int m = 0; m < 4; ++m) dst##8[m] = PG8_LD8(lds + PG8_SA(b, h) + aoff + m * 2048); } \
        else { _Pragma("unroll") for (int m = 0; m < 4; ++m) _Pragma("unroll") for (int k = 0; k < 2; ++k) dst[m][k] = *(const PG8_LAS bf16x8*)(lds + PG8_SA(b, h) + aoff + m * 2048 + k * 1024); } } while (0)
#define PG8_LDB(dst, b, h) do { if constexpr (F8) { _Pragma("unroll") for (int n = 0; n < 2; ++n) dst##8[n] = PG8_LD8(lds + PG8_SB(b, h) + boff + n * 2048); } \
        else { _Pragma("unroll") for (int n = 0; n < 2; ++n) _Pragma("unroll") for (int k = 0; k < 2; ++k) dst[n][k] = *(const PG8_LAS bf16x8*)(lds + PG8_SB(b, h) + boff + n * 2048 + k * 1024); } } while (0)
#define PG8_MMA(ai, bj, At, Bt) do { __builtin_amdgcn_s_setprio(1); _Pragma("unroll") for (int m = 0; m < 4; ++m) _Pragma("unroll") for (int n = 0; n < 2; ++n) { \
        if constexpr (F8) {   \
            acc[ai][bj][m][n] = __builtin_amdgcn_mfma_scale_f32_16x16x128_f8f6f4(Bt##8[n], At##8[m], acc[ai][bj][m][n], 0, 0, 0, 0x7f7f7f7f, 0, 0x7f7f7f7f); \
        } else { _Pragma("unroll") for (int k = 0; k < 2; ++k) acc[ai][bj][m][n] = __builtin_amdgcn_mfma_f32_16x16x32_bf16(Bt[n][k], At[m][k], acc[ai][bj][m][n], 0, 0, 0); } } \
        __builtin_amdgcn_s_setprio(0); } while (0)
#define PG8_WAIT_V(n) asm volatile("s_waitcnt vmcnt(" #n ")" ::: "memory")
#define PG8_WAIT_L(n) asm volatile("s_waitcnt lgkmcnt(" #n ")" ::: "memory")
#define PG8_BAR __builtin_amdgcn_s_barrier()
#define PG8_SCHED __builtin_amdgcn_sched_barrier(0)
    Unit cur, nxt; int ui = 0;
    if (!S.next(0, cur)) return;
    f32x4 acc[2][2][4][2];
#pragma unroll
    for (int a = 0; a < 2; ++a)
#pragma unroll
        for (int b = 0; b < 2; ++b)
#pragma unroll
            for (int m = 0; m < 4; ++m)
#pragma unroll
                for (int n = 0; n < 2; ++n) acc[a][b][m][n] = (f32x4){0.f, 0.f, 0.f, 0.f};
    bf16x8 At[4][2], B0[2][2], B1[2][2]; i32x8 At8[4], B08[2], B18[2];
    const char* cA = (const char*)g.A + (size_t)cur.pm * tstepA; const char* cB = (const char*)g.Bt + (size_t)cur.pn * tstepB;
    S.a_ready(cur);
    if constexpr (SP2) {
        PG8_STAGE(PG8_SB(0, 0), cB, voffB); PG8_STAGE(PG8_SB(0, 1), cB + hstepB, voffB); PG8_STAGE(PG8_SA(0, 0), cA, voffA); PG8_STAGE(PG8_SA(0, 1), cA + hstepA, voffA);
        if (wr == 1) PG8_BAR;
        PG8_WAIT_V(2); PG8_BAR;
        PG8_STAGE(PG8_SB(1, 0), cB + kstep, voffB); PG8_STAGE(PG8_SA(1, 0), cA + kstep, voffA); PG8_STAGE(PG8_SB(1, 1), cB + hstepB + kstep, voffB);
        PG8_WAIT_V(6); PG8_BAR;
    } else {
        PG8_STAGE(PG8_SB(0, 0), cB, voffB); PG8_STAGE(PG8_SA(0, 0), cA, voffA); PG8_STAGE(PG8_SB(0, 1), cB + hstepB, voffB); PG8_STAGE(PG8_SA(0, 1), cA + hstepA, voffA);
        if (wr == 1) PG8_BAR;
        PG8_WAIT_V(4); PG8_BAR;
        PG8_STAGE(PG8_SB(1, 0), cB + kstep, voffB); PG8_STAGE(PG8_SA(1, 0), cA + kstep, voffA); PG8_STAGE(PG8_SB(1, 1), cB + hstepB + kstep, voffB);
        PG8_WAIT_V(6); PG8_BAR;
    }
    for (;;) {
        const bool has_next = S.next(ui + 1, nxt);
        const char* nA = has_next ? (const char*)g.A + (size_t)nxt.pm * tstepA : cA; const char* nB = has_next ? (const char*)g.Bt + (size_t)nxt.pn * tstepB : cB;
        for (int t = 0; t < nt; t += 2) {
            const bool last = (t == nt - 2);
            const char* a1 = cA + (size_t)(t + 1) * kstep;
            const char* a2 = last ? nA : cA + (size_t)(t + 2) * kstep; const char* b2 = last ? nB : cB + (size_t)(t + 2) * kstep;
            const char* a3 = a2 + kstep; const char* b3 = b2 + kstep;
            if (last && has_next) S.a_ready(nxt);
            if constexpr (SP2) {
            PG8_LDB(B0, 0, 0); PG8_LDB(B1, 0, 1); PG8_SCHED; PG8_LDA(At, 0, 0); PG8_STAGE(PG8_SA(1, 1), a1 + hstepA, voffA);
            PG8_WAIT_V(8); PG8_WAIT_L(0); PG8_BAR; PG8_MMA(0, 0, At, B0); PG8_MMA(0, 1, At, B1); PG8_BAR; PG8_SCHED;
            PG8_LDA(At, 0, 1); PG8_STAGE(PG8_SB(0, 0), b2, voffB); PG8_STAGE(PG8_SB(0, 1), b2 + hstepB, voffB); PG8_STAGE(PG8_SA(0, 0), a2, voffA);
            PG8_WAIT_V(8); PG8_WAIT_L(0); PG8_BAR; PG8_MMA(1, 0, At, B0); PG8_MMA(1, 1, At, B1); PG8_BAR; PG8_SCHED;
            PG8_LDB(B0, 1, 0); PG8_LDB(B1, 1, 1); PG8_SCHED; PG8_LDA(At, 1, 0); PG8_STAGE(PG8_SA(0, 1), a2 + hstepA, voffA);
            PG8_WAIT_V(8); PG8_WAIT_L(0); PG8_BAR; PG8_MMA(0, 0, At, B0); PG8_MMA(0, 1, At, B1); PG8_BAR; PG8_SCHED;
            PG8_LDA(At, 1, 1); PG8_STAGE(PG8_SB(1, 0), b3, voffB); PG8_STAGE(PG8_SB(1, 1), b3 + hstepB, voffB); PG8_STAGE(PG8_SA(1, 0), a3, voffA);
            PG8_WAIT_V(8); PG8_WAIT_L(0); PG8_BAR; PG8_MMA(1, 0, At, B0); PG8_MMA(1, 1, At, B1); PG8_BAR; PG8_SCHED;
            } else {
            PG8_LDB(B0, 0, 0); PG8_SCHED; PG8_LDA(At, 0, 0); PG8_STAGE(PG8_SA(1, 1), a1 + hstepA, voffA);
            PG8_WAIT_L(8); PG8_BAR; PG8_WAIT_L(0); PG8_MMA(0, 0, At, B0); PG8_BAR; PG8_SCHED;
            PG8_LDB(B1, 0, 1); PG8_STAGE(PG8_SB(0, 0), b2, voffB);
            PG8_BAR; PG8_WAIT_L(0); PG8_MMA(0, 1, At, B1); PG8_BAR;
            PG8_LDA(At, 0, 1); PG8_STAGE(PG8_SA(0, 0), a2, voffA);
            PG8_BAR; PG8_WAIT_L(0); PG8_MMA(1, 0, At, B0); PG8_BAR; PG8_SCHED;
            PG8_STAGE(PG8_SB(0, 1), b2 + hstepB, voffB);
            PG8_WAIT_V(6); PG8_BAR; PG8_MMA(1, 1, At, B1); PG8_BAR;
            PG8_LDB(B0, 1, 0); PG8_SCHED; PG8_LDA(At, 1, 0); PG8_STAGE(PG8_SA(0, 1), a2 + hstepA, voffA);
            PG8_WAIT_L(8); PG8_BAR; PG8_WAIT_L(0); PG8_MMA(0, 0, At, B0); PG8_BAR; PG8_SCHED;
            PG8_LDB(B1, 1, 1); PG8_STAGE(PG8_SB(1, 0), b3, voffB);
            PG8_BAR; PG8_WAIT_L(0); PG8_MMA(0, 1, At, B1); PG8_BAR;
            PG8_LDA(At, 1, 1); PG8_STAGE(PG8_SA(1, 0), a3, voffA);
            PG8_BAR; PG8_WAIT_L(0); PG8_MMA(1, 0, At, B0); PG8_BAR; PG8_SCHED;
            PG8_STAGE(PG8_SB(1, 1), b3 + hstepB, voffB);
            PG8_WAIT_V(6); PG8_BAR; PG8_MMA(1, 1, At, B1); PG8_BAR;
            }
        }
        if constexpr (ALIGN_EPI) { if (wr == 0) PG8_BAR; }
        E(acc, cur, wr, wc, fr, fq);
        if (!has_next) break;
#pragma unroll
        for (int a = 0; a < 2; ++a)
#pragma unroll
            for (int b = 0; b < 2; ++b)
#pragma unroll
                for (int m = 0; m < 4; ++m)
#pragma unroll
                    for (int n = 0; n < 2; ++n) acc[a][b][m][n] = (f32x4){0.f, 0.f, 0.f, 0.f};
        cur = nxt; cA = nA; cB = nB; ++ui;
        if constexpr (ALIGN_EPI) { if (wr == 1) PG8_BAR; }
    }
    PG8_WAIT_V(0);
    if constexpr (!ALIGN_EPI) { if (wr == 0) PG8_BAR; }
    PG8_BAR;
#undef PG8_SA
#undef PG8_SB
#undef PG8_STAGE
#undef PG8_LDA
#undef PG8_LD8
#undef PG8_LDB
#undef PG8_MMA
#undef PG8_WAIT_V
#undef PG8_WAIT_L
#undef PG8_BAR
#undef PG8_SCHED
}

struct EpiStoreBf16 {
    static constexpr bool PERM = true;
    bf16_t* O; int ldc; float scale;
    __device__ __forceinline__ void operator()(const f32x4 (&acc)[2][2][4][2], const Unit& u, int wr, int wc, int fr, int fq) const {
        const int row0 = u.pm * BM + wr * 64 + fr, col0 = u.pn * BM + wc * 32 + 8 * fq;
#pragma unroll
        for (int ai = 0; ai < 2; ++ai)
#pragma unroll
            for (int m = 0; m < 4; ++m) { bf16_t* rowp = O + (size_t)(row0 + ai * HALF + m * 16) * ldc + col0;
#pragma unroll
                for (int bj = 0; bj < 2; ++bj) { const f32x4 v0 = acc[ai][bj][m][0] * scale, v1 = acc[ai][bj][m][1] * scale;
                    u32x4 w; w.x = pk2(v0[0], v0[1]); w.y = pk2(v0[2], v0[3]); w.z = pk2(v1[0], v1[1]); w.w = pk2(v1[2], v1[3]);
                    *(u32x4*)(rowp + bj * HALF) = w; } }
    }
};
struct EpiStoreQ {
    static constexpr bool PERM = true;
    bf16_t* O;
    __device__ __forceinline__ void operator()(const f32x4 (&acc)[2][2][4][2], const Unit& u, int wr, int wc, int fr, int fq) const {
        const int row0 = u.pm * BM + wr * 64 + fr, col0 = u.pn * BM + wc * 32 + 8 * fq;
#pragma unroll
        for (int ai = 0; ai < 2; ++ai)
#pragma unroll
            for (int m = 0; m < 4; ++m) { const int row = row0 + ai * HALF + m * 16, tg = row >> 5, t = row & 31;
#pragma unroll
                for (int bj = 0; bj < 2; ++bj) { const int c0 = col0 + bj * HALF, h = c0 >> 8, pp = (c0 >> 7) & 1, cc = c0 & 127, ks = cc >> 4, hh = (cc >> 3) & 1;
                    const f32x4 v0 = acc[ai][bj][m][0], v1 = acc[ai][bj][m][1];
                    u32x4 w; w.x = pk2(v0[0], v0[1]); w.y = pk2(v0[2], v0[3]); w.z = pk2(v1[0], v1[1]); w.w = pk2(v1[2], v1[3]);
                    *(u32x4*)(O + ((size_t)((((tg * 8 + h) * 2 + pp) * 8 + ks) * 64 + hh * 32 + t)) * 8) = w; } }
    }
};
struct EpiWout {
    static constexpr bool PERM = false;
    const float* xs; float* out; const float* g1;
    __device__ __forceinline__ void operator()(const f32x4 (&acc)[2][2][4][2], const Unit& u, int wr, int wc, int fr, int fq) const {
        const int row0 = u.pm * BM + wr * 64 + fr, col0 = u.pn * BM + wc * 32 + 4 * fq;
        const int b = (u.pm * BM) >> 11;
        f32x4 gv[2][2];
#pragma unroll
        for (int bj = 0; bj < 2; ++bj)
#pragma unroll
            for (int n = 0; n < 2; ++n) gv[bj][n] = *(const f32x4*)(g1 + (size_t)b * NMODC + col0 + bj * HALF + n * 16);
#pragma unroll
        for (int ai = 0; ai < 2; ++ai)
#pragma unroll
            for (int m = 0; m < 4; ++m) { const size_t off = (size_t)(row0 + ai * HALF + m * 16) * D + col0;
#pragma unroll
                for (int bj = 0; bj < 2; ++bj)
#pragma unroll
                    for (int n = 0; n < 2; ++n) { const f32x4 xv = *(const f32x4*)(xs + off + bj * HALF + n * 16);
                        *(f32x4*)(out + off + bj * HALF + n * 16) = xv + gv[bj][n] * acc[ai][bj][m][n]; } }
    }
};
struct EpiGlu {
    static constexpr bool PERM = true;
    const bf16_t* PB; const bf16_t* YS; const bf16_t* ORAW; const float* SSQ; const float* ng; const float* gb_; bf16_t* O;
    __device__ __forceinline__ void operator()(const f32x4 (&acc)[2][2][4][2], const Unit& u, int wr, int wc, int fr, int fq) const {
        const int row0 = u.pm * BM + wr * 64 + fr, col0 = u.pn * BM + wc * 32 + 8 * fq;
#pragma unroll
        for (int bj = 0; bj < 2; ++bj) {
            const int c = col0 + bj * HALF, head = c >> 7;
            const f32x4 n0 = *(const f32x4*)(ng + (c & 127)), n1 = *(const f32x4*)(ng + (c & 127) + 4);
            const f32x4 b0 = *(const f32x4*)(gb_ + c), b1 = *(const f32x4*)(gb_ + c + 4);
            const float ngv[8] = {n0[0], n0[1], n0[2], n0[3], n1[0], n1[1], n1[2], n1[3]};
            const float bbv[8] = {b0[0], b0[1], b0[2], b0[3], b1[0], b1[1], b1[2], b1[3]};
#pragma unroll
            for (int ai = 0; ai < 2; ++ai)
#pragma unroll
                for (int m = 0; m < 4; ++m) {
                    const int row = row0 + ai * HALF + m * 16;
                    const bf16_t* pb = PB + (size_t)row * 4096 + c;
                    const u32x4 og = *(const u32x4*)(pb), ys = *(const u32x4*)(YS + (size_t)row * D + c), ga = *(const u32x4*)(pb + 2048), gb = *(const u32x4*)(pb + 3072);
                    const u32x4 orw = *(const u32x4*)(ORAW + (size_t)row * D + c);
                    const float rstd = __builtin_amdgcn_rsqf(SSQ[(size_t)row * 8 + head] * (1.0f / 128.0f) + EPS);
                    const f32x4 a0 = acc[ai][bj][m][0], a1 = acc[ai][bj][m][1];
                    const float av[8] = {a0[0], a0[1], a0[2], a0[3], a1[0], a1[1], a1[2], a1[3]};
                    float res[8];
#pragma unroll
                    for (int j = 0; j < 8; ++j) {
                        const unsigned wog = og[j >> 1], wys = ys[j >> 1], wga = ga[j >> 1], wgb = gb[j >> 1], wor = orw[j >> 1];
                        const float fog = (j & 1) ? bfhi(wog) : bflo(wog), fys = (j & 1) ? bfhi(wys) : bflo(wys), fga = (j & 1) ? bfhi(wga) : bflo(wga),
                                    fgb = (j & 1) ? bfhi(wgb) : bflo(wgb), fo = (j & 1) ? bfhi(wor) : bflo(wor);
                        const float ya = fo * rstd * ngv[j] * fsilu(fog);
                        const float yb = fys * fsigmoid((DBG_NO_ACC ? 0.f : av[j]) + bbv[j]);
                        res[j] = (DBG_NO_YA ? 0.f : fsigmoid(fga) * ya) + (DBG_NO_YB ? 0.f : (DBG_NO_GB ? 0.5f : fsigmoid(fgb)) * yb);
                    }
                    int w0 = 0, w1 = 0;
                    w0 = __builtin_amdgcn_cvt_pk_fp8_f32(res[0] * MG_SCALE, res[1] * MG_SCALE, w0, false); w0 = __builtin_amdgcn_cvt_pk_fp8_f32(res[2] * MG_SCALE, res[3] * MG_SCALE, w0, true);
                    w1 = __builtin_amdgcn_cvt_pk_fp8_f32(res[4] * MG_SCALE, res[5] * MG_SCALE, w1, false); w1 = __builtin_amdgcn_cvt_pk_fp8_f32(res[6] * MG_SCALE, res[7] * MG_SCALE, w1, true);
                    *(u32x2*)((unsigned char*)O + (size_t)row * D + c) = (u32x2){(unsigned)w0, (unsigned)w1};
                }
        }
    }
};
}

#define XB_TMO      128
#define XB_XCNT(j)  (256  + 64 * (j))
#define XB_XSUB(j)  (1280 + 64 * (j))
#define XB_XGEN(j)  (2304 + 64 * (j))
#define XB_TOP      3328
#define XB_TOPGEN   3392
#define XCD_BAR_WORDS 3456
#define XB_SPIN_CAP (1u << 25)
__device__ __forceinline__ unsigned xb_ld(unsigned* p)              { return __hip_atomic_load(p, __ATOMIC_RELAXED, __HIP_MEMORY_SCOPE_AGENT); }
__device__ __forceinline__ unsigned xb_add(unsigned* p, unsigned v) { return __hip_atomic_fetch_add(p, v, __ATOMIC_RELAXED, __HIP_MEMORY_SCOPE_AGENT); }
__device__ __forceinline__ unsigned xb_xcc_id() { return (unsigned)__builtin_amdgcn_s_getreg((3 << 11) | 20) & 0xFu; }
#define XB_SPIN(cond, bar) do { unsigned _sp = 0; while (cond) { __builtin_amdgcn_s_sleep(1); \
    if ((++_sp & 255u) == 0u) { if (xb_ld(&(bar)[XB_TMO])) break; if (_sp > XB_SPIN_CAP) { atomicAdd(&(bar)[XB_TMO], 1u); break; } } } } while (0)
struct XcdBarrier { unsigned* bar; unsigned x; volatile LAS unsigned* st; };
__device__ __forceinline__ XcdBarrier xcd_barrier_post(unsigned* bar, volatile LAS unsigned* st) {
    XcdBarrier b; b.bar = bar; b.x = xb_xcc_id(); b.st = st;
    if (threadIdx.x == 0) (void)xb_add(&bar[XB_XCNT(b.x)], 1u);
    return b;
}
__device__ __forceinline__ void xcd_barrier_complete(unsigned* bar, unsigned x, unsigned& nloc, unsigned& nx) {
    const unsigned G = gridDim.x * gridDim.y * gridDim.z;
    unsigned sum, cnt, mine, sp = 0u;
    for (;;) {
        sum = 0u; cnt = 0u; mine = 0u;
#pragma unroll
        for (unsigned j = 0; j < 16; ++j) { const unsigned c = xb_ld(&bar[XB_XCNT(j)]); sum += c; cnt += (c > 0u) ? 1u : 0u; mine = (j == x) ? c : mine; }
        if (sum == G) break;
        __builtin_amdgcn_s_sleep(1);
        if ((++sp & 255u) == 0u) { if (xb_ld(&bar[XB_TMO])) break; if (sp > XB_SPIN_CAP) { atomicAdd(&bar[XB_TMO], 1u); break; } }
    }
    nloc = mine > 0u ? mine : 1u; nx = cnt > 0u ? cnt : 1u;
}
__device__ __forceinline__ void xcd_barrier(const XcdBarrier& b) {
    asm volatile("s_waitcnt vmcnt(0)" ::: "memory");
    __syncthreads();
    if (threadIdx.x == 0) {
        unsigned* bar = b.bar;
        __builtin_amdgcn_s_waitcnt(0);
        unsigned nloc = b.st[0], nx = b.st[1];
        if (nloc == 0u) { xcd_barrier_complete(bar, b.x, nloc, nx); b.st[0] = nloc; b.st[1] = nx; }
        const unsigned old = xb_add(&bar[XB_XSUB(b.x)], 1u);
        const unsigned gen = old / nloc;
        if (old + 1u == (gen + 1u) * nloc) {
            __builtin_amdgcn_fence(__ATOMIC_RELEASE, "agent");
            asm volatile("s_waitcnt vmcnt(0)" ::: "memory");
            const unsigned og = xb_add(&bar[XB_TOP], 1u);
            const unsigned tg = og / nx;
            if (og + 1u == (tg + 1u) * nx) xb_add(&bar[XB_TOPGEN], 1u);
            else XB_SPIN(xb_ld(&bar[XB_TOPGEN]) == tg, bar);
            __builtin_amdgcn_fence(__ATOMIC_ACQUIRE, "agent");
            xb_add(&bar[XB_XGEN(b.x)], 1u);
            asm volatile("s_waitcnt vmcnt(0)" ::: "memory");
        } else {
            XB_SPIN(xb_ld(&bar[XB_XGEN(b.x)]) == gen, bar);
            __builtin_amdgcn_fence(__ATOMIC_ACQUIRE, "agent");
            asm volatile("s_waitcnt vmcnt(0)" ::: "memory");
        }
    }
    __syncthreads();
}

struct KP { const float* in[25]; float* out; unsigned char* ws; int gp_lo, gp_hi; };
enum { I_X = 0, I_C, I_ADAW, I_ADAB, I_N1G, I_N2G, I_WIN, I_LBL, I_HNG, I_ARE, I_AIM, I_LDT, I_BRE, I_BIM, I_CRE, I_CIM, I_S5D, I_GLUW, I_GLUB, I_WOUT, I_WQ, I_SUBK, I_PU, I_PV, I_FG };

typedef const KP __attribute__((address_space(4)))* kp_cptr;
__device__ __forceinline__ KP load_kp() {
#if defined(__HIP_DEVICE_COMPILE__)
    unsigned long long a = (unsigned long long)__builtin_amdgcn_kernarg_segment_ptr(); asm volatile("" : "+s"(a)); return *(kp_cptr)a;
#else
    return KP{};
#endif
}

__device__ __forceinline__ void phase_setup(const KP& p, LAS unsigned char* lds, int G) {
    const int tid = opaque_tid();
    {
        LAS float* cact = (LAS float*)lds;
        for (int it = blockIdx.x; it < 4 * 48; it += G) {
#pragma unroll 1
            for (int i0 = 0; i0 < 64; i0 += 16) { float cv[16];
#pragma unroll
                for (int q = 0; q < 16; ++q) cv[q] = p.in[I_C][(i0 + q) * 512 + tid];
#pragma unroll
                for (int q = 0; q < 16; ++q) { const int i = (i0 + q) * 512 + tid; const int k_ = i & 1023, b_ = i >> 10; cact[k_ * 32 + ((((b_ >> 2) ^ (k_ & 7)) << 2) | (b_ & 3))] = fsilu(cv[q]); } }
            __syncthreads();
            const int l = it / 48, cb = it % 48, col = cb * 128 + (tid & 127), bg = tid >> 7;
            const float* W = p.in[I_ADAW] + (size_t)l * D * NMODC + col;
            f32x4 acc0 = {0.f, 0.f, 0.f, 0.f}, acc1 = {0.f, 0.f, 0.f, 0.f};
#pragma unroll 2
            for (int k4 = 0; k4 < 256; ++k4) {
                const float w0 = W[(size_t)(4 * k4 + 0) * NMODC], w1 = W[(size_t)(4 * k4 + 1) * NMODC], w2 = W[(size_t)(4 * k4 + 2) * NMODC], w3 = W[(size_t)(4 * k4 + 3) * NMODC];
#pragma unroll
                for (int kk = 0; kk < 4; ++kk) { const int k_ = 4 * k4 + kk; const float wv = kk == 0 ? w0 : (kk == 1 ? w1 : (kk == 2 ? w2 : w3));
                    acc0 += *(const LAS f32x4*)(cact + k_ * 32 + (((2 * bg) ^ (k_ & 7)) << 2)) * wv; acc1 += *(const LAS f32x4*)(cact + k_ * 32 + (((2 * bg + 1) ^ (k_ & 7)) << 2)) * wv; }
            }
            float* MOD = (float*)(p.ws + WS_MOD);
            const float bias = p.in[I_ADAB][l * NMODC + col];
#pragma unroll
            for (int j = 0; j < 4; ++j) { MOD[((size_t)l * 32 + 8 * bg + j) * NMODC + col] = acc0[j] + bias; MOD[((size_t)l * 32 + 8 * bg + 4 + j) * NMODC + col] = acc1[j] + bias; }
            __syncthreads();
        }
    }
    const int gtid = (G - 1 - (int)blockIdx.x) * 512 + tid;
    if (gtid < 1024) {
        const float* lg = p.in[I_LBL]; float v[4], mx = -1e30f;
#pragma unroll
        for (int l = 0; l < 4; ++l) { v[l] = lg[l * 1024 + gtid]; mx = fmaxf(mx, v[l]); }
        float s = 0.f;
#pragma unroll
        for (int l = 0; l < 4; ++l) { v[l] = __expf(v[l] - mx); s += v[l]; }
        float* LB = (float*)(p.ws + WS_LB); float cum = 0.f; const float first = v[0] / s;
#pragma unroll
        for (int l = 0; l < 4; ++l) { cum += v[l] / s; LB[l * 1024 + gtid] = (l == 0) ? 0.f : (cum - first); }
    }
    if (gtid >= 1024 && gtid < 1024 + 16384) {
        const int id = gtid - 1024, lg = id >> 6, pp = id & 63;
        const float a_re = p.in[I_ARE][id], a_im = p.in[I_AIM][id];
        const float step = expf(p.in[I_LDT][lg]);
        const float mag = expf(step * a_re), ang = step * a_im;
        const float ab_re = mag * cosf(ang), ab_im = mag * sinf(ang);
        const float den = a_re * a_re + a_im * a_im;
        const float z_re = ((ab_re - 1.0f) * a_re + ab_im * a_im) / den;
        const float z_im = (ab_im * a_re - (ab_re - 1.0f) * a_im) / den;
        float* ABAR = (float*)(p.ws + WS_ABAR); ABAR[2 * id] = ab_re; ABAR[2 * id + 1] = ab_im;
        bf16_t* BOP = (bf16_t*)(p.ws + WS_BOP); bf16_t* COP = (bf16_t*)(p.ws + WS_COP);
        const float* bre = p.in[I_BRE] + (size_t)id * 16; const float* bim = p.in[I_BIM] + (size_t)id * 16;
#pragma unroll
        for (int c = 0; c < 16; ++c) {
            const float br = bre[c], bi = bim[c];
            const float rr = z_re * br - z_im * bi, ii = z_re * bi + z_im * br;
            BOP[((size_t)lg * 128 + 2 * pp) * 16 + c] = (bf16_t)(pk2(rr, 0.f) & 0xffffu);
            BOP[((size_t)lg * 128 + 2 * pp + 1) * 16 + c] = (bf16_t)(pk2(ii, 0.f) & 0xffffu);
            const float cr = p.in[I_CRE][((size_t)lg * 16 + c) * 64 + pp], ci = p.in[I_CIM][((size_t)lg * 16 + c) * 64 + pp];
            COP[((size_t)lg * 16 + c) * 128 + 2 * pp] = (bf16_t)(pk2(cr, 0.f) & 0xffffu);
            COP[((size_t)lg * 16 + c) * 128 + 2 * pp + 1] = (bf16_t)(pk2(-ci, 0.f) & 0xffffu);
        }
    }
}

__device__ __forceinline__ void transpose_item(const float* W, int K, int N, bf16_t* WT, LAS float* scr, int item, int lane) {
    const int nblk = N / 32, kb = item / nblk, nb = item % nblk, k0 = 64 * kb, n0 = 32 * nb;
#pragma unroll 8
    for (int i = 0; i < 32; ++i) { const int kk = 2 * i + (lane >> 5); scr[kk * 33 + (lane & 31)] = W[(size_t)(k0 + kk) * N + n0 + (lane & 31)]; }
    LDS_WAIT();
    const int c = lane & 7;
#pragma unroll
    for (int j = 0; j < 4; ++j) { const int n = (lane >> 3) + 8 * j; const LAS float* s = scr + (8 * c) * 33 + n;
        u32x4 o; o.x = pk2(s[0 * 33], s[1 * 33]); o.y = pk2(s[2 * 33], s[3 * 33]); o.z = pk2(s[4 * 33], s[5 * 33]); o.w = pk2(s[6 * 33], s[7 * 33]);
        *(u32x4*)(WT + (size_t)(n0 + n) * K + k0 + 8 * c) = o; }
    LDS_WAIT();
}
__device__ __forceinline__ void cvt_f32_fp8(const float* src, unsigned char* dst, size_t n4, size_t gtid, size_t nthr, float scale) {
    for (size_t i = gtid; i < n4; i += nthr) { const f32x4 v = ((const f32x4*)src)[i] * scale; int w = 0;
        w = __builtin_amdgcn_cvt_pk_fp8_f32(v[0], v[1], w, false); w = __builtin_amdgcn_cvt_pk_fp8_f32(v[2], v[3], w, true); ((unsigned*)dst)[i] = (unsigned)w; }
}
__device__ __forceinline__ void cvt_f32_fp8_sliced(const float* src, unsigned char* dst, size_t gtid, size_t nthr, float scale) {
    for (size_t i = gtid; i < (size_t)16384 * 64; i += nthr) {
        const size_t e = i >> 6; const int sl = (int)(i & 63) >> 3, c = (int)(i & 7);
        const f32x4* sp = (const f32x4*)(src + e * 1024 + sl * 128 + c * 16); u32x4 o;
#pragma unroll
        for (int q = 0; q < 4; ++q) { const f32x4 v = sp[q] * scale; int w = 0; w = __builtin_amdgcn_cvt_pk_fp8_f32(v[0], v[1], w, false); w = __builtin_amdgcn_cvt_pk_fp8_f32(v[2], v[3], w, true); o[q] = (unsigned)w; }
        *(u32x4*)(dst + ((size_t)sl * 16384 + e) * 128 + c * 16) = o;
    }
}
__device__ __forceinline__ void transpose_item_fp8(const float* W, int K, int N, unsigned char* WT, LAS float* scr, int item, int lane, float scale) {
    const int nblk = N / 32, kb = item / nblk, nb = item % nblk, k0 = 64 * kb, n0 = 32 * nb;
#pragma unroll 8
    for (int i = 0; i < 32; ++i) { const int kk = 2 * i + (lane >> 5); scr[kk * 33 + (lane & 31)] = W[(size_t)(k0 + kk) * N + n0 + (lane & 31)]; }
    LDS_WAIT();
    const int c = lane & 7;
#pragma unroll
    for (int j = 0; j < 4; ++j) { const int n = (lane >> 3) + 8 * j; const LAS float* sp = scr + (8 * c) * 33 + n;
        int w0 = 0, w1 = 0;
        w0 = __builtin_amdgcn_cvt_pk_fp8_f32(sp[0 * 33] * scale, sp[1 * 33] * scale, w0, false); w0 = __builtin_amdgcn_cvt_pk_fp8_f32(sp[2 * 33] * scale, sp[3 * 33] * scale, w0, true);
        w1 = __builtin_amdgcn_cvt_pk_fp8_f32(sp[4 * 33] * scale, sp[5 * 33] * scale, w1, false); w1 = __builtin_amdgcn_cvt_pk_fp8_f32(sp[6 * 33] * scale, sp[7 * 33] * scale, w1, true);
        *(u32x2*)(WT + (size_t)(n0 + n) * K + k0 + 8 * c) = (u32x2){(unsigned)w0, (unsigned)w1}; }
    LDS_WAIT();
}
__device__ __forceinline__ void cvt_f32_bf16(const float* src, bf16_t* dst, size_t n4, size_t gtid, size_t nthr) {
    for (size_t i = gtid; i < n4; i += nthr) { const f32x4 v = ((const f32x4*)src)[i]; u32x2 o; o.x = pk2(v[0], v[1]); o.y = pk2(v[2], v[3]); ((u32x2*)dst)[i] = o; }
}
template <bool F8OUT, bool XBF>
__device__ __forceinline__ void norm_rows(const float* xsrc, bf16_t* hdst, const float* gain, const float* mod_l, int sh_off, int sc_off, int gw, int ngw, int lane) {
    for (int r0 = gw * 4; r0 < M; r0 += ngw * 4) {
        const int b = r0 >> 11;
        f32x4 v[4][4]; float ss[4];
#pragma unroll
        for (int i = 0; i < 4; ++i) {
            if constexpr (XBF) { const u32x2* xr = (const u32x2*)((const bf16_t*)xsrc + (size_t)(r0 + i) * D) + lane;
#pragma unroll
                for (int j = 0; j < 4; ++j) { const u32x2 xw = xr[64 * j]; v[i][j] = (f32x4){bflo(xw[0]), bfhi(xw[0]), bflo(xw[1]), bfhi(xw[1])}; } }
            else { const f32x4* xr = (const f32x4*)(xsrc + (size_t)(r0 + i) * D) + lane;
#pragma unroll
                for (int j = 0; j < 4; ++j) v[i][j] = xr[64 * j]; } }
#pragma unroll
        for (int i = 0; i < 4; ++i) { float t = 0.f;
#pragma unroll
            for (int j = 0; j < 4; ++j) t += (v[i][j][0] * v[i][j][0] + v[i][j][1] * v[i][j][1]) + (v[i][j][2] * v[i][j][2] + v[i][j][3] * v[i][j][3]);
            ss[i] = t; }
#pragma unroll
        for (int o = 1; o < 64; o <<= 1) {
#pragma unroll
            for (int i = 0; i < 4; ++i) ss[i] += __shfl_xor(ss[i], o); }
        const float* mb = mod_l + (size_t)b * NMODC;
#pragma unroll
        for (int j = 0; j < 4; ++j) { const int col = 256 * j + 4 * lane;
            const f32x4 g4 = *(const f32x4*)(gain + col), sc = *(const f32x4*)(mb + sc_off + col), sh = *(const f32x4*)(mb + sh_off + col);
            const f32x4 gs = g4 * (sc + 1.0f);
#pragma unroll
            for (int i = 0; i < 4; ++i) { const float rstd = __builtin_amdgcn_rsqf(ss[i] * (1.0f / D) + EPS);
                const f32x4 h = v[i][j] * rstd * gs + sh;
                if constexpr (F8OUT) { int w8 = 0; w8 = __builtin_amdgcn_cvt_pk_fp8_f32(h[0] * HIN_SCALE, h[1] * HIN_SCALE, w8, false); w8 = __builtin_amdgcn_cvt_pk_fp8_f32(h[2] * HIN_SCALE, h[3] * HIN_SCALE, w8, true);
                    *(unsigned*)((unsigned char*)hdst + (size_t)(r0 + i) * D + col) = (unsigned)w8; }
                else { u32x2 o; o.x = pk2(h[0], h[1]); o.y = pk2(h[2], h[3]); *(u32x2*)(hdst + (size_t)(r0 + i) * D + col) = o; } } }
    }
}
template <bool XBF>
__device__ __forceinline__ void resid_norm_rows(const float* xsrc, bf16_t* xdst, const bf16_t* delta, bf16_t* hdst, unsigned char* xf8, const float* gain, const float* mod_l, int gw, int ngw, int lane) {
    for (int r0 = gw * 4; r0 < M; r0 += ngw * 4) {
        const int b = r0 >> 11; const float* mb = mod_l + (size_t)b * NMODC;
        f32x4 v[4][4]; u32x2 dl[4][4]; float ss[4];
#pragma unroll
        for (int i = 0; i < 4; ++i) { const u32x2* dp = (const u32x2*)(delta + (size_t)(r0 + i) * D) + lane;
            if constexpr (XBF) { const u32x2* xr = (const u32x2*)((const bf16_t*)xsrc + (size_t)(r0 + i) * D) + lane;
#pragma unroll
                for (int j = 0; j < 4; ++j) { const u32x2 xw = xr[64 * j]; v[i][j] = (f32x4){bflo(xw[0]), bfhi(xw[0]), bflo(xw[1]), bfhi(xw[1])}; dl[i][j] = dp[64 * j]; } }
            else { const f32x4* xr = (const f32x4*)(xsrc + (size_t)(r0 + i) * D) + lane;
#pragma unroll
                for (int j = 0; j < 4; ++j) { v[i][j] = xr[64 * j]; dl[i][j] = dp[64 * j]; } } }
#pragma unroll
        for (int j = 0; j < 4; ++j) { const f32x4 g1 = *(const f32x4*)(mb + 2048 + 256 * j + 4 * lane);
#pragma unroll
            for (int i = 0; i < 4; ++i) { const f32x4 dv = {bflo(dl[i][j][0]), bfhi(dl[i][j][0]), bflo(dl[i][j][1]), bfhi(dl[i][j][1])}; v[i][j] = v[i][j] + g1 * dv;
                ((u32x2*)(xdst + (size_t)(r0 + i) * D) + lane)[64 * j] = (u32x2){pk2(v[i][j][0], v[i][j][1]), pk2(v[i][j][2], v[i][j][3])}; } }
#pragma unroll
        for (int i = 0; i < 4; ++i) { float t = 0.f;
#pragma unroll
            for (int j = 0; j < 4; ++j) t += (v[i][j][0] * v[i][j][0] + v[i][j][1] * v[i][j][1]) + (v[i][j][2] * v[i][j][2] + v[i][j][3] * v[i][j][3]);
            ss[i] = t; }
#pragma unroll
        for (int o = 1; o < 64; o <<= 1) {
#pragma unroll
            for (int i = 0; i < 4; ++i) ss[i] += __shfl_xor(ss[i], o); }
#pragma unroll
        for (int j = 0; j < 4; ++j) { const int col = 256 * j + 4 * lane;
            const f32x4 g4 = *(const f32x4*)(gain + col), sc = *(const f32x4*)(mb + 4096 + col), sh = *(const f32x4*)(mb + 3072 + col);
            const f32x4 gs = g4 * (sc + 1.0f);
#pragma unroll
            for (int i = 0; i < 4; ++i) { const float rstd = __builtin_amdgcn_rsqf(ss[i] * (1.0f / D) + EPS);
                const f32x4 h = v[i][j] * rstd * gs + sh; u32x2 o; o.x = pk2(h[0], h[1]); o.y = pk2(h[2], h[3]); *(u32x2*)(hdst + (size_t)(r0 + i) * D + col) = o;
                int w8 = 0; w8 = __builtin_amdgcn_cvt_pk_fp8_f32(h[0] * X_SCALE, h[1] * X_SCALE, w8, false); w8 = __builtin_amdgcn_cvt_pk_fp8_f32(h[2] * X_SCALE, h[3] * X_SCALE, w8, true);
                *(unsigned*)(xf8 + ((size_t)(col >> 7) * M + (r0 + i)) * 128 + (col & 127)) = (unsigned)w8; } }
    }
}
__device__ __forceinline__ void phase_conv_norm1(const KP& p, LAS unsigned char* lds, int l, int G) {
    const int tid = opaque_tid(), lane = tid & 63, wave = __builtin_amdgcn_readfirstlane(tid >> 6);
    const int gw = blockIdx.x * 8 + wave, ngw = G * 8;
    LAS float* scr = (LAS float*)(lds + wave * 8448);
    constexpr int I_IN = 16 * (INC / 32), I_G = 16 * 32, I_O = 16 * 32, I_Q = 16 * 64, NIT = I_IN + I_G + I_O + I_Q;
    for (int it = gw; it < NIT; it += ngw) {
        int r = it;
        if (r < I_IN) { transpose_item_fp8(p.in[I_WIN] + (size_t)l * D * INC, D, INC, p.ws + WS_WIN, scr, r, lane, WIN_SCALE); continue; } r -= I_IN;
        if (r < I_G) { transpose_item(p.in[I_GLUW] + (size_t)l * D * D, D, D, (bf16_t*)(p.ws + WS_WGLU), scr, r, lane); continue; } r -= I_G;
        if (r < I_O) { transpose_item_fp8(p.in[I_WOUT] + (size_t)l * D * D, D, D, p.ws + WS_WOUT, scr, r, lane, WO_SCALE); continue; } r -= I_O;
        transpose_item(p.in[I_WQ] + (size_t)l * D * 2048, D, 2048, (bf16_t*)(p.ws + WS_WQ), scr, r, lane);
    }
    const size_t gtid = (size_t)blockIdx.x * 512 + tid, nthr = (size_t)G * 512;
    cvt_f32_bf16(p.in[I_SUBK] + (size_t)l * 262144, (bf16_t*)(p.ws + WS_KEYS), 262144 / 4, gtid, nthr);
    if (l == 0) {
        cvt_f32_fp8_sliced(p.in[I_PU], p.ws + WS_U, gtid, nthr, U_SCALE);
        cvt_f32_fp8_sliced(p.in[I_PV], p.ws + WS_V, gtid, nthr, V_SCALE); }
    if (l == 0) norm_rows<true, false>(p.in[I_X], (bf16_t*)(p.ws + WS_H), p.in[I_N1G] + l * D, (const float*)(p.ws + WS_MOD) + (size_t)l * 32 * NMODC, 0, 1024, gw, ngw, lane);
    else norm_rows<true, true>(p.out, (bf16_t*)(p.ws + WS_H), p.in[I_N1G] + l * D, (const float*)(p.ws + WS_MOD) + (size_t)l * 32 * NMODC, 0, 1024, gw, ngw, lane);
}

__device__ __forceinline__ void phase_hgrn2(const KP& p, LAS unsigned char* lds, int l, int G) {
    const int tid = opaque_tid(), lane = tid & 63, w = __builtin_amdgcn_readfirstlane(tid >> 6), fr = lane & 15, g = lane >> 4;
    constexpr int QS = 272, TS = 72;
    constexpr int OFF_QT = 0, OFF_KH = 8704, OFF_KT = 17408, OFF_VT = 26624, OFF_EREF = 35840, OFF_ELR = 36352, OFF_SEG = 36864, PBUF = 40960;
    const bf16_t* PA = (const bf16_t*)(p.ws + WS_R0);
    bf16_t* ORAW = (bf16_t*)(p.ws + WS_OR);
    const float* LB = (const float*)(p.ws + WS_LB) + l * 1024;
    for (int unit = blockIdx.x; unit < 256; unit += G) {
        const int b = unit >> 3, h = unit & 7, k0 = 2 * lane;
        const float lb0 = LB[h * 128 + k0], lb1 = LB[h * 128 + k0 + 1];
        const float om0 = 1.0f - lb0, om1 = 1.0f - lb1;
        f32x4 S[8];
#pragma unroll
        for (int kt = 0; kt < 8; ++kt) S[kt] = (f32x4){0.f, 0.f, 0.f, 0.f};
        unsigned rq[4], rf[4], rv[4];
        {
            const bf16_t* base = PA + ((size_t)b * SEQ + 4 * w) * 3072 + h * 128 + k0;
#pragma unroll
            for (int i = 0; i < 4; ++i) { rq[i] = *(const unsigned*)(base + (size_t)i * 3072); rf[i] = *(const unsigned*)(base + (size_t)i * 3072 + 1024); rv[i] = *(const unsigned*)(base + (size_t)i * 3072 + 2048); }
        }
        for (int c = 0; c < 64; ++c) {
            LAS unsigned char* base = lds + (c & 1) * PBUF;
            float cs0[4], cs1[4], qv0[4], qv1[4], kv0[4], kv1[4];
            float run0 = 0.f, run1 = 0.f;
#pragma unroll
            for (int i = 0; i < 4; ++i) {
                const float fp0 = bflo(rf[i]), fp1 = bfhi(rf[i]);
                const float s0 = fsigmoid(fp0), s1 = fsigmoid(fp1);
                run0 += __logf(lb0 + om0 * s0); run1 += __logf(lb1 + om1 * s1);
                cs0[i] = run0; cs1[i] = run1;
                kv0[i] = om0 * (1.0f - s0); kv1[i] = om1 * (1.0f - s1);
                qv0[i] = fsilu(bflo(rq[i])); qv1[i] = fsilu(bfhi(rq[i]));
            }
            *(LAS f32x2*)(base + OFF_SEG + (w * 128 + k0) * 4) = (f32x2){run0, run1};
            __syncthreads();
            float off0 = 0.f, off1 = 0.f, ref0 = 0.f, ref1 = 0.f, all0 = 0.f, all1 = 0.f;
#pragma unroll
            for (int s = 0; s < 8; ++s) { const f32x2 t2 = *(const LAS f32x2*)(base + OFF_SEG + (s * 128 + k0) * 4);
                if (s < w) { off0 += t2[0]; off1 += t2[1]; }
                if (s < 4) { ref0 += t2[0]; ref1 += t2[1]; }
                all0 += t2[0]; all1 += t2[1]; }
            float kh0[4], kh1[4];
#pragma unroll
            for (int i = 0; i < 4; ++i) {
                const float b0 = off0 + cs0[i], b1 = off1 + cs1[i];
                const float q0 = qv0[i] * __expf(b0 - ref0), q1 = qv1[i] * __expf(b1 - ref1);
                kh0[i] = kv0[i] * __expf(ref0 - b0); kh1[i] = kv1[i] * __expf(ref1 - b1);
                const int t = 4 * w + i;
                *(LAS unsigned*)(base + OFF_QT + t * QS + k0 * 2) = pk2(q0, q1);
                *(LAS unsigned*)(base + OFF_KH + t * QS + k0 * 2) = pk2(kh0[i], kh1[i]);
            }
            *(LAS u32x2*)(base + OFF_KT + k0 * TS + 8 * w) = (u32x2){pk2(kh0[0], kh0[1]), pk2(kh0[2], kh0[3])};
            *(LAS u32x2*)(base + OFF_KT + (k0 + 1) * TS + 8 * w) = (u32x2){pk2(kh1[0], kh1[1]), pk2(kh1[2], kh1[3])};
            *(LAS u32x2*)(base + OFF_VT + k0 * TS + 8 * w) = (u32x2){(rv[0] & 0xffffu) | (rv[1] << 16), (rv[2] & 0xffffu) | (rv[3] << 16)};
            *(LAS u32x2*)(base + OFF_VT + (k0 + 1) * TS + 8 * w) = (u32x2){(rv[0] >> 16) | (rv[1] & 0xffff0000u), (rv[2] >> 16) | (rv[3] & 0xffff0000u)};
            if (w == 0) {
                *(LAS f32x2*)(base + OFF_EREF + k0 * 4) = (f32x2){__expf(ref0), __expf(ref1)};
                *(LAS f32x2*)(base + OFF_ELR + k0 * 4) = (f32x2){__expf(all0 - ref0), __expf(all1 - ref1)};
            }
            __syncthreads();
            if (c + 1 < 64) {
                const bf16_t* nb = PA + ((size_t)b * SEQ + (c + 1) * 32 + 4 * w) * 3072 + h * 128 + k0;
#pragma unroll
                for (int i = 0; i < 4; ++i) { rq[i] = *(const unsigned*)(nb + (size_t)i * 3072); rf[i] = *(const unsigned*)(nb + (size_t)i * 3072 + 1024); rv[i] = *(const unsigned*)(nb + (size_t)i * 3072 + 2048); }
            }
            bf16x8 qf[2][4], kf[2][4];
#pragma unroll
            for (int tt = 0; tt < 2; ++tt)
#pragma unroll
                for (int m = 0; m < 4; ++m) {
                    const LAS unsigned char* pq = base + OFF_QT + (16 * tt + fr) * QS + (32 * m + 4 * g) * 2;
                    const u32x2 lo = *(const LAS u32x2*)pq, hi = *(const LAS u32x2*)(pq + 32);
                    qf[tt][m] = __builtin_bit_cast(bf16x8, (u32x4){lo[0], lo[1], hi[0], hi[1]});
                    const LAS unsigned char* pk = base + OFF_KH + (16 * tt + fr) * QS + (32 * m + 4 * g) * 2;
                    const u32x2 lo2 = *(const LAS u32x2*)pk, hi2 = *(const LAS u32x2*)(pk + 32);
                    kf[tt][m] = __builtin_bit_cast(bf16x8, (u32x4){lo2[0], lo2[1], hi2[0], hi2[1]});
                }
            f32x4 PT00 = {0.f, 0.f, 0.f, 0.f}, PT01 = {0.f, 0.f, 0.f, 0.f}, PT11 = {0.f, 0.f, 0.f, 0.f};
#pragma unroll
            for (int m = 0; m < 4; ++m) {
                PT00 = __builtin_amdgcn_mfma_f32_16x16x32_bf16(kf[0][m], qf[0][m], PT00, 0, 0, 0);
                PT01 = __builtin_amdgcn_mfma_f32_16x16x32_bf16(kf[0][m], qf[1][m], PT01, 0, 0, 0);
                PT11 = __builtin_amdgcn_mfma_f32_16x16x32_bf16(kf[1][m], qf[1][m], PT11, 0, 0, 0);
            }
#pragma unroll
            for (int r = 0; r < 4; ++r) { if (4 * g + r > fr) { PT00[r] = 0.f; PT11[r] = 0.f; } }
            const bf16x8 pa0 = __builtin_bit_cast(bf16x8, (u32x4){pk2(PT00[0], PT00[1]), pk2(PT00[2], PT00[3]), 0u, 0u});
            const bf16x8 pa1 = __builtin_bit_cast(bf16x8, (u32x4){pk2(PT01[0], PT01[1]), pk2(PT01[2], PT01[3]), pk2(PT11[0], PT11[1]), pk2(PT11[2], PT11[3])});
            const LAS unsigned char* vrow = base + OFF_VT + (16 * w + fr) * TS;
            const u32x2 vpa = *(const LAS u32x2*)(vrow + 8 * g), vpb = *(const LAS u32x2*)(vrow + 32 + 8 * g);
            const u32x2 vna = *(const LAS u32x2*)(vrow + 16 * g), vnb = *(const LAS u32x2*)(vrow + 16 * g + 8);
            const bf16x8 vperm = __builtin_bit_cast(bf16x8, (u32x4){vpa[0], vpa[1], vpb[0], vpb[1]});
            const bf16x8 vnat = __builtin_bit_cast(bf16x8, (u32x4){vna[0], vna[1], vnb[0], vnb[1]});
#pragma unroll
            for (int kt = 0; kt < 8; ++kt) { const f32x4 e = *(const LAS f32x4*)(base + OFF_EREF + (16 * kt + 4 * g) * 4); S[kt] = S[kt] * e; }
            f32x4 O0 = {0.f, 0.f, 0.f, 0.f}, O1 = {0.f, 0.f, 0.f, 0.f};
#pragma unroll
            for (int m = 0; m < 4; ++m) {
                const bf16x8 sf = __builtin_bit_cast(bf16x8, (u32x4){pk2(S[2 * m][0], S[2 * m][1]), pk2(S[2 * m][2], S[2 * m][3]), pk2(S[2 * m + 1][0], S[2 * m + 1][1]), pk2(S[2 * m + 1][2], S[2 * m + 1][3])});
                O0 = __builtin_amdgcn_mfma_f32_16x16x32_bf16(qf[0][m], sf, O0, 0, 0, 0);
                O1 = __builtin_amdgcn_mfma_f32_16x16x32_bf16(qf[1][m], sf, O1, 0, 0, 0);
            }
            O0 = __builtin_amdgcn_mfma_f32_16x16x32_bf16(pa0, vperm, O0, 0, 0, 0);
            O1 = __builtin_amdgcn_mfma_f32_16x16x32_bf16(pa1, vperm, O1, 0, 0, 0);
#pragma unroll
            for (int kt = 0; kt < 8; ++kt) {
                const LAS unsigned char* krow = base + OFF_KT + (16 * kt + fr) * TS + 16 * g;
                const u32x2 ka = *(const LAS u32x2*)krow, kb = *(const LAS u32x2*)(krow + 8);
                const bf16x8 ktf = __builtin_bit_cast(bf16x8, (u32x4){ka[0], ka[1], kb[0], kb[1]});
                S[kt] = __builtin_amdgcn_mfma_f32_16x16x32_bf16(ktf, vnat, S[kt], 0, 0, 0);
            }
#pragma unroll
            for (int kt = 0; kt < 8; ++kt) { const f32x4 e = *(const LAS f32x4*)(base + OFF_ELR + (16 * kt + 4 * g) * 4); S[kt] = S[kt] * e; }
            bf16_t* orow = ORAW + ((size_t)b * SEQ + c * 32 + 4 * g) * D + h * 128 + 16 * w + fr;
#pragma unroll
            for (int r = 0; r < 4; ++r) { orow[(size_t)r * D] = (bf16_t)(pk2(O0[r], 0.f) & 0xffffu); orow[(size_t)(16 + r) * D] = (bf16_t)(pk2(O1[r], 0.f) & 0xffffu); }
        }
        __syncthreads();
    }
}

__device__ __forceinline__ void phase_s5(const KP& p, LAS unsigned char* lds, int l, int G, size_t ys_off) {
    const int tid = opaque_tid(), lane = tid & 63, w = __builtin_amdgcn_readfirstlane(tid >> 6), fr = lane & 15, g = lane >> 4;
    const int gw = blockIdx.x * 8 + w, ngw = G * 8;
    constexpr int BUS = 132;
    LAS float* BU = (LAS float*)(lds + w * 16896);
    LAS unsigned char* XI = (LAS unsigned char*)BU;
    const bf16_t* PB = (const bf16_t*)(p.ws + WS_R0);
    const bf16x8 zero8 = {0, 0, 0, 0, 0, 0, 0, 0};
    const bf16_t* ORAWs = (const bf16_t*)(p.ws + WS_OR); float* SSQs = (float*)(p.ws + WS_SSQ);
    for (int unit = gw; unit < BATCH * 64; unit += ngw) {
        const int b = unit >> 6, grp = unit & 63, lg = l * 64 + grp;
        const bf16_t* BOP = (const bf16_t*)(p.ws + WS_BOP) + (size_t)lg * 128 * 16;
        const bf16_t* COP = (const bf16_t*)(p.ws + WS_COP) + (size_t)lg * 16 * 128;
        bf16x8 bfrag[8], cfrag[4], dfrag;
#pragma unroll
        for (int nt = 0; nt < 8; ++nt) bfrag[nt] = (g < 2) ? *(const bf16x8*)(BOP + (size_t)(16 * nt + fr) * 16 + 8 * g) : zero8;
#pragma unroll
        for (int ks = 0; ks < 4; ++ks) cfrag[ks] = DBG_S5_NOSSM ? zero8 : *(const bf16x8*)(COP + (size_t)fr * 128 + 32 * ks + 8 * g);
        {
            const unsigned dbits = pk2(p.in[I_S5D][l * 1024 + grp * 16 + fr], 0.f) & 0xffffu;
#pragma unroll
            for (int j = 0; j < 8; ++j) dfrag[j] = (g < 2 && (8 * g + j) == fr) ? (short)dbits : (short)0;
        }
        const float ar = ((const float*)(p.ws + WS_ABAR))[2 * ((size_t)lg * 64 + lane)], ai = ((const float*)(p.ws + WS_ABAR))[2 * ((size_t)lg * 64 + lane) + 1];
        const float nai = -ai; float xr = 0.f, xi = 0.f; unsigned hBU = 0u, hXI = 0u, hY = 0u;
        const bf16_t* ub = PB + ((size_t)b * SEQ) * 4096 + 1024 + grp * 16;
        bf16_t* yb_ = (bf16_t*)(p.ws + ys_off) + ((size_t)b * SEQ) * D + grp * 16;
        bf16x8 unext[2];
#pragma unroll
        for (int tt = 0; tt < 2; ++tt) unext[tt] = (g < 2) ? *(const bf16x8*)(ub + (size_t)(16 * tt + fr) * 4096 + 8 * g) : zero8;
        const bool cvt_next = (l + 1 < DEPTH);
        const float* tsrc = ((lane < 32) ? p.in[I_PU] : p.in[I_PV]) + (size_t)(l + 1 < DEPTH ? l + 1 : l) * 16384 * 1024 + 4 * (lane & 31);
        unsigned char* tdst = p.ws + ((lane < 32) ? WS_U : WS_V) + (size_t)((l + 1) & 1) * TAB_BYTES + 4 * (lane & 31);
        const float tscale = (lane < 32) ? U_SCALE : V_SCALE;
        for (int t0 = 0; t0 < SEQ; t0 += 32) {
            const int item = unit * 64 + (t0 >> 5), te = item >> 3, tsl = item & 7;
            f32x4 tv = {0.f, 0.f, 0.f, 0.f}; if (cvt_next) tv = *(const f32x4*)(tsrc + (size_t)te * 1024 + tsl * 128);
            const bool ssq_it = ((t0 >> 5) & 1) == 0; const int srow = item >> 1;
            u32x4 sa = {0u, 0u, 0u, 0u}, sc2 = {0u, 0u, 0u, 0u};
            if (ssq_it) { sa = *(const u32x4*)(ORAWs + (size_t)srow * D + 8 * lane); sc2 = *(const u32x4*)(ORAWs + (size_t)srow * D + 512 + 8 * lane); }
            bf16x8 ufrag[2];
#pragma unroll
            for (int tt = 0; tt < 2; ++tt) { ufrag[tt] = unext[tt]; if (t0 + 32 < SEQ) unext[tt] = (g < 2) ? *(const bf16x8*)(ub + (size_t)(t0 + 32 + 16 * tt + fr) * 4096 + 8 * g) : zero8; }
#pragma unroll
            for (int tt = 0; tt < 2; ++tt)
#pragma unroll
                for (int nt = 0; nt < 8; ++nt) {
                    const f32x4 a = __builtin_amdgcn_mfma_f32_16x16x32_bf16(ufrag[tt], bfrag[nt], (f32x4){0.f, 0.f, 0.f, 0.f}, 0, 0, 0);
#pragma unroll
                    for (int r = 0; r < 4; ++r) BU[(16 * tt + 4 * g + r) * BUS + 16 * nt + fr] = a[r];
                }
            LDS_WAIT();
#pragma unroll
            for (int t = 0; t < 32; ++t) {
                const f32x2 bb = *(const LAS f32x2*)(BU + t * BUS + 2 * lane); hBU += __float_as_uint(bb[0]) * 3u + __float_as_uint(bb[1]);
                float t1, t2, nr, ni;
                asm("v_fma_f32 %0, %1, %2, %3" : "=v"(t1) : "v"(nai), "v"(xi), "v"(bb[0]));
                asm("v_fma_f32 %0, %1, %2, %3" : "=v"(t2) : "v"(ai), "v"(xr), "v"(bb[1]));
                asm("v_fma_f32 %0, %1, %2, %3" : "=v"(nr) : "v"(ar), "v"(xr), "v"(t1));
                asm("v_fma_f32 %0, %1, %2, %3" : "=v"(ni) : "v"(ar), "v"(xi), "v"(t2));
                xr = nr; xi = ni;
                { const unsigned pv = pk2(nr, ni); hXI += pv; *(LAS unsigned*)(XI + t * (BUS * 4) + lane * 4) = pv; }
            }
            LDS_WAIT();
#pragma unroll
            for (int tt = 0; tt < 2; ++tt) {
                f32x4 y = {0.f, 0.f, 0.f, 0.f};
#pragma unroll
                for (int ks = 0; ks < 4; ++ks) {
                    const bf16x8 xf = *(const LAS bf16x8*)(XI + (16 * tt + fr) * (BUS * 4) + (32 * ks + 8 * g) * 2);
                    y = __builtin_amdgcn_mfma_f32_16x16x32_bf16(xf, cfrag[ks], y, 0, 0, 0);
                }
                y = __builtin_amdgcn_mfma_f32_16x16x32_bf16(ufrag[tt], dfrag, y, 0, 0, 0);
#pragma unroll
                for (int r = 0; r < 4; ++r) { const unsigned yv = pk2(fgelu(y[r]), 0.f) & 0xffffu; hY += yv * (unsigned)(r + 1); yb_[(size_t)(t0 + 16 * tt + 4 * g + r) * D + fr] = (bf16_t)yv; }
            }
            LDS_WAIT();
            if (ssq_it) { float s0 = 0.f, s1 = 0.f;
#pragma unroll
                for (int j = 0; j < 4; ++j) { const float x0 = bflo(sa[j]), x1 = bfhi(sa[j]), y0 = bflo(sc2[j]), y1 = bfhi(sc2[j]); s0 += x0 * x0 + x1 * x1; s1 += y0 * y0 + y1 * y1; }
                { s0 = dpp_sum8(s0); s1 = dpp_sum8(s1);
                  s0 += __uint_as_float(__builtin_amdgcn_update_dpp(0, __float_as_uint(s0), 0x140, 0xF, 0xF, true)); s1 += __uint_as_float(__builtin_amdgcn_update_dpp(0, __float_as_uint(s1), 0x140, 0xF, 0xF, true)); }
                if (fr == 0) { SSQs[(size_t)srow * 8 + g] = s0; SSQs[(size_t)srow * 8 + 4 + g] = s1; } }
            if (cvt_next) { int w8 = 0; w8 = __builtin_amdgcn_cvt_pk_fp8_f32(tv[0] * tscale, tv[1] * tscale, w8, false); w8 = __builtin_amdgcn_cvt_pk_fp8_f32(tv[2] * tscale, tv[3] * tscale, w8, true);
                *(unsigned*)(tdst + ((size_t)tsl * 16384 + te) * 128) = (unsigned)w8; }
        }
        if (DBG_SELFCHECK) { for (int o = 1; o < 64; o <<= 1) { hBU += __shfl_xor((int)hBU, o); hXI += __shfl_xor((int)hXI, o); hY += __shfl_xor((int)hY, o); }
            unsigned* hs = (unsigned*)(p.ws + WS_CTL) + 65536 + (ys_off == WS_YS ? 0 : 8192) + unit * 4; unsigned hA = __float_as_uint(ar) * 7u + __float_as_uint(ai); for (int o = 1; o < 64; o <<= 1) hA += __shfl_xor((int)hA, o); if (lane == 0) { hs[0] = hBU; hs[1] = hXI; hs[2] = hA; } }
    }
}

__device__ __forceinline__ unsigned fkey(float f) { const unsigned u = __float_as_uint(f); return u ^ ((unsigned)((int)u >> 31) | 0x80000000u); }
__device__ __forceinline__ float kval(unsigned k) { const unsigned u = (k & 0x80000000u) ? (k ^ 0x80000000u) : ~k; return __uint_as_float(u); }
#define CE_DESC(a, b) do { const unsigned _mx = (a) > (b) ? (a) : (b), _mn = (a) > (b) ? (b) : (a); (a) = _mx; (b) = _mn; } while (0)
__device__ __forceinline__ void sort16_desc(unsigned (&a)[16]) {
#pragma unroll
    for (int kk = 1; kk <= 4; ++kk)
#pragma unroll
        for (int jj = kk - 1; jj >= 0; --jj)
#pragma unroll
            for (int i = 0; i < 16; ++i) { const int k = 1 << kk, j = 1 << jj, l2 = i ^ j;
                if (l2 > i) { if ((i & k) == 0) CE_DESC(a[i], a[l2]); else CE_DESC(a[l2], a[i]); } }
}
__device__ __forceinline__ void merge_top16(unsigned (&a)[16], const unsigned (&b)[16]) {
#pragma unroll
    for (int i = 0; i < 16; ++i) a[i] = a[i] > b[15 - i] ? a[i] : b[15 - i];
#pragma unroll
    for (int jj = 3; jj >= 0; --jj)
#pragma unroll
        for (int i = 0; i < 16; ++i) { const int j = 1 << jj, l2 = i ^ j; if (l2 > i) CE_DESC(a[i], a[l2]); }
}
__device__ __forceinline__ void phase_topk(const KP& p, LAS unsigned char* lds, int G) {
    const int tid = opaque_tid(), lane = tid & 63, w = __builtin_amdgcn_readfirstlane(tid >> 6), hh = lane >> 5;
    const int gw = blockIdx.x * 8 + w, ngw = G * 8;
    const bf16_t* Q = (const bf16_t*)(p.ws + WS_R0); const bf16_t* KEYS = (const bf16_t*)(p.ws + WS_KEYS);
    unsigned* SEL = (unsigned*)(p.ws + WS_SEL);
    LAS unsigned char* tab = lds + w * 2048 + lane * 32;
    const int CI[50] = {0,0,0,0,0,0,0,0,0,0,0,0,0,0,0,0, 1,1,1,1,1,1,1,1, 2,2,2,2,2, 3,3,3,3, 4,4,4, 5,5, 6,6, 7,7, 8,9,10,11,12,13,14,15};
    const int CJ[50] = {0,1,2,3,4,5,6,7,8,9,10,11,12,13,14,15, 0,1,2,3,4,5,6,7, 0,1,2,3,4, 0,1,2,3, 0,1,2, 0,1, 0,1, 0,1, 0,0,0,0,0,0,0,0};
    LAS unsigned char* kimg = lds + 16384;
    for (int h = 0; h < 8; ++h) {
      __syncthreads();
#pragma unroll
      for (int i = 0; i < 8; ++i) { const int ch = tid + 512 * i, row = ch >> 4, c16 = ch & 15;
          *(LAS u32x4*)(kimg + row * 272 + c16 * 16) = *(const u32x4*)(KEYS + (size_t)(h * 256 + row) * 128 + c16 * 8); }
      __syncthreads();
      for (int tg = gw; tg < 2048; tg += ngw) {
        const int t = tg * 32 + (lane & 31);
        unsigned top[2][16];
#pragma unroll
        for (int pp = 0; pp < 2; ++pp) {
            bf16x8 qf[8];
#pragma unroll
            for (int ks = 0; ks < 8; ++ks) qf[ks] = *(const bf16x8*)(Q + ((size_t)((((tg * 8 + h) * 2 + pp) * 8 + ks) * 64 + lane)) * 8);
            const LAS unsigned char* kb = kimg + (pp * 128 + (lane & 31)) * 272 + 16 * hh;
#pragma unroll
            for (int nt = 0; nt < 4; ++nt) {
                f32x16 acc;
#pragma unroll
                for (int i = 0; i < 16; ++i) acc[i] = 0.f;
#pragma unroll
                for (int ks = 0; ks < 8; ++ks) { const bf16x8 kf = *(const LAS bf16x8*)(kb + (32 * nt) * 272 + 32 * ks);
                    acc = __builtin_amdgcn_mfma_f32_32x32x16_bf16(kf, qf[ks], acc, 0, 0, 0); }
                unsigned ky[16];
#pragma unroll
                for (int r = 0; r < 16; ++r) ky[r] = (fkey(acc[r]) & ~127u) | (unsigned)(32 * nt + (r & 3) + 8 * (r >> 2)) | (unsigned)(4 * hh);
                sort16_desc(ky);
                if (nt == 0) {
#pragma unroll
                    for (int i = 0; i < 16; ++i) top[pp][i] = ky[i];
                } else merge_top16(top[pp], ky);
            }
            unsigned other[16];
#pragma unroll
            for (int i = 0; i < 16; ++i) { const u32x2 sw_ = __builtin_amdgcn_permlane32_swap(top[pp][i], top[pp][i], false, false); other[i] = hh ? sw_[0] : sw_[1]; }
            merge_top16(top[pp], other);
        }
        float sa[16], sb[16];
#pragma unroll
        for (int i = 0; i < 16; ++i) { sa[i] = kval(top[0][i] & ~127u); sb[i] = kval(top[1][i] & ~127u); }
        unsigned c0[16], c1[16];
#pragma unroll
        for (int s = 0; s < 32; ++s) {
            unsigned key = 0u;
            if (s < 25) {
                const float v0 = sa[CI[s]] + sb[CJ[s]], v1 = sa[CI[25 + s]] + sb[CJ[25 + s]];
                const unsigned k0 = (fkey(v0) & ~255u) | (unsigned)(CI[s] * 16 + CJ[s]), k1 = (fkey(v1) & ~255u) | (unsigned)(CI[25 + s] * 16 + CJ[25 + s]);
                key = hh ? k1 : k0;
            }
            if (s < 16) c0[s] = key; else c1[s - 16] = key;
        }
        sort16_desc(c0); sort16_desc(c1); merge_top16(c0, c1);
#pragma unroll
        for (int i = 0; i < 16; ++i) { const u32x2 sw_ = __builtin_amdgcn_permlane32_swap(c0[i], c0[i], false, false); c1[i] = hh ? sw_[0] : sw_[1]; }
        merge_top16(c0, c1);
        {
            u32x4 wa, wb;
#pragma unroll
            for (int q4 = 0; q4 < 4; ++q4) {
                wa[q4] = (top[0][4 * q4] & 127u) | ((top[0][4 * q4 + 1] & 127u) << 8) | ((top[0][4 * q4 + 2] & 127u) << 16) | ((top[0][4 * q4 + 3] & 127u) << 24);
                wb[q4] = (top[1][4 * q4] & 127u) | ((top[1][4 * q4 + 1] & 127u) << 8) | ((top[1][4 * q4 + 2] & 127u) << 16) | ((top[1][4 * q4 + 3] & 127u) << 24);
            }
            *(LAS u32x4*)tab = wa; *(LAS u32x4*)(tab + 16) = wb;
        }
        float ev[16], esum = 0.f; const float vmax = kval(c0[0] & ~255u);
#pragma unroll
        for (int k = 0; k < 16; ++k) { ev[k] = __expf(kval(c0[k] & ~255u) - vmax); esum += ev[k]; }
        const float rs = 1.0f / esum;
        LDS_WAIT();
        unsigned outw[8]; const unsigned hmask = hh ? 0xffffffffu : 0u;
#pragma unroll
        for (int kk = 0; kk < 8; ++kk) {
            const unsigned key = c0[kk] ^ ((c0[kk] ^ c0[8 + kk]) & hmask); const float e = __uint_as_float(__float_as_uint(ev[kk]) ^ ((__float_as_uint(ev[kk]) ^ __float_as_uint(ev[8 + kk])) & hmask));
            const unsigned code = key & 255u, ia = tab[code >> 4], ib = tab[16 + (code & 15u)];
            outw[kk] = (pk2(0.f, e * rs) & 0xffff0000u) | (ia * 128u + ib);
        }
        u32x4* dst = (u32x4*)(SEL + (size_t)t * 128 + h * 16 + hh * 8);
        dst[0] = (u32x4){outw[0], outw[1], outw[2], outw[3]}; dst[1] = (u32x4){outw[4], outw[5], outw[6], outw[7]};
        LDS_WAIT();
      }
    }
    __syncthreads();
}

__device__ __forceinline__ void fp8x4_to_f32(unsigned w, float& a, float& b, float& c, float& d) {
    const f32x2 lo = __builtin_amdgcn_cvt_pk_f32_fp8((int)w, false), hi = __builtin_amdgcn_cvt_pk_f32_fp8((int)w, true); a = lo[0]; b = lo[1]; c = hi[0]; d = hi[1];
}
struct XSlice { int sl, rank, nloc; };
__device__ __forceinline__ XSlice xslice_of_block(const KP& p, volatile LAS unsigned* MISC, int G) {
    unsigned* bar = (unsigned*)(p.ws + WS_CTL) + 4096; unsigned cnt[8]; unsigned tot = 0; bool ok = true;
#pragma unroll
    for (int j = 0; j < 8; ++j) { cnt[j] = xb_ld(&bar[XB_XCNT(j)]); tot += cnt[j]; ok = ok && (cnt[j] > 0u); }
    ok = ok && (tot == (unsigned)G);
    XSlice x;
    if (ok) { const unsigned myx = MISC[16]; x.sl = (int)myx; x.rank = (int)MISC[17]; x.nloc = (int)cnt[myx & 7u]; }
    else { x.sl = (int)(blockIdx.x & 7); x.rank = (int)(blockIdx.x >> 3); x.nloc = (G - x.sl + 7) >> 3; }
    x.sl = __builtin_amdgcn_readfirstlane(x.sl); x.rank = __builtin_amdgcn_readfirstlane(x.rank); x.nloc = __builtin_amdgcn_readfirstlane(x.nloc);
    return x;
}
__device__ __forceinline__ float dot16_fp8(const u32x4 u, const float (&hf)[16]) {
    float d = 0.f;
#pragma unroll
    for (int j = 0; j < 4; ++j) { float f0, f1, f2, f3; fp8x4_to_f32(u[j], f0, f1, f2, f3);
        d = __builtin_fmaf(f0, hf[4 * j], d); d = __builtin_fmaf(f1, hf[4 * j + 1], d); d = __builtin_fmaf(f2, hf[4 * j + 2], d); d = __builtin_fmaf(f3, hf[4 * j + 3], d); }
    return d;
}
typedef __bf16 bf16v8 __attribute__((ext_vector_type(8)));
__device__ __forceinline__ float dot16_fp8_bf16(const u32x4 u, const bf16v8 h0, const bf16v8 h1) {
    float d0 = 0.f, d1 = 0.f;
    d0 = __builtin_amdgcn_fdot2_f32_bf16(__builtin_amdgcn_cvt_scalef32_pk_bf16_fp8(u[0], 1.0f, false), __builtin_shufflevector(h0, h0, 0, 1), d0, false);
    d1 = __builtin_amdgcn_fdot2_f32_bf16(__builtin_amdgcn_cvt_scalef32_pk_bf16_fp8(u[0], 1.0f, true),  __builtin_shufflevector(h0, h0, 2, 3), d1, false);
    d0 = __builtin_amdgcn_fdot2_f32_bf16(__builtin_amdgcn_cvt_scalef32_pk_bf16_fp8(u[1], 1.0f, false), __builtin_shufflevector(h0, h0, 4, 5), d0, false);
    d1 = __builtin_amdgcn_fdot2_f32_bf16(__builtin_amdgcn_cvt_scalef32_pk_bf16_fp8(u[1], 1.0f, true),  __builtin_shufflevector(h0, h0, 6, 7), d1, false);
    d0 = __builtin_amdgcn_fdot2_f32_bf16(__builtin_amdgcn_cvt_scalef32_pk_bf16_fp8(u[2], 1.0f, false), __builtin_shufflevector(h1, h1, 0, 1), d0, false);
    d1 = __builtin_amdgcn_fdot2_f32_bf16(__builtin_amdgcn_cvt_scalef32_pk_bf16_fp8(u[2], 1.0f, true),  __builtin_shufflevector(h1, h1, 2, 3), d1, false);
    d0 = __builtin_amdgcn_fdot2_f32_bf16(__builtin_amdgcn_cvt_scalef32_pk_bf16_fp8(u[3], 1.0f, false), __builtin_shufflevector(h1, h1, 4, 5), d0, false);
    d1 = __builtin_amdgcn_fdot2_f32_bf16(__builtin_amdgcn_cvt_scalef32_pk_bf16_fp8(u[3], 1.0f, true),  __builtin_shufflevector(h1, h1, 6, 7), d1, false);
    return d0 + d1;
}
__device__ __forceinline__ float dpp_sum8(float d) {
    d += __uint_as_float(__builtin_amdgcn_update_dpp(0, __float_as_uint(d), 0xB1, 0xF, 0xF, true));
    d += __uint_as_float(__builtin_amdgcn_update_dpp(0, __float_as_uint(d), 0x4E, 0xF, 0xF, true));
    d += __uint_as_float(__builtin_amdgcn_update_dpp(0, __float_as_uint(d), 0x141, 0xF, 0xF, true));
    return d;
}
__device__ __forceinline__ void phase_expert_u(const KP& p, LAS unsigned char* lds, volatile LAS unsigned* MISC, int l, int G) {
    const int tid = opaque_tid(), lane = tid & 63, w = __builtin_amdgcn_readfirstlane(tid >> 6), j = lane >> 3, c = lane & 7, i16 = lane & 15, kq = lane >> 4;
    const XSlice xs = xslice_of_block(p, MISC, G);
    const unsigned char* XF = p.ws + WS_XF8 + (size_t)xs.sl * M * 128; const unsigned char* Us = p.ws + WS_U + (size_t)(l & 1) * TAB_BYTES + (size_t)xs.sl * 16384 * 128;
    const unsigned* SEL = (const unsigned*)(p.ws + WS_SEL); unsigned* PDu = (unsigned*)(p.ws + WS_R0) + (size_t)xs.sl * M * 64;
    const int t0 = xs.rank * 8 + w, tstep = xs.nloc * 8;
    LAS unsigned char* ring = lds + w * 18176;
    LAS unsigned char* selb = ring + 16384; LAS unsigned char* hbuf = ring + 16384 + 1024; LAS unsigned char* pdscr = ring + 16384 + 1024 + 512;
    const int tlast = t0 + ((M - 1 - t0) / tstep) * tstep;
    const int ai = (int)((0x5172023724663367ull >> (4 * i16)) & 7ull);
    const int ch0 = (ai ^ (2 * kq)) & 7, ch1 = ch0 ^ 1;
    const int rowoff = (i16 >> 3) * 1024 + (i16 & 7) * 128;
    const bool diag = kq == (i16 >> 2);
    LAS unsigned short* pdw = (LAS unsigned short*)pdscr + 16 * (i16 & 7) + (i16 >> 3);
#define E1_CL(t) ((t) <= tlast ? (t) : tlast)
#define E1_DMA_SEL(t, par) do { const unsigned* sp = SEL + (size_t)E1_CL(t) * 128 + lane; \
            __builtin_amdgcn_global_load_lds(sp, (LAS unsigned*)(selb + (par) * 512), 4, 0, 0); __builtin_amdgcn_global_load_lds(sp + 64, (LAS unsigned*)(selb + (par) * 512 + 256), 4, 0, 0); } while (0)
#define E1_DMA_H(t, par) do { __builtin_amdgcn_global_load_lds((const unsigned*)(XF + (size_t)E1_CL(t) * 128) + lane, (LAS unsigned*)(hbuf + (par) * 256), 4, 0, 0); } while (0)
#define E1_DMA_ROW(i, idxv) do { __builtin_amdgcn_global_load_lds((const unsigned*)(Us + (size_t)((idxv) & 0x3fffu) * 128 + 16 * c), (LAS unsigned*)(ring + (i) * 1024), 16, 0, 0); } while (0)
    if (t0 < M) {
        E1_DMA_SEL(t0, 0); E1_DMA_SEL(t0 + tstep, 1); E1_DMA_H(t0, 0);
        asm volatile("s_waitcnt vmcnt(0)" ::: "memory");
        { u32x4 s0[4];
#pragma unroll
          for (int q = 0; q < 4; ++q) s0[q] = *(const LAS u32x4*)(selb + (16 * j + 4 * q) * 4);
#pragma unroll
          for (int i = 0; i < 16; ++i) E1_DMA_ROW(i, s0[i >> 2][i & 3]); }
        { PDu[(size_t)t0 * 64 + lane] = 0u; }
        int par = 0;
        for (int tok = t0; tok < M; tok += tstep, par ^= 1) {
            E1_DMA_SEL(tok + 2 * tstep, par); E1_DMA_H(tok + tstep, par ^ 1);
            asm volatile("s_waitcnt vmcnt(19)" ::: "memory");
            u32x4 sn[4];
#pragma unroll
            for (int q = 0; q < 4; ++q) sn[q] = *(const LAS u32x4*)(selb + (par ^ 1) * 512 + (16 * j + 4 * q) * 4);
            const i32x4 xb0 = *(const LAS i32x4*)(hbuf + par * 256 + 16 * ch0), xb1 = *(const LAS i32x4*)(hbuf + par * 256 + 16 * ch1);
            const i32x8 B = __builtin_shufflevector(xb0, xb1, 0, 1, 2, 3, 4, 5, 6, 7);
#pragma unroll
            for (int i0 = 0; i0 < 16; i0 += 4) {
                asm volatile("s_waitcnt vmcnt(16)" ::: "memory");
                const LAS unsigned char* rb = ring + i0 * 1024 + rowoff;
                const i32x4 a0 = *(const LAS i32x4*)(rb + 16 * ch0), a1 = *(const LAS i32x4*)(rb + 16 * ch1), a2 = *(const LAS i32x4*)(rb + 2048 + 16 * ch0), a3 = *(const LAS i32x4*)(rb + 2048 + 16 * ch1);
                asm volatile("s_waitcnt lgkmcnt(0)" ::: "memory");
#pragma unroll
                for (int r = 0; r < 4; ++r) E1_DMA_ROW(i0 + r, sn[(i0 + r) >> 2][(i0 + r) & 3]);
                const f32x4 z = {0.f, 0.f, 0.f, 0.f};
                const f32x4 d0 = __builtin_amdgcn_mfma_scale_f32_16x16x128_f8f6f4(__builtin_shufflevector(a0, a1, 0, 1, 2, 3, 4, 5, 6, 7), B, z, 0, 0, 0, 0x7f7f7f7f, 0, 0x7f7f7f7f);
                const f32x4 d1 = __builtin_amdgcn_mfma_scale_f32_16x16x128_f8f6f4(__builtin_shufflevector(a2, a3, 0, 1, 2, 3, 4, 5, 6, 7), B, z, 0, 0, 0, 0x7f7f7f7f, 0, 0x7f7f7f7f);
                const float v0 = (i16 & 2) ? ((i16 & 1) ? d0[3] : d0[2]) : ((i16 & 1) ? d0[1] : d0[0]), v1 = (i16 & 2) ? ((i16 & 1) ? d1[3] : d1[2]) : ((i16 & 1) ? d1[1] : d1[0]);
                if (diag) { pdw[i0] = (unsigned short)(pk2(v0, 0.f) & 0xffffu); pdw[i0 + 2] = (unsigned short)(pk2(v1, 0.f) & 0xffffu); }
            }
            asm volatile("s_waitcnt lgkmcnt(0)" ::: "memory");
            PDu[(size_t)tok * 64 + lane] = *(const LAS unsigned*)(pdscr + 4 * lane);
        }
        asm volatile("s_waitcnt vmcnt(0)" ::: "memory");
    }
#undef E1_CL
#undef E1_DMA_SEL
#undef E1_DMA_H
#undef E1_DMA_ROW
}
__device__ __forceinline__ void phase_expert_w(const KP& p, int G) {
    const int tid = opaque_tid(), lane = tid & 63, w = __builtin_amdgcn_readfirstlane(tid >> 6);
    const int gw = blockIdx.x * 8 + w, ngw = G * 8;
    unsigned* SEL = (unsigned*)(p.ws + WS_SEL); const unsigned* PDu = (const unsigned*)(p.ws + WS_R0);
    for (int tok0 = gw; tok0 < M; tok0 += 4 * ngw) {
        unsigned pw[4][8]; u32x2 s2[4];
#pragma unroll
        for (int k = 0; k < 4; ++k) { const int tok = (tok0 + k * ngw < M) ? tok0 + k * ngw : tok0;
#pragma unroll
            for (int sl = 0; sl < 8; ++sl) pw[k][sl] = PDu[((size_t)sl * M + tok) * 64 + lane];
            s2[k] = *(const u32x2*)(SEL + (size_t)tok * 128 + 2 * lane); }
#pragma unroll
        for (int k = 0; k < 4; ++k) { const int tok = tok0 + k * ngw;
            f32x2 d = {0.f, 0.f};
#pragma unroll
            for (int sl = 0; sl < 8; ++sl) { d[0] += bflo(pw[k][sl]); d[1] += bfhi(pw[k][sl]); }
            const float w0 = __uint_as_float(s2[k][0] & 0xffff0000u) * fgelu(d[0] * (1.0f / (U_SCALE * X_SCALE))) * (1.0f / V_SCALE);
            const float w1 = __uint_as_float(s2[k][1] & 0xffff0000u) * fgelu(d[1] * (1.0f / (U_SCALE * X_SCALE))) * (1.0f / V_SCALE);
            u32x2 o; o[0] = (pk2(0.f, w0) & 0xffff0000u) | (s2[k][0] & 0x3fffu); o[1] = (pk2(0.f, w1) & 0xffff0000u) | (s2[k][1] & 0x3fffu);
            if (tok < M) { *(u32x2*)(SEL + (size_t)tok * 128 + 2 * lane) = o;
                const int wq = __builtin_amdgcn_cvt_pk_fp8_f32(w0 * W8_SCALE, w1 * W8_SCALE, 0, false); const int s_ = (2 * lane) & 15, q_ = lane >> 3;
                unsigned char* wf = p.ws + WS_WF8 + (size_t)tok * 128 + 32 * (s_ >> 2) + 8 * (s_ & 3) + q_; wf[0] = (unsigned char)(wq & 255); wf[8] = (unsigned char)((wq >> 8) & 255); } }
    }
}
__device__ __forceinline__ void phase_expert_v(const KP& p, LAS unsigned char* lds, volatile LAS unsigned* MISC, int l, int G) {
    const int tid = opaque_tid(), lane = tid & 63, w = __builtin_amdgcn_readfirstlane(tid >> 6), j = lane >> 3, c = lane & 7, li = lane & 15, g = lane >> 4;
    const XSlice xs = xslice_of_block(p, MISC, G);
    const unsigned char* Vs = p.ws + WS_V + (size_t)(l & 1) * TAB_BYTES + (size_t)xs.sl * 16384 * 128;
    const unsigned* SEL = (const unsigned*)(p.ws + WS_SEL); const unsigned char* WF = p.ws + WS_WF8;
    const float* g2 = (const float*)(p.ws + WS_MOD) + (size_t)l * 32 * NMODC + 5120;
    const bf16_t* X = (const bf16_t*)p.out; bf16_t* XO = (l == DEPTH - 1) ? (bf16_t*)(p.ws + WS_YS) : (bf16_t*)p.out;
    const int t0 = xs.rank * 8 + w, tstep = xs.nloc * 8;
    LAS unsigned char* ring = lds + w * 19712; LAS unsigned char* selb = ring + 16384;
    LAS unsigned char* xbuf = ring + 16384 + 1024;
    LAS unsigned char* wbuf = ring + 16384 + 1024 + 512;
    LAS float* obuf = (LAS float*)(ring + 16384 + 1024 + 1024);
    const int tlast = t0 + ((M - 1 - t0) / tstep) * tstep;
    int troff[8];
#pragma unroll
    for (int n = 0; n < 8; ++n) troff[n] = (li >> 1) * 128 + 16 * (n ^ (li >> 1) ^ (g & 1)) + 8 * (li & 1);
    const int dim = xs.sl * 128 + 2 * lane;
#define E2_CL(t) ((t) <= tlast ? (t) : tlast)
#define E2_DMA_SEL(t, par) do { const unsigned* sp = SEL + (size_t)E2_CL(t) * 128 + lane; \
            __builtin_amdgcn_global_load_lds(sp, (LAS unsigned*)(selb + (par) * 512), 4, 0, 0); __builtin_amdgcn_global_load_lds(sp + 64, (LAS unsigned*)(selb + (par) * 512 + 256), 4, 0, 0); } while (0)
#define E2_DMA_WF(t, par) __builtin_amdgcn_global_load_lds((const unsigned*)(WF + (size_t)E2_CL(t) * 128) + lane, (LAS unsigned*)(wbuf + (par) * 256), 4, 0, 0)
#define E2_DMA_ROW(s_, idxv) do { __builtin_amdgcn_global_load_lds((const unsigned*)(Vs + (size_t)((idxv) & 0x3fffu) * 128 + 16 * (c ^ j ^ (((s_) >> 2) & 1))), (LAS unsigned*)(ring + (s_) * 1024), 16, 0, 0); } while (0)
#define E2_SLOT(k) (4 * ((k) & 3) + ((k) >> 2))
    if (t0 < M) {
        E2_DMA_SEL(t0, 0); E2_DMA_SEL(t0 + tstep, 1); E2_DMA_WF(t0, 0);
        asm volatile("s_waitcnt vmcnt(0)" ::: "memory");
        { u32x4 sc[4];
#pragma unroll
          for (int q = 0; q < 4; ++q) sc[q] = *(const LAS u32x4*)(selb + (16 * j + 4 * q) * 4);
#pragma unroll
          for (int k = 0; k < 16; ++k) { const int s_ = E2_SLOT(k); E2_DMA_ROW(s_, sc[s_ >> 2][s_ & 3]); } }
        { __builtin_amdgcn_global_load_lds((const unsigned*)(X + (size_t)t0 * D + dim), (LAS unsigned*)xbuf, 4, 0, 0); }
        int par = 0, bcur = -1; f32x2 gv = {0.f, 0.f};
        for (int tok = t0; tok < M; tok += tstep, par ^= 1) {
            const size_t xo = (size_t)tok * D + dim;
            if ((tok >> 11) != bcur) { bcur = tok >> 11; const f32x2 gl = *(const f32x2*)(g2 + (size_t)bcur * NMODC + dim); asm volatile("s_waitcnt vmcnt(0)" ::: "memory"); gv[0] = gl[0] * (1.0f / W8_SCALE); gv[1] = gl[1] * (1.0f / W8_SCALE); asm volatile("" : "+v"(gv)); }
            E2_DMA_SEL(tok + 2 * tstep, par);
            __builtin_amdgcn_global_load_lds((const unsigned*)(X + (size_t)E2_CL(tok + tstep) * D + dim), (LAS unsigned*)(xbuf + 256 * (par ^ 1)), 4, 0, 0);
            E2_DMA_WF(tok + tstep, par ^ 1);
            asm volatile("s_waitcnt vmcnt(21)" ::: "memory");
            u32x4 sn[4];
#pragma unroll
            for (int q = 0; q < 4; ++q) sn[q] = *(const LAS u32x4*)(selb + (par ^ 1) * 512 + (16 * j + 4 * q) * 4);
            i32x8 A;
            { const i32x4 wa = *(const LAS i32x4*)(wbuf + par * 256 + 32 * g), wb = *(const LAS i32x4*)(wbuf + par * 256 + 32 * g + 16);
#pragma unroll
              for (int q = 0; q < 4; ++q) { A[q] = (li == 0) ? wa[q] : 0; A[4 + q] = (li == 0) ? wb[q] : 0; } }
            int Bm[8][8];
#pragma unroll
            for (int t = 0; t < 4; ++t) {
                asm volatile("s_waitcnt vmcnt(17)" ::: "memory");
                const LAS unsigned char* sb = ring + (4 * g + t) * 1024;
#pragma unroll
                for (int n = 0; n < 8; ++n) { const i32x2 r2_ = __builtin_amdgcn_ds_read_tr8_b64_v2i32((LAS i32x2*)(sb + troff[n])); Bm[n][2 * t] = r2_[0]; Bm[n][2 * t + 1] = r2_[1]; }
                asm volatile("s_waitcnt lgkmcnt(0)" ::: "memory");
#pragma unroll
                for (int k = 4 * t; k < 4 * t + 4; ++k) { const int s_ = E2_SLOT(k); E2_DMA_ROW(s_, sn[s_ >> 2][s_ & 3]); }
            }
#pragma unroll
            for (int n = 0; n < 8; ++n) { const f32x4 z = {0.f, 0.f, 0.f, 0.f};
                const i32x8 Bv = {Bm[n][0], Bm[n][1], Bm[n][2], Bm[n][3], Bm[n][4], Bm[n][5], Bm[n][6], Bm[n][7]};
                f32x4 d = __builtin_amdgcn_mfma_scale_f32_16x16x128_f8f6f4(A, Bv, z, 0, 0, 0, 0x7f7f7f7f, 0, 0x7f7f7f7f);
                asm volatile("" : "+v"(d));
                const float d0_ = d[0] + 0.0f;
                if (g == 0) obuf[16 * n + li] = d0_; }
            asm volatile("s_waitcnt lgkmcnt(0)" ::: "memory");
            const f32x2 ov = *(const LAS f32x2*)(obuf + 2 * lane);
            asm volatile("s_waitcnt vmcnt(16)" ::: "memory");
            { const unsigned xw = *(const LAS unsigned*)(xbuf + 256 * par + 4 * lane); *(unsigned*)(XO + xo) = pk2(bflo(xw) + gv[0] * ov[0], bfhi(xw) + gv[1] * ov[1]); }
        }
        asm volatile("s_waitcnt vmcnt(0)" ::: "memory");
    }
#undef E2_CL
#undef E2_DMA_SEL
#undef E2_DMA_WF
#undef E2_DMA_ROW
#undef E2_SLOT
}

__device__ __forceinline__ void phase_final(const KP& p, int G) {
    const int tid = opaque_tid(), lane = tid & 63, w = __builtin_amdgcn_readfirstlane(tid >> 6);
    const int gw = blockIdx.x * 8 + w, ngw = G * 8;
    const float* fg = p.in[I_FG];
    for (int r0 = gw * 4; r0 < M; r0 += ngw * 4) {
        f32x4 v[4][4]; float ss[4];
#pragma unroll
        for (int i = 0; i < 4; ++i) { const u32x2* xr = (const u32x2*)((const bf16_t*)(p.ws + WS_YS) + (size_t)(r0 + i) * D) + lane;
#pragma unroll
            for (int j = 0; j < 4; ++j) { const u32x2 xw = xr[64 * j]; v[i][j] = (f32x4){bflo(xw[0]), bfhi(xw[0]), bflo(xw[1]), bfhi(xw[1])}; } }
#pragma unroll
        for (int i = 0; i < 4; ++i) { float t = 0.f;
#pragma unroll
            for (int j = 0; j < 4; ++j) t += (v[i][j][0] * v[i][j][0] + v[i][j][1] * v[i][j][1]) + (v[i][j][2] * v[i][j][2] + v[i][j][3] * v[i][j][3]);
            ss[i] = t; }
#pragma unroll
        for (int o = 1; o < 64; o <<= 1) {
#pragma unroll
            for (int i = 0; i < 4; ++i) ss[i] += __shfl_xor(ss[i], o); }
#pragma unroll
        for (int j = 0; j < 4; ++j) { const f32x4 g4 = *(const f32x4*)(fg + 256 * j + 4 * lane);
#pragma unroll
            for (int i = 0; i < 4; ++i) { const float rstd = __builtin_amdgcn_rsqf(ss[i] * (1.0f / D) + EPS); ((f32x4*)(p.out + (size_t)(r0 + i) * D) + lane)[64 * j] = v[i][j] * rstd * g4; } }
    }
}

__global__ void __launch_bounds__(512, 2) mk_fwd(KP p_) {
    extern __shared__ __attribute__((aligned(16))) unsigned char lds_raw[];
    LAS unsigned char* lds = (LAS unsigned char*)lds_raw;
    const int tid = threadIdx.x, G = gridDim.x;
    volatile LAS unsigned* MISC = (volatile LAS unsigned*)(lds + MISC_OFF);
    for (int i = tid; i < LDS_BYTES / 4; i += 512) ((LAS unsigned*)lds)[i] = 0u;
    __syncthreads();
    XcdBarrier bar = xcd_barrier_post((unsigned*)(p_.ws + WS_CTL) + 4096, MISC + 8);
    if (tid == 0) { const unsigned myx = xb_xcc_id(); MISC[16] = myx; MISC[17] = xb_add((unsigned*)(p_.ws + WS_CTL) + 8192 + 64 * (myx & 15u), 1u); }
    __syncthreads();
    const int lo = p_.gp_lo, hi = p_.gp_hi;
#ifndef PH_MASK
#define PH_MASK 0xFFFFF
#endif
#define IN(k) (lo <= (k) && (k) < hi)
#define EN(b) ((PH_MASK >> (b)) & 1)
#ifndef PH_REPEAT
#define PH_REPEAT 0
#endif
#define NREP(b) (((PH_REPEAT >> (b)) & 1) ? 2 : 1)
#define SEAM(k) do { if ((k) + 1 < hi) xcd_barrier(bar); } while (0)
    if (EN(12) && IN(GP_SETUP)) { const KP p = load_kp(); phase_setup(p, lds, G); SEAM(GP_SETUP); }
    for (int l = 0; l < DEPTH; ++l) {
        const int g0 = 1 + l * NPH;
        if (EN(0) && IN(g0 + 0)) { _Pragma("nounroll") for (int rep = 0; rep < NREP(0); ++rep) { const KP p = load_kp(); phase_conv_norm1(p, lds, l, G); } SEAM(g0 + 0); }
        if (EN(1) && IN(g0 + 1)) { const KP p = load_kp();
            pg8::Gemm g{(const bf16_t*)(p.ws + WS_H), (const bf16_t*)(p.ws + WS_WIN), M, 3072, D / 2, D / 2, D / 2}; pg8::StaticOrder S; S.init(M, 3072, G, (int)blockIdx.x);
            pg8::EpiStoreBf16 E{(bf16_t*)(p.ws + WS_R0), 3072, 1.0f / (WIN_SCALE * HIN_SCALE)};
            _Pragma("nounroll") for (int rep = 0; rep < NREP(1); ++rep) pg8::gemm_phase<pg8::EpiStoreBf16, pg8::StaticOrder, false, true, true>(lds, g, S, E);
            SEAM(g0 + 1);
        }
        if (EN(2) && IN(g0 + 2)) { _Pragma("nounroll") for (int rep = 0; rep < NREP(2); ++rep) { const KP p = load_kp(); phase_hgrn2(p, lds, l, G); } SEAM(g0 + 2); }
        if (EN(3) && IN(g0 + 3)) { const KP p = load_kp();
            pg8::Gemm g{(const bf16_t*)(p.ws + WS_H), (const bf16_t*)(p.ws + WS_WIN) + (size_t)3072 * (D / 2), M, 4096, D / 2, D / 2, D / 2}; pg8::StaticOrder S; S.init(M, 4096, G, (int)blockIdx.x);
            pg8::EpiStoreBf16 E{(bf16_t*)(p.ws + WS_R0), 4096, 1.0f / (WIN_SCALE * HIN_SCALE)};
            _Pragma("nounroll") for (int rep = 0; rep < NREP(3); ++rep) pg8::gemm_phase<pg8::EpiStoreBf16, pg8::StaticOrder, false, true, true>(lds, g, S, E);
            SEAM(g0 + 3);
        }
        #if DBG_SELFCHECK
        if (EN(4) && IN(g0 + 4)) {
#pragma nounroll
            for (int rep = 0; rep < 2; ++rep) { const KP p = load_kp(); size_t yo = rep ? WS_H : WS_YS; asm volatile("" : "+s"(yo)); phase_s5(p, lds, l, G, yo); SEAM(g0 + 4); }
            const KP p = load_kp();
            const unsigned* a = (const unsigned*)(p.ws + WS_YS); const unsigned* b2 = (const unsigned*)(p.ws + WS_H); unsigned bad = 0;
            for (size_t i = (size_t)blockIdx.x * 512 + opaque_tid(); i < (size_t)M * D / 2; i += (size_t)G * 512) bad += (a[i] != b2[i]) ? 1u : 0u;
            if (bad) atomicAdd((unsigned*)(p.ws + WS_CTL) + 64, bad);
            { const unsigned* h1 = (const unsigned*)(p.ws + WS_CTL) + 65536; const unsigned* h2 = h1 + 8192; const int u2 = blockIdx.x * 512 + opaque_tid();
              if (u2 < 2048) { if (h1[u2 * 4] != h2[u2 * 4]) atomicAdd((unsigned*)(p.ws + WS_CTL) + 128, 1u); if (h1[u2 * 4 + 1] != h2[u2 * 4 + 1]) atomicAdd((unsigned*)(p.ws + WS_CTL) + 192, 1u); if (h1[u2 * 4 + 2] != h2[u2 * 4 + 2]) atomicAdd((unsigned*)(p.ws + WS_CTL) + 256, 1u); } }
            SEAM(g0 + 4); }
#else
        if (EN(4) && IN(g0 + 4)) { _Pragma("nounroll") for (int rep = 0; rep < NREP(4); ++rep) { const KP p = load_kp(); phase_s5(p, lds, l, G, WS_YS); } SEAM(g0 + 4); }
#endif
        if (EN(5) && IN(g0 + 5)) { const KP p = load_kp();
            pg8::Gemm g{(const bf16_t*)(p.ws + WS_YS), (const bf16_t*)(p.ws + WS_WGLU), M, D, D, D, D}; pg8::StaticOrder S; S.init(M, D, G, (int)blockIdx.x);
            pg8::EpiGlu E{(const bf16_t*)(p.ws + WS_R0), (const bf16_t*)(p.ws + WS_YS), (const bf16_t*)(p.ws + WS_OR), (const float*)(p.ws + WS_SSQ), p.in[I_HNG] + l * 128, p.in[I_GLUB] + l * D, (bf16_t*)(p.ws + WS_H)};
            _Pragma("nounroll") for (int rep = 0; rep < NREP(5); ++rep) pg8::gemm_phase<pg8::EpiGlu, pg8::StaticOrder, true, true>(lds, g, S, E);
            SEAM(g0 + 5);
        }
        if (EN(6) && IN(g0 + 6)) { const KP p = load_kp();
            pg8::Gemm g{(const bf16_t*)(p.ws + WS_H), (const bf16_t*)(p.ws + WS_WOUT), M, D, D / 2, D / 2, D / 2}; pg8::StaticOrder S; S.init(M, D, G, (int)blockIdx.x);
            pg8::EpiStoreBf16 E{(bf16_t*)(p.ws + WS_OR), D, 1.0f / (WO_SCALE * MG_SCALE)};
            pg8::gemm_phase<pg8::EpiStoreBf16, pg8::StaticOrder, false, true, true>(lds, g, S, E);
            SEAM(g0 + 6);
        }
        if (EN(7) && IN(g0 + 7)) { const KP p = load_kp();
            const int t2 = opaque_tid(), lane = t2 & 63, wave = __builtin_amdgcn_readfirstlane(t2 >> 6);
            if (l == 0) resid_norm_rows<false>(p.in[I_X], (bf16_t*)p.out, (const bf16_t*)(p.ws + WS_OR), (bf16_t*)(p.ws + WS_H), p.ws + WS_XF8, p.in[I_N2G] + l * D, (const float*)(p.ws + WS_MOD) + (size_t)l * 32 * NMODC, blockIdx.x * 8 + wave, G * 8, lane);
            else resid_norm_rows<true>(p.out, (bf16_t*)p.out, (const bf16_t*)(p.ws + WS_OR), (bf16_t*)(p.ws + WS_H), p.ws + WS_XF8, p.in[I_N2G] + l * D, (const float*)(p.ws + WS_MOD) + (size_t)l * 32 * NMODC, blockIdx.x * 8 + wave, G * 8, lane);
            SEAM(g0 + 7);
        }
        if (EN(8) && IN(g0 + 8)) { const KP p = load_kp();
            pg8::Gemm g{(const bf16_t*)(p.ws + WS_H), (const bf16_t*)(p.ws + WS_WQ), M, 2048, D, D, D}; pg8::StaticOrder S; S.init(M, 2048, G, (int)blockIdx.x);
            pg8::EpiStoreQ E{(bf16_t*)(p.ws + WS_R0)};
            _Pragma("nounroll") for (int rep = 0; rep < NREP(8); ++rep) pg8::gemm_phase<pg8::EpiStoreQ, pg8::StaticOrder, true, true>(lds, g, S, E);
            SEAM(g0 + 8);
        }
        if (EN(9) && IN(g0 + 9)) { _Pragma("nounroll") for (int rep = 0; rep < NREP(9); ++rep) { const KP p = load_kp(); phase_topk(p, lds, G); } SEAM(g0 + 9); }
        if (EN(10) && IN(g0 + 10)) {
            { const KP p = load_kp(); phase_expert_u(p, lds, MISC, l, G); } xcd_barrier(bar);
            { const KP p = load_kp(); phase_expert_w(p, G); } xcd_barrier(bar);
            { const KP p = load_kp(); phase_expert_v(p, lds, MISC, l, G); }
            SEAM(g0 + 10); }
    }
    if (EN(13) && IN(GP_FINAL)) { const KP p = load_kp(); phase_final(p, G); }
#undef IN
#undef EN
#undef NREP
#undef SEAM
}

extern "C" void kernel_launch(void* const* d_in, const int* in_sizes, int n_in, void* d_out, int out_size, void* d_ws, size_t ws_size, hipStream_t stream) {
    static int grid = 0;
    if (grid == 0) {
        if (n_in != 25 || out_size != M * D || ws_size < WS_END) { fprintf(stderr, "kernel_launch: unexpected shapes (n_in %d, out %d, ws %zu < %zu)\n", n_in, out_size, ws_size, (size_t)WS_END); grid = -1; return; }
        int dev = 0, cus = 0, per_cu = 0;
        if (hipGetDevice(&dev) != hipSuccess || hipDeviceGetAttribute(&cus, hipDeviceAttributeMultiprocessorCount, dev) != hipSuccess) { grid = -1; return; }
        if (hipFuncSetAttribute((const void*)mk_fwd, hipFuncAttributeMaxDynamicSharedMemorySize, LDS_BYTES) != hipSuccess) { fprintf(stderr, "kernel_launch: hipFuncSetAttribute failed\n"); grid = -1; return; }
        if (hipOccupancyMaxActiveBlocksPerMultiprocessor(&per_cu, (const void*)mk_fwd, 512, LDS_BYTES) != hipSuccess || per_cu < 1) fprintf(stderr, "kernel_launch: occupancy query says %d\n", per_cu);
        (void)hipGetLastError();
        grid = cus;
    }
    if (grid < 0) return;
    (void)hipMemsetAsync((char*)d_ws + WS_CTL, 0, CTL_ZERO_BYTES, stream);
    KP a{};
    for (int i = 0; i < 25; ++i) a.in[i] = (const float*)d_in[i];
    a.out = (float*)d_out; a.ws = (unsigned char*)d_ws;
#if MK_LAUNCHES == 1
    a.gp_lo = 0; a.gp_hi = GP_END;
    hipLaunchKernelGGL(mk_fwd, dim3(grid), dim3(512), LDS_BYTES, stream, a);
#else
    for (int gp = 0; gp < GP_END; ++gp) { a.gp_lo = gp; a.gp_hi = gp + 1; hipLaunchKernelGGL(mk_fwd, dim3(grid), dim3(512), LDS_BYTES, stream, a); }
#endif
}
```

```cpp
#include <hip/hip_runtime.h>
#include <cstdio>
#include <cstdint>

#define DBG_HASHSEL 0
#define DBG_H2_FROM_INPUT 0
#define DBG_NO_YA 0
#define DBG_NO_YB 0
#define DBG_NO_ACC 0
#define DBG_NO_GB 0
#define DBG_S5_NOSSM 0
#define DBG_S5_NOREC 0
#define DBG_SELFCHECK 0
#ifndef MK_LAUNCHES
#define MK_LAUNCHES 1
#endif

#define LAS __attribute__((address_space(3)))
typedef unsigned short bf16_t;
typedef short bf16x8 __attribute__((ext_vector_type(8)));
typedef float f32x2 __attribute__((ext_vector_type(2)));
typedef float f32x4 __attribute__((ext_vector_type(4)));
typedef float f32x16 __attribute__((ext_vector_type(16)));
typedef unsigned u32x2 __attribute__((ext_vector_type(2)));
typedef unsigned u32x4 __attribute__((ext_vector_type(4)));
typedef __bf16 bf16v2 __attribute__((ext_vector_type(2)));
typedef int i32x8 __attribute__((ext_vector_type(8)));
typedef int i32x4 __attribute__((ext_vector_type(4)));
typedef int i32x2 __attribute__((ext_vector_type(2)));

constexpr int D = 1024, BATCH = 32, SEQ = 2048, DEPTH = 4, M = BATCH * SEQ;
constexpr int INC = 7168, NMODC = 6 * D;
constexpr int NPH = 11, GP_SETUP = 0, GP_FINAL = 1 + DEPTH * NPH, GP_END = GP_FINAL + 1;
constexpr float EPS = 1e-6f;
constexpr float U_SCALE = 64.0f, V_SCALE = 4.0f;
constexpr size_t TAB_BYTES = (size_t)16384 * 1024;
constexpr float WIN_SCALE = 64.0f, HIN_SCALE = 4.0f;
constexpr float X_SCALE = 8.0f;
constexpr float W8_SCALE = 512.0f;
constexpr float WO_SCALE = 64.0f, MG_SCALE = 8.0f;

constexpr size_t MiB = 1u << 20;
constexpr size_t WS_CTL = 0, CTL_ZERO_BYTES = 1 * MiB;
constexpr size_t WS_MOD = 1 * MiB;
constexpr size_t WS_LB = 4 * MiB;
constexpr size_t WS_ABAR = 4 * MiB + 65536;
constexpr size_t WS_BOP = 5 * MiB;
constexpr size_t WS_COP = 6 * MiB;
constexpr size_t WS_WIN = 8 * MiB;
constexpr size_t WS_WGLU = 22 * MiB;
constexpr size_t WS_WOUT = 24 * MiB;
constexpr size_t WS_WQ = 26 * MiB;
constexpr size_t WS_KEYS = 30 * MiB;
constexpr size_t WS_U = 32 * MiB;
constexpr size_t WS_V = 64 * MiB;
constexpr size_t WS_H = 96 * MiB;
constexpr size_t WS_OR = 224 * MiB;
constexpr size_t WS_SSQ = 352 * MiB;
constexpr size_t WS_R0 = 354 * MiB;
constexpr size_t WS_SEL = WS_R0 + 256 * MiB;
constexpr size_t WS_XF8 = WS_R0 + 352 * MiB;
constexpr size_t WS_WF8 = WS_R0 + 416 * MiB;
constexpr size_t WS_YS = WS_R0 + 512 * MiB;
constexpr size_t WS_END = WS_YS + 128 * MiB;

constexpr int LDS_BYTES = 163840;
constexpr int MISC_OFF = LDS_BYTES - 256;

__device__ __forceinline__ unsigned pk2(float lo, float hi) { f32x2 v = {lo, hi}; bf16v2 r = __builtin_convertvector(v, bf16v2); return __builtin_bit_cast(unsigned, r); }
__device__ __forceinline__ float bflo(unsigned w) { return __uint_as_float(w << 16); }
__device__ __forceinline__ float bfhi(unsigned w) { return __uint_as_float(w & 0xffff0000u); }
__device__ __forceinline__ float fsigmoid(float x) { return __builtin_amdgcn_rcpf(1.0f + __expf(-x)); }
__device__ __forceinline__ float fsilu(float x) { return x * fsigmoid(x); }
__device__ __forceinline__ float fgelu(float x) { return x * fsigmoid(1.5957691216f * (x + 0.044715f * x * x * x)); }
__device__ __forceinline__ float wave_sum(float v) {
#pragma unroll
    for (int o = 1; o < 64; o <<= 1) v += __shfl_xor(v, o);
    return v;
}
#define LDS_WAIT() asm volatile("s_waitcnt lgkmcnt(0)" ::: "memory")
__device__ __forceinline__ float dpp_sum8(float d);
__device__ __forceinline__ int opaque_tid() { int t = threadIdx.x; asm volatile("" : "+v"(t)); return t; }

namespace pg8 {
#define PG8_LAS __attribute__((address_space(3)))
constexpr int BM = 256, BK = 64, HALF = 128, HTB = HALF * BK * 2, STAGE_BYTES = 8 * HTB, NXCD = 8, WGM = 8;
__host__ __device__ __forceinline__ int lds_byte(int r, int c) { const int st = (r >> 4) * 2 + (c >> 5), rr = r & 15, cc = c & 31, ob = rr * 64 + cc * 2; return st * 1024 + (ob ^ (((ob >> 9) & 1) << 5)); }
__host__ __device__ __forceinline__ void stage_rc(int b, int& R, int& C) { const int st = b / 1024, sb = b % 1024, swz = sb ^ (((sb >> 9) & 1) << 5); R = (st >> 1) * 16 + swz / 64; C = (st & 1) * 32 + (swz % 64) / 2; }
__host__ __device__ __forceinline__ int perm32(int rho) { const int n = rho >> 4, i = rho & 15; return 8 * (i >> 2) + 4 * n + (i & 3); }
struct Unit { int pm, pn; };
struct Gemm { const bf16_t* A; const bf16_t* Bt; int M, N, K, lda, ldb; };
struct StaticOrder {
    int nM, nN, nwg, G, c;
    __host__ __device__ void init(int M_, int N_, int G_, int c_) { nM = M_ / BM; nN = N_ / BM; nwg = nM * nN; G = G_; c = c_; }
    __host__ __device__ bool next(int i, Unit& u) const {
        const long L = (long)i * G + c; if (L >= nwg) return false;
        int wgid = (int)L; { const int q = nwg / NXCD, r = nwg % NXCD, xcd = wgid % NXCD, off = wgid / NXCD; wgid = (xcd < r ? xcd * (q + 1) : r * (q + 1) + (xcd - r) * q) + off; }
        const int nig = WGM * nN, gid = wgid / nig, fm = gid * WGM, gsz = (nM - fm) < WGM ? (nM - fm) : WGM;
        u.pm = fm + ((wgid % nig) % gsz); u.pn = (wgid % nig) / gsz; return true;
    }
    __device__ __forceinline__ void a_ready(const Unit&) const {}
    __device__ __forceinline__ void done(const Unit&) const {}
};
template <class Epi, class Sched, bool ALIGN_EPI = false, bool SP2 = false, bool F8 = false>
__device__ __forceinline__ void gemm_phase(PG8_LAS unsigned char* lds, const Gemm g, const Sched& S, const Epi& E) {
    const int tid = opaque_tid(), wid = __builtin_amdgcn_readfirstlane(tid >> 6), lane = tid & 63, wr = wid >> 2, wc = wid & 3, fr = lane & 15, fq = lane >> 4;
    const int K = g.K, nt = K / BK;
    unsigned voffA[2], voffB[2];
#pragma unroll
    for (int i = 0; i < 2; ++i) { int R, C; stage_rc(tid * 16 + i * 8192, R, C); const int Rb = Epi::PERM ? ((R & ~31) + perm32(R & 31)) : R;
        voffA[i] = (unsigned)(R * g.lda + C) * 2u; voffB[i] = (unsigned)(Rb * g.ldb + C) * 2u; }
    const size_t kstep = (size_t)(BK * 2);
    const size_t hstepA = (size_t)HALF * g.lda * 2, hstepB = (size_t)HALF * g.ldb * 2;
    const size_t tstepA = 2 * hstepA, tstepB = 2 * hstepB;
    const unsigned ldsw = (unsigned)wid * 1024u;
    const int aoff = lds_byte(wr * 64 + fr, fq * 8), boff = lds_byte(wc * 32 + fr, fq * 8);
#define PG8_SA(b, h) (((b) * 2 + (h)) * HTB)
#define PG8_SB(b, h) ((4 + (b) * 2 + (h)) * HTB)
#define PG8_STAGE(bufoff, gbase, voff) do { _Pragma("unroll") for (int _i = 0; _i < 2; ++_i) \
        __builtin_amdgcn_global_load_lds((const unsigned*)((const char*)(gbase) + (voff)[_i]), (PG8_LAS unsigned*)(lds + (bufoff) + ldsw + _i * 8192), 16, 0, 0); } while (0)
#define PG8_LD8(p) __builtin_shufflevector(*(const PG8_LAS i32x4*)(p), *(const PG8_LAS i32x4*)((p) + 1024), 0, 1, 2, 3, 4, 5, 6, 7)
#define PG8_LDA(dst, b, h) do { if constexpr (F8) { _Pragma("unroll") for (int m = 0; m < 4; ++m) dst##8[m] = PG8_LD8(lds + PG8_SA(b, h) + aoff + m * 2048); } \
        else { _Pragma("unroll") for (int m = 0; m < 4; ++m) _Pragma("unroll") for (int k = 0; k < 2; ++k) dst[m][k] = *(const PG8_LAS bf16x8*)(lds + PG8_SA(b, h) + aoff + m * 2048 + k * 1024); } } while (0)
#define PG8_LDB(dst, b, h) do { if constexpr (F8) { _Pragma("unroll") for (int n = 0; n < 2; ++n) dst##8[n] = PG8_LD8(lds + PG8_SB(b, h) + boff + n * 2048); } \
        else { _Pragma("unroll") for (int n = 0; n < 2; ++n) _Pragma("unroll") for (int k = 0; k < 2; ++k) dst[n][k] = *(const PG8_LAS bf16x8*)(lds + PG8_SB(b, h) + boff + n * 2048 + k * 1024); } } while (0)
#define PG8_MMA(ai, bj, At, Bt) do { __builtin_amdgcn_s_setprio(1); _Pragma("unroll") for (int m = 0; m < 4; ++m) _Pragma("unroll") for (int n = 0; n < 2; ++n) { \
        if constexpr (F8) {   \
            acc[ai][bj][m][n] = __builtin_amdgcn_mfma_scale_f32_16x16x128_f8f6f4(Bt##8[n], At##8[m], acc[ai][bj][m][n], 0, 0, 0, 0x7f7f7f7f, 0, 0x7f7f7f7f); \
        } else { _Pragma("unroll") for (int k = 0; k < 2; ++k) acc[ai][bj][m][n] = __builtin_amdgcn_mfma_f32_16x16x32_bf16(Bt[n][k], At[m][k], acc[ai][bj][m][n], 0, 0, 0); } } \
        __builtin_amdgcn_s_setprio(0); } while (0)
#define PG8_WAIT_V(n) asm volatile("s_waitcnt vmcnt(" #n ")" ::: "memory")
#define PG8_WAIT_L(n) asm volatile("s_waitcnt lgkmcnt(" #n ")" ::: "memory")
#define PG8_BAR __builtin_amdgcn_s_barrier()
#define PG8_SCHED __builtin_amdgcn_sched_barrier(0)
    Unit cur, nxt; int ui = 0;
    if (!S.next(0, cur)) return;
    f32x4 acc[2][2][4][2];
#pragma unroll
    for (int a = 0; a < 2; ++a)
#pragma unroll
        for (int b = 0; b < 2; ++b)
#pragma unroll
            for (int m = 0; m < 4; ++m)
#pragma unroll
                for (int n = 0; n < 2; ++n) acc[a][b][m][n] = (f32x4){0.f, 0.f, 0.f, 0.f};
    bf16x8 At[4][2], B0[2][2], B1[2][2]; i32x8 At8[4], B08[2], B18[2];
    const char* cA = (const char*)g.A + (size_t)cur.pm * tstepA; const char* cB = (const char*)g.Bt + (size_t)cur.pn * tstepB;
    S.a_ready(cur);
    if constexpr (SP2) {
        PG8_STAGE(PG8_SB(0, 0), cB, voffB); PG8_STAGE(PG8_SB(0, 1), cB + hstepB, voffB); PG8_STAGE(PG8_SA(0, 0), cA, voffA); PG8_STAGE(PG8_SA(0, 1), cA + hstepA, voffA);
        if (wr == 1) PG8_BAR;
        PG8_WAIT_V(2); PG8_BAR;
        PG8_STAGE(PG8_SB(1, 0), cB + kstep, voffB); PG8_STAGE(PG8_SA(1, 0), cA + kstep, voffA); PG8_STAGE(PG8_SB(1, 1), cB + hstepB + kstep, voffB);
        PG8_WAIT_V(6); PG8_BAR;
    } else {
        PG8_STAGE(PG8_SB(0, 0), cB, voffB); PG8_STAGE(PG8_SA(0, 0), cA, voffA); PG8_STAGE(PG8_SB(0, 1), cB + hstepB, voffB); PG8_STAGE(PG8_SA(0, 1), cA + hstepA, voffA);
        if (wr == 1) PG8_BAR;
        PG8_WAIT_V(4); PG8_BAR;
        PG8_STAGE(PG8_SB(1, 0), cB + kstep, voffB); PG8_STAGE(PG8_SA(1, 0), cA + kstep, voffA); PG8_STAGE(PG8_SB(1, 1), cB + hstepB + kstep, voffB);
        PG8_WAIT_V(6); PG8_BAR;
    }
    for (;;) {
        const bool has_next = S.next(ui + 1, nxt);
        const char* nA = has_next ? (const char*)g.A + (size_t)nxt.pm * tstepA : cA; const char* nB = has_next ? (const char*)g.Bt + (size_t)nxt.pn * tstepB : cB;
        for (int t = 0; t < nt; t += 2) {
            const bool last = (t == nt - 2);
            const char* a1 = cA + (size_t)(t + 1) * kstep;
            const char* a2 = last ? nA : cA + (size_t)(t + 2) * kstep; const char* b2 = last ? nB : cB + (size_t)(t + 2) * kstep;
            const char* a3 = a2 + kstep; const char* b3 = b2 + kstep;
            if (last && has_next) S.a_ready(nxt);
            if constexpr (SP2) {
            PG8_LDB(B0, 0, 0); PG8_LDB(B1, 0, 1); PG8_SCHED; PG8_LDA(At, 0, 0); PG8_STAGE(PG8_SA(1, 1), a1 + hstepA, voffA);
            PG8_WAIT_V(8); PG8_WAIT_L(0); PG8_BAR; PG8_MMA(0, 0, At, B0); PG8_MMA(0, 1, At, B1); PG8_BAR; PG8_SCHED;
            PG8_LDA(At, 0, 1); PG8_STAGE(PG8_SB(0, 0), b2, voffB); PG8_STAGE(PG8_SB(0, 1), b2 + hstepB, voffB); PG8_STAGE(PG8_SA(0, 0), a2, voffA);
            PG8_WAIT_V(8); PG8_WAIT_L(0); PG8_BAR; PG8_MMA(1, 0, At, B0); PG8_MMA(1, 1, At, B1); PG8_BAR; PG8_SCHED;
            PG8_LDB(B0, 1, 0); PG8_LDB(B1, 1, 1); PG8_SCHED; PG8_LDA(At, 1, 0); PG8_STAGE(PG8_SA(0, 1), a2 + hstepA, voffA);
            PG8_WAIT_V(8); PG8_WAIT_L(0); PG8_BAR; PG8_MMA(0, 0, At, B0); PG8_MMA(0, 1, At, B1); PG8_BAR; PG8_SCHED;
            PG8_LDA(At, 1, 1); PG8_STAGE(PG8_SB(1, 0), b3, voffB); PG8_STAGE(PG8_SB(1, 1), b3 + hstepB, voffB); PG8_STAGE(PG8_SA(1, 0), a3, voffA);
            PG8_WAIT_V(8); PG8_WAIT_L(0); PG8_BAR; PG8_MMA(1, 0, At, B0); PG8_MMA(1, 1, At, B1); PG8_BAR; PG8_SCHED;
            } else {
            PG8_LDB(B0, 0, 0); PG8_SCHED; PG8_LDA(At, 0, 0); PG8_STAGE(PG8_SA(1, 1), a1 + hstepA, voffA);
            PG8_WAIT_L(8); PG8_BAR; PG8_WAIT_L(0); PG8_MMA(0, 0, At, B0); PG8_BAR; PG8_SCHED;
            PG8_LDB(B1, 0, 1); PG8_STAGE(PG8_SB(0, 0), b2, voffB);
            PG8_BAR; PG8_WAIT_L(0); PG8_MMA(0, 1, At, B1); PG8_BAR;
            PG8_LDA(At, 0, 1); PG8_STAGE(PG8_SA(0, 0), a2, voffA);
            PG8_BAR; PG8_WAIT_L(0); PG8_MMA(1, 0, At, B0); PG8_BAR; PG8_SCHED;
            PG8_STAGE(PG8_SB(0, 1), b2 + hstepB, voffB);
            PG8_WAIT_V(6); PG8_BAR; PG8_MMA(1, 1, At, B1); PG8_BAR;
            PG8_LDB(B0, 1, 0); PG8_SCHED; PG8_LDA(At, 1, 0); PG8_STAGE(PG8_SA(0, 1), a2 + hstepA, voffA);
            PG8_WAIT_L(8); PG8_BAR; PG8_WAIT_L(0); PG8_MMA(0, 0, At, B0); PG8_BAR; PG8_SCHED;
            PG8_LDB(B1, 1, 1); PG8_STAGE(PG8_SB(1, 0), b3, voffB);
            PG8_BAR; PG8_WAIT_L(0); PG8_MMA(0, 1, At, B1); PG8_BAR;
            PG8_LDA(At, 1, 1); PG8_STAGE(PG8_SA(1, 0), a3, voffA);
            PG8_BAR; PG8_WAIT_L(0); PG8_MMA(1, 0, At, B0); PG8_BAR; PG8_SCHED;
            PG8_STAGE(PG8_SB(1, 1), b3 + hstepB, voffB);
            PG8_WAIT_V(6); PG8_BAR; PG8_MMA(1, 1, At, B1); PG8_BAR;
            }
        }
        if constexpr (ALIGN_EPI) { if (wr == 0) PG8_BAR; }
        E(acc, cur, wr, wc, fr, fq);
        if (!has_next) break;
#pragma unroll
        for (int a = 0; a < 2; ++a)
#pragma unroll
            for (int b = 0; b < 2; ++b)
#pragma unroll
                for (int m = 0; m < 4; ++m)
#pragma unroll
                    for (int n = 0; n < 2; ++n) acc[a][b][m][n] = (f32x4){0.f, 0.f, 0.f, 0.f};
        cur = nxt; cA = nA; cB = nB; ++ui;
        if constexpr (ALIGN_EPI) { if (wr == 1) PG8_BAR; }
    }
    PG8_WAIT_V(0);
    if constexpr (!ALIGN_EPI) { if (wr == 0) PG8_BAR; }
    PG8_BAR;
#undef PG8_SA
#undef PG8_SB
#undef PG8_STAGE
#undef PG8_LDA
#undef PG8_LD8
#undef PG8_LDB
#undef PG8_MMA
#undef PG8_WAIT_V
#undef PG8_WAIT_L
#undef PG8_BAR
#undef PG8_SCHED
}

struct EpiStoreBf16 {
    static constexpr bool PERM = true;
    bf16_t* O; int ldc; float scale;
    __device__ __forceinline__ void operator()(const f32x4 (&acc)[2][2][4][2], const Unit& u, int wr, int wc, int fr, int fq) const {
        const int row0 = u.pm * BM + wr * 64 + fr, col0 = u.pn * BM + wc * 32 + 8 * fq;
#pragma unroll
        for (int ai = 0; ai < 2; ++ai)
#pragma unroll
            for (int m = 0; m < 4; ++m) { bf16_t* rowp = O + (size_t)(row0 + ai * HALF + m * 16) * ldc + col0;
#pragma unroll
                for (int bj = 0; bj < 2; ++bj) { const f32x4 v0 = acc[ai][bj][m][0] * scale, v1 = acc[ai][bj][m][1] * scale;
                    u32x4 w; w.x = pk2(v0[0], v0[1]); w.y = pk2(v0[2], v0[3]); w.z = pk2(v1[0], v1[1]); w.w = pk2(v1[2], v1[3]);
                    *(u32x4*)(rowp + bj * HALF) = w; } }
    }
};
struct EpiStoreQ {
    static constexpr bool PERM = true;
    bf16_t* O;
    __device__ __forceinline__ void operator()(const f32x4 (&acc)[2][2][4][2], const Unit& u, int wr, int wc, int fr, int fq) const {
        const int row0 = u.pm * BM + wr * 64 + fr, col0 = u.pn * BM + wc * 32 + 8 * fq;
#pragma unroll
        for (int ai = 0; ai < 2; ++ai)
#pragma unroll
            for (int m = 0; m < 4; ++m) { const int row = row0 + ai * HALF + m * 16, tg = row >> 5, t = row & 31;
#pragma unroll
                for (int bj = 0; bj < 2; ++bj) { const int c0 = col0 + bj * HALF, h = c0 >> 8, pp = (c0 >> 7) & 1, cc = c0 & 127, ks = cc >> 4, hh = (cc >> 3) & 1;
                    const f32x4 v0 = acc[ai][bj][m][0], v1 = acc[ai][bj][m][1];
                    u32x4 w; w.x = pk2(v0[0], v0[1]); w.y = pk2(v0[2], v0[3]); w.z = pk2(v1[0], v1[1]); w.w = pk2(v1[2], v1[3]);
                    *(u32x4*)(O + ((size_t)((((tg * 8 + h) * 2 + pp) * 8 + ks) * 64 + hh * 32 + t)) * 8) = w; } }
    }
};
struct EpiWout {
    static constexpr bool PERM = false;
    const float* xs; float* out; const float* g1;
    __device__ __forceinline__ void operator()(const f32x4 (&acc)[2][2][4][2], const Unit& u, int wr, int wc, int fr, int fq) const {
        const int row0 = u.pm * BM + wr * 64 + fr, col0 = u.pn * BM + wc * 32 + 4 * fq;
        const int b = (u.pm * BM) >> 11;
        f32x4 gv[2][2];
#pragma unroll
        for (int bj = 0; bj < 2; ++bj)
#pragma unroll
            for (int n = 0; n < 2; ++n) gv[bj][n] = *(const f32x4*)(g1 + (size_t)b * NMODC + col0 + bj * HALF + n * 16);
#pragma unroll
        for (int ai = 0; ai < 2; ++ai)
#pragma unroll
            for (int m = 0; m < 4; ++m) { const size_t off = (size_t)(row0 + ai * HALF + m * 16) * D + col0;
#pragma unroll
                for (int bj = 0; bj < 2; ++bj)
#pragma unroll
                    for (int n = 0; n < 2; ++n) { const f32x4 xv = *(const f32x4*)(xs + off + bj * HALF + n * 16);
                        *(f32x4*)(out + off + bj * HALF + n * 16) = xv + gv[bj][n] * acc[ai][bj][m][n]; } }
    }
};
struct EpiGlu {
    static constexpr bool PERM = true;
    const bf16_t* PB; const bf16_t* YS; const bf16_t* ORAW; const float* SSQ; const float* ng; const float* gb_; bf16_t* O;
    __device__ __forceinline__ void operator()(const f32x4 (&acc)[2][2][4][2], const Unit& u, int wr, int wc, int fr, int fq) const {
        const int row0 = u.pm * BM + wr * 64 + fr, col0 = u.pn * BM + wc * 32 + 8 * fq;
#pragma unroll
        for (int bj = 0; bj < 2; ++bj) {
            const int c = col0 + bj * HALF, head = c >> 7;
            const f32x4 n0 = *(const f32x4*)(ng + (c & 127)), n1 = *(const f32x4*)(ng + (c & 127) + 4);
            const f32x4 b0 = *(const f32x4*)(gb_ + c), b1 = *(const f32x4*)(gb_ + c + 4);
            const float ngv[8] = {n0[0], n0[1], n0[2], n0[3], n1[0], n1[1], n1[2], n1[3]};
            const float bbv[8] = {b0[0], b0[1], b0[2], b0[3], b1[0], b1[1], b1[2], b1[3]};
#pragma unroll
            for (int ai = 0; ai < 2; ++ai)
#pragma unroll
                for (int m = 0; m < 4; ++m) {
                    const int row = row0 + ai * HALF + m * 16;
                    const bf16_t* pb = PB + (size_t)row * 4096 + c;
                    const u32x4 og = *(const u32x4*)(pb), ys = *(const u32x4*)(YS + (size_t)row * D + c), ga = *(const u32x4*)(pb + 2048), gb = *(const u32x4*)(pb + 3072);
                    const u32x4 orw = *(const u32x4*)(ORAW + (size_t)row * D + c);
                    const float rstd = __builtin_amdgcn_rsqf(SSQ[(size_t)row * 8 + head] * (1.0f / 128.0f) + EPS);
                    const f32x4 a0 = acc[ai][bj][m][0], a1 = acc[ai][bj][m][1];
                    const float av[8] = {a0[0], a0[1], a0[2], a0[3], a1[0], a1[1], a1[2], a1[3]};
                    float res[8];
#pragma unroll
                    for (int j = 0; j < 8; ++j) {
                        const unsigned wog = og[j >> 1], wys = ys[j >> 1], wga = ga[j >> 1], wgb = gb[j >> 1], wor = orw[j >> 1];
                        const float fog = (j & 1) ? bfhi(wog) : bflo(wog), fys = (j & 1) ? bfhi(wys) : bflo(wys), fga = (j & 1) ? bfhi(wga) : bflo(wga),
                                    fgb = (j & 1) ? bfhi(wgb) : bflo(wgb), fo = (j & 1) ? bfhi(wor) : bflo(wor);
                        const float ya = fo * rstd * ngv[j] * fsilu(fog);
                        const float yb = fys * fsigmoid((DBG_NO_ACC ? 0.f : av[j]) + bbv[j]);
                        res[j] = (DBG_NO_YA ? 0.f : fsigmoid(fga) * ya) + (DBG_NO_YB ? 0.f : (DBG_NO_GB ? 0.5f : fsigmoid(fgb)) * yb);
                    }
                    int w0 = 0, w1 = 0;
                    w0 = __builtin_amdgcn_cvt_pk_fp8_f32(res[0] * MG_SCALE, res[1] * MG_SCALE, w0, false); w0 = __builtin_amdgcn_cvt_pk_fp8_f32(res[2] * MG_SCALE, res[3] * MG_SCALE, w0, true);
                    w1 = __builtin_amdgcn_cvt_pk_fp8_f32(res[4] * MG_SCALE, res[5] * MG_SCALE, w1, false); w1 = __builtin_amdgcn_cvt_pk_fp8_f32(res[6] * MG_SCALE, res[7] * MG_SCALE, w1, true);
                    *(u32x2*)((unsigned char*)O + (size_t)row * D + c) = (u32x2){(unsigned)w0, (unsigned)w1};
                }
        }
    }
};
}

#define XB_TMO      128
#define XB_XCNT(j)  (256  + 64 * (j))
#define XB_XSUB(j)  (1280 + 64 * (j))
#define XB_XGEN(j)  (2304 + 64 * (j))
#define XB_TOP      3328
#define XB_TOPGEN   3392
#define XCD_BAR_WORDS 3456
#define XB_SPIN_CAP (1u << 25)
__device__ __forceinline__ unsigned xb_ld(unsigned* p)              { return __hip_atomic_load(p, __ATOMIC_RELAXED, __HIP_MEMORY_SCOPE_AGENT); }
__device__ __forceinline__ unsigned xb_add(unsigned* p, unsigned v) { return __hip_atomic_fetch_add(p, v, __ATOMIC_RELAXED, __HIP_MEMORY_SCOPE_AGENT); }
__device__ __forceinline__ unsigned xb_xcc_id() { return (unsigned)__builtin_amdgcn_s_getreg((3 << 11) | 20) & 0xFu; }
#define XB_SPIN(cond, bar) do { unsigned _sp = 0; while (cond) { __builtin_amdgcn_s_sleep(1); \
    if ((++_sp & 255u) == 0u) { if (xb_ld(&(bar)[XB_TMO])) break; if (_sp > XB_SPIN_CAP) { atomicAdd(&(bar)[XB_TMO], 1u); break; } } } } while (0)
struct XcdBarrier { unsigned* bar; unsigned x; volatile LAS unsigned* st; };
__device__ __forceinline__ XcdBarrier xcd_barrier_post(unsigned* bar, volatile LAS unsigned* st) {
    XcdBarrier b; b.bar = bar; b.x = xb_xcc_id(); b.st = st;
    if (threadIdx.x == 0) (void)xb_add(&bar[XB_XCNT(b.x)], 1u);
    return b;
}
__device__ __forceinline__ void xcd_barrier_complete(unsigned* bar, unsigned x, unsigned& nloc, unsigned& nx) {
    const unsigned G = gridDim.x * gridDim.y * gridDim.z;
    unsigned sum, cnt, mine, sp = 0u;
    for (;;) {
        sum = 0u; cnt = 0u; mine = 0u;
#pragma unroll
        for (unsigned j = 0; j < 16; ++j) { const unsigned c = xb_ld(&bar[XB_XCNT(j)]); sum += c; cnt += (c > 0u) ? 1u : 0u; mine = (j == x) ? c : mine; }
        if (sum == G) break;
        __builtin_amdgcn_s_sleep(1);
        if ((++sp & 255u) == 0u) { if (xb_ld(&bar[XB_TMO])) break; if (sp > XB_SPIN_CAP) { atomicAdd(&bar[XB_TMO], 1u); break; } }
    }
    nloc = mine > 0u ? mine : 1u; nx = cnt > 0u ? cnt : 1u;
}
__device__ __forceinline__ void xcd_barrier(const XcdBarrier& b) {
    asm volatile("s_waitcnt vmcnt(0)" ::: "memory");
    __syncthreads();
    if (threadIdx.x == 0) {
        unsigned* bar = b.bar;
        __builtin_amdgcn_s_waitcnt(0);
        unsigned nloc = b.st[0], nx = b.st[1];
        if (nloc == 0u) { xcd_barrier_complete(bar, b.x, nloc, nx); b.st[0] = nloc; b.st[1] = nx; }
        const unsigned old = xb_add(&bar[XB_XSUB(b.x)], 1u);
        const unsigned gen = old / nloc;
        if (old + 1u == (gen + 1u) * nloc) {
            __builtin_amdgcn_fence(__ATOMIC_RELEASE, "agent");
            asm volatile("s_waitcnt vmcnt(0)" ::: "memory");
            const unsigned og = xb_add(&bar[XB_TOP], 1u);
            const unsigned tg = og / nx;
            if (og + 1u == (tg + 1u) * nx) xb_add(&bar[XB_TOPGEN], 1u);
            else XB_SPIN(xb_ld(&bar[XB_TOPGEN]) == tg, bar);
            __builtin_amdgcn_fence(__ATOMIC_ACQUIRE, "agent");
            xb_add(&bar[XB_XGEN(b.x)], 1u);
            asm volatile("s_waitcnt vmcnt(0)" ::: "memory");
        } else {
            XB_SPIN(xb_ld(&bar[XB_XGEN(b.x)]) == gen, bar);
            __builtin_amdgcn_fence(__ATOMIC_ACQUIRE, "agent");
            asm volatile("s_waitcnt vmcnt(0)" ::: "memory");
        }
    }
    __syncthreads();
}

struct KP { const float* in[25]; float* out; unsigned char* ws; int gp_lo, gp_hi; };
enum { I_X = 0, I_C, I_ADAW, I_ADAB, I_N1G, I_N2G, I_WIN, I_LBL, I_HNG, I_ARE, I_AIM, I_LDT, I_BRE, I_BIM, I_CRE, I_CIM, I_S5D, I_GLUW, I_GLUB, I_WOUT, I_WQ, I_SUBK, I_PU, I_PV, I_FG };

typedef const KP __attribute__((address_space(4)))* kp_cptr;
__device__ __forceinline__ KP load_kp() {
#if defined(__HIP_DEVICE_COMPILE__)
    unsigned long long a = (unsigned long long)__builtin_amdgcn_kernarg_segment_ptr(); asm volatile("" : "+s"(a)); return *(kp_cptr)a;
#else
    return KP{};
#endif
}

__device__ __forceinline__ void phase_setup(const KP& p, LAS unsigned char* lds, int G) {
    const int tid = opaque_tid();
    {
        LAS float* cact = (LAS float*)lds;
        for (int it = blockIdx.x; it < 4 * 48; it += G) {
#pragma unroll 1
            for (int i0 = 0; i0 < 64; i0 += 16) { float cv[16];
#pragma unroll
                for (int q = 0; q < 16; ++q) cv[q] = p.in[I_C][(i0 + q) * 512 + tid];
#pragma unroll
                for (int q = 0; q < 16; ++q) { const int i = (i0 + q) * 512 + tid; const int k_ = i & 1023, b_ = i >> 10; cact[k_ * 32 + ((((b_ >> 2) ^ (k_ & 7)) << 2) | (b_ & 3))] = fsilu(cv[q]); } }
            __syncthreads();
            const int l = it / 48, cb = it % 48, col = cb * 128 + (tid & 127), bg = tid >> 7;
            const float* W = p.in[I_ADAW] + (size_t)l * D * NMODC + col;
            f32x4 acc0 = {0.f, 0.f, 0.f, 0.f}, acc1 = {0.f, 0.f, 0.f, 0.f};
#pragma unroll 2
            for (int k4 = 0; k4 < 256; ++k4) {
                const float w0 = W[(size_t)(4 * k4 + 0) * NMODC], w1 = W[(size_t)(4 * k4 + 1) * NMODC], w2 = W[(size_t)(4 * k4 + 2) * NMODC], w3 = W[(size_t)(4 * k4 + 3) * NMODC];
#pragma unroll
                for (int kk = 0; kk < 4; ++kk) { const int k_ = 4 * k4 + kk; const float wv = kk == 0 ? w0 : (kk == 1 ? w1 : (kk == 2 ? w2 : w3));
                    acc0 += *(const LAS f32x4*)(cact + k_ * 32 + (((2 * bg) ^ (k_ & 7)) << 2)) * wv; acc1 += *(const LAS f32x4*)(cact + k_ * 32 + (((2 * bg + 1) ^ (k_ & 7)) << 2)) * wv; }
            }
            float* MOD = (float*)(p.ws + WS_MOD);
            const float bias = p.in[I_ADAB][l * NMODC + col];
#pragma unroll
            for (int j = 0; j < 4; ++j) { MOD[((size_t)l * 32 + 8 * bg + j) * NMODC + col] = acc0[j] + bias; MOD[((size_t)l * 32 + 8 * bg + 4 + j) * NMODC + col] = acc1[j] + bias; }
            __syncthreads();
        }
    }
    const int gtid = (G - 1 - (int)blockIdx.x) * 512 + tid;
    if (gtid < 1024) {
        const float* lg = p.in[I_LBL]; float v[4], mx = -1e30f;
#pragma unroll
        for (int l = 0; l < 4; ++l) { v[l] = lg[l * 1024 + gtid]; mx = fmaxf(mx, v[l]); }
        float s = 0.f;
#pragma unroll
        for (int l = 0; l < 4; ++l) { v[l] = __expf(v[l] - mx); s += v[l]; }
        float* LB = (float*)(p.ws + WS_LB); float cum = 0.f; const float first = v[0] / s;
#pragma unroll
        for (int l = 0; l < 4; ++l) { cum += v[l] / s; LB[l * 1024 + gtid] = (l == 0) ? 0.f : (cum - first); }
    }
    if (gtid >= 1024 && gtid < 1024 + 16384) {
        const int id = gtid - 1024, lg = id >> 6, pp = id & 63;
        const float a_re = p.in[I_ARE][id], a_im = p.in[I_AIM][id];
        const float step = expf(p.in[I_LDT][lg]);
        const float mag = expf(step * a_re), ang = step * a_im;
        const float ab_re = mag * cosf(ang), ab_im = mag * sinf(ang);
        const float den = a_re * a_re + a_im * a_im;
        const float z_re = ((ab_re - 1.0f) * a_re + ab_im * a_im) / den;
        const float z_im = (ab_im * a_re - (ab_re - 1.0f) * a_im) / den;
        float* ABAR = (float*)(p.ws + WS_ABAR); ABAR[2 * id] = ab_re; ABAR[2 * id + 1] = ab_im;
        bf16_t* BOP = (bf16_t*)(p.ws + WS_BOP); bf16_t* COP = (bf16_t*)(p.ws + WS_COP);
        const float* bre = p.in[I_BRE] + (size_t)id * 16; const float* bim = p.in[I_BIM] + (size_t)id * 16;
#pragma unroll
        for (int c = 0; c < 16; ++c) {
            const float br = bre[c], bi = bim[c];
            const float rr = z_re * br - z_im * bi, ii = z_re * bi + z_im * br;
            BOP[((size_t)lg * 128 + 2 * pp) * 16 + c] = (bf16_t)(pk2(rr, 0.f) & 0xffffu);
            BOP[((size_t)lg * 128 + 2 * pp + 1) * 16 + c] = (bf16_t)(pk2(ii, 0.f) & 0xffffu);
            const float cr = p.in[I_CRE][((size_t)lg * 16 + c) * 64 + pp], ci = p.in[I_CIM][((size_t)lg * 16 + c) * 64 + pp];
            COP[((size_t)lg * 16 + c) * 128 + 2 * pp] = (bf16_t)(pk2(cr, 0.f) & 0xffffu);
            COP[((size_t)lg * 16 + c) * 128 + 2 * pp + 1] = (bf16_t)(pk2(-ci, 0.f) & 0xffffu);
        }
    }
}

__device__ __forceinline__ void transpose_item(const float* W, int K, int N, bf16_t* WT, LAS float* scr, int item, int lane) {
    const int nblk = N / 32, kb = item / nblk, nb = item % nblk, k0 = 64 * kb, n0 = 32 * nb;
#pragma unroll 8
    for (int i = 0; i < 32; ++i) { const int kk = 2 * i + (lane >> 5); scr[kk * 33 + (lane & 31)] = W[(size_t)(k0 + kk) * N + n0 + (lane & 31)]; }
    LDS_WAIT();
    const int c = lane & 7;
#pragma unroll
    for (int j = 0; j < 4; ++j) { const int n = (lane >> 3) + 8 * j; const LAS float* s = scr + (8 * c) * 33 + n;
        u32x4 o; o.x = pk2(s[0 * 33], s[1 * 33]); o.y = pk2(s[2 * 33], s[3 * 33]); o.z = pk2(s[4 * 33], s[5 * 33]); o.w = pk2(s[6 * 33], s[7 * 33]);
        *(u32x4*)(WT + (size_t)(n0 + n) * K + k0 + 8 * c) = o; }
    LDS_WAIT();
}
__device__ __forceinline__ void cvt_f32_fp8(const float* src, unsigned char* dst, size_t n4, size_t gtid, size_t nthr, float scale) {
    for (size_t i = gtid; i < n4; i += nthr) { const f32x4 v = ((const f32x4*)src)[i] * scale; int w = 0;
        w = __builtin_amdgcn_cvt_pk_fp8_f32(v[0], v[1], w, false); w = __builtin_amdgcn_cvt_pk_fp8_f32(v[2], v[3], w, true); ((unsigned*)dst)[i] = (unsigned)w; }
}
__device__ __forceinline__ void cvt_f32_fp8_sliced(const float* src, unsigned char* dst, size_t gtid, size_t nthr, float scale) {
    for (size_t i = gtid; i < (size_t)16384 * 64; i += nthr) {
        const size_t e = i >> 6; const int sl = (int)(i & 63) >> 3, c = (int)(i & 7);
        const f32x4* sp = (const f32x4*)(src + e * 1024 + sl * 128 + c * 16); u32x4 o;
#pragma unroll
        for (int q = 0; q < 4; ++q) { const f32x4 v = sp[q] * scale; int w = 0; w = __builtin_amdgcn_cvt_pk_fp8_f32(v[0], v[1], w, false); w = __builtin_amdgcn_cvt_pk_fp8_f32(v[2], v[3], w, true); o[q] = (unsigned)w; }
        *(u32x4*)(dst + ((size_t)sl * 16384 + e) * 128 + c * 16) = o;
    }
}
__device__ __forceinline__ void transpose_item_fp8(const float* W, int K, int N, unsigned char* WT, LAS float* scr, int item, int lane, float scale) {
    const int nblk = N / 32, kb = item / nblk, nb = item % nblk, k0 = 64 * kb, n0 = 32 * nb;
#pragma unroll 8
    for (int i = 0; i < 32; ++i) { const int kk = 2 * i + (lane >> 5); scr[kk * 33 + (lane & 31)] = W[(size_t)(k0 + kk) * N + n0 + (lane & 31)]; }
    LDS_WAIT();
    const int c = lane & 7;
#pragma unroll
    for (int j = 0; j < 4; ++j) { const int n = (lane >> 3) + 8 * j; const LAS float* sp = scr + (8 * c) * 33 + n;
        int w0 = 0, w1 = 0;
        w0 = __builtin_amdgcn_cvt_pk_fp8_f32(sp[0 * 33] * scale, sp[1 * 33] * scale, w0, false); w0 = __builtin_amdgcn_cvt_pk_fp8_f32(sp[2 * 33] * scale, sp[3 * 33] * scale, w0, true);
        w1 = __builtin_amdgcn_cvt_pk_fp8_f32(sp[4 * 33] * scale, sp[5 * 33] * scale, w1, false); w1 = __builtin_amdgcn_cvt_pk_fp8_f32(sp[6 * 33] * scale, sp[7 * 33] * scale, w1, true);
        *(u32x2*)(WT + (size_t)(n0 + n) * K + k0 + 8 * c) = (u32x2){(unsigned)w0, (unsigned)w1}; }
    LDS_WAIT();
}
__device__ __forceinline__ void cvt_f32_bf16(const float* src, bf16_t* dst, size_t n4, size_t gtid, size_t nthr) {
    for (size_t i = gtid; i < n4; i += nthr) { const f32x4 v = ((const f32x4*)src)[i]; u32x2 o; o.x = pk2(v[0], v[1]); o.y = pk2(v[2], v[3]); ((u32x2*)dst)[i] = o; }
}
template <bool F8OUT, bool XBF>
__device__ __forceinline__ void norm_rows(const float* xsrc, bf16_t* hdst, const float* gain, const float* mod_l, int sh_off, int sc_off, int gw, int ngw, int lane) {
    for (int r0 = gw * 4; r0 < M; r0 += ngw * 4) {
        const int b = r0 >> 11;
        f32x4 v[4][4]; float ss[4];
#pragma unroll
        for (int i = 0; i < 4; ++i) {
            if constexpr (XBF) { const u32x2* xr = (const u32x2*)((const bf16_t*)xsrc + (size_t)(r0 + i) * D) + lane;
#pragma unroll
                for (int j = 0; j < 4; ++j) { const u32x2 xw = xr[64 * j]; v[i][j] = (f32x4){bflo(xw[0]), bfhi(xw[0]), bflo(xw[1]), bfhi(xw[1])}; } }
            else { const f32x4* xr = (const f32x4*)(xsrc + (size_t)(r0 + i) * D) + lane;
#pragma unroll
                for (int j = 0; j < 4; ++j) v[i][j] = xr[64 * j]; } }
#pragma unroll
        for (int i = 0; i < 4; ++i) { float t = 0.f;
#pragma unroll
            for (int j = 0; j < 4; ++j) t += (v[i][j][0] * v[i][j][0] + v[i][j][1] * v[i][j][1]) + (v[i][j][2] * v[i][j][2] + v[i][j][3] * v[i][j][3]);
            ss[i] = t; }
#pragma unroll
        for (int o = 1; o < 64; o <<= 1) {
#pragma unroll
            for (int i = 0; i < 4; ++i) ss[i] += __shfl_xor(ss[i], o); }
        const float* mb = mod_l + (size_t)b * NMODC;
#pragma unroll
        for (int j = 0; j < 4; ++j) { const int col = 256 * j + 4 * lane;
            const f32x4 g4 = *(const f32x4*)(gain + col), sc = *(const f32x4*)(mb + sc_off + col), sh = *(const f32x4*)(mb + sh_off + col);
            const f32x4 gs = g4 * (sc + 1.0f);
#pragma unroll
            for (int i = 0; i < 4; ++i) { const float rstd = __builtin_amdgcn_rsqf(ss[i] * (1.0f / D) + EPS);
                const f32x4 h = v[i][j] * rstd * gs + sh;
                if constexpr (F8OUT) { int w8 = 0; w8 = __builtin_amdgcn_cvt_pk_fp8_f32(h[0] * HIN_SCALE, h[1] * HIN_SCALE, w8, false); w8 = __builtin_amdgcn_cvt_pk_fp8_f32(h[2] * HIN_SCALE, h[3] * HIN_SCALE, w8, true);
                    *(unsigned*)((unsigned char*)hdst + (size_t)(r0 + i) * D + col) = (unsigned)w8; }
                else { u32x2 o; o.x = pk2(h[0], h[1]); o.y = pk2(h[2], h[3]); *(u32x2*)(hdst + (size_t)(r0 + i) * D + col) = o; } } }
    }
}
template <bool XBF>
__device__ __forceinline__ void resid_norm_rows(const float* xsrc, bf16_t* xdst, const bf16_t* delta, bf16_t* hdst, unsigned char* xf8, const float* gain, const float* mod_l, int gw, int ngw, int lane) {
    for (int r0 = gw * 4; r0 < M; r0 += ngw * 4) {
        const int b = r0 >> 11; const float* mb = mod_l + (size_t)b * NMODC;
        f32x4 v[4][4]; u32x2 dl[4][4]; float ss[4];
#pragma unroll
        for (int i = 0; i < 4; ++i) { const u32x2* dp = (const u32x2*)(delta + (size_t)(r0 + i) * D) + lane;
            if constexpr (XBF) { const u32x2* xr = (const u32x2*)((const bf16_t*)xsrc + (size_t)(r0 + i) * D) + lane;
#pragma unroll
                for (int j = 0; j < 4; ++j) { const u32x2 xw = xr[64 * j]; v[i][j] = (f32x4){bflo(xw[0]), bfhi(xw[0]), bflo(xw[1]), bfhi(xw[1])}; dl[i][j] = dp[64 * j]; } }
            else { const f32x4* xr = (const f32x4*)(xsrc + (size_t)(r0 + i) * D) + lane;
#pragma unroll
                for (int j = 0; j < 4; ++j) { v[i][j] = xr[64 * j]; dl[i][j] = dp[64 * j]; } } }
#pragma unroll
        for (int j = 0; j < 4; ++j) { const f32x4 g1 = *(const f32x4*)(mb + 2048 + 256 * j + 4 * lane);
#pragma unroll
            for (int i = 0; i < 4; ++i) { const f32x4 dv = {bflo(dl[i][j][0]), bfhi(dl[i][j][0]), bflo(dl[i][j][1]), bfhi(dl[i][j][1])}; v[i][j] = v[i][j] + g1 * dv;
                ((u32x2*)(xdst + (size_t)(r0 + i) * D) + lane)[64 * j] = (u32x2){pk2(v[i][j][0], v[i][j][1]), pk2(v[i][j][2], v[i][j][3])}; } }
#pragma unroll
        for (int i = 0; i < 4; ++i) { float t = 0.f;
#pragma unroll
            for (int j = 0; j < 4; ++j) t += (v[i][j][0] * v[i][j][0] + v[i][j][1] * v[i][j][1]) + (v[i][j][2] * v[i][j][2] + v[i][j][3] * v[i][j][3]);
            ss[i] = t; }
#pragma unroll
        for (int o = 1; o < 64; o <<= 1) {
#pragma unroll
            for (int i = 0; i < 4; ++i) ss[i] += __shfl_xor(ss[i], o); }
#pragma unroll
        for (int j = 0; j < 4; ++j) { const int col = 256 * j + 4 * lane;
            const f32x4 g4 = *(const f32x4*)(gain + col), sc = *(const f32x4*)(mb + 4096 + col), sh = *(const f32x4*)(mb + 3072 + col);
            const f32x4 gs = g4 * (sc + 1.0f);
#pragma unroll
            for (int i = 0; i < 4; ++i) { const float rstd = __builtin_amdgcn_rsqf(ss[i] * (1.0f / D) + EPS);
                const f32x4 h = v[i][j] * rstd * gs + sh; u32x2 o; o.x = pk2(h[0], h[1]); o.y = pk2(h[2], h[3]); *(u32x2*)(hdst + (size_t)(r0 + i) * D + col) = o;
                int w8 = 0; w8 = __builtin_amdgcn_cvt_pk_fp8_f32(h[0] * X_SCALE, h[1] * X_SCALE, w8, false); w8 = __builtin_amdgcn_cvt_pk_fp8_f32(h[2] * X_SCALE, h[3] * X_SCALE, w8, true);
                *(unsigned*)(xf8 + ((size_t)(col >> 7) * M + (r0 + i)) * 128 + (col & 127)) = (unsigned)w8; } }
    }
}
__device__ __forceinline__ void phase_conv_norm1(const KP& p, LAS unsigned char* lds, int l, int G) {
    const int tid = opaque_tid(), lane = tid & 63, wave = __builtin_amdgcn_readfirstlane(tid >> 6);
    const int gw = blockIdx.x * 8 + wave, ngw = G * 8;
    LAS float* scr = (LAS float*)(lds + wave * 8448);
    constexpr int I_IN = 16 * (INC / 32), I_G = 16 * 32, I_O = 16 * 32, I_Q = 16 * 64, NIT = I_IN + I_G + I_O + I_Q;
    for (int it = gw; it < NIT; it += ngw) {
        int r = it;
        if (r < I_IN) { transpose_item_fp8(p.in[I_WIN] + (size_t)l * D * INC, D, INC, p.ws + WS_WIN, scr, r, lane, WIN_SCALE); continue; } r -= I_IN;
        if (r < I_G) { transpose_item(p.in[I_GLUW] + (size_t)l * D * D, D, D, (bf16_t*)(p.ws + WS_WGLU), scr, r, lane); continue; } r -= I_G;
        if (r < I_O) { transpose_item_fp8(p.in[I_WOUT] + (size_t)l * D * D, D, D, p.ws + WS_WOUT, scr, r, lane, WO_SCALE); continue; } r -= I_O;
        transpose_item(p.in[I_WQ] + (size_t)l * D * 2048, D, 2048, (bf16_t*)(p.ws + WS_WQ), scr, r, lane);
    }
    const size_t gtid = (size_t)blockIdx.x * 512 + tid, nthr = (size_t)G * 512;
    cvt_f32_bf16(p.in[I_SUBK] + (size_t)l * 262144, (bf16_t*)(p.ws + WS_KEYS), 262144 / 4, gtid, nthr);
    if (l == 0) norm_rows<true, false>(p.in[I_X], (bf16_t*)(p.ws + WS_H), p.in[I_N1G] + l * D, (const float*)(p.ws + WS_MOD) + (size_t)l * 32 * NMODC, 0, 1024, gw, ngw, lane);
    else norm_rows<true, true>(p.out, (bf16_t*)(p.ws + WS_H), p.in[I_N1G] + l * D, (const float*)(p.ws + WS_MOD) + (size_t)l * 32 * NMODC, 0, 1024, gw, ngw, lane);
}

__device__ __forceinline__ void phase_hgrn2(const KP& p, LAS unsigned char* lds, int l, int G) {
    const int tid = opaque_tid(), lane = tid & 63, w = __builtin_amdgcn_readfirstlane(tid >> 6), fr = lane & 15, g = lane >> 4;
    constexpr int QS = 272, TS = 72;
    constexpr int OFF_QT = 0, OFF_KH = 8704, OFF_KT = 17408, OFF_VT = 26624, OFF_EREF = 35840, OFF_ELR = 36352, OFF_SEG = 36864, PBUF = 40960;
    const bf16_t* PA = (const bf16_t*)(p.ws + WS_R0);
    bf16_t* ORAW = (bf16_t*)(p.ws + WS_OR);
    const float* LB = (const float*)(p.ws + WS_LB) + l * 1024;
    for (int unit = blockIdx.x; unit < 256; unit += G) {
        const int b = unit >> 3, h = unit & 7, k0 = 2 * lane;
        const float lb0 = LB[h * 128 + k0], lb1 = LB[h * 128 + k0 + 1];
        const float om0 = 1.0f - lb0, om1 = 1.0f - lb1;
        f32x4 S[8];
#pragma unroll
        for (int kt = 0; kt < 8; ++kt) S[kt] = (f32x4){0.f, 0.f, 0.f, 0.f};
        unsigned rq[4], rf[4], rv[4];
        {
            const bf16_t* base = PA + ((size_t)b * SEQ + 4 * w) * 3072 + h * 128 + k0;
#pragma unroll
            for (int i = 0; i < 4; ++i) { rq[i] = *(const unsigned*)(base + (size_t)i * 3072); rf[i] = *(const unsigned*)(base + (size_t)i * 3072 + 1024); rv[i] = *(const unsigned*)(base + (size_t)i * 3072 + 2048); }
        }
        for (int c = 0; c < 64; ++c) {
            LAS unsigned char* base = lds + (c & 1) * PBUF;
            float cs0[4], cs1[4], qv0[4], qv1[4], kv0[4], kv1[4];
            float run0 = 0.f, run1 = 0.f;
#pragma unroll
            for (int i = 0; i < 4; ++i) {
                const float fp0 = bflo(rf[i]), fp1 = bfhi(rf[i]);
                const float s0 = fsigmoid(fp0), s1 = fsigmoid(fp1);
                run0 += __logf(lb0 + om0 * s0); run1 += __logf(lb1 + om1 * s1);
                cs0[i] = run0; cs1[i] = run1;
                kv0[i] = om0 * (1.0f - s0); kv1[i] = om1 * (1.0f - s1);
                qv0[i] = fsilu(bflo(rq[i])); qv1[i] = fsilu(bfhi(rq[i]));
            }
            *(LAS f32x2*)(base + OFF_SEG + (w * 128 + k0) * 4) = (f32x2){run0, run1};
            __syncthreads();
            float off0 = 0.f, off1 = 0.f, ref0 = 0.f, ref1 = 0.f, all0 = 0.f, all1 = 0.f;
#pragma unroll
            for (int s = 0; s < 8; ++s) { const f32x2 t2 = *(const LAS f32x2*)(base + OFF_SEG + (s * 128 + k0) * 4);
                if (s < w) { off0 += t2[0]; off1 += t2[1]; }
                if (s < 4) { ref0 += t2[0]; ref1 += t2[1]; }
                all0 += t2[0]; all1 += t2[1]; }
            float kh0[4], kh1[4];
#pragma unroll
            for (int i = 0; i < 4; ++i) {
                const float b0 = off0 + cs0[i], b1 = off1 + cs1[i];
                const float q0 = qv0[i] * __expf(b0 - ref0), q1 = qv1[i] * __expf(b1 - ref1);
                kh0[i] = kv0[i] * __expf(ref0 - b0); kh1[i] = kv1[i] * __expf(ref1 - b1);
                const int t = 4 * w + i;
                *(LAS unsigned*)(base + OFF_QT + t * QS + k0 * 2) = pk2(q0, q1);
                *(LAS unsigned*)(base + OFF_KH + t * QS + k0 * 2) = pk2(kh0[i], kh1[i]);
            }
            *(LAS u32x2*)(base + OFF_KT + k0 * TS + 8 * w) = (u32x2){pk2(kh0[0], kh0[1]), pk2(kh0[2], kh0[3])};
            *(LAS u32x2*)(base + OFF_KT + (k0 + 1) * TS + 8 * w) = (u32x2){pk2(kh1[0], kh1[1]), pk2(kh1[2], kh1[3])};
            *(LAS u32x2*)(base + OFF_VT + k0 * TS + 8 * w) = (u32x2){(rv[0] & 0xffffu) | (rv[1] << 16), (rv[2] & 0xffffu) | (rv[3] << 16)};
            *(LAS u32x2*)(base + OFF_VT + (k0 + 1) * TS + 8 * w) = (u32x2){(rv[0] >> 16) | (rv[1] & 0xffff0000u), (rv[2] >> 16) | (rv[3] & 0xffff0000u)};
            if (w == 0) {
                *(LAS f32x2*)(base + OFF_EREF + k0 * 4) = (f32x2){__expf(ref0), __expf(ref1)};
                *(LAS f32x2*)(base + OFF_ELR + k0 * 4) = (f32x2){__expf(all0 - ref0), __expf(all1 - ref1)};
            }
            __syncthreads();
            if (c + 1 < 64) {
                const bf16_t* nb = PA + ((size_t)b * SEQ + (c + 1) * 32 + 4 * w) * 3072 + h * 128 + k0;
#pragma unroll
                for (int i = 0; i < 4; ++i) { rq[i] = *(const unsigned*)(nb + (size_t)i * 3072); rf[i] = *(const unsigned*)(nb + (size_t)i * 3072 + 1024); rv[i] = *(const unsigned*)(nb + (size_t)i * 3072 + 2048); }
            }
            bf16x8 qf[2][4], kf[2][4];
#pragma unroll
            for (int tt = 0; tt < 2; ++tt)
#pragma unroll
                for (int m = 0; m < 4; ++m) {
                    const LAS unsigned char* pq = base + OFF_QT + (16 * tt + fr) * QS + (32 * m + 4 * g) * 2;
                    const u32x2 lo = *(const LAS u32x2*)pq, hi = *(const LAS u32x2*)(pq + 32);
                    qf[tt][m] = __builtin_bit_cast(bf16x8, (u32x4){lo[0], lo[1], hi[0], hi[1]});
                    const LAS unsigned char* pk = base + OFF_KH + (16 * tt + fr) * QS + (32 * m + 4 * g) * 2;
                    const u32x2 lo2 = *(const LAS u32x2*)pk, hi2 = *(const LAS u32x2*)(pk + 32);
                    kf[tt][m] = __builtin_bit_cast(bf16x8, (u32x4){lo2[0], lo2[1], hi2[0], hi2[1]});
                }
            f32x4 PT00 = {0.f, 0.f, 0.f, 0.f}, PT01 = {0.f, 0.f, 0.f, 0.f}, PT11 = {0.f, 0.f, 0.f, 0.f};
#pragma unroll
            for (int m = 0; m < 4; ++m) {
                PT00 = __builtin_amdgcn_mfma_f32_16x16x32_bf16(kf[0][m], qf[0][m], PT00, 0, 0, 0);
                PT01 = __builtin_amdgcn_mfma_f32_16x16x32_bf16(kf[0][m], qf[1][m], PT01, 0, 0, 0);
                PT11 = __builtin_amdgcn_mfma_f32_16x16x32_bf16(kf[1][m], qf[1][m], PT11, 0, 0, 0);
            }
#pragma unroll
            for (int r = 0; r < 4; ++r) { if (4 * g + r > fr) { PT00[r] = 0.f; PT11[r] = 0.f; } }
            const bf16x8 pa0 = __builtin_bit_cast(bf16x8, (u32x4){pk2(PT00[0], PT00[1]), pk2(PT00[2], PT00[3]), 0u, 0u});
            const bf16x8 pa1 = __builtin_bit_cast(bf16x8, (u32x4){pk2(PT01[0], PT01[1]), pk2(PT01[2], PT01[3]), pk2(PT11[0], PT11[1]), pk2(PT11[2], PT11[3])});
            const LAS unsigned char* vrow = base + OFF_VT + (16 * w + fr) * TS;
            const u32x2 vpa = *(const LAS u32x2*)(vrow + 8 * g), vpb = *(const LAS u32x2*)(vrow + 32 + 8 * g);
            const u32x2 vna = *(const LAS u32x2*)(vrow + 16 * g), vnb = *(const LAS u32x2*)(vrow + 16 * g + 8);
            const bf16x8 vperm = __builtin_bit_cast(bf16x8, (u32x4){vpa[0], vpa[1], vpb[0], vpb[1]});
            const bf16x8 vnat = __builtin_bit_cast(bf16x8, (u32x4){vna[0], vna[1], vnb[0], vnb[1]});
#pragma unroll
            for (int kt = 0; kt < 8; ++kt) { const f32x4 e = *(const LAS f32x4*)(base + OFF_EREF + (16 * kt + 4 * g) * 4); S[kt] = S[kt] * e; }
            f32x4 O0 = {0.f, 0.f, 0.f, 0.f}, O1 = {0.f, 0.f, 0.f, 0.f};
#pragma unroll
            for (int m = 0; m < 4; ++m) {
                const bf16x8 sf = __builtin_bit_cast(bf16x8, (u32x4){pk2(S[2 * m][0], S[2 * m][1]), pk2(S[2 * m][2], S[2 * m][3]), pk2(S[2 * m + 1][0], S[2 * m + 1][1]), pk2(S[2 * m + 1][2], S[2 * m + 1][3])});
                O0 = __builtin_amdgcn_mfma_f32_16x16x32_bf16(qf[0][m], sf, O0, 0, 0, 0);
                O1 = __builtin_amdgcn_mfma_f32_16x16x32_bf16(qf[1][m], sf, O1, 0, 0, 0);
            }
            O0 = __builtin_amdgcn_mfma_f32_16x16x32_bf16(pa0, vperm, O0, 0, 0, 0);
            O1 = __builtin_amdgcn_mfma_f32_16x16x32_bf16(pa1, vperm, O1, 0, 0, 0);
#pragma unroll
            for (int kt = 0; kt < 8; ++kt) {
                const LAS unsigned char* krow = base + OFF_KT + (16 * kt + fr) * TS + 16 * g;
                const u32x2 ka = *(const LAS u32x2*)krow, kb = *(const LAS u32x2*)(krow + 8);
                const bf16x8 ktf = __builtin_bit_cast(bf16x8, (u32x4){ka[0], ka[1], kb[0], kb[1]});
                S[kt] = __builtin_amdgcn_mfma_f32_16x16x32_bf16(ktf, vnat, S[kt], 0, 0, 0);
            }
#pragma unroll
            for (int kt = 0; kt < 8; ++kt) { const f32x4 e = *(const LAS f32x4*)(base + OFF_ELR + (16 * kt + 4 * g) * 4); S[kt] = S[kt] * e; }
            bf16_t* orow = ORAW + ((size_t)b * SEQ + c * 32 + 4 * g) * D + h * 128 + 16 * w + fr;
#pragma unroll
            for (int r = 0; r < 4; ++r) { orow[(size_t)r * D] = (bf16_t)(pk2(O0[r], 0.f) & 0xffffu); orow[(size_t)(16 + r) * D] = (bf16_t)(pk2(O1[r], 0.f) & 0xffffu); }
        }
        __syncthreads();
    }
}

__device__ __forceinline__ void phase_s5(const KP& p, LAS unsigned char* lds, int l, int G, size_t ys_off) {
    const int tid = opaque_tid(), lane = tid & 63, w = __builtin_amdgcn_readfirstlane(tid >> 6), fr = lane & 15, g = lane >> 4;
    const int gw = blockIdx.x * 8 + w, ngw = G * 8;
    constexpr int BUS = 132;
    LAS float* BU = (LAS float*)(lds + w * 16896);
    LAS unsigned char* XI = (LAS unsigned char*)BU;
    const bf16_t* PB = (const bf16_t*)(p.ws + WS_R0);
    const bf16x8 zero8 = {0, 0, 0, 0, 0, 0, 0, 0};
    const bf16_t* ORAWs = (const bf16_t*)(p.ws + WS_OR); float* SSQs = (float*)(p.ws + WS_SSQ);
    for (int unit = gw; unit < BATCH * 64; unit += ngw) {
        const int b = unit >> 6, grp = unit & 63, lg = l * 64 + grp;
        const bf16_t* BOP = (const bf16_t*)(p.ws + WS_BOP) + (size_t)lg * 128 * 16;
        const bf16_t* COP = (const bf16_t*)(p.ws + WS_COP) + (size_t)lg * 16 * 128;
        bf16x8 bfrag[8], cfrag[4], dfrag;
#pragma unroll
        for (int nt = 0; nt < 8; ++nt) bfrag[nt] = (g < 2) ? *(const bf16x8*)(BOP + (size_t)(16 * nt + fr) * 16 + 8 * g) : zero8;
#pragma unroll
        for (int ks = 0; ks < 4; ++ks) cfrag[ks] = DBG_S5_NOSSM ? zero8 : *(const bf16x8*)(COP + (size_t)fr * 128 + 32 * ks + 8 * g);
        {
            const unsigned dbits = pk2(p.in[I_S5D][l * 1024 + grp * 16 + fr], 0.f) & 0xffffu;
#pragma unroll
            for (int j = 0; j < 8; ++j) dfrag[j] = (g < 2 && (8 * g + j) == fr) ? (short)dbits : (short)0;
        }
        const float ar = ((const float*)(p.ws + WS_ABAR))[2 * ((size_t)lg * 64 + lane)], ai = ((const float*)(p.ws + WS_ABAR))[2 * ((size_t)lg * 64 + lane) + 1];
        const float nai = -ai; float xr = 0.f, xi = 0.f; unsigned hBU = 0u, hXI = 0u, hY = 0u;
        const bf16_t* ub = PB + ((size_t)b * SEQ) * 4096 + 1024 + grp * 16;
        bf16_t* yb_ = (bf16_t*)(p.ws + ys_off) + ((size_t)b * SEQ) * D + grp * 16;
        bf16x8 unext[2];
#pragma unroll
        for (int tt = 0; tt < 2; ++tt) unext[tt] = (g < 2) ? *(const bf16x8*)(ub + (size_t)(16 * tt + fr) * 4096 + 8 * g) : zero8;
        const bool cvt_next = true;
        const float* tsrc = ((lane < 32) ? p.in[I_PU] : p.in[I_PV]) + (size_t)l * 16384 * 1024 + 4 * (lane & 31);
        unsigned char* tdst = p.ws + ((lane < 32) ? WS_U : WS_V) + (size_t)(l & 1) * TAB_BYTES + 4 * (lane & 31);
        const float tscale = (lane < 32) ? U_SCALE : V_SCALE;
        for (int t0 = 0; t0 < SEQ; t0 += 32) {
            const int item = unit * 64 + (t0 >> 5), te = item >> 3, tsl = item & 7;
            f32x4 tv = {0.f, 0.f, 0.f, 0.f}; if (cvt_next) tv = *(const f32x4*)(tsrc + (size_t)te * 1024 + tsl * 128);
            const bool ssq_it = ((t0 >> 5) & 1) == 0; const int srow = item >> 1;
            u32x4 sa = {0u, 0u, 0u, 0u}, sc2 = {0u, 0u, 0u, 0u};
            if (ssq_it) { sa = *(const u32x4*)(ORAWs + (size_t)srow * D + 8 * lane); sc2 = *(const u32x4*)(ORAWs + (size_t)srow * D + 512 + 8 * lane); }
            bf16x8 ufrag[2];
#pragma unroll
            for (int tt = 0; tt < 2; ++tt) { ufrag[tt] = unext[tt]; if (t0 + 32 < SEQ) unext[tt] = (g < 2) ? *(const bf16x8*)(ub + (size_t)(t0 + 32 + 16 * tt + fr) * 4096 + 8 * g) : zero8; }
#pragma unroll
            for (int tt = 0; tt < 2; ++tt)
#pragma unroll
                for (int nt = 0; nt < 8; ++nt) {
                    const f32x4 a = __builtin_amdgcn_mfma_f32_16x16x32_bf16(ufrag[tt], bfrag[nt], (f32x4){0.f, 0.f, 0.f, 0.f}, 0, 0, 0);
#pragma unroll
                    for (int r = 0; r < 4; ++r) BU[(16 * tt + 4 * g + r) * BUS + 16 * nt + fr] = a[r];
                }
            LDS_WAIT();
#pragma unroll
            for (int t = 0; t < 32; ++t) {
                const f32x2 bb = *(const LAS f32x2*)(BU + t * BUS + 2 * lane); hBU += __float_as_uint(bb[0]) * 3u + __float_as_uint(bb[1]);
                float t1, t2, nr, ni;
                asm("v_fma_f32 %0, %1, %2, %3" : "=v"(t1) : "v"(nai), "v"(xi), "v"(bb[0]));
                asm("v_fma_f32 %0, %1, %2, %3" : "=v"(t2) : "v"(ai), "v"(xr), "v"(bb[1]));
                asm("v_fma_f32 %0, %1, %2, %3" : "=v"(nr) : "v"(ar), "v"(xr), "v"(t1));
                asm("v_fma_f32 %0, %1, %2, %3" : "=v"(ni) : "v"(ar), "v"(xi), "v"(t2));
                xr = nr; xi = ni;
                { const unsigned pv = pk2(nr, ni); hXI += pv; *(LAS unsigned*)(XI + t * (BUS * 4) + lane * 4) = pv; }
            }
            LDS_WAIT();
#pragma unroll
            for (int tt = 0; tt < 2; ++tt) {
                f32x4 y = {0.f, 0.f, 0.f, 0.f};
#pragma unroll
                for (int ks = 0; ks < 4; ++ks) {
                    const bf16x8 xf = *(const LAS bf16x8*)(XI + (16 * tt + fr) * (BUS * 4) + (32 * ks + 8 * g) * 2);
                    y = __builtin_amdgcn_mfma_f32_16x16x32_bf16(xf, cfrag[ks], y, 0, 0, 0);
                }
                y = __builtin_amdgcn_mfma_f32_16x16x32_bf16(ufrag[tt], dfrag, y, 0, 0, 0);
#pragma unroll
                for (int r = 0; r < 4; ++r) { const unsigned yv = pk2(fgelu(y[r]), 0.f) & 0xffffu; hY += yv * (unsigned)(r + 1); yb_[(size_t)(t0 + 16 * tt + 4 * g + r) * D + fr] = (bf16_t)yv; }
            }
            LDS_WAIT();
            if (ssq_it) { float s0 = 0.f, s1 = 0.f;
#pragma unroll
                for (int j = 0; j < 4; ++j) { const float x0 = bflo(sa[j]), x1 = bfhi(sa[j]), y0 = bflo(sc2[j]), y1 = bfhi(sc2[j]); s0 += x0 * x0 + x1 * x1; s1 += y0 * y0 + y1 * y1; }
                { s0 = dpp_sum8(s0); s1 = dpp_sum8(s1);
                  s0 += __uint_as_float(__builtin_amdgcn_update_dpp(0, __float_as_uint(s0), 0x140, 0xF, 0xF, true)); s1 += __uint_as_float(__builtin_amdgcn_update_dpp(0, __float_as_uint(s1), 0x140, 0xF, 0xF, true)); }
                if (fr == 0) { SSQs[(size_t)srow * 8 + g] = s0; SSQs[(size_t)srow * 8 + 4 + g] = s1; } }
            if (cvt_next) { int w8 = 0; w8 = __builtin_amdgcn_cvt_pk_fp8_f32(tv[0] * tscale, tv[1] * tscale, w8, false); w8 = __builtin_amdgcn_cvt_pk_fp8_f32(tv[2] * tscale, tv[3] * tscale, w8, true);
                *(unsigned*)(tdst + ((size_t)tsl * 16384 + te) * 128) = (unsigned)w8; }
        }
        if (DBG_SELFCHECK) { for (int o = 1; o < 64; o <<= 1) { hBU += __shfl_xor((int)hBU, o); hXI += __shfl_xor((int)hXI, o); hY += __shfl_xor((int)hY, o); }
            unsigned* hs = (unsigned*)(p.ws + WS_CTL) + 65536 + (ys_off == WS_YS ? 0 : 8192) + unit * 4; unsigned hA = __float_as_uint(ar) * 7u + __float_as_uint(ai); for (int o = 1; o < 64; o <<= 1) hA += __shfl_xor((int)hA, o); if (lane == 0) { hs[0] = hBU; hs[1] = hXI; hs[2] = hA; } }
    }
}

__device__ __forceinline__ unsigned fkey(float f) { const unsigned u = __float_as_uint(f); return u ^ ((unsigned)((int)u >> 31) | 0x80000000u); }
__device__ __forceinline__ float kval(unsigned k) { const unsigned u = (k & 0x80000000u) ? (k ^ 0x80000000u) : ~k; return __uint_as_float(u); }
#define CE_DESC(a, b) do { const unsigned _mx = (a) > (b) ? (a) : (b), _mn = (a) > (b) ? (b) : (a); (a) = _mx; (b) = _mn; } while (0)
__device__ __forceinline__ void sort16_desc(unsigned (&a)[16]) {
#pragma unroll
    for (int kk = 1; kk <= 4; ++kk)
#pragma unroll
        for (int jj = kk - 1; jj >= 0; --jj)
#pragma unroll
            for (int i = 0; i < 16; ++i) { const int k = 1 << kk, j = 1 << jj, l2 = i ^ j;
                if (l2 > i) { if ((i & k) == 0) CE_DESC(a[i], a[l2]); else CE_DESC(a[l2], a[i]); } }
}
__device__ __forceinline__ void merge_top16(unsigned (&a)[16], const unsigned (&b)[16]) {
#pragma unroll
    for (int i = 0; i < 16; ++i) a[i] = a[i] > b[15 - i] ? a[i] : b[15 - i];
#pragma unroll
    for (int jj = 3; jj >= 0; --jj)
#pragma unroll
        for (int i = 0; i < 16; ++i) { const int j = 1 << jj, l2 = i ^ j; if (l2 > i) CE_DESC(a[i], a[l2]); }
}
__device__ __forceinline__ void phase_topk(const KP& p, LAS unsigned char* lds, int G) {
    const int tid = opaque_tid(), lane = tid & 63, w = __builtin_amdgcn_readfirstlane(tid >> 6), hh = lane >> 5;
    const int gw = blockIdx.x * 8 + w, ngw = G * 8;
    const bf16_t* Q = (const bf16_t*)(p.ws + WS_R0); const bf16_t* KEYS = (const bf16_t*)(p.ws + WS_KEYS);
    unsigned* SEL = (unsigned*)(p.ws + WS_SEL);
    LAS unsigned char* tab = lds + w * 2048 + lane * 32;
    const int CI[50] = {0,0,0,0,0,0,0,0,0,0,0,0,0,0,0,0, 1,1,1,1,1,1,1,1, 2,2,2,2,2, 3,3,3,3, 4,4,4, 5,5, 6,6, 7,7, 8,9,10,11,12,13,14,15};
    const int CJ[50] = {0,1,2,3,4,5,6,7,8,9,10,11,12,13,14,15, 0,1,2,3,4,5,6,7, 0,1,2,3,4, 0,1,2,3, 0,1,2, 0,1, 0,1, 0,1, 0,0,0,0,0,0,0,0};
    LAS unsigned char* kimg = lds + 16384;
    for (int h = 0; h < 8; ++h) {
      __syncthreads();
#pragma unroll
      for (int i = 0; i < 8; ++i) { const int ch = tid + 512 * i, row = ch >> 4, c16 = ch & 15;
          *(LAS u32x4*)(kimg + row * 272 + c16 * 16) = *(const u32x4*)(KEYS + (size_t)(h * 256 + row) * 128 + c16 * 8); }
      __syncthreads();
      for (int tg = gw; tg < 2048; tg += ngw) {
        const int t = tg * 32 + (lane & 31);
        unsigned top[2][16];
#pragma unroll
        for (int pp = 0; pp < 2; ++pp) {
            bf16x8 qf[8];
#pragma unroll
            for (int ks = 0; ks < 8; ++ks) qf[ks] = *(const bf16x8*)(Q + ((size_t)((((tg * 8 + h) * 2 + pp) * 8 + ks) * 64 + lane)) * 8);
            const LAS unsigned char* kb = kimg + (pp * 128 + (lane & 31)) * 272 + 16 * hh;
#pragma unroll
            for (int nt = 0; nt < 4; ++nt) {
                f32x16 acc;
#pragma unroll
                for (int i = 0; i < 16; ++i) acc[i] = 0.f;
#pragma unroll
                for (int ks = 0; ks < 8; ++ks) { const bf16x8 kf = *(const LAS bf16x8*)(kb + (32 * nt) * 272 + 32 * ks);
                    acc = __builtin_amdgcn_mfma_f32_32x32x16_bf16(kf, qf[ks], acc, 0, 0, 0); }
                unsigned ky[16];
#pragma unroll
                for (int r = 0; r < 16; ++r) ky[r] = (fkey(acc[r]) & ~127u) | (unsigned)(32 * nt + (r & 3) + 8 * (r >> 2)) | (unsigned)(4 * hh);
                sort16_desc(ky);
                if (nt == 0) {
#pragma unroll
                    for (int i = 0; i < 16; ++i) top[pp][i] = ky[i];
                } else merge_top16(top[pp], ky);
            }
            unsigned other[16];
#pragma unroll
            for (int i = 0; i < 16; ++i) { const u32x2 sw_ = __builtin_amdgcn_permlane32_swap(top[pp][i], top[pp][i], false, false); other[i] = hh ? sw_[0] : sw_[1]; }
            merge_top16(top[pp], other);
        }
        float sa[16], sb[16];
#pragma unroll
        for (int i = 0; i < 16; ++i) { sa[i] = kval(top[0][i] & ~127u); sb[i] = kval(top[1][i] & ~127u); }
        unsigned c0[16], c1[16];
#pragma unroll
        for (int s = 0; s < 32; ++s) {
            unsigned key = 0u;
            if (s < 25) {
                const float v0 = sa[CI[s]] + sb[CJ[s]], v1 = sa[CI[25 + s]] + sb[CJ[25 + s]];
                const unsigned k0 = (fkey(v0) & ~255u) | (unsigned)(CI[s] * 16 + CJ[s]), k1 = (fkey(v1) & ~255u) | (unsigned)(CI[25 + s] * 16 + CJ[25 + s]);
                key = hh ? k1 : k0;
            }
            if (s < 16) c0[s] = key; else c1[s - 16] = key;
        }
        sort16_desc(c0); sort16_desc(c1); merge_top16(c0, c1);
#pragma unroll
        for (int i = 0; i < 16; ++i) { const u32x2 sw_ = __builtin_amdgcn_permlane32_swap(c0[i], c0[i], false, false); c1[i] = hh ? sw_[0] : sw_[1]; }
        merge_top16(c0, c1);
        {
            u32x4 wa, wb;
#pragma unroll
            for (int q4 = 0; q4 < 4; ++q4) {
                wa[q4] = (top[0][4 * q4] & 127u) | ((top[0][4 * q4 + 1] & 127u) << 8) | ((top[0][4 * q4 + 2] & 127u) << 16) | ((top[0][4 * q4 + 3] & 127u) << 24);
                wb[q4] = (top[1][4 * q4] & 127u) | ((top[1][4 * q4 + 1] & 127u) << 8) | ((top[1][4 * q4 + 2] & 127u) << 16) | ((top[1][4 * q4 + 3] & 127u) << 24);
            }
            *(LAS u32x4*)tab = wa; *(LAS u32x4*)(tab + 16) = wb;
        }
        float ev[16], esum = 0.f; const float vmax = kval(c0[0] & ~255u);
#pragma unroll
        for (int k = 0; k < 16; ++k) { ev[k] = __expf(kval(c0[k] & ~255u) - vmax); esum += ev[k]; }
        const float rs = 1.0f / esum;
        LDS_WAIT();
        unsigned outw[8]; const unsigned hmask = hh ? 0xffffffffu : 0u;
#pragma unroll
        for (int kk = 0; kk < 8; ++kk) {
            const unsigned key = c0[kk] ^ ((c0[kk] ^ c0[8 + kk]) & hmask); const float e = __uint_as_float(__float_as_uint(ev[kk]) ^ ((__float_as_uint(ev[kk]) ^ __float_as_uint(ev[8 + kk])) & hmask));
            const unsigned code = key & 255u, ia = tab[code >> 4], ib = tab[16 + (code & 15u)];
            outw[kk] = (pk2(0.f, e * rs) & 0xffff0000u) | (ia * 128u + ib);
        }
        u32x4* dst = (u32x4*)(SEL + (size_t)t * 128 + h * 16 + hh * 8);
        dst[0] = (u32x4){outw[0], outw[1], outw[2], outw[3]}; dst[1] = (u32x4){outw[4], outw[5], outw[6], outw[7]};
        LDS_WAIT();
      }
    }
    __syncthreads();
}

__device__ __forceinline__ void fp8x4_to_f32(unsigned w, float& a, float& b, float& c, float& d) {
    const f32x2 lo = __builtin_amdgcn_cvt_pk_f32_fp8((int)w, false), hi = __builtin_amdgcn_cvt_pk_f32_fp8((int)w, true); a = lo[0]; b = lo[1]; c = hi[0]; d = hi[1];
}
struct XSlice { int sl, rank, nloc; };
__device__ __forceinline__ XSlice xslice_of_block(const KP& p, volatile LAS unsigned* MISC, int G) {
    unsigned* bar = (unsigned*)(p.ws + WS_CTL) + 4096; unsigned cnt[8]; unsigned tot = 0; bool ok = true;
#pragma unroll
    for (int j = 0; j < 8; ++j) { cnt[j] = xb_ld(&bar[XB_XCNT(j)]); tot += cnt[j]; ok = ok && (cnt[j] > 0u); }
    ok = ok && (tot == (unsigned)G);
    XSlice x;
    if (ok) { const unsigned myx = MISC[16]; x.sl = (int)myx; x.rank = (int)MISC[17]; x.nloc = (int)cnt[myx & 7u]; }
    else { x.sl = (int)(blockIdx.x & 7); x.rank = (int)(blockIdx.x >> 3); x.nloc = (G - x.sl + 7) >> 3; }
    x.sl = __builtin_amdgcn_readfirstlane(x.sl); x.rank = __builtin_amdgcn_readfirstlane(x.rank); x.nloc = __builtin_amdgcn_readfirstlane(x.nloc);
    return x;
}
__device__ __forceinline__ float dot16_fp8(const u32x4 u, const float (&hf)[16]) {
    float d = 0.f;
#pragma unroll
    for (int j = 0; j < 4; ++j) { float f0, f1, f2, f3; fp8x4_to_f32(u[j], f0, f1, f2, f3);
        d = __builtin_fmaf(f0, hf[4 * j], d); d = __builtin_fmaf(f1, hf[4 * j + 1], d); d = __builtin_fmaf(f2, hf[4 * j + 2], d); d = __builtin_fmaf(f3, hf[4 * j + 3], d); }
    return d;
}
typedef __bf16 bf16v8 __attribute__((ext_vector_type(8)));
__device__ __forceinline__ float dot16_fp8_bf16(const u32x4 u, const bf16v8 h0, const bf16v8 h1) {
    float d0 = 0.f, d1 = 0.f;
    d0 = __builtin_amdgcn_fdot2_f32_bf16(__builtin_amdgcn_cvt_scalef32_pk_bf16_fp8(u[0], 1.0f, false), __builtin_shufflevector(h0, h0, 0, 1), d0, false);
    d1 = __builtin_amdgcn_fdot2_f32_bf16(__builtin_amdgcn_cvt_scalef32_pk_bf16_fp8(u[0], 1.0f, true),  __builtin_shufflevector(h0, h0, 2, 3), d1, false);
    d0 = __builtin_amdgcn_fdot2_f32_bf16(__builtin_amdgcn_cvt_scalef32_pk_bf16_fp8(u[1], 1.0f, false), __builtin_shufflevector(h0, h0, 4, 5), d0, false);
    d1 = __builtin_amdgcn_fdot2_f32_bf16(__builtin_amdgcn_cvt_scalef32_pk_bf16_fp8(u[1], 1.0f, true),  __builtin_shufflevector(h0, h0, 6, 7), d1, false);
    d0 = __builtin_amdgcn_fdot2_f32_bf16(__builtin_amdgcn_cvt_scalef32_pk_bf16_fp8(u[2], 1.0f, false), __builtin_shufflevector(h1, h1, 0, 1), d0, false);
    d1 = __builtin_amdgcn_fdot2_f32_bf16(__builtin_amdgcn_cvt_scalef32_pk_bf16_fp8(u[2], 1.0f, true),  __builtin_shufflevector(h1, h1, 2, 3), d1, false);
    d0 = __builtin_amdgcn_fdot2_f32_bf16(__builtin_amdgcn_cvt_scalef32_pk_bf16_fp8(u[3], 1.0f, false), __builtin_shufflevector(h1, h1, 4, 5), d0, false);
    d1 = __builtin_amdgcn_fdot2_f32_bf16(__builtin_amdgcn_cvt_scalef32_pk_bf16_fp8(u[3], 1.0f, true),  __builtin_shufflevector(h1, h1, 6, 7), d1, false);
    return d0 + d1;
}
__device__ __forceinline__ float dpp_sum8(float d) {
    d += __uint_as_float(__builtin_amdgcn_update_dpp(0, __float_as_uint(d), 0xB1, 0xF, 0xF, true));
    d += __uint_as_float(__builtin_amdgcn_update_dpp(0, __float_as_uint(d), 0x4E, 0xF, 0xF, true));
    d += __uint_as_float(__builtin_amdgcn_update_dpp(0, __float_as_uint(d), 0x141, 0xF, 0xF, true));
    return d;
}
__device__ __forceinline__ void phase_expert_u(const KP& p, LAS unsigned char* lds, volatile LAS unsigned* MISC, int l, int G) {
    const int tid = opaque_tid(), lane = tid & 63, w = __builtin_amdgcn_readfirstlane(tid >> 6), j = lane >> 3, c = lane & 7, i16 = lane & 15, kq = lane >> 4;
    const XSlice xs = xslice_of_block(p, MISC, G);
    const unsigned char* XF = p.ws + WS_XF8 + (size_t)xs.sl * M * 128; const unsigned char* Us = p.ws + WS_U + (size_t)(l & 1) * TAB_BYTES + (size_t)xs.sl * 16384 * 128;
    const unsigned* SEL = (const unsigned*)(p.ws + WS_SEL); unsigned* PDu = (unsigned*)(p.ws + WS_R0) + (size_t)xs.sl * M * 64;
    const int t0 = xs.rank * 8 + w, tstep = xs.nloc * 8;
    LAS unsigned char* ring = lds + w * 18176;
    LAS unsigned char* selb = ring + 16384; LAS unsigned char* hbuf = ring + 16384 + 1024; LAS unsigned char* pdscr = ring + 16384 + 1024 + 512;
    const int tlast = t0 + ((M - 1 - t0) / tstep) * tstep;
    const int ai = (int)((0x5172023724663367ull >> (4 * i16)) & 7ull);
    const int ch0 = (ai ^ (2 * kq)) & 7, ch1 = ch0 ^ 1;
    const int rowoff = (i16 >> 3) * 1024 + (i16 & 7) * 128;
    const bool diag = kq == (i16 >> 2);
    LAS unsigned short* pdw = (LAS unsigned short*)pdscr + 16 * (i16 & 7) + (i16 >> 3);
#define E1_CL(t) ((t) <= tlast ? (t) : tlast)
#define E1_DMA_SEL(t, par) do { const unsigned* sp = SEL + (size_t)E1_CL(t) * 128 + lane; \
            __builtin_amdgcn_global_load_lds(sp, (LAS unsigned*)(selb + (par) * 512), 4, 0, 0); __builtin_amdgcn_global_load_lds(sp + 64, (LAS unsigned*)(selb + (par) * 512 + 256), 4, 0, 0); } while (0)
#define E1_DMA_H(t, par) do { __builtin_amdgcn_global_load_lds((const unsigned*)(XF + (size_t)E1_CL(t) * 128) + lane, (LAS unsigned*)(hbuf + (par) * 256), 4, 0, 0); } while (0)
#define E1_DMA_ROW(i, idxv) do { __builtin_amdgcn_global_load_lds((const unsigned*)(Us + (size_t)((idxv) & 0x3fffu) * 128 + 16 * c), (LAS unsigned*)(ring + (i) * 1024), 16, 0, 0); } while (0)
    if (t0 < M) {
        E1_DMA_SEL(t0, 0); E1_DMA_SEL(t0 + tstep, 1); E1_DMA_H(t0, 0);
        asm volatile("s_waitcnt vmcnt(0)" ::: "memory");
        { u32x4 s0[4];
#pragma unroll
          for (int q = 0; q < 4; ++q) s0[q] = *(const LAS u32x4*)(selb + (16 * j + 4 * q) * 4);
#pragma unroll
          for (int i = 0; i < 16; ++i) E1_DMA_ROW(i, s0[i >> 2][i & 3]); }
        { PDu[(size_t)t0 * 64 + lane] = 0u; }
        int par = 0;
        for (int tok = t0; tok < M; tok += tstep, par ^= 1) {
            E1_DMA_SEL(tok + 2 * tstep, par); E1_DMA_H(tok + tstep, par ^ 1);
            asm volatile("s_waitcnt vmcnt(19)" ::: "memory");
            u32x4 sn[4];
#pragma unroll
            for (int q = 0; q < 4; ++q) sn[q] = *(const LAS u32x4*)(selb + (par ^ 1) * 512 + (16 * j + 4 * q) * 4);
            const i32x4 xb0 = *(const LAS i32x4*)(hbuf + par * 256 + 16 * ch0), xb1 = *(const LAS i32x4*)(hbuf + par * 256 + 16 * ch1);
            const i32x8 B = __builtin_shufflevector(xb0, xb1, 0, 1, 2, 3, 4, 5, 6, 7);
#pragma unroll
            for (int i0 = 0; i0 < 16; i0 += 4) {
                asm volatile("s_waitcnt vmcnt(16)" ::: "memory");
                const LAS unsigned char* rb = ring + i0 * 1024 + rowoff;
                const i32x4 a0 = *(const LAS i32x4*)(rb + 16 * ch0), a1 = *(const LAS i32x4*)(rb + 16 * ch1), a2 = *(const LAS i32x4*)(rb + 2048 + 16 * ch0), a3 = *(const LAS i32x4*)(rb + 2048 + 16 * ch1);
                asm volatile("s_waitcnt lgkmcnt(0)" ::: "memory");
#pragma unroll
                for (int r = 0; r < 4; ++r) E1_DMA_ROW(i0 + r, sn[(i0 + r) >> 2][(i0 + r) & 3]);
                const f32x4 z = {0.f, 0.f, 0.f, 0.f};
                const f32x4 d0 = __builtin_amdgcn_mfma_scale_f32_16x16x128_f8f6f4(__builtin_shufflevector(a0, a1, 0, 1, 2, 3, 4, 5, 6, 7), B, z, 0, 0, 0, 0x7f7f7f7f, 0, 0x7f7f7f7f);
                const f32x4 d1 = __builtin_amdgcn_mfma_scale_f32_16x16x128_f8f6f4(__builtin_shufflevector(a2, a3, 0, 1, 2, 3, 4, 5, 6, 7), B, z, 0, 0, 0, 0x7f7f7f7f, 0, 0x7f7f7f7f);
                const float v0 = (i16 & 2) ? ((i16 & 1) ? d0[3] : d0[2]) : ((i16 & 1) ? d0[1] : d0[0]), v1 = (i16 & 2) ? ((i16 & 1) ? d1[3] : d1[2]) : ((i16 & 1) ? d1[1] : d1[0]);
                if (diag) { pdw[i0] = (unsigned short)(pk2(v0, 0.f) & 0xffffu); pdw[i0 + 2] = (unsigned short)(pk2(v1, 0.f) & 0xffffu); }
            }
            asm volatile("s_waitcnt lgkmcnt(0)" ::: "memory");
            PDu[(size_t)tok * 64 + lane] = *(const LAS unsigned*)(pdscr + 4 * lane);
        }
        asm volatile("s_waitcnt vmcnt(0)" ::: "memory");
    }
#undef E1_CL
#undef E1_DMA_SEL
#undef E1_DMA_H
#undef E1_DMA_ROW
}
__device__ __forceinline__ void phase_expert_w(const KP& p, int G) {
    const int tid = opaque_tid(), lane = tid & 63, w = __builtin_amdgcn_readfirstlane(tid >> 6);
    const int gw = blockIdx.x * 8 + w, ngw = G * 8;
    unsigned* SEL = (unsigned*)(p.ws + WS_SEL); const unsigned* PDu = (const unsigned*)(p.ws + WS_R0);
    for (int tok0 = gw; tok0 < M; tok0 += 4 * ngw) {
        unsigned pw[4][8]; u32x2 s2[4];
#pragma unroll
        for (int k = 0; k < 4; ++k) { const int tok = (tok0 + k * ngw < M) ? tok0 + k * ngw : tok0;
#pragma unroll
            for (int sl = 0; sl < 8; ++sl) pw[k][sl] = PDu[((size_t)sl * M + tok) * 64 + lane];
            s2[k] = *(const u32x2*)(SEL + (size_t)tok * 128 + 2 * lane); }
#pragma unroll
        for (int k = 0; k < 4; ++k) { const int tok = tok0 + k * ngw;
            f32x2 d = {0.f, 0.f};
#pragma unroll
            for (int sl = 0; sl < 8; ++sl) { d[0] += bflo(pw[k][sl]); d[1] += bfhi(pw[k][sl]); }
            const float w0 = __uint_as_float(s2[k][0] & 0xffff0000u) * fgelu(d[0] * (1.0f / (U_SCALE * X_SCALE))) * (1.0f / V_SCALE);
            const float w1 = __uint_as_float(s2[k][1] & 0xffff0000u) * fgelu(d[1] * (1.0f / (U_SCALE * X_SCALE))) * (1.0f / V_SCALE);
            u32x2 o; o[0] = (pk2(0.f, w0) & 0xffff0000u) | (s2[k][0] & 0x3fffu); o[1] = (pk2(0.f, w1) & 0xffff0000u) | (s2[k][1] & 0x3fffu);
            if (tok < M) { *(u32x2*)(SEL + (size_t)tok * 128 + 2 * lane) = o;
                const int wq = __builtin_amdgcn_cvt_pk_fp8_f32(w0 * W8_SCALE, w1 * W8_SCALE, 0, false); const int s_ = (2 * lane) & 15, q_ = lane >> 3;
                unsigned char* wf = p.ws + WS_WF8 + (size_t)tok * 128 + 32 * (s_ >> 2) + 8 * (s_ & 3) + q_; wf[0] = (unsigned char)(wq & 255); wf[8] = (unsigned char)((wq >> 8) & 255); } }
    }
}
__device__ __forceinline__ void phase_expert_v(const KP& p, LAS unsigned char* lds, volatile LAS unsigned* MISC, int l, int G) {
    const int tid = opaque_tid(), lane = tid & 63, w = __builtin_amdgcn_readfirstlane(tid >> 6), j = lane >> 3, c = lane & 7, li = lane & 15, g = lane >> 4;
    const XSlice xs = xslice_of_block(p, MISC, G);
    const unsigned char* Vs = p.ws + WS_V + (size_t)(l & 1) * TAB_BYTES + (size_t)xs.sl * 16384 * 128;
    const unsigned* SEL = (const unsigned*)(p.ws + WS_SEL); const unsigned char* WF = p.ws + WS_WF8;
    const float* g2 = (const float*)(p.ws + WS_MOD) + (size_t)l * 32 * NMODC + 5120;
    const bf16_t* X = (const bf16_t*)p.out; bf16_t* XO = (l == DEPTH - 1) ? (bf16_t*)(p.ws + WS_YS) : (bf16_t*)p.out;
    const int t0 = xs.rank * 8 + w, tstep = xs.nloc * 8;
    LAS unsigned char* ring = lds + w * 19712; LAS unsigned char* selb = ring + 16384;
    LAS unsigned char* xbuf = ring + 16384 + 1024;
    LAS unsigned char* wbuf = ring + 16384 + 1024 + 512;
    LAS float* obuf = (LAS float*)(ring + 16384 + 1024 + 1024);
    const int tlast = t0 + ((M - 1 - t0) / tstep) * tstep;
    int troff[8];
#pragma unroll
    for (int n = 0; n < 8; ++n) troff[n] = (li >> 1) * 128 + 16 * (n ^ (li >> 1) ^ (g & 1)) + 8 * (li & 1);
    const int dim = xs.sl * 128 + 2 * lane;
#define E2_CL(t) ((t) <= tlast ? (t) : tlast)
#define E2_DMA_SEL(t, par) do { const unsigned* sp = SEL + (size_t)E2_CL(t) * 128 + lane; \
            __builtin_amdgcn_global_load_lds(sp, (LAS unsigned*)(selb + (par) * 512), 4, 0, 0); __builtin_amdgcn_global_load_lds(sp + 64, (LAS unsigned*)(selb + (par) * 512 + 256), 4, 0, 0); } while (0)
#define E2_DMA_WF(t, par) __builtin_amdgcn_global_load_lds((const unsigned*)(WF + (size_t)E2_CL(t) * 128) + lane, (LAS unsigned*)(wbuf + (par) * 256), 4, 0, 0)
#define E2_DMA_ROW(s_, idxv) do { __builtin_amdgcn_global_load_lds((const unsigned*)(Vs + (size_t)((idxv) & 0x3fffu) * 128 + 16 * (c ^ j ^ (((s_) >> 2) & 1))), (LAS unsigned*)(ring + (s_) * 1024), 16, 0, 0); } while (0)
#define E2_SLOT(k) (4 * ((k) & 3) + ((k) >> 2))
    if (t0 < M) {
        E2_DMA_SEL(t0, 0); E2_DMA_SEL(t0 + tstep, 1); E2_DMA_WF(t0, 0);
        asm volatile("s_waitcnt vmcnt(0)" ::: "memory");
        { u32x4 sc[4];
#pragma unroll
          for (int q = 0; q < 4; ++q) sc[q] = *(const LAS u32x4*)(selb + (16 * j + 4 * q) * 4);
#pragma unroll
          for (int k = 0; k < 16; ++k) { const int s_ = E2_SLOT(k); E2_DMA_ROW(s_, sc[s_ >> 2][s_ & 3]); } }
        { __builtin_amdgcn_global_load_lds((const unsigned*)(X + (size_t)t0 * D + dim), (LAS unsigned*)xbuf, 4, 0, 0); }
        int par = 0, bcur = -1; f32x2 gv = {0.f, 0.f};
        for (int tok = t0; tok < M; tok += tstep, par ^= 1) {
            const size_t xo = (size_t)tok * D + dim;
            if ((tok >> 11) != bcur) { bcur = tok >> 11; const f32x2 gl = *(const f32x2*)(g2 + (size_t)bcur * NMODC + dim); asm volatile("s_waitcnt vmcnt(0)" ::: "memory"); gv[0] = gl[0] * (1.0f / W8_SCALE); gv[1] = gl[1] * (1.0f / W8_SCALE); asm volatile("" : "+v"(gv)); }
            E2_DMA_SEL(tok + 2 * tstep, par);
            __builtin_amdgcn_global_load_lds((const unsigned*)(X + (size_t)E2_CL(tok + tstep) * D + dim), (LAS unsigned*)(xbuf + 256 * (par ^ 1)), 4, 0, 0);
            E2_DMA_WF(tok + tstep, par ^ 1);
            asm volatile("s_waitcnt vmcnt(21)" ::: "memory");
            u32x4 sn[4];
#pragma unroll
            for (int q = 0; q < 4; ++q) sn[q] = *(const LAS u32x4*)(selb + (par ^ 1) * 512 + (16 * j + 4 * q) * 4);
            i32x8 A;
            { const i32x4 wa = *(const LAS i32x4*)(wbuf + par * 256 + 32 * g), wb = *(const LAS i32x4*)(wbuf + par * 256 + 32 * g + 16);
#pragma unroll
              for (int q = 0; q < 4; ++q) { A[q] = (li == 0) ? wa[q] : 0; A[4 + q] = (li == 0) ? wb[q] : 0; } }
            int Bm[8][8];
#pragma unroll
            for (int t = 0; t < 4; ++t) {
                asm volatile("s_waitcnt vmcnt(17)" ::: "memory");
                const LAS unsigned char* sb = ring + (4 * g + t) * 1024;
#pragma unroll
                for (int n = 0; n < 8; ++n) { const i32x2 r2_ = __builtin_amdgcn_ds_read_tr8_b64_v2i32((LAS i32x2*)(sb + troff[n])); Bm[n][2 * t] = r2_[0]; Bm[n][2 * t + 1] = r2_[1]; }
                asm volatile("s_waitcnt lgkmcnt(0)" ::: "memory");
#pragma unroll
                for (int k = 4 * t; k < 4 * t + 4; ++k) { const int s_ = E2_SLOT(k); E2_DMA_ROW(s_, sn[s_ >> 2][s_ & 3]); }
            }
#pragma unroll
            for (int n = 0; n < 8; ++n) { const f32x4 z = {0.f, 0.f, 0.f, 0.f};
                const i32x8 Bv = {Bm[n][0], Bm[n][1], Bm[n][2], Bm[n][3], Bm[n][4], Bm[n][5], Bm[n][6], Bm[n][7]};
                f32x4 d = __builtin_amdgcn_mfma_scale_f32_16x16x128_f8f6f4(A, Bv, z, 0, 0, 0, 0x7f7f7f7f, 0, 0x7f7f7f7f);
                asm volatile("" : "+v"(d));
                const float d0_ = d[0] + 0.0f;
                if (g == 0) obuf[16 * n + li] = d0_; }
            asm volatile("s_waitcnt lgkmcnt(0)" ::: "memory");
            const f32x2 ov = *(const LAS f32x2*)(obuf + 2 * lane);
            asm volatile("s_waitcnt vmcnt(16)" ::: "memory");
            { const unsigned xw = *(const LAS unsigned*)(xbuf + 256 * par + 4 * lane); *(unsigned*)(XO + xo) = pk2(bflo(xw) + gv[0] * ov[0], bfhi(xw) + gv[1] * ov[1]); }
        }
        asm volatile("s_waitcnt vmcnt(0)" ::: "memory");
    }
#undef E2_CL
#undef E2_DMA_SEL
#undef E2_DMA_WF
#undef E2_DMA_ROW
#undef E2_SLOT
}

__device__ __forceinline__ void phase_final(const KP& p, int G) {
    const int tid = opaque_tid(), lane = tid & 63, w = __builtin_amdgcn_readfirstlane(tid >> 6);
    const int gw = blockIdx.x * 8 + w, ngw = G * 8;
    const float* fg = p.in[I_FG];
    for (int r0 = gw * 4; r0 < M; r0 += ngw * 4) {
        f32x4 v[4][4]; float ss[4];
#pragma unroll
        for (int i = 0; i < 4; ++i) { const u32x2* xr = (const u32x2*)((const bf16_t*)(p.ws + WS_YS) + (size_t)(r0 + i) * D) + lane;
#pragma unroll
            for (int j = 0; j < 4; ++j) { const u32x2 xw = xr[64 * j]; v[i][j] = (f32x4){bflo(xw[0]), bfhi(xw[0]), bflo(xw[1]), bfhi(xw[1])}; } }
#pragma unroll
        for (int i = 0; i < 4; ++i) { float t = 0.f;
#pragma unroll
            for (int j = 0; j < 4; ++j) t += (v[i][j][0] * v[i][j][0] + v[i][j][1] * v[i][j][1]) + (v[i][j][2] * v[i][j][2] + v[i][j][3] * v[i][j][3]);
            ss[i] = t; }
#pragma unroll
        for (int o = 1; o < 64; o <<= 1) {
#pragma unroll
            for (int i = 0; i < 4; ++i) ss[i] += __shfl_xor(ss[i], o); }
#pragma unroll
        for (int j = 0; j < 4; ++j) { const f32x4 g4 = *(const f32x4*)(fg + 256 * j + 4 * lane);
#pragma unroll
            for (int i = 0; i < 4; ++i) { const float rstd = __builtin_amdgcn_rsqf(ss[i] * (1.0f / D) + EPS); ((f32x4*)(p.out + (size_t)(r0 + i) * D) + lane)[64 * j] = v[i][j] * rstd * g4; } }
    }
}

__global__ void __launch_bounds__(512, 2) mk_fwd(KP p_) {
    extern __shared__ __attribute__((aligned(16))) unsigned char lds_raw[];
    LAS unsigned char* lds = (LAS unsigned char*)lds_raw;
    const int tid = threadIdx.x, G = gridDim.x;
    volatile LAS unsigned* MISC = (volatile LAS unsigned*)(lds + MISC_OFF);
    for (int i = tid; i < LDS_BYTES / 4; i += 512) ((LAS unsigned*)lds)[i] = 0u;
    __syncthreads();
    XcdBarrier bar = xcd_barrier_post((unsigned*)(p_.ws + WS_CTL) + 4096, MISC + 8);
    if (tid == 0) { const unsigned myx = xb_xcc_id(); MISC[16] = myx; MISC[17] = xb_add((unsigned*)(p_.ws + WS_CTL) + 8192 + 64 * (myx & 15u), 1u); }
    __syncthreads();
    const int lo = p_.gp_lo, hi = p_.gp_hi;
#ifndef PH_MASK
#define PH_MASK 0xFFFFF
#endif
#define IN(k) (lo <= (k) && (k) < hi)
#define EN(b) ((PH_MASK >> (b)) & 1)
#ifndef PH_REPEAT
#define PH_REPEAT 0
#endif
#define NREP(b) (((PH_REPEAT >> (b)) & 1) ? 2 : 1)
#define SEAM(k) do { if ((k) + 1 < hi) xcd_barrier(bar); } while (0)
    if (EN(12) && IN(GP_SETUP)) { const KP p = load_kp(); phase_setup(p, lds, G); SEAM(GP_SETUP); }
    for (int l = 0; l < DEPTH; ++l) {
        const int g0 = 1 + l * NPH;
        if (EN(0) && IN(g0 + 0)) { _Pragma("nounroll") for (int rep = 0; rep < NREP(0); ++rep) { const KP p = load_kp(); phase_conv_norm1(p, lds, l, G); } SEAM(g0 + 0); }
        if (EN(1) && IN(g0 + 1)) { const KP p = load_kp();
            pg8::Gemm g{(const bf16_t*)(p.ws + WS_H), (const bf16_t*)(p.ws + WS_WIN), M, 3072, D / 2, D / 2, D / 2}; pg8::StaticOrder S; S.init(M, 3072, G, (int)blockIdx.x);
            pg8::EpiStoreBf16 E{(bf16_t*)(p.ws + WS_R0), 3072, 1.0f / (WIN_SCALE * HIN_SCALE)};
            _Pragma("nounroll") for (int rep = 0; rep < NREP(1); ++rep) pg8::gemm_phase<pg8::EpiStoreBf16, pg8::StaticOrder, false, true, true>(lds, g, S, E);
            SEAM(g0 + 1);
        }
        if (EN(2) && IN(g0 + 2)) { _Pragma("nounroll") for (int rep = 0; rep < NREP(2); ++rep) { const KP p = load_kp(); phase_hgrn2(p, lds, l, G); } SEAM(g0 + 2); }
        if (EN(3) && IN(g0 + 3)) { const KP p = load_kp();
            pg8::Gemm g{(const bf16_t*)(p.ws + WS_H), (const bf16_t*)(p.ws + WS_WIN) + (size_t)3072 * (D / 2), M, 4096, D / 2, D / 2, D / 2}; pg8::StaticOrder S; S.init(M, 4096, G, (int)blockIdx.x);
            pg8::EpiStoreBf16 E{(bf16_t*)(p.ws + WS_R0), 4096, 1.0f / (WIN_SCALE * HIN_SCALE)};
            _Pragma("nounroll") for (int rep = 0; rep < NREP(3); ++rep) pg8::gemm_phase<pg8::EpiStoreBf16, pg8::StaticOrder, false, true, true>(lds, g, S, E);
            SEAM(g0 + 3);
        }
        #if DBG_SELFCHECK
        if (EN(4) && IN(g0 + 4)) {
#pragma nounroll
            for (int rep = 0; rep < 2; ++rep) { const KP p = load_kp(); size_t yo = rep ? WS_H : WS_YS; asm volatile("" : "+s"(yo)); phase_s5(p, lds, l, G, yo); SEAM(g0 + 4); }
            const KP p = load_kp();
            const unsigned* a = (const unsigned*)(p.ws + WS_YS); const unsigned* b2 = (const unsigned*)(p.ws + WS_H); unsigned bad = 0;
            for (size_t i = (size_t)blockIdx.x * 512 + opaque_tid(); i < (size_t)M * D / 2; i += (size_t)G * 512) bad += (a[i] != b2[i]) ? 1u : 0u;
            if (bad) atomicAdd((unsigned*)(p.ws + WS_CTL) + 64, bad);
            { const unsigned* h1 = (const unsigned*)(p.ws + WS_CTL) + 65536; const unsigned* h2 = h1 + 8192; const int u2 = blockIdx.x * 512 + opaque_tid();
              if (u2 < 2048) { if (h1[u2 * 4] != h2[u2 * 4]) atomicAdd((unsigned*)(p.ws + WS_CTL) + 128, 1u); if (h1[u2 * 4 + 1] != h2[u2 * 4 + 1]) atomicAdd((unsigned*)(p.ws + WS_CTL) + 192, 1u); if (h1[u2 * 4 + 2] != h2[u2 * 4 + 2]) atomicAdd((unsigned*)(p.ws + WS_CTL) + 256, 1u); } }
            SEAM(g0 + 4); }
#else
        if (EN(4) && IN(g0 + 4)) { _Pragma("nounroll") for (int rep = 0; rep < NREP(4); ++rep) { const KP p = load_kp(); phase_s5(p, lds, l, G, WS_YS); } SEAM(g0 + 4); }
#endif
        if (EN(5) && IN(g0 + 5)) { const KP p = load_kp();
            pg8::Gemm g{(const bf16_t*)(p.ws + WS_YS), (const bf16_t*)(p.ws + WS_WGLU), M, D, D, D, D}; pg8::StaticOrder S; S.init(M, D, G, (int)blockIdx.x);
            pg8::EpiGlu E{(const bf16_t*)(p.ws + WS_R0), (const bf16_t*)(p.ws + WS_YS), (const bf16_t*)(p.ws + WS_OR), (const float*)(p.ws + WS_SSQ), p.in[I_HNG] + l * 128, p.in[I_GLUB] + l * D, (bf16_t*)(p.ws + WS_H)};
            _Pragma("nounroll") for (int rep = 0; rep < NREP(5); ++rep) pg8::gemm_phase<pg8::EpiGlu, pg8::StaticOrder, true, true>(lds, g, S, E);
            SEAM(g0 + 5);
        }
        if (EN(6) && IN(g0 + 6)) { const KP p = load_kp();
            pg8::Gemm g{(const bf16_t*)(p.ws + WS_H), (const bf16_t*)(p.ws + WS_WOUT), M, D, D / 2, D / 2, D / 2}; pg8::StaticOrder S; S.init(M, D, G, (int)blockIdx.x);
            pg8::EpiStoreBf16 E{(bf16_t*)(p.ws + WS_OR), D, 1.0f / (WO_SCALE * MG_SCALE)};
            pg8::gemm_phase<pg8::EpiStoreBf16, pg8::StaticOrder, false, true, true>(lds, g, S, E);
            SEAM(g0 + 6);
        }
        if (EN(7) && IN(g0 + 7)) { const KP p = load_kp();
            const int t2 = opaque_tid(), lane = t2 & 63, wave = __builtin_amdgcn_readfirstlane(t2 >> 6);
            if (l == 0) resid_norm_rows<false>(p.in[I_X], (bf16_t*)p.out, (const bf16_t*)(p.ws + WS_OR), (bf16_t*)(p.ws + WS_H), p.ws + WS_XF8, p.in[I_N2G] + l * D, (const float*)(p.ws + WS_MOD) + (size_t)l * 32 * NMODC, blockIdx.x * 8 + wave, G * 8, lane);
            else resid_norm_rows<true>(p.out, (bf16_t*)p.out, (const bf16_t*)(p.ws + WS_OR), (bf16_t*)(p.ws + WS_H), p.ws + WS_XF8, p.in[I_N2G] + l * D, (const float*)(p.ws + WS_MOD) + (size_t)l * 32 * NMODC, blockIdx.x * 8 + wave, G * 8, lane);
            SEAM(g0 + 7);
        }
        if (EN(8) && IN(g0 + 8)) { const KP p = load_kp();
            pg8::Gemm g{(const bf16_t*)(p.ws + WS_H), (const bf16_t*)(p.ws + WS_WQ), M, 2048, D, D, D}; pg8::StaticOrder S; S.init(M, 2048, G, (int)blockIdx.x);
            pg8::EpiStoreQ E{(bf16_t*)(p.ws + WS_R0)};
            _Pragma("nounroll") for (int rep = 0; rep < NREP(8); ++rep) pg8::gemm_phase<pg8::EpiStoreQ, pg8::StaticOrder, true, true>(lds, g, S, E);
            SEAM(g0 + 8);
        }
        if (EN(9) && IN(g0 + 9)) { _Pragma("nounroll") for (int rep = 0; rep < NREP(9); ++rep) { const KP p = load_kp(); phase_topk(p, lds, G); } SEAM(g0 + 9); }
        if (EN(10) && IN(g0 + 10)) {
            { const KP p = load_kp(); phase_expert_u(p, lds, MISC, l, G); } xcd_barrier(bar);
            { const KP p = load_kp(); phase_expert_w(p, G); } xcd_barrier(bar);
            { const KP p = load_kp(); phase_expert_v(p, lds, MISC, l, G); }
            SEAM(g0 + 10); }
    }
    if (EN(13) && IN(GP_FINAL)) { const KP p = load_kp(); phase_final(p, G); }
#undef IN
#undef EN
#undef NREP
#undef SEAM
}

extern "C" void kernel_launch(void* const* d_in, const int* in_sizes, int n_in, void* d_out, int out_size, void* d_ws, size_t ws_size, hipStream_t stream) {
    static int grid = 0;
    if (grid == 0) {
        if (n_in != 25 || out_size != M * D || ws_size < WS_END) { fprintf(stderr, "kernel_launch: unexpected shapes (n_in %d, out %d, ws %zu < %zu)\n", n_in, out_size, ws_size, (size_t)WS_END); grid = -1; return; }
        int dev = 0, cus = 0, per_cu = 0;
        if (hipGetDevice(&dev) != hipSuccess || hipDeviceGetAttribute(&cus, hipDeviceAttributeMultiprocessorCount, dev) != hipSuccess) { grid = -1; return; }
        if (hipFuncSetAttribute((const void*)mk_fwd, hipFuncAttributeMaxDynamicSharedMemorySize, LDS_BYTES) != hipSuccess) { fprintf(stderr, "kernel_launch: hipFuncSetAttribute failed\n"); grid = -1; return; }
        if (hipOccupancyMaxActiveBlocksPerMultiprocessor(&per_cu, (const void*)mk_fwd, 512, LDS_BYTES) != hipSuccess || per_cu < 1) fprintf(stderr, "kernel_launch: occupancy query says %d\n", per_cu);
        (void)hipGetLastError();
        grid = cus;
    }
    if (grid < 0) return;
    (void)hipMemsetAsync((char*)d_ws + WS_CTL, 0, CTL_ZERO_BYTES, stream);
    KP a{};
    for (int i = 0; i < 25; ++i) a.in[i] = (const float*)d_in[i];
    a.out = (float*)d_out; a.ws = (unsigned char*)d_ws;
#if MK_LAUNCHES == 1
    a.gp_lo = 0; a.gp_hi = GP_END;
    hipLaunchKernelGGL(mk_fwd, dim3(grid), dim3(512), LDS_BYTES, stream, a);
#else
    for (int gp = 0; gp < GP_END; ++gp) { a.gp_lo = gp; a.gp_hi = gp + 1; hipLaunchKernelGGL(mk_fwd, dim3(grid), dim3(512), LDS_BYTES, stream, a); }
#endif
}
```

```cpp
#include <hip/hip_runtime.h>
#include <cstdio>
#include <cstdint>

#define DBG_HASHSEL 0
#define DBG_H2_FROM_INPUT 0
#define DBG_NO_YA 0
#define DBG_NO_YB 0
#define DBG_NO_ACC 0
#define DBG_NO_GB 0
#define DBG_S5_NOSSM 0
#define DBG_S5_NOREC 0
#define DBG_SELFCHECK 0
#ifndef MK_LAUNCHES
#define MK_LAUNCHES 1
#endif

#define LAS __attribute__((address_space(3)))
typedef unsigned short bf16_t;
typedef short bf16x8 __attribute__((ext_vector_type(8)));
typedef float f32x2 __attribute__((ext_vector_type(2)));
typedef float f32x4 __attribute__((ext_vector_type(4)));
typedef float f32x16 __attribute__((ext_vector_type(16)));
typedef unsigned u32x2 __attribute__((ext_vector_type(2)));
typedef unsigned u32x4 __attribute__((ext_vector_type(4)));
typedef __bf16 bf16v2 __attribute__((ext_vector_type(2)));
typedef int i32x8 __attribute__((ext_vector_type(8)));
typedef int i32x4 __attribute__((ext_vector_type(4)));
typedef int i32x2 __attribute__((ext_vector_type(2)));

constexpr int D = 1024, BATCH = 32, SEQ = 2048, DEPTH = 4, M = BATCH * SEQ;
constexpr int INC = 7168, NMODC = 6 * D;
constexpr int NPH = 11, GP_SETUP = 0, GP_FINAL = 1 + DEPTH * NPH, GP_END = GP_FINAL + 1;
constexpr float EPS = 1e-6f;
constexpr float U_SCALE = 64.0f, V_SCALE = 4.0f;
constexpr size_t TAB_BYTES = (size_t)16384 * 1024;
constexpr float WIN_SCALE = 64.0f, HIN_SCALE = 4.0f;
constexpr float X_SCALE = 8.0f;
constexpr float W8_SCALE = 512.0f;
constexpr float WO_SCALE = 64.0f, MG_SCALE = 8.0f;

constexpr size_t MiB = 1u << 20;
constexpr size_t WS_CTL = 0, CTL_ZERO_BYTES = 1 * MiB;
constexpr size_t WS_MOD = 1 * MiB;
constexpr size_t WS_LB = 4 * MiB;
constexpr size_t WS_ABAR = 4 * MiB + 65536;
constexpr size_t WS_BOP = 5 * MiB;
constexpr size_t WS_COP = 6 * MiB;
constexpr size_t WS_WIN = 8 * MiB;
constexpr size_t WS_WGLU = 22 * MiB;
constexpr size_t WS_WOUT = 24 * MiB;
constexpr size_t WS_WQ = 26 * MiB;
constexpr size_t WS_KEYS = 30 * MiB;
constexpr size_t WS_U = 32 * MiB;
constexpr size_t WS_V = 64 * MiB;
constexpr size_t WS_H = 96 * MiB;
constexpr size_t WS_OR = 224 * MiB;
constexpr size_t WS_SSQ = 352 * MiB;
constexpr size_t WS_R0 = 354 * MiB;
constexpr size_t WS_SEL = WS_R0 + 256 * MiB;
constexpr size_t WS_XF8 = WS_R0 + 352 * MiB;
constexpr size_t WS_WF8 = WS_R0 + 416 * MiB;
constexpr size_t WS_YS = WS_R0 + 512 * MiB;
constexpr size_t WS_END = WS_YS + 128 * MiB;

constexpr int LDS_BYTES = 163840;
constexpr int MISC_OFF = LDS_BYTES - 256;

__device__ __forceinline__ unsigned pk2(float lo, float hi) { f32x2 v = {lo, hi}; bf16v2 r = __builtin_convertvector(v, bf16v2); return __builtin_bit_cast(unsigned, r); }
__device__ __forceinline__ float bflo(unsigned w) { return __uint_as_float(w << 16); }
__device__ __forceinline__ float bfhi(unsigned w) { return __uint_as_float(w & 0xffff0000u); }
__device__ __forceinline__ float fsigmoid(float x) { return __builtin_amdgcn_rcpf(1.0f + __expf(-x)); }
__device__ __forceinline__ float fsilu(float x) { return x * fsigmoid(x); }
__device__ __forceinline__ float fgelu(float x) { return x * fsigmoid(1.5957691216f * (x + 0.044715f * x * x * x)); }
__device__ __forceinline__ float wave_sum(float v) {
#pragma unroll
    for (int o = 1; o < 64; o <<= 1) v += __shfl_xor(v, o);
    return v;
}
#define LDS_WAIT() asm volatile("s_waitcnt lgkmcnt(0)" ::: "memory")
__device__ __forceinline__ float dpp_sum8(float d);
__device__ __forceinline__ int opaque_tid() { int t = threadIdx.x; asm volatile("" : "+v"(t)); return t; }

namespace pg8 {
#define PG8_LAS __attribute__((address_space(3)))
constexpr int BM = 256, BK = 64, HALF = 128, HTB = HALF * BK * 2, STAGE_BYTES = 8 * HTB, NXCD = 8, WGM = 8;
__host__ __device__ __forceinline__ int lds_byte(int r, int c) { const int st = (r >> 4) * 2 + (c >> 5), rr = r & 15, cc = c & 31, ob = rr * 64 + cc * 2; return st * 1024 + (ob ^ (((ob >> 9) & 1) << 5)); }
__host__ __device__ __forceinline__ void stage_rc(int b, int& R, int& C) { const int st = b / 1024, sb = b % 1024, swz = sb ^ (((sb >> 9) & 1) << 5); R = (st >> 1) * 16 + swz / 64; C = (st & 1) * 32 + (swz % 64) / 2; }
__host__ __device__ __forceinline__ int perm32(int rho) { const int n = rho >> 4, i = rho & 15; return 8 * (i >> 2) + 4 * n + (i & 3); }
struct Unit { int pm, pn; };
struct Gemm { const bf16_t* A; const bf16_t* Bt; int M, N, K, lda, ldb; };
struct StaticOrder {
    int nM, nN, nwg, G, c;
    __host__ __device__ void init(int M_, int N_, int G_, int c_) { nM = M_ / BM; nN = N_ / BM; nwg = nM * nN; G = G_; c = c_; }
    __host__ __device__ bool next(int i, Unit& u) const {
        const long L = (long)i * G + c; if (L >= nwg) return false;
        int wgid = (int)L; { const int q = nwg / NXCD, r = nwg % NXCD, xcd = wgid % NXCD, off = wgid / NXCD; wgid = (xcd < r ? xcd * (q + 1) : r * (q + 1) + (xcd - r) * q) + off; }
        const int nig = WGM * nN, gid = wgid / nig, fm = gid * WGM, gsz = (nM - fm) < WGM ? (nM - fm) : WGM;
        u.pm = fm + ((wgid % nig) % gsz); u.pn = (wgid % nig) / gsz; return true;
    }
    __device__ __forceinline__ void a_ready(const Unit&) const {}
    __device__ __forceinline__ void done(const Unit&) const {}
};
template <class Epi, class Sched, bool ALIGN_EPI = false, bool SP2 = false, bool F8 = false>
__device__ __forceinline__ void gemm_phase(PG8_LAS unsigned char* lds, const Gemm g, const Sched& S, const Epi& E) {
    const int tid = opaque_tid(), wid = __builtin_amdgcn_readfirstlane(tid >> 6), lane = tid & 63, wr = wid >> 2, wc = wid & 3, fr = lane & 15, fq = lane >> 4;
    const int K = g.K, nt = K / BK;
    unsigned voffA[2], voffB[2];
#pragma unroll
    for (int i = 0; i < 2; ++i) { int R, C; stage_rc(tid * 16 + i * 8192, R, C); const int Rb = Epi::PERM ? ((R & ~31) + perm32(R & 31)) : R;
        voffA[i] = (unsigned)(R * g.lda + C) * 2u; voffB[i] = (unsigned)(Rb * g.ldb + C) * 2u; }
    const size_t kstep = (size_t)(BK * 2);
    const size_t hstepA = (size_t)HALF * g.lda * 2, hstepB = (size_t)HALF * g.ldb * 2;
    const size_t tstepA = 2 * hstepA, tstepB = 2 * hstepB;
    const unsigned ldsw = (unsigned)wid * 1024u;
    const int aoff = lds_byte(wr * 64 + fr, fq * 8), boff = lds_byte(wc * 32 + fr, fq * 8);
#define PG8_SA(b, h) (((b) * 2 + (h)) * HTB)
#define PG8_SB(b, h) ((4 + (b) * 2 + (h)) * HTB)
#define PG8_STAGE(bufoff, gbase, voff) do { _Pragma("unroll") for (int _i = 0; _i < 2; ++_i) \
        __builtin_amdgcn_global_load_lds((const unsigned*)((const char*)(gbase) + (voff)[_i]), (PG8_LAS unsigned*)(lds + (bufoff) + ldsw + _i * 8192), 16, 0, 0); } while (0)
#define PG8_LD8(p) __builtin_shufflevector(*(const PG8_LAS i32x4*)(p), *(const PG8_LAS i32x4*)((p) + 1024), 0, 1, 2, 3, 4, 5, 6, 7)
#define PG8_LDA(dst, b, h) do { if constexpr (F8) { _Pragma("unroll") for (int m = 0; m < 4; ++m) dst##8[m] = PG8_LD8(lds + PG8_SA(b, h) + aoff + m * 2048); } \
        else { _Pragma("unroll") for (int m = 0; m < 4; ++m) _Pragma("unroll") for (int k = 0; k < 2; ++k) dst[m][k] = *(const PG8_LAS bf16x8*)(lds + PG8_SA(b, h) + aoff + m * 2048 + k * 1024); } } while (0)
#define PG8_LDB(dst, b, h) do { if constexpr (F8) { _Pragma("unroll") for (int n = 0; n < 2; ++n) dst##8[n] = PG8_LD8(lds + PG8_SB(b, h) + boff + n * 2048); } \
        else { _Pragma("unroll") for (int n = 0; n < 2; ++n) _Pragma("unroll") for (int k = 0; k < 2; ++k) dst[n][k] = *(const PG8_LAS bf16x8*)(lds + PG8_SB(b, h) + boff + n * 2048 + k * 1024); } } while (0)
#define PG8_MMA(ai, bj, At, Bt) do { __builtin_amdgcn_s_setprio(1); _Pragma("unroll") for (int m = 0; m < 4; ++m) _Pragma("unroll") for (int n = 0; n < 2; ++n) { \
        if constexpr (F8) {   \
            acc[ai][bj][m][n] = __builtin_amdgcn_mfma_scale_f32_16x16x128_f8f6f4(Bt##8[n], At##8[m], acc[ai][bj][m][n], 0, 0, 0, 0x7f7f7f7f, 0, 0x7f7f7f7f); \
        } else { _Pragma("unroll") for (int k = 0; k < 2; ++k) acc[ai][bj][m][n] = __builtin_amdgcn_mfma_f32_16x16x32_bf16(Bt[n][k], At[m][k], acc[ai][bj][m][n], 0, 0, 0); } } \
        __builtin_amdgcn_s_setprio(0); } while (0)
#define PG8_WAIT_V(n) asm volatile("s_waitcnt vmcnt(" #n ")" ::: "memory")
#define PG8_WAIT_L(n) asm volatile("s_waitcnt lgkmcnt(" #n ")" ::: "memory")
#define PG8_BAR __builtin_amdgcn_s_barrier()
#define PG8_SCHED __builtin_amdgcn_sched_barrier(0)
    Unit cur, nxt; int ui = 0;
    if (!S.next(0, cur)) return;
    f32x4 acc[2][2][4][2];
#pragma unroll
    for (int a = 0; a < 2; ++a)
#pragma unroll
        for (int b = 0; b < 2; ++b)
#pragma unroll
            for (int m = 0; m < 4; ++m)
#pragma unroll
                for (int n = 0; n < 2; ++n) acc[a][b][m][n] = (f32x4){0.f, 0.f, 0.f, 0.f};
    bf16x8 At[4][2], B0[2][2], B1[2][2]; i32x8 At8[4], B08[2], B18[2];
    const char* cA = (const char*)g.A + (size_t)cur.pm * tstepA; const char* cB = (const char*)g.Bt + (size_t)cur.pn * tstepB;
    S.a_ready(cur);
    if constexpr (SP2) {
        PG8_STAGE(PG8_SB(0, 0), cB, voffB); PG8_STAGE(PG8_SB(0, 1), cB + hstepB, voffB); PG8_STAGE(PG8_SA(0, 0), cA, voffA); PG8_STAGE(PG8_SA(0, 1), cA + hstepA, voffA);
        if (wr == 1) PG8_BAR;
        PG8_WAIT_V(2); PG8_BAR;
        PG8_STAGE(PG8_SB(1, 0), cB + kstep, voffB); PG8_STAGE(PG8_SA(1, 0), cA + kstep, voffA); PG8_STAGE(PG8_SB(1, 1), cB + hstepB + kstep, voffB);
        PG8_WAIT_V(6); PG8_BAR;
    } else {
        PG8_STAGE(PG8_SB(0, 0), cB, voffB); PG8_STAGE(PG8_SA(0, 0), cA, voffA); PG8_STAGE(PG8_SB(0, 1), cB + hstepB, voffB); PG8_STAGE(PG8_SA(0, 1), cA + hstepA, voffA);
        if (wr == 1) PG8_BAR;
        PG8_WAIT_V(4); PG8_BAR;
        PG8_STAGE(PG8_SB(1, 0), cB + kstep, voffB); PG8_STAGE(PG8_SA(1, 0), cA + kstep, voffA); PG8_STAGE(PG8_SB(1, 1), cB + hstepB + kstep, voffB);
        PG8_WAIT_V(6); PG8_BAR;
    }
    for (;;) {
        const bool has_next = S.next(ui + 1, nxt);
        const char* nA = has_next ? (const char*)g.A + (size_t)nxt.pm * tstepA : cA; const char* nB = has_next ? (const char*)g.Bt + (size_t)nxt.pn * tstepB : cB;
        for (int t = 0; t < nt; t += 2) {
            const bool last = (t == nt - 2);
            const char* a1 = cA + (size_t)(t + 1) * kstep;
            const char* a2 = last ? nA : cA + (size_t)(t + 2) * kstep; const char* b2 = last ? nB : cB + (size_t)(t + 2) * kstep;
            const char* a3 = a2 + kstep; const char* b3 = b2 + kstep;
            if (last && has_next) S.a_ready(nxt);
            if constexpr (SP2) {
            PG8_LDB(B0, 0, 0); PG8_LDB(B1, 0, 1); PG8_SCHED; PG8_LDA(At, 0, 0); PG8_STAGE(PG8_SA(1, 1), a1 + hstepA, voffA);
            PG8_WAIT_V(8); PG8_WAIT_L(0); PG8_BAR; PG8_MMA(0, 0, At, B0); PG8_MMA(0, 1, At, B1); PG8_BAR; PG8_SCHED;
            PG8_LDA(At, 0, 1); PG8_STAGE(PG8_SB(0, 0), b2, voffB); PG8_STAGE(PG8_SB(0, 1), b2 + hstepB, voffB); PG8_STAGE(PG8_SA(0, 0), a2, voffA);
            PG8_WAIT_V(8); PG8_WAIT_L(0); PG8_BAR; PG8_MMA(1, 0, At, B0); PG8_MMA(1, 1, At, B1); PG8_BAR; PG8_SCHED;
            PG8_LDB(B0, 1, 0); PG8_LDB(B1, 1, 1); PG8_SCHED; PG8_LDA(At, 1, 0); PG8_STAGE(PG8_SA(0, 1), a2 + hstepA, voffA);
            PG8_WAIT_V(8); PG8_WAIT_L(0); PG8_BAR; PG8_MMA(0, 0, At, B0); PG8_MMA(0, 1, At, B1); PG8_BAR; PG8_SCHED;
            PG8_LDA(At, 1, 1); PG8_STAGE(PG8_SB(1, 0), b3, voffB); PG8_STAGE(PG8_SB(1, 1), b3 + hstepB, voffB); PG8_STAGE(PG8_SA(1, 0), a3, voffA);
            PG8_WAIT_V(8); PG8_WAIT_L(0); PG8_BAR; PG8_MMA(1, 0, At, B0); PG8_MMA(1, 1, At, B1); PG8_BAR; PG8_SCHED;
            } else {
            PG8_LDB(B0, 0, 0); PG8_SCHED; PG8_LDA(At, 0, 0); PG8_STAGE(PG8_SA(1, 1), a1 + hstepA, voffA);
            PG8_WAIT_L(8); PG8_BAR; PG8_WAIT_L(0); PG8_MMA(0, 0, At, B0); PG8_BAR; PG8_SCHED;
            PG8_LDB(B1, 0, 1); PG8_STAGE(PG8_SB(0, 0), b2, voffB);
            PG8_BAR; PG8_WAIT_L(0); PG8_MMA(0, 1, At, B1); PG8_BAR;
            PG8_LDA(At, 0, 1); PG8_STAGE(PG8_SA(0, 0), a2, voffA);
            PG8_BAR; PG8_WAIT_L(0); PG8_MMA(1, 0, At, B0); PG8_BAR; PG8_SCHED;
            PG8_STAGE(PG8_SB(0, 1), b2 + hstepB, voffB);
            PG8_WAIT_V(6); PG8_BAR; PG8_MMA(1, 1, At, B1); PG8_BAR;
            PG8_LDB(B0, 1, 0); PG8_SCHED; PG8_LDA(At, 1, 0); PG8_STAGE(PG8_SA(0, 1), a2 + hstepA, voffA);
            PG8_WAIT_L(8); PG8_BAR; PG8_WAIT_L(0); PG8_MMA(0, 0, At, B0); PG8_BAR; PG8_SCHED;
            PG8_LDB(B1, 1, 1); PG8_STAGE(PG8_SB(1, 0), b3, voffB);
            PG8_BAR; PG8_WAIT_L(0); PG8_MMA(0, 1, At, B1); PG8_BAR;
            PG8_LDA(At, 1, 1); PG8_STAGE(PG8_SA(1, 0), a3, voffA);
            PG8_BAR; PG8_WAIT_L(0); PG8_MMA(1, 0, At, B0); PG8_BAR; PG8_SCHED;
            PG8_STAGE(PG8_SB(1, 1), b3 + hstepB, voffB);
            PG8_WAIT_V(6); PG8_BAR; PG8_MMA(1, 1, At, B1); PG8_BAR;
            }
        }
        if constexpr (ALIGN_EPI) { if (wr == 0) PG8_BAR; }
        E(acc, cur, wr, wc, fr, fq);
        if (!has_next) break;
#pragma unroll
        for (int a = 0; a < 2; ++a)
#pragma unroll
            for (int b = 0; b < 2; ++b)
#pragma unroll
                for (int m = 0; m < 4; ++m)
#pragma unroll
                    for (int n = 0; n < 2; ++n) acc[a][b][m][n] = (f32x4){0.f, 0.f, 0.f, 0.f};
        cur = nxt; cA = nA; cB = nB; ++ui;
        if constexpr (ALIGN_EPI) { if (wr == 1) PG8_BAR; }
    }
    PG8_WAIT_V(0);
    if constexpr (!ALIGN_EPI) { if (wr == 0) PG8_BAR; }
    PG8_BAR;
#undef PG8_SA
#undef PG8_SB
#undef PG8_STAGE
#undef PG8_LDA
#undef PG8_LD8
#undef PG8_LDB
#undef PG8_MMA
#undef PG8_WAIT_V
#undef PG8_WAIT_L
#undef PG8_BAR
#undef PG8_SCHED
}

struct EpiStoreBf16 {
    static constexpr bool PERM = true;
    bf16_t* O; int ldc; float scale;
    __device__ __forceinline__ void operator()(const f32x4 (&acc)[2][2][4][2], const Unit& u, int wr, int wc, int fr, int fq) const {
        const int row0 = u.pm * BM + wr * 64 + fr, col0 = u.pn * BM + wc * 32 + 8 * fq;
#pragma unroll
        for (int ai = 0; ai < 2; ++ai)
#pragma unroll
            for (int m = 0; m < 4; ++m) { bf16_t* rowp = O + (size_t)(row0 + ai * HALF + m * 16) * ldc + col0;
#pragma unroll
                for (int bj = 0; bj < 2; ++bj) { const f32x4 v0 = acc[ai][bj][m][0] * scale, v1 = acc[ai][bj][m][1] * scale;
                    u32x4 w; w.x = pk2(v0[0], v0[1]); w.y = pk2(v0[2], v0[3]); w.z = pk2(v1[0], v1[1]); w.w = pk2(v1[2], v1[3]);
                    *(u32x4*)(rowp + bj * HALF) = w; } }
    }
};
struct EpiStoreQ {
    static constexpr bool PERM = true;
    bf16_t* O;
    __device__ __forceinline__ void operator()(const f32x4 (&acc)[2][2][4][2], const Unit& u, int wr, int wc, int fr, int fq) const {
        const int row0 = u.pm * BM + wr * 64 + fr, col0 = u.pn * BM + wc * 32 + 8 * fq;
#pragma unroll
        for (int ai = 0; ai < 2; ++ai)
#pragma unroll
            for (int m = 0; m < 4; ++m) { const int row = row0 + ai * HALF + m * 16, tg = row >> 5, t = row & 31;
#pragma unroll
                for (int bj = 0; bj < 2; ++bj) { const int c0 = col0 + bj * HALF, h = c0 >> 8, pp = (c0 >> 7) & 1, cc = c0 & 127, ks = cc >> 4, hh = (cc >> 3) & 1;
                    const f32x4 v0 = acc[ai][bj][m][0], v1 = acc[ai][bj][m][1];
                    u32x4 w; w.x = pk2(v0[0], v0[1]); w.y = pk2(v0[2], v0[3]); w.z = pk2(v1[0], v1[1]); w.w = pk2(v1[2], v1[3]);
                    *(u32x4*)(O + ((size_t)((((tg * 8 + h) * 2 + pp) * 8 + ks) * 64 + hh * 32 + t)) * 8) = w; } }
    }
};
struct EpiWout {
    static constexpr bool PERM = false;
    const float* xs; float* out; const float* g1;
    __device__ __forceinline__ void operator()(const f32x4 (&acc)[2][2][4][2], const Unit& u, int wr, int wc, int fr, int fq) const {
        const int row0 = u.pm * BM + wr * 64 + fr, col0 = u.pn * BM + wc * 32 + 4 * fq;
        const int b = (u.pm * BM) >> 11;
        f32x4 gv[2][2];
#pragma unroll
        for (int bj = 0; bj < 2; ++bj)
#pragma unroll
            for (int n = 0; n < 2; ++n) gv[bj][n] = *(const f32x4*)(g1 + (size_t)b * NMODC + col0 + bj * HALF + n * 16);
#pragma unroll
        for (int ai = 0; ai < 2; ++ai)
#pragma unroll
            for (int m = 0; m < 4; ++m) { const size_t off = (size_t)(row0 + ai * HALF + m * 16) * D + col0;
#pragma unroll
                for (int bj = 0; bj < 2; ++bj)
#pragma unroll
                    for (int n = 0; n < 2; ++n) { const f32x4 xv = *(const f32x4*)(xs + off + bj * HALF + n * 16);
                        *(f32x4*)(out + off + bj * HALF + n * 16) = xv + gv[bj][n] * acc[ai][bj][m][n]; } }
    }
};
struct EpiGlu {
    static constexpr bool PERM = true;
    const bf16_t* PB; const bf16_t* YS; const bf16_t* ORAW; const float* SSQ; const float* ng; const float* gb_; bf16_t* O;
    __device__ __forceinline__ void operator()(const f32x4 (&acc)[2][2][4][2], const Unit& u, int wr, int wc, int fr, int fq) const {
        const int row0 = u.pm * BM + wr * 64 + fr, col0 = u.pn * BM + wc * 32 + 8 * fq;
#pragma unroll
        for (int bj = 0; bj < 2; ++bj) {
            const int c = col0 + bj * HALF, head = c >> 7;
            const f32x4 n0 = *(const f32x4*)(ng + (c & 127)), n1 = *(const f32x4*)(ng + (c & 127) + 4);
            const f32x4 b0 = *(const f32x4*)(gb_ + c), b1 = *(const f32x4*)(gb_ + c + 4);
            const float ngv[8] = {n0[0], n0[1], n0[2], n0[3], n1[0], n1[1], n1[2], n1[3]};
            const float bbv[8] = {b0[0], b0[1], b0[2], b0[3], b1[0], b1[1], b1[2], b1[3]};
#pragma unroll
            for (int ai = 0; ai < 2; ++ai)
#pragma unroll
                for (int m = 0; m < 4; ++m) {
                    const int row = row0 + ai * HALF + m * 16;
                    const bf16_t* pb = PB + (size_t)row * 4096 + c;
                    const u32x4 og = *(const u32x4*)(pb), ys = *(const u32x4*)(YS + (size_t)row * D + c), ga = *(const u32x4*)(pb + 2048), gb = *(const u32x4*)(pb + 3072);
                    const u32x4 orw = *(const u32x4*)(ORAW + (size_t)row * D + c);
                    const float rstd = __builtin_amdgcn_rsqf(SSQ[(size_t)row * 8 + head] * (1.0f / 128.0f) + EPS);
                    const f32x4 a0 = acc[ai][bj][m][0], a1 = acc[ai][bj][m][1];
                    const float av[8] = {a0[0], a0[1], a0[2], a0[3], a1[0], a1[1], a1[2], a1[3]};
                    float res[8];
#pragma unroll
                    for (int j = 0; j < 8; ++j) {
                        const unsigned wog = og[j >> 1], wys = ys[j >> 1], wga = ga[j >> 1], wgb = gb[j >> 1], wor = orw[j >> 1];
                        const float fog = (j & 1) ? bfhi(wog) : bflo(wog), fys = (j & 1) ? bfhi(wys) : bflo(wys), fga = (j & 1) ? bfhi(wga) : bflo(wga),
                                    fgb = (j & 1) ? bfhi(wgb) : bflo(wgb), fo = (j & 1) ? bfhi(wor) : bflo(wor);
                        const float ea = (1.0f + __expf(-fog)) * (1.0f + __expf(-fga)), eb = (1.0f + __expf(-((DBG_NO_ACC ? 0.f : av[j]) + bbv[j]))) * (1.0f + __expf(-fgb));
                        const float ya = fo * rstd * ngv[j] * fog * __builtin_amdgcn_rcpf(ea);
                        const float yb = fys * __builtin_amdgcn_rcpf(eb);
                        res[j] = ya + yb;
                    }
                    int w0 = 0, w1 = 0;
                    w0 = __builtin_amdgcn_cvt_pk_fp8_f32(res[0] * MG_SCALE, res[1] * MG_SCALE, w0, false); w0 = __builtin_amdgcn_cvt_pk_fp8_f32(res[2] * MG_SCALE, res[3] * MG_SCALE, w0, true);
                    w1 = __builtin_amdgcn_cvt_pk_fp8_f32(res[4] * MG_SCALE, res[5] * MG_SCALE, w1, false); w1 = __builtin_amdgcn_cvt_pk_fp8_f32(res[6] * MG_SCALE, res[7] * MG_SCALE, w1, true);
                    *(u32x2*)((unsigned char*)O + (size_t)row * D + c) = (u32x2){(unsigned)w0, (unsigned)w1};
                }
        }
    }
};
}

#define XB_TMO      128
#define XB_XCNT(j)  (256  + 64 * (j))
#define XB_XSUB(j)  (1280 + 64 * (j))
#define XB_XGEN(j)  (2304 + 64 * (j))
#define XB_TOP      3328
#define XB_TOPGEN   3392
#define XCD_BAR_WORDS 3456
#define XB_SPIN_CAP (1u << 25)
__device__ __forceinline__ unsigned xb_ld(unsigned* p)              { return __hip_atomic_load(p, __ATOMIC_RELAXED, __HIP_MEMORY_SCOPE_AGENT); }
__device__ __forceinline__ unsigned xb_add(unsigned* p, unsigned v) { return __hip_atomic_fetch_add(p, v, __ATOMIC_RELAXED, __HIP_MEMORY_SCOPE_AGENT); }
__device__ __forceinline__ unsigned xb_xcc_id() { return (unsigned)__builtin_amdgcn_s_getreg((3 << 11) | 20) & 0xFu; }
#define XB_SPIN(cond, bar) do { unsigned _sp = 0; while (cond) { __builtin_amdgcn_s_sleep(1); \
    if ((++_sp & 255u) == 0u) { if (xb_ld(&(bar)[XB_TMO])) break; if (_sp > XB_SPIN_CAP) { atomicAdd(&(bar)[XB_TMO], 1u); break; } } } } while (0)
struct XcdBarrier { unsigned* bar; unsigned x; volatile LAS unsigned* st; };
__device__ __forceinline__ XcdBarrier xcd_barrier_post(unsigned* bar, volatile LAS unsigned* st) {
    XcdBarrier b; b.bar = bar; b.x = xb_xcc_id(); b.st = st;
    if (threadIdx.x == 0) (void)xb_add(&bar[XB_XCNT(b.x)], 1u);
    return b;
}
__device__ __forceinline__ void xcd_barrier_complete(unsigned* bar, unsigned x, unsigned& nloc, unsigned& nx) {
    const unsigned G = gridDim.x * gridDim.y * gridDim.z;
    unsigned sum, cnt, mine, sp = 0u;
    for (;;) {
        sum = 0u; cnt = 0u; mine = 0u;
#pragma unroll
        for (unsigned j = 0; j < 16; ++j) { const unsigned c = xb_ld(&bar[XB_XCNT(j)]); sum += c; cnt += (c > 0u) ? 1u : 0u; mine = (j == x) ? c : mine; }
        if (sum == G) break;
        __builtin_amdgcn_s_sleep(1);
        if ((++sp & 255u) == 0u) { if (xb_ld(&bar[XB_TMO])) break; if (sp > XB_SPIN_CAP) { atomicAdd(&bar[XB_TMO], 1u); break; } }
    }
    nloc = mine > 0u ? mine : 1u; nx = cnt > 0u ? cnt : 1u;
}
__device__ __forceinline__ void xcd_barrier(const XcdBarrier& b) {
    asm volatile("s_waitcnt vmcnt(0)" ::: "memory");
    __syncthreads();
    if (threadIdx.x == 0) {
        unsigned* bar = b.bar;
        __builtin_amdgcn_s_waitcnt(0);
        unsigned nloc = b.st[0], nx = b.st[1];
        if (nloc == 0u) { xcd_barrier_complete(bar, b.x, nloc, nx); b.st[0] = nloc; b.st[1] = nx; }
        const unsigned old = xb_add(&bar[XB_XSUB(b.x)], 1u);
        const unsigned gen = old / nloc;
        if (old + 1u == (gen + 1u) * nloc) {
            __builtin_amdgcn_fence(__ATOMIC_RELEASE, "agent");
            asm volatile("s_waitcnt vmcnt(0)" ::: "memory");
            const unsigned og = xb_add(&bar[XB_TOP], 1u);
            const unsigned tg = og / nx;
            if (og + 1u == (tg + 1u) * nx) xb_add(&bar[XB_TOPGEN], 1u);
            else XB_SPIN(xb_ld(&bar[XB_TOPGEN]) == tg, bar);
            __builtin_amdgcn_fence(__ATOMIC_ACQUIRE, "agent");
            xb_add(&bar[XB_XGEN(b.x)], 1u);
            asm volatile("s_waitcnt vmcnt(0)" ::: "memory");
        } else {
            XB_SPIN(xb_ld(&bar[XB_XGEN(b.x)]) == gen, bar);
            __builtin_amdgcn_fence(__ATOMIC_ACQUIRE, "agent");
            asm volatile("s_waitcnt vmcnt(0)" ::: "memory");
        }
    }
    __syncthreads();
}

struct KP { const float* in[25]; float* out; unsigned char* ws; int gp_lo, gp_hi; };
enum { I_X = 0, I_C, I_ADAW, I_ADAB, I_N1G, I_N2G, I_WIN, I_LBL, I_HNG, I_ARE, I_AIM, I_LDT, I_BRE, I_BIM, I_CRE, I_CIM, I_S5D, I_GLUW, I_GLUB, I_WOUT, I_WQ, I_SUBK, I_PU, I_PV, I_FG };

typedef const KP __attribute__((address_space(4)))* kp_cptr;
__device__ __forceinline__ KP load_kp() {
#if defined(__HIP_DEVICE_COMPILE__)
    unsigned long long a = (unsigned long long)__builtin_amdgcn_kernarg_segment_ptr(); asm volatile("" : "+s"(a)); return *(kp_cptr)a;
#else
    return KP{};
#endif
}

__device__ __forceinline__ void phase_setup(const KP& p, LAS unsigned char* lds, int G) {
    const int tid = opaque_tid();
    {
        LAS float* cact = (LAS float*)lds;
        for (int it = blockIdx.x; it < 4 * 48; it += G) {
#pragma unroll 1
            for (int i0 = 0; i0 < 64; i0 += 16) { float cv[16];
#pragma unroll
                for (int q = 0; q < 16; ++q) cv[q] = p.in[I_C][(i0 + q) * 512 + tid];
#pragma unroll
                for (int q = 0; q < 16; ++q) { const int i = (i0 + q) * 512 + tid; const int k_ = i & 1023, b_ = i >> 10; cact[k_ * 32 + ((((b_ >> 2) ^ (k_ & 7)) << 2) | (b_ & 3))] = fsilu(cv[q]); } }
            __syncthreads();
            const int l = it / 48, cb = it % 48, col = cb * 128 + (tid & 127), bg = tid >> 7;
            const float* W = p.in[I_ADAW] + (size_t)l * D * NMODC + col;
            f32x4 acc0 = {0.f, 0.f, 0.f, 0.f}, acc1 = {0.f, 0.f, 0.f, 0.f};
#pragma unroll 2
            for (int k4 = 0; k4 < 256; ++k4) {
                const float w0 = W[(size_t)(4 * k4 + 0) * NMODC], w1 = W[(size_t)(4 * k4 + 1) * NMODC], w2 = W[(size_t)(4 * k4 + 2) * NMODC], w3 = W[(size_t)(4 * k4 + 3) * NMODC];
#pragma unroll
                for (int kk = 0; kk < 4; ++kk) { const int k_ = 4 * k4 + kk; const float wv = kk == 0 ? w0 : (kk == 1 ? w1 : (kk == 2 ? w2 : w3));
                    acc0 += *(const LAS f32x4*)(cact + k_ * 32 + (((2 * bg) ^ (k_ & 7)) << 2)) * wv; acc1 += *(const LAS f32x4*)(cact + k_ * 32 + (((2 * bg + 1) ^ (k_ & 7)) << 2)) * wv; }
            }
            float* MOD = (float*)(p.ws + WS_MOD);
            const float bias = p.in[I_ADAB][l * NMODC + col];
#pragma unroll
            for (int j = 0; j < 4; ++j) { MOD[((size_t)l * 32 + 8 * bg + j) * NMODC + col] = acc0[j] + bias; MOD[((size_t)l * 32 + 8 * bg + 4 + j) * NMODC + col] = acc1[j] + bias; }
            __syncthreads();
        }
    }
    const int gtid = (G - 1 - (int)blockIdx.x) * 512 + tid;
    if (gtid < 1024) {
        const float* lg = p.in[I_LBL]; float v[4], mx = -1e30f;
#pragma unroll
        for (int l = 0; l < 4; ++l) { v[l] = lg[l * 1024 + gtid]; mx = fmaxf(mx, v[l]); }
        float s = 0.f;
#pragma unroll
        for (int l = 0; l < 4; ++l) { v[l] = __expf(v[l] - mx); s += v[l]; }
        float* LB = (float*)(p.ws + WS_LB); float cum = 0.f; const float first = v[0] / s;
#pragma unroll
        for (int l = 0; l < 4; ++l) { cum += v[l] / s; LB[l * 1024 + gtid] = (l == 0) ? 0.f : (cum - first); }
    }
    if (gtid >= 1024 && gtid < 1024 + 16384) {
        const int id = gtid - 1024, lg = id >> 6, pp = id & 63;
        const float a_re = p.in[I_ARE][id], a_im = p.in[I_AIM][id];
        const float step = expf(p.in[I_LDT][lg]);
        const float mag = expf(step * a_re), ang = step * a_im;
        const float ab_re = mag * cosf(ang), ab_im = mag * sinf(ang);
        const float den = a_re * a_re + a_im * a_im;
        const float z_re = ((ab_re - 1.0f) * a_re + ab_im * a_im) / den;
        const float z_im = (ab_im * a_re - (ab_re - 1.0f) * a_im) / den;
        float* ABAR = (float*)(p.ws + WS_ABAR); ABAR[2 * id] = ab_re; ABAR[2 * id + 1] = ab_im;
        bf16_t* BOP = (bf16_t*)(p.ws + WS_BOP); bf16_t* COP = (bf16_t*)(p.ws + WS_COP);
        const float* bre = p.in[I_BRE] + (size_t)id * 16; const float* bim = p.in[I_BIM] + (size_t)id * 16;
#pragma unroll
        for (int c = 0; c < 16; ++c) {
            const float br = bre[c], bi = bim[c];
            const float rr = z_re * br - z_im * bi, ii = z_re * bi + z_im * br;
            BOP[((size_t)lg * 128 + 2 * pp) * 16 + c] = (bf16_t)(pk2(rr, 0.f) & 0xffffu);
            BOP[((size_t)lg * 128 + 2 * pp + 1) * 16 + c] = (bf16_t)(pk2(ii, 0.f) & 0xffffu);
            const float cr = p.in[I_CRE][((size_t)lg * 16 + c) * 64 + pp], ci = p.in[I_CIM][((size_t)lg * 16 + c) * 64 + pp];
            COP[((size_t)lg * 16 + c) * 128 + 2 * pp] = (bf16_t)(pk2(cr, 0.f) & 0xffffu);
            COP[((size_t)lg * 16 + c) * 128 + 2 * pp + 1] = (bf16_t)(pk2(-ci, 0.f) & 0xffffu);
        }
    }
}

__device__ __forceinline__ void transpose_item(const float* W, int K, int N, bf16_t* WT, LAS float* scr, int item, int lane) {
    const int nblk = N / 32, kb = item / nblk, nb = item % nblk, k0 = 64 * kb, n0 = 32 * nb;
#pragma unroll 8
    for (int i = 0; i < 32; ++i) { const int kk = 2 * i + (lane >> 5); scr[kk * 33 + (lane & 31)] = W[(size_t)(k0 + kk) * N + n0 + (lane & 31)]; }
    LDS_WAIT();
    const int c = lane & 7;
#pragma unroll
    for (int j = 0; j < 4; ++j) { const int n = (lane >> 3) + 8 * j; const LAS float* s = scr + (8 * c) * 33 + n;
        u32x4 o; o.x = pk2(s[0 * 33], s[1 * 33]); o.y = pk2(s[2 * 33], s[3 * 33]); o.z = pk2(s[4 * 33], s[5 * 33]); o.w = pk2(s[6 * 33], s[7 * 33]);
        *(u32x4*)(WT + (size_t)(n0 + n) * K + k0 + 8 * c) = o; }
    LDS_WAIT();
}
__device__ __forceinline__ void cvt_f32_fp8(const float* src, unsigned char* dst, size_t n4, size_t gtid, size_t nthr, float scale) {
    for (size_t i = gtid; i < n4; i += nthr) { const f32x4 v = ((const f32x4*)src)[i] * scale; int w = 0;
        w = __builtin_amdgcn_cvt_pk_fp8_f32(v[0], v[1], w, false); w = __builtin_amdgcn_cvt_pk_fp8_f32(v[2], v[3], w, true); ((unsigned*)dst)[i] = (unsigned)w; }
}
__device__ __forceinline__ void cvt_f32_fp8_sliced(const float* src, unsigned char* dst, size_t gtid, size_t nthr, float scale) {
    for (size_t i = gtid; i < (size_t)16384 * 64; i += nthr) {
        const size_t e = i >> 6; const int sl = (int)(i & 63) >> 3, c = (int)(i & 7);
        const f32x4* sp = (const f32x4*)(src + e * 1024 + sl * 128 + c * 16); u32x4 o;
#pragma unroll
        for (int q = 0; q < 4; ++q) { const f32x4 v = sp[q] * scale; int w = 0; w = __builtin_amdgcn_cvt_pk_fp8_f32(v[0], v[1], w, false); w = __builtin_amdgcn_cvt_pk_fp8_f32(v[2], v[3], w, true); o[q] = (unsigned)w; }
        *(u32x4*)(dst + ((size_t)sl * 16384 + e) * 128 + c * 16) = o;
    }
}
__device__ __forceinline__ void transpose_item_fp8(const float* W, int K, int N, unsigned char* WT, LAS float* scr, int item, int lane, float scale) {
    const int nblk = N / 32, kb = item / nblk, nb = item % nblk, k0 = 64 * kb, n0 = 32 * nb;
#pragma unroll 8
    for (int i = 0; i < 32; ++i) { const int kk = 2 * i + (lane >> 5); scr[kk * 33 + (lane & 31)] = W[(size_t)(k0 + kk) * N + n0 + (lane & 31)]; }
    LDS_WAIT();
    const int c = lane & 7;
#pragma unroll
    for (int j = 0; j < 4; ++j) { const int n = (lane >> 3) + 8 * j; const LAS float* sp = scr + (8 * c) * 33 + n;
        int w0 = 0, w1 = 0;
        w0 = __builtin_amdgcn_cvt_pk_fp8_f32(sp[0 * 33] * scale, sp[1 * 33] * scale, w0, false); w0 = __builtin_amdgcn_cvt_pk_fp8_f32(sp[2 * 33] * scale, sp[3 * 33] * scale, w0, true);
        w1 = __builtin_amdgcn_cvt_pk_fp8_f32(sp[4 * 33] * scale, sp[5 * 33] * scale, w1, false); w1 = __builtin_amdgcn_cvt_pk_fp8_f32(sp[6 * 33] * scale, sp[7 * 33] * scale, w1, true);
        *(u32x2*)(WT + (size_t)(n0 + n) * K + k0 + 8 * c) = (u32x2){(unsigned)w0, (unsigned)w1}; }
    LDS_WAIT();
}
__device__ __forceinline__ void cvt_f32_bf16(const float* src, bf16_t* dst, size_t n4, size_t gtid, size_t nthr) {
    for (size_t i = gtid; i < n4; i += nthr) { const f32x4 v = ((const f32x4*)src)[i]; u32x2 o; o.x = pk2(v[0], v[1]); o.y = pk2(v[2], v[3]); ((u32x2*)dst)[i] = o; }
}
template <bool F8OUT, bool XBF>
__device__ __forceinline__ void norm_rows(const float* xsrc, bf16_t* hdst, const float* gain, const float* mod_l, int sh_off, int sc_off, int gw, int ngw, int lane) {
    for (int r0 = gw * 4; r0 < M; r0 += ngw * 4) {
        const int b = r0 >> 11;
        f32x4 v[4][4]; float ss[4];
#pragma unroll
        for (int i = 0; i < 4; ++i) {
            if constexpr (XBF) { const u32x2* xr = (const u32x2*)((const bf16_t*)xsrc + (size_t)(r0 + i) * D) + lane;
#pragma unroll
                for (int j = 0; j < 4; ++j) { const u32x2 xw = xr[64 * j]; v[i][j] = (f32x4){bflo(xw[0]), bfhi(xw[0]), bflo(xw[1]), bfhi(xw[1])}; } }
            else { const f32x4* xr = (const f32x4*)(xsrc + (size_t)(r0 + i) * D) + lane;
#pragma unroll
                for (int j = 0; j < 4; ++j) v[i][j] = xr[64 * j]; } }
#pragma unroll
        for (int i = 0; i < 4; ++i) { float t = 0.f;
#pragma unroll
            for (int j = 0; j < 4; ++j) t += (v[i][j][0] * v[i][j][0] + v[i][j][1] * v[i][j][1]) + (v[i][j][2] * v[i][j][2] + v[i][j][3] * v[i][j][3]);
            ss[i] = t; }
#pragma unroll
        for (int o = 1; o < 64; o <<= 1) {
#pragma unroll
            for (int i = 0; i < 4; ++i) ss[i] += __shfl_xor(ss[i], o); }
        const float* mb = mod_l + (size_t)b * NMODC;
#pragma unroll
        for (int j = 0; j < 4; ++j) { const int col = 256 * j + 4 * lane;
            const f32x4 g4 = *(const f32x4*)(gain + col), sc = *(const f32x4*)(mb + sc_off + col), sh = *(const f32x4*)(mb + sh_off + col);
            const f32x4 gs = g4 * (sc + 1.0f);
#pragma unroll
            for (int i = 0; i < 4; ++i) { const float rstd = __builtin_amdgcn_rsqf(ss[i] * (1.0f / D) + EPS);
                const f32x4 h = v[i][j] * rstd * gs + sh;
                if constexpr (F8OUT) { int w8 = 0; w8 = __builtin_amdgcn_cvt_pk_fp8_f32(h[0] * HIN_SCALE, h[1] * HIN_SCALE, w8, false); w8 = __builtin_amdgcn_cvt_pk_fp8_f32(h[2] * HIN_SCALE, h[3] * HIN_SCALE, w8, true);
                    *(unsigned*)((unsigned char*)hdst + (size_t)(r0 + i) * D + col) = (unsigned)w8; }
                else { u32x2 o; o.x = pk2(h[0], h[1]); o.y = pk2(h[2], h[3]); *(u32x2*)(hdst + (size_t)(r0 + i) * D + col) = o; } } }
    }
}
template <bool XBF>
__device__ __forceinline__ void resid_norm_rows(const float* xsrc, bf16_t* xdst, const bf16_t* delta, bf16_t* hdst, unsigned char* xf8, const float* gain, const float* mod_l, int gw, int ngw, int lane) {
    for (int r0 = gw * 4; r0 < M; r0 += ngw * 4) {
        const int b = r0 >> 11; const float* mb = mod_l + (size_t)b * NMODC;
        f32x4 v[4][4]; u32x2 dl[4][4]; float ss[4];
#pragma unroll
        for (int i = 0; i < 4; ++i) { const u32x2* dp = (const u32x2*)(delta + (size_t)(r0 + i) * D) + lane;
            if constexpr (XBF) { const u32x2* xr = (const u32x2*)((const bf16_t*)xsrc + (size_t)(r0 + i) * D) + lane;
#pragma unroll
                for (int j = 0; j < 4; ++j) { const u32x2 xw = xr[64 * j]; v[i][j] = (f32x4){bflo(xw[0]), bfhi(xw[0]), bflo(xw[1]), bfhi(xw[1])}; dl[i][j] = dp[64 * j]; } }
            else { const f32x4* xr = (const f32x4*)(xsrc + (size_t)(r0 + i) * D) + lane;
#pragma unroll
                for (int j = 0; j < 4; ++j) { v[i][j] = xr[64 * j]; dl[i][j] = dp[64 * j]; } } }
#pragma unroll
        for (int j = 0; j < 4; ++j) { const f32x4 g1 = *(const f32x4*)(mb + 2048 + 256 * j + 4 * lane);
#pragma unroll
            for (int i = 0; i < 4; ++i) { const f32x4 dv = {bflo(dl[i][j][0]), bfhi(dl[i][j][0]), bflo(dl[i][j][1]), bfhi(dl[i][j][1])}; v[i][j] = v[i][j] + g1 * dv;
                ((u32x2*)(xdst + (size_t)(r0 + i) * D) + lane)[64 * j] = (u32x2){pk2(v[i][j][0], v[i][j][1]), pk2(v[i][j][2], v[i][j][3])}; } }
#pragma unroll
        for (int i = 0; i < 4; ++i) { float t = 0.f;
#pragma unroll
            for (int j = 0; j < 4; ++j) t += (v[i][j][0] * v[i][j][0] + v[i][j][1] * v[i][j][1]) + (v[i][j][2] * v[i][j][2] + v[i][j][3] * v[i][j][3]);
            ss[i] = t; }
#pragma unroll
        for (int o = 1; o < 64; o <<= 1) {
#pragma unroll
            for (int i = 0; i < 4; ++i) ss[i] += __shfl_xor(ss[i], o); }
#pragma unroll
        for (int j = 0; j < 4; ++j) { const int col = 256 * j + 4 * lane;
            const f32x4 g4 = *(const f32x4*)(gain + col), sc = *(const f32x4*)(mb + 4096 + col), sh = *(const f32x4*)(mb + 3072 + col);
            const f32x4 gs = g4 * (sc + 1.0f);
#pragma unroll
            for (int i = 0; i < 4; ++i) { const float rstd = __builtin_amdgcn_rsqf(ss[i] * (1.0f / D) + EPS);
                const f32x4 h = v[i][j] * rstd * gs + sh; u32x2 o; o.x = pk2(h[0], h[1]); o.y = pk2(h[2], h[3]); *(u32x2*)(hdst + (size_t)(r0 + i) * D + col) = o;
                int w8 = 0; w8 = __builtin_amdgcn_cvt_pk_fp8_f32(h[0] * X_SCALE, h[1] * X_SCALE, w8, false); w8 = __builtin_amdgcn_cvt_pk_fp8_f32(h[2] * X_SCALE, h[3] * X_SCALE, w8, true);
                *(unsigned*)(xf8 + ((size_t)(col >> 7) * M + (r0 + i)) * 128 + (col & 127)) = (unsigned)w8; } }
    }
}
__device__ __forceinline__ void phase_conv_norm1(const KP& p, LAS unsigned char* lds, int l, int G) {
    const int tid = opaque_tid(), lane = tid & 63, wave = __builtin_amdgcn_readfirstlane(tid >> 6);
    const int gw = blockIdx.x * 8 + wave, ngw = G * 8;
    LAS float* scr = (LAS float*)(lds + wave * 8448);
    constexpr int I_IN = 16 * (INC / 32), I_G = 16 * 32, I_O = 16 * 32, I_Q = 16 * 64, NIT = I_IN + I_G + I_O + I_Q;
    for (int it = gw; it < NIT; it += ngw) {
        int r = it;
        if (r < I_IN) { transpose_item_fp8(p.in[I_WIN] + (size_t)l * D * INC, D, INC, p.ws + WS_WIN, scr, r, lane, WIN_SCALE); continue; } r -= I_IN;
        if (r < I_G) { transpose_item(p.in[I_GLUW] + (size_t)l * D * D, D, D, (bf16_t*)(p.ws + WS_WGLU), scr, r, lane); continue; } r -= I_G;
        if (r < I_O) { transpose_item_fp8(p.in[I_WOUT] + (size_t)l * D * D, D, D, p.ws + WS_WOUT, scr, r, lane, WO_SCALE); continue; } r -= I_O;
        transpose_item(p.in[I_WQ] + (size_t)l * D * 2048, D, 2048, (bf16_t*)(p.ws + WS_WQ), scr, r, lane);
    }
    const size_t gtid = (size_t)blockIdx.x * 512 + tid, nthr = (size_t)G * 512;
    cvt_f32_bf16(p.in[I_SUBK] + (size_t)l * 262144, (bf16_t*)(p.ws + WS_KEYS), 262144 / 4, gtid, nthr);
    if (l == 0) norm_rows<true, false>(p.in[I_X], (bf16_t*)(p.ws + WS_H), p.in[I_N1G] + l * D, (const float*)(p.ws + WS_MOD) + (size_t)l * 32 * NMODC, 0, 1024, gw, ngw, lane);
    else norm_rows<true, true>(p.out, (bf16_t*)(p.ws + WS_H), p.in[I_N1G] + l * D, (const float*)(p.ws + WS_MOD) + (size_t)l * 32 * NMODC, 0, 1024, gw, ngw, lane);
}

__device__ __forceinline__ void phase_hgrn2(const KP& p, LAS unsigned char* lds, int l, int G) {
    const int tid = opaque_tid(), lane = tid & 63, w = __builtin_amdgcn_readfirstlane(tid >> 6), fr = lane & 15, g = lane >> 4;
    constexpr int QS = 272, TS = 72;
    constexpr int OFF_QT = 0, OFF_KH = 8704, OFF_KT = 17408, OFF_VT = 26624, OFF_EREF = 35840, OFF_ELR = 36352, OFF_SEG = 36864, PBUF = 40960;
    const bf16_t* PA = (const bf16_t*)(p.ws + WS_R0);
    bf16_t* ORAW = (bf16_t*)(p.ws + WS_OR);
    const float* LB = (const float*)(p.ws + WS_LB) + l * 1024;
    for (int unit = blockIdx.x; unit < 256; unit += G) {
        const int b = unit >> 3, h = unit & 7, k0 = 2 * lane;
        const float lb0 = LB[h * 128 + k0], lb1 = LB[h * 128 + k0 + 1];
        const float om0 = 1.0f - lb0, om1 = 1.0f - lb1;
        f32x4 S[8];
#pragma unroll
        for (int kt = 0; kt < 8; ++kt) S[kt] = (f32x4){0.f, 0.f, 0.f, 0.f};
        unsigned rq[4], rf[4], rv[4];
        {
            const bf16_t* base = PA + ((size_t)b * SEQ + 4 * w) * 3072 + h * 128 + k0;
#pragma unroll
            for (int i = 0; i < 4; ++i) { rq[i] = *(const unsigned*)(base + (size_t)i * 3072); rf[i] = *(const unsigned*)(base + (size_t)i * 3072 + 1024); rv[i] = *(const unsigned*)(base + (size_t)i * 3072 + 2048); }
        }
        for (int c = 0; c < 64; ++c) {
            LAS unsigned char* base = lds + (c & 1) * PBUF;
            float cs0[4], cs1[4], qv0[4], qv1[4], kv0[4], kv1[4];
            float run0 = 0.f, run1 = 0.f;
#pragma unroll
            for (int i = 0; i < 4; ++i) {
                const float fp0 = bflo(rf[i]), fp1 = bfhi(rf[i]);
                const float s0 = fsigmoid(fp0), s1 = fsigmoid(fp1);
                run0 += __logf(lb0 + om0 * s0); run1 += __logf(lb1 + om1 * s1);
                cs0[i] = run0; cs1[i] = run1;
                kv0[i] = om0 * (1.0f - s0); kv1[i] = om1 * (1.0f - s1);
                qv0[i] = fsilu(bflo(rq[i])); qv1[i] = fsilu(bfhi(rq[i]));
            }
            *(LAS f32x2*)(base + OFF_SEG + (w * 128 + k0) * 4) = (f32x2){run0, run1};
            __syncthreads();
            float off0 = 0.f, off1 = 0.f, ref0 = 0.f, ref1 = 0.f, all0 = 0.f, all1 = 0.f;
#pragma unroll
            for (int s = 0; s < 8; ++s) { const f32x2 t2 = *(const LAS f32x2*)(base + OFF_SEG + (s * 128 + k0) * 4);
                if (s < w) { off0 += t2[0]; off1 += t2[1]; }
                if (s < 4) { ref0 += t2[0]; ref1 += t2[1]; }
                all0 += t2[0]; all1 += t2[1]; }
            float kh0[4], kh1[4];
#pragma unroll
            for (int i = 0; i < 4; ++i) {
                const float b0 = off0 + cs0[i], b1 = off1 + cs1[i];
                const float q0 = qv0[i] * __expf(b0 - ref0), q1 = qv1[i] * __expf(b1 - ref1);
                kh0[i] = kv0[i] * __expf(ref0 - b0); kh1[i] = kv1[i] * __expf(ref1 - b1);
                const int t = 4 * w + i;
                *(LAS unsigned*)(base + OFF_QT + t * QS + k0 * 2) = pk2(q0, q1);
                *(LAS unsigned*)(base + OFF_KH + t * QS + k0 * 2) = pk2(kh0[i], kh1[i]);
            }
            *(LAS u32x2*)(base + OFF_KT + k0 * TS + 8 * w) = (u32x2){pk2(kh0[0], kh0[1]), pk2(kh0[2], kh0[3])};
            *(LAS u32x2*)(base + OFF_KT + (k0 + 1) * TS + 8 * w) = (u32x2){pk2(kh1[0], kh1[1]), pk2(kh1[2], kh1[3])};
            *(LAS u32x2*)(base + OFF_VT + k0 * TS + 8 * w) = (u32x2){(rv[0] & 0xffffu) | (rv[1] << 16), (rv[2] & 0xffffu) | (rv[3] << 16)};
            *(LAS u32x2*)(base + OFF_VT + (k0 + 1) * TS + 8 * w) = (u32x2){(rv[0] >> 16) | (rv[1] & 0xffff0000u), (rv[2] >> 16) | (rv[3] & 0xffff0000u)};
            if (w == 0) {
                *(LAS f32x2*)(base + OFF_EREF + k0 * 4) = (f32x2){__expf(ref0), __expf(ref1)};
                *(LAS f32x2*)(base + OFF_ELR + k0 * 4) = (f32x2){__expf(all0 - ref0), __expf(all1 - ref1)};
            }
            __syncthreads();
            if (c + 1 < 64) {
                const bf16_t* nb = PA + ((size_t)b * SEQ + (c + 1) * 32 + 4 * w) * 3072 + h * 128 + k0;
#pragma unroll
                for (int i = 0; i < 4; ++i) { rq[i] = *(const unsigned*)(nb + (size_t)i * 3072); rf[i] = *(const unsigned*)(nb + (size_t)i * 3072 + 1024); rv[i] = *(const unsigned*)(nb + (size_t)i * 3072 + 2048); }
            }
            bf16x8 qf[2][4], kf[2][4];
#pragma unroll
            for (int tt = 0; tt < 2; ++tt)
#pragma unroll
                for (int m = 0; m < 4; ++m) {
                    const LAS unsigned char* pq = base + OFF_QT + (16 * tt + fr) * QS + (32 * m + 4 * g) * 2;
                    const u32x2 lo = *(const LAS u32x2*)pq, hi = *(const LAS u32x2*)(pq + 32);
                    qf[tt][m] = __builtin_bit_cast(bf16x8, (u32x4){lo[0], lo[1], hi[0], hi[1]});
                    const LAS unsigned char* pk = base + OFF_KH + (16 * tt + fr) * QS + (32 * m + 4 * g) * 2;
                    const u32x2 lo2 = *(const LAS u32x2*)pk, hi2 = *(const LAS u32x2*)(pk + 32);
                    kf[tt][m] = __builtin_bit_cast(bf16x8, (u32x4){lo2[0], lo2[1], hi2[0], hi2[1]});
                }
            f32x4 PT00 = {0.f, 0.f, 0.f, 0.f}, PT01 = {0.f, 0.f, 0.f, 0.f}, PT11 = {0.f, 0.f, 0.f, 0.f};
#pragma unroll
            for (int m = 0; m < 4; ++m) {
                PT00 = __builtin_amdgcn_mfma_f32_16x16x32_bf16(kf[0][m], qf[0][m], PT00, 0, 0, 0);
                PT01 = __builtin_amdgcn_mfma_f32_16x16x32_bf16(kf[0][m], qf[1][m], PT01, 0, 0, 0);
                PT11 = __builtin_amdgcn_mfma_f32_16x16x32_bf16(kf[1][m], qf[1][m], PT11, 0, 0, 0);
            }
#pragma unroll
            for (int r = 0; r < 4; ++r) { if (4 * g + r > fr) { PT00[r] = 0.f; PT11[r] = 0.f; } }
            const bf16x8 pa0 = __builtin_bit_cast(bf16x8, (u32x4){pk2(PT00[0], PT00[1]), pk2(PT00[2], PT00[3]), 0u, 0u});
            const bf16x8 pa1 = __builtin_bit_cast(bf16x8, (u32x4){pk2(PT01[0], PT01[1]), pk2(PT01[2], PT01[3]), pk2(PT11[0], PT11[1]), pk2(PT11[2], PT11[3])});
            const LAS unsigned char* vrow = base + OFF_VT + (16 * w + fr) * TS;
            const u32x2 vpa = *(const LAS u32x2*)(vrow + 8 * g), vpb = *(const LAS u32x2*)(vrow + 32 + 8 * g);
            const u32x2 vna = *(const LAS u32x2*)(vrow + 16 * g), vnb = *(const LAS u32x2*)(vrow + 16 * g + 8);
            const bf16x8 vperm = __builtin_bit_cast(bf16x8, (u32x4){vpa[0], vpa[1], vpb[0], vpb[1]});
            const bf16x8 vnat = __builtin_bit_cast(bf16x8, (u32x4){vna[0], vna[1], vnb[0], vnb[1]});
#pragma unroll
            for (int kt = 0; kt < 8; ++kt) { const f32x4 e = *(const LAS f32x4*)(base + OFF_EREF + (16 * kt + 4 * g) * 4); S[kt] = S[kt] * e; }
            f32x4 O0 = {0.f, 0.f, 0.f, 0.f}, O1 = {0.f, 0.f, 0.f, 0.f};
#pragma unroll
            for (int m = 0; m < 4; ++m) {
                const bf16x8 sf = __builtin_bit_cast(bf16x8, (u32x4){pk2(S[2 * m][0], S[2 * m][1]), pk2(S[2 * m][2], S[2 * m][3]), pk2(S[2 * m + 1][0], S[2 * m + 1][1]), pk2(S[2 * m + 1][2], S[2 * m + 1][3])});
                O0 = __builtin_amdgcn_mfma_f32_16x16x32_bf16(qf[0][m], sf, O0, 0, 0, 0);
                O1 = __builtin_amdgcn_mfma_f32_16x16x32_bf16(qf[1][m], sf, O1, 0, 0, 0);
            }
            O0 = __builtin_amdgcn_mfma_f32_16x16x32_bf16(pa0, vperm, O0, 0, 0, 0);
            O1 = __builtin_amdgcn_mfma_f32_16x16x32_bf16(pa1, vperm, O1, 0, 0, 0);
#pragma unroll
            for (int kt = 0; kt < 8; ++kt) {
                const LAS unsigned char* krow = base + OFF_KT + (16 * kt + fr) * TS + 16 * g;
                const u32x2 ka = *(const LAS u32x2*)krow, kb = *(const LAS u32x2*)(krow + 8);
                const bf16x8 ktf = __builtin_bit_cast(bf16x8, (u32x4){ka[0], ka[1], kb[0], kb[1]});
                S[kt] = __builtin_amdgcn_mfma_f32_16x16x32_bf16(ktf, vnat, S[kt], 0, 0, 0);
            }
#pragma unroll
            for (int kt = 0; kt < 8; ++kt) { const f32x4 e = *(const LAS f32x4*)(base + OFF_ELR + (16 * kt + 4 * g) * 4); S[kt] = S[kt] * e; }
            bf16_t* orow = ORAW + ((size_t)b * SEQ + c * 32 + 4 * g) * D + h * 128 + 16 * w + fr;
#pragma unroll
            for (int r = 0; r < 4; ++r) { orow[(size_t)r * D] = (bf16_t)(pk2(O0[r], 0.f) & 0xffffu); orow[(size_t)(16 + r) * D] = (bf16_t)(pk2(O1[r], 0.f) & 0xffffu); }
        }
        __syncthreads();
    }
}

__device__ __forceinline__ void phase_s5(const KP& p, LAS unsigned char* lds, int l, int G, size_t ys_off) {
    const int tid = opaque_tid(), lane = tid & 63, w = __builtin_amdgcn_readfirstlane(tid >> 6), fr = lane & 15, g = lane >> 4;
    const int gw = blockIdx.x * 8 + w, ngw = G * 8;
    constexpr int BUS = 132;
    LAS float* BU = (LAS float*)(lds + w * 16896);
    LAS unsigned char* XI = (LAS unsigned char*)BU;
    const bf16_t* PB = (const bf16_t*)(p.ws + WS_R0);
    const bf16x8 zero8 = {0, 0, 0, 0, 0, 0, 0, 0};
    const bf16_t* ORAWs = (const bf16_t*)(p.ws + WS_OR); float* SSQs = (float*)(p.ws + WS_SSQ);
    for (int unit = gw; unit < BATCH * 64; unit += ngw) {
        const int b = unit >> 6, grp = unit & 63, lg = l * 64 + grp;
        const bf16_t* BOP = (const bf16_t*)(p.ws + WS_BOP) + (size_t)lg * 128 * 16;
        const bf16_t* COP = (const bf16_t*)(p.ws + WS_COP) + (size_t)lg * 16 * 128;
        bf16x8 bfrag[8], cfrag[4], dfrag;
#pragma unroll
        for (int nt = 0; nt < 8; ++nt) bfrag[nt] = (g < 2) ? *(const bf16x8*)(BOP + (size_t)(16 * nt + fr) * 16 + 8 * g) : zero8;
#pragma unroll
        for (int ks = 0; ks < 4; ++ks) cfrag[ks] = DBG_S5_NOSSM ? zero8 : *(const bf16x8*)(COP + (size_t)fr * 128 + 32 * ks + 8 * g);
        {
            const unsigned dbits = pk2(p.in[I_S5D][l * 1024 + grp * 16 + fr], 0.f) & 0xffffu;
#pragma unroll
            for (int j = 0; j < 8; ++j) dfrag[j] = (g < 2 && (8 * g + j) == fr) ? (short)dbits : (short)0;
        }
        const float ar = ((const float*)(p.ws + WS_ABAR))[2 * ((size_t)lg * 64 + lane)], ai = ((const float*)(p.ws + WS_ABAR))[2 * ((size_t)lg * 64 + lane) + 1];
        const float nai = -ai; float xr = 0.f, xi = 0.f; unsigned hBU = 0u, hXI = 0u, hY = 0u;
        const bf16_t* ub = PB + ((size_t)b * SEQ) * 4096 + 1024 + grp * 16;
        bf16_t* yb_ = (bf16_t*)(p.ws + ys_off) + ((size_t)b * SEQ) * D + grp * 16;
        bf16x8 unext[2];
#pragma unroll
        for (int tt = 0; tt < 2; ++tt) unext[tt] = (g < 2) ? *(const bf16x8*)(ub + (size_t)(16 * tt + fr) * 4096 + 8 * g) : zero8;
        const bool cvt_next = true;
        const float* tsrc = ((lane < 32) ? p.in[I_PU] : p.in[I_PV]) + (size_t)l * 16384 * 1024 + 4 * (lane & 31);
        unsigned char* tdst = p.ws + ((lane < 32) ? WS_U : WS_V) + (size_t)(l & 1) * TAB_BYTES + 4 * (lane & 31);
        const float tscale = (lane < 32) ? U_SCALE : V_SCALE;
        for (int t0 = 0; t0 < SEQ; t0 += 32) {
            const int item = unit * 64 + (t0 >> 5), te = item >> 3, tsl = item & 7;
            f32x4 tv = {0.f, 0.f, 0.f, 0.f}; if (cvt_next) tv = *(const f32x4*)(tsrc + (size_t)te * 1024 + tsl * 128);
            const bool ssq_it = ((t0 >> 5) & 1) == 0; const int srow = item >> 1;
            u32x4 sa = {0u, 0u, 0u, 0u}, sc2 = {0u, 0u, 0u, 0u};
            if (ssq_it) { sa = *(const u32x4*)(ORAWs + (size_t)srow * D + 8 * lane); sc2 = *(const u32x4*)(ORAWs + (size_t)srow * D + 512 + 8 * lane); }
            bf16x8 ufrag[2];
#pragma unroll
            for (int tt = 0; tt < 2; ++tt) { ufrag[tt] = unext[tt]; if (t0 + 32 < SEQ) unext[tt] = (g < 2) ? *(const bf16x8*)(ub + (size_t)(t0 + 32 + 16 * tt + fr) * 4096 + 8 * g) : zero8; }
#pragma unroll
            for (int tt = 0; tt < 2; ++tt)
#pragma unroll
                for (int nt = 0; nt < 8; ++nt) {
                    const f32x4 a = __builtin_amdgcn_mfma_f32_16x16x32_bf16(ufrag[tt], bfrag[nt], (f32x4){0.f, 0.f, 0.f, 0.f}, 0, 0, 0);
#pragma unroll
                    for (int r = 0; r < 4; ++r) BU[(16 * tt + 4 * g + r) * BUS + 16 * nt + fr] = a[r];
                }
            LDS_WAIT();
#pragma unroll
            for (int t = 0; t < 32; ++t) {
                const f32x2 bb = *(const LAS f32x2*)(BU + t * BUS + 2 * lane); hBU += __float_as_uint(bb[0]) * 3u + __float_as_uint(bb[1]);
                float t1, t2, nr, ni;
                asm("v_fma_f32 %0, %1, %2, %3" : "=v"(t1) : "v"(nai), "v"(xi), "v"(bb[0]));
                asm("v_fma_f32 %0, %1, %2, %3" : "=v"(t2) : "v"(ai), "v"(xr), "v"(bb[1]));
                asm("v_fma_f32 %0, %1, %2, %3" : "=v"(nr) : "v"(ar), "v"(xr), "v"(t1));
                asm("v_fma_f32 %0, %1, %2, %3" : "=v"(ni) : "v"(ar), "v"(xi), "v"(t2));
                xr = nr; xi = ni;
                { const unsigned pv = pk2(nr, ni); hXI += pv; *(LAS unsigned*)(XI + t * (BUS * 4) + lane * 4) = pv; }
            }
            LDS_WAIT();
#pragma unroll
            for (int tt = 0; tt < 2; ++tt) {
                f32x4 y = {0.f, 0.f, 0.f, 0.f};
#pragma unroll
                for (int ks = 0; ks < 4; ++ks) {
                    const bf16x8 xf = *(const LAS bf16x8*)(XI + (16 * tt + fr) * (BUS * 4) + (32 * ks + 8 * g) * 2);
                    y = __builtin_amdgcn_mfma_f32_16x16x32_bf16(xf, cfrag[ks], y, 0, 0, 0);
                }
                y = __builtin_amdgcn_mfma_f32_16x16x32_bf16(ufrag[tt], dfrag, y, 0, 0, 0);
#pragma unroll
                for (int r = 0; r < 4; ++r) { const unsigned yv = pk2(fgelu(y[r]), 0.f) & 0xffffu; hY += yv * (unsigned)(r + 1); yb_[(size_t)(t0 + 16 * tt + 4 * g + r) * D + fr] = (bf16_t)yv; }
            }
            LDS_WAIT();
            if (ssq_it) { float s0 = 0.f, s1 = 0.f;
#pragma unroll
                for (int j = 0; j < 4; ++j) { const float x0 = bflo(sa[j]), x1 = bfhi(sa[j]), y0 = bflo(sc2[j]), y1 = bfhi(sc2[j]); s0 += x0 * x0 + x1 * x1; s1 += y0 * y0 + y1 * y1; }
                { s0 = dpp_sum8(s0); s1 = dpp_sum8(s1);
                  s0 += __uint_as_float(__builtin_amdgcn_update_dpp(0, __float_as_uint(s0), 0x140, 0xF, 0xF, true)); s1 += __uint_as_float(__builtin_amdgcn_update_dpp(0, __float_as_uint(s1), 0x140, 0xF, 0xF, true)); }
                if (fr == 0) { SSQs[(size_t)srow * 8 + g] = s0; SSQs[(size_t)srow * 8 + 4 + g] = s1; } }
            if (cvt_next) { int w8 = 0; w8 = __builtin_amdgcn_cvt_pk_fp8_f32(tv[0] * tscale, tv[1] * tscale, w8, false); w8 = __builtin_amdgcn_cvt_pk_fp8_f32(tv[2] * tscale, tv[3] * tscale, w8, true);
                *(unsigned*)(tdst + ((size_t)tsl * 16384 + te) * 128) = (unsigned)w8; }
        }
        if (DBG_SELFCHECK) { for (int o = 1; o < 64; o <<= 1) { hBU += __shfl_xor((int)hBU, o); hXI += __shfl_xor((int)hXI, o); hY += __shfl_xor((int)hY, o); }
            unsigned* hs = (unsigned*)(p.ws + WS_CTL) + 65536 + (ys_off == WS_YS ? 0 : 8192) + unit * 4; unsigned hA = __float_as_uint(ar) * 7u + __float_as_uint(ai); for (int o = 1; o < 64; o <<= 1) hA += __shfl_xor((int)hA, o); if (lane == 0) { hs[0] = hBU; hs[1] = hXI; hs[2] = hA; } }
    }
}

__device__ __forceinline__ unsigned fkey(float f) { const unsigned u = __float_as_uint(f); return u ^ ((unsigned)((int)u >> 31) | 0x80000000u); }
__device__ __forceinline__ float kval(unsigned k) { const unsigned u = (k & 0x80000000u) ? (k ^ 0x80000000u) : ~k; return __uint_as_float(u); }
#define CE_DESC(a, b) do { const unsigned _mx = (a) > (b) ? (a) : (b), _mn = (a) > (b) ? (b) : (a); (a) = _mx; (b) = _mn; } while (0)
__device__ __forceinline__ void sort16_desc(unsigned (&a)[16]) {
#pragma unroll
    for (int kk = 1; kk <= 4; ++kk)
#pragma unroll
        for (int jj = kk - 1; jj >= 0; --jj)
#pragma unroll
            for (int i = 0; i < 16; ++i) { const int k = 1 << kk, j = 1 << jj, l2 = i ^ j;
                if (l2 > i) { if ((i & k) == 0) CE_DESC(a[i], a[l2]); else CE_DESC(a[l2], a[i]); } }
}
__device__ __forceinline__ void merge_top16(unsigned (&a)[16], const unsigned (&b)[16]) {
#pragma unroll
    for (int i = 0; i < 16; ++i) a[i] = a[i] > b[15 - i] ? a[i] : b[15 - i];
#pragma unroll
    for (int jj = 3; jj >= 0; --jj)
#pragma unroll
        for (int i = 0; i < 16; ++i) { const int j = 1 << jj, l2 = i ^ j; if (l2 > i) CE_DESC(a[i], a[l2]); }
}
__device__ __forceinline__ void phase_topk(const KP& p, LAS unsigned char* lds, int G) {
    const int tid = opaque_tid(), lane = tid & 63, w = __builtin_amdgcn_readfirstlane(tid >> 6), hh = lane >> 5;
    const int gw = blockIdx.x * 8 + w, ngw = G * 8;
    const bf16_t* Q = (const bf16_t*)(p.ws + WS_R0); const bf16_t* KEYS = (const bf16_t*)(p.ws + WS_KEYS);
    unsigned* SEL = (unsigned*)(p.ws + WS_SEL);
    LAS unsigned char* tab = lds + w * 2048 + lane * 32;
    const int CI[50] = {0,0,0,0,0,0,0,0,0,0,0,0,0,0,0,0, 1,1,1,1,1,1,1,1, 2,2,2,2,2, 3,3,3,3, 4,4,4, 5,5, 6,6, 7,7, 8,9,10,11,12,13,14,15};
    const int CJ[50] = {0,1,2,3,4,5,6,7,8,9,10,11,12,13,14,15, 0,1,2,3,4,5,6,7, 0,1,2,3,4, 0,1,2,3, 0,1,2, 0,1, 0,1, 0,1, 0,0,0,0,0,0,0,0};
    LAS unsigned char* kimg = lds + 16384;
    for (int h = 0; h < 8; ++h) {
      __syncthreads();
#pragma unroll
      for (int i = 0; i < 8; ++i) { const int ch = tid + 512 * i, row = ch >> 4, c16 = ch & 15;
          *(LAS u32x4*)(kimg + row * 272 + c16 * 16) = *(const u32x4*)(KEYS + (size_t)(h * 256 + row) * 128 + c16 * 8); }
      __syncthreads();
      for (int tg = gw; tg < 2048; tg += ngw) {
        const int t = tg * 32 + (lane & 31);
        unsigned top[2][16];
#pragma unroll
        for (int pp = 0; pp < 2; ++pp) {
            bf16x8 qf[8];
#pragma unroll
            for (int ks = 0; ks < 8; ++ks) qf[ks] = *(const bf16x8*)(Q + ((size_t)((((tg * 8 + h) * 2 + pp) * 8 + ks) * 64 + lane)) * 8);
            const LAS unsigned char* kb = kimg + (pp * 128 + (lane & 31)) * 272 + 16 * hh;
#pragma unroll
            for (int nt = 0; nt < 4; ++nt) {
                f32x16 acc;
#pragma unroll
                for (int i = 0; i < 16; ++i) acc[i] = 0.f;
#pragma unroll
                for (int ks = 0; ks < 8; ++ks) { const bf16x8 kf = *(const LAS bf16x8*)(kb + (32 * nt) * 272 + 32 * ks);
                    acc = __builtin_amdgcn_mfma_f32_32x32x16_bf16(kf, qf[ks], acc, 0, 0, 0); }
                unsigned ky[16];
#pragma unroll
                for (int r = 0; r < 16; ++r) ky[r] = (fkey(acc[r]) & ~127u) | (unsigned)(32 * nt + (r & 3) + 8 * (r >> 2)) | (unsigned)(4 * hh);
                sort16_desc(ky);
                if (nt == 0) {
#pragma unroll
                    for (int i = 0; i < 16; ++i) top[pp][i] = ky[i];
                } else merge_top16(top[pp], ky);
            }
            unsigned other[16];
#pragma unroll
            for (int i = 0; i < 16; ++i) { const u32x2 sw_ = __builtin_amdgcn_permlane32_swap(top[pp][i], top[pp][i], false, false); other[i] = hh ? sw_[0] : sw_[1]; }
            merge_top16(top[pp], other);
        }
        float sa[16], sb[16];
#pragma unroll
        for (int i = 0; i < 16; ++i) { sa[i] = kval(top[0][i] & ~127u); sb[i] = kval(top[1][i] & ~127u); }
        unsigned c0[16], c1[16];
#pragma unroll
        for (int s = 0; s < 32; ++s) {
            unsigned key = 0u;
            if (s < 25) {
                const float v0 = sa[CI[s]] + sb[CJ[s]], v1 = sa[CI[25 + s]] + sb[CJ[25 + s]];
                const unsigned k0 = (fkey(v0) & ~255u) | (unsigned)(CI[s] * 16 + CJ[s]), k1 = (fkey(v1) & ~255u) | (unsigned)(CI[25 + s] * 16 + CJ[25 + s]);
                key = hh ? k1 : k0;
            }
            if (s < 16) c0[s] = key; else c1[s - 16] = key;
        }
        sort16_desc(c0); sort16_desc(c1); merge_top16(c0, c1);
#pragma unroll
        for (int i = 0; i < 16; ++i) { const u32x2 sw_ = __builtin_amdgcn_permlane32_swap(c0[i], c0[i], false, false); c1[i] = hh ? sw_[0] : sw_[1]; }
        merge_top16(c0, c1);
        {
            u32x4 wa, wb;
#pragma unroll
            for (int q4 = 0; q4 < 4; ++q4) {
                wa[q4] = (top[0][4 * q4] & 127u) | ((top[0][4 * q4 + 1] & 127u) << 8) | ((top[0][4 * q4 + 2] & 127u) << 16) | ((top[0][4 * q4 + 3] & 127u) << 24);
                wb[q4] = (top[1][4 * q4] & 127u) | ((top[1][4 * q4 + 1] & 127u) << 8) | ((top[1][4 * q4 + 2] & 127u) << 16) | ((top[1][4 * q4 + 3] & 127u) << 24);
            }
            *(LAS u32x4*)tab = wa; *(LAS u32x4*)(tab + 16) = wb;
        }
        float ev[16], esum = 0.f; const float vmax = kval(c0[0] & ~255u);
#pragma unroll
        for (int k = 0; k < 16; ++k) { ev[k] = __expf(kval(c0[k] & ~255u) - vmax); esum += ev[k]; }
        const float rs = 1.0f / esum;
        LDS_WAIT();
        unsigned outw[8]; const unsigned hmask = hh ? 0xffffffffu : 0u;
#pragma unroll
        for (int kk = 0; kk < 8; ++kk) {
            const unsigned key = c0[kk] ^ ((c0[kk] ^ c0[8 + kk]) & hmask); const float e = __uint_as_float(__float_as_uint(ev[kk]) ^ ((__float_as_uint(ev[kk]) ^ __float_as_uint(ev[8 + kk])) & hmask));
            const unsigned code = key & 255u, ia = tab[code >> 4], ib = tab[16 + (code & 15u)];
            outw[kk] = (pk2(0.f, e * rs) & 0xffff0000u) | (ia * 128u + ib);
        }
        u32x4* dst = (u32x4*)(SEL + (size_t)t * 128 + h * 16 + hh * 8);
        dst[0] = (u32x4){outw[0], outw[1], outw[2], outw[3]}; dst[1] = (u32x4){outw[4], outw[5], outw[6], outw[7]};
        LDS_WAIT();
      }
    }
    __syncthreads();
}

__device__ __forceinline__ void fp8x4_to_f32(unsigned w, float& a, float& b, float& c, float& d) {
    const f32x2 lo = __builtin_amdgcn_cvt_pk_f32_fp8((int)w, false), hi = __builtin_amdgcn_cvt_pk_f32_fp8((int)w, true); a = lo[0]; b = lo[1]; c = hi[0]; d = hi[1];
}
struct XSlice { int sl, rank, nloc; };
__device__ __forceinline__ XSlice xslice_of_block(const KP& p, volatile LAS unsigned* MISC, int G) {
    unsigned* bar = (unsigned*)(p.ws + WS_CTL) + 4096; unsigned cnt[8]; unsigned tot = 0; bool ok = true;
#pragma unroll
    for (int j = 0; j < 8; ++j) { cnt[j] = xb_ld(&bar[XB_XCNT(j)]); tot += cnt[j]; ok = ok && (cnt[j] > 0u); }
    ok = ok && (tot == (unsigned)G);
    XSlice x;
    if (ok) { const unsigned myx = MISC[16]; x.sl = (int)myx; x.rank = (int)MISC[17]; x.nloc = (int)cnt[myx & 7u]; }
    else { x.sl = (int)(blockIdx.x & 7); x.rank = (int)(blockIdx.x >> 3); x.nloc = (G - x.sl + 7) >> 3; }
    x.sl = __builtin_amdgcn_readfirstlane(x.sl); x.rank = __builtin_amdgcn_readfirstlane(x.rank); x.nloc = __builtin_amdgcn_readfirstlane(x.nloc);
    return x;
}
__device__ __forceinline__ float dot16_fp8(const u32x4 u, const float (&hf)[16]) {
    float d = 0.f;
#pragma unroll
    for (int j = 0; j < 4; ++j) { float f0, f1, f2, f3; fp8x4_to_f32(u[j], f0, f1, f2, f3);
        d = __builtin_fmaf(f0, hf[4 * j], d); d = __builtin_fmaf(f1, hf[4 * j + 1], d); d = __builtin_fmaf(f2, hf[4 * j + 2], d); d = __builtin_fmaf(f3, hf[4 * j + 3], d); }
    return d;
}
typedef __bf16 bf16v8 __attribute__((ext_vector_type(8)));
__device__ __forceinline__ float dot16_fp8_bf16(const u32x4 u, const bf16v8 h0, const bf16v8 h1) {
    float d0 = 0.f, d1 = 0.f;
    d0 = __builtin_amdgcn_fdot2_f32_bf16(__builtin_amdgcn_cvt_scalef32_pk_bf16_fp8(u[0], 1.0f, false), __builtin_shufflevector(h0, h0, 0, 1), d0, false);
    d1 = __builtin_amdgcn_fdot2_f32_bf16(__builtin_amdgcn_cvt_scalef32_pk_bf16_fp8(u[0], 1.0f, true),  __builtin_shufflevector(h0, h0, 2, 3), d1, false);
    d0 = __builtin_amdgcn_fdot2_f32_bf16(__builtin_amdgcn_cvt_scalef32_pk_bf16_fp8(u[1], 1.0f, false), __builtin_shufflevector(h0, h0, 4, 5), d0, false);
    d1 = __builtin_amdgcn_fdot2_f32_bf16(__builtin_amdgcn_cvt_scalef32_pk_bf16_fp8(u[1], 1.0f, true),  __builtin_shufflevector(h0, h0, 6, 7), d1, false);
    d0 = __builtin_amdgcn_fdot2_f32_bf16(__builtin_amdgcn_cvt_scalef32_pk_bf16_fp8(u[2], 1.0f, false), __builtin_shufflevector(h1, h1, 0, 1), d0, false);
    d1 = __builtin_amdgcn_fdot2_f32_bf16(__builtin_amdgcn_cvt_scalef32_pk_bf16_fp8(u[2], 1.0f, true),  __builtin_shufflevector(h1, h1, 2, 3), d1, false);
    d0 = __builtin_amdgcn_fdot2_f32_bf16(__builtin_amdgcn_cvt_scalef32_pk_bf16_fp8(u[3], 1.0f, false), __builtin_shufflevector(h1, h1, 4, 5), d0, false);
    d1 = __builtin_amdgcn_fdot2_f32_bf16(__builtin_amdgcn_cvt_scalef32_pk_bf16_fp8(u[3], 1.0f, true),  __builtin_shufflevector(h1, h1, 6, 7), d1, false);
    return d0 + d1;
}
__device__ __forceinline__ float dpp_sum8(float d) {
    d += __uint_as_float(__builtin_amdgcn_update_dpp(0, __float_as_uint(d), 0xB1, 0xF, 0xF, true));
    d += __uint_as_float(__builtin_amdgcn_update_dpp(0, __float_as_uint(d), 0x4E, 0xF, 0xF, true));
    d += __uint_as_float(__builtin_amdgcn_update_dpp(0, __float_as_uint(d), 0x141, 0xF, 0xF, true));
    return d;
}
__device__ __forceinline__ void phase_expert_u(const KP& p, LAS unsigned char* lds, volatile LAS unsigned* MISC, int l, int G) {
    const int tid = opaque_tid(), lane = tid & 63, w = __builtin_amdgcn_readfirstlane(tid >> 6), j = lane >> 3, c = lane & 7, i16 = lane & 15, kq = lane >> 4;
    const XSlice xs = xslice_of_block(p, MISC, G);
    const unsigned char* XF = p.ws + WS_XF8 + (size_t)xs.sl * M * 128; const unsigned char* Us = p.ws + WS_U + (size_t)(l & 1) * TAB_BYTES + (size_t)xs.sl * 16384 * 128;
    const unsigned* SEL = (const unsigned*)(p.ws + WS_SEL); unsigned* PDu = (unsigned*)(p.ws + WS_R0) + (size_t)xs.sl * M * 64;
    const int t0 = xs.rank * 8 + w, tstep = xs.nloc * 8;
    LAS unsigned char* ring = lds + w * 18176;
    LAS unsigned char* selb = ring + 16384; LAS unsigned char* hbuf = ring + 16384 + 1024; LAS unsigned char* pdscr = ring + 16384 + 1024 + 512;
    const int tlast = t0 + ((M - 1 - t0) / tstep) * tstep;
    const int ai = (int)((0x5172023724663367ull >> (4 * i16)) & 7ull);
    const int ch0 = (ai ^ (2 * kq)) & 7, ch1 = ch0 ^ 1;
    const int rowoff = (i16 >> 3) * 1024 + (i16 & 7) * 128;
    const bool diag = kq == (i16 >> 2);
    LAS unsigned short* pdw = (LAS unsigned short*)pdscr + 16 * (i16 & 7) + (i16 >> 3);
#define E1_CL(t) ((t) <= tlast ? (t) : tlast)
#define E1_DMA_SEL(t, par) do { const unsigned* sp = SEL + (size_t)E1_CL(t) * 128 + lane; \
            __builtin_amdgcn_global_load_lds(sp, (LAS unsigned*)(selb + (par) * 512), 4, 0, 0); __builtin_amdgcn_global_load_lds(sp + 64, (LAS unsigned*)(selb + (par) * 512 + 256), 4, 0, 0); } while (0)
#define E1_DMA_H(t, par) do { __builtin_amdgcn_global_load_lds((const unsigned*)(XF + (size_t)E1_CL(t) * 128) + lane, (LAS unsigned*)(hbuf + (par) * 256), 4, 0, 0); } while (0)
#define E1_DMA_ROW(i, idxv) do { __builtin_amdgcn_global_load_lds((const unsigned*)(Us + (size_t)((idxv) & 0x3fffu) * 128 + 16 * c), (LAS unsigned*)(ring + (i) * 1024), 16, 0, 0); } while (0)
    if (t0 < M) {
        E1_DMA_SEL(t0, 0); E1_DMA_SEL(t0 + tstep, 1); E1_DMA_H(t0, 0);
        asm volatile("s_waitcnt vmcnt(0)" ::: "memory");
        { u32x4 s0[4];
#pragma unroll
          for (int q = 0; q < 4; ++q) s0[q] = *(const LAS u32x4*)(selb + (16 * j + 4 * q) * 4);
#pragma unroll
          for (int i = 0; i < 16; ++i) E1_DMA_ROW(i, s0[i >> 2][i & 3]); }
        { PDu[(size_t)t0 * 64 + lane] = 0u; }
        int par = 0;
        for (int tok = t0; tok < M; tok += tstep, par ^= 1) {
            E1_DMA_SEL(tok + 2 * tstep, par); E1_DMA_H(tok + tstep, par ^ 1);
            asm volatile("s_waitcnt vmcnt(19)" ::: "memory");
            u32x4 sn[4];
#pragma unroll
            for (int q = 0; q < 4; ++q) sn[q] = *(const LAS u32x4*)(selb + (par ^ 1) * 512 + (16 * j + 4 * q) * 4);
            const i32x4 xb0 = *(const LAS i32x4*)(hbuf + par * 256 + 16 * ch0), xb1 = *(const LAS i32x4*)(hbuf + par * 256 + 16 * ch1);
            const i32x8 B = __builtin_shufflevector(xb0, xb1, 0, 1, 2, 3, 4, 5, 6, 7);
#pragma unroll
            for (int i0 = 0; i0 < 16; i0 += 4) {
                asm volatile("s_waitcnt vmcnt(16)" ::: "memory");
                const LAS unsigned char* rb = ring + i0 * 1024 + rowoff;
                const i32x4 a0 = *(const LAS i32x4*)(rb + 16 * ch0), a1 = *(const LAS i32x4*)(rb + 16 * ch1), a2 = *(const LAS i32x4*)(rb + 2048 + 16 * ch0), a3 = *(const LAS i32x4*)(rb + 2048 + 16 * ch1);
                asm volatile("s_waitcnt lgkmcnt(0)" ::: "memory");
#pragma unroll
                for (int r = 0; r < 4; ++r) E1_DMA_ROW(i0 + r, sn[(i0 + r) >> 2][(i0 + r) & 3]);
                const f32x4 z = {0.f, 0.f, 0.f, 0.f};
                const f32x4 d0 = __builtin_amdgcn_mfma_scale_f32_16x16x128_f8f6f4(__builtin_shufflevector(a0, a1, 0, 1, 2, 3, 4, 5, 6, 7), B, z, 0, 0, 0, 0x7f7f7f7f, 0, 0x7f7f7f7f);
                const f32x4 d1 = __builtin_amdgcn_mfma_scale_f32_16x16x128_f8f6f4(__builtin_shufflevector(a2, a3, 0, 1, 2, 3, 4, 5, 6, 7), B, z, 0, 0, 0, 0x7f7f7f7f, 0, 0x7f7f7f7f);
                const float v0 = (i16 & 2) ? ((i16 & 1) ? d0[3] : d0[2]) : ((i16 & 1) ? d0[1] : d0[0]), v1 = (i16 & 2) ? ((i16 & 1) ? d1[3] : d1[2]) : ((i16 & 1) ? d1[1] : d1[0]);
                if (diag) { pdw[i0] = (unsigned short)(pk2(v0, 0.f) & 0xffffu); pdw[i0 + 2] = (unsigned short)(pk2(v1, 0.f) & 0xffffu); }
            }
            asm volatile("s_waitcnt lgkmcnt(0)" ::: "memory");
            PDu[(size_t)tok * 64 + lane] = *(const LAS unsigned*)(pdscr + 4 * lane);
        }
        asm volatile("s_waitcnt vmcnt(0)" ::: "memory");
    }
#undef E1_CL
#undef E1_DMA_SEL
#undef E1_DMA_H
#undef E1_DMA_ROW
}
__device__ __forceinline__ void phase_expert_w(const KP& p, int G) {
    const int tid = opaque_tid(), lane = tid & 63, w = __builtin_amdgcn_readfirstlane(tid >> 6);
    const int gw = blockIdx.x * 8 + w, ngw = G * 8;
    unsigned* SEL = (unsigned*)(p.ws + WS_SEL); const unsigned* PDu = (const unsigned*)(p.ws + WS_R0);
    for (int tok0 = gw; tok0 < M; tok0 += 4 * ngw) {
        unsigned pw[4][8]; u32x2 s2[4];
#pragma unroll
        for (int k = 0; k < 4; ++k) { const int tok = (tok0 + k * ngw < M) ? tok0 + k * ngw : tok0;
#pragma unroll
            for (int sl = 0; sl < 8; ++sl) pw[k][sl] = PDu[((size_t)sl * M + tok) * 64 + lane];
            s2[k] = *(const u32x2*)(SEL + (size_t)tok * 128 + 2 * lane); }
#pragma unroll
        for (int k = 0; k < 4; ++k) { const int tok = tok0 + k * ngw;
            f32x2 d = {0.f, 0.f};
#pragma unroll
            for (int sl = 0; sl < 8; ++sl) { d[0] += bflo(pw[k][sl]); d[1] += bfhi(pw[k][sl]); }
            const float w0 = __uint_as_float(s2[k][0] & 0xffff0000u) * fgelu(d[0] * (1.0f / (U_SCALE * X_SCALE))) * (1.0f / V_SCALE);
            const float w1 = __uint_as_float(s2[k][1] & 0xffff0000u) * fgelu(d[1] * (1.0f / (U_SCALE * X_SCALE))) * (1.0f / V_SCALE);
            u32x2 o; o[0] = (pk2(0.f, w0) & 0xffff0000u) | (s2[k][0] & 0x3fffu); o[1] = (pk2(0.f, w1) & 0xffff0000u) | (s2[k][1] & 0x3fffu);
            if (tok < M) { *(u32x2*)(SEL + (size_t)tok * 128 + 2 * lane) = o;
                const int wq = __builtin_amdgcn_cvt_pk_fp8_f32(w0 * W8_SCALE, w1 * W8_SCALE, 0, false); const int s_ = (2 * lane) & 15, q_ = lane >> 3;
                unsigned char* wf = p.ws + WS_WF8 + (size_t)tok * 128 + 32 * (s_ >> 2) + 8 * (s_ & 3) + q_; wf[0] = (unsigned char)(wq & 255); wf[8] = (unsigned char)((wq >> 8) & 255); } }
    }
}
__device__ __forceinline__ void phase_expert_v(const KP& p, LAS unsigned char* lds, volatile LAS unsigned* MISC, int l, int G) {
    const int tid = opaque_tid(), lane = tid & 63, w = __builtin_amdgcn_readfirstlane(tid >> 6), j = lane >> 3, c = lane & 7, li = lane & 15, g = lane >> 4;
    const XSlice xs = xslice_of_block(p, MISC, G);
    const unsigned char* Vs = p.ws + WS_V + (size_t)(l & 1) * TAB_BYTES + (size_t)xs.sl * 16384 * 128;
    const unsigned* SEL = (const unsigned*)(p.ws + WS_SEL); const unsigned char* WF = p.ws + WS_WF8;
    const float* g2 = (const float*)(p.ws + WS_MOD) + (size_t)l * 32 * NMODC + 5120;
    const bf16_t* X = (const bf16_t*)p.out; bf16_t* XO = (l == DEPTH - 1) ? (bf16_t*)(p.ws + WS_YS) : (bf16_t*)p.out;
    const int t0 = xs.rank * 8 + w, tstep = xs.nloc * 8;
    LAS unsigned char* ring = lds + w * 19712; LAS unsigned char* selb = ring + 16384;
    LAS unsigned char* xbuf = ring + 16384 + 1024;
    LAS unsigned char* wbuf = ring + 16384 + 1024 + 512;
    LAS float* obuf = (LAS float*)(ring + 16384 + 1024 + 1024);
    const int tlast = t0 + ((M - 1 - t0) / tstep) * tstep;
    int troff[8];
#pragma unroll
    for (int n = 0; n < 8; ++n) troff[n] = (li >> 1) * 128 + 16 * (n ^ (li >> 1) ^ (g & 1)) + 8 * (li & 1);
    const int dim = xs.sl * 128 + 2 * lane;
#define E2_CL(t) ((t) <= tlast ? (t) : tlast)
#define E2_DMA_SEL(t, par) do { const unsigned* sp = SEL + (size_t)E2_CL(t) * 128 + lane; \
            __builtin_amdgcn_global_load_lds(sp, (LAS unsigned*)(selb + (par) * 512), 4, 0, 0); __builtin_amdgcn_global_load_lds(sp + 64, (LAS unsigned*)(selb + (par) * 512 + 256), 4, 0, 0); } while (0)
#define E2_DMA_WF(t, par) __builtin_amdgcn_global_load_lds((const unsigned*)(WF + (size_t)E2_CL(t) * 128) + lane, (LAS unsigned*)(wbuf + (par) * 256), 4, 0, 0)
#define E2_DMA_ROW(s_, idxv) do { __builtin_amdgcn_global_load_lds((const unsigned*)(Vs + (size_t)((idxv) & 0x3fffu) * 128 + 16 * (c ^ j ^ (((s_) >> 2) & 1))), (LAS unsigned*)(ring + (s_) * 1024), 16, 0, 0); } while (0)
#define E2_SLOT(k) (4 * ((k) & 3) + ((k) >> 2))
    if (t0 < M) {
        E2_DMA_SEL(t0, 0); E2_DMA_SEL(t0 + tstep, 1); E2_DMA_WF(t0, 0);
        asm volatile("s_waitcnt vmcnt(0)" ::: "memory");
        { u32x4 sc[4];
#pragma unroll
          for (int q = 0; q < 4; ++q) sc[q] = *(const LAS u32x4*)(selb + (16 * j + 4 * q) * 4);
#pragma unroll
          for (int k = 0; k < 16; ++k) { const int s_ = E2_SLOT(k); E2_DMA_ROW(s_, sc[s_ >> 2][s_ & 3]); } }
        { __builtin_amdgcn_global_load_lds((const unsigned*)(X + (size_t)t0 * D + dim), (LAS unsigned*)xbuf, 4, 0, 0); }
        int par = 0, bcur = -1; f32x2 gv = {0.f, 0.f};
        for (int tok = t0; tok < M; tok += tstep, par ^= 1) {
            const size_t xo = (size_t)tok * D + dim;
            if ((tok >> 11) != bcur) { bcur = tok >> 11; const f32x2 gl = *(const f32x2*)(g2 + (size_t)bcur * NMODC + dim); asm volatile("s_waitcnt vmcnt(0)" ::: "memory"); gv[0] = gl[0] * (1.0f / W8_SCALE); gv[1] = gl[1] * (1.0f / W8_SCALE); asm volatile("" : "+v"(gv)); }
            E2_DMA_SEL(tok + 2 * tstep, par);
            __builtin_amdgcn_global_load_lds((const unsigned*)(X + (size_t)E2_CL(tok + tstep) * D + dim), (LAS unsigned*)(xbuf + 256 * (par ^ 1)), 4, 0, 0);
            E2_DMA_WF(tok + tstep, par ^ 1);
            asm volatile("s_waitcnt vmcnt(21)" ::: "memory");
            u32x4 sn[4];
#pragma unroll
            for (int q = 0; q < 4; ++q) sn[q] = *(const LAS u32x4*)(selb + (par ^ 1) * 512 + (16 * j + 4 * q) * 4);
            i32x8 A;
            { const i32x4 wa = *(const LAS i32x4*)(wbuf + par * 256 + 32 * g), wb = *(const LAS i32x4*)(wbuf + par * 256 + 32 * g + 16);
#pragma unroll
              for (int q = 0; q < 4; ++q) { A[q] = (li == 0) ? wa[q] : 0; A[4 + q] = (li == 0) ? wb[q] : 0; } }
            int Bm[8][8];
#pragma unroll
            for (int t = 0; t < 4; ++t) {
                asm volatile("s_waitcnt vmcnt(17)" ::: "memory");
                const LAS unsigned char* sb = ring + (4 * g + t) * 1024;
#pragma unroll
                for (int n = 0; n < 8; ++n) { const i32x2 r2_ = __builtin_amdgcn_ds_read_tr8_b64_v2i32((LAS i32x2*)(sb + troff[n])); Bm[n][2 * t] = r2_[0]; Bm[n][2 * t + 1] = r2_[1]; }
                asm volatile("s_waitcnt lgkmcnt(0)" ::: "memory");
#pragma unroll
                for (int k = 4 * t; k < 4 * t + 4; ++k) { const int s_ = E2_SLOT(k); E2_DMA_ROW(s_, sn[s_ >> 2][s_ & 3]); }
            }
#pragma unroll
            for (int n = 0; n < 8; ++n) { const f32x4 z = {0.f, 0.f, 0.f, 0.f};
                const i32x8 Bv = {Bm[n][0], Bm[n][1], Bm[n][2], Bm[n][3], Bm[n][4], Bm[n][5], Bm[n][6], Bm[n][7]};
                f32x4 d = __builtin_amdgcn_mfma_scale_f32_16x16x128_f8f6f4(A, Bv, z, 0, 0, 0, 0x7f7f7f7f, 0, 0x7f7f7f7f);
                asm volatile("" : "+v"(d));
                const float d0_ = d[0] + 0.0f;
                if (g == 0) obuf[16 * n + li] = d0_; }
            asm volatile("s_waitcnt lgkmcnt(0)" ::: "memory");
            const f32x2 ov = *(const LAS f32x2*)(obuf + 2 * lane);
            asm volatile("s_waitcnt vmcnt(16)" ::: "memory");
            { const unsigned xw = *(const LAS unsigned*)(xbuf + 256 * par + 4 * lane); *(unsigned*)(XO + xo) = pk2(bflo(xw) + gv[0] * ov[0], bfhi(xw) + gv[1] * ov[1]); }
        }
        asm volatile("s_waitcnt vmcnt(0)" ::: "memory");
    }
#undef E2_CL
#undef E2_DMA_SEL
#undef E2_DMA_WF
#undef E2_DMA_ROW
#undef E2_SLOT
}

__device__ __forceinline__ void phase_final(const KP& p, int G) {
    const int tid = opaque_tid(), lane = tid & 63, w = __builtin_amdgcn_readfirstlane(tid >> 6);
    const int gw = blockIdx.x * 8 + w, ngw = G * 8;
    const float* fg = p.in[I_FG];
    for (int r0 = gw * 4; r0 < M; r0 += ngw * 4) {
        f32x4 v[4][4]; float ss[4];
#pragma unroll
        for (int i = 0; i < 4; ++i) { const u32x2* xr = (const u32x2*)((const bf16_t*)(p.ws + WS_YS) + (size_t)(r0 + i) * D) + lane;
#pragma unroll
            for (int j = 0; j < 4; ++j) { const u32x2 xw = xr[64 * j]; v[i][j] = (f32x4){bflo(xw[0]), bfhi(xw[0]), bflo(xw[1]), bfhi(xw[1])}; } }
#pragma unroll
        for (int i = 0; i < 4; ++i) { float t = 0.f;
#pragma unroll
            for (int j = 0; j < 4; ++j) t += (v[i][j][0] * v[i][j][0] + v[i][j][1] * v[i][j][1]) + (v[i][j][2] * v[i][j][2] + v[i][j][3] * v[i][j][3]);
            ss[i] = t; }
#pragma unroll
        for (int o = 1; o < 64; o <<= 1) {
#pragma unroll
            for (int i = 0; i < 4; ++i) ss[i] += __shfl_xor(ss[i], o); }
#pragma unroll
        for (int j = 0; j < 4; ++j) { const f32x4 g4 = *(const f32x4*)(fg + 256 * j + 4 * lane);
#pragma unroll
            for (int i = 0; i < 4; ++i) { const float rstd = __builtin_amdgcn_rsqf(ss[i] * (1.0f / D) + EPS); ((f32x4*)(p.out + (size_t)(r0 + i) * D) + lane)[64 * j] = v[i][j] * rstd * g4; } }
    }
}

__global__ void __launch_bounds__(512, 2) mk_fwd(KP p_) {
    extern __shared__ __attribute__((aligned(16))) unsigned char lds_raw[];
    LAS unsigned char* lds = (LAS unsigned char*)lds_raw;
    const int tid = threadIdx.x, G = gridDim.x;
    volatile LAS unsigned* MISC = (volatile LAS unsigned*)(lds + MISC_OFF);
    for (int i = tid; i < LDS_BYTES / 4; i += 512) ((LAS unsigned*)lds)[i] = 0u;
    __syncthreads();
    XcdBarrier bar = xcd_barrier_post((unsigned*)(p_.ws + WS_CTL) + 4096, MISC + 8);
    if (tid == 0) { const unsigned myx = xb_xcc_id(); MISC[16] = myx; MISC[17] = xb_add((unsigned*)(p_.ws + WS_CTL) + 8192 + 64 * (myx & 15u), 1u); }
    __syncthreads();
    const int lo = p_.gp_lo, hi = p_.gp_hi;
#ifndef PH_MASK
#define PH_MASK 0xFFFFF
#endif
#define IN(k) (lo <= (k) && (k) < hi)
#define EN(b) ((PH_MASK >> (b)) & 1)
#ifndef PH_REPEAT
#define PH_REPEAT 0
#endif
#define NREP(b) (((PH_REPEAT >> (b)) & 1) ? 2 : 1)
#define SEAM(k) do { if ((k) + 1 < hi) xcd_barrier(bar); } while (0)
    if (EN(12) && IN(GP_SETUP)) { const KP p = load_kp(); phase_setup(p, lds, G); SEAM(GP_SETUP); }
    for (int l = 0; l < DEPTH; ++l) {
        const int g0 = 1 + l * NPH;
        if (EN(0) && IN(g0 + 0)) { _Pragma("nounroll") for (int rep = 0; rep < NREP(0); ++rep) { const KP p = load_kp(); phase_conv_norm1(p, lds, l, G); } SEAM(g0 + 0); }
        if (EN(1) && IN(g0 + 1)) { const KP p = load_kp();
            pg8::Gemm g{(const bf16_t*)(p.ws + WS_H), (const bf16_t*)(p.ws + WS_WIN), M, 3072, D / 2, D / 2, D / 2}; pg8::StaticOrder S; S.init(M, 3072, G, (int)blockIdx.x);
            pg8::EpiStoreBf16 E{(bf16_t*)(p.ws + WS_R0), 3072, 1.0f / (WIN_SCALE * HIN_SCALE)};
            _Pragma("nounroll") for (int rep = 0; rep < NREP(1); ++rep) pg8::gemm_phase<pg8::EpiStoreBf16, pg8::StaticOrder, false, true, true>(lds, g, S, E);
            SEAM(g0 + 1);
        }
        if (EN(2) && IN(g0 + 2)) { _Pragma("nounroll") for (int rep = 0; rep < NREP(2); ++rep) { const KP p = load_kp(); phase_hgrn2(p, lds, l, G); } SEAM(g0 + 2); }
        if (EN(3) && IN(g0 + 3)) { const KP p = load_kp();
            pg8::Gemm g{(const bf16_t*)(p.ws + WS_H), (const bf16_t*)(p.ws + WS_WIN) + (size_t)3072 * (D / 2), M, 4096, D / 2, D / 2, D / 2}; pg8::StaticOrder S; S.init(M, 4096, G, (int)blockIdx.x);
            pg8::EpiStoreBf16 E{(bf16_t*)(p.ws + WS_R0), 4096, 1.0f / (WIN_SCALE * HIN_SCALE)};
            _Pragma("nounroll") for (int rep = 0; rep < NREP(3); ++rep) pg8::gemm_phase<pg8::EpiStoreBf16, pg8::StaticOrder, false, true, true>(lds, g, S, E);
            SEAM(g0 + 3);
        }
        #if DBG_SELFCHECK
        if (EN(4) && IN(g0 + 4)) {
#pragma nounroll
            for (int rep = 0; rep < 2; ++rep) { const KP p = load_kp(); size_t yo = rep ? WS_H : WS_YS; asm volatile("" : "+s"(yo)); phase_s5(p, lds, l, G, yo); SEAM(g0 + 4); }
            const KP p = load_kp();
            const unsigned* a = (const unsigned*)(p.ws + WS_YS); const unsigned* b2 = (const unsigned*)(p.ws + WS_H); unsigned bad = 0;
            for (size_t i = (size_t)blockIdx.x * 512 + opaque_tid(); i < (size_t)M * D / 2; i += (size_t)G * 512) bad += (a[i] != b2[i]) ? 1u : 0u;
            if (bad) atomicAdd((unsigned*)(p.ws + WS_CTL) + 64, bad);
            { const unsigned* h1 = (const unsigned*)(p.ws + WS_CTL) + 65536; const unsigned* h2 = h1 + 8192; const int u2 = blockIdx.x * 512 + opaque_tid();
              if (u2 < 2048) { if (h1[u2 * 4] != h2[u2 * 4]) atomicAdd((unsigned*)(p.ws + WS_CTL) + 128, 1u); if (h1[u2 * 4 + 1] != h2[u2 * 4 + 1]) atomicAdd((unsigned*)(p.ws + WS_CTL) + 192, 1u); if (h1[u2 * 4 + 2] != h2[u2 * 4 + 2]) atomicAdd((unsigned*)(p.ws + WS_CTL) + 256, 1u); } }
            SEAM(g0 + 4); }
#else
        if (EN(4) && IN(g0 + 4)) { _Pragma("nounroll") for (int rep = 0; rep < NREP(4); ++rep) { const KP p = load_kp(); phase_s5(p, lds, l, G, WS_YS); } SEAM(g0 + 4); }
#endif
        if (EN(5) && IN(g0 + 5)) { const KP p = load_kp();
            pg8::Gemm g{(const bf16_t*)(p.ws + WS_YS), (const bf16_t*)(p.ws + WS_WGLU), M, D, D, D, D}; pg8::StaticOrder S; S.init(M, D, G, (int)blockIdx.x);
            pg8::EpiGlu E{(const bf16_t*)(p.ws + WS_R0), (const bf16_t*)(p.ws + WS_YS), (const bf16_t*)(p.ws + WS_OR), (const float*)(p.ws + WS_SSQ), p.in[I_HNG] + l * 128, p.in[I_GLUB] + l * D, (bf16_t*)(p.ws + WS_H)};
            _Pragma("nounroll") for (int rep = 0; rep < NREP(5); ++rep) pg8::gemm_phase<pg8::EpiGlu, pg8::StaticOrder, true, true>(lds, g, S, E);
            SEAM(g0 + 5);
        }
        if (EN(6) && IN(g0 + 6)) { const KP p = load_kp();
            pg8::Gemm g{(const bf16_t*)(p.ws + WS_H), (const bf16_t*)(p.ws + WS_WOUT), M, D, D / 2, D / 2, D / 2}; pg8::StaticOrder S; S.init(M, D, G, (int)blockIdx.x);
            pg8::EpiStoreBf16 E{(bf16_t*)(p.ws + WS_OR), D, 1.0f / (WO_SCALE * MG_SCALE)};
            pg8::gemm_phase<pg8::EpiStoreBf16, pg8::StaticOrder, false, true, true>(lds, g, S, E);
            SEAM(g0 + 6);
        }
        if (EN(7) && IN(g0 + 7)) { const KP p = load_kp();
            const int t2 = opaque_tid(), lane = t2 & 63, wave = __builtin_amdgcn_readfirstlane(t2 >> 6);
            if (l == 0) resid_norm_rows<false>(p.in[I_X], (bf16_t*)p.out, (const bf16_t*)(p.ws + WS_OR), (bf16_t*)(p.ws + WS_H), p.ws + WS_XF8, p.in[I_N2G] + l * D, (const float*)(p.ws + WS_MOD) + (size_t)l * 32 * NMODC, blockIdx.x * 8 + wave, G * 8, lane);
            else resid_norm_rows<true>(p.out, (bf16_t*)p.out, (const bf16_t*)(p.ws + WS_OR), (bf16_t*)(p.ws + WS_H), p.ws + WS_XF8, p.in[I_N2G] + l * D, (const float*)(p.ws + WS_MOD) + (size_t)l * 32 * NMODC, blockIdx.x * 8 + wave, G * 8, lane);
            SEAM(g0 + 7);
        }
        if (EN(8) && IN(g0 + 8)) { const KP p = load_kp();
            pg8::Gemm g{(const bf16_t*)(p.ws + WS_H), (const bf16_t*)(p.ws + WS_WQ), M, 2048, D, D, D}; pg8::StaticOrder S; S.init(M, 2048, G, (int)blockIdx.x);
            pg8::EpiStoreQ E{(bf16_t*)(p.ws + WS_R0)};
            _Pragma("nounroll") for (int rep = 0; rep < NREP(8); ++rep) pg8::gemm_phase<pg8::EpiStoreQ, pg8::StaticOrder, true, true>(lds, g, S, E);
            SEAM(g0 + 8);
        }
        if (EN(9) && IN(g0 + 9)) { _Pragma("nounroll") for (int rep = 0; rep < NREP(9); ++rep) { const KP p = load_kp(); phase_topk(p, lds, G); } SEAM(g0 + 9); }
        if (EN(10) && IN(g0 + 10)) {
            { const KP p = load_kp(); phase_expert_u(p, lds, MISC, l, G); } xcd_barrier(bar);
            { const KP p = load_kp(); phase_expert_w(p, G); } xcd_barrier(bar);
            { const KP p = load_kp(); phase_expert_v(p, lds, MISC, l, G); }
            SEAM(g0 + 10); }
    }
    if (EN(13) && IN(GP_FINAL)) { const KP p = load_kp(); phase_final(p, G); }
#undef IN
#undef EN
#undef NREP
#undef SEAM
}

extern "C" void kernel_launch(void* const* d_in, const int* in_sizes, int n_in, void* d_out, int out_size, void* d_ws, size_t ws_size, hipStream_t stream) {
    static int grid = 0;
    if (grid == 0) {
        if (n_in != 25 || out_size != M * D || ws_size < WS_END) { fprintf(stderr, "kernel_launch: unexpected shapes (n_in %d, out %d, ws %zu < %zu)\n", n_in, out_size, ws_size, (size_t)WS_END); grid = -1; return; }
        int dev = 0, cus = 0, per_cu = 0;
        if (hipGetDevice(&dev) != hipSuccess || hipDeviceGetAttribute(&cus, hipDeviceAttributeMultiprocessorCount, dev) != hipSuccess) { grid = -1; return; }
        if (hipFuncSetAttribute((const void*)mk_fwd, hipFuncAttributeMaxDynamicSharedMemorySize, LDS_BYTES) != hipSuccess) { fprintf(stderr, "kernel_launch: hipFuncSetAttribute failed\n"); grid = -1; return; }
        if (hipOccupancyMaxActiveBlocksPerMultiprocessor(&per_cu, (const void*)mk_fwd, 512, LDS_BYTES) != hipSuccess || per_cu < 1) fprintf(stderr, "kernel_launch: occupancy query says %d\n", per_cu);
        (void)hipGetLastError();
        grid = cus;
    }
    if (grid < 0) return;
    (void)hipMemsetAsync((char*)d_ws + WS_CTL, 0, CTL_ZERO_BYTES, stream);
    KP a{};
    for (int i = 0; i < 25; ++i) a.in[i] = (const float*)d_in[i];
    a.out = (float*)d_out; a.ws = (unsigned char*)d_ws;
#if MK_LAUNCHES == 1
    a.gp_lo = 0; a.gp_hi = GP_END;
    hipLaunchKernelGGL(mk_fwd, dim3(grid), dim3(512), LDS_BYTES, stream, a);
#else
    for (int gp = 0; gp < GP_END; ++gp) { a.gp_lo = gp; a.gp_hi = gp + 1; hipLaunchKernelGGL(mk_fwd, dim3(grid), dim3(512), LDS_BYTES, stream, a); }
#endif
}
```
